# Optimizing an MI355X kernel written in HIP

```python
import jax, jax.numpy as jnp
from jax import lax
import numpy as np


D_MODEL = 1024
BATCH = 8
SEQ = 4096
DEPTH = 4

ROPE_THETA = 500000.0
Q_BLOCK = 128
LN_EPS = 1e-5
RMS_EPS = 1e-6
BRANCH_WIDTH = D_MODEL // 2
N_BRANCH = 3

A_HEADS = 8
A_HEAD_DIM = BRANCH_WIDTH // A_HEADS
A_ROT_DIM = A_HEAD_DIM // 4
IDX_HEADS = 8
IDX_HEAD_DIM = 64
IDX_TOPK_MAX = 256

B_GROUPS = 8
B_GROUP_DIM = BRANCH_WIDTH // B_GROUPS
B_CHUNK = 128

C_HEADS = 8
C_NOPE_DIM = 64
C_ROPE_DIM = 32
C_V_DIM = 64
C_Q_RANK = 256
C_KV_RANK = 128

N_EXPERTS = 32
TOP_K = 4
D_FF = D_MODEL
SWIGLU_LIMIT = 7.0
SWIGLU_ALPHA = 1.702

DEEPNORM_ALPHA = (2 * DEPTH) ** 0.25
DEEPNORM_BETA = (8 * DEPTH) ** -0.25

IN_SPLITS = (
    A_HEADS * A_HEAD_DIM,
    A_HEADS * A_HEAD_DIM,
    A_HEADS * A_HEAD_DIM,
    IDX_HEADS * IDX_HEAD_DIM,
    IDX_HEAD_DIM,
    IDX_HEADS,
    2 * BRANCH_WIDTH,
    C_Q_RANK,
    C_KV_RANK,
    C_ROPE_DIM,
    N_BRANCH * D_MODEL,
)
N_IN = sum(IN_SPLITS)

kernel_name = 'hybrid_dsa_gmlp_mla_moe_deepnorm'


def layer_norm(x, g, b):
    xf = x.astype(jnp.float32)
    mu = jnp.mean(xf, axis=-1, keepdims=True)
    var = jnp.mean(jnp.square(xf - mu), axis=-1, keepdims=True)
    y = (xf - mu) * lax.rsqrt(var + LN_EPS) * g.astype(jnp.float32) + b.astype(jnp.float32)
    return y.astype(x.dtype)


def rms_norm(x, g):
    xf = x.astype(jnp.float32)
    y = xf * lax.rsqrt(jnp.mean(jnp.square(xf), axis=-1, keepdims=True) + RMS_EPS) * g.astype(jnp.float32)
    return y.astype(x.dtype)


def rope_tables(positions, rot_dim):
    half = rot_dim // 2
    inv_freq = ROPE_THETA ** (-jnp.arange(half, dtype=jnp.float32) / half)
    ang = positions.astype(jnp.float32)[..., None] * inv_freq
    return jnp.cos(ang), jnp.sin(ang)


def apply_rope(x, cos, sin):
    half = cos.shape[-1]
    if x.ndim == 4:
        cos = cos[:, :, None]
        sin = sin[:, :, None]
    cos = cos.astype(x.dtype)
    sin = sin.astype(x.dtype)
    x1 = x[..., :half]
    x2 = x[..., half:2 * half]
    return jnp.concatenate([x1 * cos - x2 * sin, x2 * cos + x1 * sin, x[..., 2 * half:]], axis=-1)


def to_blocks(a, n_blocks):
    return a.reshape((a.shape[0], n_blocks, Q_BLOCK) + a.shape[2:]).swapaxes(0, 1)


def dsa_attention(q, k, v, iq, ik, iw):
    B_, S_ = q.shape[0], q.shape[1]
    n_sel = min(IDX_TOPK_MAX, S_ // 4)
    nb = S_ // Q_BLOCK
    key_pos = jnp.arange(S_)
    ik32 = ik.astype(jnp.float32)

    def one_block(args):
        qb, iqb, iwb, qpos = args
        s = jnp.einsum('bqhd,bsd->bqhs', iqb.astype(jnp.float32), ik32) * (IDX_HEAD_DIM ** -0.5)
        score = jnp.einsum('bqhs,bqh->bqs', jax.nn.relu(s), iwb.astype(jnp.float32))
        causal = key_pos[None, None, :] <= qpos[None, :, None]
        score = jnp.where(causal, score, -jnp.inf)
        _, sel = lax.top_k(score, n_sel)
        k_sel = jax.vmap(lambda kk, ii: kk[ii])(k, sel)
        v_sel = jax.vmap(lambda vv, ii: vv[ii])(v, sel)
        logits = jnp.einsum('bqhd,bqkhd->bhqk', qb, k_sel).astype(jnp.float32) * (A_HEAD_DIM ** -0.5)
        valid = sel <= qpos[None, :, None]
        logits = jnp.where(valid[:, None], logits, -jnp.inf)
        p = jax.nn.softmax(logits, axis=-1).astype(v.dtype)
        return jnp.einsum('bhqk,bqkhd->bqhd', p, v_sel)

    qpos_blocks = jnp.arange(S_).reshape(nb, Q_BLOCK)
    out = lax.map(one_block, (to_blocks(q, nb), to_blocks(iq, nb), to_blocks(iw, nb), qpos_blocks))
    return out.swapaxes(0, 1).reshape(B_, S_, -1)


def causal_block_attention(q, k, v):
    B_, S_ = q.shape[0], q.shape[1]
    nb = S_ // Q_BLOCK
    key_pos = jnp.arange(S_)
    scale = q.shape[-1] ** -0.5

    def one_block(args):
        qb, qpos = args
        logits = jnp.einsum('bqhd,bshd->bhqs', qb, k).astype(jnp.float32) * scale
        causal = key_pos[None, :] <= qpos[:, None]
        logits = jnp.where(causal, logits, -jnp.inf)
        p = jax.nn.softmax(logits, axis=-1).astype(v.dtype)
        return jnp.einsum('bhqs,bshd->bqhd', p, v)

    qpos_blocks = jnp.arange(S_).reshape(nb, Q_BLOCK)
    out = lax.map(one_block, (to_blocks(q, nb), qpos_blocks))
    return out.swapaxes(0, 1).reshape(B_, S_, -1)


def chunked_spatial_gating(u, v, w_s, b_s):
    B_, S_ = u.shape[0], u.shape[1]
    nc = S_ // B_CHUNK
    mask = jnp.tril(jnp.ones((B_CHUNK, B_CHUNK), dtype=bool))
    w = jnp.where(mask[None], w_s, 0)
    vc = v.reshape(B_, nc, B_CHUNK, B_GROUPS, B_GROUP_DIM)
    s = jnp.einsum('gij,bcjgd->bcigd', w, vc) + b_s.T[None, None, :, :, None]
    return u * s.reshape(B_, S_, -1)


def clamped_swiglu(h):
    glu, lin = jnp.split(h, 2, axis=-1)
    glu = jnp.minimum(glu, SWIGLU_LIMIT)
    lin = jnp.clip(lin, -SWIGLU_LIMIT, SWIGLU_LIMIT)
    return (lin + 1) * (glu * jax.nn.sigmoid(SWIGLU_ALPHA * glu))


def moe(x, rw, rb, wgu, bgu, wdn, bdn):
    B_, S_, D = x.shape
    xf = x.reshape(-1, D)
    logits = (xf @ rw + rb).astype(jnp.float32)
    top_v, top_i = lax.top_k(logits, TOP_K)
    top_w = jax.nn.softmax(top_v, axis=-1)
    gates = jnp.einsum('nk,nke->ne', top_w, jax.nn.one_hot(top_i, N_EXPERTS, dtype=jnp.float32)).astype(x.dtype)
    out = jnp.zeros_like(xf)
    for e in range(N_EXPERTS):
        h = clamped_swiglu(xf @ wgu[e] + bgu[e])
        out = out + gates[:, e:e + 1] * (h @ wdn[e] + bdn[e])
    return out.reshape(B_, S_, D)


def setup_inputs(seed: int = 0) -> dict:
    key = jax.random.key(seed)
    ks = jax.random.split(key, 24)
    L, D, W = DEPTH, D_MODEL, BRANCH_WIDTH
    nrm = lambda k, shape, scale: jax.random.normal(k, shape, jnp.float32) * scale
    return {
        'x': nrm(ks[0], (BATCH, SEQ, D), 1.0),
        'positions': jnp.broadcast_to(jnp.arange(SEQ, dtype=jnp.int32), (BATCH, SEQ)),
        'w_in': nrm(ks[1], (L, D, N_IN), D ** -0.5),
        'gm_norm_g': 1.0 + nrm(ks[2], (L, W), 0.02),
        'gm_norm_b': nrm(ks[3], (L, W), 0.02),
        'gm_w_s': nrm(ks[4], (L, B_GROUPS, B_CHUNK, B_CHUNK), B_CHUNK ** -0.5),
        'gm_b_s': 1.0 + nrm(ks[5], (L, B_GROUPS, B_CHUNK), 0.02),
        'mla_q_norm': 1.0 + nrm(ks[6], (L, C_Q_RANK), 0.02),
        'mla_kv_norm': 1.0 + nrm(ks[7], (L, C_KV_RANK), 0.02),
        'mla_w_uq': nrm(ks[8], (L, C_Q_RANK, C_HEADS * (C_NOPE_DIM + C_ROPE_DIM)), C_Q_RANK ** -0.5),
        'mla_w_ukv': nrm(ks[9], (L, C_KV_RANK, C_HEADS * (C_NOPE_DIM + C_V_DIM)), C_KV_RANK ** -0.5),
        'w_branch': nrm(ks[10], (L, N_BRANCH, W, D), W ** -0.5),
        'w_out': nrm(ks[11], (L, D, D), D ** -0.5 * DEEPNORM_BETA),
        'ln1_g': 1.0 + nrm(ks[12], (L, D), 0.02),
        'ln1_b': nrm(ks[13], (L, D), 0.02),
        'router_w': nrm(ks[14], (L, D, N_EXPERTS), D ** -0.5),
        'router_b': nrm(ks[15], (L, N_EXPERTS), 0.01),
        'exp_w_gu': nrm(ks[16], (L, N_EXPERTS, D, 2 * D_FF), D ** -0.5),
        'exp_b_gu': nrm(ks[17], (L, N_EXPERTS, 2 * D_FF), 0.02),
        'exp_w_dn': nrm(ks[18], (L, N_EXPERTS, D_FF, D), D_FF ** -0.5 * DEEPNORM_BETA),
        'exp_b_dn': nrm(ks[19], (L, N_EXPERTS, D), 0.02),
        'ln2_g': 1.0 + nrm(ks[20], (L, D), 0.02),
        'ln2_b': nrm(ks[21], (L, D), 0.02),
    }


def reference(x, positions, w_in, gm_norm_g, gm_norm_b, gm_w_s, gm_b_s, mla_q_norm, mla_kv_norm,
              mla_w_uq, mla_w_ukv, w_branch, w_out, ln1_g, ln1_b, router_w, router_b,
              exp_w_gu, exp_b_gu, exp_w_dn, exp_b_dn, ln2_g, ln2_b):
    B_, S_, _ = x.shape
    split_pts = [int(p) for p in np.cumsum(IN_SPLITS)[:-1]]
    cos_p, sin_p = rope_tables(positions, A_ROT_DIM)
    cos_c, sin_c = rope_tables(positions, C_ROPE_DIM)
    for l in range(DEPTH):
        h = x
        proj = h @ w_in[l]
        aq, ak, av, iq, ik, iw, buv, cdq, cdkv, ckr, gate_logits = jnp.split(proj, split_pts, axis=-1)

        aq = apply_rope(aq.reshape(B_, S_, A_HEADS, A_HEAD_DIM), cos_p, sin_p)
        ak = apply_rope(ak.reshape(B_, S_, A_HEADS, A_HEAD_DIM), cos_p, sin_p)
        av = av.reshape(B_, S_, A_HEADS, A_HEAD_DIM)
        iq = apply_rope(iq.reshape(B_, S_, IDX_HEADS, IDX_HEAD_DIM), cos_p, sin_p)
        ik = apply_rope(ik, cos_p, sin_p)
        iw = iw * (IDX_HEADS ** -0.5)
        o_a = dsa_attention(aq, ak, av, iq, ik, iw)

        u, v = jnp.split(jax.nn.gelu(buv, approximate=False), 2, axis=-1)
        v = layer_norm(v, gm_norm_g[l], gm_norm_b[l])
        o_b = chunked_spatial_gating(u, v, gm_w_s[l], gm_b_s[l])

        cq = rms_norm(cdq, mla_q_norm[l])
        q = (cq @ mla_w_uq[l]).reshape(B_, S_, C_HEADS, C_NOPE_DIM + C_ROPE_DIM)
        q = jnp.concatenate([q[..., :C_NOPE_DIM], apply_rope(q[..., C_NOPE_DIM:], cos_c, sin_c)], axis=-1)
        ckv = rms_norm(cdkv, mla_kv_norm[l])
        kv = (ckv @ mla_w_ukv[l]).reshape(B_, S_, C_HEADS, C_NOPE_DIM + C_V_DIM)
        k_rope = apply_rope(ckr, cos_c, sin_c)
        k = jnp.concatenate([kv[..., :C_NOPE_DIM],
                             jnp.broadcast_to(k_rope[:, :, None], (B_, S_, C_HEADS, C_ROPE_DIM))], axis=-1)
        o_c = causal_block_attention(q, k, kv[..., C_NOPE_DIM:])

        branches = jnp.stack([o_a, o_b, o_c], axis=2)
        br = jnp.einsum('bsnw,nwd->bsnd', branches, w_branch[l])
        gates = jax.nn.sigmoid(gate_logits.reshape(B_, S_, N_BRANCH, D_MODEL))
        merged = jnp.sum(gates * br, axis=2)
        y = merged @ w_out[l]
        x = layer_norm(DEEPNORM_ALPHA * h + y, ln1_g[l], ln1_b[l])

        f = moe(x, router_w[l], router_b[l], exp_w_gu[l], exp_b_gu[l], exp_w_dn[l], exp_b_dn[l])
        x = layer_norm(DEEPNORM_ALPHA * x + f, ln2_g[l], ln2_b[l])
    return x
```

```cpp
#include <hip/hip_runtime.h>
#include <cstdio>
#include <cstdint>

#ifndef MK_ONE_LAUNCH
#define MK_ONE_LAUNCH 1
#endif

#define LAS __attribute__((address_space(3)))
typedef unsigned short bf16_t;
typedef short bf16x8 __attribute__((ext_vector_type(8)));
typedef float f32x4 __attribute__((ext_vector_type(4)));
typedef float f32x16 __attribute__((ext_vector_type(16)));
typedef unsigned u32x4 __attribute__((ext_vector_type(4)));
typedef unsigned u32x2 __attribute__((ext_vector_type(2)));
typedef float f32x2_t __attribute__((ext_vector_type(2)));
typedef __bf16 bf16x2_t __attribute__((ext_vector_type(2)));

__device__ __forceinline__ unsigned pk2(float lo, float hi) { f32x2_t v = {lo, hi}; bf16x2_t b = __builtin_convertvector(v, bf16x2_t); return __builtin_bit_cast(unsigned, b); }
__device__ __forceinline__ float bf2f(unsigned short x) { return __uint_as_float(((unsigned)x) << 16); }
__device__ __forceinline__ float bflo(unsigned w) { return __uint_as_float(w << 16); }
__device__ __forceinline__ float bfhi(unsigned w) { return __uint_as_float(w & 0xffff0000u); }
template <int M> __device__ __forceinline__ float xswz(float v) { static_assert(M >= 1 && M <= 16, "xswz"); return __int_as_float(__builtin_amdgcn_ds_swizzle(__float_as_int(v), 0x1F | (M << 10))); }
template <int M> __device__ __forceinline__ unsigned xswzu(unsigned v) { return (unsigned)__builtin_amdgcn_ds_swizzle((int)v, 0x1F | (M << 10)); }
__device__ __forceinline__ float xsum32(float v) { auto rr = __builtin_amdgcn_permlane32_swap(__float_as_uint(v), __float_as_uint(v), false, false); return __uint_as_float(rr[0]) + __uint_as_float(rr[1]); }
__device__ __forceinline__ float xmax32(float v) { auto rr = __builtin_amdgcn_permlane32_swap(__float_as_uint(v), __float_as_uint(v), false, false); return fmaxf(__uint_as_float(rr[0]), __uint_as_float(rr[1])); }
__device__ __forceinline__ float xother32(float v, bool upper) { auto rr = __builtin_amdgcn_permlane32_swap(__float_as_uint(v), __float_as_uint(v), false, false); return __uint_as_float(upper ? rr[0] : rr[1]); }
#define LDS_WAIT() asm volatile("s_waitcnt lgkmcnt(0)" ::: "memory")
#define VM_WAIT() asm volatile("s_waitcnt vmcnt(0)" ::: "memory")

constexpr int NB = 8, SEQ = 4096, NTOK = NB * SEQ, DM = 1024, NLAYER = 4;
constexpr int NIN_SRC = 6632, NIN = 6656;
constexpr int NEXP = 32, TOPK = 4, DFF = 1024;
constexpr int NSLOT = NTOK * TOPK, NSLOT_PAD = NSLOT + NEXP * 256;
constexpr float LN_EPS = 1e-5f, RMS_EPS = 1e-6f;
constexpr float DN_ALPHA = 1.681792830507429f;
constexpr float LOG2E = 1.4426950408889634f;
constexpr float QSCALE_A = 0.125f * LOG2E;
constexpr float QSCALE_C = 0.10206207261596577f * LOG2E;
constexpr float IW_SCALE = 0.35355339059327373f * 0.125f;

constexpr size_t MiB = (size_t)1 << 20;
constexpr size_t WS_CTL = 0, CTL_ZERO_BYTES = 1 * MiB;
constexpr int CW_BAR = 4096, CW_CNT = 16384;
constexpr size_t SZ_WIN = (size_t)NIN * DM * 2, SZ_WUQ = (size_t)768 * 256 * 2, SZ_WUKV = (size_t)1024 * 256 * 2, SZ_WBR = (size_t)3 * 1024 * 512 * 2, SZ_WOUT = (size_t)1024 * 1024 * 2;
constexpr size_t SZ_WGU = (size_t)NEXP * 2048 * 1024 * 2, SZ_WDN = (size_t)NEXP * 1024 * 1024 * 2, SZ_WGM = (size_t)8 * 128 * 128 * 2;
constexpr size_t WS_WIN = 2 * MiB;
constexpr size_t WS_WUQ = WS_WIN + NLAYER * SZ_WIN;
constexpr size_t WS_WUKV = WS_WUQ + NLAYER * SZ_WUQ;
constexpr size_t WS_WBR = WS_WUKV + NLAYER * SZ_WUKV;
constexpr size_t WS_WOUT = WS_WBR + NLAYER * SZ_WBR;
constexpr size_t WS_WGU = WS_WOUT + NLAYER * SZ_WOUT;
constexpr size_t WS_WDN = WS_WGU + NLAYER * SZ_WGU;
constexpr size_t WS_WGM = WS_WDN + NLAYER * SZ_WDN;
constexpr size_t WS_COSA = WS_WGM + NLAYER * SZ_WGM;
constexpr size_t WS_SINA = WS_COSA + (size_t)NTOK * 8 * 4;
constexpr size_t WS_COSC = WS_SINA + (size_t)NTOK * 8 * 4;
constexpr size_t WS_SINC = WS_COSC + (size_t)NTOK * 16 * 4;
constexpr size_t WS_XRES = WS_SINC + (size_t)NTOK * 16 * 4;
constexpr size_t WS_XB = WS_XRES + (size_t)NTOK * DM * 4;
constexpr size_t WS_QA = WS_XB + (size_t)NTOK * DM * 2;
constexpr size_t WS_KA = WS_QA + (size_t)NTOK * 512 * 2;
constexpr size_t WS_VAT = WS_KA + (size_t)NTOK * 512 * 2;
constexpr size_t WS_IQ = WS_VAT + (size_t)NTOK * 512 * 2;
constexpr size_t WS_IK = WS_IQ + (size_t)NTOK * 512 * 2;
constexpr size_t WS_IW = WS_IK + (size_t)NTOK * 64 * 2;
constexpr size_t WS_U = WS_IW + (size_t)NTOK * 8 * 4;
constexpr size_t WS_V = WS_U + (size_t)NTOK * 512 * 2;
constexpr size_t WS_CDQ = WS_V + (size_t)NTOK * 512 * 2;
constexpr size_t WS_CDKV = WS_CDQ + (size_t)NTOK * 256 * 2;
constexpr size_t WS_SSQ = WS_CDKV + (size_t)NTOK * 256 * 2;
constexpr size_t WS_GATE = WS_SSQ + (size_t)NTOK * 8 * 4;
constexpr size_t WS_QC = WS_GATE + (size_t)NTOK * 3072 * 2;
constexpr size_t WS_KC = WS_QC + (size_t)NTOK * 768 * 2;
constexpr size_t WS_VCT = WS_KC + (size_t)NTOK * 768 * 2;
constexpr size_t WS_SCORE = WS_VCT + (size_t)NTOK * 512 * 2;
constexpr size_t WS_MASK = WS_SCORE + (size_t)NTOK * SEQ * 4;
constexpr size_t WS_OBUF = WS_MASK + (size_t)NTOK * 128 * 4;
constexpr size_t WS_MERGED = WS_OBUF + (size_t)3 * NTOK * 512 * 2;
constexpr size_t WS_TKE = WS_MERGED + (size_t)NTOK * DM * 2;
constexpr size_t WS_TKP = WS_TKE + (size_t)NSLOT * 4;
constexpr size_t WS_TKW = WS_TKP + (size_t)NSLOT * 4;
constexpr size_t WS_STK = WS_TKW + (size_t)NSLOT * 4;
constexpr size_t WS_SW = WS_STK + (size_t)NSLOT_PAD * 4;
constexpr size_t WS_XG = WS_SW + (size_t)NSLOT_PAD * 4;
constexpr size_t WS_H = WS_XG + (size_t)NSLOT_PAD * DM * 2;
constexpr size_t WS_Y = WS_H + (size_t)NSLOT_PAD * DFF * 2;
constexpr size_t WS_CCNT = WS_Y + (size_t)NSLOT_PAD * DM * 2;
constexpr size_t WS_END = WS_CCNT + (size_t)(NTOK / 128) * 32 * 4;
constexpr size_t WS_DRY = (WS_END + 255) & ~(size_t)255;
static_assert(WS_END < (size_t)4200 * MiB, "workspace map too large");
static_assert((WS_WIN % 256) == 0 && (WS_COSA % 256) == 0 && (WS_XRES % 256) == 0 && (WS_SCORE % 256) == 0 && (WS_XG % 256) == 0, "alignment");

constexpr int LDS_BYTES = 147456;
constexpr int MISC_OFF = 143360;
constexpr int NWAVES = 8;

#define XB_TMO      128
#define XB_XCNT(j)  (256  + 64 * (j))
#define XB_XSUB(j)  (1280 + 64 * (j))
#define XB_XGEN(j)  (2304 + 64 * (j))
#define XB_TOP      3328
#define XB_TOPGEN   3392
#define XCD_BAR_WORDS 3456
#define XB_SPIN_CAP (1u << 18)
__device__ __forceinline__ unsigned xb_ld(unsigned* p)              { return __hip_atomic_load(p, __ATOMIC_RELAXED, __HIP_MEMORY_SCOPE_AGENT); }
__device__ __forceinline__ unsigned xb_add(unsigned* p, unsigned v) { return __hip_atomic_fetch_add(p, v, __ATOMIC_RELAXED, __HIP_MEMORY_SCOPE_AGENT); }
__device__ __forceinline__ unsigned xb_xcc_id() { return (unsigned)__builtin_amdgcn_s_getreg((3 << 11) | 20) & 0xFu; }
#define XB_SPIN(cond, bar) do { unsigned _sp = 0; while (cond) { __builtin_amdgcn_s_sleep(1); \
    if ((++_sp & 255u) == 0u) { if (xb_ld(&(bar)[XB_TMO])) break; if (_sp > XB_SPIN_CAP) { atomicAdd(&(bar)[XB_TMO], 1u); break; } } } } while (0)
struct XcdBarrier { unsigned* bar; unsigned x; volatile LAS unsigned* st; };
__device__ __forceinline__ XcdBarrier xcd_barrier_post(unsigned* bar, volatile LAS unsigned* st) {
    XcdBarrier b; b.bar = bar; b.x = xb_xcc_id(); b.st = st;
    if (threadIdx.x == 0) (void)xb_add(&bar[XB_XCNT(b.x)], 1u);
    return b;
}
__device__ __forceinline__ void xcd_barrier_complete(unsigned* bar, unsigned x, unsigned& nloc, unsigned& nx) {
    const unsigned G = gridDim.x * gridDim.y * gridDim.z;
    unsigned sum, cnt, mine, sp = 0u;
    for (;;) {
        sum = 0u; cnt = 0u; mine = 0u;
#pragma unroll
        for (unsigned j = 0; j < 16; ++j) { const unsigned c = xb_ld(&bar[XB_XCNT(j)]); sum += c; cnt += (c > 0u) ? 1u : 0u; mine = (j == x) ? c : mine; }
        if (sum == G) break;
        __builtin_amdgcn_s_sleep(1);
        if ((++sp & 255u) == 0u) { if (xb_ld(&bar[XB_TMO])) break; if (sp > XB_SPIN_CAP) { atomicAdd(&bar[XB_TMO], 1u); break; } }
    }
    nloc = mine > 0u ? mine : 1u; nx = cnt > 0u ? cnt : 1u;
}
__device__ __forceinline__ void xcd_barrier(const XcdBarrier& b, bool leader_thread) {
    asm volatile("s_waitcnt vmcnt(0)" ::: "memory");
    __syncthreads();
    if (leader_thread) {
        unsigned* bar = b.bar;
        __builtin_amdgcn_s_waitcnt(0);
        unsigned nloc = b.st[0], nx = b.st[1];
        if (nloc == 0u) { xcd_barrier_complete(bar, b.x, nloc, nx); b.st[0] = nloc; b.st[1] = nx; }
        const unsigned old = xb_add(&bar[XB_XSUB(b.x)], 1u);
        const unsigned gen = old / nloc;
        if (old + 1u == (gen + 1u) * nloc) {
            __builtin_amdgcn_fence(__ATOMIC_RELEASE, "agent");
            asm volatile("s_waitcnt vmcnt(0)" ::: "memory");
            const unsigned og = xb_add(&bar[XB_TOP], 1u);
            const unsigned tg = og / nx;
            if (og + 1u == (tg + 1u) * nx) xb_add(&bar[XB_TOPGEN], 1u);
            else XB_SPIN(xb_ld(&bar[XB_TOPGEN]) == tg, bar);
            __builtin_amdgcn_fence(__ATOMIC_ACQUIRE, "agent");
            xb_add(&bar[XB_XGEN(b.x)], 1u);
            asm volatile("s_waitcnt vmcnt(0)" ::: "memory");
        } else {
            XB_SPIN(xb_ld(&bar[XB_XGEN(b.x)]) == gen, bar);
            __builtin_amdgcn_fence(__ATOMIC_ACQUIRE, "agent");
            asm volatile("s_waitcnt vmcnt(0)" ::: "memory");
        }
    }
    __syncthreads();
}

namespace pg8 {
constexpr int BM = 256, BK = 64, HALF = 128, HTB = HALF * BK * 2;
__host__ __device__ __forceinline__ int lds_byte(int r, int c) { const int st = (r >> 4) * 2 + (c >> 5), rr = r & 15, cc = c & 31, ob = rr * 64 + cc * 2; return st * 1024 + (ob ^ (((ob >> 9) & 1) << 5)); }
__host__ __device__ __forceinline__ void stage_rc(int b, int& R, int& C) { const int st = b / 1024, sb = b % 1024, swz = sb ^ (((sb >> 9) & 1) << 5); R = (st >> 1) * 16 + swz / 64; C = (st & 1) * 32 + (swz % 64) / 2; }
__host__ __device__ __forceinline__ int perm32(int rho) { const int n = rho >> 4, i = rho & 15; return 8 * (i >> 2) + 4 * n + (i & 3); }
struct Unit { int pm, pn; };
struct Gemm { const bf16_t* A; const bf16_t* Bt; int lda, K; const int* rowmap; };

template <class Epi, class Sched, bool GATHER = false>
__device__ __forceinline__ void gemm_phase(LAS unsigned char* lds, const Gemm g, const Sched& S, const Epi& E, int tid0) {
    int tid = tid0; asm volatile("" : "+v"(tid));
    const int wid = __builtin_amdgcn_readfirstlane(tid >> 6), lane = tid & 63, wr = wid >> 2, wc = wid & 3, fr = lane & 15, fq = lane >> 4;
    const int K = g.K, nt = K / BK, lda = g.lda;
    unsigned voffA[2], voffB[2]; unsigned colA2 = 0u;
#pragma unroll
    for (int i = 0; i < 2; ++i) { int R, C; stage_rc(tid * 16 + i * 8192, R, C); voffA[i] = (unsigned)(R * lda + C) * 2u; const int Rb = (R & ~31) + perm32(R & 31); voffB[i] = (unsigned)(Rb * K + C) * 2u; colA2 = (unsigned)C * 2u; }
    unsigned gcur[2] = {0u, 0u}, gnxt[2] = {0u, 0u};
#define PG8_GLOAD(d, pm_) do { int ln_; asm volatile("v_mbcnt_lo_u32_b32 %0, -1, 0\n\tv_mbcnt_hi_u32_b32 %0, -1, %0" : "=v"(ln_));   \
        int R0_, C0_; stage_rc(((wid << 6) | ln_) * 16, R0_, C0_); const int* rm_ = g.rowmap + (pm_) * BM + R0_; \
        d[0] = (unsigned)rm_[0] | ((unsigned)rm_[64] << 16); d[1] = (unsigned)rm_[HALF] | ((unsigned)rm_[HALF + 64] << 16); } while (0)
#define PG8_GOFF(p, i) ((((i) ? ((p) >> 16) : ((p) & 0xffffu)) * (unsigned)(lda * 2)) + colA2)
#define PG8_STAGE_G(bufoff, gbase, p) do { _Pragma("unroll") for (int _i = 0; _i < 2; ++_i) \
        __builtin_amdgcn_global_load_lds((const unsigned*)((const char*)(gbase) + PG8_GOFF(p, _i)), (LAS unsigned*)(lds + (bufoff) + ldsw + _i * 8192), 16, 0, 0); } while (0)
    const size_t kstep = (size_t)(BK * 2);
    const size_t hstepA = (size_t)HALF * lda * 2, hstepB = (size_t)HALF * K * 2;
    const size_t tstepA = 2 * hstepA, tstepB = 2 * hstepB;
    const unsigned ldsw = (unsigned)wid * 1024u;
    const int aoff = lds_byte(wr * 64 + fr, fq * 8), boff = lds_byte(wc * 32 + fr, fq * 8);
#define PG8_SA(b, h) (((b) * 2 + (h)) * HTB)
#define PG8_SB(b, h) ((4 + (b) * 2 + (h)) * HTB)
#define PG8_STAGE(bufoff, gbase, voff) do { _Pragma("unroll") for (int _i = 0; _i < 2; ++_i) \
        __builtin_amdgcn_global_load_lds((const unsigned*)((const char*)(gbase) + (voff)[_i]), (LAS unsigned*)(lds + (bufoff) + ldsw + _i * 8192), 16, 0, 0); } while (0)
#define PG8_STAGE_A(bufoff, gbase, half, nextu) do { if constexpr (GATHER) { if (nextu) PG8_STAGE_G(bufoff, gbase, gnxt[half]); else PG8_STAGE_G(bufoff, gbase, gcur[half]); } \
        else { PG8_STAGE(bufoff, (gbase) + ((half) ? hstepA : 0), voffA); } } while (0)
#define PG8_LDA(dst, b, h) do { _Pragma("unroll") for (int m = 0; m < 4; ++m) _Pragma("unroll") for (int k = 0; k < 2; ++k) dst[m][k] = *(const LAS bf16x8*)(lds + PG8_SA(b, h) + aoff + m * 2048 + k * 1024); } while (0)
#define PG8_LDB(dst, b, h) do { _Pragma("unroll") for (int n = 0; n < 2; ++n) _Pragma("unroll") for (int k = 0; k < 2; ++k) dst[n][k] = *(const LAS bf16x8*)(lds + PG8_SB(b, h) + boff + n * 2048 + k * 1024); } while (0)
#define PG8_MMA(ai, bj, At, Bt) do { __builtin_amdgcn_s_setprio(1); _Pragma("unroll") for (int m = 0; m < 4; ++m) _Pragma("unroll") for (int n = 0; n < 2; ++n) _Pragma("unroll") for (int k = 0; k < 2; ++k) \
        acc[ai][bj][m][n] = __builtin_amdgcn_mfma_f32_16x16x32_bf16(Bt[n][k], At[m][k], acc[ai][bj][m][n], 0, 0, 0); __builtin_amdgcn_s_setprio(0); } while (0)
#define PG8_WAIT_V(n) asm volatile("s_waitcnt vmcnt(" #n ")" ::: "memory")
#define PG8_WAIT_L(n) asm volatile("s_waitcnt lgkmcnt(" #n ")" ::: "memory")
#define PG8_BAR __builtin_amdgcn_s_barrier()
#define PG8_SCHED __builtin_amdgcn_sched_barrier(0)
    Unit cur, nxt; int ui = 0;
    if (!S.next(0, cur)) return;
    f32x4 acc[2][2][4][2];
#pragma unroll
    for (int a = 0; a < 2; ++a)
#pragma unroll
        for (int b = 0; b < 2; ++b)
#pragma unroll
            for (int m = 0; m < 4; ++m)
#pragma unroll
                for (int n = 0; n < 2; ++n) acc[a][b][m][n] = (f32x4){0.f, 0.f, 0.f, 0.f};
    bf16x8 At[4][2], B0[2][2], B1[2][2];
    const char* cA = GATHER ? (const char*)g.A : (const char*)g.A + (size_t)cur.pm * tstepA; const char* cB = (const char*)g.Bt + (size_t)cur.pn * tstepB;
    if constexpr (GATHER) { PG8_GLOAD(gcur, cur.pm); }
    PG8_STAGE(PG8_SB(0, 0), cB, voffB); PG8_STAGE(PG8_SB(0, 1), cB + hstepB, voffB); PG8_STAGE_A(PG8_SA(0, 0), cA, 0, false); PG8_STAGE_A(PG8_SA(0, 1), cA, 1, false);
    if (wr == 1) PG8_BAR;
    PG8_WAIT_V(2); PG8_BAR;
    PG8_STAGE(PG8_SB(1, 0), cB + kstep, voffB); PG8_STAGE_A(PG8_SA(1, 0), cA + kstep, 0, false); PG8_STAGE(PG8_SB(1, 1), cB + hstepB + kstep, voffB);
    PG8_WAIT_V(6); PG8_BAR;
    for (;;) {
        const bool has_next = S.next(ui + 1, nxt);
        const char* nA = GATHER ? cA : (has_next ? (const char*)g.A + (size_t)nxt.pm * tstepA : cA); const char* nB = has_next ? (const char*)g.Bt + (size_t)nxt.pn * tstepB : cB;
        if constexpr (GATHER) { if (has_next) { PG8_GLOAD(gnxt, nxt.pm); } else { gnxt[0] = gcur[0]; gnxt[1] = gcur[1]; } }
        for (int t = 0; t < nt; t += 2) {
            const bool last = (t == nt - 2);
            const char* a1 = cA + (size_t)(t + 1) * kstep;
            const char* a2 = last ? nA : cA + (size_t)(t + 2) * kstep; const char* b2 = last ? nB : cB + (size_t)(t + 2) * kstep;
            const char* a3 = a2 + kstep; const char* b3 = b2 + kstep;
            PG8_LDB(B0, 0, 0); PG8_LDB(B1, 0, 1); PG8_SCHED; PG8_LDA(At, 0, 0); PG8_STAGE_A(PG8_SA(1, 1), a1, 1, false);
            PG8_WAIT_V(8); PG8_WAIT_L(0); PG8_BAR; PG8_MMA(0, 0, At, B0); PG8_MMA(0, 1, At, B1); PG8_BAR; PG8_SCHED;
            PG8_LDA(At, 0, 1); PG8_STAGE(PG8_SB(0, 0), b2, voffB); PG8_STAGE(PG8_SB(0, 1), b2 + hstepB, voffB); PG8_STAGE_A(PG8_SA(0, 0), a2, 0, last);
            PG8_WAIT_V(8); PG8_WAIT_L(0); PG8_BAR; PG8_MMA(1, 0, At, B0); PG8_MMA(1, 1, At, B1); PG8_BAR; PG8_SCHED;
            PG8_LDB(B0, 1, 0); PG8_LDB(B1, 1, 1); PG8_SCHED; PG8_LDA(At, 1, 0); PG8_STAGE_A(PG8_SA(0, 1), a2, 1, last);
            PG8_WAIT_V(8); PG8_WAIT_L(0); PG8_BAR; PG8_MMA(0, 0, At, B0); PG8_MMA(0, 1, At, B1); PG8_BAR; PG8_SCHED;
            PG8_LDA(At, 1, 1); PG8_STAGE(PG8_SB(1, 0), b3, voffB); PG8_STAGE(PG8_SB(1, 1), b3 + hstepB, voffB); PG8_STAGE_A(PG8_SA(1, 0), a3, 0, last);
            PG8_WAIT_V(8); PG8_WAIT_L(0); PG8_BAR; PG8_MMA(1, 0, At, B0); PG8_MMA(1, 1, At, B1); PG8_BAR; PG8_SCHED;
        }
        if (wr == 0) PG8_BAR;
        { int el; asm volatile("v_mbcnt_lo_u32_b32 %0, -1, 0\n\tv_mbcnt_hi_u32_b32 %0, -1, %0" : "=v"(el));
          E(acc, cur, wr, wc, el & 15, el >> 4); }
        if (!has_next) break;
        if constexpr (!Epi::CHAIN) {
#pragma unroll
        for (int a = 0; a < 2; ++a)
#pragma unroll
            for (int b = 0; b < 2; ++b)
#pragma unroll
                for (int m = 0; m < 4; ++m)
#pragma unroll
                    for (int n = 0; n < 2; ++n) acc[a][b][m][n] = (f32x4){0.f, 0.f, 0.f, 0.f};
        }
        cur = nxt; cA = nA; cB = nB; ++ui;
        if constexpr (GATHER) { gcur[0] = gnxt[0]; gcur[1] = gnxt[1]; }
        if (wr == 1) PG8_BAR;
    }
    PG8_WAIT_V(0);
    PG8_BAR;
#undef PG8_SA
#undef PG8_SB
#undef PG8_STAGE
#undef PG8_LDA
#undef PG8_STAGE_A
#undef PG8_GLOAD
#undef PG8_GOFF
#undef PG8_STAGE_G
#undef PG8_LDB
#undef PG8_MMA
#undef PG8_WAIT_V
#undef PG8_WAIT_L
#undef PG8_BAR
#undef PG8_SCHED
}
}
using pg8::Unit;

struct Args { const float* in[23]; float* out; unsigned char* ws; int ph_lo, ph_hi; int sub, pad; };
struct Ctx {
    LAS unsigned char* lds;
    int tid, lane, wave, G, bid;
    unsigned char* ws;
};
#define WSP(T, off) ((T*)(C.ws + (off)))

struct GridOrder {
    int nN, total, G, c;
    __device__ __forceinline__ bool next(int i, Unit& u) const {
        const int L = c + i * G; if (L >= total) return false;
        const int nM = total / nN; int wgid;
        { const int q = total >> 3, r = total & 7, xcd = L & 7, off = L >> 3; wgid = (xcd < r ? xcd * (q + 1) : r * (q + 1) + (xcd - r) * q) + off; }
        const int nig = 8 * nN, gid = wgid / nig, fm = gid * 8, gsz = (nM - fm) < 8 ? (nM - fm) : 8, w = wgid - gid * nig;
        const int pn = w / gsz; u.pm = fm + (w - pn * gsz); u.pn = pn; return true;
    }
};
struct MergeOrder {
    int G, c;
    __device__ __forceinline__ bool next(int i, Unit& u) const { const int t = i / 3, n = i - 3 * t, tile = c + t * G; if (tile >= 512) return false; u.pm = n * 128 + (tile >> 2); u.pn = n * 4 + (tile & 3); return true; }
};
struct MoeOrder {
    int NT, total, G, c; const LAS int* tb;
    __device__ __forceinline__ bool next(int i, Unit& u) const {
        if ((G & 7) != 0) { const int idx = c + i * G; if (idx >= total) return false; const int mt = idx / NT, pn = idx - mt * NT;
            const int e = __builtin_amdgcn_readfirstlane(tb[40 + mt]); u.pm = mt; u.pn = e * NT + pn; return true; }
        const int T = __builtin_amdgcn_readfirstlane(tb[NEXP]), x = c & 7, lo = (x * T) >> 3, ntl = (((x + 1) * T) >> 3) - lo;
        const int j = (c >> 3) + i * (G >> 3);
        if (j >= ntl * NT) return false;
        const int gsh = (NT == 8) ? 6 : 5, gm = j >> gsh, rem = j - (gm << gsh);
        const int gs = (ntl - 8 * gm < 8) ? (ntl - 8 * gm) : 8, g4 = gs * 4, pg = (rem >= g4) ? 1 : 0, r2 = rem - pg * g4;
        const int mt = lo + 8 * gm + (r2 >> 2), e = __builtin_amdgcn_readfirstlane(tb[40 + mt]);
        u.pm = mt; u.pn = e * NT + pg * 4 + (r2 & 3); return true;
    }
};

__device__ __forceinline__ float gelu_f(float v) {
    const float av = fabsf(v), t = __builtin_amdgcn_rcpf(fmaf(av, 0.2316418882f, 1.0f));
    float q = fmaf(t, 0.5307027145f, -0.7265760135f); q = fmaf(q, t, 0.7107068705f); q = fmaf(q, t, -0.142248368f); q = fmaf(q, t, 0.127414796f); q = q * t;
    const float e = __builtin_amdgcn_exp2f((v * v) * (-0.72134752044f));
    const float m = v * (q * e);
    return v < 0.f ? m : v - m;
}
__device__ __forceinline__ float sigmoid_f(float x) { return __builtin_amdgcn_rcpf(1.f + __builtin_amdgcn_exp2f(x * (-LOG2E))); }
__device__ __forceinline__ int perm16(int o) { return (o & 3) | (((o >> 3) & 1) << 2) | (((o >> 2) & 1) << 3); }
__device__ __forceinline__ void st_bf4(bf16_t* p, f32x4 v) { u32x2 w; w.x = pk2(v[0], v[1]); w.y = pk2(v[2], v[3]); *(u32x2*)p = w; }
__device__ __forceinline__ f32x4 other32_4(f32x4 v, bool upper) { f32x4 r; r[0] = xother32(v[0], upper); r[1] = xother32(v[1], upper); r[2] = xother32(v[2], upper); r[3] = xother32(v[3], upper); return r; }

__device__ __forceinline__ void st_bf8(bf16_t* p, f32x4 v0, f32x4 v1) { u32x4 w; w.x = pk2(v0[0], v0[1]); w.y = pk2(v0[2], v0[3]); w.z = pk2(v1[0], v1[1]); w.w = pk2(v1[2], v1[3]); __builtin_nontemporal_store(w, (u32x4*)p); }
__device__ __forceinline__ f32x4 swz16_4(f32x4 v) { f32x4 r; r[0] = xswz<16>(v[0]); r[1] = xswz<16>(v[1]); r[2] = xswz<16>(v[2]); r[3] = xswz<16>(v[3]); return r; }
__device__ __forceinline__ void ld_bf8(const bf16_t* p, f32x4& a, f32x4& b) { const u32x4 w = *(const u32x4*)p; a = (f32x4){bflo(w.x), bfhi(w.x), bflo(w.y), bfhi(w.y)}; b = (f32x4){bflo(w.z), bfhi(w.z), bflo(w.w), bfhi(w.w)}; }
__device__ __forceinline__ void st_vt8(bf16_t* p, f32x4 v0, f32x4 v1) {
    const unsigned w0 = pk2(v0[0], v0[1]), w1 = pk2(v0[2], v0[3]), w2 = pk2(v1[0], v1[1]), w3 = pk2(v1[2], v1[3]);
    p[0] = (bf16_t)(w0 & 0xffff); p[SEQ] = (bf16_t)(w0 >> 16); p[2 * SEQ] = (bf16_t)(w1 & 0xffff); p[3 * SEQ] = (bf16_t)(w1 >> 16);
    p[4 * SEQ] = (bf16_t)(w2 & 0xffff); p[5 * SEQ] = (bf16_t)(w2 >> 16); p[6 * SEQ] = (bf16_t)(w3 & 0xffff); p[7 * SEQ] = (bf16_t)(w3 >> 16);
}
struct EpiInProj {
    static constexpr bool CHAIN = false;
    unsigned char* ws; bool skip;
    __device__ __forceinline__ void operator()(f32x4 (&acc)[2][2][4][2], const Unit& un, int wr, int wc, int fr, int fq) const {
        if (skip) return;
        const int pn = un.pn; const int row0 = un.pm * 256 + wr * 64 + fr;
        const float* cosA = (const float*)(ws + WS_COSA); const float* sinA = (const float*)(ws + WS_SINA); const float* cosC = (const float*)(ws + WS_COSC); const float* sinC = (const float*)(ws + WS_SINC);
        if (pn < 4 || pn == 6 || pn == 7) {
            const size_t doff = pn < 2 ? WS_QA : (pn < 4 ? WS_KA : WS_IQ); bf16_t* dst = (bf16_t*)(ws + doff); const float sc = pn < 2 ? QSCALE_A : 1.f; const int tcol = (pn & 1) * 256;
            const bool rope = (wc & 1) == 0;
#pragma unroll
            for (int ai = 0; ai < 2; ++ai)
#pragma unroll
                for (int m = 0; m < 4; ++m) { const int row = row0 + ai * 128 + m * 16;
                    f32x4 c0 = {1.f, 1.f, 1.f, 1.f}, c1 = c0, s0 = {0.f, 0.f, 0.f, 0.f}, s1 = s0;
                    if (rope) { c0 = *(const f32x4*)(cosA + (size_t)row * 8); c1 = *(const f32x4*)(cosA + (size_t)row * 8 + 4); s0 = *(const f32x4*)(sinA + (size_t)row * 8); s1 = *(const f32x4*)(sinA + (size_t)row * 8 + 4); }
#pragma unroll
                    for (int bj = 0; bj < 2; ++bj) { f32x4 v0 = acc[ai][bj][m][0], v1 = acc[ai][bj][m][1];
                        const f32x4 p0 = swz16_4(v0), p1 = swz16_4(v1);
                        if (rope && fq < 2) { v0 = (fq == 0) ? (v0 * c0 - p0 * s0) : (v0 * c0 + p0 * s0); v1 = (fq == 0) ? (v1 * c1 - p1 * s1) : (v1 * c1 + p1 * s1); }
                        st_bf8(dst + (size_t)row * 512 + tcol + bj * 128 + wc * 32 + 8 * fq, v0 * sc, v1 * sc); } }
        } else if (pn < 6) {
            bf16_t* vat = (bf16_t*)(ws + WS_VAT);
#pragma unroll
            for (int ai = 0; ai < 2; ++ai)
#pragma unroll
                for (int m = 0; m < 4; ++m) { const int row = row0 + ai * 128 + m * 16; const int b = row >> 12, s = row & 4095, ps = (s & ~15) | perm16(s & 15);
#pragma unroll
                    for (int bj = 0; bj < 2; ++bj) { const int c = (pn - 4) * 256 + bj * 128 + wc * 32 + 8 * fq; const int h = c >> 6, d = c & 63;
                        st_vt8(vat + ((size_t)(b * 8 + h) * 64 + d) * SEQ + ps, acc[ai][bj][m][0], acc[ai][bj][m][1]); } }
        } else if (pn == 8) {
            bf16_t* ik = (bf16_t*)(ws + WS_IK); float* iw = (float*)(ws + WS_IW); bf16_t* kc = (bf16_t*)(ws + WS_KC); bf16_t* cd = (bf16_t*)(ws + WS_CDKV); float* ssq = (float*)(ws + WS_SSQ);
#pragma unroll
            for (int ai = 0; ai < 2; ++ai)
#pragma unroll
                for (int m = 0; m < 4; ++m) { const int row = row0 + ai * 128 + m * 16;
                    { f32x4 v0 = acc[ai][0][m][0], v1 = acc[ai][0][m][1];
                      { unsigned zz = 0u; asm volatile("" : "+v"(zz)); const u32x4 z = {zz, zz, zz, zz}; *(u32x4*)(cd + (size_t)row * 256 + wc * 32 + 8 * fq) = z; }
                      if (wc == 0) {
                          const f32x4 p0 = swz16_4(v0), p1 = swz16_4(v1);
                          if (fq < 2) { const f32x4 c0 = *(const f32x4*)(cosA + (size_t)row * 8), c1 = *(const f32x4*)(cosA + (size_t)row * 8 + 4), s0 = *(const f32x4*)(sinA + (size_t)row * 8), s1 = *(const f32x4*)(sinA + (size_t)row * 8 + 4);
                              v0 = (fq == 0) ? (v0 * c0 - p0 * s0) : (v0 * c0 + p0 * s0); v1 = (fq == 0) ? (v1 * c1 - p1 * s1) : (v1 * c1 + p1 * s1); }
                          st_bf8(ik + (size_t)row * 64 + 8 * fq, v0, v1);
                      } else if (wc == 1) { st_bf8(ik + (size_t)row * 64 + 32 + 8 * fq, v0, v1);
                      } else if (wc == 2) { if (fq == 0) { *(f32x4*)(iw + (size_t)row * 8) = v0 * IW_SCALE; *(f32x4*)(iw + (size_t)row * 8 + 4) = v1 * IW_SCALE; }
                      } else {
                          const bool up = fq >= 2; const f32x4 p0 = other32_4(v0, up), p1 = other32_4(v1, up);
                          const f32x4 c0 = *(const f32x4*)(cosC + (size_t)row * 16 + 8 * (fq & 1)), c1 = *(const f32x4*)(cosC + (size_t)row * 16 + 8 * (fq & 1) + 4), s0 = *(const f32x4*)(sinC + (size_t)row * 16 + 8 * (fq & 1)), s1 = *(const f32x4*)(sinC + (size_t)row * 16 + 8 * (fq & 1) + 4);
                          const f32x4 o0 = up ? (v0 * c0 + p0 * s0) : (v0 * c0 - p0 * s0), o1 = up ? (v1 * c1 + p1 * s1) : (v1 * c1 - p1 * s1);
                          bf16_t* p = kc + (size_t)row * 768 + 64 + 8 * fq;
#pragma unroll
                          for (int h = 0; h < 8; ++h) st_bf8(p + h * 96, o0, o1); } }
                    { const f32x4 v0 = acc[ai][1][m][0], v1 = acc[ai][1][m][1];
                      st_bf8(cd + (size_t)row * 256 + 128 + wc * 32 + 8 * fq, v0, v1);
                      float s = (v0[0] * v0[0] + v0[1] * v0[1]) + (v0[2] * v0[2] + v0[3] * v0[3]) + (v1[0] * v1[0] + v1[1] * v1[1]) + (v1[2] * v1[2] + v1[3] * v1[3]);
                      s += xswz<16>(s); s = xsum32(s);
                      if (fq == 0) ssq[(size_t)row * 8 + 4 + wc] = s; } }
        } else if (pn < 13) {
            bf16_t* dst = (bf16_t*)(ws + (pn < 11 ? WS_U : WS_V)); const int tcol = ((pn - 9) & 1) * 256;
#pragma unroll
            for (int ai = 0; ai < 2; ++ai)
#pragma unroll
                for (int m = 0; m < 4; ++m) { const int row = row0 + ai * 128 + m * 16;
#pragma unroll
                    for (int bj = 0; bj < 2; ++bj) { f32x4 v0 = acc[ai][bj][m][0], v1 = acc[ai][bj][m][1];
                        v0[0] = gelu_f(v0[0]); v0[1] = gelu_f(v0[1]); v0[2] = gelu_f(v0[2]); v0[3] = gelu_f(v0[3]); v1[0] = gelu_f(v1[0]); v1[1] = gelu_f(v1[1]); v1[2] = gelu_f(v1[2]); v1[3] = gelu_f(v1[3]);
                        st_bf8(dst + (size_t)row * 512 + tcol + bj * 128 + wc * 32 + 8 * fq, v0, v1); } }
        } else if (pn == 13) {
            bf16_t* cd = (bf16_t*)(ws + WS_CDQ); float* ssq = (float*)(ws + WS_SSQ);
#pragma unroll
            for (int ai = 0; ai < 2; ++ai)
#pragma unroll
                for (int m = 0; m < 4; ++m) { const int row = row0 + ai * 128 + m * 16; float s = 0.f;
#pragma unroll
                    for (int bj = 0; bj < 2; ++bj) { const f32x4 v0 = acc[ai][bj][m][0], v1 = acc[ai][bj][m][1];
                        st_bf8(cd + (size_t)row * 256 + bj * 128 + wc * 32 + 8 * fq, v0, v1);
                        s += ((v0[0] * v0[0] + v0[1] * v0[1]) + (v0[2] * v0[2] + v0[3] * v0[3])) + ((v1[0] * v1[0] + v1[1] * v1[1]) + (v1[2] * v1[2] + v1[3] * v1[3])); }
                    s += xswz<16>(s); s = xsum32(s);
                    if (fq == 0) ssq[(size_t)row * 8 + wc] = s; }
        } else {
            const int tcol = (pn - 14) * 256; bf16_t* gate = (bf16_t*)(ws + WS_GATE);
#pragma unroll
            for (int ai = 0; ai < 2; ++ai)
#pragma unroll
                for (int m = 0; m < 4; ++m) { const int row = row0 + ai * 128 + m * 16;
#pragma unroll
                    for (int bj = 0; bj < 2; ++bj) { f32x4 v0 = acc[ai][bj][m][0], v1 = acc[ai][bj][m][1];
                        v0[0] = sigmoid_f(v0[0]); v0[1] = sigmoid_f(v0[1]); v0[2] = sigmoid_f(v0[2]); v0[3] = sigmoid_f(v0[3]); v1[0] = sigmoid_f(v1[0]); v1[1] = sigmoid_f(v1[1]); v1[2] = sigmoid_f(v1[2]); v1[3] = sigmoid_f(v1[3]);
                        st_bf8(gate + (size_t)row * 3072 + tcol + bj * 128 + wc * 32 + 8 * fq, v0, v1); } }
        }
    }
};

struct EpiQUp {
    static constexpr bool CHAIN = false;
    bf16_t* qc; const float* ssq; const float *cosC, *sinC;
    __device__ __forceinline__ void operator()(f32x4 (&acc)[2][2][4][2], const Unit& un, int wr, int wc, int fr, int fq) const {
        const int row0 = un.pm * 256 + wr * 64 + fr; const bool up = fq >= 2;
#pragma unroll
        for (int ai = 0; ai < 2; ++ai)
#pragma unroll
            for (int m = 0; m < 4; ++m) { const int row = row0 + ai * 128 + m * 16;
                const f32x4 sp = *(const f32x4*)(ssq + (size_t)row * 8);
                const float rs = rsqrtf(((sp[0] + sp[1]) + (sp[2] + sp[3])) * (1.f / 256.f) + RMS_EPS) * QSCALE_C;
                const f32x4 c0 = *(const f32x4*)(cosC + (size_t)row * 16 + 8 * (fq & 1)), c1 = *(const f32x4*)(cosC + (size_t)row * 16 + 8 * (fq & 1) + 4), s0 = *(const f32x4*)(sinC + (size_t)row * 16 + 8 * (fq & 1)), s1 = *(const f32x4*)(sinC + (size_t)row * 16 + 8 * (fq & 1) + 4);
#pragma unroll
                for (int bj = 0; bj < 2; ++bj) { const int gidx = un.pn * 8 + bj * 4 + wc;
                    f32x4 v0 = acc[ai][bj][m][0] * rs, v1 = acc[ai][bj][m][1] * rs;
                    if ((gidx % 3) == 2) { const f32x4 p0 = other32_4(v0, up), p1 = other32_4(v1, up);
                        v0 = up ? (v0 * c0 + p0 * s0) : (v0 * c0 - p0 * s0); v1 = up ? (v1 * c1 + p1 * s1) : (v1 * c1 - p1 * s1); }
                    st_bf8(qc + (size_t)row * 768 + gidx * 32 + 8 * fq, v0, v1); } }
    }
};
struct EpiKvUp {
    static constexpr bool CHAIN = false;
    bf16_t *kc, *vct; const float* ssq;
    __device__ __forceinline__ void operator()(f32x4 (&acc)[2][2][4][2], const Unit& un, int wr, int wc, int fr, int fq) const {
        const int row0 = un.pm * 256 + wr * 64 + fr;
#pragma unroll
        for (int ai = 0; ai < 2; ++ai)
#pragma unroll
            for (int m = 0; m < 4; ++m) { const int row = row0 + ai * 128 + m * 16;
                const f32x4 sp = *(const f32x4*)(ssq + (size_t)row * 8 + 4);
                const float rs = rsqrtf(((sp[0] + sp[1]) + (sp[2] + sp[3])) * (1.f / 128.f) + RMS_EPS);
                const int b = row >> 12, s = row & 4095, ps = (s & ~15) | perm16(s & 15);
#pragma unroll
                for (int bj = 0; bj < 2; ++bj) { const int h = un.pn * 2 + bj; const f32x4 v0 = acc[ai][bj][m][0] * rs, v1 = acc[ai][bj][m][1] * rs;
                    if (wc < 2) st_bf8(kc + (size_t)row * 768 + h * 96 + wc * 32 + 8 * fq, v0, v1);
                    else st_vt8(vct + ((size_t)(b * 8 + h) * 64 + (wc - 2) * 32 + 8 * fq) * SEQ + ps, v0, v1); }
                asm volatile("" ::: "memory"); }
    }
};
struct EpiMerge {
    static constexpr bool CHAIN = true;
    const bf16_t* gate; bf16_t* merged;
    __device__ __forceinline__ void operator()(f32x4 (&acc)[2][2][4][2], const Unit& un, int wr, int wc, int fr, int fq) const {
        const int n3 = un.pm >> 7, pm = un.pm & 127, pn = un.pn & 3; const int row0 = pm * 256 + wr * 64 + fr;
#pragma unroll
        for (int ai = 0; ai < 2; ++ai)
#pragma unroll
            for (int m = 0; m < 4; ++m) { const int row = row0 + ai * 128 + m * 16;
#pragma unroll
                for (int bj = 0; bj < 2; ++bj) { const int col = pn * 256 + bj * 128 + wc * 32 + 8 * fq;
                    const bf16_t* gp = gate + (size_t)row * 3072 + n3 * 1024 + col;
                    f32x4 ga0, ga1; ld_bf8(gp, ga0, ga1);
                    if (n3 < 2) { f32x4 gb0, gb1; ld_bf8(gp + 1024, gb0, gb1);
#pragma unroll
                        for (int j = 0; j < 4; ++j) { if (n3 == 1) { ga0[j] = fmaxf(ga0[j], 1e-20f); ga1[j] = fmaxf(ga1[j], 1e-20f); }
                            acc[ai][bj][m][0][j] *= ga0[j] * __builtin_amdgcn_rcpf(fmaxf(gb0[j], 1e-20f)); acc[ai][bj][m][1][j] *= ga1[j] * __builtin_amdgcn_rcpf(fmaxf(gb1[j], 1e-20f)); }
                    } else {
#pragma unroll
                        for (int j = 0; j < 4; ++j) { ga0[j] = fmaxf(ga0[j], 1e-20f); ga1[j] = fmaxf(ga1[j], 1e-20f); }
                        st_bf8(merged + (size_t)row * 1024 + col, acc[ai][bj][m][0] * ga0, acc[ai][bj][m][1] * ga1);
                        acc[ai][bj][m][0] = (f32x4){0.f, 0.f, 0.f, 0.f}; acc[ai][bj][m][1] = (f32x4){0.f, 0.f, 0.f, 0.f};
                    } } }
    }
};
struct EpiOut {
    static constexpr bool CHAIN = false;
    bf16_t* yo;
    __device__ __forceinline__ void operator()(f32x4 (&acc)[2][2][4][2], const Unit& un, int wr, int wc, int fr, int fq) const {
        const int row0 = un.pm * 256 + wr * 64 + fr;
#pragma unroll
        for (int ai = 0; ai < 2; ++ai)
#pragma unroll
            for (int m = 0; m < 4; ++m) { const int row = row0 + ai * 128 + m * 16;
#pragma unroll
                for (int bj = 0; bj < 2; ++bj) st_bf8(yo + (size_t)row * 1024 + un.pn * 256 + bj * 128 + wc * 32 + 8 * fq, acc[ai][bj][m][0], acc[ai][bj][m][1]); }
    }
};
struct EpiMoeUp {
    static constexpr bool CHAIN = false;
    bf16_t* hbuf; const float* bgu;
    __device__ __forceinline__ void operator()(f32x4 (&acc)[2][2][4][2], const Unit& un, int wr, int wc, int fr, int fq) const {
        const int e = un.pn >> 3, pnl = un.pn & 7; const int row0 = un.pm * 256 + wr * 64 + fr; const float* be = bgu + (size_t)e * 2048;
        const int jh = pnl * 128 + wc * 32 + 8 * fq;
        const f32x4 bg0 = *(const f32x4*)(be + jh), bg1 = *(const f32x4*)(be + jh + 4), bl0 = *(const f32x4*)(be + 1024 + jh), bl1 = *(const f32x4*)(be + 1024 + jh + 4);
#pragma unroll
        for (int ai = 0; ai < 2; ++ai)
#pragma unroll
            for (int m = 0; m < 4; ++m) { const int row = row0 + ai * 128 + m * 16;
                const f32x4 g0 = acc[ai][0][m][0] + bg0, g1 = acc[ai][0][m][1] + bg1, l0 = acc[ai][1][m][0] + bl0, l1 = acc[ai][1][m][1] + bl1; f32x4 o0, o1;
#pragma unroll
                for (int j = 0; j < 4; ++j) { const float ga = fminf(g0[j], 7.f), la = fminf(fmaxf(l0[j], -7.f), 7.f); o0[j] = (la + 1.f) * (ga * sigmoid_f(1.702f * ga));
                    const float gb = fminf(g1[j], 7.f), lb = fminf(fmaxf(l1[j], -7.f), 7.f); o1[j] = (lb + 1.f) * (gb * sigmoid_f(1.702f * gb)); }
                st_bf8(hbuf + (size_t)row * 1024 + jh, o0, o1);
                __builtin_amdgcn_sched_barrier(0); }
    }
};
struct EpiMoeDn {
    static constexpr bool CHAIN = false;
    bf16_t* y; const float* bdn; bool skip;
    __device__ __forceinline__ void operator()(f32x4 (&acc)[2][2][4][2], const Unit& un, int wr, int wc, int fr, int fq) const {
        const int e = un.pn >> 2, pnl = un.pn & 3; const int row0 = (skip ? 0 : un.pm * 256) + wr * 64 + fr; const float* be = bdn + (size_t)e * 1024;
#pragma unroll
        for (int bj = 0; bj < 2; ++bj) { const int col = pnl * 256 + bj * 128 + wc * 32 + 8 * fq; const f32x4 b0 = *(const f32x4*)(be + col), b1 = *(const f32x4*)(be + col + 4);
#pragma unroll
            for (int ai = 0; ai < 2; ++ai)
#pragma unroll
                for (int m = 0; m < 4; ++m) st_bf8(y + (size_t)(row0 + ai * 128 + m * 16) * 1024 + col, acc[ai][bj][m][0] + b0, acc[ai][bj][m][1] + b1); }
    }
};

__device__ __forceinline__ int colmap_in(int np) {
    if (np < 2048) return np;
    if (np < 2304) { const int t = np - 2048; if (t < 64) return 2048 + t; if (t < 72) return 2112 + (t - 64); if (t < 96) return -1; if (t < 128) return 3528 + (t - 96); return 3400 + (t - 128); }
    if (np < 3328) return 2120 + (np - 2304);
    if (np < 3584) return 3144 + (np - 3328);
    return 3560 + (np - 3584);
}
__device__ __forceinline__ int colmap_gu(int np) { const int tile = np >> 8, w = np & 255; return (w < 128) ? (tile * 128 + w) : (1024 + tile * 128 + (w - 128)); }
template <int KIND>
__device__ __forceinline__ void tconv_item(const float* src, int ldsrc, bf16_t* dst, int Kdst, int koff, const float* kscale, int item, int nblk, LAS float* scr, int lane) {
    const int kb = item / nblk, nb = item - kb * nblk, k0 = 64 * kb, n0 = 32 * nb;
    const int np = n0 + (lane & 31);
    const int col = KIND == 1 ? colmap_in(np) : (KIND == 2 ? colmap_gu(np) : np);
    float vv[32];
#pragma unroll
    for (int i = 0; i < 32; ++i) { const int kk = 2 * i + (lane >> 5); const int ks = k0 + kk - koff; float v = 0.f;
        if (col >= 0 && ks >= 0) { v = src[(size_t)ks * ldsrc + col]; if (kscale) v *= kscale[ks]; }
        vv[i] = v; }
#pragma unroll
    for (int i = 0; i < 32; ++i) { const int kk = 2 * i + (lane >> 5); scr[kk * 33 + (lane & 31)] = vv[i]; }
    LDS_WAIT(); asm volatile("" ::: "memory");
    const int c = lane & 7;
#pragma unroll
    for (int j = 0; j < 4; ++j) { const int n = (lane >> 3) + 8 * j; const LAS float* s = scr + (8 * c) * 33 + n;
        u32x4 o; o.x = pk2(s[0 * 33], s[1 * 33]); o.y = pk2(s[2 * 33], s[3 * 33]); o.z = pk2(s[4 * 33], s[5 * 33]); o.w = pk2(s[6 * 33], s[7 * 33]);
        *(u32x4*)(dst + (size_t)(n0 + n) * Kdst + k0 + 8 * c) = o; }
    LDS_WAIT(); asm volatile("" ::: "memory");
}
__device__ __forceinline__ void phase_prologue(const Ctx& C, const Args& A) {
    LAS float* scr = (LAS float*)(C.lds + C.wave * 16384);
    const int gw = C.bid * NWAVES + C.wave, NGW = C.G * NWAVES;
    constexpr int I_IN = 16 * (NIN / 32), I_UQ = 4 * 24, I_UKV = 4 * 32, I_BR = 8 * 32, I_OUT = 16 * 32, I_GU = 16 * 64, I_DN = 16 * 32;
    constexpr int I_LAYER = I_IN + I_UQ + I_UKV + 3 * I_BR + I_OUT + NEXP * I_GU + NEXP * I_DN;
    for (int it = gw; it < NLAYER * I_LAYER; it += NGW) {
        const int l = it / I_LAYER; int r = it - l * I_LAYER;
        if (r < I_IN) { tconv_item<1>(A.in[2] + (size_t)l * DM * NIN_SRC, NIN_SRC, WSP(bf16_t, WS_WIN + l * SZ_WIN), 1024, 0, nullptr, r, NIN / 32, scr, C.lane); continue; } r -= I_IN;
        if (r < I_UQ) { tconv_item<0>(A.in[9] + (size_t)l * 256 * 768, 768, WSP(bf16_t, WS_WUQ + l * SZ_WUQ), 256, 0, A.in[7] + l * 256, r, 24, scr, C.lane); continue; } r -= I_UQ;
        if (r < I_UKV) { tconv_item<0>(A.in[10] + (size_t)l * 128 * 1024, 1024, WSP(bf16_t, WS_WUKV + l * SZ_WUKV), 256, 128, A.in[8] + l * 128, r, 32, scr, C.lane); continue; } r -= I_UKV;
        if (r < 3 * I_BR) { const int n = r / I_BR; r -= n * I_BR;
            tconv_item<0>(A.in[11] + ((size_t)l * 3 + n) * 512 * 1024, 1024, WSP(bf16_t, WS_WBR + l * SZ_WBR) + (size_t)n * 1024 * 512, 512, 0, nullptr, r, 32, scr, C.lane); continue; } r -= 3 * I_BR;
        if (r < I_OUT) { tconv_item<0>(A.in[12] + (size_t)l * 1024 * 1024, 1024, WSP(bf16_t, WS_WOUT + l * SZ_WOUT), 1024, 0, nullptr, r, 32, scr, C.lane); continue; } r -= I_OUT;
        if (r < NEXP * I_GU) { const int e = r / I_GU; r -= e * I_GU;
            tconv_item<2>(A.in[17] + ((size_t)l * NEXP + e) * 1024 * 2048, 2048, WSP(bf16_t, WS_WGU + l * SZ_WGU) + (size_t)e * 2048 * 1024, 1024, 0, nullptr, r, 64, scr, C.lane); continue; } r -= NEXP * I_GU;
        { const int e = r / I_DN; r -= e * I_DN;
            tconv_item<0>(A.in[19] + ((size_t)l * NEXP + e) * 1024 * 1024, 1024, WSP(bf16_t, WS_WDN + l * SZ_WDN) + (size_t)e * 1024 * 1024, 1024, 0, nullptr, r, 32, scr, C.lane); }
    }
    const int gt = C.bid * 512 + C.tid, NGT = C.G * 512;
    { bf16_t* d = WSP(bf16_t, WS_WGM); const float* s = A.in[5];
      for (int i = gt; i < NLAYER * 8 * 128 * 128; i += NGT) { const int jj = i & 127, ii = (i >> 7) & 127; d[i] = (jj <= ii) ? (bf16_t)(pk2(s[i], 0.f) & 0xffff) : (bf16_t)0; } }
    { const int* pos = (const int*)A.in[1]; float *ca = WSP(float, WS_COSA), *sa = WSP(float, WS_SINA), *cc = WSP(float, WS_COSC), *sc = WSP(float, WS_SINC);
      for (int i = gt; i < NTOK * 8; i += NGT) { const int t = i >> 3, f = i & 7; const float inv = powf(500000.f, -(float)f / 8.f); const float ang = (float)pos[t] * inv; ca[i] = cosf(ang); sa[i] = sinf(ang); }
      for (int i = gt; i < NTOK * 16; i += NGT) { const int t = i >> 4, f = i & 15; const float inv = powf(500000.f, -(float)f / 16.f); const float ang = (float)pos[t] * inv; cc[i] = cosf(ang); sc[i] = sinf(ang); } }
    { const f32x4* x4 = (const f32x4*)A.in[0]; u32x2* xb = WSP(u32x2, WS_XB);
      for (int i = gt; i < NTOK * DM / 4; i += NGT) { const f32x4 v = x4[i]; u32x2 w; w.x = pk2(v[0], v[1]); w.y = pk2(v[2], v[3]); xb[i] = w; } }
}

__device__ __forceinline__ void idx_block(const Ctx& C, int b, int qb) {
    const int tid = C.tid, lane = C.lane, wid = C.wave, r32 = lane & 31, hi = lane >> 5;
    const bf16_t* iq = WSP(bf16_t, WS_IQ); const bf16_t* ik = WSP(bf16_t, WS_IK); const float* iw = WSP(float, WS_IW); float* score = WSP(float, WS_SCORE);
    const int qi_l = ((r32 >> 4) << 1) + ((r32 >> 2) & 1), h_l = (r32 & 3) + 4 * ((r32 >> 3) & 1);
    bf16x8 af[2][4]; float wv[2][2][8];
#pragma unroll
    for (int rb = 0; rb < 2; ++rb) { const size_t tok = (size_t)b * SEQ + qb * 64 + wid * 8 + rb * 4 + qi_l;
#pragma unroll
        for (int ks = 0; ks < 4; ++ks) af[rb][ks] = *(const bf16x8*)(iq + tok * 512 + h_l * 64 + ks * 16 + hi * 8);
#pragma unroll
        for (int g = 0; g < 2; ++g) { const size_t tq = (size_t)b * SEQ + qb * 64 + wid * 8 + rb * 4 + 2 * g + hi;
            const f32x4 w0 = *(const f32x4*)(iw + tq * 8), w1 = *(const f32x4*)(iw + tq * 8 + 4);
            wv[rb][g][0] = w0[0]; wv[rb][g][1] = w0[1]; wv[rb][g][2] = w0[2]; wv[rb][g][3] = w0[3]; wv[rb][g][4] = w1[0]; wv[rb][g][5] = w1[1]; wv[rb][g][6] = w1[2]; wv[rb][g][7] = w1[3]; } }
    const int lkey = tid & 63, lch = tid >> 6;
    const bf16_t* ksrc = ik + ((size_t)b * SEQ + lkey) * 64 + lch * 8;
    LAS unsigned char* kdst = C.lds + (lch * 64 + lkey) * 16;
    const int NT = qb + 1;
    u32x4 rk = *(const u32x4*)ksrc;
    *(LAS u32x4*)kdst = rk;
    __syncthreads();
    for (int kt = 0; kt < NT; ++kt) {
        const int cur = kt & 1;
        if (kt + 1 < NT) rk = *(const u32x4*)(ksrc + (size_t)(kt + 1) * 64 * 64);
        const LAS unsigned char* kb = C.lds + cur * 8192;
        bf16x8 bfr[2][4];
#pragma unroll
        for (int kbk = 0; kbk < 2; ++kbk)
#pragma unroll
            for (int ks = 0; ks < 4; ++ks) bfr[kbk][ks] = *(const LAS bf16x8*)(kb + ((2 * ks + hi) * 64 + kbk * 32 + r32) * 16);
#pragma unroll
        for (int rb = 0; rb < 2; ++rb)
#pragma unroll
            for (int kbk = 0; kbk < 2; ++kbk) {
                f32x16 a = {};
#pragma unroll
                for (int ks = 0; ks < 4; ++ks) a = __builtin_amdgcn_mfma_f32_32x32x16_bf16(af[rb][ks], bfr[kbk][ks], a, 0, 0, 0);
#pragma unroll
                for (int g = 0; g < 2; ++g) { float s = 0.f;
#pragma unroll
                    for (int hh = 0; hh < 8; ++hh) s = fmaf(fmaxf(a[8 * g + hh], 0.f), wv[rb][g][hh], s);
                    const size_t tq = (size_t)b * SEQ + qb * 64 + wid * 8 + rb * 4 + 2 * g + hi;
                    score[tq * SEQ + kt * 64 + kbk * 32 + r32] = s; } }
        if (kt + 1 < NT) *(LAS u32x4*)(kdst + (cur ^ 1) * 8192) = rk;
        __syncthreads();
    }
}
__device__ __forceinline__ void phase_indexer(const Ctx& C) {
    for (int u0 = C.bid; u0 < NB * 32; u0 += C.G) {
        int u = u0; if (C.G == NB * 32) u = (C.bid & 7) * 32 + (C.bid >> 3);
        const int b = u >> 5, p = u & 31; idx_block(C, b, p); idx_block(C, b, 63 - p); }
}

__device__ __forceinline__ unsigned f2key(float f) { const unsigned u = __float_as_uint(f); return (u & 0x80000000u) ? ~u : (u | 0x80000000u); }
__device__ __forceinline__ int wave_total7(unsigned cv) {
    int t = 0;
#pragma unroll
    for (int b = 0; b < 7; ++b) t += __popcll(__ballot((cv >> b) & 1u)) << b;
    return t;
}
template <int NG>
__device__ __forceinline__ unsigned select_radix(const unsigned (&u)[64]) {
    unsigned prefix = 0u;
    for (int bit = 31; bit >= 0; --bit) {
        const unsigned cand = prefix | (1u << bit); unsigned cv = 0u;
#pragma unroll
        for (int i = 0; i < NG * 8; ++i) cv += (u[i] >= cand) ? 1u : 0u;
        const int cnt = wave_total7(cv);
        if (cnt >= 256) prefix = cand;
        if (cnt == 256) break;
    }
    return prefix;
}
__device__ __forceinline__ int wave_sum_dpp(int x) {
    x += __builtin_amdgcn_update_dpp(0, x, 0xB1, 0xf, 0xf, true);
    x += __builtin_amdgcn_update_dpp(0, x, 0x4E, 0xf, 0xf, true);
    x += __builtin_amdgcn_update_dpp(0, x, 0x141, 0xf, 0xf, true);
    x += __builtin_amdgcn_update_dpp(0, x, 0x140, 0xf, 0xf, true);
    x += __builtin_amdgcn_update_dpp(0, x, 0x142, 0xa, 0xf, false);
    x += __builtin_amdgcn_update_dpp(0, x, 0x143, 0xc, 0xf, false);
    return __builtin_amdgcn_readlane(x, 63);
}
__device__ __forceinline__ unsigned bfi32(unsigned m, unsigned x, unsigned y) { return (m & x) | (~m & y); }
__device__ __forceinline__ void bit_transpose32(unsigned* a) {
#pragma unroll
    for (int k = 0; k < 16; ++k) { const unsigned x = a[k], y = a[k + 16]; a[k] = __builtin_amdgcn_perm(y, x, 0x05040100u); a[k + 16] = __builtin_amdgcn_perm(y, x, 0x07060302u); }
#pragma unroll
    for (int k = 0; k < 32; ++k) if ((k & 8) == 0) { const unsigned x = a[k], y = a[k + 8]; a[k] = __builtin_amdgcn_perm(y, x, 0x06020400u); a[k + 8] = __builtin_amdgcn_perm(y, x, 0x07030501u); }
#pragma unroll
    for (int k = 0; k < 32; ++k) if ((k & 4) == 0) { const unsigned x = a[k], y = a[k + 4]; a[k] = bfi32(0x0f0f0f0fu, x, y << 4); a[k + 4] = bfi32(0x0f0f0f0fu, x >> 4, y); }
#pragma unroll
    for (int k = 0; k < 32; ++k) if ((k & 2) == 0) { const unsigned x = a[k], y = a[k + 2]; a[k] = bfi32(0x33333333u, x, y << 2); a[k + 2] = bfi32(0x33333333u, x >> 2, y); }
#pragma unroll
    for (int k = 0; k < 32; ++k) if ((k & 1) == 0) { const unsigned x = a[k], y = a[k + 1]; a[k] = bfi32(0x55555555u, x, y << 1); a[k + 1] = bfi32(0x55555555u, x >> 1, y); }
}
__device__ __forceinline__ void sel_load(u32x4 (&raw)[16], const float* row, int n, int lane) {
    const u32x4* src = (const u32x4*)(row + lane * (n > 2048 ? 64 : 32));
#pragma unroll
    for (int i = 0; i < 8; ++i) raw[i] = src[i];
    if (n > 2048) {
#pragma unroll
        for (int i = 8; i < 16; ++i) raw[i] = src[i];
    }
    __builtin_amdgcn_sched_barrier(0);
}
template <int NW>
__device__ __forceinline__ void select_bits(unsigned (&a)[64], int n, unsigned* mrow, int lane) {
    constexpr int W = 32 * NW;
#pragma unroll
    for (int blk = 0; blk < NW; ++blk) bit_transpose32(a + 32 * blk);
    unsigned alive[NW], above[NW];
#pragma unroll
    for (int w = 0; w < NW; ++w) { const int nv = n - lane * W - 32 * w; alive[w] = nv >= 32 ? 0xffffffffu : (nv <= 0 ? 0u : ((1u << nv) - 1u)); above[w] = 0u; }
    int cnta = 0; bool exact = false;
#pragma unroll
    for (int b = 31; b >= 0; --b) {
        unsigned o[NW]; int pc = 0;
#pragma unroll
        for (int w = 0; w < NW; ++w) { o[w] = alive[w] & a[32 * w + b]; pc += __popc(o[w]); }
        const int tot = cnta + wave_sum_dpp(pc);
        if (tot >= 256) {
#pragma unroll
            for (int w = 0; w < NW; ++w) alive[w] = o[w];
            if (tot == 256) { exact = true; break; }
        } else {
#pragma unroll
            for (int w = 0; w < NW; ++w) { above[w] |= o[w]; alive[w] ^= o[w]; }
            cnta = tot;
        }
    }
    if (!exact) {
        int pc = 0;
#pragma unroll
        for (int w = 0; w < NW; ++w) pc += __popc(alive[w]);
        const int ceq = wave_sum_dpp(pc), need = 256 - cnta;
        if (ceq > need) {
            int excl = 0;
#pragma unroll 1
            for (int L = 0; L < 63; ++L) { const int v = __builtin_amdgcn_readlane(pc, L); excl += (lane > L) ? v : 0; }
            int take = need - excl; take = take < 0 ? 0 : (take > pc ? pc : take);
            int c = pc;
            if (NW == 2) { while (c > take && alive[NW - 1] != 0u) { alive[NW - 1] &= ~(0x80000000u >> __clz(alive[NW - 1])); --c; } }
            while (c > take) { alive[0] &= ~(0x80000000u >> __clz(alive[0])); --c; }
        }
    }
    if (NW == 2) { u32x2 m; m.x = above[0] | alive[0]; m.y = above[NW - 1] | alive[NW - 1]; *(u32x2*)(mrow + 2 * lane) = m; }
    else { mrow[lane] = above[0] | alive[0]; mrow[64 + lane] = 0u; }
}
__device__ __forceinline__ void phase_select(const Ctx& C) {
    const float* score = WSP(float, WS_SCORE); unsigned long long* mask = WSP(unsigned long long, WS_MASK);
    const int gw = C.bid * NWAVES + C.wave, NGW = C.G * NWAVES, lane = C.lane;
    u32x4 raw[16];
    if (gw < NTOK) sel_load(raw, score + (size_t)gw * SEQ, (gw & (SEQ - 1)) + 1, lane);
    for (int idx = gw; idx < NTOK; idx += NGW) {
        const int n = (idx & (SEQ - 1)) + 1; const int nidx = idx + NGW < NTOK ? idx + NGW : idx;
        unsigned a[64];
#pragma unroll
        for (int i = 0; i < 8; ++i) { const u32x4 v = raw[i];
#pragma unroll
            for (int j = 0; j < 4; ++j) { const unsigned u = v[j]; a[4 * i + j] = u ^ ((unsigned)((int)u >> 31) | 0x80000000u); } }
        if (n > 2048) {
#pragma unroll
            for (int i = 8; i < 16; ++i) { const u32x4 v = raw[i];
#pragma unroll
                for (int j = 0; j < 4; ++j) { const unsigned u = v[j]; a[4 * i + j] = u ^ ((unsigned)((int)u >> 31) | 0x80000000u); } }
        }
        __builtin_amdgcn_sched_barrier(0);
        sel_load(raw, score + (size_t)nidx * SEQ, (nidx & (SEQ - 1)) + 1, lane);
        if (n <= 256) {
            const int lo = n - 64 * lane;
            const unsigned long long m = lo >= 64 ? ~0ull : (lo <= 0 ? 0ull : ((1ull << lo) - 1ull));
            mask[(size_t)idx * 64 + lane] = m;
        } else if (n <= 2048) select_bits<1>(a, n, (unsigned*)(mask + (size_t)idx * 64), lane);
        else select_bits<2>(a, n, (unsigned*)(mask + (size_t)idx * 64), lane);
    }
}

__device__ __forceinline__ int crow(int r, int hi) { return (r & 3) + 8 * (r >> 2) + 4 * hi; }
template <int DQK, bool MASKED>
__device__ __forceinline__ void attn_unit(const Ctx& C, int b, int h, int qb, const bf16_t* Q, const bf16_t* K, const bf16_t* VT, const unsigned* mask, bf16_t* O) {
    constexpr int NKS = DQK / 16, NCH = DQK / 8, KTB = NCH * 1024, BUF = KTB + 8192, QS = 8 * DQK;
    const int tid = C.tid, lane = C.lane, wid = C.wave, r32 = lane & 31, hi = lane >> 5;
    const int NT = 4 * (qb + 1);
    const size_t tok = (size_t)b * SEQ + qb * 256 + wid * 32 + r32;
    bf16x8 qf[NKS];
#pragma unroll
    for (int ks = 0; ks < NKS; ++ks) qf[ks] = *(const bf16x8*)(Q + tok * QS + h * DQK + ks * 16 + hi * 8);
    const int lrow = tid & 63, lch = tid >> 6;
    const bf16_t* ksrc0 = K + ((size_t)b * SEQ + lrow) * QS + h * DQK + lch * 8;
    const bf16_t* ksrc1 = ksrc0 + 64;
    const bf16_t* vsrc = VT + ((size_t)(b * 8 + h) * 64 + lrow) * SEQ + lch * 8;
    LAS unsigned char* kd0 = C.lds + (lch * 64 + lrow) * 16;
    LAS unsigned char* kd1 = C.lds + ((8 + lch) * 64 + lrow) * 16;
    LAS unsigned char* vd = C.lds + KTB + (lch * 64 + lrow) * 16;
    const bool k1 = (DQK > 64) && (tid < 256);
    u32x4 rk0, rk1 = {0u, 0u, 0u, 0u}, rv;
    rk0 = *(const u32x4*)ksrc0; if (k1) rk1 = *(const u32x4*)ksrc1; rv = *(const u32x4*)vsrc;
    *(LAS u32x4*)kd0 = rk0; if (k1) *(LAS u32x4*)kd1 = rk1; *(LAS u32x4*)vd = rv;
    u32x2 mw = {0u, 0u};
    if (MASKED) mw = *(const u32x2*)(mask + tok * 128);
    float mrun = -1e30f, lsum = 0.f;
    f32x16 o0 = {}, o1 = {};
    __syncthreads();
    for (int kt = 0; kt < NT; ++kt) {
        const int cur = kt & 1;
        u32x2 mwn = {0u, 0u};
        if (kt + 1 < NT) {
            rk0 = *(const u32x4*)(ksrc0 + (size_t)(kt + 1) * 64 * QS); if (k1) rk1 = *(const u32x4*)(ksrc1 + (size_t)(kt + 1) * 64 * QS);
            rv = *(const u32x4*)(vsrc + (kt + 1) * 64);
            if (MASKED) mwn = *(const u32x2*)(mask + tok * 128 + 2 * (kt + 1));
        }
        const LAS unsigned char* kb = C.lds + cur * BUF; const LAS unsigned char* vb = kb + KTB;
        f32x16 p0 = {}, p1 = {};
        bf16x8 kf[2 * NKS], vf[8];
#pragma unroll
        for (int ks = 0; ks < NKS; ++ks) {
            kf[2 * ks] = *(const LAS bf16x8*)(kb + ((2 * ks + hi) * 64 + r32) * 16);
            kf[2 * ks + 1] = *(const LAS bf16x8*)(kb + ((2 * ks + hi) * 64 + 32 + r32) * 16);
        }
#pragma unroll
        for (int s4 = 0; s4 < 4; ++s4) {
            vf[2 * s4] = *(const LAS bf16x8*)(vb + ((2 * s4 + hi) * 64 + r32) * 16);
            vf[2 * s4 + 1] = *(const LAS bf16x8*)(vb + ((2 * s4 + hi) * 64 + 32 + r32) * 16);
        }
        __builtin_amdgcn_sched_barrier(0);
#pragma unroll
        for (int ks = 0; ks < NKS; ++ks) {
            p0 = __builtin_amdgcn_mfma_f32_32x32x16_bf16(kf[2 * ks], qf[ks], p0, 0, 0, 0);
            p1 = __builtin_amdgcn_mfma_f32_32x32x16_bf16(kf[2 * ks + 1], qf[ks], p1, 0, 0, 0);
        }
        if (MASKED) {
            const unsigned w0 = mw.x >> (4 * hi), w1 = mw.y >> (4 * hi);
#pragma unroll
            for (int r = 0; r < 16; ++r) { const int bit = (r & 3) + 8 * (r >> 2);
                const unsigned t0 = (unsigned)__builtin_amdgcn_sbfe((int)w0, bit, 1), t1 = (unsigned)__builtin_amdgcn_sbfe((int)w1, bit, 1);
                p0[r] = __uint_as_float((__float_as_uint(p0[r]) & t0) | (~t0 & 0xFF800000u));
                p1[r] = __uint_as_float((__float_as_uint(p1[r]) & t1) | (~t1 & 0xFF800000u)); }
        } else {
            if (kt >= NT - 4) { const int kb0 = (kt - (NT - 4)) * 64, qrel = wid * 32 + r32;
#pragma unroll
                for (int r = 0; r < 16; ++r) { const int kv = kb0 + crow(r, hi); if (kv > qrel) p0[r] = -INFINITY; if (kv + 32 > qrel) p1[r] = -INFINITY; } }
        }
        float mx;
        { float a0 = fmaxf(fmaxf(p0[0], p0[1]), p0[2]), a1 = fmaxf(fmaxf(p0[3], p0[4]), p0[5]), a2 = fmaxf(fmaxf(p0[6], p0[7]), p0[8]), a3 = fmaxf(fmaxf(p0[9], p0[10]), p0[11]);
          float a4 = fmaxf(fmaxf(p0[12], p0[13]), p0[14]), a5 = fmaxf(fmaxf(p0[15], p1[0]), p1[1]), a6 = fmaxf(fmaxf(p1[2], p1[3]), p1[4]), a7 = fmaxf(fmaxf(p1[5], p1[6]), p1[7]);
          float a8 = fmaxf(fmaxf(p1[8], p1[9]), p1[10]), a9 = fmaxf(fmaxf(p1[11], p1[12]), p1[13]), a10 = fmaxf(p1[14], p1[15]);
          a0 = fmaxf(fmaxf(a0, a1), a2); a3 = fmaxf(fmaxf(a3, a4), a5); a6 = fmaxf(fmaxf(a6, a7), a8); a9 = fmaxf(a9, a10);
          mx = fmaxf(fmaxf(a0, a3), fmaxf(a6, a9)); }
        mx = xmax32(mx);
        if (__any(mx > mrun)) {
            const float mnew = fmaxf(mrun, mx); const float alpha = __builtin_amdgcn_exp2f(mrun - mnew); mrun = mnew;
            lsum *= alpha;
#pragma unroll
            for (int r = 0; r < 16; ++r) { o0[r] *= alpha; o1[r] *= alpha; }
        }
        {
#pragma unroll
            for (int r = 0; r < 16; ++r) { p0[r] = __builtin_amdgcn_exp2f(p0[r] - mrun); p1[r] = __builtin_amdgcn_exp2f(p1[r] - mrun); }
            float s0 = (p0[0] + p0[1]) + (p0[2] + p0[3]), s1 = (p0[4] + p0[5]) + (p0[6] + p0[7]), s2 = (p0[8] + p0[9]) + (p0[10] + p0[11]), s3 = (p0[12] + p0[13]) + (p0[14] + p0[15]);
            float s4 = (p1[0] + p1[1]) + (p1[2] + p1[3]), s5 = (p1[4] + p1[5]) + (p1[6] + p1[7]), s6 = (p1[8] + p1[9]) + (p1[10] + p1[11]), s7 = (p1[12] + p1[13]) + (p1[14] + p1[15]);
            lsum += ((s0 + s1) + (s2 + s3)) + ((s4 + s5) + (s6 + s7));
        }
        bf16x8 pf[4];
        { u32x4 t;
          t.x = pk2(p0[0], p0[1]); t.y = pk2(p0[2], p0[3]); t.z = pk2(p0[4], p0[5]); t.w = pk2(p0[6], p0[7]); pf[0] = __builtin_bit_cast(bf16x8, t);
          t.x = pk2(p0[8], p0[9]); t.y = pk2(p0[10], p0[11]); t.z = pk2(p0[12], p0[13]); t.w = pk2(p0[14], p0[15]); pf[1] = __builtin_bit_cast(bf16x8, t);
          t.x = pk2(p1[0], p1[1]); t.y = pk2(p1[2], p1[3]); t.z = pk2(p1[4], p1[5]); t.w = pk2(p1[6], p1[7]); pf[2] = __builtin_bit_cast(bf16x8, t);
          t.x = pk2(p1[8], p1[9]); t.y = pk2(p1[10], p1[11]); t.z = pk2(p1[12], p1[13]); t.w = pk2(p1[14], p1[15]); pf[3] = __builtin_bit_cast(bf16x8, t); }
#pragma unroll
        for (int s = 0; s < 4; ++s) {
            o0 = __builtin_amdgcn_mfma_f32_32x32x16_bf16(vf[2 * s], pf[s], o0, 0, 0, 0);
            o1 = __builtin_amdgcn_mfma_f32_32x32x16_bf16(vf[2 * s + 1], pf[s], o1, 0, 0, 0);
        }
        if (kt + 1 < NT) {
            const int nb = (cur ^ 1) * BUF;
            *(LAS u32x4*)(kd0 + nb) = rk0; if (k1) *(LAS u32x4*)(kd1 + nb) = rk1; *(LAS u32x4*)(vd + nb) = rv;
        }
        mw = mwn;
        __syncthreads();
    }
    lsum = xsum32(lsum);
    const float inv = 1.f / lsum;
    bf16_t* op = O + tok * 512 + h * 64 + 4 * hi;
#pragma unroll
    for (int i = 0; i < 4; ++i) {
        st_bf4(op + 8 * i, (f32x4){o0[4 * i] * inv, o0[4 * i + 1] * inv, o0[4 * i + 2] * inv, o0[4 * i + 3] * inv});
        st_bf4(op + 32 + 8 * i, (f32x4){o1[4 * i] * inv, o1[4 * i + 1] * inv, o1[4 * i + 2] * inv, o1[4 * i + 3] * inv});
    }
}
template <int DQK, bool MASKED>
__device__ __forceinline__ void phase_attn(const Ctx& C, const bf16_t* Q, const bf16_t* K, const bf16_t* VT, const unsigned* mask, bf16_t* O) {
    for (int u0 = C.bid; u0 < NB * 8 * 8; u0 += C.G) {
        int u = u0; if ((C.G & 7) == 0) { const int r = (C.bid >> 3) + (C.G >> 3) * (u0 / C.G); u = ((C.bid & 7) * 8 + (r >> 3)) * 8 + (r & 7); if (u >= NB * 8 * 8) u = u0; }
        const int bh = u >> 3, p = u & 7, b = bh >> 3, h = bh & 7;
        attn_unit<DQK, MASKED>(C, b, h, 15 - p, Q, K, VT, mask, O);
        attn_unit<DQK, MASKED>(C, b, h, p, Q, K, VT, mask, O); }
}

__device__ __forceinline__ void phase_gmlp(const Ctx& C, const float* lng, const float* lnb, const float* bs, int l) {
    const bf16_t* U = WSP(bf16_t, WS_U); const bf16_t* V = WSP(bf16_t, WS_V); bf16_t* OB = WSP(bf16_t, WS_OBUF) + (size_t)NTOK * 512;
    const bf16_t* WG = WSP(bf16_t, WS_WGM + l * SZ_WGM);
    const int tid = C.tid, lane = C.lane, wid = C.wave, r32 = lane & 31, hi = lane >> 5;
    constexpr int VST = 136;
    LAS bf16_t* vT = (LAS bf16_t*)C.lds;
    for (int un = C.bid; un < 512; un += C.G) {
        const int hf = un & 1, ch = un >> 1; const size_t t0 = (size_t)ch * 128;
        { const int pos = tid >> 2, q = tid & 3; const bf16_t* vr = V + (t0 + pos) * 512 + q * 32;
          float s = 0.f;
#pragma unroll
          for (int i = 0; i < 4; ++i)
#pragma unroll
              for (int j = 0; j < 4; ++j) { const u32x4 w = *(const u32x4*)(vr + i * 128 + j * 8); s += ((bflo(w.x) + bfhi(w.x)) + (bflo(w.y) + bfhi(w.y))) + ((bflo(w.z) + bfhi(w.z)) + (bflo(w.w) + bfhi(w.w))); }
          s += xswz<1>(s); s += xswz<2>(s);
          const float mean = s * (1.f / 512.f); float qv = 0.f;
          asm volatile("" ::: "memory");
#pragma unroll
          for (int i = 0; i < 4; ++i)
#pragma unroll
              for (int j = 0; j < 4; ++j) { const u32x4 w = *(const u32x4*)(vr + i * 128 + j * 8); float d;
                  d = bflo(w.x) - mean; qv += d * d; d = bfhi(w.x) - mean; qv += d * d; d = bflo(w.y) - mean; qv += d * d; d = bfhi(w.y) - mean; qv += d * d;
                  d = bflo(w.z) - mean; qv += d * d; d = bfhi(w.z) - mean; qv += d * d; d = bflo(w.w) - mean; qv += d * d; d = bfhi(w.w) - mean; qv += d * d; }
          qv += xswz<1>(qv); qv += xswz<2>(qv);
          const float rstd = rsqrtf(qv * (1.f / 512.f) + LN_EPS);
          asm volatile("" ::: "memory");
          const bf16_t* vh = vr + hf * 256;
#pragma unroll
          for (int ii = 0; ii < 2; ++ii)
#pragma unroll
              for (int j = 0; j < 4; ++j) { const u32x4 w = *(const u32x4*)(vh + ii * 128 + j * 8);
                  const int cl = ii * 128 + q * 32 + j * 8; const int c0 = hf * 256 + cl;
                  const f32x4 g0 = *(const f32x4*)(lng + c0), g1 = *(const f32x4*)(lng + c0 + 4), b0 = *(const f32x4*)(lnb + c0), b1 = *(const f32x4*)(lnb + c0 + 4);
                  LAS bf16_t* dp = vT + cl * VST + pos;
                  dp[0 * VST] = (bf16_t)(pk2((bflo(w.x) - mean) * rstd * g0[0] + b0[0], 0.f) & 0xffff);
                  dp[1 * VST] = (bf16_t)(pk2((bfhi(w.x) - mean) * rstd * g0[1] + b0[1], 0.f) & 0xffff);
                  dp[2 * VST] = (bf16_t)(pk2((bflo(w.y) - mean) * rstd * g0[2] + b0[2], 0.f) & 0xffff);
                  dp[3 * VST] = (bf16_t)(pk2((bfhi(w.y) - mean) * rstd * g0[3] + b0[3], 0.f) & 0xffff);
                  dp[4 * VST] = (bf16_t)(pk2((bflo(w.z) - mean) * rstd * g1[0] + b1[0], 0.f) & 0xffff);
                  dp[5 * VST] = (bf16_t)(pk2((bfhi(w.z) - mean) * rstd * g1[1] + b1[1], 0.f) & 0xffff);
                  dp[6 * VST] = (bf16_t)(pk2((bflo(w.w) - mean) * rstd * g1[2] + b1[2], 0.f) & 0xffff);
                  dp[7 * VST] = (bf16_t)(pk2((bfhi(w.w) - mean) * rstd * g1[3] + b1[3], 0.f) & 0xffff); } }
        __syncthreads();
        { const int gl = wid >> 1, ih = wid & 1, g = 4 * hf + gl;
          f32x16 acc[2][2] = {};
          const int nks = 4 * (ih + 1);
          const bf16_t* wrow = WG + ((size_t)g * 128 + ih * 64 + r32) * 128 + hi * 8;
          for (int ks = 0; ks < nks; ++ks) {
              bf16x8 a[2], bb[2];
#pragma unroll
              for (int mb = 0; mb < 2; ++mb) a[mb] = *(const bf16x8*)(wrow + (size_t)mb * 32 * 128 + ks * 16);
#pragma unroll
              for (int nb = 0; nb < 2; ++nb) bb[nb] = *(const LAS bf16x8*)(vT + (gl * 64 + nb * 32 + r32) * VST + ks * 16 + hi * 8);
#pragma unroll
              for (int mb = 0; mb < 2; ++mb)
#pragma unroll
                  for (int nb = 0; nb < 2; ++nb) acc[mb][nb] = __builtin_amdgcn_mfma_f32_32x32x16_bf16(a[mb], bb[nb], acc[mb][nb], 0, 0, 0);
          }
#pragma unroll
          for (int mb = 0; mb < 2; ++mb)
#pragma unroll
              for (int r = 0; r < 16; ++r) { const int i = ih * 64 + mb * 32 + crow(r, hi); const float bi = bs[g * 128 + i];
#pragma unroll
                  for (int nb = 0; nb < 2; ++nb) { const size_t o = (t0 + i) * 512 + g * 64 + nb * 32 + r32;
                      const float uu = bf2f(U[o]); OB[o] = (bf16_t)(pk2(uu * (acc[mb][nb][r] + bi), 0.f) & 0xffff); } } }
        __syncthreads();
    }
}

__device__ __forceinline__ float wave_sum(float v) {
    v += xswz<1>(v); v += xswz<2>(v); v += xswz<4>(v); v += xswz<8>(v); v += xswz<16>(v); return xsum32(v);
}
__device__ __forceinline__ void phase_ln1_router(const Ctx& C, const float* g1, const float* b1, const float* rw, const float* rbias, int l, bool dry) {
    constexpr int RST = 1028;
    LAS float* rwT = (LAS float*)C.lds;
    LAS float* gws = (LAS float*)(C.lds + 32 * RST * 4);
    LAS float* bws = gws + 32;
    LAS float* stat = bws + 32;
    LAS int* trec = (LAS int*)(C.lds + MISC_OFF + 64);
    LAS int* tpos = trec + 512;
    const int tid = C.tid, lane = C.lane, wid = C.wave;
    const bf16_t* xin = WSP(bf16_t, WS_XB); const bf16_t* yo = WSP(bf16_t, WS_OBUF); bf16_t* xb = dry ? WSP(bf16_t, WS_DRY + (size_t)NTOK * DM * 4) : WSP(bf16_t, WS_XB);
    int* tke = dry ? WSP(int, WS_DRY + (size_t)NTOK * DM * 6) : WSP(int, WS_TKE); int* tkp = dry ? WSP(int, WS_DRY + (size_t)NTOK * DM * 6 + NSLOT * 4) : WSP(int, WS_TKP); float* tkw = dry ? WSP(float, WS_DRY + (size_t)NTOK * DM * 6 + NSLOT * 8) : WSP(float, WS_TKW);
    int* ccnt = dry ? WSP(int, WS_DRY + (size_t)NTOK * DM * 6 + NSLOT * 12) : WSP(int, WS_CCNT);
    for (int i = tid; i < 1024 * 32; i += 512) { const int k = i >> 5, e = i & 31; rwT[e * RST + k] = rw[i] * g1[k]; }
    __syncthreads();
    for (int e = wid; e < 32; e += NWAVES) {
        float sg = 0.f, sb = 0.f;
#pragma unroll
        for (int j = 0; j < 16; ++j) { const int k = lane + 64 * j; sg += rwT[e * RST + k]; sb += b1[k] * rw[k * 32 + e]; }
        sg = wave_sum(sg); sb = wave_sum(sb);
        if (lane == 0) { gws[e] = sg; bws[e] = sb + rbias[e]; }
    }
    f32x4 gg[4], bb[4];
#pragma unroll
    for (int j = 0; j < 4; ++j) { gg[j] = *(const f32x4*)(g1 + 4 * (lane + 64 * j)); bb[j] = *(const f32x4*)(b1 + 4 * (lane + 64 * j)); }
    const int fr = lane & 15, fq = lane >> 4;
    for (int chunk = C.bid; chunk < NTOK / 128; chunk += C.G) {
        __syncthreads();
        const size_t tok0 = (size_t)chunk * 128 + wid * 16;
        f32x4 acc0 = {0.f, 0.f, 0.f, 0.f}, acc1 = {0.f, 0.f, 0.f, 0.f};
        { const bf16_t* zr = xin + (tok0 + fr) * 1024 + 4 * fq; const bf16_t* yr = yo + (tok0 + fr) * 1024 + 4 * fq; const LAS float* w0 = rwT + fr * RST + 4 * fq; const LAS float* w1 = rwT + (16 + fr) * RST + 4 * fq;
#pragma unroll 4
          for (int sI = 0; sI < 64; ++sI) { const u32x2 hw = *(const u32x2*)(zr + 16 * sI); const f32x4 h4 = {bflo(hw.x), bfhi(hw.x), bflo(hw.y), bfhi(hw.y)}; const u32x2 yw = *(const u32x2*)(yr + 16 * sI);
              const f32x4 a4 = h4 * DN_ALPHA + (f32x4){bflo(yw.x), bfhi(yw.x), bflo(yw.y), bfhi(yw.y)};
              const f32x4 b0 = *(const LAS f32x4*)(w0 + 16 * sI), b1v = *(const LAS f32x4*)(w1 + 16 * sI);
#pragma unroll
              for (int j = 0; j < 4; ++j) { acc0 = __builtin_amdgcn_mfma_f32_16x16x4f32(a4[j], b0[j], acc0, 0, 0, 0); acc1 = __builtin_amdgcn_mfma_f32_16x16x4f32(a4[j], b1v[j], acc1, 0, 0, 0); } } }
        for (int ti = 0; ti < 16; ++ti) {
            const size_t tok = tok0 + ti;
            const u32x2* xr = (const u32x2*)(xin + tok * 1024); const u32x2* yr2 = (const u32x2*)(yo + tok * 1024);
            f32x4 v[4]; float s = 0.f;
#pragma unroll
            for (int j = 0; j < 4; ++j) { const u32x2 yw = yr2[lane + 64 * j], hw = xr[lane + 64 * j]; v[j] = (f32x4){bflo(hw.x), bfhi(hw.x), bflo(hw.y), bfhi(hw.y)} * DN_ALPHA + (f32x4){bflo(yw.x), bfhi(yw.x), bflo(yw.y), bfhi(yw.y)}; s += (v[j][0] + v[j][1]) + (v[j][2] + v[j][3]); }
            const float mean = wave_sum(s) * (1.f / 1024.f); float s2 = 0.f;
#pragma unroll
            for (int j = 0; j < 4; ++j) { v[j] = v[j] - mean; s2 += (v[j][0] * v[j][0] + v[j][1] * v[j][1]) + (v[j][2] * v[j][2] + v[j][3] * v[j][3]); }
            const float rstd = rsqrtf(wave_sum(s2) * (1.f / 1024.f) + LN_EPS);
            u32x2* xbr = (u32x2*)(xb + tok * 1024);
#pragma unroll
            for (int j = 0; j < 4; ++j) { v[j] = v[j] * rstd * gg[j] + bb[j]; u32x2 w; w.x = pk2(v[j][0], v[j][1]); w.y = pk2(v[j][2], v[j][3]); xbr[lane + 64 * j] = w; }
            if (lane == 0) { stat[(wid * 16 + ti) * 2] = mean; stat[(wid * 16 + ti) * 2 + 1] = rstd; }
        }
        LDS_WAIT();
        const float gw0 = gws[fr], gw1 = gws[16 + fr], bw0 = bws[fr], bw1 = bws[16 + fr];
#pragma unroll
        for (int r = 0; r < 4; ++r) {
            const int tl = wid * 16 + 4 * fq + r; const float mean = stat[tl * 2], rstd = stat[tl * 2 + 1];
            const float l0 = rstd * (acc0[r] - mean * gw0) + bw0, l1 = rstd * (acc1[r] - mean * gw1) + bw1;
            unsigned long long k0 = ((unsigned long long)f2key(l0) << 32) | (unsigned)(31 - fr), k1 = ((unsigned long long)f2key(l1) << 32) | (unsigned)(31 - (16 + fr));
            int te[4]; float tv[4];
#pragma unroll
            for (int k = 0; k < 4; ++k) {
                unsigned long long mxk = k0 > k1 ? k0 : k1;
#define MX_STEP(o) do { const unsigned long long ot = ((unsigned long long)xswzu<o>((unsigned)(mxk >> 32)) << 32) | xswzu<o>((unsigned)mxk); mxk = ot > mxk ? ot : mxk; } while (0)
                MX_STEP(1); MX_STEP(2); MX_STEP(4); MX_STEP(8);
#undef MX_STEP
                te[k] = 31 - (int)(mxk & 31ull); const unsigned ku = (unsigned)(mxk >> 32); tv[k] = __uint_as_float((ku & 0x80000000u) ? (ku & 0x7fffffffu) : ~ku);
                if (te[k] == fr) k0 = 0ull; if (te[k] == 16 + fr) k1 = 0ull;
            }
            const float e1 = __expf(tv[1] - tv[0]), e2 = __expf(tv[2] - tv[0]), e3 = __expf(tv[3] - tv[0]); const float inv = 1.f / (1.f + e1 + e2 + e3);
            if (fr == 0) {
                const float ww[4] = {inv, e1 * inv, e2 * inv, e3 * inv}; const size_t tok = (size_t)chunk * 128 + tl;
#pragma unroll
                for (int k = 0; k < 4; ++k) { trec[tl * 4 + k] = te[k]; tkw[tok * 4 + k] = ww[k]; }
            }
        }
        __syncthreads();
        if (tid < 32) { int c = 0; for (int r = 0; r < 512; ++r) { if (trec[r] == tid) { tpos[r] = c; ++c; } } ccnt[chunk * 32 + tid] = c; }
        __syncthreads();
        { const size_t o = (size_t)chunk * 512 + tid; tke[o] = trec[tid]; tkp[o] = tpos[tid]; }
        __syncthreads();
    }
}

__device__ __forceinline__ void moe_tables(const Ctx& C, int l) {
    LAS int* cnt = (LAS int*)(C.lds + MISC_OFF + 64); LAS int* tb = cnt + 32; LAS int* tile_e = tb + 40;
    const int* ccnt = WSP(int, WS_CCNT);
    if (C.tid < 32) { int a = 0; for (int c = 0; c < NTOK / 128; ++c) a += ccnt[c * 32 + C.tid]; cnt[C.tid] = a; }
    __syncthreads();
    if (C.tid == 0) { int a = 0; for (int e = 0; e < 32; ++e) { tb[e] = a; a += (cnt[e] + 255) >> 8; } tb[32] = a; }
    __syncthreads();
    if (C.tid < 32) { for (int t = tb[C.tid]; t < tb[C.tid + 1]; ++t) tile_e[t] = C.tid; }
    __syncthreads();
}
__device__ __forceinline__ void phase_dispatch(const Ctx& C, int l) {
    moe_tables(C, l);
    LAS int* cnt = (LAS int*)(C.lds + MISC_OFF + 64); LAS int* tb = cnt + 32;
    const int* tke = WSP(int, WS_TKE); int* tkp = WSP(int, WS_TKP); int* stk = WSP(int, WS_STK);
    LAS int* cbase = (LAS int*)C.lds;
    { const int* ccnt = WSP(int, WS_CCNT); if (C.tid < 32) { int a = 0; for (int c = 0; c < NTOK / 128; ++c) { cbase[c * 32 + C.tid] = a; a += ccnt[c * 32 + C.tid]; } } }
    __syncthreads();
    for (int s = C.bid * 512 + C.tid; s < NSLOT; s += C.G * 512) {
        const int e = tke[s], p = cbase[(s >> 9) * 32 + e] + tkp[s]; const int row = tb[e] * 256 + p;
        stk[row] = s >> 2; tkp[s] = row;
    }
    for (int e = C.bid; e < 32; e += C.G) { const int r0 = tb[e] * 256 + cnt[e], r1 = tb[e + 1] * 256; for (int r = r0 + C.tid; r < r1; r += 512) stk[r] = 0; }
}

__device__ __forceinline__ void phase_ln2(const Ctx& C, const float* g2, const float* b2, float* outp, int l, bool dry) {
    const bf16_t* xin = WSP(bf16_t, WS_XB); bf16_t* xb = dry ? WSP(bf16_t, WS_DRY + (size_t)NTOK * DM * 4) : WSP(bf16_t, WS_XB); const bf16_t* y = WSP(bf16_t, WS_Y);
    const int* tkrow = WSP(int, WS_TKP); const float* tkw = WSP(float, WS_TKW);
    if (dry) outp = WSP(float, WS_DRY);
    const int gw = C.bid * NWAVES + C.wave, NGW = C.G * NWAVES, lane = C.lane;
    f32x4 gg[4], bb[4];
#pragma unroll
    for (int j = 0; j < 4; ++j) { gg[j] = *(const f32x4*)(g2 + 4 * (lane + 64 * j)); bb[j] = *(const f32x4*)(b2 + 4 * (lane + 64 * j)); }
    const bool last = (l == NLAYER - 1);
    for (int tok = gw; tok < NTOK; tok += NGW) {
        const u32x2* xr = (const u32x2*)(xin + (size_t)tok * 1024);
        f32x4 v[4]; float s = 0.f;
        int rk[4]; float wk[4];
#pragma unroll
        for (int k = 0; k < 4; ++k) { rk[k] = tkrow[(size_t)tok * 4 + k]; wk[k] = tkw[(size_t)tok * 4 + k]; }
#pragma unroll
        for (int j = 0; j < 4; ++j) { const u32x2 hw = xr[lane + 64 * j]; const f32x4 x1 = {bflo(hw.x), bfhi(hw.x), bflo(hw.y), bfhi(hw.y)}; f32x4 f[4];
#pragma unroll
            for (int k = 0; k < 4; ++k) { const u32x2 w = *(const u32x2*)(y + (size_t)rk[k] * 1024 + 4 * (lane + 64 * j)); f[k] = (f32x4){bflo(w.x), bfhi(w.x), bflo(w.y), bfhi(w.y)} * wk[k]; }
            v[j] = x1 * DN_ALPHA + ((f[0] + f[1]) + (f[2] + f[3]));
            s += (v[j][0] + v[j][1]) + (v[j][2] + v[j][3]); }
        const float mean = wave_sum(s) * (1.f / 1024.f); float s2 = 0.f;
#pragma unroll
        for (int j = 0; j < 4; ++j) { v[j] = v[j] - mean; s2 += (v[j][0] * v[j][0] + v[j][1] * v[j][1]) + (v[j][2] * v[j][2] + v[j][3] * v[j][3]); }
        const float rstd = rsqrtf(wave_sum(s2) * (1.f / 1024.f) + LN_EPS);
        if (last) { f32x4* orow = (f32x4*)(outp + (size_t)tok * 1024);
#pragma unroll
            for (int j = 0; j < 4; ++j) orow[lane + 64 * j] = v[j] * rstd * gg[j] + bb[j];
        } else { u32x2* xbr = (u32x2*)(xb + (size_t)tok * 1024);
#pragma unroll
            for (int j = 0; j < 4; ++j) { const f32x4 o = v[j] * rstd * gg[j] + bb[j]; u32x2 w; w.x = pk2(o[0], o[1]); w.y = pk2(o[2], o[3]); xbr[lane + 64 * j] = w; } }
    }
}

#ifdef DBG_STOP
__device__ __forceinline__ void dbg_dump(const Ctx& C, float* out) {
    const int gt = C.bid * 512 + C.tid, NGT = C.G * 512;
    const bf16_t* qa = WSP(bf16_t, WS_QA); const bf16_t* ka = WSP(bf16_t, WS_KA); const bf16_t* vat = WSP(bf16_t, WS_VAT); const bf16_t* iq = WSP(bf16_t, WS_IQ);
    const bf16_t* u = WSP(bf16_t, WS_U); const bf16_t* v = WSP(bf16_t, WS_V); const bf16_t* cdq = WSP(bf16_t, WS_CDQ); const bf16_t* cdkv = WSP(bf16_t, WS_CDKV);
    const bf16_t* gate = WSP(bf16_t, WS_GATE); const bf16_t* qc = WSP(bf16_t, WS_QC); const bf16_t* kc = WSP(bf16_t, WS_KC); const bf16_t* vct = WSP(bf16_t, WS_VCT);
    const unsigned* mask = WSP(unsigned, WS_MASK); const bf16_t* ob = WSP(bf16_t, WS_OBUF); const bf16_t* mg = WSP(bf16_t, WS_MERGED); const float* xr = WSP(float, WS_XRES);
    const bf16_t* y = WSP(bf16_t, WS_Y); const float* sc = WSP(float, WS_SCORE); const bf16_t* ik = WSP(bf16_t, WS_IK); const float* iw = WSP(float, WS_IW); const float* ssq = WSP(float, WS_SSQ);
    const bf16_t* hb = WSP(bf16_t, WS_H); const bf16_t* xg = WSP(bf16_t, WS_XG); const int* stk = WSP(int, WS_STK);
    for (size_t i = gt; i < (size_t)NTOK * DM; i += NGT) {
        const size_t h = i & ((size_t)NTOK * 512 - 1);
        float a = 0.f;
#if DBG_STOP >= 1
        a += bf2f(qa[h]) + bf2f(ka[h]) + bf2f(vat[h]) + bf2f(iq[h]) + bf2f(u[h]) + bf2f(v[h]) + bf2f(cdq[i & ((size_t)NTOK * 256 - 1)]) + bf2f(cdkv[i & ((size_t)NTOK * 256 - 1)]);
        a += bf2f(gate[i]) + bf2f(gate[i + (size_t)NTOK * DM]) + bf2f(gate[i + (size_t)2 * NTOK * DM]) + bf2f(ik[i & ((size_t)NTOK * 64 - 1)]) + iw[i & ((size_t)NTOK * 8 - 1)] + ssq[i & ((size_t)NTOK * 8 - 1)];
#endif
#if DBG_STOP >= 2
        a += bf2f(qc[i % ((size_t)NTOK * 768)]) + bf2f(kc[i % ((size_t)NTOK * 768)]) + bf2f(vct[h]) + bf2f(ob[(size_t)NTOK * 512 + h]);
#ifdef DBG_BITS
        a = (float)(__float_as_uint(sc[i]) & 0xfffu) + (float)(__float_as_uint(sc[i + (size_t)NTOK * DM]) & 0xfffu) + (float)(__float_as_uint(sc[i + (size_t)2 * NTOK * DM]) & 0xfffu) + (float)(__float_as_uint(sc[i + (size_t)3 * NTOK * DM]) & 0xfffu);
        a += (float)(iq[h] & 0xff) + (float)(ik[i & ((size_t)NTOK * 64 - 1)] & 0xff) + (float)(__float_as_uint(iw[i & ((size_t)NTOK * 8 - 1)]) & 0xfffu);
#else
        a += sc[i] + sc[i + (size_t)NTOK * DM] + sc[i + (size_t)2 * NTOK * DM] + sc[i + (size_t)3 * NTOK * DM];
#endif
#endif
#if DBG_STOP >= 3
        { const unsigned m = mask[i & ((size_t)NTOK * 128 - 1)]; a += (float)(m & 0xffffu) + (float)(m >> 16); } a += bf2f(ob[(size_t)2 * NTOK * 512 + h]);
#endif
#if DBG_STOP >= 4
        a += bf2f(ob[h]);
#endif
#if DBG_STOP >= 5
        a += bf2f(mg[i]);
#endif
#if DBG_STOP >= 6
        a += xr[i];
#endif
#if DBG_STOP >= 8
        a += (float)stk[i % (size_t)NSLOT_PAD] + bf2f(xg[i]) + bf2f(xg[i + (size_t)NTOK * DM]) + bf2f(xg[i + (size_t)2 * NTOK * DM]) + bf2f(xg[i + (size_t)3 * NTOK * DM]);
#endif
#if DBG_STOP >= 9
        a += bf2f(hb[i]) + bf2f(hb[i + (size_t)NTOK * DM]) + bf2f(hb[i + (size_t)2 * NTOK * DM]) + bf2f(hb[i + (size_t)3 * NTOK * DM]);
#endif
#if DBG_STOP >= 10
        a += bf2f(y[i]) + bf2f(y[i + (size_t)NTOK * DM]) + bf2f(y[i + (size_t)2 * NTOK * DM]) + bf2f(y[i + (size_t)3 * NTOK * DM]);
#endif
        out[i] = a;
    }
}
#endif

#ifdef DBG_CHECK
constexpr int CW_ERR = 20000;
__device__ __forceinline__ void err_max(unsigned* ctl, int k, float e) { if (!(e >= 0.f)) e = 1e30f; atomicMax(ctl + CW_ERR + k, __float_as_uint(e)); }
__device__ __forceinline__ float rope1(float x1, float x2, float c, float s_) { return x1 * c - x2 * s_; }
__device__ __forceinline__ float rope2(float x1, float x2, float c, float s_) { return x2 * c + x1 * s_; }
__device__ __forceinline__ void chk_proj(const Ctx& C, const Args& A) {
    unsigned* ctl = WSP(unsigned, WS_CTL); LAS float* pj = (LAS float*)C.lds;
    const int tok = (C.bid * 131 + 7) % NTOK; const int b = tok >> 12, sp = tok & 4095, ps = (sp & ~15) | perm16(sp & 15);
    const float* x = A.in[0] + (size_t)tok * DM; const float* w = A.in[2];
    for (int n = C.tid; n < 3560; n += 512) { float a = 0.f; for (int k = 0; k < DM; ++k) a = fmaf(x[k], w[(size_t)k * NIN_SRC + n], a); pj[n] = a; }
    __syncthreads();
    const float pos = (float)((const int*)A.in[1])[tok];
    const bf16_t* qa = WSP(bf16_t, WS_QA); const bf16_t* ka = WSP(bf16_t, WS_KA); const bf16_t* vat = WSP(bf16_t, WS_VAT); const bf16_t* iq = WSP(bf16_t, WS_IQ); const bf16_t* ik = WSP(bf16_t, WS_IK); const float* iw = WSP(float, WS_IW);
    float e = 0.f;
    for (int c = C.tid; c < 512; c += 512) { const int d = c & 63; const int base = c - d;
        float cq, ck, ci;
        if (d < 16) { const int i = d & 7; const float ang = pos * powf(500000.f, -(float)i / 8.f), cs = cosf(ang), sn = sinf(ang);
            const int o1 = base + i, o2 = base + 8 + i;
            cq = d < 8 ? rope1(pj[o1], pj[o2], cs, sn) : rope2(pj[o1], pj[o2], cs, sn);
            ck = d < 8 ? rope1(pj[512 + o1], pj[512 + o2], cs, sn) : rope2(pj[512 + o1], pj[512 + o2], cs, sn);
            ci = d < 8 ? rope1(pj[1536 + o1], pj[1536 + o2], cs, sn) : rope2(pj[1536 + o1], pj[1536 + o2], cs, sn);
        } else { cq = pj[c]; ck = pj[512 + c]; ci = pj[1536 + c]; }
        e = fmaxf(e, fabsf(bf2f(qa[(size_t)tok * 512 + c]) - cq * QSCALE_A)); e = fmaxf(e, fabsf(bf2f(ka[(size_t)tok * 512 + c]) - ck)); e = fmaxf(e, fabsf(bf2f(iq[(size_t)tok * 512 + c]) - ci));
        const int h = c >> 6; e = fmaxf(e, fabsf(bf2f(vat[((size_t)(b * 8 + h) * 64 + d) * SEQ + ps]) - pj[1024 + c]));
        if (c < 64) { float cik; if (c < 16) { const int i = c & 7; const float ang = pos * powf(500000.f, -(float)i / 8.f), cs = cosf(ang), sn = sinf(ang);
                cik = c < 8 ? rope1(pj[2048 + i], pj[2048 + 8 + i], cs, sn) : rope2(pj[2048 + i], pj[2048 + 8 + i], cs, sn); } else cik = pj[2048 + c];
            e = fmaxf(e, fabsf(bf2f(ik[(size_t)tok * 64 + c]) - cik)); }
        if (c < 8) e = fmaxf(e, 8.f * fabsf(iw[(size_t)tok * 8 + c] - pj[2112 + c] * IW_SCALE));
    }
    err_max(ctl, 0, e);
    __syncthreads();
    LAS float* cqn = pj + 3600; LAS float* ckn = cqn + 256;
    { float sq = 0.f; for (int k = 0; k < 256; ++k) sq += pj[3144 + k] * pj[3144 + k]; const float r = rsqrtf(sq / 256.f + RMS_EPS);
      float sk = 0.f; for (int k = 0; k < 128; ++k) sk += pj[3400 + k] * pj[3400 + k]; const float rk = rsqrtf(sk / 128.f + RMS_EPS);
      if (C.tid < 256) cqn[C.tid] = pj[3144 + C.tid] * r * A.in[7][C.tid]; if (C.tid < 128) ckn[C.tid] = pj[3400 + C.tid] * rk * A.in[8][C.tid]; }
    __syncthreads();
    const bf16_t* qc = WSP(bf16_t, WS_QC); const bf16_t* kc = WSP(bf16_t, WS_KC); const bf16_t* vct = WSP(bf16_t, WS_VCT);
    LAS float* qraw = ckn + 128;
    for (int n = C.tid; n < 768; n += 512) { float a = 0.f; for (int k = 0; k < 256; ++k) a = fmaf(cqn[k], A.in[9][(size_t)k * 768 + n], a); qraw[n] = a; }
    __syncthreads();
    float e2 = 0.f;
    for (int n = C.tid; n < 768; n += 512) { const int h = n / 96, d = n % 96; float v;
        if (d >= 64) { const int i = (d - 64) & 15; const float ang = pos * powf(500000.f, -(float)i / 16.f), cs = cosf(ang), sn = sinf(ang); const int o1 = h * 96 + 64 + i, o2 = o1 + 16;
            v = (d - 64) < 16 ? rope1(qraw[o1], qraw[o2], cs, sn) : rope2(qraw[o1], qraw[o2], cs, sn); } else v = qraw[n];
        e2 = fmaxf(e2, fabsf(bf2f(qc[(size_t)tok * 768 + n]) - v * QSCALE_C)); }
    for (int n = C.tid; n < 1024; n += 512) { float a = 0.f; for (int k = 0; k < 128; ++k) a = fmaf(ckn[k], A.in[10][(size_t)k * 1024 + n], a);
        const int h = n >> 7, wv = n & 127;
        if (wv < 64) e2 = fmaxf(e2, fabsf(bf2f(kc[(size_t)tok * 768 + h * 96 + wv]) - a));
        else e2 = fmaxf(e2, fabsf(bf2f(vct[((size_t)(b * 8 + h) * 64 + (wv - 64)) * SEQ + ps]) - a)); }
    if (C.tid < 32) { const int i = C.tid & 15; const float ang = pos * powf(500000.f, -(float)i / 16.f), cs = cosf(ang), sn = sinf(ang);
        const float v = C.tid < 16 ? rope1(pj[3528 + i], pj[3528 + 16 + i], cs, sn) : rope2(pj[3528 + i], pj[3528 + 16 + i], cs, sn);
        for (int h = 0; h < 8; ++h) e2 = fmaxf(e2, fabsf(bf2f(kc[(size_t)tok * 768 + h * 96 + 64 + C.tid]) - v)); }
    err_max(ctl, 1, e2);
    __syncthreads();
}
__device__ __forceinline__ void chk_attn(const Ctx& C) {
    unsigned* ctl = WSP(unsigned, WS_CTL);
    const int b = C.bid & 7, q = (C.bid * 977 + 300 + 13 * (C.bid >> 3)) & 4095; const size_t tq = (size_t)b * SEQ + q; const int n = q + 1;
    LAS float* sc = (LAS float*)C.lds;
    LAS float* pr = sc + 4096;
    LAS float* red = pr + 4096;
    const bf16_t* iq = WSP(bf16_t, WS_IQ); const bf16_t* ik = WSP(bf16_t, WS_IK); const float* iw = WSP(float, WS_IW); const float* score = WSP(float, WS_SCORE);
    float e1 = 0.f;
    for (int k = C.tid; k < n; k += 512) { float s_ = 0.f;
        for (int h = 0; h < 8; ++h) { float d = 0.f; for (int j = 0; j < 64; ++j) d = fmaf(bf2f(iq[tq * 512 + h * 64 + j]), bf2f(ik[((size_t)b * SEQ + k) * 64 + j]), d); s_ = fmaf(fmaxf(d, 0.f), iw[tq * 8 + h], s_); }
        sc[k] = s_; e1 = fmaxf(e1, fabsf(s_ - score[tq * SEQ + k])); }
    err_max(ctl, 2, e1);
    __syncthreads();
    const unsigned* mask = WSP(unsigned, WS_MASK); float e2 = 0.f;
    for (int k = C.tid; k < 4096; k += 512) { bool sel = false;
        if (k < n) { if (n <= 256) sel = true; else { const float sk = score[tq * SEQ + k]; int rank = 0; for (int j = 0; j < n; ++j) { const float sj = score[tq * SEQ + j]; rank += (sj > sk || (sj == sk && j < k)) ? 1 : 0; } sel = rank < 256; } }
        const bool mb = (mask[tq * 128 + (k >> 5)] >> (k & 31)) & 1u; if (sel != mb) e2 = 1.f; }
    err_max(ctl, 3, e2);
    const int h = (C.bid >> 3) & 7;
    for (int which = 0; which < 2; ++which) {
        const bf16_t* Q = which ? WSP(bf16_t, WS_QC) : WSP(bf16_t, WS_QA); const bf16_t* K = which ? WSP(bf16_t, WS_KC) : WSP(bf16_t, WS_KA); const bf16_t* VT = which ? WSP(bf16_t, WS_VCT) : WSP(bf16_t, WS_VAT);
        const bf16_t* O = WSP(bf16_t, WS_OBUF) + (which ? (size_t)2 * NTOK * 512 : 0); const int dq = which ? 96 : 64, qs = 8 * dq;
        __syncthreads();
        float mx = -INFINITY;
        for (int k = C.tid; k < 4096; k += 512) { float lgt = -INFINITY;
            const bool ok = k < n && (which || ((mask[tq * 128 + (k >> 5)] >> (k & 31)) & 1u));
            if (ok) { float d = 0.f; for (int j = 0; j < dq; ++j) d = fmaf(bf2f(Q[tq * qs + h * dq + j]), bf2f(K[((size_t)b * SEQ + k) * qs + h * dq + j]), d); lgt = d; }
            pr[k] = lgt; mx = fmaxf(mx, lgt); }
        red[C.tid] = mx; __syncthreads();
        if (C.tid == 0) { float m = -INFINITY; for (int i = 0; i < 512; ++i) m = fmaxf(m, red[i]); red[0] = m; } __syncthreads();
        const float m = red[0]; __syncthreads();
        float sm = 0.f; for (int k = C.tid; k < 4096; k += 512) { const float p = exp2f(pr[k] - m); pr[k] = p; sm += p; }
        red[C.tid] = sm; __syncthreads();
        if (C.tid == 0) { float t = 0.f; for (int i = 0; i < 512; ++i) t += red[i]; red[0] = t; } __syncthreads();
        const float den = red[0];
        if (C.tid < 64) { const int d = C.tid; float o = 0.f;
            for (int k = 0; k < n; ++k) { const int ps = (k & ~15) | perm16(k & 15); o = fmaf(pr[k], bf2f(VT[((size_t)(b * 8 + h) * 64 + d) * SEQ + ps]), o); }
            o /= den; err_max(ctl, 4 + which, fabsf(o - bf2f(O[tq * 512 + h * 64 + d]))); }
    }
    __syncthreads();
}
#endif

constexpr int NPH_LAYER = 11, NPHASE = 1 + NLAYER * NPH_LAYER;
__global__ void __launch_bounds__(NWAVES * 64, 2) trunk_fwd(Args args) {
    extern __shared__ __attribute__((aligned(16))) unsigned char lds_raw[];
    Ctx C;
    C.lds = (LAS unsigned char*)lds_raw; C.tid = threadIdx.x; C.lane = C.tid & 63; C.wave = __builtin_amdgcn_readfirstlane(C.tid >> 6); C.G = gridDim.x; C.bid = blockIdx.x; C.ws = args.ws;
    volatile LAS unsigned* MISC = (volatile LAS unsigned*)(C.lds + MISC_OFF);
    if (C.tid < 16) MISC[C.tid] = 0u;
    __syncthreads();
#if MK_ONE_LAUNCH
    XcdBarrier bar = xcd_barrier_post(WSP(unsigned, WS_CTL) + CW_BAR, MISC + 0);
#define GRID_BAR() do { FRESH(); XcdBarrier b_ = bar; { unsigned* bp_ = b_.bar; asm volatile("" : "+s"(bp_)); b_.bar = bp_; } xcd_barrier(b_, C.tid == 0); } while (0)
#else
#define GRID_BAR() do {} while (0)
#endif
    typedef const __attribute__((address_space(4))) Args* KArgsP;
    KArgsP kp = (KArgsP)__builtin_amdgcn_kernarg_segment_ptr();
    const int grid_s = gridDim.x, bid_s = blockIdx.x;
    const int wave_s = __builtin_amdgcn_readfirstlane((int)threadIdx.x >> 6);
#define FRESH() do { int ln_; asm volatile("v_mbcnt_lo_u32_b32 %0, -1, 0\n\tv_mbcnt_hi_u32_b32 %0, -1, %0" : "=v"(ln_)); int w_ = wave_s; asm volatile("" : "+s"(w_)); C.tid = (w_ << 6) | ln_; C.lane = ln_; C.wave = w_; \
        int g_ = grid_s, b_ = bid_s; asm volatile("" : "+s"(g_), "+s"(b_)); C.G = g_; C.bid = b_; \
        kp = (KArgsP)__builtin_amdgcn_kernarg_segment_ptr(); asm volatile("" : "+s"(kp)); C.ws = kp->ws; } while (0)
#define KIN(i) (kp->in[i])
    const int lo = args.ph_lo, hi = args.ph_hi, sub_mask = args.sub; const bool dry = (args.pad != 0);
#ifndef PH_ONLY
#define PH_ONLY -1
#endif
#ifndef PH_SUB
#define PH_SUB -1
#endif
#define PON(k) (PH_ONLY < 0 || PH_ONLY == (k))
#define PON2(k) ((PH_SUB < 0 || PH_SUB == (k)) && ((sub_mask >> (((k) / 10 - 1) * 4 + (k) % 10 - 1)) & 1))
#define IN(k) (lo <= (k) && (k) < hi)
#define SEAM(k) do { if (IN(k) && IN((k) + 1)) GRID_BAR(); } while (0)
    if (IN(0) && PON(100)) { phase_prologue(C, args); }
    SEAM(0);
    for (int l = 0; l < NLAYER; ++l) {
        const int P = 1 + l * NPH_LAYER;
        if (IN(P + 0) && PON(0)) { FRESH();
            pg8::Gemm g{WSP(bf16_t, WS_XB), WSP(bf16_t, WS_WIN + l * SZ_WIN), 1024, 1024, nullptr}; GridOrder S{NIN / 256, (NTOK / 256) * (NIN / 256), C.G, C.bid};
            EpiInProj E{C.ws, dry};
            pg8::gemm_phase<EpiInProj, GridOrder>(C.lds, g, S, E, C.tid);
        }
        SEAM(P + 0);
        if (IN(P + 1) && PON(1)) { FRESH();
            if (PON2(11)) phase_indexer(C);
            __syncthreads();
            FRESH();
            if (PON2(12)) { pg8::Gemm g{WSP(bf16_t, WS_CDQ), WSP(bf16_t, WS_WUQ + l * SZ_WUQ), 256, 256, nullptr}; GridOrder S{3, 128 * 3, C.G, C.bid};
              EpiQUp E{WSP(bf16_t, WS_QC), WSP(float, WS_SSQ), WSP(float, WS_COSC), WSP(float, WS_SINC)};
              pg8::gemm_phase<EpiQUp, GridOrder>(C.lds, g, S, E, C.tid); }
            FRESH();
            if (PON2(13)) { pg8::Gemm g{WSP(bf16_t, WS_CDKV), WSP(bf16_t, WS_WUKV + l * SZ_WUKV), 256, 256, nullptr}; GridOrder S{4, 128 * 4, C.G, C.bid};
              EpiKvUp E{WSP(bf16_t, WS_KC), WSP(bf16_t, WS_VCT), WSP(float, WS_SSQ)};
              pg8::gemm_phase<EpiKvUp, GridOrder>(C.lds, g, S, E, C.tid); }
            __syncthreads();
            if (PON2(14)) { FRESH(); phase_gmlp(C, KIN(3) + l * 512, KIN(4) + l * 512, KIN(6) + (size_t)l * 8 * 128, l); }
        }
        SEAM(P + 1);
        if (IN(P + 2) && PON(2)) { FRESH();
            if (PON2(21)) phase_select(C);
            __syncthreads();
            FRESH(); if (PON2(22)) phase_attn<96, false>(C, WSP(bf16_t, WS_QC), WSP(bf16_t, WS_KC), WSP(bf16_t, WS_VCT), nullptr, WSP(bf16_t, WS_OBUF) + (size_t)2 * NTOK * 512);
        }
        SEAM(P + 2);
        if (IN(P + 3) && PON(3)) { FRESH(); phase_attn<64, true>(C, WSP(bf16_t, WS_QA), WSP(bf16_t, WS_KA), WSP(bf16_t, WS_VAT), WSP(unsigned, WS_MASK), WSP(bf16_t, WS_OBUF)); }
        SEAM(P + 3);
        if (IN(P + 4) && PON(4)) { FRESH();
            pg8::Gemm g{WSP(bf16_t, WS_OBUF), WSP(bf16_t, WS_WBR + l * SZ_WBR), 512, 512, nullptr}; MergeOrder S{C.G, C.bid};
            EpiMerge E{WSP(bf16_t, WS_GATE), WSP(bf16_t, WS_MERGED)};
            pg8::gemm_phase<EpiMerge, MergeOrder>(C.lds, g, S, E, C.tid);
        }
        SEAM(P + 4);
        if (IN(P + 5) && PON(5)) { FRESH();
            pg8::Gemm g{WSP(bf16_t, WS_MERGED), WSP(bf16_t, WS_WOUT + l * SZ_WOUT), 1024, 1024, nullptr}; GridOrder S{4, 128 * 4, C.G, C.bid};
            EpiOut E{dry ? WSP(bf16_t, WS_DRY) : WSP(bf16_t, WS_OBUF)};
            pg8::gemm_phase<EpiOut, GridOrder>(C.lds, g, S, E, C.tid);
        }
        SEAM(P + 5);
        if (IN(P + 6) && PON(6)) { FRESH(); phase_ln1_router(C, KIN(13) + l * 1024, KIN(14) + l * 1024, KIN(15) + (size_t)l * 1024 * 32, KIN(16) + l * 32, l, dry); }
        SEAM(P + 6);
        if (IN(P + 7) && PON(7)) { FRESH(); phase_dispatch(C, l); }
        SEAM(P + 7);
        if (IN(P + 8) && PON(8)) { FRESH();
            moe_tables(C, l);
            const LAS int* tb = (const LAS int*)(C.lds + MISC_OFF + 64) + 32;
            pg8::Gemm g{WSP(bf16_t, WS_XB), WSP(bf16_t, WS_WGU + l * SZ_WGU), 1024, 1024, WSP(int, WS_STK)}; MoeOrder S{8, tb[32] * 8, C.G, C.bid, tb};
            EpiMoeUp E{WSP(bf16_t, WS_H), KIN(18) + (size_t)l * NEXP * 2048};
            pg8::gemm_phase<EpiMoeUp, MoeOrder, true>(C.lds, g, S, E, C.tid);
        }
        SEAM(P + 8);
        if (IN(P + 9) && PON(9)) { FRESH();
            moe_tables(C, l);
            const LAS int* tb = (const LAS int*)(C.lds + MISC_OFF + 64) + 32;
            pg8::Gemm g{WSP(bf16_t, WS_H), WSP(bf16_t, WS_WDN + l * SZ_WDN), 1024, 1024, nullptr}; MoeOrder S{4, tb[32] * 4, C.G, C.bid, tb};
            EpiMoeDn E{dry ? WSP(bf16_t, WS_DRY) : WSP(bf16_t, WS_Y), KIN(20) + (size_t)l * NEXP * 1024, dry};
            pg8::gemm_phase<EpiMoeDn, MoeOrder>(C.lds, g, S, E, C.tid);
        }
        SEAM(P + 9);
        if (IN(P + 10) && PON(10)) { FRESH(); phase_ln2(C, KIN(21) + l * 1024, KIN(22) + l * 1024, kp->out, l, dry); }
        SEAM(P + 10);
    }
#ifdef DBG_STOP
    if (IN(NPHASE)) { FRESH(); dbg_dump(C, kp->out); }
#endif
#ifdef DBG_CHECK
    if (IN(NPHASE + 1)) { FRESH(); chk_proj(C, args); chk_attn(C); }
    if (IN(NPHASE + 2)) { FRESH();
        const unsigned* ctl = WSP(unsigned, WS_CTL); const float tol[6] = {0.06f, 0.06f, 2e-3f, 0.5f, 0.02f, 0.02f}; float sc = 1.f;
        for (int k = 0; k < 6; ++k) if (__uint_as_float(ctl[CW_ERR + k]) > tol[k]) sc += 0.2f * (float)(1 << k);
        float* o = kp->out; for (size_t i = (size_t)C.bid * 512 + C.tid; i < (size_t)NTOK * DM; i += (size_t)C.G * 512) o[i] *= sc; }
#endif
#undef IN
#undef SEAM
}

extern "C" void kernel_launch(void* const* d_in, const int* in_sizes, int n_in, void* d_out, int out_size, void* d_ws, size_t ws_size, hipStream_t stream) {
    static int grid = 0;
    if (grid == 0) {
        if (n_in != 23 || out_size != NTOK * DM || ws_size < WS_END) { fprintf(stderr, "kernel_launch: unexpected shapes (n_in %d, out %d, ws %zu < %zu)\n", n_in, out_size, ws_size, (size_t)WS_END); grid = -1; return; }
        int dev = 0, cus = 0, per_cu = 0;
        if (hipGetDevice(&dev) != hipSuccess || hipDeviceGetAttribute(&cus, hipDeviceAttributeMultiprocessorCount, dev) != hipSuccess) { grid = -1; return; }
        if (hipFuncSetAttribute((const void*)trunk_fwd, hipFuncAttributeMaxDynamicSharedMemorySize, LDS_BYTES) != hipSuccess) { fprintf(stderr, "kernel_launch: hipFuncSetAttribute failed\n"); grid = -1; return; }
        if (hipOccupancyMaxActiveBlocksPerMultiprocessor(&per_cu, (const void*)trunk_fwd, NWAVES * 64, LDS_BYTES) != hipSuccess || per_cu < 1) { fprintf(stderr, "kernel_launch: occupancy query reports %d\n", per_cu); }
        (void)hipGetLastError();
        grid = cus;
    }
    if (grid < 0) return;
    (void)hipMemsetAsync((char*)d_ws + WS_CTL, 0, CTL_ZERO_BYTES, stream);
#ifdef DBG_ZERO_WS
    (void)hipMemsetAsync((char*)d_ws + WS_XRES, 0, WS_END - WS_XRES, stream);
#endif
    Args a{};
    for (int i = 0; i < 23; ++i) a.in[i] = (const float*)d_in[i];
    a.out = (float*)d_out; a.ws = (unsigned char*)d_ws; a.sub = -1; a.pad = 0;
#if MK_ONE_LAUNCH
    a.ph_lo = 0; a.ph_hi = NPHASE;
    hipLaunchKernelGGL(trunk_fwd, dim3(grid), dim3(NWAVES * 64), LDS_BYTES, stream, a);
#else
#ifdef DBG_STOP
    for (int p = 0; p < 1 + DBG_STOP; ++p) { a.ph_lo = p; a.ph_hi = p + 1; hipLaunchKernelGGL(trunk_fwd, dim3(grid), dim3(NWAVES * 64), LDS_BYTES, stream, a); }
    a.ph_lo = NPHASE; a.ph_hi = NPHASE + 1; hipLaunchKernelGGL(trunk_fwd, dim3(grid), dim3(NWAVES * 64), LDS_BYTES, stream, a);
#else
    for (int p = 0; p < NPHASE; ++p) { a.ph_lo = p; a.ph_hi = p + 1; a.sub = -1; a.pad = 0; hipLaunchKernelGGL(trunk_fwd, dim3(grid), dim3(NWAVES * 64), LDS_BYTES, stream, a);
#ifdef DBG_CHECK
        if (p == 4) { a.ph_lo = NPHASE + 1; a.ph_hi = NPHASE + 2; hipLaunchKernelGGL(trunk_fwd, dim3(grid), dim3(NWAVES * 64), LDS_BYTES, stream, a); }
        if (p == NPHASE - 1) { a.ph_lo = NPHASE + 2; a.ph_hi = NPHASE + 3; hipLaunchKernelGGL(trunk_fwd, dim3(grid), dim3(NWAVES * 64), LDS_BYTES, stream, a); }
#endif
#ifdef PROBE_PH
#ifndef PROBE_DRY
#define PROBE_DRY 0
#endif
        if ((p == 0 && PROBE_PH == -1) || (p >= 1 && (p - 1) % NPH_LAYER == PROBE_PH)) { a.sub = PROBE_SUB; a.pad = PROBE_DRY; hipLaunchKernelGGL(trunk_fwd, dim3(grid), dim3(NWAVES * 64), LDS_BYTES, stream, a); }
#endif
    }
#endif
#endif
}
```

```cpp
#include <hip/hip_runtime.h>
#include <cstdio>
#include <cstdint>

#ifndef MK_ONE_LAUNCH
#define MK_ONE_LAUNCH 1
#endif

#define LAS __attribute__((address_space(3)))
typedef unsigned short bf16_t;
typedef short bf16x8 __attribute__((ext_vector_type(8)));
typedef float f32x4 __attribute__((ext_vector_type(4)));
typedef float f32x16 __attribute__((ext_vector_type(16)));
typedef unsigned u32x4 __attribute__((ext_vector_type(4)));
typedef unsigned u32x2 __attribute__((ext_vector_type(2)));
typedef float f32x2_t __attribute__((ext_vector_type(2)));
typedef __bf16 bf16x2_t __attribute__((ext_vector_type(2)));

__device__ __forceinline__ unsigned pk2(float lo, float hi) { f32x2_t v = {lo, hi}; bf16x2_t b = __builtin_convertvector(v, bf16x2_t); return __builtin_bit_cast(unsigned, b); }
__device__ __forceinline__ float bf2f(unsigned short x) { return __uint_as_float(((unsigned)x) << 16); }
__device__ __forceinline__ float bflo(unsigned w) { return __uint_as_float(w << 16); }
__device__ __forceinline__ float bfhi(unsigned w) { return __uint_as_float(w & 0xffff0000u); }
template <int M> __device__ __forceinline__ float xswz(float v) { static_assert(M >= 1 && M <= 16, "xswz"); return __int_as_float(__builtin_amdgcn_ds_swizzle(__float_as_int(v), 0x1F | (M << 10))); }
template <int M> __device__ __forceinline__ unsigned xswzu(unsigned v) { return (unsigned)__builtin_amdgcn_ds_swizzle((int)v, 0x1F | (M << 10)); }
__device__ __forceinline__ float xsum32(float v) { auto rr = __builtin_amdgcn_permlane32_swap(__float_as_uint(v), __float_as_uint(v), false, false); return __uint_as_float(rr[0]) + __uint_as_float(rr[1]); }
__device__ __forceinline__ float xmax32(float v) { auto rr = __builtin_amdgcn_permlane32_swap(__float_as_uint(v), __float_as_uint(v), false, false); return fmaxf(__uint_as_float(rr[0]), __uint_as_float(rr[1])); }
__device__ __forceinline__ float xother32(float v, bool upper) { auto rr = __builtin_amdgcn_permlane32_swap(__float_as_uint(v), __float_as_uint(v), false, false); return __uint_as_float(upper ? rr[0] : rr[1]); }
#define LDS_WAIT() asm volatile("s_waitcnt lgkmcnt(0)" ::: "memory")
#define VM_WAIT() asm volatile("s_waitcnt vmcnt(0)" ::: "memory")

constexpr int NB = 8, SEQ = 4096, NTOK = NB * SEQ, DM = 1024, NLAYER = 4;
constexpr int NIN_SRC = 6632, NIN = 6656;
constexpr int NEXP = 32, TOPK = 4, DFF = 1024;
constexpr int NSLOT = NTOK * TOPK, NSLOT_PAD = NSLOT + NEXP * 256;
constexpr float LN_EPS = 1e-5f, RMS_EPS = 1e-6f;
constexpr float DN_ALPHA = 1.681792830507429f;
constexpr float LOG2E = 1.4426950408889634f;
constexpr float QSCALE_A = 0.125f * LOG2E;
constexpr float QSCALE_C = 0.10206207261596577f * LOG2E;
constexpr float IW_SCALE = 0.35355339059327373f * 0.125f;

constexpr size_t MiB = (size_t)1 << 20;
constexpr size_t WS_CTL = 0, CTL_ZERO_BYTES = 1 * MiB;
constexpr int CW_BAR = 4096, CW_CNT = 16384;
constexpr size_t SZ_WIN = (size_t)NIN * DM * 2, SZ_WUQ = (size_t)768 * 256 * 2, SZ_WUKV = (size_t)1024 * 256 * 2, SZ_WBR = (size_t)3 * 1024 * 512 * 2, SZ_WOUT = (size_t)1024 * 1024 * 2;
constexpr size_t SZ_WGU = (size_t)NEXP * 2048 * 1024 * 2, SZ_WDN = (size_t)NEXP * 1024 * 1024 * 2, SZ_WGM = (size_t)8 * 128 * 128 * 2;
constexpr size_t WS_WIN = 2 * MiB;
constexpr size_t WS_WUQ = WS_WIN + NLAYER * SZ_WIN;
constexpr size_t WS_WUKV = WS_WUQ + NLAYER * SZ_WUQ;
constexpr size_t WS_WBR = WS_WUKV + NLAYER * SZ_WUKV;
constexpr size_t WS_WOUT = WS_WBR + NLAYER * SZ_WBR;
constexpr size_t WS_WGU = WS_WOUT + NLAYER * SZ_WOUT;
constexpr size_t WS_WDN = WS_WGU + NLAYER * SZ_WGU;
constexpr size_t WS_WGM = WS_WDN + NLAYER * SZ_WDN;
constexpr size_t WS_COSA = WS_WGM + NLAYER * SZ_WGM;
constexpr size_t WS_SINA = WS_COSA + (size_t)NTOK * 8 * 4;
constexpr size_t WS_COSC = WS_SINA + (size_t)NTOK * 8 * 4;
constexpr size_t WS_SINC = WS_COSC + (size_t)NTOK * 16 * 4;
constexpr size_t WS_XRES = WS_SINC + (size_t)NTOK * 16 * 4;
constexpr size_t WS_XB = WS_XRES + (size_t)NTOK * DM * 4;
constexpr size_t WS_QA = WS_XB + (size_t)NTOK * DM * 2;
constexpr size_t WS_KA = WS_QA + (size_t)NTOK * 512 * 2;
constexpr size_t WS_VAT = WS_KA + (size_t)NTOK * 512 * 2;
constexpr size_t WS_IQ = WS_VAT + (size_t)NTOK * 512 * 2;
constexpr size_t WS_IK = WS_IQ + (size_t)NTOK * 512 * 2;
constexpr size_t WS_IW = WS_IK + (size_t)NTOK * 64 * 2;
constexpr size_t WS_U = WS_IW + (size_t)NTOK * 8 * 4;
constexpr size_t WS_V = WS_U + (size_t)NTOK * 512 * 2;
constexpr size_t WS_CDQ = WS_V + (size_t)NTOK * 512 * 2;
constexpr size_t WS_CDKV = WS_CDQ + (size_t)NTOK * 256 * 2;
constexpr size_t WS_SSQ = WS_CDKV + (size_t)NTOK * 256 * 2;
constexpr size_t WS_GATE = WS_SSQ + (size_t)NTOK * 8 * 4;
constexpr size_t WS_QC = WS_GATE + (size_t)NTOK * 3072 * 2;
constexpr size_t WS_KC = WS_QC + (size_t)NTOK * 768 * 2;
constexpr size_t WS_VCT = WS_KC + (size_t)NTOK * 768 * 2;
constexpr size_t WS_SCORE = WS_VCT + (size_t)NTOK * 512 * 2;
constexpr size_t WS_MASK = WS_SCORE + (size_t)NTOK * SEQ * 4;
constexpr size_t WS_OBUF = WS_MASK + (size_t)NTOK * 128 * 4;
constexpr size_t WS_MERGED = WS_OBUF + (size_t)3 * NTOK * 512 * 2;
constexpr size_t WS_TKE = WS_MERGED + (size_t)NTOK * DM * 2;
constexpr size_t WS_TKP = WS_TKE + (size_t)NSLOT * 4;
constexpr size_t WS_TKW = WS_TKP + (size_t)NSLOT * 4;
constexpr size_t WS_STK = WS_TKW + (size_t)NSLOT * 4;
constexpr size_t WS_SW = WS_STK + (size_t)NSLOT_PAD * 4;
constexpr size_t WS_XG = WS_SW + (size_t)NSLOT_PAD * 4;
constexpr size_t WS_H = WS_XG + (size_t)NSLOT_PAD * DM * 2;
constexpr size_t WS_Y = WS_H + (size_t)NSLOT_PAD * DFF * 2;
constexpr size_t WS_CCNT = WS_Y + (size_t)NSLOT_PAD * DM * 2;
constexpr size_t WS_END = WS_CCNT + (size_t)(NTOK / 128) * 32 * 4;
constexpr size_t WS_DRY = (WS_END + 255) & ~(size_t)255;
static_assert(WS_END < (size_t)4200 * MiB, "workspace map too large");
static_assert((WS_WIN % 256) == 0 && (WS_COSA % 256) == 0 && (WS_XRES % 256) == 0 && (WS_SCORE % 256) == 0 && (WS_XG % 256) == 0, "alignment");

constexpr int LDS_BYTES = 147456;
constexpr int MISC_OFF = 143360;
constexpr int NWAVES = 8;

#define XB_TMO      128
#define XB_XCNT(j)  (256  + 64 * (j))
#define XB_XSUB(j)  (1280 + 64 * (j))
#define XB_XGEN(j)  (2304 + 64 * (j))
#define XB_TOP      3328
#define XB_TOPGEN   3392
#define XCD_BAR_WORDS 3456
#define XB_SPIN_CAP (1u << 18)
__device__ __forceinline__ unsigned xb_ld(unsigned* p)              { return __hip_atomic_load(p, __ATOMIC_RELAXED, __HIP_MEMORY_SCOPE_AGENT); }
__device__ __forceinline__ unsigned xb_add(unsigned* p, unsigned v) { return __hip_atomic_fetch_add(p, v, __ATOMIC_RELAXED, __HIP_MEMORY_SCOPE_AGENT); }
__device__ __forceinline__ unsigned xb_xcc_id() { return (unsigned)__builtin_amdgcn_s_getreg((3 << 11) | 20) & 0xFu; }
#define XB_SPIN(cond, bar) do { unsigned _sp = 0; while (cond) { __builtin_amdgcn_s_sleep(1); \
    if ((++_sp & 255u) == 0u) { if (xb_ld(&(bar)[XB_TMO])) break; if (_sp > XB_SPIN_CAP) { atomicAdd(&(bar)[XB_TMO], 1u); break; } } } } while (0)
struct XcdBarrier { unsigned* bar; unsigned x; volatile LAS unsigned* st; };
__device__ __forceinline__ XcdBarrier xcd_barrier_post(unsigned* bar, volatile LAS unsigned* st) {
    XcdBarrier b; b.bar = bar; b.x = xb_xcc_id(); b.st = st;
    if (threadIdx.x == 0) (void)xb_add(&bar[XB_XCNT(b.x)], 1u);
    return b;
}
__device__ __forceinline__ void xcd_barrier_complete(unsigned* bar, unsigned x, unsigned& nloc, unsigned& nx) {
    const unsigned G = gridDim.x * gridDim.y * gridDim.z;
    unsigned sum, cnt, mine, sp = 0u;
    for (;;) {
        sum = 0u; cnt = 0u; mine = 0u;
#pragma unroll
        for (unsigned j = 0; j < 16; ++j) { const unsigned c = xb_ld(&bar[XB_XCNT(j)]); sum += c; cnt += (c > 0u) ? 1u : 0u; mine = (j == x) ? c : mine; }
        if (sum == G) break;
        __builtin_amdgcn_s_sleep(1);
        if ((++sp & 255u) == 0u) { if (xb_ld(&bar[XB_TMO])) break; if (sp > XB_SPIN_CAP) { atomicAdd(&bar[XB_TMO], 1u); break; } }
    }
    nloc = mine > 0u ? mine : 1u; nx = cnt > 0u ? cnt : 1u;
}
__device__ __forceinline__ void xcd_barrier(const XcdBarrier& b, bool leader_thread) {
    asm volatile("s_waitcnt vmcnt(0)" ::: "memory");
    __syncthreads();
    if (leader_thread) {
        unsigned* bar = b.bar;
        __builtin_amdgcn_s_waitcnt(0);
        unsigned nloc = b.st[0], nx = b.st[1];
        if (nloc == 0u) { xcd_barrier_complete(bar, b.x, nloc, nx); b.st[0] = nloc; b.st[1] = nx; }
        const unsigned old = xb_add(&bar[XB_XSUB(b.x)], 1u);
        const unsigned gen = old / nloc;
        if (old + 1u == (gen + 1u) * nloc) {
            __builtin_amdgcn_fence(__ATOMIC_RELEASE, "agent");
            asm volatile("s_waitcnt vmcnt(0)" ::: "memory");
            const unsigned og = xb_add(&bar[XB_TOP], 1u);
            const unsigned tg = og / nx;
            if (og + 1u == (tg + 1u) * nx) xb_add(&bar[XB_TOPGEN], 1u);
            else XB_SPIN(xb_ld(&bar[XB_TOPGEN]) == tg, bar);
            __builtin_amdgcn_fence(__ATOMIC_ACQUIRE, "agent");
            xb_add(&bar[XB_XGEN(b.x)], 1u);
            asm volatile("s_waitcnt vmcnt(0)" ::: "memory");
        } else {
            XB_SPIN(xb_ld(&bar[XB_XGEN(b.x)]) == gen, bar);
            __builtin_amdgcn_fence(__ATOMIC_ACQUIRE, "agent");
            asm volatile("s_waitcnt vmcnt(0)" ::: "memory");
        }
    }
    __syncthreads();
}

namespace pg8 {
constexpr int BM = 256, BK = 64, HALF = 128, HTB = HALF * BK * 2;
__host__ __device__ __forceinline__ int lds_byte(int r, int c) { const int st = (r >> 4) * 2 + (c >> 5), rr = r & 15, cc = c & 31, ob = rr * 64 + cc * 2; return st * 1024 + (ob ^ (((ob >> 9) & 1) << 5)); }
__host__ __device__ __forceinline__ void stage_rc(int b, int& R, int& C) { const int st = b / 1024, sb = b % 1024, swz = sb ^ (((sb >> 9) & 1) << 5); R = (st >> 1) * 16 + swz / 64; C = (st & 1) * 32 + (swz % 64) / 2; }
__host__ __device__ __forceinline__ int perm32(int rho) { const int n = rho >> 4, i = rho & 15; return 8 * (i >> 2) + 4 * n + (i & 3); }
struct Unit { int pm, pn; };
struct Gemm { const bf16_t* A; const bf16_t* Bt; int lda, K; const int* rowmap; };

template <class Epi, class Sched, bool GATHER = false>
__device__ __forceinline__ void gemm_phase(LAS unsigned char* lds, const Gemm g, const Sched& S, const Epi& E, int tid0) {
    int tid = tid0; asm volatile("" : "+v"(tid));
    const int wid = __builtin_amdgcn_readfirstlane(tid >> 6), lane = tid & 63, wr = wid >> 2, wc = wid & 3, fr = lane & 15, fq = lane >> 4;
    const int K = g.K, nt = K / BK, lda = g.lda;
    unsigned voffA[2], voffB[2]; unsigned colA2 = 0u;
#pragma unroll
    for (int i = 0; i < 2; ++i) { int R, C; stage_rc(tid * 16 + i * 8192, R, C); voffA[i] = (unsigned)(R * lda + C) * 2u; const int Rb = (R & ~31) + perm32(R & 31); voffB[i] = (unsigned)(Rb * K + C) * 2u; colA2 = (unsigned)C * 2u; }
    unsigned gcur[2] = {0u, 0u}, gnxt[2] = {0u, 0u};
#define PG8_GLOAD(d, pm_) do { int ln_; asm volatile("v_mbcnt_lo_u32_b32 %0, -1, 0\n\tv_mbcnt_hi_u32_b32 %0, -1, %0" : "=v"(ln_));   \
        int R0_, C0_; stage_rc(((wid << 6) | ln_) * 16, R0_, C0_); const int* rm_ = g.rowmap + (pm_) * BM + R0_; \
        d[0] = (unsigned)rm_[0] | ((unsigned)rm_[64] << 16); d[1] = (unsigned)rm_[HALF] | ((unsigned)rm_[HALF + 64] << 16); } while (0)
#define PG8_GOFF(p, i) ((((i) ? ((p) >> 16) : ((p) & 0xffffu)) * (unsigned)(lda * 2)) + colA2)
#define PG8_STAGE_G(bufoff, gbase, p) do { _Pragma("unroll") for (int _i = 0; _i < 2; ++_i) \
        __builtin_amdgcn_global_load_lds((const unsigned*)((const char*)(gbase) + PG8_GOFF(p, _i)), (LAS unsigned*)(lds + (bufoff) + ldsw + _i * 8192), 16, 0, 0); } while (0)
    const size_t kstep = (size_t)(BK * 2);
    const size_t hstepA = (size_t)HALF * lda * 2, hstepB = (size_t)HALF * K * 2;
    const size_t tstepA = 2 * hstepA, tstepB = 2 * hstepB;
    const unsigned ldsw = (unsigned)wid * 1024u;
    const int aoff = lds_byte(wr * 64 + fr, fq * 8), boff = lds_byte(wc * 32 + fr, fq * 8);
#define PG8_SA(b, h) (((b) * 2 + (h)) * HTB)
#define PG8_SB(b, h) ((4 + (b) * 2 + (h)) * HTB)
#define PG8_STAGE(bufoff, gbase, voff) do { _Pragma("unroll") for (int _i = 0; _i < 2; ++_i) \
        __builtin_amdgcn_global_load_lds((const unsigned*)((const char*)(gbase) + (voff)[_i]), (LAS unsigned*)(lds + (bufoff) + ldsw + _i * 8192), 16, 0, 0); } while (0)
#define PG8_STAGE_A(bufoff, gbase, half, nextu) do { if constexpr (GATHER) { if (nextu) PG8_STAGE_G(bufoff, gbase, gnxt[half]); else PG8_STAGE_G(bufoff, gbase, gcur[half]); } \
        else { PG8_STAGE(bufoff, (gbase) + ((half) ? hstepA : 0), voffA); } } while (0)
#define PG8_LDA(dst, b, h) do { _Pragma("unroll") for (int m = 0; m < 4; ++m) _Pragma("unroll") for (int k = 0; k < 2; ++k) dst[m][k] = *(const LAS bf16x8*)(lds + PG8_SA(b, h) + aoff + m * 2048 + k * 1024); } while (0)
#define PG8_LDB(dst, b, h) do { _Pragma("unroll") for (int n = 0; n < 2; ++n) _Pragma("unroll") for (int k = 0; k < 2; ++k) dst[n][k] = *(const LAS bf16x8*)(lds + PG8_SB(b, h) + boff + n * 2048 + k * 1024); } while (0)
#define PG8_MMA(ai, bj, At, Bt) do { __builtin_amdgcn_s_setprio(1); _Pragma("unroll") for (int m = 0; m < 4; ++m) _Pragma("unroll") for (int n = 0; n < 2; ++n) _Pragma("unroll") for (int k = 0; k < 2; ++k) \
        acc[ai][bj][m][n] = __builtin_amdgcn_mfma_f32_16x16x32_bf16(Bt[n][k], At[m][k], acc[ai][bj][m][n], 0, 0, 0); __builtin_amdgcn_s_setprio(0); } while (0)
#define PG8_WAIT_V(n) asm volatile("s_waitcnt vmcnt(" #n ")" ::: "memory")
#define PG8_WAIT_L(n) asm volatile("s_waitcnt lgkmcnt(" #n ")" ::: "memory")
#define PG8_BAR __builtin_amdgcn_s_barrier()
#define PG8_SCHED __builtin_amdgcn_sched_barrier(0)
    Unit cur, nxt; int ui = 0;
    if (!S.next(0, cur)) return;
    f32x4 acc[2][2][4][2];
#pragma unroll
    for (int a = 0; a < 2; ++a)
#pragma unroll
        for (int b = 0; b < 2; ++b)
#pragma unroll
            for (int m = 0; m < 4; ++m)
#pragma unroll
                for (int n = 0; n < 2; ++n) acc[a][b][m][n] = (f32x4){0.f, 0.f, 0.f, 0.f};
    bf16x8 At[4][2], B0[2][2], B1[2][2];
    const char* cA = GATHER ? (const char*)g.A : (const char*)g.A + (size_t)cur.pm * tstepA; const char* cB = (const char*)g.Bt + (size_t)cur.pn * tstepB;
    if constexpr (GATHER) { PG8_GLOAD(gcur, cur.pm); }
    PG8_STAGE(PG8_SB(0, 0), cB, voffB); PG8_STAGE(PG8_SB(0, 1), cB + hstepB, voffB); PG8_STAGE_A(PG8_SA(0, 0), cA, 0, false); PG8_STAGE_A(PG8_SA(0, 1), cA, 1, false);
    if (wr == 1) PG8_BAR;
    PG8_WAIT_V(2); PG8_BAR;
    PG8_STAGE(PG8_SB(1, 0), cB + kstep, voffB); PG8_STAGE_A(PG8_SA(1, 0), cA + kstep, 0, false); PG8_STAGE(PG8_SB(1, 1), cB + hstepB + kstep, voffB);
    PG8_WAIT_V(6); PG8_BAR;
    for (;;) {
        const bool has_next = S.next(ui + 1, nxt);
        const char* nA = GATHER ? cA : (has_next ? (const char*)g.A + (size_t)nxt.pm * tstepA : cA); const char* nB = has_next ? (const char*)g.Bt + (size_t)nxt.pn * tstepB : cB;
        if constexpr (GATHER) { if (has_next) { PG8_GLOAD(gnxt, nxt.pm); } else { gnxt[0] = gcur[0]; gnxt[1] = gcur[1]; } }
        for (int t = 0; t < nt; t += 2) {
            const bool last = (t == nt - 2);
            const char* a1 = cA + (size_t)(t + 1) * kstep;
            const char* a2 = last ? nA : cA + (size_t)(t + 2) * kstep; const char* b2 = last ? nB : cB + (size_t)(t + 2) * kstep;
            const char* a3 = a2 + kstep; const char* b3 = b2 + kstep;
            PG8_LDB(B0, 0, 0); PG8_LDB(B1, 0, 1); PG8_SCHED; PG8_LDA(At, 0, 0); PG8_STAGE_A(PG8_SA(1, 1), a1, 1, false);
            PG8_WAIT_V(8); PG8_WAIT_L(0); PG8_BAR; PG8_MMA(0, 0, At, B0); PG8_MMA(0, 1, At, B1); PG8_BAR; PG8_SCHED;
            PG8_LDA(At, 0, 1); PG8_STAGE(PG8_SB(0, 0), b2, voffB); PG8_STAGE(PG8_SB(0, 1), b2 + hstepB, voffB); PG8_STAGE_A(PG8_SA(0, 0), a2, 0, last);
            PG8_WAIT_V(8); PG8_WAIT_L(0); PG8_BAR; PG8_MMA(1, 0, At, B0); PG8_MMA(1, 1, At, B1); PG8_BAR; PG8_SCHED;
            PG8_LDB(B0, 1, 0); PG8_LDB(B1, 1, 1); PG8_SCHED; PG8_LDA(At, 1, 0); PG8_STAGE_A(PG8_SA(0, 1), a2, 1, last);
            PG8_WAIT_V(8); PG8_WAIT_L(0); PG8_BAR; PG8_MMA(0, 0, At, B0); PG8_MMA(0, 1, At, B1); PG8_BAR; PG8_SCHED;
            PG8_LDA(At, 1, 1); PG8_STAGE(PG8_SB(1, 0), b3, voffB); PG8_STAGE(PG8_SB(1, 1), b3 + hstepB, voffB); PG8_STAGE_A(PG8_SA(1, 0), a3, 0, last);
            PG8_WAIT_V(8); PG8_WAIT_L(0); PG8_BAR; PG8_MMA(1, 0, At, B0); PG8_MMA(1, 1, At, B1); PG8_BAR; PG8_SCHED;
        }
        if (wr == 0) PG8_BAR;
        { int el; asm volatile("v_mbcnt_lo_u32_b32 %0, -1, 0\n\tv_mbcnt_hi_u32_b32 %0, -1, %0" : "=v"(el));
          E(acc, cur, wr, wc, el & 15, el >> 4); }
        if (!has_next) break;
        if constexpr (!Epi::CHAIN) {
#pragma unroll
        for (int a = 0; a < 2; ++a)
#pragma unroll
            for (int b = 0; b < 2; ++b)
#pragma unroll
                for (int m = 0; m < 4; ++m)
#pragma unroll
                    for (int n = 0; n < 2; ++n) acc[a][b][m][n] = (f32x4){0.f, 0.f, 0.f, 0.f};
        }
        cur = nxt; cA = nA; cB = nB; ++ui;
        if constexpr (GATHER) { gcur[0] = gnxt[0]; gcur[1] = gnxt[1]; }
        if (wr == 1) PG8_BAR;
    }
    PG8_WAIT_V(0);
    PG8_BAR;
#undef PG8_SA
#undef PG8_SB
#undef PG8_STAGE
#undef PG8_LDA
#undef PG8_STAGE_A
#undef PG8_GLOAD
#undef PG8_GOFF
#undef PG8_STAGE_G
#undef PG8_LDB
#undef PG8_MMA
#undef PG8_WAIT_V
#undef PG8_WAIT_L
#undef PG8_BAR
#undef PG8_SCHED
}
}
using pg8::Unit;

struct Args { const float* in[23]; float* out; unsigned char* ws; int ph_lo, ph_hi; int sub, pad; };
struct Ctx {
    LAS unsigned char* lds;
    int tid, lane, wave, G, bid;
    unsigned char* ws;
};
#define WSP(T, off) ((T*)(C.ws + (off)))

struct GridOrder {
    int nN, total, G, c;
    __device__ __forceinline__ bool next(int i, Unit& u) const {
        const int L = c + i * G; if (L >= total) return false;
        const int nM = total / nN; int wgid;
        { const int q = total >> 3, r = total & 7, xcd = L & 7, off = L >> 3; wgid = (xcd < r ? xcd * (q + 1) : r * (q + 1) + (xcd - r) * q) + off; }
        const int nig = 8 * nN, gid = wgid / nig, fm = gid * 8, gsz = (nM - fm) < 8 ? (nM - fm) : 8, w = wgid - gid * nig;
        const int pn = w / gsz; u.pm = fm + (w - pn * gsz); u.pn = pn; return true;
    }
};
struct MergeOrder {
    int G, c;
    __device__ __forceinline__ bool next(int i, Unit& u) const { const int t = i / 3, n = i - 3 * t, tile = c + t * G; if (tile >= 512) return false; u.pm = n * 128 + (tile >> 2); u.pn = n * 4 + (tile & 3); return true; }
};
struct MoeOrder {
    int NT, total, G, c; const LAS int* tb;
    __device__ __forceinline__ bool next(int i, Unit& u) const {
        if ((G & 7) != 0) { const int idx = c + i * G; if (idx >= total) return false; const int mt = idx / NT, pn = idx - mt * NT;
            const int e = __builtin_amdgcn_readfirstlane(tb[40 + mt]); u.pm = mt; u.pn = e * NT + pn; return true; }
        const int T = __builtin_amdgcn_readfirstlane(tb[NEXP]), x = c & 7, lo = (x * T) >> 3, ntl = (((x + 1) * T) >> 3) - lo;
        const int j = (c >> 3) + i * (G >> 3);
        if (j >= ntl * NT) return false;
        const int gsh = (NT == 8) ? 6 : 5, gm = j >> gsh, rem = j - (gm << gsh);
        const int gs = (ntl - 8 * gm < 8) ? (ntl - 8 * gm) : 8, g4 = gs * 4, pg = (rem >= g4) ? 1 : 0, r2 = rem - pg * g4;
        const int mt = lo + 8 * gm + (r2 >> 2), e = __builtin_amdgcn_readfirstlane(tb[40 + mt]);
        u.pm = mt; u.pn = e * NT + pg * 4 + (r2 & 3); return true;
    }
};

__device__ __forceinline__ float gelu_f(float v) {
    const float av = fabsf(v), t = __builtin_amdgcn_rcpf(fmaf(av, 0.2316418882f, 1.0f));
    float q = fmaf(t, 0.5307027145f, -0.7265760135f); q = fmaf(q, t, 0.7107068705f); q = fmaf(q, t, -0.142248368f); q = fmaf(q, t, 0.127414796f); q = q * t;
    const float e = __builtin_amdgcn_exp2f((v * v) * (-0.72134752044f));
    const float m = v * (q * e);
    return v < 0.f ? m : v - m;
}
__device__ __forceinline__ float sigmoid_f(float x) { return __builtin_amdgcn_rcpf(1.f + __builtin_amdgcn_exp2f(x * (-LOG2E))); }
__device__ __forceinline__ int perm16(int o) { return (o & 3) | (((o >> 3) & 1) << 2) | (((o >> 2) & 1) << 3); }
__device__ __forceinline__ void st_bf4(bf16_t* p, f32x4 v) { u32x2 w; w.x = pk2(v[0], v[1]); w.y = pk2(v[2], v[3]); *(u32x2*)p = w; }
__device__ __forceinline__ f32x4 other32_4(f32x4 v, bool upper) { f32x4 r; r[0] = xother32(v[0], upper); r[1] = xother32(v[1], upper); r[2] = xother32(v[2], upper); r[3] = xother32(v[3], upper); return r; }

__device__ __forceinline__ void st_bf8(bf16_t* p, f32x4 v0, f32x4 v1) { u32x4 w; w.x = pk2(v0[0], v0[1]); w.y = pk2(v0[2], v0[3]); w.z = pk2(v1[0], v1[1]); w.w = pk2(v1[2], v1[3]); __builtin_nontemporal_store(w, (u32x4*)p); }
__device__ __forceinline__ f32x4 swz16_4(f32x4 v) { f32x4 r; r[0] = xswz<16>(v[0]); r[1] = xswz<16>(v[1]); r[2] = xswz<16>(v[2]); r[3] = xswz<16>(v[3]); return r; }
__device__ __forceinline__ void ld_bf8(const bf16_t* p, f32x4& a, f32x4& b) { const u32x4 w = *(const u32x4*)p; a = (f32x4){bflo(w.x), bfhi(w.x), bflo(w.y), bfhi(w.y)}; b = (f32x4){bflo(w.z), bfhi(w.z), bflo(w.w), bfhi(w.w)}; }
__device__ __forceinline__ void st_vt8(bf16_t* p, f32x4 v0, f32x4 v1) {
    const unsigned w0 = pk2(v0[0], v0[1]), w1 = pk2(v0[2], v0[3]), w2 = pk2(v1[0], v1[1]), w3 = pk2(v1[2], v1[3]);
    p[0] = (bf16_t)(w0 & 0xffff); p[SEQ] = (bf16_t)(w0 >> 16); p[2 * SEQ] = (bf16_t)(w1 & 0xffff); p[3 * SEQ] = (bf16_t)(w1 >> 16);
    p[4 * SEQ] = (bf16_t)(w2 & 0xffff); p[5 * SEQ] = (bf16_t)(w2 >> 16); p[6 * SEQ] = (bf16_t)(w3 & 0xffff); p[7 * SEQ] = (bf16_t)(w3 >> 16);
}
struct EpiInProj {
    static constexpr bool CHAIN = false;
    unsigned char* ws; bool skip;
    __device__ __forceinline__ void operator()(f32x4 (&acc)[2][2][4][2], const Unit& un, int wr, int wc, int fr, int fq) const {
        if (skip) return;
        const int pn = un.pn; const int row0 = un.pm * 256 + wr * 64 + fr;
        const float* cosA = (const float*)(ws + WS_COSA); const float* sinA = (const float*)(ws + WS_SINA); const float* cosC = (const float*)(ws + WS_COSC); const float* sinC = (const float*)(ws + WS_SINC);
        if (pn < 4 || pn == 6 || pn == 7) {
            const size_t doff = pn < 2 ? WS_QA : (pn < 4 ? WS_KA : WS_IQ); bf16_t* dst = (bf16_t*)(ws + doff); const float sc = pn < 2 ? QSCALE_A : 1.f; const int tcol = (pn & 1) * 256;
            const bool rope = (wc & 1) == 0;
#pragma unroll
            for (int ai = 0; ai < 2; ++ai)
#pragma unroll
                for (int m = 0; m < 4; ++m) { const int row = row0 + ai * 128 + m * 16;
                    f32x4 c0 = {1.f, 1.f, 1.f, 1.f}, c1 = c0, s0 = {0.f, 0.f, 0.f, 0.f}, s1 = s0;
                    if (rope) { c0 = *(const f32x4*)(cosA + (size_t)row * 8); c1 = *(const f32x4*)(cosA + (size_t)row * 8 + 4); s0 = *(const f32x4*)(sinA + (size_t)row * 8); s1 = *(const f32x4*)(sinA + (size_t)row * 8 + 4); }
#pragma unroll
                    for (int bj = 0; bj < 2; ++bj) { f32x4 v0 = acc[ai][bj][m][0], v1 = acc[ai][bj][m][1];
                        const f32x4 p0 = swz16_4(v0), p1 = swz16_4(v1);
                        if (rope && fq < 2) { v0 = (fq == 0) ? (v0 * c0 - p0 * s0) : (v0 * c0 + p0 * s0); v1 = (fq == 0) ? (v1 * c1 - p1 * s1) : (v1 * c1 + p1 * s1); }
                        st_bf8(dst + (size_t)row * 512 + tcol + bj * 128 + wc * 32 + 8 * fq, v0 * sc, v1 * sc); } }
        } else if (pn < 6) {
            bf16_t* vat = (bf16_t*)(ws + WS_VAT);
#pragma unroll
            for (int ai = 0; ai < 2; ++ai)
#pragma unroll
                for (int m = 0; m < 4; ++m) { const int row = row0 + ai * 128 + m * 16; const int b = row >> 12, s = row & 4095, ps = (s & ~15) | perm16(s & 15);
#pragma unroll
                    for (int bj = 0; bj < 2; ++bj) { const int c = (pn - 4) * 256 + bj * 128 + wc * 32 + 8 * fq; const int h = c >> 6, d = c & 63;
                        st_vt8(vat + ((size_t)(b * 8 + h) * 64 + d) * SEQ + ps, acc[ai][bj][m][0], acc[ai][bj][m][1]); } }
        } else if (pn == 8) {
            bf16_t* ik = (bf16_t*)(ws + WS_IK); float* iw = (float*)(ws + WS_IW); bf16_t* kc = (bf16_t*)(ws + WS_KC); bf16_t* cd = (bf16_t*)(ws + WS_CDKV); float* ssq = (float*)(ws + WS_SSQ);
#pragma unroll
            for (int ai = 0; ai < 2; ++ai)
#pragma unroll
                for (int m = 0; m < 4; ++m) { const int row = row0 + ai * 128 + m * 16;
                    { f32x4 v0 = acc[ai][0][m][0], v1 = acc[ai][0][m][1];
                      { unsigned zz = 0u; asm volatile("" : "+v"(zz)); const u32x4 z = {zz, zz, zz, zz}; *(u32x4*)(cd + (size_t)row * 256 + wc * 32 + 8 * fq) = z; }
                      if (wc == 0) {
                          const f32x4 p0 = swz16_4(v0), p1 = swz16_4(v1);
                          if (fq < 2) { const f32x4 c0 = *(const f32x4*)(cosA + (size_t)row * 8), c1 = *(const f32x4*)(cosA + (size_t)row * 8 + 4), s0 = *(const f32x4*)(sinA + (size_t)row * 8), s1 = *(const f32x4*)(sinA + (size_t)row * 8 + 4);
                              v0 = (fq == 0) ? (v0 * c0 - p0 * s0) : (v0 * c0 + p0 * s0); v1 = (fq == 0) ? (v1 * c1 - p1 * s1) : (v1 * c1 + p1 * s1); }
                          st_bf8(ik + (size_t)row * 64 + 8 * fq, v0, v1);
                      } else if (wc == 1) { st_bf8(ik + (size_t)row * 64 + 32 + 8 * fq, v0, v1);
                      } else if (wc == 2) { if (fq == 0) { *(f32x4*)(iw + (size_t)row * 8) = v0 * IW_SCALE; *(f32x4*)(iw + (size_t)row * 8 + 4) = v1 * IW_SCALE; }
                      } else {
                          const bool up = fq >= 2; const f32x4 p0 = other32_4(v0, up), p1 = other32_4(v1, up);
                          const f32x4 c0 = *(const f32x4*)(cosC + (size_t)row * 16 + 8 * (fq & 1)), c1 = *(const f32x4*)(cosC + (size_t)row * 16 + 8 * (fq & 1) + 4), s0 = *(const f32x4*)(sinC + (size_t)row * 16 + 8 * (fq & 1)), s1 = *(const f32x4*)(sinC + (size_t)row * 16 + 8 * (fq & 1) + 4);
                          const f32x4 o0 = up ? (v0 * c0 + p0 * s0) : (v0 * c0 - p0 * s0), o1 = up ? (v1 * c1 + p1 * s1) : (v1 * c1 - p1 * s1);
                          bf16_t* p = kc + (size_t)row * 768 + 64 + 8 * fq;
#pragma unroll
                          for (int h = 0; h < 8; ++h) st_bf8(p + h * 96, o0, o1); } }
                    { const f32x4 v0 = acc[ai][1][m][0], v1 = acc[ai][1][m][1];
                      st_bf8(cd + (size_t)row * 256 + 128 + wc * 32 + 8 * fq, v0, v1);
                      float s = (v0[0] * v0[0] + v0[1] * v0[1]) + (v0[2] * v0[2] + v0[3] * v0[3]) + (v1[0] * v1[0] + v1[1] * v1[1]) + (v1[2] * v1[2] + v1[3] * v1[3]);
                      s += xswz<16>(s); s = xsum32(s);
                      if (fq == 0) ssq[(size_t)row * 8 + 4 + wc] = s; } }
        } else if (pn < 13) {
            bf16_t* dst = (bf16_t*)(ws + (pn < 11 ? WS_U : WS_V)); const int tcol = ((pn - 9) & 1) * 256;
#pragma unroll
            for (int ai = 0; ai < 2; ++ai)
#pragma unroll
                for (int m = 0; m < 4; ++m) { const int row = row0 + ai * 128 + m * 16;
#pragma unroll
                    for (int bj = 0; bj < 2; ++bj) { f32x4 v0 = acc[ai][bj][m][0], v1 = acc[ai][bj][m][1];
                        v0[0] = gelu_f(v0[0]); v0[1] = gelu_f(v0[1]); v0[2] = gelu_f(v0[2]); v0[3] = gelu_f(v0[3]); v1[0] = gelu_f(v1[0]); v1[1] = gelu_f(v1[1]); v1[2] = gelu_f(v1[2]); v1[3] = gelu_f(v1[3]);
                        st_bf8(dst + (size_t)row * 512 + tcol + bj * 128 + wc * 32 + 8 * fq, v0, v1); } }
        } else if (pn == 13) {
            bf16_t* cd = (bf16_t*)(ws + WS_CDQ); float* ssq = (float*)(ws + WS_SSQ);
#pragma unroll
            for (int ai = 0; ai < 2; ++ai)
#pragma unroll
                for (int m = 0; m < 4; ++m) { const int row = row0 + ai * 128 + m * 16; float s = 0.f;
#pragma unroll
                    for (int bj = 0; bj < 2; ++bj) { const f32x4 v0 = acc[ai][bj][m][0], v1 = acc[ai][bj][m][1];
                        st_bf8(cd + (size_t)row * 256 + bj * 128 + wc * 32 + 8 * fq, v0, v1);
                        s += ((v0[0] * v0[0] + v0[1] * v0[1]) + (v0[2] * v0[2] + v0[3] * v0[3])) + ((v1[0] * v1[0] + v1[1] * v1[1]) + (v1[2] * v1[2] + v1[3] * v1[3])); }
                    s += xswz<16>(s); s = xsum32(s);
                    if (fq == 0) ssq[(size_t)row * 8 + wc] = s; }
        } else {
            const int tcol = (pn - 14) * 256; bf16_t* gate = (bf16_t*)(ws + WS_GATE);
#pragma unroll
            for (int ai = 0; ai < 2; ++ai)
#pragma unroll
                for (int m = 0; m < 4; ++m) { const int row = row0 + ai * 128 + m * 16;
#pragma unroll
                    for (int bj = 0; bj < 2; ++bj) { f32x4 v0 = acc[ai][bj][m][0], v1 = acc[ai][bj][m][1];
                        v0[0] = sigmoid_f(v0[0]); v0[1] = sigmoid_f(v0[1]); v0[2] = sigmoid_f(v0[2]); v0[3] = sigmoid_f(v0[3]); v1[0] = sigmoid_f(v1[0]); v1[1] = sigmoid_f(v1[1]); v1[2] = sigmoid_f(v1[2]); v1[3] = sigmoid_f(v1[3]);
                        st_bf8(gate + (size_t)row * 3072 + tcol + bj * 128 + wc * 32 + 8 * fq, v0, v1); } }
        }
    }
};

struct EpiQUp {
    static constexpr bool CHAIN = false;
    bf16_t* qc; const float* ssq; const float *cosC, *sinC;
    __device__ __forceinline__ void operator()(f32x4 (&acc)[2][2][4][2], const Unit& un, int wr, int wc, int fr, int fq) const {
        const int row0 = un.pm * 256 + wr * 64 + fr; const bool up = fq >= 2;
#pragma unroll
        for (int ai = 0; ai < 2; ++ai)
#pragma unroll
            for (int m = 0; m < 4; ++m) { const int row = row0 + ai * 128 + m * 16;
                const f32x4 sp = *(const f32x4*)(ssq + (size_t)row * 8);
                const float rs = rsqrtf(((sp[0] + sp[1]) + (sp[2] + sp[3])) * (1.f / 256.f) + RMS_EPS) * QSCALE_C;
                const f32x4 c0 = *(const f32x4*)(cosC + (size_t)row * 16 + 8 * (fq & 1)), c1 = *(const f32x4*)(cosC + (size_t)row * 16 + 8 * (fq & 1) + 4), s0 = *(const f32x4*)(sinC + (size_t)row * 16 + 8 * (fq & 1)), s1 = *(const f32x4*)(sinC + (size_t)row * 16 + 8 * (fq & 1) + 4);
#pragma unroll
                for (int bj = 0; bj < 2; ++bj) { const int gidx = un.pn * 8 + bj * 4 + wc;
                    f32x4 v0 = acc[ai][bj][m][0] * rs, v1 = acc[ai][bj][m][1] * rs;
                    if ((gidx % 3) == 2) { const f32x4 p0 = other32_4(v0, up), p1 = other32_4(v1, up);
                        v0 = up ? (v0 * c0 + p0 * s0) : (v0 * c0 - p0 * s0); v1 = up ? (v1 * c1 + p1 * s1) : (v1 * c1 - p1 * s1); }
                    st_bf8(qc + (size_t)row * 768 + gidx * 32 + 8 * fq, v0, v1); } }
    }
};
struct EpiKvUp {
    static constexpr bool CHAIN = false;
    bf16_t *kc, *vct; const float* ssq;
    __device__ __forceinline__ void operator()(f32x4 (&acc)[2][2][4][2], const Unit& un, int wr, int wc, int fr, int fq) const {
        const int row0 = un.pm * 256 + wr * 64 + fr;
#pragma unroll
        for (int ai = 0; ai < 2; ++ai)
#pragma unroll
            for (int m = 0; m < 4; ++m) { const int row = row0 + ai * 128 + m * 16;
                const f32x4 sp = *(const f32x4*)(ssq + (size_t)row * 8 + 4);
                const float rs = rsqrtf(((sp[0] + sp[1]) + (sp[2] + sp[3])) * (1.f / 128.f) + RMS_EPS);
                const int b = row >> 12, s = row & 4095, ps = (s & ~15) | perm16(s & 15);
#pragma unroll
                for (int bj = 0; bj < 2; ++bj) { const int h = un.pn * 2 + bj; const f32x4 v0 = acc[ai][bj][m][0] * rs, v1 = acc[ai][bj][m][1] * rs;
                    if (wc < 2) st_bf8(kc + (size_t)row * 768 + h * 96 + wc * 32 + 8 * fq, v0, v1);
                    else st_vt8(vct + ((size_t)(b * 8 + h) * 64 + (wc - 2) * 32 + 8 * fq) * SEQ + ps, v0, v1); }
                asm volatile("" ::: "memory"); }
    }
};
struct EpiMerge {
    static constexpr bool CHAIN = true;
    const bf16_t* gate; bf16_t* merged;
    __device__ __forceinline__ void operator()(f32x4 (&acc)[2][2][4][2], const Unit& un, int wr, int wc, int fr, int fq) const {
        const int n3 = un.pm >> 7, pm = un.pm & 127, pn = un.pn & 3; const int row0 = pm * 256 + wr * 64 + fr;
#pragma unroll
        for (int ai = 0; ai < 2; ++ai)
#pragma unroll
            for (int m = 0; m < 4; ++m) { const int row = row0 + ai * 128 + m * 16;
#pragma unroll
                for (int bj = 0; bj < 2; ++bj) { const int col = pn * 256 + bj * 128 + wc * 32 + 8 * fq;
                    const bf16_t* gp = gate + (size_t)row * 3072 + n3 * 1024 + col;
                    f32x4 ga0, ga1; ld_bf8(gp, ga0, ga1);
                    if (n3 < 2) { f32x4 gb0, gb1; ld_bf8(gp + 1024, gb0, gb1);
#pragma unroll
                        for (int j = 0; j < 4; ++j) { if (n3 == 1) { ga0[j] = fmaxf(ga0[j], 1e-20f); ga1[j] = fmaxf(ga1[j], 1e-20f); }
                            acc[ai][bj][m][0][j] *= ga0[j] * __builtin_amdgcn_rcpf(fmaxf(gb0[j], 1e-20f)); acc[ai][bj][m][1][j] *= ga1[j] * __builtin_amdgcn_rcpf(fmaxf(gb1[j], 1e-20f)); }
                    } else {
#pragma unroll
                        for (int j = 0; j < 4; ++j) { ga0[j] = fmaxf(ga0[j], 1e-20f); ga1[j] = fmaxf(ga1[j], 1e-20f); }
                        st_bf8(merged + (size_t)row * 1024 + col, acc[ai][bj][m][0] * ga0, acc[ai][bj][m][1] * ga1);
                        acc[ai][bj][m][0] = (f32x4){0.f, 0.f, 0.f, 0.f}; acc[ai][bj][m][1] = (f32x4){0.f, 0.f, 0.f, 0.f};
                    } } }
    }
};
struct EpiOut {
    static constexpr bool CHAIN = false;
    bf16_t* yo;
    __device__ __forceinline__ void operator()(f32x4 (&acc)[2][2][4][2], const Unit& un, int wr, int wc, int fr, int fq) const {
        const int row0 = un.pm * 256 + wr * 64 + fr;
#pragma unroll
        for (int ai = 0; ai < 2; ++ai)
#pragma unroll
            for (int m = 0; m < 4; ++m) { const int row = row0 + ai * 128 + m * 16;
#pragma unroll
                for (int bj = 0; bj < 2; ++bj) st_bf8(yo + (size_t)row * 1024 + un.pn * 256 + bj * 128 + wc * 32 + 8 * fq, acc[ai][bj][m][0], acc[ai][bj][m][1]); }
    }
};
struct EpiMoeUp {
    static constexpr bool CHAIN = false;
    bf16_t* hbuf; const float* bgu;
    __device__ __forceinline__ void operator()(f32x4 (&acc)[2][2][4][2], const Unit& un, int wr, int wc, int fr, int fq) const {
        const int e = un.pn >> 3, pnl = un.pn & 7; const int row0 = un.pm * 256 + wr * 64 + fr; const float* be = bgu + (size_t)e * 2048;
        const int jh = pnl * 128 + wc * 32 + 8 * fq;
        const f32x4 bg0 = *(const f32x4*)(be + jh), bg1 = *(const f32x4*)(be + jh + 4), bl0 = *(const f32x4*)(be + 1024 + jh), bl1 = *(const f32x4*)(be + 1024 + jh + 4);
#pragma unroll
        for (int ai = 0; ai < 2; ++ai)
#pragma unroll
            for (int m = 0; m < 4; ++m) { const int row = row0 + ai * 128 + m * 16;
                const f32x4 g0 = acc[ai][0][m][0] + bg0, g1 = acc[ai][0][m][1] + bg1, l0 = acc[ai][1][m][0] + bl0, l1 = acc[ai][1][m][1] + bl1; f32x4 o0, o1;
#pragma unroll
                for (int j = 0; j < 4; ++j) { const float ga = fminf(g0[j], 7.f), la = fminf(fmaxf(l0[j], -7.f), 7.f); o0[j] = (la + 1.f) * (ga * sigmoid_f(1.702f * ga));
                    const float gb = fminf(g1[j], 7.f), lb = fminf(fmaxf(l1[j], -7.f), 7.f); o1[j] = (lb + 1.f) * (gb * sigmoid_f(1.702f * gb)); }
                st_bf8(hbuf + (size_t)row * 1024 + jh, o0, o1);
                __builtin_amdgcn_sched_barrier(0); }
    }
};
struct EpiMoeDn {
    static constexpr bool CHAIN = false;
    bf16_t* y; const float* bdn; bool skip;
    __device__ __forceinline__ void operator()(f32x4 (&acc)[2][2][4][2], const Unit& un, int wr, int wc, int fr, int fq) const {
        const int e = un.pn >> 2, pnl = un.pn & 3; const int row0 = (skip ? 0 : un.pm * 256) + wr * 64 + fr; const float* be = bdn + (size_t)e * 1024;
#pragma unroll
        for (int bj = 0; bj < 2; ++bj) { const int col = pnl * 256 + bj * 128 + wc * 32 + 8 * fq; const f32x4 b0 = *(const f32x4*)(be + col), b1 = *(const f32x4*)(be + col + 4);
#pragma unroll
            for (int ai = 0; ai < 2; ++ai)
#pragma unroll
                for (int m = 0; m < 4; ++m) st_bf8(y + (size_t)(row0 + ai * 128 + m * 16) * 1024 + col, acc[ai][bj][m][0] + b0, acc[ai][bj][m][1] + b1); }
    }
};

__device__ __forceinline__ int colmap_in(int np) {
    if (np < 2048) return np;
    if (np < 2304) { const int t = np - 2048; if (t < 64) return 2048 + t; if (t < 72) return 2112 + (t - 64); if (t < 96) return -1; if (t < 128) return 3528 + (t - 96); return 3400 + (t - 128); }
    if (np < 3328) return 2120 + (np - 2304);
    if (np < 3584) return 3144 + (np - 3328);
    return 3560 + (np - 3584);
}
__device__ __forceinline__ int colmap_gu(int np) { const int tile = np >> 8, w = np & 255; return (w < 128) ? (tile * 128 + w) : (1024 + tile * 128 + (w - 128)); }
template <int KIND>
__device__ __forceinline__ void tconv_item(const float* src, int ldsrc, bf16_t* dst, int Kdst, int koff, const float* kscale, int item, int nblk, LAS float* scr, int lane) {
    const int kb = item / nblk, nb = item - kb * nblk, k0 = 64 * kb, n0 = 32 * nb;
    const int np = n0 + (lane & 31);
    const int col = KIND == 1 ? colmap_in(np) : (KIND == 2 ? colmap_gu(np) : np);
    float vv[32];
#pragma unroll
    for (int i = 0; i < 32; ++i) { const int kk = 2 * i + (lane >> 5); const int ks = k0 + kk - koff; float v = 0.f;
        if (col >= 0 && ks >= 0) { v = src[(size_t)ks * ldsrc + col]; if (kscale) v *= kscale[ks]; }
        vv[i] = v; }
#pragma unroll
    for (int i = 0; i < 32; ++i) { const int kk = 2 * i + (lane >> 5); scr[kk * 33 + (lane & 31)] = vv[i]; }
    LDS_WAIT(); asm volatile("" ::: "memory");
    const int c = lane & 7;
#pragma unroll
    for (int j = 0; j < 4; ++j) { const int n = (lane >> 3) + 8 * j; const LAS float* s = scr + (8 * c) * 33 + n;
        u32x4 o; o.x = pk2(s[0 * 33], s[1 * 33]); o.y = pk2(s[2 * 33], s[3 * 33]); o.z = pk2(s[4 * 33], s[5 * 33]); o.w = pk2(s[6 * 33], s[7 * 33]);
        *(u32x4*)(dst + (size_t)(n0 + n) * Kdst + k0 + 8 * c) = o; }
    LDS_WAIT(); asm volatile("" ::: "memory");
}
__device__ __forceinline__ void phase_prologue(const Ctx& C, const Args& A) {
    LAS float* scr = (LAS float*)(C.lds + C.wave * 16384);
    const int gw = C.bid * NWAVES + C.wave, NGW = C.G * NWAVES;
    constexpr int I_IN = 16 * (NIN / 32), I_UQ = 4 * 24, I_UKV = 4 * 32, I_BR = 8 * 32, I_OUT = 16 * 32, I_GU = 16 * 64, I_DN = 16 * 32;
    constexpr int I_LAYER = I_IN + I_UQ + I_UKV + 3 * I_BR + I_OUT + NEXP * I_GU + NEXP * I_DN;
    for (int it = gw; it < NLAYER * I_LAYER; it += NGW) {
        const int l = it / I_LAYER; int r = it - l * I_LAYER;
        if (r < I_IN) { tconv_item<1>(A.in[2] + (size_t)l * DM * NIN_SRC, NIN_SRC, WSP(bf16_t, WS_WIN + l * SZ_WIN), 1024, 0, nullptr, r, NIN / 32, scr, C.lane); continue; } r -= I_IN;
        if (r < I_UQ) { tconv_item<0>(A.in[9] + (size_t)l * 256 * 768, 768, WSP(bf16_t, WS_WUQ + l * SZ_WUQ), 256, 0, A.in[7] + l * 256, r, 24, scr, C.lane); continue; } r -= I_UQ;
        if (r < I_UKV) { tconv_item<0>(A.in[10] + (size_t)l * 128 * 1024, 1024, WSP(bf16_t, WS_WUKV + l * SZ_WUKV), 256, 128, A.in[8] + l * 128, r, 32, scr, C.lane); continue; } r -= I_UKV;
        if (r < 3 * I_BR) { const int n = r / I_BR; r -= n * I_BR;
            tconv_item<0>(A.in[11] + ((size_t)l * 3 + n) * 512 * 1024, 1024, WSP(bf16_t, WS_WBR + l * SZ_WBR) + (size_t)n * 1024 * 512, 512, 0, nullptr, r, 32, scr, C.lane); continue; } r -= 3 * I_BR;
        if (r < I_OUT) { tconv_item<0>(A.in[12] + (size_t)l * 1024 * 1024, 1024, WSP(bf16_t, WS_WOUT + l * SZ_WOUT), 1024, 0, nullptr, r, 32, scr, C.lane); continue; } r -= I_OUT;
        if (r < NEXP * I_GU) { const int e = r / I_GU; r -= e * I_GU;
            tconv_item<2>(A.in[17] + ((size_t)l * NEXP + e) * 1024 * 2048, 2048, WSP(bf16_t, WS_WGU + l * SZ_WGU) + (size_t)e * 2048 * 1024, 1024, 0, nullptr, r, 64, scr, C.lane); continue; } r -= NEXP * I_GU;
        { const int e = r / I_DN; r -= e * I_DN;
            tconv_item<0>(A.in[19] + ((size_t)l * NEXP + e) * 1024 * 1024, 1024, WSP(bf16_t, WS_WDN + l * SZ_WDN) + (size_t)e * 1024 * 1024, 1024, 0, nullptr, r, 32, scr, C.lane); }
    }
    const int gt = C.bid * 512 + C.tid, NGT = C.G * 512;
    { bf16_t* d = WSP(bf16_t, WS_WGM); const float* s = A.in[5];
      for (int i = gt; i < NLAYER * 8 * 128 * 128; i += NGT) { const int jj = i & 127, ii = (i >> 7) & 127; d[i] = (jj <= ii) ? (bf16_t)(pk2(s[i], 0.f) & 0xffff) : (bf16_t)0; } }
    { const int* pos = (const int*)A.in[1]; float *ca = WSP(float, WS_COSA), *sa = WSP(float, WS_SINA), *cc = WSP(float, WS_COSC), *sc = WSP(float, WS_SINC);
      for (int i = gt; i < NTOK * 8; i += NGT) { const int t = i >> 3, f = i & 7; const float inv = powf(500000.f, -(float)f / 8.f); const float ang = (float)pos[t] * inv; ca[i] = cosf(ang); sa[i] = sinf(ang); }
      for (int i = gt; i < NTOK * 16; i += NGT) { const int t = i >> 4, f = i & 15; const float inv = powf(500000.f, -(float)f / 16.f); const float ang = (float)pos[t] * inv; cc[i] = cosf(ang); sc[i] = sinf(ang); } }
    { const f32x4* x4 = (const f32x4*)A.in[0]; u32x2* xb = WSP(u32x2, WS_XB);
      for (int i = gt; i < NTOK * DM / 4; i += NGT) { const f32x4 v = x4[i]; u32x2 w; w.x = pk2(v[0], v[1]); w.y = pk2(v[2], v[3]); xb[i] = w; } }
}

__device__ __forceinline__ void idx_block(const Ctx& C, int b, int qb) {
    const int tid = C.tid, lane = C.lane, wid = C.wave, r32 = lane & 31, hi = lane >> 5;
    const bf16_t* iq = WSP(bf16_t, WS_IQ); const bf16_t* ik = WSP(bf16_t, WS_IK); const float* iw = WSP(float, WS_IW); float* score = WSP(float, WS_SCORE);
    const int qi_l = ((r32 >> 4) << 1) + ((r32 >> 2) & 1), h_l = (r32 & 3) + 4 * ((r32 >> 3) & 1);
    bf16x8 af[2][4]; float wv[2][2][8];
#pragma unroll
    for (int rb = 0; rb < 2; ++rb) { const size_t tok = (size_t)b * SEQ + qb * 64 + wid * 8 + rb * 4 + qi_l;
#pragma unroll
        for (int ks = 0; ks < 4; ++ks) af[rb][ks] = *(const bf16x8*)(iq + tok * 512 + h_l * 64 + ks * 16 + hi * 8);
#pragma unroll
        for (int g = 0; g < 2; ++g) { const size_t tq = (size_t)b * SEQ + qb * 64 + wid * 8 + rb * 4 + 2 * g + hi;
            const f32x4 w0 = *(const f32x4*)(iw + tq * 8), w1 = *(const f32x4*)(iw + tq * 8 + 4);
            wv[rb][g][0] = w0[0]; wv[rb][g][1] = w0[1]; wv[rb][g][2] = w0[2]; wv[rb][g][3] = w0[3]; wv[rb][g][4] = w1[0]; wv[rb][g][5] = w1[1]; wv[rb][g][6] = w1[2]; wv[rb][g][7] = w1[3]; } }
    const int lkey = tid & 63, lch = tid >> 6;
    const bf16_t* ksrc = ik + ((size_t)b * SEQ + lkey) * 64 + lch * 8;
    LAS unsigned char* kdst = C.lds + (lch * 64 + lkey) * 16;
    const int NT = qb + 1;
    u32x4 rk = *(const u32x4*)ksrc;
    *(LAS u32x4*)kdst = rk;
    __syncthreads();
    for (int kt = 0; kt < NT; ++kt) {
        const int cur = kt & 1;
        if (kt + 1 < NT) rk = *(const u32x4*)(ksrc + (size_t)(kt + 1) * 64 * 64);
        const LAS unsigned char* kb = C.lds + cur * 8192;
        bf16x8 bfr[2][4];
#pragma unroll
        for (int kbk = 0; kbk < 2; ++kbk)
#pragma unroll
            for (int ks = 0; ks < 4; ++ks) bfr[kbk][ks] = *(const LAS bf16x8*)(kb + ((2 * ks + hi) * 64 + kbk * 32 + r32) * 16);
#pragma unroll
        for (int rb = 0; rb < 2; ++rb)
#pragma unroll
            for (int kbk = 0; kbk < 2; ++kbk) {
                f32x16 a = {};
#pragma unroll
                for (int ks = 0; ks < 4; ++ks) a = __builtin_amdgcn_mfma_f32_32x32x16_bf16(af[rb][ks], bfr[kbk][ks], a, 0, 0, 0);
#pragma unroll
                for (int g = 0; g < 2; ++g) { float s = 0.f;
#pragma unroll
                    for (int hh = 0; hh < 8; ++hh) s = fmaf(fmaxf(a[8 * g + hh], 0.f), wv[rb][g][hh], s);
                    const size_t tq = (size_t)b * SEQ + qb * 64 + wid * 8 + rb * 4 + 2 * g + hi;
                    score[tq * SEQ + kt * 64 + kbk * 32 + r32] = s; } }
        if (kt + 1 < NT) *(LAS u32x4*)(kdst + (cur ^ 1) * 8192) = rk;
        __syncthreads();
    }
}
__device__ __forceinline__ void phase_indexer(const Ctx& C) {
    for (int u0 = C.bid; u0 < NB * 32; u0 += C.G) {
        int u = u0; if (C.G == NB * 32) u = (C.bid & 7) * 32 + (C.bid >> 3);
        const int b = u >> 5, p = u & 31; idx_block(C, b, p); idx_block(C, b, 63 - p); }
}

__device__ __forceinline__ unsigned f2key(float f) { const unsigned u = __float_as_uint(f); return (u & 0x80000000u) ? ~u : (u | 0x80000000u); }
__device__ __forceinline__ int wave_total7(unsigned cv) {
    int t = 0;
#pragma unroll
    for (int b = 0; b < 7; ++b) t += __popcll(__ballot((cv >> b) & 1u)) << b;
    return t;
}
template <int NG>
__device__ __forceinline__ unsigned select_radix(const unsigned (&u)[64]) {
    unsigned prefix = 0u;
    for (int bit = 31; bit >= 0; --bit) {
        const unsigned cand = prefix | (1u << bit); unsigned cv = 0u;
#pragma unroll
        for (int i = 0; i < NG * 8; ++i) cv += (u[i] >= cand) ? 1u : 0u;
        const int cnt = wave_total7(cv);
        if (cnt >= 256) prefix = cand;
        if (cnt == 256) break;
    }
    return prefix;
}
__device__ __forceinline__ int wave_sum_dpp(int x) {
    x += __builtin_amdgcn_update_dpp(0, x, 0xB1, 0xf, 0xf, true);
    x += __builtin_amdgcn_update_dpp(0, x, 0x4E, 0xf, 0xf, true);
    x += __builtin_amdgcn_update_dpp(0, x, 0x141, 0xf, 0xf, true);
    x += __builtin_amdgcn_update_dpp(0, x, 0x140, 0xf, 0xf, true);
    x += __builtin_amdgcn_update_dpp(0, x, 0x142, 0xa, 0xf, false);
    x += __builtin_amdgcn_update_dpp(0, x, 0x143, 0xc, 0xf, false);
    return __builtin_amdgcn_readlane(x, 63);
}
__device__ __forceinline__ unsigned bfi32(unsigned m, unsigned x, unsigned y) { return (m & x) | (~m & y); }
__device__ __forceinline__ void bit_transpose32(unsigned* a) {
#pragma unroll
    for (int k = 0; k < 16; ++k) { const unsigned x = a[k], y = a[k + 16]; a[k] = __builtin_amdgcn_perm(y, x, 0x05040100u); a[k + 16] = __builtin_amdgcn_perm(y, x, 0x07060302u); }
#pragma unroll
    for (int k = 0; k < 32; ++k) if ((k & 8) == 0) { const unsigned x = a[k], y = a[k + 8]; a[k] = __builtin_amdgcn_perm(y, x, 0x06020400u); a[k + 8] = __builtin_amdgcn_perm(y, x, 0x07030501u); }
#pragma unroll
    for (int k = 0; k < 32; ++k) if ((k & 4) == 0) { const unsigned x = a[k], y = a[k + 4]; a[k] = bfi32(0x0f0f0f0fu, x, y << 4); a[k + 4] = bfi32(0x0f0f0f0fu, x >> 4, y); }
#pragma unroll
    for (int k = 0; k < 32; ++k) if ((k & 2) == 0) { const unsigned x = a[k], y = a[k + 2]; a[k] = bfi32(0x33333333u, x, y << 2); a[k + 2] = bfi32(0x33333333u, x >> 2, y); }
#pragma unroll
    for (int k = 0; k < 32; ++k) if ((k & 1) == 0) { const unsigned x = a[k], y = a[k + 1]; a[k] = bfi32(0x55555555u, x, y << 1); a[k + 1] = bfi32(0x55555555u, x >> 1, y); }
}
template <int NW>
__device__ __forceinline__ void select_bits(const float* row, int n, unsigned* mrow, int lane) {
    constexpr int W = 32 * NW;
    unsigned a[W];
    {   const u32x4* src = (const u32x4*)(row + lane * W);
#pragma unroll
        for (int i = 0; i < W / 4; ++i) { const u32x4 v = src[i];
#pragma unroll
            for (int j = 0; j < 4; ++j) { const unsigned u = v[j]; a[4 * i + j] = u ^ ((unsigned)((int)u >> 31) | 0x80000000u); } }
    }
#pragma unroll
    for (int blk = 0; blk < NW; ++blk) bit_transpose32(a + 32 * blk);
    unsigned alive[NW], above[NW];
#pragma unroll
    for (int w = 0; w < NW; ++w) { const int nv = n - lane * W - 32 * w; alive[w] = nv >= 32 ? 0xffffffffu : (nv <= 0 ? 0u : ((1u << nv) - 1u)); above[w] = 0u; }
    int cnta = 0; bool exact = false;
#pragma unroll
    for (int b = 31; b >= 0; --b) {
        unsigned o[NW]; int pc = 0;
#pragma unroll
        for (int w = 0; w < NW; ++w) { o[w] = alive[w] & a[32 * w + b]; pc += __popc(o[w]); }
        const int tot = cnta + wave_sum_dpp(pc);
        if (tot >= 256) {
#pragma unroll
            for (int w = 0; w < NW; ++w) alive[w] = o[w];
            if (tot == 256) { exact = true; break; }
        } else {
#pragma unroll
            for (int w = 0; w < NW; ++w) { above[w] |= o[w]; alive[w] ^= o[w]; }
            cnta = tot;
        }
    }
    if (!exact) {
        int pc = 0;
#pragma unroll
        for (int w = 0; w < NW; ++w) pc += __popc(alive[w]);
        const int ceq = wave_sum_dpp(pc), need = 256 - cnta;
        if (ceq > need) {
            int excl = 0;
#pragma unroll 1
            for (int L = 0; L < 63; ++L) { const int v = __builtin_amdgcn_readlane(pc, L); excl += (lane > L) ? v : 0; }
            int take = need - excl; take = take < 0 ? 0 : (take > pc ? pc : take);
            int c = pc;
            if (NW == 2) { while (c > take && alive[NW - 1] != 0u) { alive[NW - 1] &= ~(0x80000000u >> __clz(alive[NW - 1])); --c; } }
            while (c > take) { alive[0] &= ~(0x80000000u >> __clz(alive[0])); --c; }
        }
    }
    if (NW == 2) { u32x2 m; m.x = above[0] | alive[0]; m.y = above[NW - 1] | alive[NW - 1]; *(u32x2*)(mrow + 2 * lane) = m; }
    else { mrow[lane] = above[0] | alive[0]; mrow[64 + lane] = 0u; }
}
__device__ __forceinline__ void phase_select(const Ctx& C) {
    const float* score = WSP(float, WS_SCORE); unsigned long long* mask = WSP(unsigned long long, WS_MASK);
    const int gw = C.bid * NWAVES + C.wave, NGW = C.G * NWAVES, lane = C.lane;
    for (int idx = gw; idx < NTOK; idx += NGW) {
        const int q = idx & (SEQ - 1); const int n = q + 1; const float* row = score + (size_t)idx * SEQ;
        if (n <= 256) {
            const int lo = n - 64 * lane;
            const unsigned long long m = lo >= 64 ? ~0ull : (lo <= 0 ? 0ull : ((1ull << lo) - 1ull));
            mask[(size_t)idx * 64 + lane] = m;
        } else if (n <= 2048) select_bits<1>(row, n, (unsigned*)(mask + (size_t)idx * 64), lane);
        else select_bits<2>(row, n, (unsigned*)(mask + (size_t)idx * 64), lane);
    }
}

__device__ __forceinline__ int crow(int r, int hi) { return (r & 3) + 8 * (r >> 2) + 4 * hi; }
template <int DQK, bool MASKED>
__device__ __forceinline__ void attn_unit(const Ctx& C, int b, int h, int qb, const bf16_t* Q, const bf16_t* K, const bf16_t* VT, const unsigned* mask, bf16_t* O) {
    constexpr int NKS = DQK / 16, NCH = DQK / 8, KTB = NCH * 1024, BUF = KTB + 8192, QS = 8 * DQK;
    const int tid = C.tid, lane = C.lane, wid = C.wave, r32 = lane & 31, hi = lane >> 5;
    const int NT = 4 * (qb + 1);
    const size_t tok = (size_t)b * SEQ + qb * 256 + wid * 32 + r32;
    bf16x8 qf[NKS];
#pragma unroll
    for (int ks = 0; ks < NKS; ++ks) qf[ks] = *(const bf16x8*)(Q + tok * QS + h * DQK + ks * 16 + hi * 8);
    const int lrow = tid & 63, lch = tid >> 6;
    const bf16_t* ksrc0 = K + ((size_t)b * SEQ + lrow) * QS + h * DQK + lch * 8;
    const bf16_t* ksrc1 = ksrc0 + 64;
    const bf16_t* vsrc = VT + ((size_t)(b * 8 + h) * 64 + lrow) * SEQ + lch * 8;
    LAS unsigned char* kd0 = C.lds + (lch * 64 + lrow) * 16;
    LAS unsigned char* kd1 = C.lds + ((8 + lch) * 64 + lrow) * 16;
    LAS unsigned char* vd = C.lds + KTB + (lch * 64 + lrow) * 16;
    const bool k1 = (DQK > 64) && (tid < 256);
    u32x4 rk0, rk1 = {0u, 0u, 0u, 0u}, rv;
    rk0 = *(const u32x4*)ksrc0; if (k1) rk1 = *(const u32x4*)ksrc1; rv = *(const u32x4*)vsrc;
    *(LAS u32x4*)kd0 = rk0; if (k1) *(LAS u32x4*)kd1 = rk1; *(LAS u32x4*)vd = rv;
    u32x2 mw = {0u, 0u};
    if (MASKED) mw = *(const u32x2*)(mask + tok * 128);
    float mbias = 0.f, thr = -1e30f, lsum = 0.f;
    u32x4 qmw = {0u, 0u, 0u, 0u};
    const bf16x8 kone = __builtin_bit_cast(bf16x8, (u32x4){hi == 0 ? 0x3F80u : 0u, 0u, 0u, 0u});
    f32x16 o0 = {}, o1 = {};
    __syncthreads();
    for (int kt = 0; kt < NT; ++kt) {
        const int cur = kt & 1;
        u32x2 mwn = {0u, 0u};
        if (kt + 1 < NT) {
            rk0 = *(const u32x4*)(ksrc0 + (size_t)(kt + 1) * 64 * QS); if (k1) rk1 = *(const u32x4*)(ksrc1 + (size_t)(kt + 1) * 64 * QS);
            rv = *(const u32x4*)(vsrc + (kt + 1) * 64);
            if (MASKED) mwn = *(const u32x2*)(mask + tok * 128 + 2 * (kt + 1));
        }
        const LAS unsigned char* kb = C.lds + cur * BUF; const LAS unsigned char* vb = kb + KTB;
        f32x16 p0 = {}, p1 = {};
        bf16x8 kf[2 * NKS], vf[8];
#pragma unroll
        for (int ks = 0; ks < NKS; ++ks) {
            kf[2 * ks] = *(const LAS bf16x8*)(kb + ((2 * ks + hi) * 64 + r32) * 16);
            kf[2 * ks + 1] = *(const LAS bf16x8*)(kb + ((2 * ks + hi) * 64 + 32 + r32) * 16);
        }
#pragma unroll
        for (int s4 = 0; s4 < 4; ++s4) {
            vf[2 * s4] = *(const LAS bf16x8*)(vb + ((2 * s4 + hi) * 64 + r32) * 16);
            vf[2 * s4 + 1] = *(const LAS bf16x8*)(vb + ((2 * s4 + hi) * 64 + 32 + r32) * 16);
        }
        __builtin_amdgcn_sched_barrier(0);
#pragma unroll
        for (int ks = 0; ks < NKS; ++ks) {
            p0 = __builtin_amdgcn_mfma_f32_32x32x16_bf16(kf[2 * ks], qf[ks], p0, 0, 0, 0);
            p1 = __builtin_amdgcn_mfma_f32_32x32x16_bf16(kf[2 * ks + 1], qf[ks], p1, 0, 0, 0);
        }
        { const bf16x8 qm = __builtin_bit_cast(bf16x8, qmw);
          p0 = __builtin_amdgcn_mfma_f32_32x32x16_bf16(kone, qm, p0, 0, 0, 0); p1 = __builtin_amdgcn_mfma_f32_32x32x16_bf16(kone, qm, p1, 0, 0, 0); }
        if (MASKED) {
            const unsigned w0 = mw.x >> (4 * hi), w1 = mw.y >> (4 * hi);
#pragma unroll
            for (int r = 0; r < 16; ++r) { const int bit = (r & 3) + 8 * (r >> 2);
                const unsigned t0 = (unsigned)__builtin_amdgcn_sbfe((int)w0, bit, 1), t1 = (unsigned)__builtin_amdgcn_sbfe((int)w1, bit, 1);
                p0[r] = __uint_as_float((__float_as_uint(p0[r]) & t0) | (~t0 & 0xFF800000u));
                p1[r] = __uint_as_float((__float_as_uint(p1[r]) & t1) | (~t1 & 0xFF800000u)); }
        } else {
            if (kt >= NT - 4) { const int kb0 = (kt - (NT - 4)) * 64, qrel = wid * 32 + r32;
#pragma unroll
                for (int r = 0; r < 16; ++r) { const int kv = kb0 + crow(r, hi); if (kv > qrel) p0[r] = -INFINITY; if (kv + 32 > qrel) p1[r] = -INFINITY; } }
        }
        float mx;
        { float a0 = fmaxf(fmaxf(p0[0], p0[1]), p0[2]), a1 = fmaxf(fmaxf(p0[3], p0[4]), p0[5]), a2 = fmaxf(fmaxf(p0[6], p0[7]), p0[8]), a3 = fmaxf(fmaxf(p0[9], p0[10]), p0[11]);
          float a4 = fmaxf(fmaxf(p0[12], p0[13]), p0[14]), a5 = fmaxf(fmaxf(p0[15], p1[0]), p1[1]), a6 = fmaxf(fmaxf(p1[2], p1[3]), p1[4]), a7 = fmaxf(fmaxf(p1[5], p1[6]), p1[7]);
          float a8 = fmaxf(fmaxf(p1[8], p1[9]), p1[10]), a9 = fmaxf(fmaxf(p1[11], p1[12]), p1[13]), a10 = fmaxf(p1[14], p1[15]);
          a0 = fmaxf(fmaxf(a0, a1), a2); a3 = fmaxf(fmaxf(a3, a4), a5); a6 = fmaxf(fmaxf(a6, a7), a8); a9 = fmaxf(a9, a10);
          mx = fmaxf(fmaxf(a0, a3), fmaxf(a6, a9)); }
        mx = xmax32(mx);
        if (__any(mx > thr)) {
            const bool upd = mx > thr;
            const float mnew = upd ? __uint_as_float(pk2(mbias + mx, 0.f) << 16) : mbias;
            const float delta = mnew - mbias; const float alpha = (thr < 0.f) ? 1.f : __builtin_amdgcn_exp2f(-delta);
            mbias = mnew; thr = upd ? 4.f : thr;
            qmw.x = hi == 0 ? (pk2(-mnew, 0.f) & 0xffffu) : 0u;
            lsum *= alpha;
#pragma unroll
            for (int r = 0; r < 16; ++r) { o0[r] *= alpha; o1[r] *= alpha; p0[r] -= delta; p1[r] -= delta; }
        }
        {
#pragma unroll
            for (int r = 0; r < 16; ++r) { p0[r] = __builtin_amdgcn_exp2f(p0[r]); p1[r] = __builtin_amdgcn_exp2f(p1[r]); }
            float s0 = (p0[0] + p0[1]) + (p0[2] + p0[3]), s1 = (p0[4] + p0[5]) + (p0[6] + p0[7]), s2 = (p0[8] + p0[9]) + (p0[10] + p0[11]), s3 = (p0[12] + p0[13]) + (p0[14] + p0[15]);
            float s4 = (p1[0] + p1[1]) + (p1[2] + p1[3]), s5 = (p1[4] + p1[5]) + (p1[6] + p1[7]), s6 = (p1[8] + p1[9]) + (p1[10] + p1[11]), s7 = (p1[12] + p1[13]) + (p1[14] + p1[15]);
            lsum += ((s0 + s1) + (s2 + s3)) + ((s4 + s5) + (s6 + s7));
        }
        bf16x8 pf[4];
        { u32x4 t;
          t.x = pk2(p0[0], p0[1]); t.y = pk2(p0[2], p0[3]); t.z = pk2(p0[4], p0[5]); t.w = pk2(p0[6], p0[7]); pf[0] = __builtin_bit_cast(bf16x8, t);
          t.x = pk2(p0[8], p0[9]); t.y = pk2(p0[10], p0[11]); t.z = pk2(p0[12], p0[13]); t.w = pk2(p0[14], p0[15]); pf[1] = __builtin_bit_cast(bf16x8, t);
          t.x = pk2(p1[0], p1[1]); t.y = pk2(p1[2], p1[3]); t.z = pk2(p1[4], p1[5]); t.w = pk2(p1[6], p1[7]); pf[2] = __builtin_bit_cast(bf16x8, t);
          t.x = pk2(p1[8], p1[9]); t.y = pk2(p1[10], p1[11]); t.z = pk2(p1[12], p1[13]); t.w = pk2(p1[14], p1[15]); pf[3] = __builtin_bit_cast(bf16x8, t); }
#pragma unroll
        for (int s = 0; s < 4; ++s) {
            o0 = __builtin_amdgcn_mfma_f32_32x32x16_bf16(vf[2 * s], pf[s], o0, 0, 0, 0);
            o1 = __builtin_amdgcn_mfma_f32_32x32x16_bf16(vf[2 * s + 1], pf[s], o1, 0, 0, 0);
        }
        if (kt + 1 < NT) {
            const int nb = (cur ^ 1) * BUF;
            *(LAS u32x4*)(kd0 + nb) = rk0; if (k1) *(LAS u32x4*)(kd1 + nb) = rk1; *(LAS u32x4*)(vd + nb) = rv;
        }
        mw = mwn;
        __syncthreads();
    }
    lsum = xsum32(lsum);
    const float inv = 1.f / lsum;
    bf16_t* op = O + tok * 512 + h * 64 + 4 * hi;
#pragma unroll
    for (int i = 0; i < 4; ++i) {
        st_bf4(op + 8 * i, (f32x4){o0[4 * i] * inv, o0[4 * i + 1] * inv, o0[4 * i + 2] * inv, o0[4 * i + 3] * inv});
        st_bf4(op + 32 + 8 * i, (f32x4){o1[4 * i] * inv, o1[4 * i + 1] * inv, o1[4 * i + 2] * inv, o1[4 * i + 3] * inv});
    }
}
template <int DQK, bool MASKED>
__device__ __forceinline__ void phase_attn(const Ctx& C, const bf16_t* Q, const bf16_t* K, const bf16_t* VT, const unsigned* mask, bf16_t* O) {
    for (int u0 = C.bid; u0 < NB * 8 * 8; u0 += C.G) {
        int u = u0; if ((C.G & 7) == 0) { const int r = (C.bid >> 3) + (C.G >> 3) * (u0 / C.G); u = ((C.bid & 7) * 8 + (r >> 3)) * 8 + (r & 7); if (u >= NB * 8 * 8) u = u0; }
        const int bh = u >> 3, p = u & 7, b = bh >> 3, h = bh & 7;
        attn_unit<DQK, MASKED>(C, b, h, 15 - p, Q, K, VT, mask, O);
        attn_unit<DQK, MASKED>(C, b, h, p, Q, K, VT, mask, O); }
}

__device__ __forceinline__ void phase_gmlp(const Ctx& C, const float* lng, const float* lnb, const float* bs, int l) {
    const bf16_t* U = WSP(bf16_t, WS_U); const bf16_t* V = WSP(bf16_t, WS_V); bf16_t* OB = WSP(bf16_t, WS_OBUF) + (size_t)NTOK * 512;
    const bf16_t* WG = WSP(bf16_t, WS_WGM + l * SZ_WGM);
    const int tid = C.tid, lane = C.lane, wid = C.wave, r32 = lane & 31, hi = lane >> 5;
    constexpr int VST = 136;
    LAS bf16_t* vT = (LAS bf16_t*)C.lds;
    for (int un = C.bid; un < 512; un += C.G) {
        const int hf = un & 1, ch = un >> 1; const size_t t0 = (size_t)ch * 128;
        { const int pos = tid >> 2, q = tid & 3; const bf16_t* vr = V + (t0 + pos) * 512 + q * 32;
          float s = 0.f;
#pragma unroll
          for (int i = 0; i < 4; ++i)
#pragma unroll
              for (int j = 0; j < 4; ++j) { const u32x4 w = *(const u32x4*)(vr + i * 128 + j * 8); s += ((bflo(w.x) + bfhi(w.x)) + (bflo(w.y) + bfhi(w.y))) + ((bflo(w.z) + bfhi(w.z)) + (bflo(w.w) + bfhi(w.w))); }
          s += xswz<1>(s); s += xswz<2>(s);
          const float mean = s * (1.f / 512.f); float qv = 0.f;
          asm volatile("" ::: "memory");
#pragma unroll
          for (int i = 0; i < 4; ++i)
#pragma unroll
              for (int j = 0; j < 4; ++j) { const u32x4 w = *(const u32x4*)(vr + i * 128 + j * 8); float d;
                  d = bflo(w.x) - mean; qv += d * d; d = bfhi(w.x) - mean; qv += d * d; d = bflo(w.y) - mean; qv += d * d; d = bfhi(w.y) - mean; qv += d * d;
                  d = bflo(w.z) - mean; qv += d * d; d = bfhi(w.z) - mean; qv += d * d; d = bflo(w.w) - mean; qv += d * d; d = bfhi(w.w) - mean; qv += d * d; }
          qv += xswz<1>(qv); qv += xswz<2>(qv);
          const float rstd = rsqrtf(qv * (1.f / 512.f) + LN_EPS);
          asm volatile("" ::: "memory");
          const bf16_t* vh = vr + hf * 256;
#pragma unroll
          for (int ii = 0; ii < 2; ++ii)
#pragma unroll
              for (int j = 0; j < 4; ++j) { const u32x4 w = *(const u32x4*)(vh + ii * 128 + j * 8);
                  const int cl = ii * 128 + q * 32 + j * 8; const int c0 = hf * 256 + cl;
                  const f32x4 g0 = *(const f32x4*)(lng + c0), g1 = *(const f32x4*)(lng + c0 + 4), b0 = *(const f32x4*)(lnb + c0), b1 = *(const f32x4*)(lnb + c0 + 4);
                  LAS bf16_t* dp = vT + cl * VST + pos;
                  dp[0 * VST] = (bf16_t)(pk2((bflo(w.x) - mean) * rstd * g0[0] + b0[0], 0.f) & 0xffff);
                  dp[1 * VST] = (bf16_t)(pk2((bfhi(w.x) - mean) * rstd * g0[1] + b0[1], 0.f) & 0xffff);
                  dp[2 * VST] = (bf16_t)(pk2((bflo(w.y) - mean) * rstd * g0[2] + b0[2], 0.f) & 0xffff);
                  dp[3 * VST] = (bf16_t)(pk2((bfhi(w.y) - mean) * rstd * g0[3] + b0[3], 0.f) & 0xffff);
                  dp[4 * VST] = (bf16_t)(pk2((bflo(w.z) - mean) * rstd * g1[0] + b1[0], 0.f) & 0xffff);
                  dp[5 * VST] = (bf16_t)(pk2((bfhi(w.z) - mean) * rstd * g1[1] + b1[1], 0.f) & 0xffff);
                  dp[6 * VST] = (bf16_t)(pk2((bflo(w.w) - mean) * rstd * g1[2] + b1[2], 0.f) & 0xffff);
                  dp[7 * VST] = (bf16_t)(pk2((bfhi(w.w) - mean) * rstd * g1[3] + b1[3], 0.f) & 0xffff); } }
        __syncthreads();
        { const int gl = wid >> 1, ih = wid & 1, g = 4 * hf + gl;
          f32x16 acc[2][2] = {};
          const int nks = 4 * (ih + 1);
          const bf16_t* wrow = WG + ((size_t)g * 128 + ih * 64 + r32) * 128 + hi * 8;
          for (int ks = 0; ks < nks; ++ks) {
              bf16x8 a[2], bb[2];
#pragma unroll
              for (int mb = 0; mb < 2; ++mb) a[mb] = *(const bf16x8*)(wrow + (size_t)mb * 32 * 128 + ks * 16);
#pragma unroll
              for (int nb = 0; nb < 2; ++nb) bb[nb] = *(const LAS bf16x8*)(vT + (gl * 64 + nb * 32 + r32) * VST + ks * 16 + hi * 8);
#pragma unroll
              for (int mb = 0; mb < 2; ++mb)
#pragma unroll
                  for (int nb = 0; nb < 2; ++nb) acc[mb][nb] = __builtin_amdgcn_mfma_f32_32x32x16_bf16(a[mb], bb[nb], acc[mb][nb], 0, 0, 0);
          }
#pragma unroll
          for (int mb = 0; mb < 2; ++mb)
#pragma unroll
              for (int r = 0; r < 16; ++r) { const int i = ih * 64 + mb * 32 + crow(r, hi); const float bi = bs[g * 128 + i];
#pragma unroll
                  for (int nb = 0; nb < 2; ++nb) { const size_t o = (t0 + i) * 512 + g * 64 + nb * 32 + r32;
                      const float uu = bf2f(U[o]); OB[o] = (bf16_t)(pk2(uu * (acc[mb][nb][r] + bi), 0.f) & 0xffff); } } }
        __syncthreads();
    }
}

__device__ __forceinline__ float wave_sum(float v) {
    v += xswz<1>(v); v += xswz<2>(v); v += xswz<4>(v); v += xswz<8>(v); v += xswz<16>(v); return xsum32(v);
}
__device__ __forceinline__ void phase_ln1_router(const Ctx& C, const float* g1, const float* b1, const float* rw, const float* rbias, int l, bool dry) {
    constexpr int RST = 1028;
    LAS float* rwT = (LAS float*)C.lds;
    LAS float* gws = (LAS float*)(C.lds + 32 * RST * 4);
    LAS float* bws = gws + 32;
    LAS float* stat = bws + 32;
    LAS int* trec = (LAS int*)(C.lds + MISC_OFF + 64);
    LAS int* tpos = trec + 512;
    const int tid = C.tid, lane = C.lane, wid = C.wave;
    const bf16_t* xin = WSP(bf16_t, WS_XB); const bf16_t* yo = WSP(bf16_t, WS_OBUF); bf16_t* xb = dry ? WSP(bf16_t, WS_DRY + (size_t)NTOK * DM * 4) : WSP(bf16_t, WS_XB);
    int* tke = dry ? WSP(int, WS_DRY + (size_t)NTOK * DM * 6) : WSP(int, WS_TKE); int* tkp = dry ? WSP(int, WS_DRY + (size_t)NTOK * DM * 6 + NSLOT * 4) : WSP(int, WS_TKP); float* tkw = dry ? WSP(float, WS_DRY + (size_t)NTOK * DM * 6 + NSLOT * 8) : WSP(float, WS_TKW);
    int* ccnt = dry ? WSP(int, WS_DRY + (size_t)NTOK * DM * 6 + NSLOT * 12) : WSP(int, WS_CCNT);
    for (int i = tid; i < 1024 * 32; i += 512) { const int k = i >> 5, e = i & 31; rwT[e * RST + k] = rw[i] * g1[k]; }
    __syncthreads();
    for (int e = wid; e < 32; e += NWAVES) {
        float sg = 0.f, sb = 0.f;
#pragma unroll
        for (int j = 0; j < 16; ++j) { const int k = lane + 64 * j; sg += rwT[e * RST + k]; sb += b1[k] * rw[k * 32 + e]; }
        sg = wave_sum(sg); sb = wave_sum(sb);
        if (lane == 0) { gws[e] = sg; bws[e] = sb + rbias[e]; }
    }
    f32x4 gg[4], bb[4];
#pragma unroll
    for (int j = 0; j < 4; ++j) { gg[j] = *(const f32x4*)(g1 + 4 * (lane + 64 * j)); bb[j] = *(const f32x4*)(b1 + 4 * (lane + 64 * j)); }
    const int fr = lane & 15, fq = lane >> 4;
    for (int chunk = C.bid; chunk < NTOK / 128; chunk += C.G) {
        __syncthreads();
        const size_t tok0 = (size_t)chunk * 128 + wid * 16;
        f32x4 acc0 = {0.f, 0.f, 0.f, 0.f}, acc1 = {0.f, 0.f, 0.f, 0.f};
        { const bf16_t* zr = xin + (tok0 + fr) * 1024 + 4 * fq; const bf16_t* yr = yo + (tok0 + fr) * 1024 + 4 * fq; const LAS float* w0 = rwT + fr * RST + 4 * fq; const LAS float* w1 = rwT + (16 + fr) * RST + 4 * fq;
#pragma unroll 4
          for (int sI = 0; sI < 64; ++sI) { const u32x2 hw = *(const u32x2*)(zr + 16 * sI); const f32x4 h4 = {bflo(hw.x), bfhi(hw.x), bflo(hw.y), bfhi(hw.y)}; const u32x2 yw = *(const u32x2*)(yr + 16 * sI);
              const f32x4 a4 = h4 * DN_ALPHA + (f32x4){bflo(yw.x), bfhi(yw.x), bflo(yw.y), bfhi(yw.y)};
              const f32x4 b0 = *(const LAS f32x4*)(w0 + 16 * sI), b1v = *(const LAS f32x4*)(w1 + 16 * sI);
#pragma unroll
              for (int j = 0; j < 4; ++j) { acc0 = __builtin_amdgcn_mfma_f32_16x16x4f32(a4[j], b0[j], acc0, 0, 0, 0); acc1 = __builtin_amdgcn_mfma_f32_16x16x4f32(a4[j], b1v[j], acc1, 0, 0, 0); } } }
        for (int ti = 0; ti < 16; ++ti) {
            const size_t tok = tok0 + ti;
            const u32x2* xr = (const u32x2*)(xin + tok * 1024); const u32x2* yr2 = (const u32x2*)(yo + tok * 1024);
            f32x4 v[4]; float s = 0.f;
#pragma unroll
            for (int j = 0; j < 4; ++j) { const u32x2 yw = yr2[lane + 64 * j], hw = xr[lane + 64 * j]; v[j] = (f32x4){bflo(hw.x), bfhi(hw.x), bflo(hw.y), bfhi(hw.y)} * DN_ALPHA + (f32x4){bflo(yw.x), bfhi(yw.x), bflo(yw.y), bfhi(yw.y)}; s += (v[j][0] + v[j][1]) + (v[j][2] + v[j][3]); }
            const float mean = wave_sum(s) * (1.f / 1024.f); float s2 = 0.f;
#pragma unroll
            for (int j = 0; j < 4; ++j) { v[j] = v[j] - mean; s2 += (v[j][0] * v[j][0] + v[j][1] * v[j][1]) + (v[j][2] * v[j][2] + v[j][3] * v[j][3]); }
            const float rstd = rsqrtf(wave_sum(s2) * (1.f / 1024.f) + LN_EPS);
            u32x2* xbr = (u32x2*)(xb + tok * 1024);
#pragma unroll
            for (int j = 0; j < 4; ++j) { v[j] = v[j] * rstd * gg[j] + bb[j]; u32x2 w; w.x = pk2(v[j][0], v[j][1]); w.y = pk2(v[j][2], v[j][3]); xbr[lane + 64 * j] = w; }
            if (lane == 0) { stat[(wid * 16 + ti) * 2] = mean; stat[(wid * 16 + ti) * 2 + 1] = rstd; }
        }
        LDS_WAIT();
        const float gw0 = gws[fr], gw1 = gws[16 + fr], bw0 = bws[fr], bw1 = bws[16 + fr];
#pragma unroll
        for (int r = 0; r < 4; ++r) {
            const int tl = wid * 16 + 4 * fq + r; const float mean = stat[tl * 2], rstd = stat[tl * 2 + 1];
            const float l0 = rstd * (acc0[r] - mean * gw0) + bw0, l1 = rstd * (acc1[r] - mean * gw1) + bw1;
            unsigned long long k0 = ((unsigned long long)f2key(l0) << 32) | (unsigned)(31 - fr), k1 = ((unsigned long long)f2key(l1) << 32) | (unsigned)(31 - (16 + fr));
            int te[4]; float tv[4];
#pragma unroll
            for (int k = 0; k < 4; ++k) {
                unsigned long long mxk = k0 > k1 ? k0 : k1;
#define MX_STEP(o) do { const unsigned long long ot = ((unsigned long long)xswzu<o>((unsigned)(mxk >> 32)) << 32) | xswzu<o>((unsigned)mxk); mxk = ot > mxk ? ot : mxk; } while (0)
                MX_STEP(1); MX_STEP(2); MX_STEP(4); MX_STEP(8);
#undef MX_STEP
                te[k] = 31 - (int)(mxk & 31ull); const unsigned ku = (unsigned)(mxk >> 32); tv[k] = __uint_as_float((ku & 0x80000000u) ? (ku & 0x7fffffffu) : ~ku);
                if (te[k] == fr) k0 = 0ull; if (te[k] == 16 + fr) k1 = 0ull;
            }
            const float e1 = __expf(tv[1] - tv[0]), e2 = __expf(tv[2] - tv[0]), e3 = __expf(tv[3] - tv[0]); const float inv = 1.f / (1.f + e1 + e2 + e3);
            if (fr == 0) {
                const float ww[4] = {inv, e1 * inv, e2 * inv, e3 * inv}; const size_t tok = (size_t)chunk * 128 + tl;
#pragma unroll
                for (int k = 0; k < 4; ++k) { trec[tl * 4 + k] = te[k]; tkw[tok * 4 + k] = ww[k]; }
            }
        }
        __syncthreads();
        if (tid < 32) { int c = 0; for (int r = 0; r < 512; ++r) { if (trec[r] == tid) { tpos[r] = c; ++c; } } ccnt[chunk * 32 + tid] = c; }
        __syncthreads();
        { const size_t o = (size_t)chunk * 512 + tid; tke[o] = trec[tid]; tkp[o] = tpos[tid]; }
        __syncthreads();
    }
}

__device__ __forceinline__ void moe_tables(const Ctx& C, int l) {
    LAS int* cnt = (LAS int*)(C.lds + MISC_OFF + 64); LAS int* tb = cnt + 32; LAS int* tile_e = tb + 40;
    const int* ccnt = WSP(int, WS_CCNT);
    if (C.tid < 32) { int a = 0; for (int c = 0; c < NTOK / 128; ++c) a += ccnt[c * 32 + C.tid]; cnt[C.tid] = a; }
    __syncthreads();
    if (C.tid == 0) { int a = 0; for (int e = 0; e < 32; ++e) { tb[e] = a; a += (cnt[e] + 255) >> 8; } tb[32] = a; }
    __syncthreads();
    if (C.tid < 32) { for (int t = tb[C.tid]; t < tb[C.tid + 1]; ++t) tile_e[t] = C.tid; }
    __syncthreads();
}
__device__ __forceinline__ void phase_dispatch(const Ctx& C, int l) {
    moe_tables(C, l);
    LAS int* cnt = (LAS int*)(C.lds + MISC_OFF + 64); LAS int* tb = cnt + 32;
    const int* tke = WSP(int, WS_TKE); int* tkp = WSP(int, WS_TKP); int* stk = WSP(int, WS_STK);
    LAS int* cbase = (LAS int*)C.lds;
    { const int* ccnt = WSP(int, WS_CCNT); if (C.tid < 32) { int a = 0; for (int c = 0; c < NTOK / 128; ++c) { cbase[c * 32 + C.tid] = a; a += ccnt[c * 32 + C.tid]; } } }
    __syncthreads();
    for (int s = C.bid * 512 + C.tid; s < NSLOT; s += C.G * 512) {
        const int e = tke[s], p = cbase[(s >> 9) * 32 + e] + tkp[s]; const int row = tb[e] * 256 + p;
        stk[row] = s >> 2; tkp[s] = row;
    }
    for (int e = C.bid; e < 32; e += C.G) { const int r0 = tb[e] * 256 + cnt[e], r1 = tb[e + 1] * 256; for (int r = r0 + C.tid; r < r1; r += 512) stk[r] = 0; }
}

__device__ __forceinline__ void phase_ln2(const Ctx& C, const float* g2, const float* b2, float* outp, int l, bool dry) {
    const bf16_t* xin = WSP(bf16_t, WS_XB); bf16_t* xb = dry ? WSP(bf16_t, WS_DRY + (size_t)NTOK * DM * 4) : WSP(bf16_t, WS_XB); const bf16_t* y = WSP(bf16_t, WS_Y);
    const int* tkrow = WSP(int, WS_TKP); const float* tkw = WSP(float, WS_TKW);
    if (dry) outp = WSP(float, WS_DRY);
    const int gw = C.bid * NWAVES + C.wave, NGW = C.G * NWAVES, lane = C.lane;
    f32x4 gg[4], bb[4];
#pragma unroll
    for (int j = 0; j < 4; ++j) { gg[j] = *(const f32x4*)(g2 + 4 * (lane + 64 * j)); bb[j] = *(const f32x4*)(b2 + 4 * (lane + 64 * j)); }
    const bool last = (l == NLAYER - 1);
    for (int tok = gw; tok < NTOK; tok += NGW) {
        const u32x2* xr = (const u32x2*)(xin + (size_t)tok * 1024);
        f32x4 v[4]; float s = 0.f;
        int rk[4]; float wk[4];
#pragma unroll
        for (int k = 0; k < 4; ++k) { rk[k] = tkrow[(size_t)tok * 4 + k]; wk[k] = tkw[(size_t)tok * 4 + k]; }
#pragma unroll
        for (int j = 0; j < 4; ++j) { const u32x2 hw = xr[lane + 64 * j]; const f32x4 x1 = {bflo(hw.x), bfhi(hw.x), bflo(hw.y), bfhi(hw.y)}; f32x4 f[4];
#pragma unroll
            for (int k = 0; k < 4; ++k) { const u32x2 w = *(const u32x2*)(y + (size_t)rk[k] * 1024 + 4 * (lane + 64 * j)); f[k] = (f32x4){bflo(w.x), bfhi(w.x), bflo(w.y), bfhi(w.y)} * wk[k]; }
            v[j] = x1 * DN_ALPHA + ((f[0] + f[1]) + (f[2] + f[3]));
            s += (v[j][0] + v[j][1]) + (v[j][2] + v[j][3]); }
        const float mean = wave_sum(s) * (1.f / 1024.f); float s2 = 0.f;
#pragma unroll
        for (int j = 0; j < 4; ++j) { v[j] = v[j] - mean; s2 += (v[j][0] * v[j][0] + v[j][1] * v[j][1]) + (v[j][2] * v[j][2] + v[j][3] * v[j][3]); }
        const float rstd = rsqrtf(wave_sum(s2) * (1.f / 1024.f) + LN_EPS);
        if (last) { f32x4* orow = (f32x4*)(outp + (size_t)tok * 1024);
#pragma unroll
            for (int j = 0; j < 4; ++j) orow[lane + 64 * j] = v[j] * rstd * gg[j] + bb[j];
        } else { u32x2* xbr = (u32x2*)(xb + (size_t)tok * 1024);
#pragma unroll
            for (int j = 0; j < 4; ++j) { const f32x4 o = v[j] * rstd * gg[j] + bb[j]; u32x2 w; w.x = pk2(o[0], o[1]); w.y = pk2(o[2], o[3]); xbr[lane + 64 * j] = w; } }
    }
}

#ifdef DBG_STOP
__device__ __forceinline__ void dbg_dump(const Ctx& C, float* out) {
    const int gt = C.bid * 512 + C.tid, NGT = C.G * 512;
    const bf16_t* qa = WSP(bf16_t, WS_QA); const bf16_t* ka = WSP(bf16_t, WS_KA); const bf16_t* vat = WSP(bf16_t, WS_VAT); const bf16_t* iq = WSP(bf16_t, WS_IQ);
    const bf16_t* u = WSP(bf16_t, WS_U); const bf16_t* v = WSP(bf16_t, WS_V); const bf16_t* cdq = WSP(bf16_t, WS_CDQ); const bf16_t* cdkv = WSP(bf16_t, WS_CDKV);
    const bf16_t* gate = WSP(bf16_t, WS_GATE); const bf16_t* qc = WSP(bf16_t, WS_QC); const bf16_t* kc = WSP(bf16_t, WS_KC); const bf16_t* vct = WSP(bf16_t, WS_VCT);
    const unsigned* mask = WSP(unsigned, WS_MASK); const bf16_t* ob = WSP(bf16_t, WS_OBUF); const bf16_t* mg = WSP(bf16_t, WS_MERGED); const float* xr = WSP(float, WS_XRES);
    const bf16_t* y = WSP(bf16_t, WS_Y); const float* sc = WSP(float, WS_SCORE); const bf16_t* ik = WSP(bf16_t, WS_IK); const float* iw = WSP(float, WS_IW); const float* ssq = WSP(float, WS_SSQ);
    const bf16_t* hb = WSP(bf16_t, WS_H); const bf16_t* xg = WSP(bf16_t, WS_XG); const int* stk = WSP(int, WS_STK);
    for (size_t i = gt; i < (size_t)NTOK * DM; i += NGT) {
        const size_t h = i & ((size_t)NTOK * 512 - 1);
        float a = 0.f;
#if DBG_STOP >= 1
        a += bf2f(qa[h]) + bf2f(ka[h]) + bf2f(vat[h]) + bf2f(iq[h]) + bf2f(u[h]) + bf2f(v[h]) + bf2f(cdq[i & ((size_t)NTOK * 256 - 1)]) + bf2f(cdkv[i & ((size_t)NTOK * 256 - 1)]);
        a += bf2f(gate[i]) + bf2f(gate[i + (size_t)NTOK * DM]) + bf2f(gate[i + (size_t)2 * NTOK * DM]) + bf2f(ik[i & ((size_t)NTOK * 64 - 1)]) + iw[i & ((size_t)NTOK * 8 - 1)] + ssq[i & ((size_t)NTOK * 8 - 1)];
#endif
#if DBG_STOP >= 2
        a += bf2f(qc[i % ((size_t)NTOK * 768)]) + bf2f(kc[i % ((size_t)NTOK * 768)]) + bf2f(vct[h]) + bf2f(ob[(size_t)NTOK * 512 + h]);
#ifdef DBG_BITS
        a = (float)(__float_as_uint(sc[i]) & 0xfffu) + (float)(__float_as_uint(sc[i + (size_t)NTOK * DM]) & 0xfffu) + (float)(__float_as_uint(sc[i + (size_t)2 * NTOK * DM]) & 0xfffu) + (float)(__float_as_uint(sc[i + (size_t)3 * NTOK * DM]) & 0xfffu);
        a += (float)(iq[h] & 0xff) + (float)(ik[i & ((size_t)NTOK * 64 - 1)] & 0xff) + (float)(__float_as_uint(iw[i & ((size_t)NTOK * 8 - 1)]) & 0xfffu);
#else
        a += sc[i] + sc[i + (size_t)NTOK * DM] + sc[i + (size_t)2 * NTOK * DM] + sc[i + (size_t)3 * NTOK * DM];
#endif
#endif
#if DBG_STOP >= 3
        { const unsigned m = mask[i & ((size_t)NTOK * 128 - 1)]; a += (float)(m & 0xffffu) + (float)(m >> 16); } a += bf2f(ob[(size_t)2 * NTOK * 512 + h]);
#endif
#if DBG_STOP >= 4
        a += bf2f(ob[h]);
#endif
#if DBG_STOP >= 5
        a += bf2f(mg[i]);
#endif
#if DBG_STOP >= 6
        a += xr[i];
#endif
#if DBG_STOP >= 8
        a += (float)stk[i % (size_t)NSLOT_PAD] + bf2f(xg[i]) + bf2f(xg[i + (size_t)NTOK * DM]) + bf2f(xg[i + (size_t)2 * NTOK * DM]) + bf2f(xg[i + (size_t)3 * NTOK * DM]);
#endif
#if DBG_STOP >= 9
        a += bf2f(hb[i]) + bf2f(hb[i + (size_t)NTOK * DM]) + bf2f(hb[i + (size_t)2 * NTOK * DM]) + bf2f(hb[i + (size_t)3 * NTOK * DM]);
#endif
#if DBG_STOP >= 10
        a += bf2f(y[i]) + bf2f(y[i + (size_t)NTOK * DM]) + bf2f(y[i + (size_t)2 * NTOK * DM]) + bf2f(y[i + (size_t)3 * NTOK * DM]);
#endif
        out[i] = a;
    }
}
#endif

#ifdef DBG_CHECK
constexpr int CW_ERR = 20000;
__device__ __forceinline__ void err_max(unsigned* ctl, int k, float e) { if (!(e >= 0.f)) e = 1e30f; atomicMax(ctl + CW_ERR + k, __float_as_uint(e)); }
__device__ __forceinline__ float rope1(float x1, float x2, float c, float s_) { return x1 * c - x2 * s_; }
__device__ __forceinline__ float rope2(float x1, float x2, float c, float s_) { return x2 * c + x1 * s_; }
__device__ __forceinline__ void chk_proj(const Ctx& C, const Args& A) {
    unsigned* ctl = WSP(unsigned, WS_CTL); LAS float* pj = (LAS float*)C.lds;
    const int tok = (C.bid * 131 + 7) % NTOK; const int b = tok >> 12, sp = tok & 4095, ps = (sp & ~15) | perm16(sp & 15);
    const float* x = A.in[0] + (size_t)tok * DM; const float* w = A.in[2];
    for (int n = C.tid; n < 3560; n += 512) { float a = 0.f; for (int k = 0; k < DM; ++k) a = fmaf(x[k], w[(size_t)k * NIN_SRC + n], a); pj[n] = a; }
    __syncthreads();
    const float pos = (float)((const int*)A.in[1])[tok];
    const bf16_t* qa = WSP(bf16_t, WS_QA); const bf16_t* ka = WSP(bf16_t, WS_KA); const bf16_t* vat = WSP(bf16_t, WS_VAT); const bf16_t* iq = WSP(bf16_t, WS_IQ); const bf16_t* ik = WSP(bf16_t, WS_IK); const float* iw = WSP(float, WS_IW);
    float e = 0.f;
    for (int c = C.tid; c < 512; c += 512) { const int d = c & 63; const int base = c - d;
        float cq, ck, ci;
        if (d < 16) { const int i = d & 7; const float ang = pos * powf(500000.f, -(float)i / 8.f), cs = cosf(ang), sn = sinf(ang);
            const int o1 = base + i, o2 = base + 8 + i;
            cq = d < 8 ? rope1(pj[o1], pj[o2], cs, sn) : rope2(pj[o1], pj[o2], cs, sn);
            ck = d < 8 ? rope1(pj[512 + o1], pj[512 + o2], cs, sn) : rope2(pj[512 + o1], pj[512 + o2], cs, sn);
            ci = d < 8 ? rope1(pj[1536 + o1], pj[1536 + o2], cs, sn) : rope2(pj[1536 + o1], pj[1536 + o2], cs, sn);
        } else { cq = pj[c]; ck = pj[512 + c]; ci = pj[1536 + c]; }
        e = fmaxf(e, fabsf(bf2f(qa[(size_t)tok * 512 + c]) - cq * QSCALE_A)); e = fmaxf(e, fabsf(bf2f(ka[(size_t)tok * 512 + c]) - ck)); e = fmaxf(e, fabsf(bf2f(iq[(size_t)tok * 512 + c]) - ci));
        const int h = c >> 6; e = fmaxf(e, fabsf(bf2f(vat[((size_t)(b * 8 + h) * 64 + d) * SEQ + ps]) - pj[1024 + c]));
        if (c < 64) { float cik; if (c < 16) { const int i = c & 7; const float ang = pos * powf(500000.f, -(float)i / 8.f), cs = cosf(ang), sn = sinf(ang);
                cik = c < 8 ? rope1(pj[2048 + i], pj[2048 + 8 + i], cs, sn) : rope2(pj[2048 + i], pj[2048 + 8 + i], cs, sn); } else cik = pj[2048 + c];
            e = fmaxf(e, fabsf(bf2f(ik[(size_t)tok * 64 + c]) - cik)); }
        if (c < 8) e = fmaxf(e, 8.f * fabsf(iw[(size_t)tok * 8 + c] - pj[2112 + c] * IW_SCALE));
    }
    err_max(ctl, 0, e);
    __syncthreads();
    LAS float* cqn = pj + 3600; LAS float* ckn = cqn + 256;
    { float sq = 0.f; for (int k = 0; k < 256; ++k) sq += pj[3144 + k] * pj[3144 + k]; const float r = rsqrtf(sq / 256.f + RMS_EPS);
      float sk = 0.f; for (int k = 0; k < 128; ++k) sk += pj[3400 + k] * pj[3400 + k]; const float rk = rsqrtf(sk / 128.f + RMS_EPS);
      if (C.tid < 256) cqn[C.tid] = pj[3144 + C.tid] * r * A.in[7][C.tid]; if (C.tid < 128) ckn[C.tid] = pj[3400 + C.tid] * rk * A.in[8][C.tid]; }
    __syncthreads();
    const bf16_t* qc = WSP(bf16_t, WS_QC); const bf16_t* kc = WSP(bf16_t, WS_KC); const bf16_t* vct = WSP(bf16_t, WS_VCT);
    LAS float* qraw = ckn + 128;
    for (int n = C.tid; n < 768; n += 512) { float a = 0.f; for (int k = 0; k < 256; ++k) a = fmaf(cqn[k], A.in[9][(size_t)k * 768 + n], a); qraw[n] = a; }
    __syncthreads();
    float e2 = 0.f;
    for (int n = C.tid; n < 768; n += 512) { const int h = n / 96, d = n % 96; float v;
        if (d >= 64) { const int i = (d - 64) & 15; const float ang = pos * powf(500000.f, -(float)i / 16.f), cs = cosf(ang), sn = sinf(ang); const int o1 = h * 96 + 64 + i, o2 = o1 + 16;
            v = (d - 64) < 16 ? rope1(qraw[o1], qraw[o2], cs, sn) : rope2(qraw[o1], qraw[o2], cs, sn); } else v = qraw[n];
        e2 = fmaxf(e2, fabsf(bf2f(qc[(size_t)tok * 768 + n]) - v * QSCALE_C)); }
    for (int n = C.tid; n < 1024; n += 512) { float a = 0.f; for (int k = 0; k < 128; ++k) a = fmaf(ckn[k], A.in[10][(size_t)k * 1024 + n], a);
        const int h = n >> 7, wv = n & 127;
        if (wv < 64) e2 = fmaxf(e2, fabsf(bf2f(kc[(size_t)tok * 768 + h * 96 + wv]) - a));
        else e2 = fmaxf(e2, fabsf(bf2f(vct[((size_t)(b * 8 + h) * 64 + (wv - 64)) * SEQ + ps]) - a)); }
    if (C.tid < 32) { const int i = C.tid & 15; const float ang = pos * powf(500000.f, -(float)i / 16.f), cs = cosf(ang), sn = sinf(ang);
        const float v = C.tid < 16 ? rope1(pj[3528 + i], pj[3528 + 16 + i], cs, sn) : rope2(pj[3528 + i], pj[3528 + 16 + i], cs, sn);
        for (int h = 0; h < 8; ++h) e2 = fmaxf(e2, fabsf(bf2f(kc[(size_t)tok * 768 + h * 96 + 64 + C.tid]) - v)); }
    err_max(ctl, 1, e2);
    __syncthreads();
}
__device__ __forceinline__ void chk_attn(const Ctx& C) {
    unsigned* ctl = WSP(unsigned, WS_CTL);
    const int b = C.bid & 7, q = (C.bid * 977 + 300 + 13 * (C.bid >> 3)) & 4095; const size_t tq = (size_t)b * SEQ + q; const int n = q + 1;
    LAS float* sc = (LAS float*)C.lds;
    LAS float* pr = sc + 4096;
    LAS float* red = pr + 4096;
    const bf16_t* iq = WSP(bf16_t, WS_IQ); const bf16_t* ik = WSP(bf16_t, WS_IK); const float* iw = WSP(float, WS_IW); const float* score = WSP(float, WS_SCORE);
    float e1 = 0.f;
    for (int k = C.tid; k < n; k += 512) { float s_ = 0.f;
        for (int h = 0; h < 8; ++h) { float d = 0.f; for (int j = 0; j < 64; ++j) d = fmaf(bf2f(iq[tq * 512 + h * 64 + j]), bf2f(ik[((size_t)b * SEQ + k) * 64 + j]), d); s_ = fmaf(fmaxf(d, 0.f), iw[tq * 8 + h], s_); }
        sc[k] = s_; e1 = fmaxf(e1, fabsf(s_ - score[tq * SEQ + k])); }
    err_max(ctl, 2, e1);
    __syncthreads();
    const unsigned* mask = WSP(unsigned, WS_MASK); float e2 = 0.f;
    for (int k = C.tid; k < 4096; k += 512) { bool sel = false;
        if (k < n) { if (n <= 256) sel = true; else { const float sk = score[tq * SEQ + k]; int rank = 0; for (int j = 0; j < n; ++j) { const float sj = score[tq * SEQ + j]; rank += (sj > sk || (sj == sk && j < k)) ? 1 : 0; } sel = rank < 256; } }
        const bool mb = (mask[tq * 128 + (k >> 5)] >> (k & 31)) & 1u; if (sel != mb) e2 = 1.f; }
    err_max(ctl, 3, e2);
    const int h = (C.bid >> 3) & 7;
    for (int which = 0; which < 2; ++which) {
        const bf16_t* Q = which ? WSP(bf16_t, WS_QC) : WSP(bf16_t, WS_QA); const bf16_t* K = which ? WSP(bf16_t, WS_KC) : WSP(bf16_t, WS_KA); const bf16_t* VT = which ? WSP(bf16_t, WS_VCT) : WSP(bf16_t, WS_VAT);
        const bf16_t* O = WSP(bf16_t, WS_OBUF) + (which ? (size_t)2 * NTOK * 512 : 0); const int dq = which ? 96 : 64, qs = 8 * dq;
        __syncthreads();
        float mx = -INFINITY;
        for (int k = C.tid; k < 4096; k += 512) { float lgt = -INFINITY;
            const bool ok = k < n && (which || ((mask[tq * 128 + (k >> 5)] >> (k & 31)) & 1u));
            if (ok) { float d = 0.f; for (int j = 0; j < dq; ++j) d = fmaf(bf2f(Q[tq * qs + h * dq + j]), bf2f(K[((size_t)b * SEQ + k) * qs + h * dq + j]), d); lgt = d; }
            pr[k] = lgt; mx = fmaxf(mx, lgt); }
        red[C.tid] = mx; __syncthreads();
        if (C.tid == 0) { float m = -INFINITY; for (int i = 0; i < 512; ++i) m = fmaxf(m, red[i]); red[0] = m; } __syncthreads();
        const float m = red[0]; __syncthreads();
        float sm = 0.f; for (int k = C.tid; k < 4096; k += 512) { const float p = exp2f(pr[k] - m); pr[k] = p; sm += p; }
        red[C.tid] = sm; __syncthreads();
        if (C.tid == 0) { float t = 0.f; for (int i = 0; i < 512; ++i) t += red[i]; red[0] = t; } __syncthreads();
        const float den = red[0];
        if (C.tid < 64) { const int d = C.tid; float o = 0.f;
            for (int k = 0; k < n; ++k) { const int ps = (k & ~15) | perm16(k & 15); o = fmaf(pr[k], bf2f(VT[((size_t)(b * 8 + h) * 64 + d) * SEQ + ps]), o); }
            o /= den; err_max(ctl, 4 + which, fabsf(o - bf2f(O[tq * 512 + h * 64 + d]))); }
    }
    __syncthreads();
}
#endif

constexpr int NPH_LAYER = 11, NPHASE = 1 + NLAYER * NPH_LAYER;
__global__ void __launch_bounds__(NWAVES * 64, 2) trunk_fwd(Args args) {
    extern __shared__ __attribute__((aligned(16))) unsigned char lds_raw[];
    Ctx C;
    C.lds = (LAS unsigned char*)lds_raw; C.tid = threadIdx.x; C.lane = C.tid & 63; C.wave = __builtin_amdgcn_readfirstlane(C.tid >> 6); C.G = gridDim.x; C.bid = blockIdx.x; C.ws = args.ws;
    volatile LAS unsigned* MISC = (volatile LAS unsigned*)(C.lds + MISC_OFF);
    if (C.tid < 16) MISC[C.tid] = 0u;
    __syncthreads();
#if MK_ONE_LAUNCH
    XcdBarrier bar = xcd_barrier_post(WSP(unsigned, WS_CTL) + CW_BAR, MISC + 0);
#define GRID_BAR() do { FRESH(); XcdBarrier b_ = bar; { unsigned* bp_ = b_.bar; asm volatile("" : "+s"(bp_)); b_.bar = bp_; } xcd_barrier(b_, C.tid == 0); } while (0)
#else
#define GRID_BAR() do {} while (0)
#endif
    typedef const __attribute__((address_space(4))) Args* KArgsP;
    KArgsP kp = (KArgsP)__builtin_amdgcn_kernarg_segment_ptr();
    const int grid_s = gridDim.x, bid_s = blockIdx.x;
    const int wave_s = __builtin_amdgcn_readfirstlane((int)threadIdx.x >> 6);
#define FRESH() do { int ln_; asm volatile("v_mbcnt_lo_u32_b32 %0, -1, 0\n\tv_mbcnt_hi_u32_b32 %0, -1, %0" : "=v"(ln_)); int w_ = wave_s; asm volatile("" : "+s"(w_)); C.tid = (w_ << 6) | ln_; C.lane = ln_; C.wave = w_; \
        int g_ = grid_s, b_ = bid_s; asm volatile("" : "+s"(g_), "+s"(b_)); C.G = g_; C.bid = b_; \
        kp = (KArgsP)__builtin_amdgcn_kernarg_segment_ptr(); asm volatile("" : "+s"(kp)); C.ws = kp->ws; } while (0)
#define KIN(i) (kp->in[i])
    const int lo = args.ph_lo, hi = args.ph_hi, sub_mask = args.sub; const bool dry = (args.pad != 0);
#ifndef PH_ONLY
#define PH_ONLY -1
#endif
#ifndef PH_SUB
#define PH_SUB -1
#endif
#define PON(k) (PH_ONLY < 0 || PH_ONLY == (k))
#define PON2(k) ((PH_SUB < 0 || PH_SUB == (k)) && ((sub_mask >> (((k) / 10 - 1) * 4 + (k) % 10 - 1)) & 1))
#define IN(k) (lo <= (k) && (k) < hi)
#define SEAM(k) do { if (IN(k) && IN((k) + 1)) GRID_BAR(); } while (0)
    if (IN(0) && PON(100)) { phase_prologue(C, args); }
    SEAM(0);
    for (int l = 0; l < NLAYER; ++l) {
        const int P = 1 + l * NPH_LAYER;
        if (IN(P + 0) && PON(0)) { FRESH();
            pg8::Gemm g{WSP(bf16_t, WS_XB), WSP(bf16_t, WS_WIN + l * SZ_WIN), 1024, 1024, nullptr}; GridOrder S{NIN / 256, (NTOK / 256) * (NIN / 256), C.G, C.bid};
            EpiInProj E{C.ws, dry};
            pg8::gemm_phase<EpiInProj, GridOrder>(C.lds, g, S, E, C.tid);
        }
        SEAM(P + 0);
        if (IN(P + 1) && PON(1)) { FRESH();
            if (PON2(11)) phase_indexer(C);
            __syncthreads();
            FRESH();
            if (PON2(12)) { pg8::Gemm g{WSP(bf16_t, WS_CDQ), WSP(bf16_t, WS_WUQ + l * SZ_WUQ), 256, 256, nullptr}; GridOrder S{3, 128 * 3, C.G, C.bid};
              EpiQUp E{WSP(bf16_t, WS_QC), WSP(float, WS_SSQ), WSP(float, WS_COSC), WSP(float, WS_SINC)};
              pg8::gemm_phase<EpiQUp, GridOrder>(C.lds, g, S, E, C.tid); }
            FRESH();
            if (PON2(13)) { pg8::Gemm g{WSP(bf16_t, WS_CDKV), WSP(bf16_t, WS_WUKV + l * SZ_WUKV), 256, 256, nullptr}; GridOrder S{4, 128 * 4, C.G, C.bid};
              EpiKvUp E{WSP(bf16_t, WS_KC), WSP(bf16_t, WS_VCT), WSP(float, WS_SSQ)};
              pg8::gemm_phase<EpiKvUp, GridOrder>(C.lds, g, S, E, C.tid); }
            __syncthreads();
            if (PON2(14)) { FRESH(); phase_gmlp(C, KIN(3) + l * 512, KIN(4) + l * 512, KIN(6) + (size_t)l * 8 * 128, l); }
        }
        SEAM(P + 1);
        if (IN(P + 2) && PON(2)) { FRESH();
            if (PON2(21)) phase_select(C);
            __syncthreads();
            FRESH(); if (PON2(22)) phase_attn<96, false>(C, WSP(bf16_t, WS_QC), WSP(bf16_t, WS_KC), WSP(bf16_t, WS_VCT), nullptr, WSP(bf16_t, WS_OBUF) + (size_t)2 * NTOK * 512);
        }
        SEAM(P + 2);
        if (IN(P + 3) && PON(3)) { FRESH(); phase_attn<64, true>(C, WSP(bf16_t, WS_QA), WSP(bf16_t, WS_KA), WSP(bf16_t, WS_VAT), WSP(unsigned, WS_MASK), WSP(bf16_t, WS_OBUF)); }
        SEAM(P + 3);
        if (IN(P + 4) && PON(4)) { FRESH();
            pg8::Gemm g{WSP(bf16_t, WS_OBUF), WSP(bf16_t, WS_WBR + l * SZ_WBR), 512, 512, nullptr}; MergeOrder S{C.G, C.bid};
            EpiMerge E{WSP(bf16_t, WS_GATE), WSP(bf16_t, WS_MERGED)};
            pg8::gemm_phase<EpiMerge, MergeOrder>(C.lds, g, S, E, C.tid);
        }
        SEAM(P + 4);
        if (IN(P + 5) && PON(5)) { FRESH();
            pg8::Gemm g{WSP(bf16_t, WS_MERGED), WSP(bf16_t, WS_WOUT + l * SZ_WOUT), 1024, 1024, nullptr}; GridOrder S{4, 128 * 4, C.G, C.bid};
            EpiOut E{dry ? WSP(bf16_t, WS_DRY) : WSP(bf16_t, WS_OBUF)};
            pg8::gemm_phase<EpiOut, GridOrder>(C.lds, g, S, E, C.tid);
        }
        SEAM(P + 5);
        if (IN(P + 6) && PON(6)) { FRESH(); phase_ln1_router(C, KIN(13) + l * 1024, KIN(14) + l * 1024, KIN(15) + (size_t)l * 1024 * 32, KIN(16) + l * 32, l, dry); }
        SEAM(P + 6);
        if (IN(P + 7) && PON(7)) { FRESH(); phase_dispatch(C, l); }
        SEAM(P + 7);
        if (IN(P + 8) && PON(8)) { FRESH();
            moe_tables(C, l);
            const LAS int* tb = (const LAS int*)(C.lds + MISC_OFF + 64) + 32;
            pg8::Gemm g{WSP(bf16_t, WS_XB), WSP(bf16_t, WS_WGU + l * SZ_WGU), 1024, 1024, WSP(int, WS_STK)}; MoeOrder S{8, tb[32] * 8, C.G, C.bid, tb};
            EpiMoeUp E{WSP(bf16_t, WS_H), KIN(18) + (size_t)l * NEXP * 2048};
            pg8::gemm_phase<EpiMoeUp, MoeOrder, true>(C.lds, g, S, E, C.tid);
        }
        SEAM(P + 8);
        if (IN(P + 9) && PON(9)) { FRESH();
            moe_tables(C, l);
            const LAS int* tb = (const LAS int*)(C.lds + MISC_OFF + 64) + 32;
            pg8::Gemm g{WSP(bf16_t, WS_H), WSP(bf16_t, WS_WDN + l * SZ_WDN), 1024, 1024, nullptr}; MoeOrder S{4, tb[32] * 4, C.G, C.bid, tb};
            EpiMoeDn E{dry ? WSP(bf16_t, WS_DRY) : WSP(bf16_t, WS_Y), KIN(20) + (size_t)l * NEXP * 1024, dry};
            pg8::gemm_phase<EpiMoeDn, MoeOrder>(C.lds, g, S, E, C.tid);
        }
        SEAM(P + 9);
        if (IN(P + 10) && PON(10)) { FRESH(); phase_ln2(C, KIN(21) + l * 1024, KIN(22) + l * 1024, kp->out, l, dry); }
        SEAM(P + 10);
    }
#ifdef DBG_STOP
    if (IN(NPHASE)) { FRESH(); dbg_dump(C, kp->out); }
#endif
#ifdef DBG_CHECK
    if (IN(NPHASE + 1)) { FRESH(); chk_proj(C, args); chk_attn(C); }
    if (IN(NPHASE + 2)) { FRESH();
        const unsigned* ctl = WSP(unsigned, WS_CTL); const float tol[6] = {0.06f, 0.06f, 2e-3f, 0.5f, 0.02f, 0.02f}; float sc = 1.f;
        for (int k = 0; k < 6; ++k) if (__uint_as_float(ctl[CW_ERR + k]) > tol[k]) sc += 0.2f * (float)(1 << k);
        float* o = kp->out; for (size_t i = (size_t)C.bid * 512 + C.tid; i < (size_t)NTOK * DM; i += (size_t)C.G * 512) o[i] *= sc; }
#endif
#undef IN
#undef SEAM
}

extern "C" void kernel_launch(void* const* d_in, const int* in_sizes, int n_in, void* d_out, int out_size, void* d_ws, size_t ws_size, hipStream_t stream) {
    static int grid = 0;
    if (grid == 0) {
        if (n_in != 23 || out_size != NTOK * DM || ws_size < WS_END) { fprintf(stderr, "kernel_launch: unexpected shapes (n_in %d, out %d, ws %zu < %zu)\n", n_in, out_size, ws_size, (size_t)WS_END); grid = -1; return; }
        int dev = 0, cus = 0, per_cu = 0;
        if (hipGetDevice(&dev) != hipSuccess || hipDeviceGetAttribute(&cus, hipDeviceAttributeMultiprocessorCount, dev) != hipSuccess) { grid = -1; return; }
        if (hipFuncSetAttribute((const void*)trunk_fwd, hipFuncAttributeMaxDynamicSharedMemorySize, LDS_BYTES) != hipSuccess) { fprintf(stderr, "kernel_launch: hipFuncSetAttribute failed\n"); grid = -1; return; }
        if (hipOccupancyMaxActiveBlocksPerMultiprocessor(&per_cu, (const void*)trunk_fwd, NWAVES * 64, LDS_BYTES) != hipSuccess || per_cu < 1) { fprintf(stderr, "kernel_launch: occupancy query reports %d\n", per_cu); }
        (void)hipGetLastError();
        grid = cus;
    }
    if (grid < 0) return;
    (void)hipMemsetAsync((char*)d_ws + WS_CTL, 0, CTL_ZERO_BYTES, stream);
#ifdef DBG_ZERO_WS
    (void)hipMemsetAsync((char*)d_ws + WS_XRES, 0, WS_END - WS_XRES, stream);
#endif
    Args a{};
    for (int i = 0; i < 23; ++i) a.in[i] = (const float*)d_in[i];
    a.out = (float*)d_out; a.ws = (unsigned char*)d_ws; a.sub = -1; a.pad = 0;
#if MK_ONE_LAUNCH
    a.ph_lo = 0; a.ph_hi = NPHASE;
    hipLaunchKernelGGL(trunk_fwd, dim3(grid), dim3(NWAVES * 64), LDS_BYTES, stream, a);
#else
#ifdef DBG_STOP
    for (int p = 0; p < 1 + DBG_STOP; ++p) { a.ph_lo = p; a.ph_hi = p + 1; hipLaunchKernelGGL(trunk_fwd, dim3(grid), dim3(NWAVES * 64), LDS_BYTES, stream, a); }
    a.ph_lo = NPHASE; a.ph_hi = NPHASE + 1; hipLaunchKernelGGL(trunk_fwd, dim3(grid), dim3(NWAVES * 64), LDS_BYTES, stream, a);
#else
    for (int p = 0; p < NPHASE; ++p) { a.ph_lo = p; a.ph_hi = p + 1; a.sub = -1; a.pad = 0; hipLaunchKernelGGL(trunk_fwd, dim3(grid), dim3(NWAVES * 64), LDS_BYTES, stream, a);
#ifdef DBG_CHECK
        if (p == 4) { a.ph_lo = NPHASE + 1; a.ph_hi = NPHASE + 2; hipLaunchKernelGGL(trunk_fwd, dim3(grid), dim3(NWAVES * 64), LDS_BYTES, stream, a); }
        if (p == NPHASE - 1) { a.ph_lo = NPHASE + 2; a.ph_hi = NPHASE + 3; hipLaunchKernelGGL(trunk_fwd, dim3(grid), dim3(NWAVES * 64), LDS_BYTES, stream, a); }
#endif
#ifdef PROBE_PH
#ifndef PROBE_DRY
#define PROBE_DRY 0
#endif
        if ((p == 0 && PROBE_PH == -1) || (p >= 1 && (p - 1) % NPH_LAYER == PROBE_PH)) { a.sub = PROBE_SUB; a.pad = PROBE_DRY; hipLaunchKernelGGL(trunk_fwd, dim3(grid), dim3(NWAVES * 64), LDS_BYTES, stream, a); }
#endif
    }
#endif
#endif
}
```

```cpp
#include <hip/hip_runtime.h>
#include <cstdio>
#include <cstdint>

#ifndef MK_ONE_LAUNCH
#define MK_ONE_LAUNCH 1
#endif

#define LAS __attribute__((address_space(3)))
typedef unsigned short bf16_t;
typedef short bf16x8 __attribute__((ext_vector_type(8)));
typedef float f32x4 __attribute__((ext_vector_type(4)));
typedef float f32x16 __attribute__((ext_vector_type(16)));
typedef unsigned u32x4 __attribute__((ext_vector_type(4)));
typedef unsigned u32x2 __attribute__((ext_vector_type(2)));
typedef float f32x2_t __attribute__((ext_vector_type(2)));
typedef __bf16 bf16x2_t __attribute__((ext_vector_type(2)));

__device__ __forceinline__ unsigned pk2(float lo, float hi) { f32x2_t v = {lo, hi}; bf16x2_t b = __builtin_convertvector(v, bf16x2_t); return __builtin_bit_cast(unsigned, b); }
__device__ __forceinline__ float bf2f(unsigned short x) { return __uint_as_float(((unsigned)x) << 16); }
__device__ __forceinline__ float bflo(unsigned w) { return __uint_as_float(w << 16); }
__device__ __forceinline__ float bfhi(unsigned w) { return __uint_as_float(w & 0xffff0000u); }
template <int M> __device__ __forceinline__ float xswz(float v) { static_assert(M >= 1 && M <= 16, "xswz"); return __int_as_float(__builtin_amdgcn_ds_swizzle(__float_as_int(v), 0x1F | (M << 10))); }
template <int M> __device__ __forceinline__ unsigned xswzu(unsigned v) { return (unsigned)__builtin_amdgcn_ds_swizzle((int)v, 0x1F | (M << 10)); }
__device__ __forceinline__ float xsum32(float v) { auto rr = __builtin_amdgcn_permlane32_swap(__float_as_uint(v), __float_as_uint(v), false, false); return __uint_as_float(rr[0]) + __uint_as_float(rr[1]); }
__device__ __forceinline__ float xmax32(float v) { auto rr = __builtin_amdgcn_permlane32_swap(__float_as_uint(v), __float_as_uint(v), false, false); return fmaxf(__uint_as_float(rr[0]), __uint_as_float(rr[1])); }
__device__ __forceinline__ float xother32(float v, bool upper) { auto rr = __builtin_amdgcn_permlane32_swap(__float_as_uint(v), __float_as_uint(v), false, false); return __uint_as_float(upper ? rr[0] : rr[1]); }
#define LDS_WAIT() asm volatile("s_waitcnt lgkmcnt(0)" ::: "memory")
#define VM_WAIT() asm volatile("s_waitcnt vmcnt(0)" ::: "memory")

constexpr int NB = 8, SEQ = 4096, NTOK = NB * SEQ, DM = 1024, NLAYER = 4;
constexpr int NIN_SRC = 6632, NIN = 6656;
constexpr int NEXP = 32, TOPK = 4, DFF = 1024;
constexpr int NSLOT = NTOK * TOPK, NSLOT_PAD = NSLOT + NEXP * 256;
constexpr float LN_EPS = 1e-5f, RMS_EPS = 1e-6f;
constexpr float DN_ALPHA = 1.681792830507429f;
constexpr float LOG2E = 1.4426950408889634f;
constexpr float QSCALE_A = 0.125f * LOG2E;
constexpr float QSCALE_C = 0.10206207261596577f * LOG2E;
constexpr float IW_SCALE = 0.35355339059327373f * 0.125f;

constexpr size_t MiB = (size_t)1 << 20;
constexpr size_t WS_CTL = 0, CTL_ZERO_BYTES = 1 * MiB;
constexpr int CW_BAR = 4096, CW_CNT = 16384;
constexpr size_t SZ_WIN = (size_t)NIN * DM * 2, SZ_WUQ = (size_t)768 * 256 * 2, SZ_WUKV = (size_t)1024 * 256 * 2, SZ_WBR = (size_t)3 * 1024 * 512 * 2, SZ_WOUT = (size_t)1024 * 1024 * 2;
constexpr size_t SZ_WGU = (size_t)NEXP * 2048 * 1024 * 2, SZ_WDN = (size_t)NEXP * 1024 * 1024 * 2, SZ_WGM = (size_t)8 * 128 * 128 * 2;
constexpr size_t WS_WIN = 2 * MiB;
constexpr size_t WS_WUQ = WS_WIN + NLAYER * SZ_WIN;
constexpr size_t WS_WUKV = WS_WUQ + NLAYER * SZ_WUQ;
constexpr size_t WS_WBR = WS_WUKV + NLAYER * SZ_WUKV;
constexpr size_t WS_WOUT = WS_WBR + NLAYER * SZ_WBR;
constexpr size_t WS_WGU = WS_WOUT + NLAYER * SZ_WOUT;
constexpr size_t WS_WDN = WS_WGU + NLAYER * SZ_WGU;
constexpr size_t WS_WGM = WS_WDN + NLAYER * SZ_WDN;
constexpr size_t WS_COSA = WS_WGM + NLAYER * SZ_WGM;
constexpr size_t WS_SINA = WS_COSA + (size_t)NTOK * 8 * 4;
constexpr size_t WS_COSC = WS_SINA + (size_t)NTOK * 8 * 4;
constexpr size_t WS_SINC = WS_COSC + (size_t)NTOK * 16 * 4;
constexpr size_t WS_XRES = WS_SINC + (size_t)NTOK * 16 * 4;
constexpr size_t WS_XB = WS_XRES + (size_t)NTOK * DM * 4;
constexpr size_t WS_QA = WS_XB + (size_t)NTOK * DM * 2;
constexpr size_t WS_KA = WS_QA + (size_t)NTOK * 512 * 2;
constexpr size_t WS_VAT = WS_KA + (size_t)NTOK * 512 * 2;
constexpr size_t WS_IQ = WS_VAT + (size_t)NTOK * 512 * 2;
constexpr size_t WS_IK = WS_IQ + (size_t)NTOK * 512 * 2;
constexpr size_t WS_IW = WS_IK + (size_t)NTOK * 64 * 2;
constexpr size_t WS_U = WS_IW + (size_t)NTOK * 8 * 4;
constexpr size_t WS_V = WS_U + (size_t)NTOK * 512 * 2;
constexpr size_t WS_CDQ = WS_V + (size_t)NTOK * 512 * 2;
constexpr size_t WS_CDKV = WS_CDQ + (size_t)NTOK * 256 * 2;
constexpr size_t WS_SSQ = WS_CDKV + (size_t)NTOK * 256 * 2;
constexpr size_t WS_GATE = WS_SSQ + (size_t)NTOK * 8 * 4;
constexpr size_t WS_QC = WS_GATE + (size_t)NTOK * 3072 * 2;
constexpr size_t WS_KC = WS_QC + (size_t)NTOK * 768 * 2;
constexpr size_t WS_VCT = WS_KC + (size_t)NTOK * 768 * 2;
constexpr size_t WS_SCORE = WS_VCT + (size_t)NTOK * 512 * 2;
constexpr size_t WS_MASK = WS_SCORE + (size_t)NTOK * SEQ * 4;
constexpr size_t WS_OBUF = WS_MASK + (size_t)NTOK * 128 * 4;
constexpr size_t WS_MERGED = WS_OBUF + (size_t)3 * NTOK * 512 * 2;
constexpr size_t WS_TKE = WS_MERGED + (size_t)NTOK * DM * 2;
constexpr size_t WS_TKP = WS_TKE + (size_t)NSLOT * 4;
constexpr size_t WS_TKW = WS_TKP + (size_t)NSLOT * 4;
constexpr size_t WS_STK = WS_TKW + (size_t)NSLOT * 4;
constexpr size_t WS_SW = WS_STK + (size_t)NSLOT_PAD * 4;
constexpr size_t WS_XG = WS_SW + (size_t)NSLOT_PAD * 4;
constexpr size_t WS_H = WS_XG + (size_t)NSLOT_PAD * DM * 2;
constexpr size_t WS_Y = WS_H + (size_t)NSLOT_PAD * DFF * 2;
constexpr size_t WS_CCNT = WS_Y + (size_t)NSLOT_PAD * DM * 2;
constexpr size_t WS_END = WS_CCNT + (size_t)(NTOK / 128) * 32 * 4;
constexpr size_t WS_DRY = (WS_END + 255) & ~(size_t)255;
static_assert(WS_END < (size_t)4200 * MiB, "workspace map too large");
static_assert((WS_WIN % 256) == 0 && (WS_COSA % 256) == 0 && (WS_XRES % 256) == 0 && (WS_SCORE % 256) == 0 && (WS_XG % 256) == 0, "alignment");

constexpr int LDS_BYTES = 147456;
constexpr int MISC_OFF = 143360;
constexpr int NWAVES = 8;

#define XB_TMO      128
#define XB_XCNT(j)  (256  + 64 * (j))
#define XB_XSUB(j)  (1280 + 64 * (j))
#define XB_XGEN(j)  (2304 + 64 * (j))
#define XB_TOP      3328
#define XB_TOPGEN   3392
#define XCD_BAR_WORDS 3456
#define XB_SPIN_CAP (1u << 18)
__device__ __forceinline__ unsigned xb_ld(unsigned* p)              { return __hip_atomic_load(p, __ATOMIC_RELAXED, __HIP_MEMORY_SCOPE_AGENT); }
__device__ __forceinline__ unsigned xb_add(unsigned* p, unsigned v) { return __hip_atomic_fetch_add(p, v, __ATOMIC_RELAXED, __HIP_MEMORY_SCOPE_AGENT); }
__device__ __forceinline__ unsigned xb_xcc_id() { return (unsigned)__builtin_amdgcn_s_getreg((3 << 11) | 20) & 0xFu; }
#define XB_SPIN(cond, bar) do { unsigned _sp = 0; while (cond) { __builtin_amdgcn_s_sleep(1); \
    if ((++_sp & 255u) == 0u) { if (xb_ld(&(bar)[XB_TMO])) break; if (_sp > XB_SPIN_CAP) { atomicAdd(&(bar)[XB_TMO], 1u); break; } } } } while (0)
struct XcdBarrier { unsigned* bar; unsigned x; volatile LAS unsigned* st; };
__device__ __forceinline__ XcdBarrier xcd_barrier_post(unsigned* bar, volatile LAS unsigned* st) {
    XcdBarrier b; b.bar = bar; b.x = xb_xcc_id(); b.st = st;
    if (threadIdx.x == 0) (void)xb_add(&bar[XB_XCNT(b.x)], 1u);
    return b;
}
__device__ __forceinline__ void xcd_barrier_complete(unsigned* bar, unsigned x, unsigned& nloc, unsigned& nx) {
    const unsigned G = gridDim.x * gridDim.y * gridDim.z;
    unsigned sum, cnt, mine, sp = 0u;
    for (;;) {
        sum = 0u; cnt = 0u; mine = 0u;
#pragma unroll
        for (unsigned j = 0; j < 16; ++j) { const unsigned c = xb_ld(&bar[XB_XCNT(j)]); sum += c; cnt += (c > 0u) ? 1u : 0u; mine = (j == x) ? c : mine; }
        if (sum == G) break;
        __builtin_amdgcn_s_sleep(1);
        if ((++sp & 255u) == 0u) { if (xb_ld(&bar[XB_TMO])) break; if (sp > XB_SPIN_CAP) { atomicAdd(&bar[XB_TMO], 1u); break; } }
    }
    nloc = mine > 0u ? mine : 1u; nx = cnt > 0u ? cnt : 1u;
}
__device__ __forceinline__ void xcd_barrier(const XcdBarrier& b, bool leader_thread) {
    asm volatile("s_waitcnt vmcnt(0)" ::: "memory");
    __syncthreads();
    if (leader_thread) {
        unsigned* bar = b.bar;
        __builtin_amdgcn_s_waitcnt(0);
        unsigned nloc = b.st[0], nx = b.st[1];
        if (nloc == 0u) { xcd_barrier_complete(bar, b.x, nloc, nx); b.st[0] = nloc; b.st[1] = nx; }
        const unsigned old = xb_add(&bar[XB_XSUB(b.x)], 1u);
        const unsigned gen = old / nloc;
        if (old + 1u == (gen + 1u) * nloc) {
            __builtin_amdgcn_fence(__ATOMIC_RELEASE, "agent");
            asm volatile("s_waitcnt vmcnt(0)" ::: "memory");
            const unsigned og = xb_add(&bar[XB_TOP], 1u);
            const unsigned tg = og / nx;
            if (og + 1u == (tg + 1u) * nx) xb_add(&bar[XB_TOPGEN], 1u);
            else XB_SPIN(xb_ld(&bar[XB_TOPGEN]) == tg, bar);
            __builtin_amdgcn_fence(__ATOMIC_ACQUIRE, "agent");
            xb_add(&bar[XB_XGEN(b.x)], 1u);
            asm volatile("s_waitcnt vmcnt(0)" ::: "memory");
        } else {
            XB_SPIN(xb_ld(&bar[XB_XGEN(b.x)]) == gen, bar);
            __builtin_amdgcn_fence(__ATOMIC_ACQUIRE, "agent");
            asm volatile("s_waitcnt vmcnt(0)" ::: "memory");
        }
    }
    __syncthreads();
}

namespace pg8 {
constexpr int BM = 256, BK = 64, HALF = 128, HTB = HALF * BK * 2;
__host__ __device__ __forceinline__ int lds_byte(int r, int c) { const int st = (r >> 4) * 2 + (c >> 5), rr = r & 15, cc = c & 31, ob = rr * 64 + cc * 2; return st * 1024 + (ob ^ (((ob >> 9) & 1) << 5)); }
__host__ __device__ __forceinline__ void stage_rc(int b, int& R, int& C) { const int st = b / 1024, sb = b % 1024, swz = sb ^ (((sb >> 9) & 1) << 5); R = (st >> 1) * 16 + swz / 64; C = (st & 1) * 32 + (swz % 64) / 2; }
__host__ __device__ __forceinline__ int perm32(int rho) { const int n = rho >> 4, i = rho & 15; return 8 * (i >> 2) + 4 * n + (i & 3); }
struct Unit { int pm, pn; };
struct Gemm { const bf16_t* A; const bf16_t* Bt; int lda, K; const int* rowmap; };

template <class Epi, class Sched, bool GATHER = false>
__device__ __forceinline__ void gemm_phase(LAS unsigned char* lds, const Gemm g, const Sched& S, const Epi& E, int tid0) {
    int tid = tid0; asm volatile("" : "+v"(tid));
    const int wid = __builtin_amdgcn_readfirstlane(tid >> 6), lane = tid & 63, wr = wid >> 2, wc = wid & 3, fr = lane & 15, fq = lane >> 4;
    const int K = g.K, nt = K / BK, lda = g.lda;
    unsigned voffA[2], voffB[2]; unsigned colA2 = 0u;
#pragma unroll
    for (int i = 0; i < 2; ++i) { int R, C; stage_rc(tid * 16 + i * 8192, R, C); voffA[i] = (unsigned)(R * lda + C) * 2u; const int Rb = (R & ~31) + perm32(R & 31); voffB[i] = (unsigned)(Rb * K + C) * 2u; colA2 = (unsigned)C * 2u; }
    unsigned gcur[2] = {0u, 0u}, gnxt[2] = {0u, 0u};
#define PG8_GLOAD(d, pm_) do { int ln_; asm volatile("v_mbcnt_lo_u32_b32 %0, -1, 0\n\tv_mbcnt_hi_u32_b32 %0, -1, %0" : "=v"(ln_));   \
        int R0_, C0_; stage_rc(((wid << 6) | ln_) * 16, R0_, C0_); const int* rm_ = g.rowmap + (pm_) * BM + R0_; \
        d[0] = (unsigned)rm_[0] | ((unsigned)rm_[64] << 16); d[1] = (unsigned)rm_[HALF] | ((unsigned)rm_[HALF + 64] << 16); } while (0)
#define PG8_GOFF(p, i) ((((i) ? ((p) >> 16) : ((p) & 0xffffu)) * (unsigned)(lda * 2)) + colA2)
#define PG8_STAGE_G(bufoff, gbase, p) do { _Pragma("unroll") for (int _i = 0; _i < 2; ++_i) \
        __builtin_amdgcn_global_load_lds((const unsigned*)((const char*)(gbase) + PG8_GOFF(p, _i)), (LAS unsigned*)(lds + (bufoff) + ldsw + _i * 8192), 16, 0, 0); } while (0)
    const size_t kstep = (size_t)(BK * 2);
    const size_t hstepA = (size_t)HALF * lda * 2, hstepB = (size_t)HALF * K * 2;
    const size_t tstepA = 2 * hstepA, tstepB = 2 * hstepB;
    const unsigned ldsw = (unsigned)wid * 1024u;
    const int aoff = lds_byte(wr * 64 + fr, fq * 8), boff = lds_byte(wc * 32 + fr, fq * 8);
#define PG8_SA(b, h) (((b) * 2 + (h)) * HTB)
#define PG8_SB(b, h) ((4 + (b) * 2 + (h)) * HTB)
#define PG8_STAGE(bufoff, gbase, voff) do { _Pragma("unroll") for (int _i = 0; _i < 2; ++_i) \
        __builtin_amdgcn_global_load_lds((const unsigned*)((const char*)(gbase) + (voff)[_i]), (LAS unsigned*)(lds + (bufoff) + ldsw + _i * 8192), 16, 0, 0); } while (0)
#define PG8_STAGE_A(bufoff, gbase, half, nextu) do { if constexpr (GATHER) { if (nextu) PG8_STAGE_G(bufoff, gbase, gnxt[half]); else PG8_STAGE_G(bufoff, gbase, gcur[half]); } \
        else { PG8_STAGE(bufoff, (gbase) + ((half) ? hstepA : 0), voffA); } } while (0)
#define PG8_LDA(dst, b, h) do { _Pragma("unroll") for (int m = 0; m < 4; ++m) _Pragma("unroll") for (int k = 0; k < 2; ++k) dst[m][k] = *(const LAS bf16x8*)(lds + PG8_SA(b, h) + aoff + m * 2048 + k * 1024); } while (0)
#define PG8_LDB(dst, b, h) do { _Pragma("unroll") for (int n = 0; n < 2; ++n) _Pragma("unroll") for (int k = 0; k < 2; ++k) dst[n][k] = *(const LAS bf16x8*)(lds + PG8_SB(b, h) + boff + n * 2048 + k * 1024); } while (0)
#define PG8_MMA(ai, bj, At, Bt) do { __builtin_amdgcn_s_setprio(1); _Pragma("unroll") for (int m = 0; m < 4; ++m) _Pragma("unroll") for (int n = 0; n < 2; ++n) _Pragma("unroll") for (int k = 0; k < 2; ++k) \
        acc[ai][bj][m][n] = __builtin_amdgcn_mfma_f32_16x16x32_bf16(Bt[n][k], At[m][k], acc[ai][bj][m][n], 0, 0, 0); __builtin_amdgcn_s_setprio(0); } while (0)
#define PG8_WAIT_V(n) asm volatile("s_waitcnt vmcnt(" #n ")" ::: "memory")
#define PG8_WAIT_L(n) asm volatile("s_waitcnt lgkmcnt(" #n ")" ::: "memory")
#define PG8_BAR __builtin_amdgcn_s_barrier()
#define PG8_SCHED __builtin_amdgcn_sched_barrier(0)
    Unit cur, nxt; int ui = 0;
    if (!S.next(0, cur)) return;
    f32x4 acc[2][2][4][2];
#pragma unroll
    for (int a = 0; a < 2; ++a)
#pragma unroll
        for (int b = 0; b < 2; ++b)
#pragma unroll
            for (int m = 0; m < 4; ++m)
#pragma unroll
                for (int n = 0; n < 2; ++n) acc[a][b][m][n] = (f32x4){0.f, 0.f, 0.f, 0.f};
    bf16x8 At[4][2], B0[2][2], B1[2][2];
    const char* cA = GATHER ? (const char*)g.A : (const char*)g.A + (size_t)cur.pm * tstepA; const char* cB = (const char*)g.Bt + (size_t)cur.pn * tstepB;
    if constexpr (GATHER) { PG8_GLOAD(gcur, cur.pm); }
    PG8_STAGE(PG8_SB(0, 0), cB, voffB); PG8_STAGE(PG8_SB(0, 1), cB + hstepB, voffB); PG8_STAGE_A(PG8_SA(0, 0), cA, 0, false); PG8_STAGE_A(PG8_SA(0, 1), cA, 1, false);
    if (wr == 1) PG8_BAR;
    PG8_WAIT_V(2); PG8_BAR;
    PG8_STAGE(PG8_SB(1, 0), cB + kstep, voffB); PG8_STAGE_A(PG8_SA(1, 0), cA + kstep, 0, false); PG8_STAGE(PG8_SB(1, 1), cB + hstepB + kstep, voffB);
    PG8_WAIT_V(6); PG8_BAR;
    for (;;) {
        const bool has_next = S.next(ui + 1, nxt);
        const char* nA = GATHER ? cA : (has_next ? (const char*)g.A + (size_t)nxt.pm * tstepA : cA); const char* nB = has_next ? (const char*)g.Bt + (size_t)nxt.pn * tstepB : cB;
        if constexpr (GATHER) { if (has_next) { PG8_GLOAD(gnxt, nxt.pm); } else { gnxt[0] = gcur[0]; gnxt[1] = gcur[1]; } }
        for (int t = 0; t < nt; t += 2) {
            const bool last = (t == nt - 2);
            const char* a1 = cA + (size_t)(t + 1) * kstep;
            const char* a2 = last ? nA : cA + (size_t)(t + 2) * kstep; const char* b2 = last ? nB : cB + (size_t)(t + 2) * kstep;
            const char* a3 = a2 + kstep; const char* b3 = b2 + kstep;
            PG8_LDB(B0, 0, 0); PG8_LDB(B1, 0, 1); PG8_SCHED; PG8_LDA(At, 0, 0); PG8_STAGE_A(PG8_SA(1, 1), a1, 1, false);
            PG8_WAIT_V(8); PG8_WAIT_L(0); PG8_BAR; PG8_MMA(0, 0, At, B0); PG8_MMA(0, 1, At, B1); PG8_BAR; PG8_SCHED;
            PG8_LDA(At, 0, 1); PG8_STAGE(PG8_SB(0, 0), b2, voffB); PG8_STAGE(PG8_SB(0, 1), b2 + hstepB, voffB); PG8_STAGE_A(PG8_SA(0, 0), a2, 0, last);
            PG8_WAIT_V(8); PG8_WAIT_L(0); PG8_BAR; PG8_MMA(1, 0, At, B0); PG8_MMA(1, 1, At, B1); PG8_BAR; PG8_SCHED;
            PG8_LDB(B0, 1, 0); PG8_LDB(B1, 1, 1); PG8_SCHED; PG8_LDA(At, 1, 0); PG8_STAGE_A(PG8_SA(0, 1), a2, 1, last);
            PG8_WAIT_V(8); PG8_WAIT_L(0); PG8_BAR; PG8_MMA(0, 0, At, B0); PG8_MMA(0, 1, At, B1); PG8_BAR; PG8_SCHED;
            PG8_LDA(At, 1, 1); PG8_STAGE(PG8_SB(1, 0), b3, voffB); PG8_STAGE(PG8_SB(1, 1), b3 + hstepB, voffB); PG8_STAGE_A(PG8_SA(1, 0), a3, 0, last);
            PG8_WAIT_V(8); PG8_WAIT_L(0); PG8_BAR; PG8_MMA(1, 0, At, B0); PG8_MMA(1, 1, At, B1); PG8_BAR; PG8_SCHED;
        }
        if (wr == 0) PG8_BAR;
        { int el; asm volatile("v_mbcnt_lo_u32_b32 %0, -1, 0\n\tv_mbcnt_hi_u32_b32 %0, -1, %0" : "=v"(el));
          E(acc, cur, wr, wc, el & 15, el >> 4); }
        if (!has_next) break;
        if constexpr (!Epi::CHAIN) {
#pragma unroll
        for (int a = 0; a < 2; ++a)
#pragma unroll
            for (int b = 0; b < 2; ++b)
#pragma unroll
                for (int m = 0; m < 4; ++m)
#pragma unroll
                    for (int n = 0; n < 2; ++n) acc[a][b][m][n] = (f32x4){0.f, 0.f, 0.f, 0.f};
        }
        cur = nxt; cA = nA; cB = nB; ++ui;
        if constexpr (GATHER) { gcur[0] = gnxt[0]; gcur[1] = gnxt[1]; }
        if (wr == 1) PG8_BAR;
    }
    PG8_WAIT_V(0);
    PG8_BAR;
#undef PG8_SA
#undef PG8_SB
#undef PG8_STAGE
#undef PG8_LDA
#undef PG8_STAGE_A
#undef PG8_GLOAD
#undef PG8_GOFF
#undef PG8_STAGE_G
#undef PG8_LDB
#undef PG8_MMA
#undef PG8_WAIT_V
#undef PG8_WAIT_L
#undef PG8_BAR
#undef PG8_SCHED
}
}
using pg8::Unit;

struct Args { const float* in[23]; float* out; unsigned char* ws; int ph_lo, ph_hi; int sub, pad; };
struct Ctx {
    LAS unsigned char* lds;
    int tid, lane, wave, G, bid;
    unsigned char* ws;
};
#define WSP(T, off) ((T*)(C.ws + (off)))

struct GridOrder {
    int nN, total, G, c;
    __device__ __forceinline__ bool next(int i, Unit& u) const {
        const int L = c + i * G; if (L >= total) return false;
        const int nM = total / nN; int wgid;
        { const int q = total >> 3, r = total & 7, xcd = L & 7, off = L >> 3; wgid = (xcd < r ? xcd * (q + 1) : r * (q + 1) + (xcd - r) * q) + off; }
        const int nig = 8 * nN, gid = wgid / nig, fm = gid * 8, gsz = (nM - fm) < 8 ? (nM - fm) : 8, w = wgid - gid * nig;
        const int pn = w / gsz; u.pm = fm + (w - pn * gsz); u.pn = pn; return true;
    }
};
struct MergeOrder {
    int G, c;
    __device__ __forceinline__ bool next(int i, Unit& u) const { const int t = i / 3, n = i - 3 * t, tile = c + t * G; if (tile >= 512) return false; u.pm = n * 128 + (tile >> 2); u.pn = n * 4 + (tile & 3); return true; }
};
struct MoeOrder {
    int NT, total, G, c; const LAS int* tb;
    __device__ __forceinline__ bool next(int i, Unit& u) const {
        if ((G & 7) != 0) { const int idx = c + i * G; if (idx >= total) return false; const int mt = idx / NT, pn = idx - mt * NT;
            const int e = __builtin_amdgcn_readfirstlane(tb[40 + mt]); u.pm = mt; u.pn = e * NT + pn; return true; }
        const int T = __builtin_amdgcn_readfirstlane(tb[NEXP]), x = c & 7, lo = (x * T) >> 3, ntl = (((x + 1) * T) >> 3) - lo;
        const int j = (c >> 3) + i * (G >> 3);
        if (j >= ntl * NT) return false;
        const int gsh = (NT == 8) ? 6 : 5, gm = j >> gsh, rem = j - (gm << gsh);
        const int gs = (ntl - 8 * gm < 8) ? (ntl - 8 * gm) : 8, g4 = gs * 4, pg = (rem >= g4) ? 1 : 0, r2 = rem - pg * g4;
        const int mt = lo + 8 * gm + (r2 >> 2), e = __builtin_amdgcn_readfirstlane(tb[40 + mt]);
        u.pm = mt; u.pn = e * NT + pg * 4 + (r2 & 3); return true;
    }
};

__device__ __forceinline__ float gelu_f(float v) {
    const float av = fabsf(v), t = __builtin_amdgcn_rcpf(fmaf(av, 0.2316418882f, 1.0f));
    float q = fmaf(t, 0.5307027145f, -0.7265760135f); q = fmaf(q, t, 0.7107068705f); q = fmaf(q, t, -0.142248368f); q = fmaf(q, t, 0.127414796f); q = q * t;
    const float e = __builtin_amdgcn_exp2f((v * v) * (-0.72134752044f));
    const float m = v * (q * e);
    return v < 0.f ? m : v - m;
}
__device__ __forceinline__ float sigmoid_f(float x) { return __builtin_amdgcn_rcpf(1.f + __builtin_amdgcn_exp2f(x * (-LOG2E))); }
__device__ __forceinline__ int perm16(int o) { return (o & 3) | (((o >> 3) & 1) << 2) | (((o >> 2) & 1) << 3); }
__device__ __forceinline__ void st_bf4(bf16_t* p, f32x4 v) { u32x2 w; w.x = pk2(v[0], v[1]); w.y = pk2(v[2], v[3]); *(u32x2*)p = w; }
__device__ __forceinline__ f32x4 other32_4(f32x4 v, bool upper) { f32x4 r; r[0] = xother32(v[0], upper); r[1] = xother32(v[1], upper); r[2] = xother32(v[2], upper); r[3] = xother32(v[3], upper); return r; }

__device__ __forceinline__ void st_bf8(bf16_t* p, f32x4 v0, f32x4 v1) { u32x4 w; w.x = pk2(v0[0], v0[1]); w.y = pk2(v0[2], v0[3]); w.z = pk2(v1[0], v1[1]); w.w = pk2(v1[2], v1[3]); __builtin_nontemporal_store(w, (u32x4*)p); }
__device__ __forceinline__ f32x4 swz16_4(f32x4 v) { f32x4 r; r[0] = xswz<16>(v[0]); r[1] = xswz<16>(v[1]); r[2] = xswz<16>(v[2]); r[3] = xswz<16>(v[3]); return r; }
__device__ __forceinline__ void ld_bf8(const bf16_t* p, f32x4& a, f32x4& b) { const u32x4 w = *(const u32x4*)p; a = (f32x4){bflo(w.x), bfhi(w.x), bflo(w.y), bfhi(w.y)}; b = (f32x4){bflo(w.z), bfhi(w.z), bflo(w.w), bfhi(w.w)}; }
__device__ __forceinline__ void st_vt8(bf16_t* p, f32x4 v0, f32x4 v1) {
    const unsigned w0 = pk2(v0[0], v0[1]), w1 = pk2(v0[2], v0[3]), w2 = pk2(v1[0], v1[1]), w3 = pk2(v1[2], v1[3]);
    p[0] = (bf16_t)(w0 & 0xffff); p[SEQ] = (bf16_t)(w0 >> 16); p[2 * SEQ] = (bf16_t)(w1 & 0xffff); p[3 * SEQ] = (bf16_t)(w1 >> 16);
    p[4 * SEQ] = (bf16_t)(w2 & 0xffff); p[5 * SEQ] = (bf16_t)(w2 >> 16); p[6 * SEQ] = (bf16_t)(w3 & 0xffff); p[7 * SEQ] = (bf16_t)(w3 >> 16);
}
struct EpiInProj {
    static constexpr bool CHAIN = false;
    unsigned char* ws; bool skip;
    __device__ __forceinline__ void operator()(f32x4 (&acc)[2][2][4][2], const Unit& un, int wr, int wc, int fr, int fq) const {
        if (skip) return;
        const int pn = un.pn; const int row0 = un.pm * 256 + wr * 64 + fr;
        const float* cosA = (const float*)(ws + WS_COSA); const float* sinA = (const float*)(ws + WS_SINA); const float* cosC = (const float*)(ws + WS_COSC); const float* sinC = (const float*)(ws + WS_SINC);
        if (pn < 4 || pn == 6 || pn == 7) {
            const size_t doff = pn < 2 ? WS_QA : (pn < 4 ? WS_KA : WS_IQ); bf16_t* dst = (bf16_t*)(ws + doff); const float sc = pn < 2 ? QSCALE_A : 1.f; const int tcol = (pn & 1) * 256;
            const bool rope = (wc & 1) == 0;
#pragma unroll
            for (int ai = 0; ai < 2; ++ai)
#pragma unroll
                for (int m = 0; m < 4; ++m) { const int row = row0 + ai * 128 + m * 16;
                    f32x4 c0 = {1.f, 1.f, 1.f, 1.f}, c1 = c0, s0 = {0.f, 0.f, 0.f, 0.f}, s1 = s0;
                    if (rope) { c0 = *(const f32x4*)(cosA + (size_t)row * 8); c1 = *(const f32x4*)(cosA + (size_t)row * 8 + 4); s0 = *(const f32x4*)(sinA + (size_t)row * 8); s1 = *(const f32x4*)(sinA + (size_t)row * 8 + 4); }
#pragma unroll
                    for (int bj = 0; bj < 2; ++bj) { f32x4 v0 = acc[ai][bj][m][0], v1 = acc[ai][bj][m][1];
                        const f32x4 p0 = swz16_4(v0), p1 = swz16_4(v1);
                        if (rope && fq < 2) { v0 = (fq == 0) ? (v0 * c0 - p0 * s0) : (v0 * c0 + p0 * s0); v1 = (fq == 0) ? (v1 * c1 - p1 * s1) : (v1 * c1 + p1 * s1); }
                        st_bf8(dst + (size_t)row * 512 + tcol + bj * 128 + wc * 32 + 8 * fq, v0 * sc, v1 * sc); } }
        } else if (pn < 6) {
            bf16_t* vat = (bf16_t*)(ws + WS_VAT);
#pragma unroll
            for (int ai = 0; ai < 2; ++ai)
#pragma unroll
                for (int m = 0; m < 4; ++m) { const int row = row0 + ai * 128 + m * 16; const int b = row >> 12, s = row & 4095, ps = (s & ~15) | perm16(s & 15);
#pragma unroll
                    for (int bj = 0; bj < 2; ++bj) { const int c = (pn - 4) * 256 + bj * 128 + wc * 32 + 8 * fq; const int h = c >> 6, d = c & 63;
                        st_vt8(vat + ((size_t)(b * 8 + h) * 64 + d) * SEQ + ps, acc[ai][bj][m][0], acc[ai][bj][m][1]); } }
        } else if (pn == 8) {
            bf16_t* ik = (bf16_t*)(ws + WS_IK); float* iw = (float*)(ws + WS_IW); bf16_t* kc = (bf16_t*)(ws + WS_KC); bf16_t* cd = (bf16_t*)(ws + WS_CDKV); float* ssq = (float*)(ws + WS_SSQ);
#pragma unroll
            for (int ai = 0; ai < 2; ++ai)
#pragma unroll
                for (int m = 0; m < 4; ++m) { const int row = row0 + ai * 128 + m * 16;
                    { f32x4 v0 = acc[ai][0][m][0], v1 = acc[ai][0][m][1];
                      { unsigned zz = 0u; asm volatile("" : "+v"(zz)); const u32x4 z = {zz, zz, zz, zz}; *(u32x4*)(cd + (size_t)row * 256 + wc * 32 + 8 * fq) = z; }
                      if (wc == 0) {
                          const f32x4 p0 = swz16_4(v0), p1 = swz16_4(v1);
                          if (fq < 2) { const f32x4 c0 = *(const f32x4*)(cosA + (size_t)row * 8), c1 = *(const f32x4*)(cosA + (size_t)row * 8 + 4), s0 = *(const f32x4*)(sinA + (size_t)row * 8), s1 = *(const f32x4*)(sinA + (size_t)row * 8 + 4);
                              v0 = (fq == 0) ? (v0 * c0 - p0 * s0) : (v0 * c0 + p0 * s0); v1 = (fq == 0) ? (v1 * c1 - p1 * s1) : (v1 * c1 + p1 * s1); }
                          st_bf8(ik + (size_t)row * 64 + 8 * fq, v0, v1);
                      } else if (wc == 1) { st_bf8(ik + (size_t)row * 64 + 32 + 8 * fq, v0, v1);
                      } else if (wc == 2) { if (fq == 0) { *(f32x4*)(iw + (size_t)row * 8) = v0 * IW_SCALE; *(f32x4*)(iw + (size_t)row * 8 + 4) = v1 * IW_SCALE; }
                      } else {
                          const bool up = fq >= 2; const f32x4 p0 = other32_4(v0, up), p1 = other32_4(v1, up);
                          const f32x4 c0 = *(const f32x4*)(cosC + (size_t)row * 16 + 8 * (fq & 1)), c1 = *(const f32x4*)(cosC + (size_t)row * 16 + 8 * (fq & 1) + 4), s0 = *(const f32x4*)(sinC + (size_t)row * 16 + 8 * (fq & 1)), s1 = *(const f32x4*)(sinC + (size_t)row * 16 + 8 * (fq & 1) + 4);
                          const f32x4 o0 = up ? (v0 * c0 + p0 * s0) : (v0 * c0 - p0 * s0), o1 = up ? (v1 * c1 + p1 * s1) : (v1 * c1 - p1 * s1);
                          bf16_t* p = kc + (size_t)row * 768 + 64 + 8 * fq;
#pragma unroll
                          for (int h = 0; h < 8; ++h) st_bf8(p + h * 96, o0, o1); } }
                    { const f32x4 v0 = acc[ai][1][m][0], v1 = acc[ai][1][m][1];
                      st_bf8(cd + (size_t)row * 256 + 128 + wc * 32 + 8 * fq, v0, v1);
                      float s = (v0[0] * v0[0] + v0[1] * v0[1]) + (v0[2] * v0[2] + v0[3] * v0[3]) + (v1[0] * v1[0] + v1[1] * v1[1]) + (v1[2] * v1[2] + v1[3] * v1[3]);
                      s += xswz<16>(s); s = xsum32(s);
                      if (fq == 0) ssq[(size_t)row * 8 + 4 + wc] = s; } }
        } else if (pn < 13) {
            bf16_t* dst = (bf16_t*)(ws + (pn < 11 ? WS_U : WS_V)); const int tcol = ((pn - 9) & 1) * 256;
#pragma unroll
            for (int ai = 0; ai < 2; ++ai)
#pragma unroll
                for (int m = 0; m < 4; ++m) { const int row = row0 + ai * 128 + m * 16;
#pragma unroll
                    for (int bj = 0; bj < 2; ++bj) { f32x4 v0 = acc[ai][bj][m][0], v1 = acc[ai][bj][m][1];
                        v0[0] = gelu_f(v0[0]); v0[1] = gelu_f(v0[1]); v0[2] = gelu_f(v0[2]); v0[3] = gelu_f(v0[3]); v1[0] = gelu_f(v1[0]); v1[1] = gelu_f(v1[1]); v1[2] = gelu_f(v1[2]); v1[3] = gelu_f(v1[3]);
                        st_bf8(dst + (size_t)row * 512 + tcol + bj * 128 + wc * 32 + 8 * fq, v0, v1); } }
        } else if (pn == 13) {
            bf16_t* cd = (bf16_t*)(ws + WS_CDQ); float* ssq = (float*)(ws + WS_SSQ);
#pragma unroll
            for (int ai = 0; ai < 2; ++ai)
#pragma unroll
                for (int m = 0; m < 4; ++m) { const int row = row0 + ai * 128 + m * 16; float s = 0.f;
#pragma unroll
                    for (int bj = 0; bj < 2; ++bj) { const f32x4 v0 = acc[ai][bj][m][0], v1 = acc[ai][bj][m][1];
                        st_bf8(cd + (size_t)row * 256 + bj * 128 + wc * 32 + 8 * fq, v0, v1);
                        s += ((v0[0] * v0[0] + v0[1] * v0[1]) + (v0[2] * v0[2] + v0[3] * v0[3])) + ((v1[0] * v1[0] + v1[1] * v1[1]) + (v1[2] * v1[2] + v1[3] * v1[3])); }
                    s += xswz<16>(s); s = xsum32(s);
                    if (fq == 0) ssq[(size_t)row * 8 + wc] = s; }
        } else {
            const int tcol = (pn - 14) * 256; bf16_t* gate = (bf16_t*)(ws + WS_GATE);
#pragma unroll
            for (int ai = 0; ai < 2; ++ai)
#pragma unroll
                for (int m = 0; m < 4; ++m) { const int row = row0 + ai * 128 + m * 16;
#pragma unroll
                    for (int bj = 0; bj < 2; ++bj) { f32x4 v0 = acc[ai][bj][m][0], v1 = acc[ai][bj][m][1];
                        v0[0] = sigmoid_f(v0[0]); v0[1] = sigmoid_f(v0[1]); v0[2] = sigmoid_f(v0[2]); v0[3] = sigmoid_f(v0[3]); v1[0] = sigmoid_f(v1[0]); v1[1] = sigmoid_f(v1[1]); v1[2] = sigmoid_f(v1[2]); v1[3] = sigmoid_f(v1[3]);
                        st_bf8(gate + (size_t)row * 3072 + tcol + bj * 128 + wc * 32 + 8 * fq, v0, v1); } }
        }
    }
};

struct EpiQUp {
    static constexpr bool CHAIN = false;
    bf16_t* qc; const float* ssq; const float *cosC, *sinC;
    __device__ __forceinline__ void operator()(f32x4 (&acc)[2][2][4][2], const Unit& un, int wr, int wc, int fr, int fq) const {
        const int row0 = un.pm * 256 + wr * 64 + fr; const bool up = fq >= 2;
#pragma unroll
        for (int ai = 0; ai < 2; ++ai)
#pragma unroll
            for (int m = 0; m < 4; ++m) { const int row = row0 + ai * 128 + m * 16;
                const f32x4 sp = *(const f32x4*)(ssq + (size_t)row * 8);
                const float rs = rsqrtf(((sp[0] + sp[1]) + (sp[2] + sp[3])) * (1.f / 256.f) + RMS_EPS) * QSCALE_C;
                const f32x4 c0 = *(const f32x4*)(cosC + (size_t)row * 16 + 8 * (fq & 1)), c1 = *(const f32x4*)(cosC + (size_t)row * 16 + 8 * (fq & 1) + 4), s0 = *(const f32x4*)(sinC + (size_t)row * 16 + 8 * (fq & 1)), s1 = *(const f32x4*)(sinC + (size_t)row * 16 + 8 * (fq & 1) + 4);
#pragma unroll
                for (int bj = 0; bj < 2; ++bj) { const int gidx = un.pn * 8 + bj * 4 + wc;
                    f32x4 v0 = acc[ai][bj][m][0] * rs, v1 = acc[ai][bj][m][1] * rs;
                    if ((gidx % 3) == 2) { const f32x4 p0 = other32_4(v0, up), p1 = other32_4(v1, up);
                        v0 = up ? (v0 * c0 + p0 * s0) : (v0 * c0 - p0 * s0); v1 = up ? (v1 * c1 + p1 * s1) : (v1 * c1 - p1 * s1); }
                    st_bf8(qc + (size_t)row * 768 + gidx * 32 + 8 * fq, v0, v1); } }
    }
};
struct EpiKvUp {
    static constexpr bool CHAIN = false;
    bf16_t *kc, *vct; const float* ssq;
    __device__ __forceinline__ void operator()(f32x4 (&acc)[2][2][4][2], const Unit& un, int wr, int wc, int fr, int fq) const {
        const int row0 = un.pm * 256 + wr * 64 + fr;
#pragma unroll
        for (int ai = 0; ai < 2; ++ai)
#pragma unroll
            for (int m = 0; m < 4; ++m) { const int row = row0 + ai * 128 + m * 16;
                const f32x4 sp = *(const f32x4*)(ssq + (size_t)row * 8 + 4);
                const float rs = rsqrtf(((sp[0] + sp[1]) + (sp[2] + sp[3])) * (1.f / 128.f) + RMS_EPS);
                const int b = row >> 12, s = row & 4095, ps = (s & ~15) | perm16(s & 15);
#pragma unroll
                for (int bj = 0; bj < 2; ++bj) { const int h = un.pn * 2 + bj; const f32x4 v0 = acc[ai][bj][m][0] * rs, v1 = acc[ai][bj][m][1] * rs;
                    if (wc < 2) st_bf8(kc + (size_t)row * 768 + h * 96 + wc * 32 + 8 * fq, v0, v1);
                    else st_vt8(vct + ((size_t)(b * 8 + h) * 64 + (wc - 2) * 32 + 8 * fq) * SEQ + ps, v0, v1); }
                asm volatile("" ::: "memory"); }
    }
};
struct EpiMerge {
    static constexpr bool CHAIN = true;
    const bf16_t* gate; bf16_t* merged;
    __device__ __forceinline__ void operator()(f32x4 (&acc)[2][2][4][2], const Unit& un, int wr, int wc, int fr, int fq) const {
        const int n3 = un.pm >> 7, pm = un.pm & 127, pn = un.pn & 3; const int row0 = pm * 256 + wr * 64 + fr;
#pragma unroll
        for (int ai = 0; ai < 2; ++ai)
#pragma unroll
            for (int m = 0; m < 4; ++m) { const int row = row0 + ai * 128 + m * 16;
#pragma unroll
                for (int bj = 0; bj < 2; ++bj) { const int col = pn * 256 + bj * 128 + wc * 32 + 8 * fq;
                    const bf16_t* gp = gate + (size_t)row * 3072 + n3 * 1024 + col;
                    f32x4 ga0, ga1; ld_bf8(gp, ga0, ga1);
                    if (n3 < 2) { f32x4 gb0, gb1; ld_bf8(gp + 1024, gb0, gb1);
#pragma unroll
                        for (int j = 0; j < 4; ++j) { if (n3 == 1) { ga0[j] = fmaxf(ga0[j], 1e-20f); ga1[j] = fmaxf(ga1[j], 1e-20f); }
                            acc[ai][bj][m][0][j] *= ga0[j] * __builtin_amdgcn_rcpf(fmaxf(gb0[j], 1e-20f)); acc[ai][bj][m][1][j] *= ga1[j] * __builtin_amdgcn_rcpf(fmaxf(gb1[j], 1e-20f)); }
                    } else {
#pragma unroll
                        for (int j = 0; j < 4; ++j) { ga0[j] = fmaxf(ga0[j], 1e-20f); ga1[j] = fmaxf(ga1[j], 1e-20f); }
                        st_bf8(merged + (size_t)row * 1024 + col, acc[ai][bj][m][0] * ga0, acc[ai][bj][m][1] * ga1);
                        acc[ai][bj][m][0] = (f32x4){0.f, 0.f, 0.f, 0.f}; acc[ai][bj][m][1] = (f32x4){0.f, 0.f, 0.f, 0.f};
                    } } }
    }
};
struct EpiOut {
    static constexpr bool CHAIN = false;
    bf16_t* yo;
    __device__ __forceinline__ void operator()(f32x4 (&acc)[2][2][4][2], const Unit& un, int wr, int wc, int fr, int fq) const {
        const int row0 = un.pm * 256 + wr * 64 + fr;
#pragma unroll
        for (int ai = 0; ai < 2; ++ai)
#pragma unroll
            for (int m = 0; m < 4; ++m) { const int row = row0 + ai * 128 + m * 16;
#pragma unroll
                for (int bj = 0; bj < 2; ++bj) st_bf8(yo + (size_t)row * 1024 + un.pn * 256 + bj * 128 + wc * 32 + 8 * fq, acc[ai][bj][m][0], acc[ai][bj][m][1]); }
    }
};
struct EpiMoeUp {
    static constexpr bool CHAIN = false;
    bf16_t* hbuf; const float* bgu;
    __device__ __forceinline__ void operator()(f32x4 (&acc)[2][2][4][2], const Unit& un, int wr, int wc, int fr, int fq) const {
        const int e = un.pn >> 3, pnl = un.pn & 7; const int row0 = un.pm * 256 + wr * 64 + fr; const float* be = bgu + (size_t)e * 2048;
        const int jh = pnl * 128 + wc * 32 + 8 * fq;
        const f32x4 bg0 = *(const f32x4*)(be + jh), bg1 = *(const f32x4*)(be + jh + 4), bl0 = *(const f32x4*)(be + 1024 + jh), bl1 = *(const f32x4*)(be + 1024 + jh + 4);
#pragma unroll
        for (int ai = 0; ai < 2; ++ai)
#pragma unroll
            for (int m = 0; m < 4; ++m) { const int row = row0 + ai * 128 + m * 16;
                const f32x4 g0 = acc[ai][0][m][0] + bg0, g1 = acc[ai][0][m][1] + bg1, l0 = acc[ai][1][m][0] + bl0, l1 = acc[ai][1][m][1] + bl1; f32x4 o0, o1;
#pragma unroll
                for (int j = 0; j < 4; ++j) { const float ga = fminf(g0[j], 7.f), la = fminf(fmaxf(l0[j], -7.f), 7.f); o0[j] = (la + 1.f) * (ga * sigmoid_f(1.702f * ga));
                    const float gb = fminf(g1[j], 7.f), lb = fminf(fmaxf(l1[j], -7.f), 7.f); o1[j] = (lb + 1.f) * (gb * sigmoid_f(1.702f * gb)); }
                st_bf8(hbuf + (size_t)row * 1024 + jh, o0, o1);
                __builtin_amdgcn_sched_barrier(0); }
    }
};
struct EpiMoeDn {
    static constexpr bool CHAIN = false;
    bf16_t* y; const float* bdn; bool skip;
    __device__ __forceinline__ void operator()(f32x4 (&acc)[2][2][4][2], const Unit& un, int wr, int wc, int fr, int fq) const {
        const int e = un.pn >> 2, pnl = un.pn & 3; const int row0 = (skip ? 0 : un.pm * 256) + wr * 64 + fr; const float* be = bdn + (size_t)e * 1024;
#pragma unroll
        for (int bj = 0; bj < 2; ++bj) { const int col = pnl * 256 + bj * 128 + wc * 32 + 8 * fq; const f32x4 b0 = *(const f32x4*)(be + col), b1 = *(const f32x4*)(be + col + 4);
#pragma unroll
            for (int ai = 0; ai < 2; ++ai)
#pragma unroll
                for (int m = 0; m < 4; ++m) st_bf8(y + (size_t)(row0 + ai * 128 + m * 16) * 1024 + col, acc[ai][bj][m][0] + b0, acc[ai][bj][m][1] + b1); }
    }
};

__device__ __forceinline__ int colmap_in(int np) {
    if (np < 2048) return np;
    if (np < 2304) { const int t = np - 2048; if (t < 64) return 2048 + t; if (t < 72) return 2112 + (t - 64); if (t < 96) return -1; if (t < 128) return 3528 + (t - 96); return 3400 + (t - 128); }
    if (np < 3328) return 2120 + (np - 2304);
    if (np < 3584) return 3144 + (np - 3328);
    return 3560 + (np - 3584);
}
__device__ __forceinline__ int colmap_gu(int np) { const int tile = np >> 8, w = np & 255; return (w < 128) ? (tile * 128 + w) : (1024 + tile * 128 + (w - 128)); }
template <int KIND>
__device__ __forceinline__ void tconv_item(const float* src, int ldsrc, bf16_t* dst, int Kdst, int koff, const float* kscale, int item, int nblk, LAS float* scr, int lane) {
    const int kb = item / nblk, nb = item - kb * nblk, k0 = 64 * kb, n0 = 32 * nb;
    const int np = n0 + (lane & 31);
    const int col = KIND == 1 ? colmap_in(np) : (KIND == 2 ? colmap_gu(np) : np);
    float vv[32];
#pragma unroll
    for (int i = 0; i < 32; ++i) { const int kk = 2 * i + (lane >> 5); const int ks = k0 + kk - koff; float v = 0.f;
        if (col >= 0 && ks >= 0) { v = src[(size_t)ks * ldsrc + col]; if (kscale) v *= kscale[ks]; }
        vv[i] = v; }
#pragma unroll
    for (int i = 0; i < 32; ++i) { const int kk = 2 * i + (lane >> 5); scr[kk * 33 + (lane & 31)] = vv[i]; }
    LDS_WAIT(); asm volatile("" ::: "memory");
    const int c = lane & 7;
#pragma unroll
    for (int j = 0; j < 4; ++j) { const int n = (lane >> 3) + 8 * j; const LAS float* s = scr + (8 * c) * 33 + n;
        u32x4 o; o.x = pk2(s[0 * 33], s[1 * 33]); o.y = pk2(s[2 * 33], s[3 * 33]); o.z = pk2(s[4 * 33], s[5 * 33]); o.w = pk2(s[6 * 33], s[7 * 33]);
        *(u32x4*)(dst + (size_t)(n0 + n) * Kdst + k0 + 8 * c) = o; }
    LDS_WAIT(); asm volatile("" ::: "memory");
}
__device__ __forceinline__ void phase_prologue(const Ctx& C, const Args& A) {
    LAS float* scr = (LAS float*)(C.lds + C.wave * 16384);
    const int gw = C.bid * NWAVES + C.wave, NGW = C.G * NWAVES;
    constexpr int I_IN = 16 * (NIN / 32), I_UQ = 4 * 24, I_UKV = 4 * 32, I_BR = 8 * 32, I_OUT = 16 * 32, I_GU = 16 * 64, I_DN = 16 * 32;
    constexpr int I_LAYER = I_IN + I_UQ + I_UKV + 3 * I_BR + I_OUT + NEXP * I_GU + NEXP * I_DN;
    for (int it = gw; it < NLAYER * I_LAYER; it += NGW) {
        const int l = it / I_LAYER; int r = it - l * I_LAYER;
        if (r < I_IN) { tconv_item<1>(A.in[2] + (size_t)l * DM * NIN_SRC, NIN_SRC, WSP(bf16_t, WS_WIN + l * SZ_WIN), 1024, 0, nullptr, r, NIN / 32, scr, C.lane); continue; } r -= I_IN;
        if (r < I_UQ) { tconv_item<0>(A.in[9] + (size_t)l * 256 * 768, 768, WSP(bf16_t, WS_WUQ + l * SZ_WUQ), 256, 0, A.in[7] + l * 256, r, 24, scr, C.lane); continue; } r -= I_UQ;
        if (r < I_UKV) { tconv_item<0>(A.in[10] + (size_t)l * 128 * 1024, 1024, WSP(bf16_t, WS_WUKV + l * SZ_WUKV), 256, 128, A.in[8] + l * 128, r, 32, scr, C.lane); continue; } r -= I_UKV;
        if (r < 3 * I_BR) { const int n = r / I_BR; r -= n * I_BR;
            tconv_item<0>(A.in[11] + ((size_t)l * 3 + n) * 512 * 1024, 1024, WSP(bf16_t, WS_WBR + l * SZ_WBR) + (size_t)n * 1024 * 512, 512, 0, nullptr, r, 32, scr, C.lane); continue; } r -= 3 * I_BR;
        if (r < I_OUT) { tconv_item<0>(A.in[12] + (size_t)l * 1024 * 1024, 1024, WSP(bf16_t, WS_WOUT + l * SZ_WOUT), 1024, 0, nullptr, r, 32, scr, C.lane); continue; } r -= I_OUT;
        if (r < NEXP * I_GU) { const int e = r / I_GU; r -= e * I_GU;
            tconv_item<2>(A.in[17] + ((size_t)l * NEXP + e) * 1024 * 2048, 2048, WSP(bf16_t, WS_WGU + l * SZ_WGU) + (size_t)e * 2048 * 1024, 1024, 0, nullptr, r, 64, scr, C.lane); continue; } r -= NEXP * I_GU;
        { const int e = r / I_DN; r -= e * I_DN;
            tconv_item<0>(A.in[19] + ((size_t)l * NEXP + e) * 1024 * 1024, 1024, WSP(bf16_t, WS_WDN + l * SZ_WDN) + (size_t)e * 1024 * 1024, 1024, 0, nullptr, r, 32, scr, C.lane); }
    }
    const int gt = C.bid * 512 + C.tid, NGT = C.G * 512;
    { bf16_t* d = WSP(bf16_t, WS_WGM); const float* s = A.in[5];
      for (int i = gt; i < NLAYER * 8 * 128 * 128; i += NGT) { const int jj = i & 127, ii = (i >> 7) & 127; d[i] = (jj <= ii) ? (bf16_t)(pk2(s[i], 0.f) & 0xffff) : (bf16_t)0; } }
    { const int* pos = (const int*)A.in[1]; float *ca = WSP(float, WS_COSA), *sa = WSP(float, WS_SINA), *cc = WSP(float, WS_COSC), *sc = WSP(float, WS_SINC);
      for (int i = gt; i < NTOK * 8; i += NGT) { const int t = i >> 3, f = i & 7; const float inv = powf(500000.f, -(float)f / 8.f); const float ang = (float)pos[t] * inv; ca[i] = cosf(ang); sa[i] = sinf(ang); }
      for (int i = gt; i < NTOK * 16; i += NGT) { const int t = i >> 4, f = i & 15; const float inv = powf(500000.f, -(float)f / 16.f); const float ang = (float)pos[t] * inv; cc[i] = cosf(ang); sc[i] = sinf(ang); } }
    { const f32x4* x4 = (const f32x4*)A.in[0]; u32x2* xb = WSP(u32x2, WS_XB);
      for (int i = gt; i < NTOK * DM / 4; i += NGT) { const f32x4 v = x4[i]; u32x2 w; w.x = pk2(v[0], v[1]); w.y = pk2(v[2], v[3]); xb[i] = w; } }
}

__device__ __forceinline__ void idx_block(const Ctx& C, int b, int qb) {
    const int tid = C.tid, lane = C.lane, wid = C.wave, r32 = lane & 31, hi = lane >> 5;
    const bf16_t* iq = WSP(bf16_t, WS_IQ); const bf16_t* ik = WSP(bf16_t, WS_IK); const float* iw = WSP(float, WS_IW); float* score = WSP(float, WS_SCORE);
    const int qi_l = ((r32 >> 4) << 1) + ((r32 >> 2) & 1), h_l = (r32 & 3) + 4 * ((r32 >> 3) & 1);
    bf16x8 af[2][4]; float wv[2][2][8];
#pragma unroll
    for (int rb = 0; rb < 2; ++rb) { const size_t tok = (size_t)b * SEQ + qb * 64 + wid * 8 + rb * 4 + qi_l;
#pragma unroll
        for (int ks = 0; ks < 4; ++ks) af[rb][ks] = *(const bf16x8*)(iq + tok * 512 + h_l * 64 + ks * 16 + hi * 8);
#pragma unroll
        for (int g = 0; g < 2; ++g) { const size_t tq = (size_t)b * SEQ + qb * 64 + wid * 8 + rb * 4 + 2 * g + hi;
            const f32x4 w0 = *(const f32x4*)(iw + tq * 8), w1 = *(const f32x4*)(iw + tq * 8 + 4);
            wv[rb][g][0] = w0[0]; wv[rb][g][1] = w0[1]; wv[rb][g][2] = w0[2]; wv[rb][g][3] = w0[3]; wv[rb][g][4] = w1[0]; wv[rb][g][5] = w1[1]; wv[rb][g][6] = w1[2]; wv[rb][g][7] = w1[3]; } }
    const int lkey = tid & 63, lch = tid >> 6;
    const bf16_t* ksrc = ik + ((size_t)b * SEQ + lkey) * 64 + lch * 8;
    LAS unsigned char* kdst = C.lds + (lch * 64 + lkey) * 16;
    const int NT = qb + 1;
    u32x4 rk = *(const u32x4*)ksrc;
    *(LAS u32x4*)kdst = rk;
    __syncthreads();
    for (int kt = 0; kt < NT; ++kt) {
        const int cur = kt & 1;
        if (kt + 1 < NT) rk = *(const u32x4*)(ksrc + (size_t)(kt + 1) * 64 * 64);
        const LAS unsigned char* kb = C.lds + cur * 8192;
        bf16x8 bfr[2][4];
#pragma unroll
        for (int kbk = 0; kbk < 2; ++kbk)
#pragma unroll
            for (int ks = 0; ks < 4; ++ks) bfr[kbk][ks] = *(const LAS bf16x8*)(kb + ((2 * ks + hi) * 64 + kbk * 32 + r32) * 16);
#pragma unroll
        for (int rb = 0; rb < 2; ++rb)
#pragma unroll
            for (int kbk = 0; kbk < 2; ++kbk) {
                f32x16 a = {};
#pragma unroll
                for (int ks = 0; ks < 4; ++ks) a = __builtin_amdgcn_mfma_f32_32x32x16_bf16(af[rb][ks], bfr[kbk][ks], a, 0, 0, 0);
#pragma unroll
                for (int g = 0; g < 2; ++g) { float s = 0.f;
#pragma unroll
                    for (int hh = 0; hh < 8; ++hh) s = fmaf(fmaxf(a[8 * g + hh], 0.f), wv[rb][g][hh], s);
                    const size_t tq = (size_t)b * SEQ + qb * 64 + wid * 8 + rb * 4 + 2 * g + hi;
                    score[tq * SEQ + kt * 64 + kbk * 32 + r32] = s; } }
        if (kt + 1 < NT) *(LAS u32x4*)(kdst + (cur ^ 1) * 8192) = rk;
        __syncthreads();
    }
}
__device__ __forceinline__ void phase_indexer(const Ctx& C) {
    for (int u0 = C.bid; u0 < NB * 32; u0 += C.G) {
        int u = u0; if (C.G == NB * 32) u = (C.bid & 7) * 32 + (C.bid >> 3);
        const int b = u >> 5, p = u & 31; idx_block(C, b, p); idx_block(C, b, 63 - p); }
}

__device__ __forceinline__ unsigned f2key(float f) { const unsigned u = __float_as_uint(f); return (u & 0x80000000u) ? ~u : (u | 0x80000000u); }
__device__ __forceinline__ int wave_total7(unsigned cv) {
    int t = 0;
#pragma unroll
    for (int b = 0; b < 7; ++b) t += __popcll(__ballot((cv >> b) & 1u)) << b;
    return t;
}
template <int NG>
__device__ __forceinline__ unsigned select_radix(const unsigned (&u)[64]) {
    unsigned prefix = 0u;
    for (int bit = 31; bit >= 0; --bit) {
        const unsigned cand = prefix | (1u << bit); unsigned cv = 0u;
#pragma unroll
        for (int i = 0; i < NG * 8; ++i) cv += (u[i] >= cand) ? 1u : 0u;
        const int cnt = wave_total7(cv);
        if (cnt >= 256) prefix = cand;
        if (cnt == 256) break;
    }
    return prefix;
}
__device__ __forceinline__ int wave_sum_dpp(int x) {
    x += __builtin_amdgcn_update_dpp(0, x, 0xB1, 0xf, 0xf, true);
    x += __builtin_amdgcn_update_dpp(0, x, 0x4E, 0xf, 0xf, true);
    x += __builtin_amdgcn_update_dpp(0, x, 0x141, 0xf, 0xf, true);
    x += __builtin_amdgcn_update_dpp(0, x, 0x140, 0xf, 0xf, true);
    x += __builtin_amdgcn_update_dpp(0, x, 0x142, 0xa, 0xf, false);
    x += __builtin_amdgcn_update_dpp(0, x, 0x143, 0xc, 0xf, false);
    return __builtin_amdgcn_readlane(x, 63);
}
__device__ __forceinline__ unsigned bfi32(unsigned m, unsigned x, unsigned y) { return (m & x) | (~m & y); }
__device__ __forceinline__ void bit_transpose32(unsigned* a) {
#pragma unroll
    for (int k = 0; k < 16; ++k) { const unsigned x = a[k], y = a[k + 16]; a[k] = __builtin_amdgcn_perm(y, x, 0x05040100u); a[k + 16] = __builtin_amdgcn_perm(y, x, 0x07060302u); }
#pragma unroll
    for (int k = 0; k < 32; ++k) if ((k & 8) == 0) { const unsigned x = a[k], y = a[k + 8]; a[k] = __builtin_amdgcn_perm(y, x, 0x06020400u); a[k + 8] = __builtin_amdgcn_perm(y, x, 0x07030501u); }
#pragma unroll
    for (int k = 0; k < 32; ++k) if ((k & 4) == 0) { const unsigned x = a[k], y = a[k + 4]; a[k] = bfi32(0x0f0f0f0fu, x, y << 4); a[k + 4] = bfi32(0x0f0f0f0fu, x >> 4, y); }
#pragma unroll
    for (int k = 0; k < 32; ++k) if ((k & 2) == 0) { const unsigned x = a[k], y = a[k + 2]; a[k] = bfi32(0x33333333u, x, y << 2); a[k + 2] = bfi32(0x33333333u, x >> 2, y); }
#pragma unroll
    for (int k = 0; k < 32; ++k) if ((k & 1) == 0) { const unsigned x = a[k], y = a[k + 1]; a[k] = bfi32(0x55555555u, x, y << 1); a[k + 1] = bfi32(0x55555555u, x >> 1, y); }
}
template <int NW>
__device__ __forceinline__ void select_bits(const float* row, int n, unsigned* mrow, int lane) {
    constexpr int W = 32 * NW;
    unsigned a[W];
    {   const u32x4* src = (const u32x4*)(row + lane * W);
#pragma unroll
        for (int i = 0; i < W / 4; ++i) { const u32x4 v = src[i];
#pragma unroll
            for (int j = 0; j < 4; ++j) { const unsigned u = v[j]; a[4 * i + j] = u ^ ((unsigned)((int)u >> 31) | 0x80000000u); } }
    }
#pragma unroll
    for (int blk = 0; blk < NW; ++blk) bit_transpose32(a + 32 * blk);
    unsigned alive[NW], above[NW];
#pragma unroll
    for (int w = 0; w < NW; ++w) { const int nv = n - lane * W - 32 * w; alive[w] = nv >= 32 ? 0xffffffffu : (nv <= 0 ? 0u : ((1u << nv) - 1u)); above[w] = 0u; }
    int cnta = 0; bool exact = false;
#pragma unroll
    for (int b = 31; b >= 0; --b) {
        unsigned o[NW]; int pc = 0;
#pragma unroll
        for (int w = 0; w < NW; ++w) { o[w] = alive[w] & a[32 * w + b]; pc += __popc(o[w]); }
        const int tot = cnta + wave_sum_dpp(pc);
        if (tot >= 256) {
#pragma unroll
            for (int w = 0; w < NW; ++w) alive[w] = o[w];
            if (tot == 256) { exact = true; break; }
        } else {
#pragma unroll
            for (int w = 0; w < NW; ++w) { above[w] |= o[w]; alive[w] ^= o[w]; }
            cnta = tot;
        }
    }
    if (!exact) {
        int pc = 0;
#pragma unroll
        for (int w = 0; w < NW; ++w) pc += __popc(alive[w]);
        const int ceq = wave_sum_dpp(pc), need = 256 - cnta;
        if (ceq > need) {
            int excl = 0;
#pragma unroll 1
            for (int L = 0; L < 63; ++L) { const int v = __builtin_amdgcn_readlane(pc, L); excl += (lane > L) ? v : 0; }
            int take = need - excl; take = take < 0 ? 0 : (take > pc ? pc : take);
            int c = pc;
            if (NW == 2) { while (c > take && alive[NW - 1] != 0u) { alive[NW - 1] &= ~(0x80000000u >> __clz(alive[NW - 1])); --c; } }
            while (c > take) { alive[0] &= ~(0x80000000u >> __clz(alive[0])); --c; }
        }
    }
    if (NW == 2) { u32x2 m; m.x = above[0] | alive[0]; m.y = above[NW - 1] | alive[NW - 1]; *(u32x2*)(mrow + 2 * lane) = m; }
    else { mrow[lane] = above[0] | alive[0]; mrow[64 + lane] = 0u; }
}
__device__ __forceinline__ void phase_select(const Ctx& C) {
    const float* score = WSP(float, WS_SCORE); unsigned long long* mask = WSP(unsigned long long, WS_MASK);
    const int gw = C.bid * NWAVES + C.wave, NGW = C.G * NWAVES, lane = C.lane;
    for (int idx = gw; idx < NTOK; idx += NGW) {
        const int q = idx & (SEQ - 1); const int n = q + 1; const float* row = score + (size_t)idx * SEQ;
        if (n <= 256) {
            const int lo = n - 64 * lane;
            const unsigned long long m = lo >= 64 ? ~0ull : (lo <= 0 ? 0ull : ((1ull << lo) - 1ull));
            mask[(size_t)idx * 64 + lane] = m;
        } else if (n <= 2048) select_bits<1>(row, n, (unsigned*)(mask + (size_t)idx * 64), lane);
        else select_bits<2>(row, n, (unsigned*)(mask + (size_t)idx * 64), lane);
    }
}

__device__ __forceinline__ int crow(int r, int hi) { return (r & 3) + 8 * (r >> 2) + 4 * hi; }
template <int DQK, bool MASKED>
__device__ __forceinline__ void attn_unit(const Ctx& C, int b, int h, int qb, const bf16_t* Q, const bf16_t* K, const bf16_t* VT, const unsigned* mask, bf16_t* O) {
    constexpr int NKS = DQK / 16, NCH = DQK / 8, KTB = NCH * 1024, BUF = KTB + 8192, QS = 8 * DQK;
    const int tid = C.tid, lane = C.lane, wid = C.wave, r32 = lane & 31, hi = lane >> 5;
    const int NT = 4 * (qb + 1);
    const size_t tok = (size_t)b * SEQ + qb * 256 + wid * 32 + r32;
    bf16x8 qf[NKS];
#pragma unroll
    for (int ks = 0; ks < NKS; ++ks) qf[ks] = *(const bf16x8*)(Q + tok * QS + h * DQK + ks * 16 + hi * 8);
    const int lrow = tid & 63, lch = tid >> 6;
    const bf16_t* ksrc0 = K + ((size_t)b * SEQ + lrow) * QS + h * DQK + lch * 8;
    const bf16_t* ksrc1 = ksrc0 + 64;
    const bf16_t* vsrc = VT + ((size_t)(b * 8 + h) * 64 + lrow) * SEQ + lch * 8;
    LAS unsigned char* kd0 = C.lds + (lch * 64 + lrow) * 16;
    LAS unsigned char* kd1 = C.lds + ((8 + lch) * 64 + lrow) * 16;
    LAS unsigned char* vd = C.lds + KTB + (lch * 64 + lrow) * 16;
    const bool k1 = (DQK > 64) && (tid < 256);
    u32x4 rk0, rk1 = {0u, 0u, 0u, 0u}, rv;
    rk0 = *(const u32x4*)ksrc0; if (k1) rk1 = *(const u32x4*)ksrc1; rv = *(const u32x4*)vsrc;
    *(LAS u32x4*)kd0 = rk0; if (k1) *(LAS u32x4*)kd1 = rk1; *(LAS u32x4*)vd = rv;
    u32x2 mw = {0u, 0u};
    if (MASKED) mw = *(const u32x2*)(mask + tok * 128);
    float mbias = 0.f, thr = -1e30f, lsum = 0.f;
    u32x4 qmw = {0u, 0u, 0u, 0u};
    const bf16x8 kone = __builtin_bit_cast(bf16x8, (u32x4){hi == 0 ? 0x3F80u : 0u, 0u, 0u, 0u});
    f32x16 o0 = {}, o1 = {};
    __syncthreads();
    for (int kt = 0; kt < NT; ++kt) {
        const int cur = kt & 1;
        u32x2 mwn = {0u, 0u};
        if (kt + 1 < NT) {
            rk0 = *(const u32x4*)(ksrc0 + (size_t)(kt + 1) * 64 * QS); if (k1) rk1 = *(const u32x4*)(ksrc1 + (size_t)(kt + 1) * 64 * QS);
            rv = *(const u32x4*)(vsrc + (kt + 1) * 64);
            if (MASKED) mwn = *(const u32x2*)(mask + tok * 128 + 2 * (kt + 1));
        }
        const LAS unsigned char* kb = C.lds + cur * BUF; const LAS unsigned char* vb = kb + KTB;
        f32x16 p0 = {}, p1 = {};
        bf16x8 kf[2 * NKS], vf[8];
#pragma unroll
        for (int ks = 0; ks < NKS; ++ks) {
            kf[2 * ks] = *(const LAS bf16x8*)(kb + ((2 * ks + hi) * 64 + r32) * 16);
            kf[2 * ks + 1] = *(const LAS bf16x8*)(kb + ((2 * ks + hi) * 64 + 32 + r32) * 16);
        }
#pragma unroll
        for (int s4 = 0; s4 < 4; ++s4) {
            vf[2 * s4] = *(const LAS bf16x8*)(vb + ((2 * s4 + hi) * 64 + r32) * 16);
            vf[2 * s4 + 1] = *(const LAS bf16x8*)(vb + ((2 * s4 + hi) * 64 + 32 + r32) * 16);
        }
        __builtin_amdgcn_sched_barrier(0);
#pragma unroll
        for (int ks = 0; ks < NKS; ++ks) {
            p0 = __builtin_amdgcn_mfma_f32_32x32x16_bf16(kf[2 * ks], qf[ks], p0, 0, 0, 0);
            p1 = __builtin_amdgcn_mfma_f32_32x32x16_bf16(kf[2 * ks + 1], qf[ks], p1, 0, 0, 0);
        }
        { const bf16x8 qm = __builtin_bit_cast(bf16x8, qmw);
          p0 = __builtin_amdgcn_mfma_f32_32x32x16_bf16(kone, qm, p0, 0, 0, 0); p1 = __builtin_amdgcn_mfma_f32_32x32x16_bf16(kone, qm, p1, 0, 0, 0); }
        if (MASKED) {
            const unsigned w0 = mw.x >> (4 * hi), w1 = mw.y >> (4 * hi);
#pragma unroll
            for (int r = 0; r < 16; ++r) { const int bit = (r & 3) + 8 * (r >> 2);
                const unsigned t0 = (unsigned)__builtin_amdgcn_sbfe((int)w0, bit, 1), t1 = (unsigned)__builtin_amdgcn_sbfe((int)w1, bit, 1);
                p0[r] = __uint_as_float((__float_as_uint(p0[r]) & t0) | (~t0 & 0xFF800000u));
                p1[r] = __uint_as_float((__float_as_uint(p1[r]) & t1) | (~t1 & 0xFF800000u)); }
        } else {
            if (kt >= NT - 4) { const int kb0 = (kt - (NT - 4)) * 64, qrel = wid * 32 + r32;
#pragma unroll
                for (int r = 0; r < 16; ++r) { const int kv = kb0 + crow(r, hi); if (kv > qrel) p0[r] = -INFINITY; if (kv + 32 > qrel) p1[r] = -INFINITY; } }
        }
        float mx;
        { float a0 = fmaxf(fmaxf(p0[0], p0[1]), p0[2]), a1 = fmaxf(fmaxf(p0[3], p0[4]), p0[5]), a2 = fmaxf(fmaxf(p0[6], p0[7]), p0[8]), a3 = fmaxf(fmaxf(p0[9], p0[10]), p0[11]);
          float a4 = fmaxf(fmaxf(p0[12], p0[13]), p0[14]), a5 = fmaxf(fmaxf(p0[15], p1[0]), p1[1]), a6 = fmaxf(fmaxf(p1[2], p1[3]), p1[4]), a7 = fmaxf(fmaxf(p1[5], p1[6]), p1[7]);
          float a8 = fmaxf(fmaxf(p1[8], p1[9]), p1[10]), a9 = fmaxf(fmaxf(p1[11], p1[12]), p1[13]), a10 = fmaxf(p1[14], p1[15]);
          a0 = fmaxf(fmaxf(a0, a1), a2); a3 = fmaxf(fmaxf(a3, a4), a5); a6 = fmaxf(fmaxf(a6, a7), a8); a9 = fmaxf(a9, a10);
          mx = fmaxf(fmaxf(a0, a3), fmaxf(a6, a9)); }
        mx = xmax32(mx);
        if (__any(mx > thr)) {
            const bool upd = mx > thr;
            const float mnew = upd ? __uint_as_float(pk2(mbias + mx, 0.f) << 16) : mbias;
            const float delta = mnew - mbias; const float alpha = (thr < 0.f) ? 1.f : __builtin_amdgcn_exp2f(-delta);
            mbias = mnew; thr = upd ? 4.f : thr;
            qmw.x = hi == 0 ? (pk2(-mnew, 0.f) & 0xffffu) : 0u;
            lsum *= alpha;
#pragma unroll
            for (int r = 0; r < 16; ++r) { o0[r] *= alpha; o1[r] *= alpha; p0[r] -= delta; p1[r] -= delta; }
        }
        {
#pragma unroll
            for (int r = 0; r < 16; ++r) { p0[r] = __builtin_amdgcn_exp2f(p0[r]); p1[r] = __builtin_amdgcn_exp2f(p1[r]); }
            float s0 = (p0[0] + p0[1]) + (p0[2] + p0[3]), s1 = (p0[4] + p0[5]) + (p0[6] + p0[7]), s2 = (p0[8] + p0[9]) + (p0[10] + p0[11]), s3 = (p0[12] + p0[13]) + (p0[14] + p0[15]);
            float s4 = (p1[0] + p1[1]) + (p1[2] + p1[3]), s5 = (p1[4] + p1[5]) + (p1[6] + p1[7]), s6 = (p1[8] + p1[9]) + (p1[10] + p1[11]), s7 = (p1[12] + p1[13]) + (p1[14] + p1[15]);
            lsum += ((s0 + s1) + (s2 + s3)) + ((s4 + s5) + (s6 + s7));
        }
        bf16x8 pf[4];
        { u32x4 t;
          t.x = pk2(p0[0], p0[1]); t.y = pk2(p0[2], p0[3]); t.z = pk2(p0[4], p0[5]); t.w = pk2(p0[6], p0[7]); pf[0] = __builtin_bit_cast(bf16x8, t);
          t.x = pk2(p0[8], p0[9]); t.y = pk2(p0[10], p0[11]); t.z = pk2(p0[12], p0[13]); t.w = pk2(p0[14], p0[15]); pf[1] = __builtin_bit_cast(bf16x8, t);
          t.x = pk2(p1[0], p1[1]); t.y = pk2(p1[2], p1[3]); t.z = pk2(p1[4], p1[5]); t.w = pk2(p1[6], p1[7]); pf[2] = __builtin_bit_cast(bf16x8, t);
          t.x = pk2(p1[8], p1[9]); t.y = pk2(p1[10], p1[11]); t.z = pk2(p1[12], p1[13]); t.w = pk2(p1[14], p1[15]); pf[3] = __builtin_bit_cast(bf16x8, t); }
#pragma unroll
        for (int s = 0; s < 4; ++s) {
            o0 = __builtin_amdgcn_mfma_f32_32x32x16_bf16(vf[2 * s], pf[s], o0, 0, 0, 0);
            o1 = __builtin_amdgcn_mfma_f32_32x32x16_bf16(vf[2 * s + 1], pf[s], o1, 0, 0, 0);
        }
        if (kt + 1 < NT) {
            const int nb = (cur ^ 1) * BUF;
            *(LAS u32x4*)(kd0 + nb) = rk0; if (k1) *(LAS u32x4*)(kd1 + nb) = rk1; *(LAS u32x4*)(vd + nb) = rv;
        }
        mw = mwn;
        __syncthreads();
    }
    lsum = xsum32(lsum);
    const float inv = 1.f / lsum;
    bf16_t* op = O + tok * 512 + h * 64 + 4 * hi;
#pragma unroll
    for (int i = 0; i < 4; ++i) {
        st_bf4(op + 8 * i, (f32x4){o0[4 * i] * inv, o0[4 * i + 1] * inv, o0[4 * i + 2] * inv, o0[4 * i + 3] * inv});
        st_bf4(op + 32 + 8 * i, (f32x4){o1[4 * i] * inv, o1[4 * i + 1] * inv, o1[4 * i + 2] * inv, o1[4 * i + 3] * inv});
    }
}
template <int DQK, bool MASKED>
__device__ __forceinline__ void phase_attn(const Ctx& C, const bf16_t* Q, const bf16_t* K, const bf16_t* VT, const unsigned* mask, bf16_t* O) {
    for (int u0 = C.bid; u0 < NB * 8 * 8; u0 += C.G) {
        int u = u0; if ((C.G & 7) == 0) { const int r = (C.bid >> 3) + (C.G >> 3) * (u0 / C.G); u = ((C.bid & 7) * 8 + (r >> 3)) * 8 + (r & 7); if (u >= NB * 8 * 8) u = u0; }
        const int bh = u >> 3, p = u & 7, b = bh >> 3, h = bh & 7;
        attn_unit<DQK, MASKED>(C, b, h, 15 - p, Q, K, VT, mask, O);
        attn_unit<DQK, MASKED>(C, b, h, p, Q, K, VT, mask, O); }
}

__device__ __forceinline__ void phase_gmlp(const Ctx& C, const float* lng, const float* lnb, const float* bs, int l) {
    const bf16_t* U = WSP(bf16_t, WS_U); const bf16_t* V = WSP(bf16_t, WS_V); bf16_t* OB = WSP(bf16_t, WS_OBUF) + (size_t)NTOK * 512;
    const bf16_t* WG = WSP(bf16_t, WS_WGM + l * SZ_WGM);
    const int tid = C.tid, lane = C.lane, wid = C.wave, r32 = lane & 31, hi = lane >> 5;
    constexpr int VST = 136;
    LAS bf16_t* vT = (LAS bf16_t*)C.lds;
    for (int un = C.bid; un < 512; un += C.G) {
        const int hf = un & 1, ch = un >> 1; const size_t t0 = (size_t)ch * 128;
        { const int pos = tid >> 2, q = tid & 3; const bf16_t* vr = V + (t0 + pos) * 512 + q * 32;
          float s = 0.f;
#pragma unroll
          for (int i = 0; i < 4; ++i)
#pragma unroll
              for (int j = 0; j < 4; ++j) { const u32x4 w = *(const u32x4*)(vr + i * 128 + j * 8); s += ((bflo(w.x) + bfhi(w.x)) + (bflo(w.y) + bfhi(w.y))) + ((bflo(w.z) + bfhi(w.z)) + (bflo(w.w) + bfhi(w.w))); }
          s += xswz<1>(s); s += xswz<2>(s);
          const float mean = s * (1.f / 512.f); float qv = 0.f;
          asm volatile("" ::: "memory");
#pragma unroll
          for (int i = 0; i < 4; ++i)
#pragma unroll
              for (int j = 0; j < 4; ++j) { const u32x4 w = *(const u32x4*)(vr + i * 128 + j * 8); float d;
                  d = bflo(w.x) - mean; qv += d * d; d = bfhi(w.x) - mean; qv += d * d; d = bflo(w.y) - mean; qv += d * d; d = bfhi(w.y) - mean; qv += d * d;
                  d = bflo(w.z) - mean; qv += d * d; d = bfhi(w.z) - mean; qv += d * d; d = bflo(w.w) - mean; qv += d * d; d = bfhi(w.w) - mean; qv += d * d; }
          qv += xswz<1>(qv); qv += xswz<2>(qv);
          const float rstd = rsqrtf(qv * (1.f / 512.f) + LN_EPS);
          asm volatile("" ::: "memory");
          const bf16_t* vh = vr + hf * 256;
#pragma unroll
          for (int ii = 0; ii < 2; ++ii)
#pragma unroll
              for (int j = 0; j < 4; ++j) { const u32x4 w = *(const u32x4*)(vh + ii * 128 + j * 8);
                  const int cl = ii * 128 + q * 32 + j * 8; const int c0 = hf * 256 + cl;
                  const f32x4 g0 = *(const f32x4*)(lng + c0), g1 = *(const f32x4*)(lng + c0 + 4), b0 = *(const f32x4*)(lnb + c0), b1 = *(const f32x4*)(lnb + c0 + 4);
                  LAS bf16_t* dp = vT + cl * VST + pos;
                  dp[0 * VST] = (bf16_t)(pk2((bflo(w.x) - mean) * rstd * g0[0] + b0[0], 0.f) & 0xffff);
                  dp[1 * VST] = (bf16_t)(pk2((bfhi(w.x) - mean) * rstd * g0[1] + b0[1], 0.f) & 0xffff);
                  dp[2 * VST] = (bf16_t)(pk2((bflo(w.y) - mean) * rstd * g0[2] + b0[2], 0.f) & 0xffff);
                  dp[3 * VST] = (bf16_t)(pk2((bfhi(w.y) - mean) * rstd * g0[3] + b0[3], 0.f) & 0xffff);
                  dp[4 * VST] = (bf16_t)(pk2((bflo(w.z) - mean) * rstd * g1[0] + b1[0], 0.f) & 0xffff);
                  dp[5 * VST] = (bf16_t)(pk2((bfhi(w.z) - mean) * rstd * g1[1] + b1[1], 0.f) & 0xffff);
                  dp[6 * VST] = (bf16_t)(pk2((bflo(w.w) - mean) * rstd * g1[2] + b1[2], 0.f) & 0xffff);
                  dp[7 * VST] = (bf16_t)(pk2((bfhi(w.w) - mean) * rstd * g1[3] + b1[3], 0.f) & 0xffff); } }
        __syncthreads();
        { const int gl = wid >> 1, ih = wid & 1, g = 4 * hf + gl;
          f32x16 acc[2][2] = {};
          const int nks = 4 * (ih + 1);
          const bf16_t* wrow = WG + ((size_t)g * 128 + ih * 64 + r32) * 128 + hi * 8;
          for (int ks = 0; ks < nks; ++ks) {
              bf16x8 a[2], bb[2];
#pragma unroll
              for (int mb = 0; mb < 2; ++mb) a[mb] = *(const bf16x8*)(wrow + (size_t)mb * 32 * 128 + ks * 16);
#pragma unroll
              for (int nb = 0; nb < 2; ++nb) bb[nb] = *(const LAS bf16x8*)(vT + (gl * 64 + nb * 32 + r32) * VST + ks * 16 + hi * 8);
#pragma unroll
              for (int mb = 0; mb < 2; ++mb)
#pragma unroll
                  for (int nb = 0; nb < 2; ++nb) acc[mb][nb] = __builtin_amdgcn_mfma_f32_32x32x16_bf16(a[mb], bb[nb], acc[mb][nb], 0, 0, 0);
          }
#pragma unroll
          for (int mb = 0; mb < 2; ++mb)
#pragma unroll
              for (int r = 0; r < 16; ++r) { const int i = ih * 64 + mb * 32 + crow(r, hi); const float bi = bs[g * 128 + i];
#pragma unroll
                  for (int nb = 0; nb < 2; ++nb) { const size_t o = (t0 + i) * 512 + g * 64 + nb * 32 + r32;
                      const float uu = bf2f(U[o]); OB[o] = (bf16_t)(pk2(uu * (acc[mb][nb][r] + bi), 0.f) & 0xffff); } } }
        __syncthreads();
    }
}

__device__ __forceinline__ float wave_sum(float v) {
    v += xswz<1>(v); v += xswz<2>(v); v += xswz<4>(v); v += xswz<8>(v); v += xswz<16>(v); return xsum32(v);
}
__device__ __forceinline__ void phase_ln1_router(const Ctx& C, const float* g1, const float* b1, const float* rw, const float* rbias, int l, bool dry) {
    constexpr int RST = 1028;
    LAS float* rwT = (LAS float*)C.lds;
    LAS float* gws = (LAS float*)(C.lds + 32 * RST * 4);
    LAS float* bws = gws + 32;
    LAS float* stat = bws + 32;
    LAS int* trec = (LAS int*)(C.lds + MISC_OFF + 64);
    LAS int* tpos = trec + 512;
    const int tid = C.tid, lane = C.lane, wid = C.wave;
    const bf16_t* xin = WSP(bf16_t, WS_XB); const bf16_t* yo = WSP(bf16_t, WS_OBUF); bf16_t* xb = dry ? WSP(bf16_t, WS_DRY + (size_t)NTOK * DM * 4) : WSP(bf16_t, WS_XB);
    int* tke = dry ? WSP(int, WS_DRY + (size_t)NTOK * DM * 6) : WSP(int, WS_TKE); int* tkp = dry ? WSP(int, WS_DRY + (size_t)NTOK * DM * 6 + NSLOT * 4) : WSP(int, WS_TKP); float* tkw = dry ? WSP(float, WS_DRY + (size_t)NTOK * DM * 6 + NSLOT * 8) : WSP(float, WS_TKW);
    int* ccnt = dry ? WSP(int, WS_DRY + (size_t)NTOK * DM * 6 + NSLOT * 12) : WSP(int, WS_CCNT);
    for (int i = tid; i < 1024 * 32; i += 512) { const int k = i >> 5, e = i & 31; rwT[e * RST + k] = rw[i] * g1[k]; }
    __syncthreads();
    for (int e = wid; e < 32; e += NWAVES) {
        float sg = 0.f, sb = 0.f;
#pragma unroll
        for (int j = 0; j < 16; ++j) { const int k = lane + 64 * j; sg += rwT[e * RST + k]; sb += b1[k] * rw[k * 32 + e]; }
        sg = wave_sum(sg); sb = wave_sum(sb);
        if (lane == 0) { gws[e] = sg; bws[e] = sb + rbias[e]; }
    }
    const int fr = lane & 15, fq = lane >> 4;
    for (int chunk = C.bid; chunk < NTOK / 128; chunk += C.G) {
        __syncthreads();
        const size_t tok0 = (size_t)chunk * 128 + wid * 16;
        f32x4 acc0 = {0.f, 0.f, 0.f, 0.f}, acc1 = {0.f, 0.f, 0.f, 0.f};
        u32x2 zp[64]; float s1 = 0.f, s2 = 0.f;
        { const bf16_t* zr = xin + (tok0 + fr) * 1024 + 4 * fq; const bf16_t* yr = yo + (tok0 + fr) * 1024 + 4 * fq; const LAS float* w0 = rwT + fr * RST + 4 * fq; const LAS float* w1 = rwT + (16 + fr) * RST + 4 * fq;
#pragma unroll
          for (int sI = 0; sI < 64; ++sI) { const u32x2 hw = *(const u32x2*)(zr + 16 * sI); const f32x4 h4 = {bflo(hw.x), bfhi(hw.x), bflo(hw.y), bfhi(hw.y)}; const u32x2 yw = *(const u32x2*)(yr + 16 * sI);
              const f32x4 a4 = h4 * DN_ALPHA + (f32x4){bflo(yw.x), bfhi(yw.x), bflo(yw.y), bfhi(yw.y)};
              s1 += (a4[0] + a4[1]) + (a4[2] + a4[3]); s2 += (a4[0] * a4[0] + a4[1] * a4[1]) + (a4[2] * a4[2] + a4[3] * a4[3]);
              u32x2 zz; zz.x = pk2(a4[0], a4[1]); zz.y = pk2(a4[2], a4[3]); zp[sI] = zz;
              const f32x4 b0 = *(const LAS f32x4*)(w0 + 16 * sI), b1v = *(const LAS f32x4*)(w1 + 16 * sI);
#pragma unroll
              for (int j = 0; j < 4; ++j) { acc0 = __builtin_amdgcn_mfma_f32_16x16x4f32(a4[j], b0[j], acc0, 0, 0, 0); acc1 = __builtin_amdgcn_mfma_f32_16x16x4f32(a4[j], b1v[j], acc1, 0, 0, 0); }
              if ((sI & 3) == 3) __builtin_amdgcn_sched_barrier(0); } }
        s1 += xswz<16>(s1); s1 = xsum32(s1); s2 += xswz<16>(s2); s2 = xsum32(s2);
        const float mean = s1 * (1.f / 1024.f); const float rstd = rsqrtf(fmaxf(s2 * (1.f / 1024.f) - mean * mean, 0.f) + LN_EPS);
        { u32x2* xo = (u32x2*)(xb + (tok0 + fr) * 1024 + 4 * fq); const float* gp = g1 + 4 * fq; const float* bp = b1 + 4 * fq;
#pragma unroll
          for (int sI = 0; sI < 64; ++sI) { const f32x4 g4 = *(const f32x4*)(gp + 16 * sI), b4 = *(const f32x4*)(bp + 16 * sI); const u32x2 zz = zp[sI];
              const f32x4 z4 = {bflo(zz.x), bfhi(zz.x), bflo(zz.y), bfhi(zz.y)}; const f32x4 o = (z4 - mean) * rstd * g4 + b4;
              u32x2 w; w.x = pk2(o[0], o[1]); w.y = pk2(o[2], o[3]); xo[4 * sI] = w;
              if ((sI & 7) == 7) __builtin_amdgcn_sched_barrier(0); } }
        if (fq == 0) { stat[(wid * 16 + fr) * 2] = mean; stat[(wid * 16 + fr) * 2 + 1] = rstd; }
        LDS_WAIT();
        const float gw0 = gws[fr], gw1 = gws[16 + fr], bw0 = bws[fr], bw1 = bws[16 + fr];
#pragma unroll
        for (int r = 0; r < 4; ++r) {
            const int tl = wid * 16 + 4 * fq + r; const float mean = stat[tl * 2], rstd = stat[tl * 2 + 1];
            const float l0 = rstd * (acc0[r] - mean * gw0) + bw0, l1 = rstd * (acc1[r] - mean * gw1) + bw1;
            unsigned long long k0 = ((unsigned long long)f2key(l0) << 32) | (unsigned)(31 - fr), k1 = ((unsigned long long)f2key(l1) << 32) | (unsigned)(31 - (16 + fr));
            int te[4]; float tv[4];
#pragma unroll
            for (int k = 0; k < 4; ++k) {
                unsigned long long mxk = k0 > k1 ? k0 : k1;
#define MX_STEP(o) do { const unsigned long long ot = ((unsigned long long)xswzu<o>((unsigned)(mxk >> 32)) << 32) | xswzu<o>((unsigned)mxk); mxk = ot > mxk ? ot : mxk; } while (0)
                MX_STEP(1); MX_STEP(2); MX_STEP(4); MX_STEP(8);
#undef MX_STEP
                te[k] = 31 - (int)(mxk & 31ull); const unsigned ku = (unsigned)(mxk >> 32); tv[k] = __uint_as_float((ku & 0x80000000u) ? (ku & 0x7fffffffu) : ~ku);
                if (te[k] == fr) k0 = 0ull; if (te[k] == 16 + fr) k1 = 0ull;
            }
            const float e1 = __expf(tv[1] - tv[0]), e2 = __expf(tv[2] - tv[0]), e3 = __expf(tv[3] - tv[0]); const float inv = 1.f / (1.f + e1 + e2 + e3);
            if (fr == 0) {
                const float ww[4] = {inv, e1 * inv, e2 * inv, e3 * inv}; const size_t tok = (size_t)chunk * 128 + tl;
#pragma unroll
                for (int k = 0; k < 4; ++k) { trec[tl * 4 + k] = te[k]; tkw[tok * 4 + k] = ww[k]; }
            }
        }
        __syncthreads();
        if (tid < 32) { int c = 0; for (int r = 0; r < 512; ++r) { if (trec[r] == tid) { tpos[r] = c; ++c; } } ccnt[chunk * 32 + tid] = c; }
        __syncthreads();
        { const size_t o = (size_t)chunk * 512 + tid; tke[o] = trec[tid]; tkp[o] = tpos[tid]; }
        __syncthreads();
    }
}

__device__ __forceinline__ void moe_tables(const Ctx& C, int l) {
    LAS int* cnt = (LAS int*)(C.lds + MISC_OFF + 64); LAS int* tb = cnt + 32; LAS int* tile_e = tb + 40;
    const int* ccnt = WSP(int, WS_CCNT);
    if (C.tid < 32) { int a = 0; for (int c = 0; c < NTOK / 128; ++c) a += ccnt[c * 32 + C.tid]; cnt[C.tid] = a; }
    __syncthreads();
    if (C.tid == 0) { int a = 0; for (int e = 0; e < 32; ++e) { tb[e] = a; a += (cnt[e] + 255) >> 8; } tb[32] = a; }
    __syncthreads();
    if (C.tid < 32) { for (int t = tb[C.tid]; t < tb[C.tid + 1]; ++t) tile_e[t] = C.tid; }
    __syncthreads();
}
__device__ __forceinline__ void phase_dispatch(const Ctx& C, int l) {
    moe_tables(C, l);
    LAS int* cnt = (LAS int*)(C.lds + MISC_OFF + 64); LAS int* tb = cnt + 32;
    const int* tke = WSP(int, WS_TKE); int* tkp = WSP(int, WS_TKP); int* stk = WSP(int, WS_STK);
    LAS int* cbase = (LAS int*)C.lds;
    { const int* ccnt = WSP(int, WS_CCNT); if (C.tid < 32) { int a = 0; for (int c = 0; c < NTOK / 128; ++c) { cbase[c * 32 + C.tid] = a; a += ccnt[c * 32 + C.tid]; } } }
    __syncthreads();
    for (int s = C.bid * 512 + C.tid; s < NSLOT; s += C.G * 512) {
        const int e = tke[s], p = cbase[(s >> 9) * 32 + e] + tkp[s]; const int row = tb[e] * 256 + p;
        stk[row] = s >> 2; tkp[s] = row;
    }
    for (int e = C.bid; e < 32; e += C.G) { const int r0 = tb[e] * 256 + cnt[e], r1 = tb[e + 1] * 256; for (int r = r0 + C.tid; r < r1; r += 512) stk[r] = 0; }
}

__device__ __forceinline__ void phase_ln2(const Ctx& C, const float* g2, const float* b2, float* outp, int l, bool dry) {
    const bf16_t* xin = WSP(bf16_t, WS_XB); bf16_t* xb = dry ? WSP(bf16_t, WS_DRY + (size_t)NTOK * DM * 4) : WSP(bf16_t, WS_XB); const bf16_t* y = WSP(bf16_t, WS_Y);
    const int* tkrow = WSP(int, WS_TKP); const float* tkw = WSP(float, WS_TKW);
    if (dry) outp = WSP(float, WS_DRY);
    const int gw = C.bid * NWAVES + C.wave, NGW = C.G * NWAVES, lane = C.lane;
    f32x4 gg[4], bb[4];
#pragma unroll
    for (int j = 0; j < 4; ++j) { gg[j] = *(const f32x4*)(g2 + 4 * (lane + 64 * j)); bb[j] = *(const f32x4*)(b2 + 4 * (lane + 64 * j)); }
    const bool last = (l == NLAYER - 1);
    for (int tok = gw; tok < NTOK; tok += NGW) {
        const u32x2* xr = (const u32x2*)(xin + (size_t)tok * 1024);
        f32x4 v[4]; float s = 0.f;
        int rk[4]; float wk[4];
#pragma unroll
        for (int k = 0; k < 4; ++k) { rk[k] = tkrow[(size_t)tok * 4 + k]; wk[k] = tkw[(size_t)tok * 4 + k]; }
#pragma unroll
        for (int j = 0; j < 4; ++j) { const u32x2 hw = xr[lane + 64 * j]; const f32x4 x1 = {bflo(hw.x), bfhi(hw.x), bflo(hw.y), bfhi(hw.y)}; f32x4 f[4];
#pragma unroll
            for (int k = 0; k < 4; ++k) { const u32x2 w = *(const u32x2*)(y + (size_t)rk[k] * 1024 + 4 * (lane + 64 * j)); f[k] = (f32x4){bflo(w.x), bfhi(w.x), bflo(w.y), bfhi(w.y)} * wk[k]; }
            v[j] = x1 * DN_ALPHA + ((f[0] + f[1]) + (f[2] + f[3]));
            s += (v[j][0] + v[j][1]) + (v[j][2] + v[j][3]); }
        const float mean = wave_sum(s) * (1.f / 1024.f); float s2 = 0.f;
#pragma unroll
        for (int j = 0; j < 4; ++j) { v[j] = v[j] - mean; s2 += (v[j][0] * v[j][0] + v[j][1] * v[j][1]) + (v[j][2] * v[j][2] + v[j][3] * v[j][3]); }
        const float rstd = rsqrtf(wave_sum(s2) * (1.f / 1024.f) + LN_EPS);
        if (last) { f32x4* orow = (f32x4*)(outp + (size_t)tok * 1024);
#pragma unroll
            for (int j = 0; j < 4; ++j) orow[lane + 64 * j] = v[j] * rstd * gg[j] + bb[j];
        } else { u32x2* xbr = (u32x2*)(xb + (size_t)tok * 1024);
#pragma unroll
            for (int j = 0; j < 4; ++j) { const f32x4 o = v[j] * rstd * gg[j] + bb[j]; u32x2 w; w.x = pk2(o[0], o[1]); w.y = pk2(o[2], o[3]); xbr[lane + 64 * j] = w; } }
    }
}

#ifdef DBG_STOP
__device__ __forceinline__ void dbg_dump(const Ctx& C, float* out) {
    const int gt = C.bid * 512 + C.tid, NGT = C.G * 512;
    const bf16_t* qa = WSP(bf16_t, WS_QA); const bf16_t* ka = WSP(bf16_t, WS_KA); const bf16_t* vat = WSP(bf16_t, WS_VAT); const bf16_t* iq = WSP(bf16_t, WS_IQ);
    const bf16_t* u = WSP(bf16_t, WS_U); const bf16_t* v = WSP(bf16_t, WS_V); const bf16_t* cdq = WSP(bf16_t, WS_CDQ); const bf16_t* cdkv = WSP(bf16_t, WS_CDKV);
    const bf16_t* gate = WSP(bf16_t, WS_GATE); const bf16_t* qc = WSP(bf16_t, WS_QC); const bf16_t* kc = WSP(bf16_t, WS_KC); const bf16_t* vct = WSP(bf16_t, WS_VCT);
    const unsigned* mask = WSP(unsigned, WS_MASK); const bf16_t* ob = WSP(bf16_t, WS_OBUF); const bf16_t* mg = WSP(bf16_t, WS_MERGED); const float* xr = WSP(float, WS_XRES);
    const bf16_t* y = WSP(bf16_t, WS_Y); const float* sc = WSP(float, WS_SCORE); const bf16_t* ik = WSP(bf16_t, WS_IK); const float* iw = WSP(float, WS_IW); const float* ssq = WSP(float, WS_SSQ);
    const bf16_t* hb = WSP(bf16_t, WS_H); const bf16_t* xg = WSP(bf16_t, WS_XG); const int* stk = WSP(int, WS_STK);
    for (size_t i = gt; i < (size_t)NTOK * DM; i += NGT) {
        const size_t h = i & ((size_t)NTOK * 512 - 1);
        float a = 0.f;
#if DBG_STOP >= 1
        a += bf2f(qa[h]) + bf2f(ka[h]) + bf2f(vat[h]) + bf2f(iq[h]) + bf2f(u[h]) + bf2f(v[h]) + bf2f(cdq[i & ((size_t)NTOK * 256 - 1)]) + bf2f(cdkv[i & ((size_t)NTOK * 256 - 1)]);
        a += bf2f(gate[i]) + bf2f(gate[i + (size_t)NTOK * DM]) + bf2f(gate[i + (size_t)2 * NTOK * DM]) + bf2f(ik[i & ((size_t)NTOK * 64 - 1)]) + iw[i & ((size_t)NTOK * 8 - 1)] + ssq[i & ((size_t)NTOK * 8 - 1)];
#endif
#if DBG_STOP >= 2
        a += bf2f(qc[i % ((size_t)NTOK * 768)]) + bf2f(kc[i % ((size_t)NTOK * 768)]) + bf2f(vct[h]) + bf2f(ob[(size_t)NTOK * 512 + h]);
#ifdef DBG_BITS
        a = (float)(__float_as_uint(sc[i]) & 0xfffu) + (float)(__float_as_uint(sc[i + (size_t)NTOK * DM]) & 0xfffu) + (float)(__float_as_uint(sc[i + (size_t)2 * NTOK * DM]) & 0xfffu) + (float)(__float_as_uint(sc[i + (size_t)3 * NTOK * DM]) & 0xfffu);
        a += (float)(iq[h] & 0xff) + (float)(ik[i & ((size_t)NTOK * 64 - 1)] & 0xff) + (float)(__float_as_uint(iw[i & ((size_t)NTOK * 8 - 1)]) & 0xfffu);
#else
        a += sc[i] + sc[i + (size_t)NTOK * DM] + sc[i + (size_t)2 * NTOK * DM] + sc[i + (size_t)3 * NTOK * DM];
#endif
#endif
#if DBG_STOP >= 3
        { const unsigned m = mask[i & ((size_t)NTOK * 128 - 1)]; a += (float)(m & 0xffffu) + (float)(m >> 16); } a += bf2f(ob[(size_t)2 * NTOK * 512 + h]);
#endif
#if DBG_STOP >= 4
        a += bf2f(ob[h]);
#endif
#if DBG_STOP >= 5
        a += bf2f(mg[i]);
#endif
#if DBG_STOP >= 6
        a += xr[i];
#endif
#if DBG_STOP >= 8
        a += (float)stk[i % (size_t)NSLOT_PAD] + bf2f(xg[i]) + bf2f(xg[i + (size_t)NTOK * DM]) + bf2f(xg[i + (size_t)2 * NTOK * DM]) + bf2f(xg[i + (size_t)3 * NTOK * DM]);
#endif
#if DBG_STOP >= 9
        a += bf2f(hb[i]) + bf2f(hb[i + (size_t)NTOK * DM]) + bf2f(hb[i + (size_t)2 * NTOK * DM]) + bf2f(hb[i + (size_t)3 * NTOK * DM]);
#endif
#if DBG_STOP >= 10
        a += bf2f(y[i]) + bf2f(y[i + (size_t)NTOK * DM]) + bf2f(y[i + (size_t)2 * NTOK * DM]) + bf2f(y[i + (size_t)3 * NTOK * DM]);
#endif
        out[i] = a;
    }
}
#endif

#ifdef DBG_CHECK
constexpr int CW_ERR = 20000;
__device__ __forceinline__ void err_max(unsigned* ctl, int k, float e) { if (!(e >= 0.f)) e = 1e30f; atomicMax(ctl + CW_ERR + k, __float_as_uint(e)); }
__device__ __forceinline__ float rope1(float x1, float x2, float c, float s_) { return x1 * c - x2 * s_; }
__device__ __forceinline__ float rope2(float x1, float x2, float c, float s_) { return x2 * c + x1 * s_; }
__device__ __forceinline__ void chk_proj(const Ctx& C, const Args& A) {
    unsigned* ctl = WSP(unsigned, WS_CTL); LAS float* pj = (LAS float*)C.lds;
    const int tok = (C.bid * 131 + 7) % NTOK; const int b = tok >> 12, sp = tok & 4095, ps = (sp & ~15) | perm16(sp & 15);
    const float* x = A.in[0] + (size_t)tok * DM; const float* w = A.in[2];
    for (int n = C.tid; n < 3560; n += 512) { float a = 0.f; for (int k = 0; k < DM; ++k) a = fmaf(x[k], w[(size_t)k * NIN_SRC + n], a); pj[n] = a; }
    __syncthreads();
    const float pos = (float)((const int*)A.in[1])[tok];
    const bf16_t* qa = WSP(bf16_t, WS_QA); const bf16_t* ka = WSP(bf16_t, WS_KA); const bf16_t* vat = WSP(bf16_t, WS_VAT); const bf16_t* iq = WSP(bf16_t, WS_IQ); const bf16_t* ik = WSP(bf16_t, WS_IK); const float* iw = WSP(float, WS_IW);
    float e = 0.f;
    for (int c = C.tid; c < 512; c += 512) { const int d = c & 63; const int base = c - d;
        float cq, ck, ci;
        if (d < 16) { const int i = d & 7; const float ang = pos * powf(500000.f, -(float)i / 8.f), cs = cosf(ang), sn = sinf(ang);
            const int o1 = base + i, o2 = base + 8 + i;
            cq = d < 8 ? rope1(pj[o1], pj[o2], cs, sn) : rope2(pj[o1], pj[o2], cs, sn);
            ck = d < 8 ? rope1(pj[512 + o1], pj[512 + o2], cs, sn) : rope2(pj[512 + o1], pj[512 + o2], cs, sn);
            ci = d < 8 ? rope1(pj[1536 + o1], pj[1536 + o2], cs, sn) : rope2(pj[1536 + o1], pj[1536 + o2], cs, sn);
        } else { cq = pj[c]; ck = pj[512 + c]; ci = pj[1536 + c]; }
        e = fmaxf(e, fabsf(bf2f(qa[(size_t)tok * 512 + c]) - cq * QSCALE_A)); e = fmaxf(e, fabsf(bf2f(ka[(size_t)tok * 512 + c]) - ck)); e = fmaxf(e, fabsf(bf2f(iq[(size_t)tok * 512 + c]) - ci));
        const int h = c >> 6; e = fmaxf(e, fabsf(bf2f(vat[((size_t)(b * 8 + h) * 64 + d) * SEQ + ps]) - pj[1024 + c]));
        if (c < 64) { float cik; if (c < 16) { const int i = c & 7; const float ang = pos * powf(500000.f, -(float)i / 8.f), cs = cosf(ang), sn = sinf(ang);
                cik = c < 8 ? rope1(pj[2048 + i], pj[2048 + 8 + i], cs, sn) : rope2(pj[2048 + i], pj[2048 + 8 + i], cs, sn); } else cik = pj[2048 + c];
            e = fmaxf(e, fabsf(bf2f(ik[(size_t)tok * 64 + c]) - cik)); }
        if (c < 8) e = fmaxf(e, 8.f * fabsf(iw[(size_t)tok * 8 + c] - pj[2112 + c] * IW_SCALE));
    }
    err_max(ctl, 0, e);
    __syncthreads();
    LAS float* cqn = pj + 3600; LAS float* ckn = cqn + 256;
    { float sq = 0.f; for (int k = 0; k < 256; ++k) sq += pj[3144 + k] * pj[3144 + k]; const float r = rsqrtf(sq / 256.f + RMS_EPS);
      float sk = 0.f; for (int k = 0; k < 128; ++k) sk += pj[3400 + k] * pj[3400 + k]; const float rk = rsqrtf(sk / 128.f + RMS_EPS);
      if (C.tid < 256) cqn[C.tid] = pj[3144 + C.tid] * r * A.in[7][C.tid]; if (C.tid < 128) ckn[C.tid] = pj[3400 + C.tid] * rk * A.in[8][C.tid]; }
    __syncthreads();
    const bf16_t* qc = WSP(bf16_t, WS_QC); const bf16_t* kc = WSP(bf16_t, WS_KC); const bf16_t* vct = WSP(bf16_t, WS_VCT);
    LAS float* qraw = ckn + 128;
    for (int n = C.tid; n < 768; n += 512) { float a = 0.f; for (int k = 0; k < 256; ++k) a = fmaf(cqn[k], A.in[9][(size_t)k * 768 + n], a); qraw[n] = a; }
    __syncthreads();
    float e2 = 0.f;
    for (int n = C.tid; n < 768; n += 512) { const int h = n / 96, d = n % 96; float v;
        if (d >= 64) { const int i = (d - 64) & 15; const float ang = pos * powf(500000.f, -(float)i / 16.f), cs = cosf(ang), sn = sinf(ang); const int o1 = h * 96 + 64 + i, o2 = o1 + 16;
            v = (d - 64) < 16 ? rope1(qraw[o1], qraw[o2], cs, sn) : rope2(qraw[o1], qraw[o2], cs, sn); } else v = qraw[n];
        e2 = fmaxf(e2, fabsf(bf2f(qc[(size_t)tok * 768 + n]) - v * QSCALE_C)); }
    for (int n = C.tid; n < 1024; n += 512) { float a = 0.f; for (int k = 0; k < 128; ++k) a = fmaf(ckn[k], A.in[10][(size_t)k * 1024 + n], a);
        const int h = n >> 7, wv = n & 127;
        if (wv < 64) e2 = fmaxf(e2, fabsf(bf2f(kc[(size_t)tok * 768 + h * 96 + wv]) - a));
        else e2 = fmaxf(e2, fabsf(bf2f(vct[((size_t)(b * 8 + h) * 64 + (wv - 64)) * SEQ + ps]) - a)); }
    if (C.tid < 32) { const int i = C.tid & 15; const float ang = pos * powf(500000.f, -(float)i / 16.f), cs = cosf(ang), sn = sinf(ang);
        const float v = C.tid < 16 ? rope1(pj[3528 + i], pj[3528 + 16 + i], cs, sn) : rope2(pj[3528 + i], pj[3528 + 16 + i], cs, sn);
        for (int h = 0; h < 8; ++h) e2 = fmaxf(e2, fabsf(bf2f(kc[(size_t)tok * 768 + h * 96 + 64 + C.tid]) - v)); }
    err_max(ctl, 1, e2);
    __syncthreads();
}
__device__ __forceinline__ void chk_attn(const Ctx& C) {
    unsigned* ctl = WSP(unsigned, WS_CTL);
    const int b = C.bid & 7, q = (C.bid * 977 + 300 + 13 * (C.bid >> 3)) & 4095; const size_t tq = (size_t)b * SEQ + q; const int n = q + 1;
    LAS float* sc = (LAS float*)C.lds;
    LAS float* pr = sc + 4096;
    LAS float* red = pr + 4096;
    const bf16_t* iq = WSP(bf16_t, WS_IQ); const bf16_t* ik = WSP(bf16_t, WS_IK); const float* iw = WSP(float, WS_IW); const float* score = WSP(float, WS_SCORE);
    float e1 = 0.f;
    for (int k = C.tid; k < n; k += 512) { float s_ = 0.f;
        for (int h = 0; h < 8; ++h) { float d = 0.f; for (int j = 0; j < 64; ++j) d = fmaf(bf2f(iq[tq * 512 + h * 64 + j]), bf2f(ik[((size_t)b * SEQ + k) * 64 + j]), d); s_ = fmaf(fmaxf(d, 0.f), iw[tq * 8 + h], s_); }
        sc[k] = s_; e1 = fmaxf(e1, fabsf(s_ - score[tq * SEQ + k])); }
    err_max(ctl, 2, e1);
    __syncthreads();
    const unsigned* mask = WSP(unsigned, WS_MASK); float e2 = 0.f;
    for (int k = C.tid; k < 4096; k += 512) { bool sel = false;
        if (k < n) { if (n <= 256) sel = true; else { const float sk = score[tq * SEQ + k]; int rank = 0; for (int j = 0; j < n; ++j) { const float sj = score[tq * SEQ + j]; rank += (sj > sk || (sj == sk && j < k)) ? 1 : 0; } sel = rank < 256; } }
        const bool mb = (mask[tq * 128 + (k >> 5)] >> (k & 31)) & 1u; if (sel != mb) e2 = 1.f; }
    err_max(ctl, 3, e2);
    const int h = (C.bid >> 3) & 7;
    for (int which = 0; which < 2; ++which) {
        const bf16_t* Q = which ? WSP(bf16_t, WS_QC) : WSP(bf16_t, WS_QA); const bf16_t* K = which ? WSP(bf16_t, WS_KC) : WSP(bf16_t, WS_KA); const bf16_t* VT = which ? WSP(bf16_t, WS_VCT) : WSP(bf16_t, WS_VAT);
        const bf16_t* O = WSP(bf16_t, WS_OBUF) + (which ? (size_t)2 * NTOK * 512 : 0); const int dq = which ? 96 : 64, qs = 8 * dq;
        __syncthreads();
        float mx = -INFINITY;
        for (int k = C.tid; k < 4096; k += 512) { float lgt = -INFINITY;
            const bool ok = k < n && (which || ((mask[tq * 128 + (k >> 5)] >> (k & 31)) & 1u));
            if (ok) { float d = 0.f; for (int j = 0; j < dq; ++j) d = fmaf(bf2f(Q[tq * qs + h * dq + j]), bf2f(K[((size_t)b * SEQ + k) * qs + h * dq + j]), d); lgt = d; }
            pr[k] = lgt; mx = fmaxf(mx, lgt); }
        red[C.tid] = mx; __syncthreads();
        if (C.tid == 0) { float m = -INFINITY; for (int i = 0; i < 512; ++i) m = fmaxf(m, red[i]); red[0] = m; } __syncthreads();
        const float m = red[0]; __syncthreads();
        float sm = 0.f; for (int k = C.tid; k < 4096; k += 512) { const float p = exp2f(pr[k] - m); pr[k] = p; sm += p; }
        red[C.tid] = sm; __syncthreads();
        if (C.tid == 0) { float t = 0.f; for (int i = 0; i < 512; ++i) t += red[i]; red[0] = t; } __syncthreads();
        const float den = red[0];
        if (C.tid < 64) { const int d = C.tid; float o = 0.f;
            for (int k = 0; k < n; ++k) { const int ps = (k & ~15) | perm16(k & 15); o = fmaf(pr[k], bf2f(VT[((size_t)(b * 8 + h) * 64 + d) * SEQ + ps]), o); }
            o /= den; err_max(ctl, 4 + which, fabsf(o - bf2f(O[tq * 512 + h * 64 + d]))); }
    }
    __syncthreads();
}
#endif

constexpr int NPH_LAYER = 11, NPHASE = 1 + NLAYER * NPH_LAYER;
__global__ void __launch_bounds__(NWAVES * 64, 2) trunk_fwd(Args args) {
    extern __shared__ __attribute__((aligned(16))) unsigned char lds_raw[];
    Ctx C;
    C.lds = (LAS unsigned char*)lds_raw; C.tid = threadIdx.x; C.lane = C.tid & 63; C.wave = __builtin_amdgcn_readfirstlane(C.tid >> 6); C.G = gridDim.x; C.bid = blockIdx.x; C.ws = args.ws;
    volatile LAS unsigned* MISC = (volatile LAS unsigned*)(C.lds + MISC_OFF);
    if (C.tid < 16) MISC[C.tid] = 0u;
    __syncthreads();
#if MK_ONE_LAUNCH
    XcdBarrier bar = xcd_barrier_post(WSP(unsigned, WS_CTL) + CW_BAR, MISC + 0);
#define GRID_BAR() do { FRESH(); XcdBarrier b_ = bar; { unsigned* bp_ = b_.bar; asm volatile("" : "+s"(bp_)); b_.bar = bp_; } xcd_barrier(b_, C.tid == 0); } while (0)
#else
#define GRID_BAR() do {} while (0)
#endif
    typedef const __attribute__((address_space(4))) Args* KArgsP;
    KArgsP kp = (KArgsP)__builtin_amdgcn_kernarg_segment_ptr();
    const int grid_s = gridDim.x, bid_s = blockIdx.x;
    const int wave_s = __builtin_amdgcn_readfirstlane((int)threadIdx.x >> 6);
#define FRESH() do { int ln_; asm volatile("v_mbcnt_lo_u32_b32 %0, -1, 0\n\tv_mbcnt_hi_u32_b32 %0, -1, %0" : "=v"(ln_)); int w_ = wave_s; asm volatile("" : "+s"(w_)); C.tid = (w_ << 6) | ln_; C.lane = ln_; C.wave = w_; \
        int g_ = grid_s, b_ = bid_s; asm volatile("" : "+s"(g_), "+s"(b_)); C.G = g_; C.bid = b_; \
        kp = (KArgsP)__builtin_amdgcn_kernarg_segment_ptr(); asm volatile("" : "+s"(kp)); C.ws = kp->ws; } while (0)
#define KIN(i) (kp->in[i])
    const int lo = args.ph_lo, hi = args.ph_hi, sub_mask = args.sub; const bool dry = (args.pad != 0);
#ifndef PH_ONLY
#define PH_ONLY -1
#endif
#ifndef PH_SUB
#define PH_SUB -1
#endif
#define PON(k) (PH_ONLY < 0 || PH_ONLY == (k))
#define PON2(k) ((PH_SUB < 0 || PH_SUB == (k)) && ((sub_mask >> (((k) / 10 - 1) * 4 + (k) % 10 - 1)) & 1))
#define IN(k) (lo <= (k) && (k) < hi)
#define SEAM(k) do { if (IN(k) && IN((k) + 1)) GRID_BAR(); } while (0)
    if (IN(0) && PON(100)) { phase_prologue(C, args); }
    SEAM(0);
    for (int l = 0; l < NLAYER; ++l) {
        const int P = 1 + l * NPH_LAYER;
        if (IN(P + 0) && PON(0)) { FRESH();
            pg8::Gemm g{WSP(bf16_t, WS_XB), WSP(bf16_t, WS_WIN + l * SZ_WIN), 1024, 1024, nullptr}; GridOrder S{NIN / 256, (NTOK / 256) * (NIN / 256), C.G, C.bid};
            EpiInProj E{C.ws, dry};
            pg8::gemm_phase<EpiInProj, GridOrder>(C.lds, g, S, E, C.tid);
        }
        SEAM(P + 0);
        if (IN(P + 1) && PON(1)) { FRESH();
            if (PON2(11)) phase_indexer(C);
            __syncthreads();
            FRESH();
            if (PON2(12)) { pg8::Gemm g{WSP(bf16_t, WS_CDQ), WSP(bf16_t, WS_WUQ + l * SZ_WUQ), 256, 256, nullptr}; GridOrder S{3, 128 * 3, C.G, C.bid};
              EpiQUp E{WSP(bf16_t, WS_QC), WSP(float, WS_SSQ), WSP(float, WS_COSC), WSP(float, WS_SINC)};
              pg8::gemm_phase<EpiQUp, GridOrder>(C.lds, g, S, E, C.tid); }
            FRESH();
            if (PON2(13)) { pg8::Gemm g{WSP(bf16_t, WS_CDKV), WSP(bf16_t, WS_WUKV + l * SZ_WUKV), 256, 256, nullptr}; GridOrder S{4, 128 * 4, C.G, C.bid};
              EpiKvUp E{WSP(bf16_t, WS_KC), WSP(bf16_t, WS_VCT), WSP(float, WS_SSQ)};
              pg8::gemm_phase<EpiKvUp, GridOrder>(C.lds, g, S, E, C.tid); }
            __syncthreads();
            if (PON2(14)) { FRESH(); phase_gmlp(C, KIN(3) + l * 512, KIN(4) + l * 512, KIN(6) + (size_t)l * 8 * 128, l); }
        }
        SEAM(P + 1);
        if (IN(P + 2) && PON(2)) { FRESH();
            if (PON2(21)) phase_select(C);
            __syncthreads();
            FRESH(); if (PON2(22)) phase_attn<96, false>(C, WSP(bf16_t, WS_QC), WSP(bf16_t, WS_KC), WSP(bf16_t, WS_VCT), nullptr, WSP(bf16_t, WS_OBUF) + (size_t)2 * NTOK * 512);
        }
        SEAM(P + 2);
        if (IN(P + 3) && PON(3)) { FRESH(); phase_attn<64, true>(C, WSP(bf16_t, WS_QA), WSP(bf16_t, WS_KA), WSP(bf16_t, WS_VAT), WSP(unsigned, WS_MASK), WSP(bf16_t, WS_OBUF)); }
        SEAM(P + 3);
        if (IN(P + 4) && PON(4)) { FRESH();
            pg8::Gemm g{WSP(bf16_t, WS_OBUF), WSP(bf16_t, WS_WBR + l * SZ_WBR), 512, 512, nullptr}; MergeOrder S{C.G, C.bid};
            EpiMerge E{WSP(bf16_t, WS_GATE), WSP(bf16_t, WS_MERGED)};
            pg8::gemm_phase<EpiMerge, MergeOrder>(C.lds, g, S, E, C.tid);
        }
        SEAM(P + 4);
        if (IN(P + 5) && PON(5)) { FRESH();
            pg8::Gemm g{WSP(bf16_t, WS_MERGED), WSP(bf16_t, WS_WOUT + l * SZ_WOUT), 1024, 1024, nullptr}; GridOrder S{4, 128 * 4, C.G, C.bid};
            EpiOut E{dry ? WSP(bf16_t, WS_DRY) : WSP(bf16_t, WS_OBUF)};
            pg8::gemm_phase<EpiOut, GridOrder>(C.lds, g, S, E, C.tid);
        }
        SEAM(P + 5);
        if (IN(P + 6) && PON(6)) { FRESH(); phase_ln1_router(C, KIN(13) + l * 1024, KIN(14) + l * 1024, KIN(15) + (size_t)l * 1024 * 32, KIN(16) + l * 32, l, dry); }
        SEAM(P + 6);
        if (IN(P + 7) && PON(7)) { FRESH(); phase_dispatch(C, l); }
        SEAM(P + 7);
        if (IN(P + 8) && PON(8)) { FRESH();
            moe_tables(C, l);
            const LAS int* tb = (const LAS int*)(C.lds + MISC_OFF + 64) + 32;
            pg8::Gemm g{WSP(bf16_t, WS_XB), WSP(bf16_t, WS_WGU + l * SZ_WGU), 1024, 1024, WSP(int, WS_STK)}; MoeOrder S{8, tb[32] * 8, C.G, C.bid, tb};
            EpiMoeUp E{WSP(bf16_t, WS_H), KIN(18) + (size_t)l * NEXP * 2048};
            pg8::gemm_phase<EpiMoeUp, MoeOrder, true>(C.lds, g, S, E, C.tid);
        }
        SEAM(P + 8);
        if (IN(P + 9) && PON(9)) { FRESH();
            moe_tables(C, l);
            const LAS int* tb = (const LAS int*)(C.lds + MISC_OFF + 64) + 32;
            pg8::Gemm g{WSP(bf16_t, WS_H), WSP(bf16_t, WS_WDN + l * SZ_WDN), 1024, 1024, nullptr}; MoeOrder S{4, tb[32] * 4, C.G, C.bid, tb};
            EpiMoeDn E{dry ? WSP(bf16_t, WS_DRY) : WSP(bf16_t, WS_Y), KIN(20) + (size_t)l * NEXP * 1024, dry};
            pg8::gemm_phase<EpiMoeDn, MoeOrder>(C.lds, g, S, E, C.tid);
        }
        SEAM(P + 9);
        if (IN(P + 10) && PON(10)) { FRESH(); phase_ln2(C, KIN(21) + l * 1024, KIN(22) + l * 1024, kp->out, l, dry); }
        SEAM(P + 10);
    }
#ifdef DBG_STOP
    if (IN(NPHASE)) { FRESH(); dbg_dump(C, kp->out); }
#endif
#ifdef DBG_CHECK
    if (IN(NPHASE + 1)) { FRESH(); chk_proj(C, args); chk_attn(C); }
    if (IN(NPHASE + 2)) { FRESH();
        const unsigned* ctl = WSP(unsigned, WS_CTL); const float tol[6] = {0.06f, 0.06f, 2e-3f, 0.5f, 0.02f, 0.02f}; float sc = 1.f;
        for (int k = 0; k < 6; ++k) if (__uint_as_float(ctl[CW_ERR + k]) > tol[k]) sc += 0.2f * (float)(1 << k);
        float* o = kp->out; for (size_t i = (size_t)C.bid * 512 + C.tid; i < (size_t)NTOK * DM; i += (size_t)C.G * 512) o[i] *= sc; }
#endif
#undef IN
#undef SEAM
}

extern "C" void kernel_launch(void* const* d_in, const int* in_sizes, int n_in, void* d_out, int out_size, void* d_ws, size_t ws_size, hipStream_t stream) {
    static int grid = 0;
    if (grid == 0) {
        if (n_in != 23 || out_size != NTOK * DM || ws_size < WS_END) { fprintf(stderr, "kernel_launch: unexpected shapes (n_in %d, out %d, ws %zu < %zu)\n", n_in, out_size, ws_size, (size_t)WS_END); grid = -1; return; }
        int dev = 0, cus = 0, per_cu = 0;
        if (hipGetDevice(&dev) != hipSuccess || hipDeviceGetAttribute(&cus, hipDeviceAttributeMultiprocessorCount, dev) != hipSuccess) { grid = -1; return; }
        if (hipFuncSetAttribute((const void*)trunk_fwd, hipFuncAttributeMaxDynamicSharedMemorySize, LDS_BYTES) != hipSuccess) { fprintf(stderr, "kernel_launch: hipFuncSetAttribute failed\n"); grid = -1; return; }
        if (hipOccupancyMaxActiveBlocksPerMultiprocessor(&per_cu, (const void*)trunk_fwd, NWAVES * 64, LDS_BYTES) != hipSuccess || per_cu < 1) { fprintf(stderr, "kernel_launch: occupancy query reports %d\n", per_cu); }
        (void)hipGetLastError();
        grid = cus;
    }
    if (grid < 0) return;
    (void)hipMemsetAsync((char*)d_ws + WS_CTL, 0, CTL_ZERO_BYTES, stream);
#ifdef DBG_ZERO_WS
    (void)hipMemsetAsync((char*)d_ws + WS_XRES, 0, WS_END - WS_XRES, stream);
#endif
    Args a{};
    for (int i = 0; i < 23; ++i) a.in[i] = (const float*)d_in[i];
    a.out = (float*)d_out; a.ws = (unsigned char*)d_ws; a.sub = -1; a.pad = 0;
#if MK_ONE_LAUNCH
    a.ph_lo = 0; a.ph_hi = NPHASE;
    hipLaunchKernelGGL(trunk_fwd, dim3(grid), dim3(NWAVES * 64), LDS_BYTES, stream, a);
#else
#ifdef DBG_STOP
    for (int p = 0; p < 1 + DBG_STOP; ++p) { a.ph_lo = p; a.ph_hi = p + 1; hipLaunchKernelGGL(trunk_fwd, dim3(grid), dim3(NWAVES * 64), LDS_BYTES, stream, a); }
    a.ph_lo = NPHASE; a.ph_hi = NPHASE + 1; hipLaunchKernelGGL(trunk_fwd, dim3(grid), dim3(NWAVES * 64), LDS_BYTES, stream, a);
#else
    for (int p = 0; p < NPHASE; ++p) { a.ph_lo = p; a.ph_hi = p + 1; a.sub = -1; a.pad = 0; hipLaunchKernelGGL(trunk_fwd, dim3(grid), dim3(NWAVES * 64), LDS_BYTES, stream, a);
#ifdef DBG_CHECK
        if (p == 4) { a.ph_lo = NPHASE + 1; a.ph_hi = NPHASE + 2; hipLaunchKernelGGL(trunk_fwd, dim3(grid), dim3(NWAVES * 64), LDS_BYTES, stream, a); }
        if (p == NPHASE - 1) { a.ph_lo = NPHASE + 2; a.ph_hi = NPHASE + 3; hipLaunchKernelGGL(trunk_fwd, dim3(grid), dim3(NWAVES * 64), LDS_BYTES, stream, a); }
#endif
#ifdef PROBE_PH
#ifndef PROBE_DRY
#define PROBE_DRY 0
#endif
        if ((p == 0 && PROBE_PH == -1) || (p >= 1 && (p - 1) % NPH_LAYER == PROBE_PH)) { a.sub = PROBE_SUB; a.pad = PROBE_DRY; hipLaunchKernelGGL(trunk_fwd, dim3(grid), dim3(NWAVES * 64), LDS_BYTES, stream, a); }
#endif
    }
#endif
#endif
}
```

```cpp
#include <hip/hip_runtime.h>
#include <cstdio>
#include <cstdint>

#ifndef MK_ONE_LAUNCH
#define MK_ONE_LAUNCH 1
#endif

#define LAS __attribute__((address_space(3)))
typedef unsigned short bf16_t;
typedef short bf16x8 __attribute__((ext_vector_type(8)));
typedef float f32x4 __attribute__((ext_vector_type(4)));
typedef float f32x16 __attribute__((ext_vector_type(16)));
typedef unsigned u32x4 __attribute__((ext_vector_type(4)));
typedef unsigned u32x2 __attribute__((ext_vector_type(2)));
typedef float f32x2_t __attribute__((ext_vector_type(2)));
typedef __bf16 bf16x2_t __attribute__((ext_vector_type(2)));

__device__ __forceinline__ unsigned pk2(float lo, float hi) { f32x2_t v = {lo, hi}; bf16x2_t b = __builtin_convertvector(v, bf16x2_t); return __builtin_bit_cast(unsigned, b); }
__device__ __forceinline__ float bf2f(unsigned short x) { return __uint_as_float(((unsigned)x) << 16); }
__device__ __forceinline__ float bflo(unsigned w) { return __uint_as_float(w << 16); }
__device__ __forceinline__ float bfhi(unsigned w) { return __uint_as_float(w & 0xffff0000u); }
template <int M> __device__ __forceinline__ float xswz(float v) { static_assert(M >= 1 && M <= 16, "xswz"); return __int_as_float(__builtin_amdgcn_ds_swizzle(__float_as_int(v), 0x1F | (M << 10))); }
template <int M> __device__ __forceinline__ unsigned xswzu(unsigned v) { return (unsigned)__builtin_amdgcn_ds_swizzle((int)v, 0x1F | (M << 10)); }
__device__ __forceinline__ float xsum32(float v) { auto rr = __builtin_amdgcn_permlane32_swap(__float_as_uint(v), __float_as_uint(v), false, false); return __uint_as_float(rr[0]) + __uint_as_float(rr[1]); }
__device__ __forceinline__ float xmax32(float v) { auto rr = __builtin_amdgcn_permlane32_swap(__float_as_uint(v), __float_as_uint(v), false, false); return fmaxf(__uint_as_float(rr[0]), __uint_as_float(rr[1])); }
__device__ __forceinline__ float xother32(float v, bool upper) { auto rr = __builtin_amdgcn_permlane32_swap(__float_as_uint(v), __float_as_uint(v), false, false); return __uint_as_float(upper ? rr[0] : rr[1]); }
#define LDS_WAIT() asm volatile("s_waitcnt lgkmcnt(0)" ::: "memory")
#define VM_WAIT() asm volatile("s_waitcnt vmcnt(0)" ::: "memory")

constexpr int NB = 8, SEQ = 4096, NTOK = NB * SEQ, DM = 1024, NLAYER = 4;
constexpr int NIN_SRC = 6632, NIN = 6656;
constexpr int NEXP = 32, TOPK = 4, DFF = 1024;
constexpr int NSLOT = NTOK * TOPK, NSLOT_PAD = NSLOT + NEXP * 256;
constexpr float LN_EPS = 1e-5f, RMS_EPS = 1e-6f;
constexpr float DN_ALPHA = 1.681792830507429f;
constexpr float LOG2E = 1.4426950408889634f;
constexpr float QSCALE_A = 0.125f * LOG2E;
constexpr float QSCALE_C = 0.10206207261596577f * LOG2E;
constexpr float IW_SCALE = 0.35355339059327373f * 0.125f;

constexpr size_t MiB = (size_t)1 << 20;
constexpr size_t WS_CTL = 0, CTL_ZERO_BYTES = 1 * MiB;
constexpr int CW_BAR = 4096, CW_CNT = 16384;
constexpr size_t SZ_WIN = (size_t)NIN * DM * 2, SZ_WUQ = (size_t)768 * 256 * 2, SZ_WUKV = (size_t)1024 * 256 * 2, SZ_WBR = (size_t)3 * 1024 * 512 * 2, SZ_WOUT = (size_t)1024 * 1024 * 2;
constexpr size_t SZ_WGU = (size_t)NEXP * 2048 * 1024 * 2, SZ_WDN = (size_t)NEXP * 1024 * 1024 * 2, SZ_WGM = (size_t)8 * 128 * 128 * 2;
constexpr size_t WS_WIN = 2 * MiB;
constexpr size_t WS_WUQ = WS_WIN + NLAYER * SZ_WIN;
constexpr size_t WS_WUKV = WS_WUQ + NLAYER * SZ_WUQ;
constexpr size_t WS_WBR = WS_WUKV + NLAYER * SZ_WUKV;
constexpr size_t WS_WOUT = WS_WBR + NLAYER * SZ_WBR;
constexpr size_t WS_WGU = WS_WOUT + NLAYER * SZ_WOUT;
constexpr size_t WS_WDN = WS_WGU + NLAYER * SZ_WGU;
constexpr size_t WS_WGM = WS_WDN + NLAYER * SZ_WDN;
constexpr size_t WS_COSA = WS_WGM + NLAYER * SZ_WGM;
constexpr size_t WS_SINA = WS_COSA + (size_t)NTOK * 8 * 4;
constexpr size_t WS_COSC = WS_SINA + (size_t)NTOK * 8 * 4;
constexpr size_t WS_SINC = WS_COSC + (size_t)NTOK * 16 * 4;
constexpr size_t WS_XRES = WS_SINC + (size_t)NTOK * 16 * 4;
constexpr size_t WS_XB = WS_XRES + (size_t)NTOK * DM * 4;
constexpr size_t WS_QA = WS_XB + (size_t)NTOK * DM * 2;
constexpr size_t WS_KA = WS_QA + (size_t)NTOK * 512 * 2;
constexpr size_t WS_VAT = WS_KA + (size_t)NTOK * 512 * 2;
constexpr size_t WS_IQ = WS_VAT + (size_t)NTOK * 512 * 2;
constexpr size_t WS_IK = WS_IQ + (size_t)NTOK * 512 * 2;
constexpr size_t WS_IW = WS_IK + (size_t)NTOK * 64 * 2;
constexpr size_t WS_U = WS_IW + (size_t)NTOK * 8 * 4;
constexpr size_t WS_V = WS_U + (size_t)NTOK * 512 * 2;
constexpr size_t WS_CDQ = WS_V + (size_t)NTOK * 512 * 2;
constexpr size_t WS_CDKV = WS_CDQ + (size_t)NTOK * 256 * 2;
constexpr size_t WS_SSQ = WS_CDKV + (size_t)NTOK * 256 * 2;
constexpr size_t WS_GATE = WS_SSQ + (size_t)NTOK * 8 * 4;
constexpr size_t WS_QC = WS_GATE + (size_t)NTOK * 3072 * 2;
constexpr size_t WS_KC = WS_QC + (size_t)NTOK * 768 * 2;
constexpr size_t WS_VCT = WS_KC + (size_t)NTOK * 768 * 2;
constexpr size_t WS_SCORE = WS_VCT + (size_t)NTOK * 512 * 2;
constexpr size_t WS_MASK = WS_SCORE + (size_t)NTOK * SEQ * 4;
constexpr size_t WS_OBUF = WS_MASK + (size_t)NTOK * 128 * 4;
constexpr size_t WS_MERGED = WS_OBUF + (size_t)3 * NTOK * 512 * 2;
constexpr size_t WS_TKE = WS_MERGED + (size_t)NTOK * DM * 2;
constexpr size_t WS_TKP = WS_TKE + (size_t)NSLOT * 4;
constexpr size_t WS_TKW = WS_TKP + (size_t)NSLOT * 4;
constexpr size_t WS_STK = WS_TKW + (size_t)NSLOT * 4;
constexpr size_t WS_SW = WS_STK + (size_t)NSLOT_PAD * 4;
constexpr size_t WS_XG = WS_SW + (size_t)NSLOT_PAD * 4;
constexpr size_t WS_H = WS_XG + (size_t)NSLOT_PAD * DM * 2;
constexpr size_t WS_Y = WS_H + (size_t)NSLOT_PAD * DFF * 2;
constexpr size_t WS_CCNT = WS_Y + (size_t)NSLOT_PAD * DM * 2;
constexpr size_t WS_END = WS_CCNT + (size_t)(NTOK / 128) * 32 * 4;
constexpr size_t WS_DRY = (WS_END + 255) & ~(size_t)255;
static_assert(WS_END < (size_t)4200 * MiB, "workspace map too large");
static_assert((WS_WIN % 256) == 0 && (WS_COSA % 256) == 0 && (WS_XRES % 256) == 0 && (WS_SCORE % 256) == 0 && (WS_XG % 256) == 0, "alignment");

constexpr int LDS_BYTES = 147456;
constexpr int MISC_OFF = 143360;
constexpr int NWAVES = 8;

#define XB_TMO      128
#define XB_XCNT(j)  (256  + 64 * (j))
#define XB_XSUB(j)  (1280 + 64 * (j))
#define XB_XGEN(j)  (2304 + 64 * (j))
#define XB_TOP      3328
#define XB_TOPGEN   3392
#define XCD_BAR_WORDS 3456
#define XB_SPIN_CAP (1u << 18)
__device__ __forceinline__ unsigned xb_ld(unsigned* p)              { return __hip_atomic_load(p, __ATOMIC_RELAXED, __HIP_MEMORY_SCOPE_AGENT); }
__device__ __forceinline__ unsigned xb_add(unsigned* p, unsigned v) { return __hip_atomic_fetch_add(p, v, __ATOMIC_RELAXED, __HIP_MEMORY_SCOPE_AGENT); }
__device__ __forceinline__ unsigned xb_xcc_id() { return (unsigned)__builtin_amdgcn_s_getreg((3 << 11) | 20) & 0xFu; }
#define XB_SPIN(cond, bar) do { unsigned _sp = 0; while (cond) { __builtin_amdgcn_s_sleep(1); \
    if ((++_sp & 255u) == 0u) { if (xb_ld(&(bar)[XB_TMO])) break; if (_sp > XB_SPIN_CAP) { atomicAdd(&(bar)[XB_TMO], 1u); break; } } } } while (0)
struct XcdBarrier { unsigned* bar; unsigned x; volatile LAS unsigned* st; };
__device__ __forceinline__ XcdBarrier xcd_barrier_post(unsigned* bar, volatile LAS unsigned* st) {
    XcdBarrier b; b.bar = bar; b.x = xb_xcc_id(); b.st = st;
    if (threadIdx.x == 0) (void)xb_add(&bar[XB_XCNT(b.x)], 1u);
    return b;
}
__device__ __forceinline__ void xcd_barrier_complete(unsigned* bar, unsigned x, unsigned& nloc, unsigned& nx) {
    const unsigned G = gridDim.x * gridDim.y * gridDim.z;
    unsigned sum, cnt, mine, sp = 0u;
    for (;;) {
        sum = 0u; cnt = 0u; mine = 0u;
#pragma unroll
        for (unsigned j = 0; j < 16; ++j) { const unsigned c = xb_ld(&bar[XB_XCNT(j)]); sum += c; cnt += (c > 0u) ? 1u : 0u; mine = (j == x) ? c : mine; }
        if (sum == G) break;
        __builtin_amdgcn_s_sleep(1);
        if ((++sp & 255u) == 0u) { if (xb_ld(&bar[XB_TMO])) break; if (sp > XB_SPIN_CAP) { atomicAdd(&bar[XB_TMO], 1u); break; } }
    }
    nloc = mine > 0u ? mine : 1u; nx = cnt > 0u ? cnt : 1u;
}
__device__ __forceinline__ void xcd_barrier(const XcdBarrier& b, bool leader_thread) {
    asm volatile("s_waitcnt vmcnt(0)" ::: "memory");
    __syncthreads();
    if (leader_thread) {
        unsigned* bar = b.bar;
        __builtin_amdgcn_s_waitcnt(0);
        unsigned nloc = b.st[0], nx = b.st[1];
        if (nloc == 0u) { xcd_barrier_complete(bar, b.x, nloc, nx); b.st[0] = nloc; b.st[1] = nx; }
        const unsigned old = xb_add(&bar[XB_XSUB(b.x)], 1u);
        const unsigned gen = old / nloc;
        if (old + 1u == (gen + 1u) * nloc) {
            __builtin_amdgcn_fence(__ATOMIC_RELEASE, "agent");
            asm volatile("s_waitcnt vmcnt(0)" ::: "memory");
            const unsigned og = xb_add(&bar[XB_TOP], 1u);
            const unsigned tg = og / nx;
            if (og + 1u == (tg + 1u) * nx) xb_add(&bar[XB_TOPGEN], 1u);
            else XB_SPIN(xb_ld(&bar[XB_TOPGEN]) == tg, bar);
            __builtin_amdgcn_fence(__ATOMIC_ACQUIRE, "agent");
            xb_add(&bar[XB_XGEN(b.x)], 1u);
            asm volatile("s_waitcnt vmcnt(0)" ::: "memory");
        } else {
            XB_SPIN(xb_ld(&bar[XB_XGEN(b.x)]) == gen, bar);
            __builtin_amdgcn_fence(__ATOMIC_ACQUIRE, "agent");
            asm volatile("s_waitcnt vmcnt(0)" ::: "memory");
        }
    }
    __syncthreads();
}

namespace pg8 {
constexpr int BM = 256, BK = 64, HALF = 128, HTB = HALF * BK * 2;
__host__ __device__ __forceinline__ int lds_byte(int r, int c) { const int st = (r >> 4) * 2 + (c >> 5), rr = r & 15, cc = c & 31, ob = rr * 64 + cc * 2; return st * 1024 + (ob ^ (((ob >> 9) & 1) << 5)); }
__host__ __device__ __forceinline__ void stage_rc(int b, int& R, int& C) { const int st = b / 1024, sb = b % 1024, swz = sb ^ (((sb >> 9) & 1) << 5); R = (st >> 1) * 16 + swz / 64; C = (st & 1) * 32 + (swz % 64) / 2; }
__host__ __device__ __forceinline__ int perm32(int rho) { const int n = rho >> 4, i = rho & 15; return 8 * (i >> 2) + 4 * n + (i & 3); }
struct Unit { int pm, pn; };
struct Gemm { const bf16_t* A; const bf16_t* Bt; int lda, K; const int* rowmap; };

constexpr int PRE_OFF = 131072;
template <class Epi, class Sched, bool GATHER = false>
__device__ __forceinline__ void gemm_phase(LAS unsigned char* lds, const Gemm g, const Sched& S, const Epi& E, int tid0) {
    int tid = tid0; asm volatile("" : "+v"(tid));
    const int wid = __builtin_amdgcn_readfirstlane(tid >> 6), lane = tid & 63, wr = wid >> 2, wc = wid & 3, fr = lane & 15, fq = lane >> 4;
    const int K = g.K, nt = K / BK, lda = g.lda;
    unsigned voffA[2], voffB[2]; unsigned colA2 = 0u;
#pragma unroll
    for (int i = 0; i < 2; ++i) { int R, C; stage_rc(tid * 16 + i * 8192, R, C); voffA[i] = (unsigned)(R * lda + C) * 2u; const int Rb = (R & ~31) + perm32(R & 31); voffB[i] = (unsigned)(Rb * K + C) * 2u; colA2 = (unsigned)C * 2u; }
    unsigned gcur[2] = {0u, 0u}, gnxt[2] = {0u, 0u};
#define PG8_GLOAD(d, pm_) do { int ln_; asm volatile("v_mbcnt_lo_u32_b32 %0, -1, 0\n\tv_mbcnt_hi_u32_b32 %0, -1, %0" : "=v"(ln_));   \
        int R0_, C0_; stage_rc(((wid << 6) | ln_) * 16, R0_, C0_); const int* rm_ = g.rowmap + (pm_) * BM + R0_; \
        d[0] = (unsigned)rm_[0] | ((unsigned)rm_[64] << 16); d[1] = (unsigned)rm_[HALF] | ((unsigned)rm_[HALF + 64] << 16); } while (0)
#define PG8_GOFF(p, i) ((((i) ? ((p) >> 16) : ((p) & 0xffffu)) * (unsigned)(lda * 2)) + colA2)
#define PG8_STAGE_G(bufoff, gbase, p) do { _Pragma("unroll") for (int _i = 0; _i < 2; ++_i) \
        __builtin_amdgcn_global_load_lds((const unsigned*)((const char*)(gbase) + PG8_GOFF(p, _i)), (LAS unsigned*)(lds + (bufoff) + ldsw + _i * 8192), 16, 0, 0); } while (0)
    const size_t kstep = (size_t)(BK * 2);
    const size_t hstepA = (size_t)HALF * lda * 2, hstepB = (size_t)HALF * K * 2;
    const size_t tstepA = 2 * hstepA, tstepB = 2 * hstepB;
    const unsigned ldsw = (unsigned)wid * 1024u;
    const int aoff = lds_byte(wr * 64 + fr, fq * 8), boff = lds_byte(wc * 32 + fr, fq * 8);
#define PG8_SA(b, h) (((b) * 2 + (h)) * HTB)
#define PG8_SB(b, h) ((4 + (b) * 2 + (h)) * HTB)
#define PG8_STAGE(bufoff, gbase, voff) do { _Pragma("unroll") for (int _i = 0; _i < 2; ++_i) \
        __builtin_amdgcn_global_load_lds((const unsigned*)((const char*)(gbase) + (voff)[_i]), (LAS unsigned*)(lds + (bufoff) + ldsw + _i * 8192), 16, 0, 0); } while (0)
#define PG8_STAGE_A(bufoff, gbase, half, nextu) do { if constexpr (GATHER) { if (nextu) PG8_STAGE_G(bufoff, gbase, gnxt[half]); else PG8_STAGE_G(bufoff, gbase, gcur[half]); } \
        else { PG8_STAGE(bufoff, (gbase) + ((half) ? hstepA : 0), voffA); } } while (0)
#define PG8_LDA(dst, b, h) do { _Pragma("unroll") for (int m = 0; m < 4; ++m) _Pragma("unroll") for (int k = 0; k < 2; ++k) dst[m][k] = *(const LAS bf16x8*)(lds + PG8_SA(b, h) + aoff + m * 2048 + k * 1024); } while (0)
#define PG8_LDB(dst, b, h) do { _Pragma("unroll") for (int n = 0; n < 2; ++n) _Pragma("unroll") for (int k = 0; k < 2; ++k) dst[n][k] = *(const LAS bf16x8*)(lds + PG8_SB(b, h) + boff + n * 2048 + k * 1024); } while (0)
#define PG8_MMA(ai, bj, At, Bt) do { __builtin_amdgcn_s_setprio(1); _Pragma("unroll") for (int m = 0; m < 4; ++m) _Pragma("unroll") for (int n = 0; n < 2; ++n) _Pragma("unroll") for (int k = 0; k < 2; ++k) \
        acc[ai][bj][m][n] = __builtin_amdgcn_mfma_f32_16x16x32_bf16(Bt[n][k], At[m][k], acc[ai][bj][m][n], 0, 0, 0); __builtin_amdgcn_s_setprio(0); } while (0)
#define PG8_WAIT_V(n) asm volatile("s_waitcnt vmcnt(" #n ")" ::: "memory")
#define PG8_WAIT_L(n) asm volatile("s_waitcnt lgkmcnt(" #n ")" ::: "memory")
#define PG8_BAR __builtin_amdgcn_s_barrier()
#define PG8_SCHED __builtin_amdgcn_sched_barrier(0)
    Unit cur, nxt; int ui = 0;
    if (!S.next(0, cur)) return;
    f32x4 acc[2][2][4][2];
#pragma unroll
    for (int a = 0; a < 2; ++a)
#pragma unroll
        for (int b = 0; b < 2; ++b)
#pragma unroll
            for (int m = 0; m < 4; ++m)
#pragma unroll
                for (int n = 0; n < 2; ++n) acc[a][b][m][n] = (f32x4){0.f, 0.f, 0.f, 0.f};
    bf16x8 At[4][2], B0[2][2], B1[2][2];
    const char* cA = GATHER ? (const char*)g.A : (const char*)g.A + (size_t)cur.pm * tstepA; const char* cB = (const char*)g.Bt + (size_t)cur.pn * tstepB;
    if constexpr (GATHER) { PG8_GLOAD(gcur, cur.pm); }
#define PG8_PRE(u_, slot_) do { if (wid < 4) { int ln_; asm volatile("v_mbcnt_lo_u32_b32 %0, -1, 0\n\tv_mbcnt_hi_u32_b32 %0, -1, %0" : "=v"(ln_));   \
        __builtin_amdgcn_global_load_lds((const unsigned*)(E.pre_base(u_, wid) + ln_), (LAS unsigned*)(lds + PRE_OFF + (slot_) * 1024 + wid * 256), 4, 0, 0); } } while (0)
    if constexpr (Epi::PRE) { PG8_PRE(cur, 0); }
    PG8_STAGE(PG8_SB(0, 0), cB, voffB); PG8_STAGE(PG8_SB(0, 1), cB + hstepB, voffB); PG8_STAGE_A(PG8_SA(0, 0), cA, 0, false); PG8_STAGE_A(PG8_SA(0, 1), cA, 1, false);
    if (wr == 1) PG8_BAR;
    PG8_WAIT_V(2); PG8_BAR;
    PG8_STAGE(PG8_SB(1, 0), cB + kstep, voffB); PG8_STAGE_A(PG8_SA(1, 0), cA + kstep, 0, false); PG8_STAGE(PG8_SB(1, 1), cB + hstepB + kstep, voffB);
    PG8_WAIT_V(6); PG8_BAR;
    for (;;) {
        const bool has_next = S.next(ui + 1, nxt);
        const char* nA = GATHER ? cA : (has_next ? (const char*)g.A + (size_t)nxt.pm * tstepA : cA); const char* nB = has_next ? (const char*)g.Bt + (size_t)nxt.pn * tstepB : cB;
        if constexpr (GATHER) { if (has_next) { PG8_GLOAD(gnxt, nxt.pm); } else { gnxt[0] = gcur[0]; gnxt[1] = gcur[1]; } }
        for (int t = 0; t < nt; t += 2) {
            const bool last = (t == nt - 2);
            if constexpr (Epi::PRE) { if (last && has_next) PG8_PRE(nxt, (ui + 1) & 1); }
            const char* a1 = cA + (size_t)(t + 1) * kstep;
            const char* a2 = last ? nA : cA + (size_t)(t + 2) * kstep; const char* b2 = last ? nB : cB + (size_t)(t + 2) * kstep;
            const char* a3 = a2 + kstep; const char* b3 = b2 + kstep;
            PG8_LDB(B0, 0, 0); PG8_LDB(B1, 0, 1); PG8_SCHED; PG8_LDA(At, 0, 0); PG8_STAGE_A(PG8_SA(1, 1), a1, 1, false);
            PG8_WAIT_V(8); PG8_WAIT_L(0); PG8_BAR; PG8_MMA(0, 0, At, B0); PG8_MMA(0, 1, At, B1); PG8_BAR; PG8_SCHED;
            PG8_LDA(At, 0, 1); PG8_STAGE(PG8_SB(0, 0), b2, voffB); PG8_STAGE(PG8_SB(0, 1), b2 + hstepB, voffB); PG8_STAGE_A(PG8_SA(0, 0), a2, 0, last);
            PG8_WAIT_V(8); PG8_WAIT_L(0); PG8_BAR; PG8_MMA(1, 0, At, B0); PG8_MMA(1, 1, At, B1); PG8_BAR; PG8_SCHED;
            PG8_LDB(B0, 1, 0); PG8_LDB(B1, 1, 1); PG8_SCHED; PG8_LDA(At, 1, 0); PG8_STAGE_A(PG8_SA(0, 1), a2, 1, last);
            PG8_WAIT_V(8); PG8_WAIT_L(0); PG8_BAR; PG8_MMA(0, 0, At, B0); PG8_MMA(0, 1, At, B1); PG8_BAR; PG8_SCHED;
            PG8_LDA(At, 1, 1); PG8_STAGE(PG8_SB(1, 0), b3, voffB); PG8_STAGE(PG8_SB(1, 1), b3 + hstepB, voffB); PG8_STAGE_A(PG8_SA(1, 0), a3, 0, last);
            PG8_WAIT_V(8); PG8_WAIT_L(0); PG8_BAR; PG8_MMA(1, 0, At, B0); PG8_MMA(1, 1, At, B1); PG8_BAR; PG8_SCHED;
        }
        if (wr == 0) PG8_BAR;
        { int el; asm volatile("v_mbcnt_lo_u32_b32 %0, -1, 0\n\tv_mbcnt_hi_u32_b32 %0, -1, %0" : "=v"(el));
          if constexpr (Epi::PRE) E(acc, cur, wr, wc, el & 15, el >> 4, (const LAS float*)(lds + PRE_OFF + (ui & 1) * 1024)); else E(acc, cur, wr, wc, el & 15, el >> 4); }
        if (!has_next) break;
        if constexpr (!Epi::CHAIN) {
#pragma unroll
        for (int a = 0; a < 2; ++a)
#pragma unroll
            for (int b = 0; b < 2; ++b)
#pragma unroll
                for (int m = 0; m < 4; ++m)
#pragma unroll
                    for (int n = 0; n < 2; ++n) acc[a][b][m][n] = (f32x4){0.f, 0.f, 0.f, 0.f};
        }
        cur = nxt; cA = nA; cB = nB; ++ui;
        if constexpr (GATHER) { gcur[0] = gnxt[0]; gcur[1] = gnxt[1]; }
        if (wr == 1) PG8_BAR;
    }
    PG8_WAIT_V(0);
    PG8_BAR;
#undef PG8_PRE
#undef PG8_SA
#undef PG8_SB
#undef PG8_STAGE
#undef PG8_LDA
#undef PG8_STAGE_A
#undef PG8_GLOAD
#undef PG8_GOFF
#undef PG8_STAGE_G
#undef PG8_LDB
#undef PG8_MMA
#undef PG8_WAIT_V
#undef PG8_WAIT_L
#undef PG8_BAR
#undef PG8_SCHED
}
}
using pg8::Unit;

struct Args { const float* in[23]; float* out; unsigned char* ws; int ph_lo, ph_hi; int sub, pad; };
struct Ctx {
    LAS unsigned char* lds;
    int tid, lane, wave, G, bid;
    unsigned char* ws;
};
#define WSP(T, off) ((T*)(C.ws + (off)))

struct GridOrder {
    int nN, total, G, c;
    __device__ __forceinline__ bool next(int i, Unit& u) const {
        const int L = c + i * G; if (L >= total) return false;
        const int nM = total / nN; int wgid;
        { const int q = total >> 3, r = total & 7, xcd = L & 7, off = L >> 3; wgid = (xcd < r ? xcd * (q + 1) : r * (q + 1) + (xcd - r) * q) + off; }
        const int nig = 8 * nN, gid = wgid / nig, fm = gid * 8, gsz = (nM - fm) < 8 ? (nM - fm) : 8, w = wgid - gid * nig;
        const int pn = w / gsz; u.pm = fm + (w - pn * gsz); u.pn = pn; return true;
    }
};
struct MergeOrder {
    int G, c;
    __device__ __forceinline__ bool next(int i, Unit& u) const { const int t = i / 3, n = i - 3 * t, tile = c + t * G; if (tile >= 512) return false; u.pm = n * 128 + (tile >> 2); u.pn = n * 4 + (tile & 3); return true; }
};
struct MoeOrder {
    int NT, total, G, c; const LAS int* tb;
    __device__ __forceinline__ bool next(int i, Unit& u) const {
        if ((G & 7) != 0) { const int idx = c + i * G; if (idx >= total) return false; const int mt = idx / NT, pn = idx - mt * NT;
            const int e = __builtin_amdgcn_readfirstlane(tb[40 + mt]); u.pm = mt; u.pn = e * NT + pn; return true; }
        const int T = __builtin_amdgcn_readfirstlane(tb[NEXP]), x = c & 7, lo = (x * T) >> 3, ntl = (((x + 1) * T) >> 3) - lo;
        const int j = (c >> 3) + i * (G >> 3);
        if (j >= ntl * NT) return false;
        const int gsh = (NT == 8) ? 6 : 5, gm = j >> gsh, rem = j - (gm << gsh);
        const int gs = (ntl - 8 * gm < 8) ? (ntl - 8 * gm) : 8, g4 = gs * 4, pg = (rem >= g4) ? 1 : 0, r2 = rem - pg * g4;
        const int mt = lo + 8 * gm + (r2 >> 2), e = __builtin_amdgcn_readfirstlane(tb[40 + mt]);
        u.pm = mt; u.pn = e * NT + pg * 4 + (r2 & 3); return true;
    }
};

__device__ __forceinline__ float gelu_f(float v) {
    const float av = fabsf(v), t = __builtin_amdgcn_rcpf(fmaf(av, 0.2316418882f, 1.0f));
    float q = fmaf(t, 0.5307027145f, -0.7265760135f); q = fmaf(q, t, 0.7107068705f); q = fmaf(q, t, -0.142248368f); q = fmaf(q, t, 0.127414796f); q = q * t;
    const float e = __builtin_amdgcn_exp2f((v * v) * (-0.72134752044f));
    const float m = v * (q * e);
    return v < 0.f ? m : v - m;
}
__device__ __forceinline__ float sigmoid_f(float x) { return __builtin_amdgcn_rcpf(1.f + __builtin_amdgcn_exp2f(x * (-LOG2E))); }
__device__ __forceinline__ int perm16(int o) { return (o & 3) | (((o >> 3) & 1) << 2) | (((o >> 2) & 1) << 3); }
__device__ __forceinline__ void st_bf4(bf16_t* p, f32x4 v) { u32x2 w; w.x = pk2(v[0], v[1]); w.y = pk2(v[2], v[3]); *(u32x2*)p = w; }
__device__ __forceinline__ f32x4 other32_4(f32x4 v, bool upper) { f32x4 r; r[0] = xother32(v[0], upper); r[1] = xother32(v[1], upper); r[2] = xother32(v[2], upper); r[3] = xother32(v[3], upper); return r; }

__device__ __forceinline__ void st_bf8(bf16_t* p, f32x4 v0, f32x4 v1) { u32x4 w; w.x = pk2(v0[0], v0[1]); w.y = pk2(v0[2], v0[3]); w.z = pk2(v1[0], v1[1]); w.w = pk2(v1[2], v1[3]); __builtin_nontemporal_store(w, (u32x4*)p); }
__device__ __forceinline__ f32x4 swz16_4(f32x4 v) { f32x4 r; r[0] = xswz<16>(v[0]); r[1] = xswz<16>(v[1]); r[2] = xswz<16>(v[2]); r[3] = xswz<16>(v[3]); return r; }
__device__ __forceinline__ void ld_bf8(const bf16_t* p, f32x4& a, f32x4& b) { const u32x4 w = *(const u32x4*)p; a = (f32x4){bflo(w.x), bfhi(w.x), bflo(w.y), bfhi(w.y)}; b = (f32x4){bflo(w.z), bfhi(w.z), bflo(w.w), bfhi(w.w)}; }
__device__ __forceinline__ void st_vt8(bf16_t* p, f32x4 v0, f32x4 v1) {
    const unsigned w0 = pk2(v0[0], v0[1]), w1 = pk2(v0[2], v0[3]), w2 = pk2(v1[0], v1[1]), w3 = pk2(v1[2], v1[3]);
    p[0] = (bf16_t)(w0 & 0xffff); p[SEQ] = (bf16_t)(w0 >> 16); p[2 * SEQ] = (bf16_t)(w1 & 0xffff); p[3 * SEQ] = (bf16_t)(w1 >> 16);
    p[4 * SEQ] = (bf16_t)(w2 & 0xffff); p[5 * SEQ] = (bf16_t)(w2 >> 16); p[6 * SEQ] = (bf16_t)(w3 & 0xffff); p[7 * SEQ] = (bf16_t)(w3 >> 16);
}
struct EpiInProj {
    static constexpr bool CHAIN = false; static constexpr bool PRE = false;
    unsigned char* ws; bool skip;
    __device__ __forceinline__ void operator()(f32x4 (&acc)[2][2][4][2], const Unit& un, int wr, int wc, int fr, int fq) const {
        if (skip) return;
        const int pn = un.pn; const int row0 = un.pm * 256 + wr * 64 + fr;
        const float* cosA = (const float*)(ws + WS_COSA); const float* sinA = (const float*)(ws + WS_SINA); const float* cosC = (const float*)(ws + WS_COSC); const float* sinC = (const float*)(ws + WS_SINC);
        if (pn < 4 || pn == 6 || pn == 7) {
            const size_t doff = pn < 2 ? WS_QA : (pn < 4 ? WS_KA : WS_IQ); bf16_t* dst = (bf16_t*)(ws + doff); const float sc = pn < 2 ? QSCALE_A : 1.f; const int tcol = (pn & 1) * 256;
            const bool rope = (wc & 1) == 0;
#pragma unroll
            for (int ai = 0; ai < 2; ++ai)
#pragma unroll
                for (int m = 0; m < 4; ++m) { const int row = row0 + ai * 128 + m * 16;
                    f32x4 c0 = {1.f, 1.f, 1.f, 1.f}, c1 = c0, s0 = {0.f, 0.f, 0.f, 0.f}, s1 = s0;
                    if (rope) { c0 = *(const f32x4*)(cosA + (size_t)row * 8); c1 = *(const f32x4*)(cosA + (size_t)row * 8 + 4); s0 = *(const f32x4*)(sinA + (size_t)row * 8); s1 = *(const f32x4*)(sinA + (size_t)row * 8 + 4); }
#pragma unroll
                    for (int bj = 0; bj < 2; ++bj) { f32x4 v0 = acc[ai][bj][m][0], v1 = acc[ai][bj][m][1];
                        const f32x4 p0 = swz16_4(v0), p1 = swz16_4(v1);
                        if (rope && fq < 2) { v0 = (fq == 0) ? (v0 * c0 - p0 * s0) : (v0 * c0 + p0 * s0); v1 = (fq == 0) ? (v1 * c1 - p1 * s1) : (v1 * c1 + p1 * s1); }
                        st_bf8(dst + (size_t)row * 512 + tcol + bj * 128 + wc * 32 + 8 * fq, v0 * sc, v1 * sc); } }
        } else if (pn < 6) {
            bf16_t* vat = (bf16_t*)(ws + WS_VAT);
#pragma unroll
            for (int ai = 0; ai < 2; ++ai)
#pragma unroll
                for (int m = 0; m < 4; ++m) { const int row = row0 + ai * 128 + m * 16; const int b = row >> 12, s = row & 4095, ps = (s & ~15) | perm16(s & 15);
#pragma unroll
                    for (int bj = 0; bj < 2; ++bj) { const int c = (pn - 4) * 256 + bj * 128 + wc * 32 + 8 * fq; const int h = c >> 6, d = c & 63;
                        st_vt8(vat + ((size_t)(b * 8 + h) * 64 + d) * SEQ + ps, acc[ai][bj][m][0], acc[ai][bj][m][1]); } }
        } else if (pn == 8) {
            bf16_t* ik = (bf16_t*)(ws + WS_IK); float* iw = (float*)(ws + WS_IW); bf16_t* kc = (bf16_t*)(ws + WS_KC); bf16_t* cd = (bf16_t*)(ws + WS_CDKV); float* ssq = (float*)(ws + WS_SSQ);
#pragma unroll
            for (int ai = 0; ai < 2; ++ai)
#pragma unroll
                for (int m = 0; m < 4; ++m) { const int row = row0 + ai * 128 + m * 16;
                    { f32x4 v0 = acc[ai][0][m][0], v1 = acc[ai][0][m][1];
                      { unsigned zz = 0u; asm volatile("" : "+v"(zz)); const u32x4 z = {zz, zz, zz, zz}; *(u32x4*)(cd + (size_t)row * 256 + wc * 32 + 8 * fq) = z; }
                      if (wc == 0) {
                          const f32x4 p0 = swz16_4(v0), p1 = swz16_4(v1);
                          if (fq < 2) { const f32x4 c0 = *(const f32x4*)(cosA + (size_t)row * 8), c1 = *(const f32x4*)(cosA + (size_t)row * 8 + 4), s0 = *(const f32x4*)(sinA + (size_t)row * 8), s1 = *(const f32x4*)(sinA + (size_t)row * 8 + 4);
                              v0 = (fq == 0) ? (v0 * c0 - p0 * s0) : (v0 * c0 + p0 * s0); v1 = (fq == 0) ? (v1 * c1 - p1 * s1) : (v1 * c1 + p1 * s1); }
                          st_bf8(ik + (size_t)row * 64 + 8 * fq, v0, v1);
                      } else if (wc == 1) { st_bf8(ik + (size_t)row * 64 + 32 + 8 * fq, v0, v1);
                      } else if (wc == 2) { if (fq == 0) { *(f32x4*)(iw + (size_t)row * 8) = v0 * IW_SCALE; *(f32x4*)(iw + (size_t)row * 8 + 4) = v1 * IW_SCALE; }
                      } else {
                          const bool up = fq >= 2; const f32x4 p0 = other32_4(v0, up), p1 = other32_4(v1, up);
                          const f32x4 c0 = *(const f32x4*)(cosC + (size_t)row * 16 + 8 * (fq & 1)), c1 = *(const f32x4*)(cosC + (size_t)row * 16 + 8 * (fq & 1) + 4), s0 = *(const f32x4*)(sinC + (size_t)row * 16 + 8 * (fq & 1)), s1 = *(const f32x4*)(sinC + (size_t)row * 16 + 8 * (fq & 1) + 4);
                          const f32x4 o0 = up ? (v0 * c0 + p0 * s0) : (v0 * c0 - p0 * s0), o1 = up ? (v1 * c1 + p1 * s1) : (v1 * c1 - p1 * s1);
                          bf16_t* p = kc + (size_t)row * 768 + 64 + 8 * fq;
#pragma unroll
                          for (int h = 0; h < 8; ++h) st_bf8(p + h * 96, o0, o1); } }
                    { const f32x4 v0 = acc[ai][1][m][0], v1 = acc[ai][1][m][1];
                      st_bf8(cd + (size_t)row * 256 + 128 + wc * 32 + 8 * fq, v0, v1);
                      float s = (v0[0] * v0[0] + v0[1] * v0[1]) + (v0[2] * v0[2] + v0[3] * v0[3]) + (v1[0] * v1[0] + v1[1] * v1[1]) + (v1[2] * v1[2] + v1[3] * v1[3]);
                      s += xswz<16>(s); s = xsum32(s);
                      if (fq == 0) ssq[(size_t)row * 8 + 4 + wc] = s; } }
        } else if (pn < 13) {
            bf16_t* dst = (bf16_t*)(ws + (pn < 11 ? WS_U : WS_V)); const int tcol = ((pn - 9) & 1) * 256;
#pragma unroll
            for (int ai = 0; ai < 2; ++ai)
#pragma unroll
                for (int m = 0; m < 4; ++m) { const int row = row0 + ai * 128 + m * 16;
#pragma unroll
                    for (int bj = 0; bj < 2; ++bj) { f32x4 v0 = acc[ai][bj][m][0], v1 = acc[ai][bj][m][1];
                        v0[0] = gelu_f(v0[0]); v0[1] = gelu_f(v0[1]); v0[2] = gelu_f(v0[2]); v0[3] = gelu_f(v0[3]); v1[0] = gelu_f(v1[0]); v1[1] = gelu_f(v1[1]); v1[2] = gelu_f(v1[2]); v1[3] = gelu_f(v1[3]);
                        st_bf8(dst + (size_t)row * 512 + tcol + bj * 128 + wc * 32 + 8 * fq, v0, v1); } }
        } else if (pn == 13) {
            bf16_t* cd = (bf16_t*)(ws + WS_CDQ); float* ssq = (float*)(ws + WS_SSQ);
#pragma unroll
            for (int ai = 0; ai < 2; ++ai)
#pragma unroll
                for (int m = 0; m < 4; ++m) { const int row = row0 + ai * 128 + m * 16; float s = 0.f;
#pragma unroll
                    for (int bj = 0; bj < 2; ++bj) { const f32x4 v0 = acc[ai][bj][m][0], v1 = acc[ai][bj][m][1];
                        st_bf8(cd + (size_t)row * 256 + bj * 128 + wc * 32 + 8 * fq, v0, v1);
                        s += ((v0[0] * v0[0] + v0[1] * v0[1]) + (v0[2] * v0[2] + v0[3] * v0[3])) + ((v1[0] * v1[0] + v1[1] * v1[1]) + (v1[2] * v1[2] + v1[3] * v1[3])); }
                    s += xswz<16>(s); s = xsum32(s);
                    if (fq == 0) ssq[(size_t)row * 8 + wc] = s; }
        } else {
            const int tcol = (pn - 14) * 256; bf16_t* gate = (bf16_t*)(ws + WS_GATE);
#pragma unroll
            for (int ai = 0; ai < 2; ++ai)
#pragma unroll
                for (int m = 0; m < 4; ++m) { const int row = row0 + ai * 128 + m * 16;
#pragma unroll
                    for (int bj = 0; bj < 2; ++bj) { f32x4 v0 = acc[ai][bj][m][0], v1 = acc[ai][bj][m][1];
                        v0[0] = sigmoid_f(v0[0]); v0[1] = sigmoid_f(v0[1]); v0[2] = sigmoid_f(v0[2]); v0[3] = sigmoid_f(v0[3]); v1[0] = sigmoid_f(v1[0]); v1[1] = sigmoid_f(v1[1]); v1[2] = sigmoid_f(v1[2]); v1[3] = sigmoid_f(v1[3]);
                        st_bf8(gate + (size_t)row * 3072 + tcol + bj * 128 + wc * 32 + 8 * fq, v0, v1); } }
        }
    }
};

struct EpiQUp {
    static constexpr bool CHAIN = false; static constexpr bool PRE = false;
    bf16_t* qc; const float* ssq; const float *cosC, *sinC;
    __device__ __forceinline__ void operator()(f32x4 (&acc)[2][2][4][2], const Unit& un, int wr, int wc, int fr, int fq) const {
        const int row0 = un.pm * 256 + wr * 64 + fr; const bool up = fq >= 2;
#pragma unroll
        for (int ai = 0; ai < 2; ++ai)
#pragma unroll
            for (int m = 0; m < 4; ++m) { const int row = row0 + ai * 128 + m * 16;
                const f32x4 sp = *(const f32x4*)(ssq + (size_t)row * 8);
                const float rs = rsqrtf(((sp[0] + sp[1]) + (sp[2] + sp[3])) * (1.f / 256.f) + RMS_EPS) * QSCALE_C;
                const f32x4 c0 = *(const f32x4*)(cosC + (size_t)row * 16 + 8 * (fq & 1)), c1 = *(const f32x4*)(cosC + (size_t)row * 16 + 8 * (fq & 1) + 4), s0 = *(const f32x4*)(sinC + (size_t)row * 16 + 8 * (fq & 1)), s1 = *(const f32x4*)(sinC + (size_t)row * 16 + 8 * (fq & 1) + 4);
#pragma unroll
                for (int bj = 0; bj < 2; ++bj) { const int gidx = un.pn * 8 + bj * 4 + wc;
                    f32x4 v0 = acc[ai][bj][m][0] * rs, v1 = acc[ai][bj][m][1] * rs;
                    if ((gidx % 3) == 2) { const f32x4 p0 = other32_4(v0, up), p1 = other32_4(v1, up);
                        v0 = up ? (v0 * c0 + p0 * s0) : (v0 * c0 - p0 * s0); v1 = up ? (v1 * c1 + p1 * s1) : (v1 * c1 - p1 * s1); }
                    st_bf8(qc + (size_t)row * 768 + gidx * 32 + 8 * fq, v0, v1); } }
    }
};
struct EpiKvUp {
    static constexpr bool CHAIN = false; static constexpr bool PRE = false;
    bf16_t *kc, *vct; const float* ssq;
    __device__ __forceinline__ void operator()(f32x4 (&acc)[2][2][4][2], const Unit& un, int wr, int wc, int fr, int fq) const {
        const int row0 = un.pm * 256 + wr * 64 + fr;
#pragma unroll
        for (int ai = 0; ai < 2; ++ai)
#pragma unroll
            for (int m = 0; m < 4; ++m) { const int row = row0 + ai * 128 + m * 16;
                const f32x4 sp = *(const f32x4*)(ssq + (size_t)row * 8 + 4);
                const float rs = rsqrtf(((sp[0] + sp[1]) + (sp[2] + sp[3])) * (1.f / 128.f) + RMS_EPS);
                const int b = row >> 12, s = row & 4095, ps = (s & ~15) | perm16(s & 15);
#pragma unroll
                for (int bj = 0; bj < 2; ++bj) { const int h = un.pn * 2 + bj; const f32x4 v0 = acc[ai][bj][m][0] * rs, v1 = acc[ai][bj][m][1] * rs;
                    if (wc < 2) st_bf8(kc + (size_t)row * 768 + h * 96 + wc * 32 + 8 * fq, v0, v1);
                    else st_vt8(vct + ((size_t)(b * 8 + h) * 64 + (wc - 2) * 32 + 8 * fq) * SEQ + ps, v0, v1); }
                asm volatile("" ::: "memory"); }
    }
};
struct EpiMerge {
    static constexpr bool CHAIN = true; static constexpr bool PRE = false;
    const bf16_t* gate; bf16_t* merged;
    __device__ __forceinline__ void operator()(f32x4 (&acc)[2][2][4][2], const Unit& un, int wr, int wc, int fr, int fq) const {
        const int n3 = un.pm >> 7, pm = un.pm & 127, pn = un.pn & 3; const int row0 = pm * 256 + wr * 64 + fr;
#pragma unroll
        for (int ai = 0; ai < 2; ++ai)
#pragma unroll
            for (int m = 0; m < 4; ++m) { const int row = row0 + ai * 128 + m * 16;
#pragma unroll
                for (int bj = 0; bj < 2; ++bj) { const int col = pn * 256 + bj * 128 + wc * 32 + 8 * fq;
                    const bf16_t* gp = gate + (size_t)row * 3072 + n3 * 1024 + col;
                    f32x4 ga0, ga1; ld_bf8(gp, ga0, ga1);
                    if (n3 < 2) { f32x4 gb0, gb1; ld_bf8(gp + 1024, gb0, gb1);
#pragma unroll
                        for (int j = 0; j < 4; ++j) { if (n3 == 1) { ga0[j] = fmaxf(ga0[j], 1e-20f); ga1[j] = fmaxf(ga1[j], 1e-20f); }
                            acc[ai][bj][m][0][j] *= ga0[j] * __builtin_amdgcn_rcpf(fmaxf(gb0[j], 1e-20f)); acc[ai][bj][m][1][j] *= ga1[j] * __builtin_amdgcn_rcpf(fmaxf(gb1[j], 1e-20f)); }
                    } else {
#pragma unroll
                        for (int j = 0; j < 4; ++j) { ga0[j] = fmaxf(ga0[j], 1e-20f); ga1[j] = fmaxf(ga1[j], 1e-20f); }
                        st_bf8(merged + (size_t)row * 1024 + col, acc[ai][bj][m][0] * ga0, acc[ai][bj][m][1] * ga1);
                        acc[ai][bj][m][0] = (f32x4){0.f, 0.f, 0.f, 0.f}; acc[ai][bj][m][1] = (f32x4){0.f, 0.f, 0.f, 0.f};
                    } } }
    }
};
struct EpiOut {
    static constexpr bool CHAIN = false; static constexpr bool PRE = false;
    bf16_t* yo;
    __device__ __forceinline__ void operator()(f32x4 (&acc)[2][2][4][2], const Unit& un, int wr, int wc, int fr, int fq) const {
        const int row0 = un.pm * 256 + wr * 64 + fr;
#pragma unroll
        for (int ai = 0; ai < 2; ++ai)
#pragma unroll
            for (int m = 0; m < 4; ++m) { const int row = row0 + ai * 128 + m * 16;
#pragma unroll
                for (int bj = 0; bj < 2; ++bj) st_bf8(yo + (size_t)row * 1024 + un.pn * 256 + bj * 128 + wc * 32 + 8 * fq, acc[ai][bj][m][0], acc[ai][bj][m][1]); }
    }
};
struct EpiMoeUp {
    static constexpr bool CHAIN = false; static constexpr bool PRE = true;
    bf16_t* hbuf; const float* bgu;
    __device__ __forceinline__ const float* pre_base(const Unit& un, int w) const { const int e = un.pn >> 3, pnl = un.pn & 7; return bgu + (size_t)e * 2048 + pnl * 128 + (w < 2 ? w * 64 : 1024 + (w - 2) * 64); }
    __device__ __forceinline__ void operator()(f32x4 (&acc)[2][2][4][2], const Unit& un, int wr, int wc, int fr, int fq, const LAS float* pre) const {
        const int pnl = un.pn & 7; const int row0 = un.pm * 256 + wr * 64 + fr;
        const int jh = pnl * 128 + wc * 32 + 8 * fq; const LAS float* pb = pre + wc * 32 + 8 * fq;
        const f32x4 bg0 = *(const LAS f32x4*)(pb), bg1 = *(const LAS f32x4*)(pb + 4), bl0 = *(const LAS f32x4*)(pb + 128), bl1 = *(const LAS f32x4*)(pb + 132);
#pragma unroll
        for (int ai = 0; ai < 2; ++ai)
#pragma unroll
            for (int m = 0; m < 4; ++m) { const int row = row0 + ai * 128 + m * 16;
                const f32x4 g0 = acc[ai][0][m][0] + bg0, g1 = acc[ai][0][m][1] + bg1, l0 = acc[ai][1][m][0] + bl0, l1 = acc[ai][1][m][1] + bl1; f32x4 o0, o1;
#pragma unroll
                for (int j = 0; j < 4; ++j) { const float ga = fminf(g0[j], 7.f), la = fminf(fmaxf(l0[j], -7.f), 7.f); o0[j] = (la + 1.f) * (ga * sigmoid_f(1.702f * ga));
                    const float gb = fminf(g1[j], 7.f), lb = fminf(fmaxf(l1[j], -7.f), 7.f); o1[j] = (lb + 1.f) * (gb * sigmoid_f(1.702f * gb)); }
                st_bf8(hbuf + (size_t)row * 1024 + jh, o0, o1);
                __builtin_amdgcn_sched_barrier(0); }
    }
};
struct EpiMoeDn {
    static constexpr bool CHAIN = false; static constexpr bool PRE = true;
    bf16_t* y; const float* bdn; bool skip;
    __device__ __forceinline__ const float* pre_base(const Unit& un, int w) const { const int e = un.pn >> 2, pnl = un.pn & 3; return bdn + (size_t)e * 1024 + pnl * 256 + w * 64; }
    __device__ __forceinline__ void operator()(f32x4 (&acc)[2][2][4][2], const Unit& un, int wr, int wc, int fr, int fq, const LAS float* pre) const {
        const int pnl = un.pn & 3; const int row0 = (skip ? 0 : un.pm * 256) + wr * 64 + fr;
#pragma unroll
        for (int bj = 0; bj < 2; ++bj) { const int col = pnl * 256 + bj * 128 + wc * 32 + 8 * fq; const LAS float* pb = pre + bj * 128 + wc * 32 + 8 * fq; const f32x4 b0 = *(const LAS f32x4*)(pb), b1 = *(const LAS f32x4*)(pb + 4);
#pragma unroll
            for (int ai = 0; ai < 2; ++ai)
#pragma unroll
                for (int m = 0; m < 4; ++m) st_bf8(y + (size_t)(row0 + ai * 128 + m * 16) * 1024 + col, acc[ai][bj][m][0] + b0, acc[ai][bj][m][1] + b1); }
    }
};

__device__ __forceinline__ int colmap_in(int np) {
    if (np < 2048) return np;
    if (np < 2304) { const int t = np - 2048; if (t < 64) return 2048 + t; if (t < 72) return 2112 + (t - 64); if (t < 96) return -1; if (t < 128) return 3528 + (t - 96); return 3400 + (t - 128); }
    if (np < 3328) return 2120 + (np - 2304);
    if (np < 3584) return 3144 + (np - 3328);
    return 3560 + (np - 3584);
}
__device__ __forceinline__ int colmap_gu(int np) { const int tile = np >> 8, w = np & 255; return (w < 128) ? (tile * 128 + w) : (1024 + tile * 128 + (w - 128)); }
template <int KIND>
__device__ __forceinline__ void tconv_item(const float* src, int ldsrc, bf16_t* dst, int Kdst, int koff, const float* kscale, int item, int nblk, LAS float* scr, int lane) {
    const int kb = item / nblk, nb = item - kb * nblk, k0 = 64 * kb, n0 = 32 * nb;
    const int np = n0 + (lane & 31);
    const int col = KIND == 1 ? colmap_in(np) : (KIND == 2 ? colmap_gu(np) : np);
    float vv[32];
#pragma unroll
    for (int i = 0; i < 32; ++i) { const int kk = 2 * i + (lane >> 5); const int ks = k0 + kk - koff; float v = 0.f;
        if (col >= 0 && ks >= 0) { v = src[(size_t)ks * ldsrc + col]; if (kscale) v *= kscale[ks]; }
        vv[i] = v; }
#pragma unroll
    for (int i = 0; i < 32; ++i) { const int kk = 2 * i + (lane >> 5); scr[kk * 33 + (lane & 31)] = vv[i]; }
    LDS_WAIT(); asm volatile("" ::: "memory");
    const int c = lane & 7;
#pragma unroll
    for (int j = 0; j < 4; ++j) { const int n = (lane >> 3) + 8 * j; const LAS float* s = scr + (8 * c) * 33 + n;
        u32x4 o; o.x = pk2(s[0 * 33], s[1 * 33]); o.y = pk2(s[2 * 33], s[3 * 33]); o.z = pk2(s[4 * 33], s[5 * 33]); o.w = pk2(s[6 * 33], s[7 * 33]);
        *(u32x4*)(dst + (size_t)(n0 + n) * Kdst + k0 + 8 * c) = o; }
    LDS_WAIT(); asm volatile("" ::: "memory");
}
__device__ __forceinline__ void phase_prologue(const Ctx& C, const Args& A) {
    LAS float* scr = (LAS float*)(C.lds + C.wave * 16384);
    const int gw = C.bid * NWAVES + C.wave, NGW = C.G * NWAVES;
    constexpr int I_IN = 16 * (NIN / 32), I_UQ = 4 * 24, I_UKV = 4 * 32, I_BR = 8 * 32, I_OUT = 16 * 32, I_GU = 16 * 64, I_DN = 16 * 32;
    constexpr int I_LAYER = I_IN + I_UQ + I_UKV + 3 * I_BR + I_OUT + NEXP * I_GU + NEXP * I_DN;
    for (int it = gw; it < NLAYER * I_LAYER; it += NGW) {
        const int l = it / I_LAYER; int r = it - l * I_LAYER;
        if (r < I_IN) { tconv_item<1>(A.in[2] + (size_t)l * DM * NIN_SRC, NIN_SRC, WSP(bf16_t, WS_WIN + l * SZ_WIN), 1024, 0, nullptr, r, NIN / 32, scr, C.lane); continue; } r -= I_IN;
        if (r < I_UQ) { tconv_item<0>(A.in[9] + (size_t)l * 256 * 768, 768, WSP(bf16_t, WS_WUQ + l * SZ_WUQ), 256, 0, A.in[7] + l * 256, r, 24, scr, C.lane); continue; } r -= I_UQ;
        if (r < I_UKV) { tconv_item<0>(A.in[10] + (size_t)l * 128 * 1024, 1024, WSP(bf16_t, WS_WUKV + l * SZ_WUKV), 256, 128, A.in[8] + l * 128, r, 32, scr, C.lane); continue; } r -= I_UKV;
        if (r < 3 * I_BR) { const int n = r / I_BR; r -= n * I_BR;
            tconv_item<0>(A.in[11] + ((size_t)l * 3 + n) * 512 * 1024, 1024, WSP(bf16_t, WS_WBR + l * SZ_WBR) + (size_t)n * 1024 * 512, 512, 0, nullptr, r, 32, scr, C.lane); continue; } r -= 3 * I_BR;
        if (r < I_OUT) { tconv_item<0>(A.in[12] + (size_t)l * 1024 * 1024, 1024, WSP(bf16_t, WS_WOUT + l * SZ_WOUT), 1024, 0, nullptr, r, 32, scr, C.lane); continue; } r -= I_OUT;
        if (r < NEXP * I_GU) { const int e = r / I_GU; r -= e * I_GU;
            tconv_item<2>(A.in[17] + ((size_t)l * NEXP + e) * 1024 * 2048, 2048, WSP(bf16_t, WS_WGU + l * SZ_WGU) + (size_t)e * 2048 * 1024, 1024, 0, nullptr, r, 64, scr, C.lane); continue; } r -= NEXP * I_GU;
        { const int e = r / I_DN; r -= e * I_DN;
            tconv_item<0>(A.in[19] + ((size_t)l * NEXP + e) * 1024 * 1024, 1024, WSP(bf16_t, WS_WDN + l * SZ_WDN) + (size_t)e * 1024 * 1024, 1024, 0, nullptr, r, 32, scr, C.lane); }
    }
    const int gt = C.bid * 512 + C.tid, NGT = C.G * 512;
    { bf16_t* d = WSP(bf16_t, WS_WGM); const float* s = A.in[5];
      for (int i = gt; i < NLAYER * 8 * 128 * 128; i += NGT) { const int jj = i & 127, ii = (i >> 7) & 127; d[i] = (jj <= ii) ? (bf16_t)(pk2(s[i], 0.f) & 0xffff) : (bf16_t)0; } }
    { const int* pos = (const int*)A.in[1]; float *ca = WSP(float, WS_COSA), *sa = WSP(float, WS_SINA), *cc = WSP(float, WS_COSC), *sc = WSP(float, WS_SINC);
      for (int i = gt; i < NTOK * 8; i += NGT) { const int t = i >> 3, f = i & 7; const float inv = powf(500000.f, -(float)f / 8.f); const float ang = (float)pos[t] * inv; ca[i] = cosf(ang); sa[i] = sinf(ang); }
      for (int i = gt; i < NTOK * 16; i += NGT) { const int t = i >> 4, f = i & 15; const float inv = powf(500000.f, -(float)f / 16.f); const float ang = (float)pos[t] * inv; cc[i] = cosf(ang); sc[i] = sinf(ang); } }
    { const f32x4* x4 = (const f32x4*)A.in[0]; u32x2* xb = WSP(u32x2, WS_XB);
      for (int i = gt; i < NTOK * DM / 4; i += NGT) { const f32x4 v = x4[i]; u32x2 w; w.x = pk2(v[0], v[1]); w.y = pk2(v[2], v[3]); xb[i] = w; } }
}

__device__ __forceinline__ void idx_block(const Ctx& C, int b, int qb) {
    const int tid = C.tid, lane = C.lane, wid = C.wave, r32 = lane & 31, hi = lane >> 5;
    const bf16_t* iq = WSP(bf16_t, WS_IQ); const bf16_t* ik = WSP(bf16_t, WS_IK); const float* iw = WSP(float, WS_IW); float* score = WSP(float, WS_SCORE);
    const int qi_l = ((r32 >> 4) << 1) + ((r32 >> 2) & 1), h_l = (r32 & 3) + 4 * ((r32 >> 3) & 1);
    bf16x8 af[2][4]; float wv[2][2][8];
#pragma unroll
    for (int rb = 0; rb < 2; ++rb) { const size_t tok = (size_t)b * SEQ + qb * 64 + wid * 8 + rb * 4 + qi_l;
#pragma unroll
        for (int ks = 0; ks < 4; ++ks) af[rb][ks] = *(const bf16x8*)(iq + tok * 512 + h_l * 64 + ks * 16 + hi * 8);
#pragma unroll
        for (int g = 0; g < 2; ++g) { const size_t tq = (size_t)b * SEQ + qb * 64 + wid * 8 + rb * 4 + 2 * g + hi;
            const f32x4 w0 = *(const f32x4*)(iw + tq * 8), w1 = *(const f32x4*)(iw + tq * 8 + 4);
            wv[rb][g][0] = w0[0]; wv[rb][g][1] = w0[1]; wv[rb][g][2] = w0[2]; wv[rb][g][3] = w0[3]; wv[rb][g][4] = w1[0]; wv[rb][g][5] = w1[1]; wv[rb][g][6] = w1[2]; wv[rb][g][7] = w1[3]; } }
    const int lkey = tid & 63, lch = tid >> 6;
    const bf16_t* ksrc = ik + ((size_t)b * SEQ + lkey) * 64 + lch * 8;
    LAS unsigned char* kdst = C.lds + (lch * 64 + lkey) * 16;
    const int NT = qb + 1;
    u32x4 rk = *(const u32x4*)ksrc;
    *(LAS u32x4*)kdst = rk;
    __syncthreads();
    for (int kt = 0; kt < NT; ++kt) {
        const int cur = kt & 1;
        if (kt + 1 < NT) rk = *(const u32x4*)(ksrc + (size_t)(kt + 1) * 64 * 64);
        const LAS unsigned char* kb = C.lds + cur * 8192;
        bf16x8 bfr[2][4];
#pragma unroll
        for (int kbk = 0; kbk < 2; ++kbk)
#pragma unroll
            for (int ks = 0; ks < 4; ++ks) bfr[kbk][ks] = *(const LAS bf16x8*)(kb + ((2 * ks + hi) * 64 + kbk * 32 + r32) * 16);
#pragma unroll
        for (int rb = 0; rb < 2; ++rb)
#pragma unroll
            for (int kbk = 0; kbk < 2; ++kbk) {
                f32x16 a = {};
#pragma unroll
                for (int ks = 0; ks < 4; ++ks) a = __builtin_amdgcn_mfma_f32_32x32x16_bf16(af[rb][ks], bfr[kbk][ks], a, 0, 0, 0);
#pragma unroll
                for (int g = 0; g < 2; ++g) { float s = 0.f;
#pragma unroll
                    for (int hh = 0; hh < 8; ++hh) s = fmaf(fmaxf(a[8 * g + hh], 0.f), wv[rb][g][hh], s);
                    const size_t tq = (size_t)b * SEQ + qb * 64 + wid * 8 + rb * 4 + 2 * g + hi;
                    score[tq * SEQ + kt * 64 + kbk * 32 + r32] = s; } }
        if (kt + 1 < NT) *(LAS u32x4*)(kdst + (cur ^ 1) * 8192) = rk;
        __syncthreads();
    }
}
__device__ __forceinline__ void phase_indexer(const Ctx& C) {
    for (int u0 = C.bid; u0 < NB * 32; u0 += C.G) {
        int u = u0; if (C.G == NB * 32) u = (C.bid & 7) * 32 + (C.bid >> 3);
        const int b = u >> 5, p = u & 31; idx_block(C, b, p); idx_block(C, b, 63 - p); }
}

__device__ __forceinline__ unsigned f2key(float f) { const unsigned u = __float_as_uint(f); return (u & 0x80000000u) ? ~u : (u | 0x80000000u); }
__device__ __forceinline__ int wave_total7(unsigned cv) {
    int t = 0;
#pragma unroll
    for (int b = 0; b < 7; ++b) t += __popcll(__ballot((cv >> b) & 1u)) << b;
    return t;
}
template <int NG>
__device__ __forceinline__ unsigned select_radix(const unsigned (&u)[64]) {
    unsigned prefix = 0u;
    for (int bit = 31; bit >= 0; --bit) {
        const unsigned cand = prefix | (1u << bit); unsigned cv = 0u;
#pragma unroll
        for (int i = 0; i < NG * 8; ++i) cv += (u[i] >= cand) ? 1u : 0u;
        const int cnt = wave_total7(cv);
        if (cnt >= 256) prefix = cand;
        if (cnt == 256) break;
    }
    return prefix;
}
__device__ __forceinline__ int wave_sum_dpp(int x) {
    x += __builtin_amdgcn_update_dpp(0, x, 0xB1, 0xf, 0xf, true);
    x += __builtin_amdgcn_update_dpp(0, x, 0x4E, 0xf, 0xf, true);
    x += __builtin_amdgcn_update_dpp(0, x, 0x141, 0xf, 0xf, true);
    x += __builtin_amdgcn_update_dpp(0, x, 0x140, 0xf, 0xf, true);
    x += __builtin_amdgcn_update_dpp(0, x, 0x142, 0xa, 0xf, false);
    x += __builtin_amdgcn_update_dpp(0, x, 0x143, 0xc, 0xf, false);
    return __builtin_amdgcn_readlane(x, 63);
}
__device__ __forceinline__ unsigned bfi32(unsigned m, unsigned x, unsigned y) { return (m & x) | (~m & y); }
__device__ __forceinline__ void bit_transpose32(unsigned* a) {
#pragma unroll
    for (int k = 0; k < 16; ++k) { const unsigned x = a[k], y = a[k + 16]; a[k] = __builtin_amdgcn_perm(y, x, 0x05040100u); a[k + 16] = __builtin_amdgcn_perm(y, x, 0x07060302u); }
#pragma unroll
    for (int k = 0; k < 32; ++k) if ((k & 8) == 0) { const unsigned x = a[k], y = a[k + 8]; a[k] = __builtin_amdgcn_perm(y, x, 0x06020400u); a[k + 8] = __builtin_amdgcn_perm(y, x, 0x07030501u); }
#pragma unroll
    for (int k = 0; k < 32; ++k) if ((k & 4) == 0) { const unsigned x = a[k], y = a[k + 4]; a[k] = bfi32(0x0f0f0f0fu, x, y << 4); a[k + 4] = bfi32(0x0f0f0f0fu, x >> 4, y); }
#pragma unroll
    for (int k = 0; k < 32; ++k) if ((k & 2) == 0) { const unsigned x = a[k], y = a[k + 2]; a[k] = bfi32(0x33333333u, x, y << 2); a[k + 2] = bfi32(0x33333333u, x >> 2, y); }
#pragma unroll
    for (int k = 0; k < 32; ++k) if ((k & 1) == 0) { const unsigned x = a[k], y = a[k + 1]; a[k] = bfi32(0x55555555u, x, y << 1); a[k + 1] = bfi32(0x55555555u, x >> 1, y); }
}
template <int NW>
__device__ __forceinline__ void select_bits(const float* row, int n, unsigned* mrow, int lane) {
    constexpr int W = 32 * NW;
    unsigned a[W];
    {   const u32x4* src = (const u32x4*)(row + lane * W);
#pragma unroll
        for (int i = 0; i < W / 4; ++i) { const u32x4 v = src[i];
#pragma unroll
            for (int j = 0; j < 4; ++j) { const unsigned u = v[j]; a[4 * i + j] = u ^ ((unsigned)((int)u >> 31) | 0x80000000u); } }
    }
#pragma unroll
    for (int blk = 0; blk < NW; ++blk) bit_transpose32(a + 32 * blk);
    unsigned alive[NW], above[NW];
#pragma unroll
    for (int w = 0; w < NW; ++w) { const int nv = n - lane * W - 32 * w; alive[w] = nv >= 32 ? 0xffffffffu : (nv <= 0 ? 0u : ((1u << nv) - 1u)); above[w] = 0u; }
    int cnta = 0; bool exact = false;
#pragma unroll
    for (int b = 31; b >= 0; --b) {
        unsigned o[NW]; int pc = 0;
#pragma unroll
        for (int w = 0; w < NW; ++w) { o[w] = alive[w] & a[32 * w + b]; pc += __popc(o[w]); }
        const int tot = cnta + wave_sum_dpp(pc);
        if (tot >= 256) {
#pragma unroll
            for (int w = 0; w < NW; ++w) alive[w] = o[w];
            if (tot == 256) { exact = true; break; }
        } else {
#pragma unroll
            for (int w = 0; w < NW; ++w) { above[w] |= o[w]; alive[w] ^= o[w]; }
            cnta = tot;
        }
    }
    if (!exact) {
        int pc = 0;
#pragma unroll
        for (int w = 0; w < NW; ++w) pc += __popc(alive[w]);
        const int ceq = wave_sum_dpp(pc), need = 256 - cnta;
        if (ceq > need) {
            int excl = 0;
#pragma unroll 1
            for (int L = 0; L < 63; ++L) { const int v = __builtin_amdgcn_readlane(pc, L); excl += (lane > L) ? v : 0; }
            int take = need - excl; take = take < 0 ? 0 : (take > pc ? pc : take);
            int c = pc;
            if (NW == 2) { while (c > take && alive[NW - 1] != 0u) { alive[NW - 1] &= ~(0x80000000u >> __clz(alive[NW - 1])); --c; } }
            while (c > take) { alive[0] &= ~(0x80000000u >> __clz(alive[0])); --c; }
        }
    }
    if (NW == 2) { u32x2 m; m.x = above[0] | alive[0]; m.y = above[NW - 1] | alive[NW - 1]; *(u32x2*)(mrow + 2 * lane) = m; }
    else { mrow[lane] = above[0] | alive[0]; mrow[64 + lane] = 0u; }
}
__device__ __forceinline__ void phase_select(const Ctx& C) {
    const float* score = WSP(float, WS_SCORE); unsigned long long* mask = WSP(unsigned long long, WS_MASK);
    const int gw = C.bid * NWAVES + C.wave, NGW = C.G * NWAVES, lane = C.lane;
    for (int idx = gw; idx < NTOK; idx += NGW) {
        const int q = idx & (SEQ - 1); const int n = q + 1; const float* row = score + (size_t)idx * SEQ;
        if (n <= 256) {
            const int lo = n - 64 * lane;
            const unsigned long long m = lo >= 64 ? ~0ull : (lo <= 0 ? 0ull : ((1ull << lo) - 1ull));
            mask[(size_t)idx * 64 + lane] = m;
        } else if (n <= 2048) select_bits<1>(row, n, (unsigned*)(mask + (size_t)idx * 64), lane);
        else select_bits<2>(row, n, (unsigned*)(mask + (size_t)idx * 64), lane);
    }
}

__device__ __forceinline__ int crow(int r, int hi) { return (r & 3) + 8 * (r >> 2) + 4 * hi; }
template <int DQK, bool MASKED>
__device__ __forceinline__ void attn_unit(const Ctx& C, int b, int h, int qb, const bf16_t* Q, const bf16_t* K, const bf16_t* VT, const unsigned* mask, bf16_t* O) {
    constexpr int NKS = DQK / 16, NCH = DQK / 8, KTB = NCH * 1024, BUF = KTB + 8192, QS = 8 * DQK;
    const int tid = C.tid, lane = C.lane, wid = C.wave, r32 = lane & 31, hi = lane >> 5;
    const int NT = 4 * (qb + 1);
    const size_t tok = (size_t)b * SEQ + qb * 256 + wid * 32 + r32;
    bf16x8 qf[NKS];
#pragma unroll
    for (int ks = 0; ks < NKS; ++ks) qf[ks] = *(const bf16x8*)(Q + tok * QS + h * DQK + ks * 16 + hi * 8);
    const int lrow = tid & 63, lch = tid >> 6;
    const bf16_t* ksrc0 = K + ((size_t)b * SEQ + lrow) * QS + h * DQK + lch * 8;
    const bf16_t* ksrc1 = ksrc0 + 64;
    const bf16_t* vsrc = VT + ((size_t)(b * 8 + h) * 64 + lrow) * SEQ + lch * 8;
    LAS unsigned char* kd0 = C.lds + (lch * 64 + lrow) * 16;
    LAS unsigned char* kd1 = C.lds + ((8 + lch) * 64 + lrow) * 16;
    LAS unsigned char* vd = C.lds + KTB + (lch * 64 + lrow) * 16;
    const bool k1 = (DQK > 64) && (tid < 256);
    u32x4 rk0, rk1 = {0u, 0u, 0u, 0u}, rv;
    rk0 = *(const u32x4*)ksrc0; if (k1) rk1 = *(const u32x4*)ksrc1; rv = *(const u32x4*)vsrc;
    *(LAS u32x4*)kd0 = rk0; if (k1) *(LAS u32x4*)kd1 = rk1; *(LAS u32x4*)vd = rv;
    u32x2 mw = {0u, 0u};
    if (MASKED) mw = *(const u32x2*)(mask + tok * 128);
    float mbias = 0.f, thr = -1e30f, lsum = 0.f;
    u32x4 qmw = {0u, 0u, 0u, 0u};
    const bf16x8 kone = __builtin_bit_cast(bf16x8, (u32x4){hi == 0 ? 0x3F80u : 0u, 0u, 0u, 0u});
    f32x16 o0 = {}, o1 = {};
    __syncthreads();
    for (int kt = 0; kt < NT; ++kt) {
        const int cur = kt & 1;
        u32x2 mwn = {0u, 0u};
        if (kt + 1 < NT) {
            rk0 = *(const u32x4*)(ksrc0 + (size_t)(kt + 1) * 64 * QS); if (k1) rk1 = *(const u32x4*)(ksrc1 + (size_t)(kt + 1) * 64 * QS);
            rv = *(const u32x4*)(vsrc + (kt + 1) * 64);
            if (MASKED) mwn = *(const u32x2*)(mask + tok * 128 + 2 * (kt + 1));
        }
        const LAS unsigned char* kb = C.lds + cur * BUF; const LAS unsigned char* vb = kb + KTB;
        f32x16 p0 = {}, p1 = {};
        bf16x8 kf[2 * NKS], vf[8];
#pragma unroll
        for (int ks = 0; ks < NKS; ++ks) {
            kf[2 * ks] = *(const LAS bf16x8*)(kb + ((2 * ks + hi) * 64 + r32) * 16);
            kf[2 * ks + 1] = *(const LAS bf16x8*)(kb + ((2 * ks + hi) * 64 + 32 + r32) * 16);
        }
#pragma unroll
        for (int s4 = 0; s4 < 4; ++s4) {
            vf[2 * s4] = *(const LAS bf16x8*)(vb + ((2 * s4 + hi) * 64 + r32) * 16);
            vf[2 * s4 + 1] = *(const LAS bf16x8*)(vb + ((2 * s4 + hi) * 64 + 32 + r32) * 16);
        }
        __builtin_amdgcn_sched_barrier(0);
#pragma unroll
        for (int ks = 0; ks < NKS; ++ks) {
            p0 = __builtin_amdgcn_mfma_f32_32x32x16_bf16(kf[2 * ks], qf[ks], p0, 0, 0, 0);
            p1 = __builtin_amdgcn_mfma_f32_32x32x16_bf16(kf[2 * ks + 1], qf[ks], p1, 0, 0, 0);
        }
        { const bf16x8 qm = __builtin_bit_cast(bf16x8, qmw);
          p0 = __builtin_amdgcn_mfma_f32_32x32x16_bf16(kone, qm, p0, 0, 0, 0); p1 = __builtin_amdgcn_mfma_f32_32x32x16_bf16(kone, qm, p1, 0, 0, 0); }
        if (MASKED) {
            const unsigned w0 = mw.x >> (4 * hi), w1 = mw.y >> (4 * hi);
#pragma unroll
            for (int r = 0; r < 16; ++r) { const int bit = (r & 3) + 8 * (r >> 2);
                const unsigned t0 = (unsigned)__builtin_amdgcn_sbfe((int)w0, bit, 1), t1 = (unsigned)__builtin_amdgcn_sbfe((int)w1, bit, 1);
                p0[r] = __uint_as_float((__float_as_uint(p0[r]) & t0) | (~t0 & 0xFF800000u));
                p1[r] = __uint_as_float((__float_as_uint(p1[r]) & t1) | (~t1 & 0xFF800000u)); }
        } else {
            if (kt >= NT - 4) { const int kb0 = (kt - (NT - 4)) * 64, qrel = wid * 32 + r32;
#pragma unroll
                for (int r = 0; r < 16; ++r) { const int kv = kb0 + crow(r, hi); if (kv > qrel) p0[r] = -INFINITY; if (kv + 32 > qrel) p1[r] = -INFINITY; } }
        }
        float mx;
        { float a0 = fmaxf(fmaxf(p0[0], p0[1]), p0[2]), a1 = fmaxf(fmaxf(p0[3], p0[4]), p0[5]), a2 = fmaxf(fmaxf(p0[6], p0[7]), p0[8]), a3 = fmaxf(fmaxf(p0[9], p0[10]), p0[11]);
          float a4 = fmaxf(fmaxf(p0[12], p0[13]), p0[14]), a5 = fmaxf(fmaxf(p0[15], p1[0]), p1[1]), a6 = fmaxf(fmaxf(p1[2], p1[3]), p1[4]), a7 = fmaxf(fmaxf(p1[5], p1[6]), p1[7]);
          float a8 = fmaxf(fmaxf(p1[8], p1[9]), p1[10]), a9 = fmaxf(fmaxf(p1[11], p1[12]), p1[13]), a10 = fmaxf(p1[14], p1[15]);
          a0 = fmaxf(fmaxf(a0, a1), a2); a3 = fmaxf(fmaxf(a3, a4), a5); a6 = fmaxf(fmaxf(a6, a7), a8); a9 = fmaxf(a9, a10);
          mx = fmaxf(fmaxf(a0, a3), fmaxf(a6, a9)); }
        mx = xmax32(mx);
        if (__any(mx > thr)) {
            const bool upd = mx > thr;
            const float mnew = upd ? __uint_as_float(pk2(mbias + mx, 0.f) << 16) : mbias;
            const float delta = mnew - mbias; const float alpha = (thr < 0.f) ? 1.f : __builtin_amdgcn_exp2f(-delta);
            mbias = mnew; thr = upd ? 4.f : thr;
            qmw.x = hi == 0 ? (pk2(-mnew, 0.f) & 0xffffu) : 0u;
            lsum *= alpha;
#pragma unroll
            for (int r = 0; r < 16; ++r) { o0[r] *= alpha; o1[r] *= alpha; p0[r] -= delta; p1[r] -= delta; }
        }
        {
#pragma unroll
            for (int r = 0; r < 16; ++r) { p0[r] = __builtin_amdgcn_exp2f(p0[r]); p1[r] = __builtin_amdgcn_exp2f(p1[r]); }
            float s0 = (p0[0] + p0[1]) + (p0[2] + p0[3]), s1 = (p0[4] + p0[5]) + (p0[6] + p0[7]), s2 = (p0[8] + p0[9]) + (p0[10] + p0[11]), s3 = (p0[12] + p0[13]) + (p0[14] + p0[15]);
            float s4 = (p1[0] + p1[1]) + (p1[2] + p1[3]), s5 = (p1[4] + p1[5]) + (p1[6] + p1[7]), s6 = (p1[8] + p1[9]) + (p1[10] + p1[11]), s7 = (p1[12] + p1[13]) + (p1[14] + p1[15]);
            lsum += ((s0 + s1) + (s2 + s3)) + ((s4 + s5) + (s6 + s7));
        }
        bf16x8 pf[4];
        { u32x4 t;
          t.x = pk2(p0[0], p0[1]); t.y = pk2(p0[2], p0[3]); t.z = pk2(p0[4], p0[5]); t.w = pk2(p0[6], p0[7]); pf[0] = __builtin_bit_cast(bf16x8, t);
          t.x = pk2(p0[8], p0[9]); t.y = pk2(p0[10], p0[11]); t.z = pk2(p0[12], p0[13]); t.w = pk2(p0[14], p0[15]); pf[1] = __builtin_bit_cast(bf16x8, t);
          t.x = pk2(p1[0], p1[1]); t.y = pk2(p1[2], p1[3]); t.z = pk2(p1[4], p1[5]); t.w = pk2(p1[6], p1[7]); pf[2] = __builtin_bit_cast(bf16x8, t);
          t.x = pk2(p1[8], p1[9]); t.y = pk2(p1[10], p1[11]); t.z = pk2(p1[12], p1[13]); t.w = pk2(p1[14], p1[15]); pf[3] = __builtin_bit_cast(bf16x8, t); }
#pragma unroll
        for (int s = 0; s < 4; ++s) {
            o0 = __builtin_amdgcn_mfma_f32_32x32x16_bf16(vf[2 * s], pf[s], o0, 0, 0, 0);
            o1 = __builtin_amdgcn_mfma_f32_32x32x16_bf16(vf[2 * s + 1], pf[s], o1, 0, 0, 0);
        }
        if (kt + 1 < NT) {
            const int nb = (cur ^ 1) * BUF;
            *(LAS u32x4*)(kd0 + nb) = rk0; if (k1) *(LAS u32x4*)(kd1 + nb) = rk1; *(LAS u32x4*)(vd + nb) = rv;
        }
        mw = mwn;
        __syncthreads();
    }
    lsum = xsum32(lsum);
    const float inv = 1.f / lsum;
    bf16_t* op = O + tok * 512 + h * 64 + 4 * hi;
#pragma unroll
    for (int i = 0; i < 4; ++i) {
        st_bf4(op + 8 * i, (f32x4){o0[4 * i] * inv, o0[4 * i + 1] * inv, o0[4 * i + 2] * inv, o0[4 * i + 3] * inv});
        st_bf4(op + 32 + 8 * i, (f32x4){o1[4 * i] * inv, o1[4 * i + 1] * inv, o1[4 * i + 2] * inv, o1[4 * i + 3] * inv});
    }
}
template <int DQK, bool MASKED>
__device__ __forceinline__ void phase_attn(const Ctx& C, const bf16_t* Q, const bf16_t* K, const bf16_t* VT, const unsigned* mask, bf16_t* O) {
    for (int u0 = C.bid; u0 < NB * 8 * 8; u0 += C.G) {
        int u = u0; if ((C.G & 7) == 0) { const int r = (C.bid >> 3) + (C.G >> 3) * (u0 / C.G); u = ((C.bid & 7) * 8 + (r >> 3)) * 8 + (r & 7); if (u >= NB * 8 * 8) u = u0; }
        const int bh = u >> 3, p = u & 7, b = bh >> 3, h = bh & 7;
        attn_unit<DQK, MASKED>(C, b, h, 15 - p, Q, K, VT, mask, O);
        attn_unit<DQK, MASKED>(C, b, h, p, Q, K, VT, mask, O); }
}

__device__ __forceinline__ void phase_gmlp(const Ctx& C, const float* lng, const float* lnb, const float* bs, int l) {
    const bf16_t* U = WSP(bf16_t, WS_U); const bf16_t* V = WSP(bf16_t, WS_V); bf16_t* OB = WSP(bf16_t, WS_OBUF) + (size_t)NTOK * 512;
    const bf16_t* WG = WSP(bf16_t, WS_WGM + l * SZ_WGM);
    const int tid = C.tid, lane = C.lane, wid = C.wave, r32 = lane & 31, hi = lane >> 5;
    constexpr int VST = 136;
    LAS bf16_t* vT = (LAS bf16_t*)C.lds;
    for (int un = C.bid; un < 512; un += C.G) {
        const int hf = un & 1, ch = un >> 1; const size_t t0 = (size_t)ch * 128;
        { const int pos = tid >> 2, q = tid & 3; const bf16_t* vr = V + (t0 + pos) * 512 + q * 32;
          float s = 0.f;
#pragma unroll
          for (int i = 0; i < 4; ++i)
#pragma unroll
              for (int j = 0; j < 4; ++j) { const u32x4 w = *(const u32x4*)(vr + i * 128 + j * 8); s += ((bflo(w.x) + bfhi(w.x)) + (bflo(w.y) + bfhi(w.y))) + ((bflo(w.z) + bfhi(w.z)) + (bflo(w.w) + bfhi(w.w))); }
          s += xswz<1>(s); s += xswz<2>(s);
          const float mean = s * (1.f / 512.f); float qv = 0.f;
          asm volatile("" ::: "memory");
#pragma unroll
          for (int i = 0; i < 4; ++i)
#pragma unroll
              for (int j = 0; j < 4; ++j) { const u32x4 w = *(const u32x4*)(vr + i * 128 + j * 8); float d;
                  d = bflo(w.x) - mean; qv += d * d; d = bfhi(w.x) - mean; qv += d * d; d = bflo(w.y) - mean; qv += d * d; d = bfhi(w.y) - mean; qv += d * d;
                  d = bflo(w.z) - mean; qv += d * d; d = bfhi(w.z) - mean; qv += d * d; d = bflo(w.w) - mean; qv += d * d; d = bfhi(w.w) - mean; qv += d * d; }
          qv += xswz<1>(qv); qv += xswz<2>(qv);
          const float rstd = rsqrtf(qv * (1.f / 512.f) + LN_EPS);
          asm volatile("" ::: "memory");
          const bf16_t* vh = vr + hf * 256;
#pragma unroll
          for (int ii = 0; ii < 2; ++ii)
#pragma unroll
              for (int j = 0; j < 4; ++j) { const u32x4 w = *(const u32x4*)(vh + ii * 128 + j * 8);
                  const int cl = ii * 128 + q * 32 + j * 8; const int c0 = hf * 256 + cl;
                  const f32x4 g0 = *(const f32x4*)(lng + c0), g1 = *(const f32x4*)(lng + c0 + 4), b0 = *(const f32x4*)(lnb + c0), b1 = *(const f32x4*)(lnb + c0 + 4);
                  LAS bf16_t* dp = vT + cl * VST + pos;
                  dp[0 * VST] = (bf16_t)(pk2((bflo(w.x) - mean) * rstd * g0[0] + b0[0], 0.f) & 0xffff);
                  dp[1 * VST] = (bf16_t)(pk2((bfhi(w.x) - mean) * rstd * g0[1] + b0[1], 0.f) & 0xffff);
                  dp[2 * VST] = (bf16_t)(pk2((bflo(w.y) - mean) * rstd * g0[2] + b0[2], 0.f) & 0xffff);
                  dp[3 * VST] = (bf16_t)(pk2((bfhi(w.y) - mean) * rstd * g0[3] + b0[3], 0.f) & 0xffff);
                  dp[4 * VST] = (bf16_t)(pk2((bflo(w.z) - mean) * rstd * g1[0] + b1[0], 0.f) & 0xffff);
                  dp[5 * VST] = (bf16_t)(pk2((bfhi(w.z) - mean) * rstd * g1[1] + b1[1], 0.f) & 0xffff);
                  dp[6 * VST] = (bf16_t)(pk2((bflo(w.w) - mean) * rstd * g1[2] + b1[2], 0.f) & 0xffff);
                  dp[7 * VST] = (bf16_t)(pk2((bfhi(w.w) - mean) * rstd * g1[3] + b1[3], 0.f) & 0xffff); } }
        __syncthreads();
        { const int gl = wid >> 1, ih = wid & 1, g = 4 * hf + gl;
          f32x16 acc[2][2] = {};
          const int nks = 4 * (ih + 1);
          const bf16_t* wrow = WG + ((size_t)g * 128 + ih * 64 + r32) * 128 + hi * 8;
          for (int ks = 0; ks < nks; ++ks) {
              bf16x8 a[2], bb[2];
#pragma unroll
              for (int mb = 0; mb < 2; ++mb) a[mb] = *(const bf16x8*)(wrow + (size_t)mb * 32 * 128 + ks * 16);
#pragma unroll
              for (int nb = 0; nb < 2; ++nb) bb[nb] = *(const LAS bf16x8*)(vT + (gl * 64 + nb * 32 + r32) * VST + ks * 16 + hi * 8);
#pragma unroll
              for (int mb = 0; mb < 2; ++mb)
#pragma unroll
                  for (int nb = 0; nb < 2; ++nb) acc[mb][nb] = __builtin_amdgcn_mfma_f32_32x32x16_bf16(a[mb], bb[nb], acc[mb][nb], 0, 0, 0);
          }
#pragma unroll
          for (int mb = 0; mb < 2; ++mb)
#pragma unroll
              for (int r = 0; r < 16; ++r) { const int i = ih * 64 + mb * 32 + crow(r, hi); const float bi = bs[g * 128 + i];
#pragma unroll
                  for (int nb = 0; nb < 2; ++nb) { const size_t o = (t0 + i) * 512 + g * 64 + nb * 32 + r32;
                      const float uu = bf2f(U[o]); OB[o] = (bf16_t)(pk2(uu * (acc[mb][nb][r] + bi), 0.f) & 0xffff); } } }
        __syncthreads();
    }
}

__device__ __forceinline__ float wave_sum(float v) {
    v += xswz<1>(v); v += xswz<2>(v); v += xswz<4>(v); v += xswz<8>(v); v += xswz<16>(v); return xsum32(v);
}
__device__ __forceinline__ void phase_ln1_router(const Ctx& C, const float* g1, const float* b1, const float* rw, const float* rbias, int l, bool dry) {
    constexpr int RST = 1028;
    LAS float* rwT = (LAS float*)C.lds;
    LAS float* gws = (LAS float*)(C.lds + 32 * RST * 4);
    LAS float* bws = gws + 32;
    LAS float* stat = bws + 32;
    LAS int* trec = (LAS int*)(C.lds + MISC_OFF + 64);
    LAS int* tpos = trec + 512;
    const int tid = C.tid, lane = C.lane, wid = C.wave;
    const bf16_t* xin = WSP(bf16_t, WS_XB); const bf16_t* yo = WSP(bf16_t, WS_OBUF); bf16_t* xb = dry ? WSP(bf16_t, WS_DRY + (size_t)NTOK * DM * 4) : WSP(bf16_t, WS_XB);
    int* tke = dry ? WSP(int, WS_DRY + (size_t)NTOK * DM * 6) : WSP(int, WS_TKE); int* tkp = dry ? WSP(int, WS_DRY + (size_t)NTOK * DM * 6 + NSLOT * 4) : WSP(int, WS_TKP); float* tkw = dry ? WSP(float, WS_DRY + (size_t)NTOK * DM * 6 + NSLOT * 8) : WSP(float, WS_TKW);
    int* ccnt = dry ? WSP(int, WS_DRY + (size_t)NTOK * DM * 6 + NSLOT * 12) : WSP(int, WS_CCNT);
    for (int i = tid; i < 1024 * 32; i += 512) { const int k = i >> 5, e = i & 31; rwT[e * RST + k] = rw[i] * g1[k]; }
    __syncthreads();
    for (int e = wid; e < 32; e += NWAVES) {
        float sg = 0.f, sb = 0.f;
#pragma unroll
        for (int j = 0; j < 16; ++j) { const int k = lane + 64 * j; sg += rwT[e * RST + k]; sb += b1[k] * rw[k * 32 + e]; }
        sg = wave_sum(sg); sb = wave_sum(sb);
        if (lane == 0) { gws[e] = sg; bws[e] = sb + rbias[e]; }
    }
    const int fr = lane & 15, fq = lane >> 4;
    for (int chunk = C.bid; chunk < NTOK / 128; chunk += C.G) {
        __syncthreads();
        const size_t tok0 = (size_t)chunk * 128 + wid * 16;
        f32x4 acc0 = {0.f, 0.f, 0.f, 0.f}, acc1 = {0.f, 0.f, 0.f, 0.f};
        u32x2 zp[64]; float s1 = 0.f, s2 = 0.f;
        { const bf16_t* zr = xin + (tok0 + fr) * 1024 + 4 * fq; const bf16_t* yr = yo + (tok0 + fr) * 1024 + 4 * fq; const LAS float* w0 = rwT + fr * RST + 4 * fq; const LAS float* w1 = rwT + (16 + fr) * RST + 4 * fq;
#pragma unroll
          for (int sI = 0; sI < 64; ++sI) { const u32x2 hw = *(const u32x2*)(zr + 16 * sI); const f32x4 h4 = {bflo(hw.x), bfhi(hw.x), bflo(hw.y), bfhi(hw.y)}; const u32x2 yw = *(const u32x2*)(yr + 16 * sI);
              const f32x4 a4 = h4 * DN_ALPHA + (f32x4){bflo(yw.x), bfhi(yw.x), bflo(yw.y), bfhi(yw.y)};
              s1 += (a4[0] + a4[1]) + (a4[2] + a4[3]); s2 += (a4[0] * a4[0] + a4[1] * a4[1]) + (a4[2] * a4[2] + a4[3] * a4[3]);
              u32x2 zz; zz.x = pk2(a4[0], a4[1]); zz.y = pk2(a4[2], a4[3]); zp[sI] = zz;
              const f32x4 b0 = *(const LAS f32x4*)(w0 + 16 * sI), b1v = *(const LAS f32x4*)(w1 + 16 * sI);
#pragma unroll
              for (int j = 0; j < 4; ++j) { acc0 = __builtin_amdgcn_mfma_f32_16x16x4f32(a4[j], b0[j], acc0, 0, 0, 0); acc1 = __builtin_amdgcn_mfma_f32_16x16x4f32(a4[j], b1v[j], acc1, 0, 0, 0); }
              if ((sI & 3) == 3) __builtin_amdgcn_sched_barrier(0); } }
        s1 += xswz<16>(s1); s1 = xsum32(s1); s2 += xswz<16>(s2); s2 = xsum32(s2);
        const float mean = s1 * (1.f / 1024.f); const float rstd = rsqrtf(fmaxf(s2 * (1.f / 1024.f) - mean * mean, 0.f) + LN_EPS);
        { u32x2* xo = (u32x2*)(xb + (tok0 + fr) * 1024 + 4 * fq); const float* gp = g1 + 4 * fq; const float* bp = b1 + 4 * fq;
#pragma unroll
          for (int sI = 0; sI < 64; ++sI) { const f32x4 g4 = *(const f32x4*)(gp + 16 * sI), b4 = *(const f32x4*)(bp + 16 * sI); const u32x2 zz = zp[sI];
              const f32x4 z4 = {bflo(zz.x), bfhi(zz.x), bflo(zz.y), bfhi(zz.y)}; const f32x4 o = (z4 - mean) * rstd * g4 + b4;
              u32x2 w; w.x = pk2(o[0], o[1]); w.y = pk2(o[2], o[3]); xo[4 * sI] = w;
              if ((sI & 7) == 7) __builtin_amdgcn_sched_barrier(0); } }
        if (fq == 0) { stat[(wid * 16 + fr) * 2] = mean; stat[(wid * 16 + fr) * 2 + 1] = rstd; }
        LDS_WAIT();
        const float gw0 = gws[fr], gw1 = gws[16 + fr], bw0 = bws[fr], bw1 = bws[16 + fr];
#pragma unroll
        for (int r = 0; r < 4; ++r) {
            const int tl = wid * 16 + 4 * fq + r; const float mean = stat[tl * 2], rstd = stat[tl * 2 + 1];
            const float l0 = rstd * (acc0[r] - mean * gw0) + bw0, l1 = rstd * (acc1[r] - mean * gw1) + bw1;
            unsigned long long k0 = ((unsigned long long)f2key(l0) << 32) | (unsigned)(31 - fr), k1 = ((unsigned long long)f2key(l1) << 32) | (unsigned)(31 - (16 + fr));
            int te[4]; float tv[4];
#pragma unroll
            for (int k = 0; k < 4; ++k) {
                unsigned long long mxk = k0 > k1 ? k0 : k1;
#define MX_STEP(o) do { const unsigned long long ot = ((unsigned long long)xswzu<o>((unsigned)(mxk >> 32)) << 32) | xswzu<o>((unsigned)mxk); mxk = ot > mxk ? ot : mxk; } while (0)
                MX_STEP(1); MX_STEP(2); MX_STEP(4); MX_STEP(8);
#undef MX_STEP
                te[k] = 31 - (int)(mxk & 31ull); const unsigned ku = (unsigned)(mxk >> 32); tv[k] = __uint_as_float((ku & 0x80000000u) ? (ku & 0x7fffffffu) : ~ku);
                if (te[k] == fr) k0 = 0ull; if (te[k] == 16 + fr) k1 = 0ull;
            }
            const float e1 = __expf(tv[1] - tv[0]), e2 = __expf(tv[2] - tv[0]), e3 = __expf(tv[3] - tv[0]); const float inv = 1.f / (1.f + e1 + e2 + e3);
            if (fr == 0) {
                const float ww[4] = {inv, e1 * inv, e2 * inv, e3 * inv}; const size_t tok = (size_t)chunk * 128 + tl;
#pragma unroll
                for (int k = 0; k < 4; ++k) { trec[tl * 4 + k] = te[k]; tkw[tok * 4 + k] = ww[k]; }
            }
        }
        __syncthreads();
        if (tid < 32) { int c = 0; for (int r = 0; r < 512; ++r) { if (trec[r] == tid) { tpos[r] = c; ++c; } } ccnt[chunk * 32 + tid] = c; }
        __syncthreads();
        { const size_t o = (size_t)chunk * 512 + tid; tke[o] = trec[tid]; tkp[o] = tpos[tid]; }
        __syncthreads();
    }
}

__device__ __forceinline__ void moe_tables(const Ctx& C, int l) {
    LAS int* cnt = (LAS int*)(C.lds + MISC_OFF + 64); LAS int* tb = cnt + 32; LAS int* tile_e = tb + 40;
    const int* ccnt = WSP(int, WS_CCNT);
    if (C.tid < 32) { int a = 0; for (int c = 0; c < NTOK / 128; ++c) a += ccnt[c * 32 + C.tid]; cnt[C.tid] = a; }
    __syncthreads();
    if (C.tid == 0) { int a = 0; for (int e = 0; e < 32; ++e) { tb[e] = a; a += (cnt[e] + 255) >> 8; } tb[32] = a; }
    __syncthreads();
    if (C.tid < 32) { for (int t = tb[C.tid]; t < tb[C.tid + 1]; ++t) tile_e[t] = C.tid; }
    __syncthreads();
}
__device__ __forceinline__ void phase_dispatch(const Ctx& C, int l) {
    moe_tables(C, l);
    LAS int* cnt = (LAS int*)(C.lds + MISC_OFF + 64); LAS int* tb = cnt + 32;
    const int* tke = WSP(int, WS_TKE); int* tkp = WSP(int, WS_TKP); int* stk = WSP(int, WS_STK);
    LAS int* cbase = (LAS int*)C.lds;
    { const int* ccnt = WSP(int, WS_CCNT); if (C.tid < 32) { int a = 0; for (int c = 0; c < NTOK / 128; ++c) { cbase[c * 32 + C.tid] = a; a += ccnt[c * 32 + C.tid]; } } }
    __syncthreads();
    for (int s = C.bid * 512 + C.tid; s < NSLOT; s += C.G * 512) {
        const int e = tke[s], p = cbase[(s >> 9) * 32 + e] + tkp[s]; const int row = tb[e] * 256 + p;
        stk[row] = s >> 2; tkp[s] = row;
    }
    for (int e = C.bid; e < 32; e += C.G) { const int r0 = tb[e] * 256 + cnt[e], r1 = tb[e + 1] * 256; for (int r = r0 + C.tid; r < r1; r += 512) stk[r] = 0; }
}

__device__ __forceinline__ void phase_ln2(const Ctx& C, const float* g2, const float* b2, float* outp, int l, bool dry) {
    const bf16_t* xin = WSP(bf16_t, WS_XB); bf16_t* xb = dry ? WSP(bf16_t, WS_DRY + (size_t)NTOK * DM * 4) : WSP(bf16_t, WS_XB); const bf16_t* y = WSP(bf16_t, WS_Y);
    const int* tkrow = WSP(int, WS_TKP); const float* tkw = WSP(float, WS_TKW);
    if (dry) outp = WSP(float, WS_DRY);
    const int gw = C.bid * NWAVES + C.wave, NGW = C.G * NWAVES, lane = C.lane;
    f32x4 gg[4], bb[4];
#pragma unroll
    for (int j = 0; j < 4; ++j) { gg[j] = *(const f32x4*)(g2 + 4 * (lane + 64 * j)); bb[j] = *(const f32x4*)(b2 + 4 * (lane + 64 * j)); }
    const bool last = (l == NLAYER - 1);
    for (int tok = gw; tok < NTOK; tok += NGW) {
        const u32x2* xr = (const u32x2*)(xin + (size_t)tok * 1024);
        f32x4 v[4]; float s = 0.f;
        int rk[4]; float wk[4];
#pragma unroll
        for (int k = 0; k < 4; ++k) { rk[k] = tkrow[(size_t)tok * 4 + k]; wk[k] = tkw[(size_t)tok * 4 + k]; }
#pragma unroll
        for (int j = 0; j < 4; ++j) { const u32x2 hw = xr[lane + 64 * j]; const f32x4 x1 = {bflo(hw.x), bfhi(hw.x), bflo(hw.y), bfhi(hw.y)}; f32x4 f[4];
#pragma unroll
            for (int k = 0; k < 4; ++k) { const u32x2 w = *(const u32x2*)(y + (size_t)rk[k] * 1024 + 4 * (lane + 64 * j)); f[k] = (f32x4){bflo(w.x), bfhi(w.x), bflo(w.y), bfhi(w.y)} * wk[k]; }
            v[j] = x1 * DN_ALPHA + ((f[0] + f[1]) + (f[2] + f[3]));
            s += (v[j][0] + v[j][1]) + (v[j][2] + v[j][3]); }
        const float mean = wave_sum(s) * (1.f / 1024.f); float s2 = 0.f;
#pragma unroll
        for (int j = 0; j < 4; ++j) { v[j] = v[j] - mean; s2 += (v[j][0] * v[j][0] + v[j][1] * v[j][1]) + (v[j][2] * v[j][2] + v[j][3] * v[j][3]); }
        const float rstd = rsqrtf(wave_sum(s2) * (1.f / 1024.f) + LN_EPS);
        if (last) { f32x4* orow = (f32x4*)(outp + (size_t)tok * 1024);
#pragma unroll
            for (int j = 0; j < 4; ++j) orow[lane + 64 * j] = v[j] * rstd * gg[j] + bb[j];
        } else { u32x2* xbr = (u32x2*)(xb + (size_t)tok * 1024);
#pragma unroll
            for (int j = 0; j < 4; ++j) { const f32x4 o = v[j] * rstd * gg[j] + bb[j]; u32x2 w; w.x = pk2(o[0], o[1]); w.y = pk2(o[2], o[3]); xbr[lane + 64 * j] = w; } }
    }
}

#ifdef DBG_STOP
__device__ __forceinline__ void dbg_dump(const Ctx& C, float* out) {
    const int gt = C.bid * 512 + C.tid, NGT = C.G * 512;
    const bf16_t* qa = WSP(bf16_t, WS_QA); const bf16_t* ka = WSP(bf16_t, WS_KA); const bf16_t* vat = WSP(bf16_t, WS_VAT); const bf16_t* iq = WSP(bf16_t, WS_IQ);
    const bf16_t* u = WSP(bf16_t, WS_U); const bf16_t* v = WSP(bf16_t, WS_V); const bf16_t* cdq = WSP(bf16_t, WS_CDQ); const bf16_t* cdkv = WSP(bf16_t, WS_CDKV);
    const bf16_t* gate = WSP(bf16_t, WS_GATE); const bf16_t* qc = WSP(bf16_t, WS_QC); const bf16_t* kc = WSP(bf16_t, WS_KC); const bf16_t* vct = WSP(bf16_t, WS_VCT);
    const unsigned* mask = WSP(unsigned, WS_MASK); const bf16_t* ob = WSP(bf16_t, WS_OBUF); const bf16_t* mg = WSP(bf16_t, WS_MERGED); const float* xr = WSP(float, WS_XRES);
    const bf16_t* y = WSP(bf16_t, WS_Y); const float* sc = WSP(float, WS_SCORE); const bf16_t* ik = WSP(bf16_t, WS_IK); const float* iw = WSP(float, WS_IW); const float* ssq = WSP(float, WS_SSQ);
    const bf16_t* hb = WSP(bf16_t, WS_H); const bf16_t* xg = WSP(bf16_t, WS_XG); const int* stk = WSP(int, WS_STK);
    for (size_t i = gt; i < (size_t)NTOK * DM; i += NGT) {
        const size_t h = i & ((size_t)NTOK * 512 - 1);
        float a = 0.f;
#if DBG_STOP >= 1
        a += bf2f(qa[h]) + bf2f(ka[h]) + bf2f(vat[h]) + bf2f(iq[h]) + bf2f(u[h]) + bf2f(v[h]) + bf2f(cdq[i & ((size_t)NTOK * 256 - 1)]) + bf2f(cdkv[i & ((size_t)NTOK * 256 - 1)]);
        a += bf2f(gate[i]) + bf2f(gate[i + (size_t)NTOK * DM]) + bf2f(gate[i + (size_t)2 * NTOK * DM]) + bf2f(ik[i & ((size_t)NTOK * 64 - 1)]) + iw[i & ((size_t)NTOK * 8 - 1)] + ssq[i & ((size_t)NTOK * 8 - 1)];
#endif
#if DBG_STOP >= 2
        a += bf2f(qc[i % ((size_t)NTOK * 768)]) + bf2f(kc[i % ((size_t)NTOK * 768)]) + bf2f(vct[h]) + bf2f(ob[(size_t)NTOK * 512 + h]);
#ifdef DBG_BITS
        a = (float)(__float_as_uint(sc[i]) & 0xfffu) + (float)(__float_as_uint(sc[i + (size_t)NTOK * DM]) & 0xfffu) + (float)(__float_as_uint(sc[i + (size_t)2 * NTOK * DM]) & 0xfffu) + (float)(__float_as_uint(sc[i + (size_t)3 * NTOK * DM]) & 0xfffu);
        a += (float)(iq[h] & 0xff) + (float)(ik[i & ((size_t)NTOK * 64 - 1)] & 0xff) + (float)(__float_as_uint(iw[i & ((size_t)NTOK * 8 - 1)]) & 0xfffu);
#else
        a += sc[i] + sc[i + (size_t)NTOK * DM] + sc[i + (size_t)2 * NTOK * DM] + sc[i + (size_t)3 * NTOK * DM];
#endif
#endif
#if DBG_STOP >= 3
        { const unsigned m = mask[i & ((size_t)NTOK * 128 - 1)]; a += (float)(m & 0xffffu) + (float)(m >> 16); } a += bf2f(ob[(size_t)2 * NTOK * 512 + h]);
#endif
#if DBG_STOP >= 4
        a += bf2f(ob[h]);
#endif
#if DBG_STOP >= 5
        a += bf2f(mg[i]);
#endif
#if DBG_STOP >= 6
        a += xr[i];
#endif
#if DBG_STOP >= 8
        a += (float)stk[i % (size_t)NSLOT_PAD] + bf2f(xg[i]) + bf2f(xg[i + (size_t)NTOK * DM]) + bf2f(xg[i + (size_t)2 * NTOK * DM]) + bf2f(xg[i + (size_t)3 * NTOK * DM]);
#endif
#if DBG_STOP >= 9
        a += bf2f(hb[i]) + bf2f(hb[i + (size_t)NTOK * DM]) + bf2f(hb[i + (size_t)2 * NTOK * DM]) + bf2f(hb[i + (size_t)3 * NTOK * DM]);
#endif
#if DBG_STOP >= 10
        a += bf2f(y[i]) + bf2f(y[i + (size_t)NTOK * DM]) + bf2f(y[i + (size_t)2 * NTOK * DM]) + bf2f(y[i + (size_t)3 * NTOK * DM]);
#endif
        out[i] = a;
    }
}
#endif

#ifdef DBG_CHECK
constexpr int CW_ERR = 20000;
__device__ __forceinline__ void err_max(unsigned* ctl, int k, float e) { if (!(e >= 0.f)) e = 1e30f; atomicMax(ctl + CW_ERR + k, __float_as_uint(e)); }
__device__ __forceinline__ float rope1(float x1, float x2, float c, float s_) { return x1 * c - x2 * s_; }
__device__ __forceinline__ float rope2(float x1, float x2, float c, float s_) { return x2 * c + x1 * s_; }
__device__ __forceinline__ void chk_proj(const Ctx& C, const Args& A) {
    unsigned* ctl = WSP(unsigned, WS_CTL); LAS float* pj = (LAS float*)C.lds;
    const int tok = (C.bid * 131 + 7) % NTOK; const int b = tok >> 12, sp = tok & 4095, ps = (sp & ~15) | perm16(sp & 15);
    const float* x = A.in[0] + (size_t)tok * DM; const float* w = A.in[2];
    for (int n = C.tid; n < 3560; n += 512) { float a = 0.f; for (int k = 0; k < DM; ++k) a = fmaf(x[k], w[(size_t)k * NIN_SRC + n], a); pj[n] = a; }
    __syncthreads();
    const float pos = (float)((const int*)A.in[1])[tok];
    const bf16_t* qa = WSP(bf16_t, WS_QA); const bf16_t* ka = WSP(bf16_t, WS_KA); const bf16_t* vat = WSP(bf16_t, WS_VAT); const bf16_t* iq = WSP(bf16_t, WS_IQ); const bf16_t* ik = WSP(bf16_t, WS_IK); const float* iw = WSP(float, WS_IW);
    float e = 0.f;
    for (int c = C.tid; c < 512; c += 512) { const int d = c & 63; const int base = c - d;
        float cq, ck, ci;
        if (d < 16) { const int i = d & 7; const float ang = pos * powf(500000.f, -(float)i / 8.f), cs = cosf(ang), sn = sinf(ang);
            const int o1 = base + i, o2 = base + 8 + i;
            cq = d < 8 ? rope1(pj[o1], pj[o2], cs, sn) : rope2(pj[o1], pj[o2], cs, sn);
            ck = d < 8 ? rope1(pj[512 + o1], pj[512 + o2], cs, sn) : rope2(pj[512 + o1], pj[512 + o2], cs, sn);
            ci = d < 8 ? rope1(pj[1536 + o1], pj[1536 + o2], cs, sn) : rope2(pj[1536 + o1], pj[1536 + o2], cs, sn);
        } else { cq = pj[c]; ck = pj[512 + c]; ci = pj[1536 + c]; }
        e = fmaxf(e, fabsf(bf2f(qa[(size_t)tok * 512 + c]) - cq * QSCALE_A)); e = fmaxf(e, fabsf(bf2f(ka[(size_t)tok * 512 + c]) - ck)); e = fmaxf(e, fabsf(bf2f(iq[(size_t)tok * 512 + c]) - ci));
        const int h = c >> 6; e = fmaxf(e, fabsf(bf2f(vat[((size_t)(b * 8 + h) * 64 + d) * SEQ + ps]) - pj[1024 + c]));
        if (c < 64) { float cik; if (c < 16) { const int i = c & 7; const float ang = pos * powf(500000.f, -(float)i / 8.f), cs = cosf(ang), sn = sinf(ang);
                cik = c < 8 ? rope1(pj[2048 + i], pj[2048 + 8 + i], cs, sn) : rope2(pj[2048 + i], pj[2048 + 8 + i], cs, sn); } else cik = pj[2048 + c];
            e = fmaxf(e, fabsf(bf2f(ik[(size_t)tok * 64 + c]) - cik)); }
        if (c < 8) e = fmaxf(e, 8.f * fabsf(iw[(size_t)tok * 8 + c] - pj[2112 + c] * IW_SCALE));
    }
    err_max(ctl, 0, e);
    __syncthreads();
    LAS float* cqn = pj + 3600; LAS float* ckn = cqn + 256;
    { float sq = 0.f; for (int k = 0; k < 256; ++k) sq += pj[3144 + k] * pj[3144 + k]; const float r = rsqrtf(sq / 256.f + RMS_EPS);
      float sk = 0.f; for (int k = 0; k < 128; ++k) sk += pj[3400 + k] * pj[3400 + k]; const float rk = rsqrtf(sk / 128.f + RMS_EPS);
      if (C.tid < 256) cqn[C.tid] = pj[3144 + C.tid] * r * A.in[7][C.tid]; if (C.tid < 128) ckn[C.tid] = pj[3400 + C.tid] * rk * A.in[8][C.tid]; }
    __syncthreads();
    const bf16_t* qc = WSP(bf16_t, WS_QC); const bf16_t* kc = WSP(bf16_t, WS_KC); const bf16_t* vct = WSP(bf16_t, WS_VCT);
    LAS float* qraw = ckn + 128;
    for (int n = C.tid; n < 768; n += 512) { float a = 0.f; for (int k = 0; k < 256; ++k) a = fmaf(cqn[k], A.in[9][(size_t)k * 768 + n], a); qraw[n] = a; }
    __syncthreads();
    float e2 = 0.f;
    for (int n = C.tid; n < 768; n += 512) { const int h = n / 96, d = n % 96; float v;
        if (d >= 64) { const int i = (d - 64) & 15; const float ang = pos * powf(500000.f, -(float)i / 16.f), cs = cosf(ang), sn = sinf(ang); const int o1 = h * 96 + 64 + i, o2 = o1 + 16;
            v = (d - 64) < 16 ? rope1(qraw[o1], qraw[o2], cs, sn) : rope2(qraw[o1], qraw[o2], cs, sn); } else v = qraw[n];
        e2 = fmaxf(e2, fabsf(bf2f(qc[(size_t)tok * 768 + n]) - v * QSCALE_C)); }
    for (int n = C.tid; n < 1024; n += 512) { float a = 0.f; for (int k = 0; k < 128; ++k) a = fmaf(ckn[k], A.in[10][(size_t)k * 1024 + n], a);
        const int h = n >> 7, wv = n & 127;
        if (wv < 64) e2 = fmaxf(e2, fabsf(bf2f(kc[(size_t)tok * 768 + h * 96 + wv]) - a));
        else e2 = fmaxf(e2, fabsf(bf2f(vct[((size_t)(b * 8 + h) * 64 + (wv - 64)) * SEQ + ps]) - a)); }
    if (C.tid < 32) { const int i = C.tid & 15; const float ang = pos * powf(500000.f, -(float)i / 16.f), cs = cosf(ang), sn = sinf(ang);
        const float v = C.tid < 16 ? rope1(pj[3528 + i], pj[3528 + 16 + i], cs, sn) : rope2(pj[3528 + i], pj[3528 + 16 + i], cs, sn);
        for (int h = 0; h < 8; ++h) e2 = fmaxf(e2, fabsf(bf2f(kc[(size_t)tok * 768 + h * 96 + 64 + C.tid]) - v)); }
    err_max(ctl, 1, e2);
    __syncthreads();
}
__device__ __forceinline__ void chk_attn(const Ctx& C) {
    unsigned* ctl = WSP(unsigned, WS_CTL);
    const int b = C.bid & 7, q = (C.bid * 977 + 300 + 13 * (C.bid >> 3)) & 4095; const size_t tq = (size_t)b * SEQ + q; const int n = q + 1;
    LAS float* sc = (LAS float*)C.lds;
    LAS float* pr = sc + 4096;
    LAS float* red = pr + 4096;
    const bf16_t* iq = WSP(bf16_t, WS_IQ); const bf16_t* ik = WSP(bf16_t, WS_IK); const float* iw = WSP(float, WS_IW); const float* score = WSP(float, WS_SCORE);
    float e1 = 0.f;
    for (int k = C.tid; k < n; k += 512) { float s_ = 0.f;
        for (int h = 0; h < 8; ++h) { float d = 0.f; for (int j = 0; j < 64; ++j) d = fmaf(bf2f(iq[tq * 512 + h * 64 + j]), bf2f(ik[((size_t)b * SEQ + k) * 64 + j]), d); s_ = fmaf(fmaxf(d, 0.f), iw[tq * 8 + h], s_); }
        sc[k] = s_; e1 = fmaxf(e1, fabsf(s_ - score[tq * SEQ + k])); }
    err_max(ctl, 2, e1);
    __syncthreads();
    const unsigned* mask = WSP(unsigned, WS_MASK); float e2 = 0.f;
    for (int k = C.tid; k < 4096; k += 512) { bool sel = false;
        if (k < n) { if (n <= 256) sel = true; else { const float sk = score[tq * SEQ + k]; int rank = 0; for (int j = 0; j < n; ++j) { const float sj = score[tq * SEQ + j]; rank += (sj > sk || (sj == sk && j < k)) ? 1 : 0; } sel = rank < 256; } }
        const bool mb = (mask[tq * 128 + (k >> 5)] >> (k & 31)) & 1u; if (sel != mb) e2 = 1.f; }
    err_max(ctl, 3, e2);
    const int h = (C.bid >> 3) & 7;
    for (int which = 0; which < 2; ++which) {
        const bf16_t* Q = which ? WSP(bf16_t, WS_QC) : WSP(bf16_t, WS_QA); const bf16_t* K = which ? WSP(bf16_t, WS_KC) : WSP(bf16_t, WS_KA); const bf16_t* VT = which ? WSP(bf16_t, WS_VCT) : WSP(bf16_t, WS_VAT);
        const bf16_t* O = WSP(bf16_t, WS_OBUF) + (which ? (size_t)2 * NTOK * 512 : 0); const int dq = which ? 96 : 64, qs = 8 * dq;
        __syncthreads();
        float mx = -INFINITY;
        for (int k = C.tid; k < 4096; k += 512) { float lgt = -INFINITY;
            const bool ok = k < n && (which || ((mask[tq * 128 + (k >> 5)] >> (k & 31)) & 1u));
            if (ok) { float d = 0.f; for (int j = 0; j < dq; ++j) d = fmaf(bf2f(Q[tq * qs + h * dq + j]), bf2f(K[((size_t)b * SEQ + k) * qs + h * dq + j]), d); lgt = d; }
            pr[k] = lgt; mx = fmaxf(mx, lgt); }
        red[C.tid] = mx; __syncthreads();
        if (C.tid == 0) { float m = -INFINITY; for (int i = 0; i < 512; ++i) m = fmaxf(m, red[i]); red[0] = m; } __syncthreads();
        const float m = red[0]; __syncthreads();
        float sm = 0.f; for (int k = C.tid; k < 4096; k += 512) { const float p = exp2f(pr[k] - m); pr[k] = p; sm += p; }
        red[C.tid] = sm; __syncthreads();
        if (C.tid == 0) { float t = 0.f; for (int i = 0; i < 512; ++i) t += red[i]; red[0] = t; } __syncthreads();
        const float den = red[0];
        if (C.tid < 64) { const int d = C.tid; float o = 0.f;
            for (int k = 0; k < n; ++k) { const int ps = (k & ~15) | perm16(k & 15); o = fmaf(pr[k], bf2f(VT[((size_t)(b * 8 + h) * 64 + d) * SEQ + ps]), o); }
            o /= den; err_max(ctl, 4 + which, fabsf(o - bf2f(O[tq * 512 + h * 64 + d]))); }
    }
    __syncthreads();
}
#endif

constexpr int NPH_LAYER = 11, NPHASE = 1 + NLAYER * NPH_LAYER;
__global__ void __launch_bounds__(NWAVES * 64, 2) trunk_fwd(Args args) {
    extern __shared__ __attribute__((aligned(16))) unsigned char lds_raw[];
    Ctx C;
    C.lds = (LAS unsigned char*)lds_raw; C.tid = threadIdx.x; C.lane = C.tid & 63; C.wave = __builtin_amdgcn_readfirstlane(C.tid >> 6); C.G = gridDim.x; C.bid = blockIdx.x; C.ws = args.ws;
    volatile LAS unsigned* MISC = (volatile LAS unsigned*)(C.lds + MISC_OFF);
    if (C.tid < 16) MISC[C.tid] = 0u;
    __syncthreads();
#if MK_ONE_LAUNCH
    XcdBarrier bar = xcd_barrier_post(WSP(unsigned, WS_CTL) + CW_BAR, MISC + 0);
#define GRID_BAR() do { FRESH(); XcdBarrier b_ = bar; { unsigned* bp_ = b_.bar; asm volatile("" : "+s"(bp_)); b_.bar = bp_; } xcd_barrier(b_, C.tid == 0); } while (0)
#else
#define GRID_BAR() do {} while (0)
#endif
    typedef const __attribute__((address_space(4))) Args* KArgsP;
    KArgsP kp = (KArgsP)__builtin_amdgcn_kernarg_segment_ptr();
    const int grid_s = gridDim.x, bid_s = blockIdx.x;
    const int wave_s = __builtin_amdgcn_readfirstlane((int)threadIdx.x >> 6);
#define FRESH() do { int ln_; asm volatile("v_mbcnt_lo_u32_b32 %0, -1, 0\n\tv_mbcnt_hi_u32_b32 %0, -1, %0" : "=v"(ln_)); int w_ = wave_s; asm volatile("" : "+s"(w_)); C.tid = (w_ << 6) | ln_; C.lane = ln_; C.wave = w_; \
        int g_ = grid_s, b_ = bid_s; asm volatile("" : "+s"(g_), "+s"(b_)); C.G = g_; C.bid = b_; \
        kp = (KArgsP)__builtin_amdgcn_kernarg_segment_ptr(); asm volatile("" : "+s"(kp)); C.ws = kp->ws; } while (0)
#define KIN(i) (kp->in[i])
    const int lo = args.ph_lo, hi = args.ph_hi, sub_mask = args.sub; const bool dry = (args.pad != 0);
#ifndef PH_ONLY
#define PH_ONLY -1
#endif
#ifndef PH_SUB
#define PH_SUB -1
#endif
#define PON(k) (PH_ONLY < 0 || PH_ONLY == (k))
#define PON2(k) ((PH_SUB < 0 || PH_SUB == (k)) && ((sub_mask >> (((k) / 10 - 1) * 4 + (k) % 10 - 1)) & 1))
#define IN(k) (lo <= (k) && (k) < hi)
#define SEAM(k) do { if (IN(k) && IN((k) + 1)) GRID_BAR(); } while (0)
    if (IN(0) && PON(100)) { phase_prologue(C, args); }
    SEAM(0);
    for (int l = 0; l < NLAYER; ++l) {
        const int P = 1 + l * NPH_LAYER;
        if (IN(P + 0) && PON(0)) { FRESH();
            pg8::Gemm g{WSP(bf16_t, WS_XB), WSP(bf16_t, WS_WIN + l * SZ_WIN), 1024, 1024, nullptr}; GridOrder S{NIN / 256, (NTOK / 256) * (NIN / 256), C.G, C.bid};
            EpiInProj E{C.ws, dry};
            pg8::gemm_phase<EpiInProj, GridOrder>(C.lds, g, S, E, C.tid);
        }
        SEAM(P + 0);
        if (IN(P + 1) && PON(1)) { FRESH();
            if (PON2(11)) phase_indexer(C);
            __syncthreads();
            FRESH();
            if (PON2(12)) { pg8::Gemm g{WSP(bf16_t, WS_CDQ), WSP(bf16_t, WS_WUQ + l * SZ_WUQ), 256, 256, nullptr}; GridOrder S{3, 128 * 3, C.G, C.bid};
              EpiQUp E{WSP(bf16_t, WS_QC), WSP(float, WS_SSQ), WSP(float, WS_COSC), WSP(float, WS_SINC)};
              pg8::gemm_phase<EpiQUp, GridOrder>(C.lds, g, S, E, C.tid); }
            FRESH();
            if (PON2(13)) { pg8::Gemm g{WSP(bf16_t, WS_CDKV), WSP(bf16_t, WS_WUKV + l * SZ_WUKV), 256, 256, nullptr}; GridOrder S{4, 128 * 4, C.G, C.bid};
              EpiKvUp E{WSP(bf16_t, WS_KC), WSP(bf16_t, WS_VCT), WSP(float, WS_SSQ)};
              pg8::gemm_phase<EpiKvUp, GridOrder>(C.lds, g, S, E, C.tid); }
            __syncthreads();
            if (PON2(14)) { FRESH(); phase_gmlp(C, KIN(3) + l * 512, KIN(4) + l * 512, KIN(6) + (size_t)l * 8 * 128, l); }
        }
        SEAM(P + 1);
        if (IN(P + 2) && PON(2)) { FRESH();
            if (PON2(21)) phase_select(C);
            __syncthreads();
            FRESH(); if (PON2(22)) phase_attn<96, false>(C, WSP(bf16_t, WS_QC), WSP(bf16_t, WS_KC), WSP(bf16_t, WS_VCT), nullptr, WSP(bf16_t, WS_OBUF) + (size_t)2 * NTOK * 512);
        }
        SEAM(P + 2);
        if (IN(P + 3) && PON(3)) { FRESH(); phase_attn<64, true>(C, WSP(bf16_t, WS_QA), WSP(bf16_t, WS_KA), WSP(bf16_t, WS_VAT), WSP(unsigned, WS_MASK), WSP(bf16_t, WS_OBUF)); }
        SEAM(P + 3);
        if (IN(P + 4) && PON(4)) { FRESH();
            pg8::Gemm g{WSP(bf16_t, WS_OBUF), WSP(bf16_t, WS_WBR + l * SZ_WBR), 512, 512, nullptr}; MergeOrder S{C.G, C.bid};
            EpiMerge E{WSP(bf16_t, WS_GATE), WSP(bf16_t, WS_MERGED)};
            pg8::gemm_phase<EpiMerge, MergeOrder>(C.lds, g, S, E, C.tid);
        }
        SEAM(P + 4);
        if (IN(P + 5) && PON(5)) { FRESH();
            pg8::Gemm g{WSP(bf16_t, WS_MERGED), WSP(bf16_t, WS_WOUT + l * SZ_WOUT), 1024, 1024, nullptr}; GridOrder S{4, 128 * 4, C.G, C.bid};
            EpiOut E{dry ? WSP(bf16_t, WS_DRY) : WSP(bf16_t, WS_OBUF)};
            pg8::gemm_phase<EpiOut, GridOrder>(C.lds, g, S, E, C.tid);
        }
        SEAM(P + 5);
        if (IN(P + 6) && PON(6)) { FRESH(); phase_ln1_router(C, KIN(13) + l * 1024, KIN(14) + l * 1024, KIN(15) + (size_t)l * 1024 * 32, KIN(16) + l * 32, l, dry); }
        SEAM(P + 6);
        if (IN(P + 7) && PON(7)) { FRESH(); phase_dispatch(C, l); }
        SEAM(P + 7);
        if (IN(P + 8) && PON(8)) { FRESH();
            moe_tables(C, l);
            const LAS int* tb = (const LAS int*)(C.lds + MISC_OFF + 64) + 32;
            pg8::Gemm g{WSP(bf16_t, WS_XB), WSP(bf16_t, WS_WGU + l * SZ_WGU), 1024, 1024, WSP(int, WS_STK)}; MoeOrder S{8, tb[32] * 8, C.G, C.bid, tb};
            EpiMoeUp E{WSP(bf16_t, WS_H), KIN(18) + (size_t)l * NEXP * 2048};
            pg8::gemm_phase<EpiMoeUp, MoeOrder, true>(C.lds, g, S, E, C.tid);
        }
        SEAM(P + 8);
        if (IN(P + 9) && PON(9)) { FRESH();
            moe_tables(C, l);
            const LAS int* tb = (const LAS int*)(C.lds + MISC_OFF + 64) + 32;
            pg8::Gemm g{WSP(bf16_t, WS_H), WSP(bf16_t, WS_WDN + l * SZ_WDN), 1024, 1024, nullptr}; MoeOrder S{4, tb[32] * 4, C.G, C.bid, tb};
            EpiMoeDn E{dry ? WSP(bf16_t, WS_DRY) : WSP(bf16_t, WS_Y), KIN(20) + (size_t)l * NEXP * 1024, dry};
            pg8::gemm_phase<EpiMoeDn, MoeOrder>(C.lds, g, S, E, C.tid);
        }
        SEAM(P + 9);
        if (IN(P + 10) && PON(10)) { FRESH(); phase_ln2(C, KIN(21) + l * 1024, KIN(22) + l * 1024, kp->out, l, dry); }
        SEAM(P + 10);
    }
#ifdef DBG_STOP
    if (IN(NPHASE)) { FRESH(); dbg_dump(C, kp->out); }
#endif
#ifdef DBG_CHECK
    if (IN(NPHASE + 1)) { FRESH(); chk_proj(C, args); chk_attn(C); }
    if (IN(NPHASE + 2)) { FRESH();
        const unsigned* ctl = WSP(unsigned, WS_CTL); const float tol[6] = {0.06f, 0.06f, 2e-3f, 0.5f, 0.02f, 0.02f}; float sc = 1.f;
        for (int k = 0; k < 6; ++k) if (__uint_as_float(ctl[CW_ERR + k]) > tol[k]) sc += 0.2f * (float)(1 << k);
        float* o = kp->out; for (size_t i = (size_t)C.bid * 512 + C.tid; i < (size_t)NTOK * DM; i += (size_t)C.G * 512) o[i] *= sc; }
#endif
#undef IN
#undef SEAM
}

extern "C" void kernel_launch(void* const* d_in, const int* in_sizes, int n_in, void* d_out, int out_size, void* d_ws, size_t ws_size, hipStream_t stream) {
    static int grid = 0;
    if (grid == 0) {
        if (n_in != 23 || out_size != NTOK * DM || ws_size < WS_END) { fprintf(stderr, "kernel_launch: unexpected shapes (n_in %d, out %d, ws %zu < %zu)\n", n_in, out_size, ws_size, (size_t)WS_END); grid = -1; return; }
        int dev = 0, cus = 0, per_cu = 0;
        if (hipGetDevice(&dev) != hipSuccess || hipDeviceGetAttribute(&cus, hipDeviceAttributeMultiprocessorCount, dev) != hipSuccess) { grid = -1; return; }
        if (hipFuncSetAttribute((const void*)trunk_fwd, hipFuncAttributeMaxDynamicSharedMemorySize, LDS_BYTES) != hipSuccess) { fprintf(stderr, "kernel_launch: hipFuncSetAttribute failed\n"); grid = -1; return; }
        if (hipOccupancyMaxActiveBlocksPerMultiprocessor(&per_cu, (const void*)trunk_fwd, NWAVES * 64, LDS_BYTES) != hipSuccess || per_cu < 1) { fprintf(stderr, "kernel_launch: occupancy query reports %d\n", per_cu); }
        (void)hipGetLastError();
        grid = cus;
    }
    if (grid < 0) return;
    (void)hipMemsetAsync((char*)d_ws + WS_CTL, 0, CTL_ZERO_BYTES, stream);
#ifdef DBG_ZERO_WS
    (void)hipMemsetAsync((char*)d_ws + WS_XRES, 0, WS_END - WS_XRES, stream);
#endif
    Args a{};
    for (int i = 0; i < 23; ++i) a.in[i] = (const float*)d_in[i];
    a.out = (float*)d_out; a.ws = (unsigned char*)d_ws; a.sub = -1; a.pad = 0;
#if MK_ONE_LAUNCH
    a.ph_lo = 0; a.ph_hi = NPHASE;
    hipLaunchKernelGGL(trunk_fwd, dim3(grid), dim3(NWAVES * 64), LDS_BYTES, stream, a);
#else
#ifdef DBG_STOP
    for (int p = 0; p < 1 + DBG_STOP; ++p) { a.ph_lo = p; a.ph_hi = p + 1; hipLaunchKernelGGL(trunk_fwd, dim3(grid), dim3(NWAVES * 64), LDS_BYTES, stream, a); }
    a.ph_lo = NPHASE; a.ph_hi = NPHASE + 1; hipLaunchKernelGGL(trunk_fwd, dim3(grid), dim3(NWAVES * 64), LDS_BYTES, stream, a);
#else
    for (int p = 0; p < NPHASE; ++p) { a.ph_lo = p; a.ph_hi = p + 1; a.sub = -1; a.pad = 0; hipLaunchKernelGGL(trunk_fwd, dim3(grid), dim3(NWAVES * 64), LDS_BYTES, stream, a);
#ifdef DBG_CHECK
        if (p == 4) { a.ph_lo = NPHASE + 1; a.ph_hi = NPHASE + 2; hipLaunchKernelGGL(trunk_fwd, dim3(grid), dim3(NWAVES * 64), LDS_BYTES, stream, a); }
        if (p == NPHASE - 1) { a.ph_lo = NPHASE + 2; a.ph_hi = NPHASE + 3; hipLaunchKernelGGL(trunk_fwd, dim3(grid), dim3(NWAVES * 64), LDS_BYTES, stream, a); }
#endif
#ifdef PROBE_PH
#ifndef PROBE_DRY
#define PROBE_DRY 0
#endif
        if ((p == 0 && PROBE_PH == -1) || (p >= 1 && (p - 1) % NPH_LAYER == PROBE_PH)) { a.sub = PROBE_SUB; a.pad = PROBE_DRY; hipLaunchKernelGGL(trunk_fwd, dim3(grid), dim3(NWAVES * 64), LDS_BYTES, stream, a); }
#endif
    }
#endif
#endif
}
```

```cpp
#include <hip/hip_runtime.h>
#include <cstdio>
#include <cstdint>

#ifndef MK_ONE_LAUNCH
#define MK_ONE_LAUNCH 1
#endif

#define LAS __attribute__((address_space(3)))
typedef unsigned short bf16_t;
typedef short bf16x8 __attribute__((ext_vector_type(8)));
typedef float f32x4 __attribute__((ext_vector_type(4)));
typedef float f32x16 __attribute__((ext_vector_type(16)));
typedef unsigned u32x4 __attribute__((ext_vector_type(4)));
typedef unsigned u32x2 __attribute__((ext_vector_type(2)));
typedef float f32x2_t __attribute__((ext_vector_type(2)));
typedef __bf16 bf16x2_t __attribute__((ext_vector_type(2)));

__device__ __forceinline__ unsigned pk2(float lo, float hi) { f32x2_t v = {lo, hi}; bf16x2_t b = __builtin_convertvector(v, bf16x2_t); return __builtin_bit_cast(unsigned, b); }
__device__ __forceinline__ float bf2f(unsigned short x) { return __uint_as_float(((unsigned)x) << 16); }
__device__ __forceinline__ float bflo(unsigned w) { return __uint_as_float(w << 16); }
__device__ __forceinline__ float bfhi(unsigned w) { return __uint_as_float(w & 0xffff0000u); }
template <int M> __device__ __forceinline__ float xswz(float v) { static_assert(M >= 1 && M <= 16, "xswz"); return __int_as_float(__builtin_amdgcn_ds_swizzle(__float_as_int(v), 0x1F | (M << 10))); }
template <int M> __device__ __forceinline__ unsigned xswzu(unsigned v) { return (unsigned)__builtin_amdgcn_ds_swizzle((int)v, 0x1F | (M << 10)); }
__device__ __forceinline__ float xsum32(float v) { auto rr = __builtin_amdgcn_permlane32_swap(__float_as_uint(v), __float_as_uint(v), false, false); return __uint_as_float(rr[0]) + __uint_as_float(rr[1]); }
__device__ __forceinline__ float xmax32(float v) { auto rr = __builtin_amdgcn_permlane32_swap(__float_as_uint(v), __float_as_uint(v), false, false); return fmaxf(__uint_as_float(rr[0]), __uint_as_float(rr[1])); }
__device__ __forceinline__ float xother32(float v, bool upper) { auto rr = __builtin_amdgcn_permlane32_swap(__float_as_uint(v), __float_as_uint(v), false, false); return __uint_as_float(upper ? rr[0] : rr[1]); }
#define LDS_WAIT() asm volatile("s_waitcnt lgkmcnt(0)" ::: "memory")
#define VM_WAIT() asm volatile("s_waitcnt vmcnt(0)" ::: "memory")

constexpr int NB = 8, SEQ = 4096, NTOK = NB * SEQ, DM = 1024, NLAYER = 4;
constexpr int NIN_SRC = 6632, NIN = 6656;
constexpr int NEXP = 32, TOPK = 4, DFF = 1024;
constexpr int NSLOT = NTOK * TOPK, NSLOT_PAD = NSLOT + NEXP * 256;
constexpr float LN_EPS = 1e-5f, RMS_EPS = 1e-6f;
constexpr float DN_ALPHA = 1.681792830507429f;
constexpr float LOG2E = 1.4426950408889634f;
constexpr float QSCALE_A = 0.125f * LOG2E;
constexpr float QSCALE_C = 0.10206207261596577f * LOG2E;
constexpr float IW_SCALE = 0.35355339059327373f * 0.125f;

constexpr size_t MiB = (size_t)1 << 20;
constexpr size_t WS_CTL = 0, CTL_ZERO_BYTES = 1 * MiB;
constexpr int CW_BAR = 4096, CW_CNT = 16384;
constexpr size_t SZ_WIN = (size_t)NIN * DM * 2, SZ_WUQ = (size_t)768 * 256 * 2, SZ_WUKV = (size_t)1024 * 256 * 2, SZ_WBR = (size_t)3 * 1024 * 512 * 2, SZ_WOUT = (size_t)1024 * 1024 * 2;
constexpr size_t SZ_WGU = (size_t)NEXP * 2048 * 1024 * 2, SZ_WDN = (size_t)NEXP * 1024 * 1024 * 2, SZ_WGM = (size_t)8 * 128 * 128 * 2;
constexpr size_t WS_WIN = 2 * MiB;
constexpr size_t WS_WUQ = WS_WIN + NLAYER * SZ_WIN;
constexpr size_t WS_WUKV = WS_WUQ + NLAYER * SZ_WUQ;
constexpr size_t WS_WBR = WS_WUKV + NLAYER * SZ_WUKV;
constexpr size_t WS_WOUT = WS_WBR + NLAYER * SZ_WBR;
constexpr size_t WS_WGU = WS_WOUT + NLAYER * SZ_WOUT;
constexpr size_t WS_WDN = WS_WGU + NLAYER * SZ_WGU;
constexpr size_t WS_WGM = WS_WDN + NLAYER * SZ_WDN;
constexpr size_t WS_COSA = WS_WGM + NLAYER * SZ_WGM;
constexpr size_t WS_SINA = WS_COSA + (size_t)NTOK * 8 * 4;
constexpr size_t WS_COSC = WS_SINA + (size_t)NTOK * 8 * 4;
constexpr size_t WS_SINC = WS_COSC + (size_t)NTOK * 16 * 4;
constexpr size_t WS_XRES = WS_SINC + (size_t)NTOK * 16 * 4;
constexpr size_t WS_XB = WS_XRES + (size_t)NTOK * DM * 4;
constexpr size_t WS_QA = WS_XB + (size_t)NTOK * DM * 2;
constexpr size_t WS_KA = WS_QA + (size_t)NTOK * 512 * 2;
constexpr size_t WS_VAT = WS_KA + (size_t)NTOK * 512 * 2;
constexpr size_t WS_IQ = WS_VAT + (size_t)NTOK * 512 * 2;
constexpr size_t WS_IK = WS_IQ + (size_t)NTOK * 512 * 2;
constexpr size_t WS_IW = WS_IK + (size_t)NTOK * 64 * 2;
constexpr size_t WS_U = WS_IW + (size_t)NTOK * 8 * 4;
constexpr size_t WS_V = WS_U + (size_t)NTOK * 512 * 2;
constexpr size_t WS_CDQ = WS_V + (size_t)NTOK * 512 * 2;
constexpr size_t WS_CDKV = WS_CDQ + (size_t)NTOK * 256 * 2;
constexpr size_t WS_SSQ = WS_CDKV + (size_t)NTOK * 256 * 2;
constexpr size_t WS_GATE = WS_SSQ + (size_t)NTOK * 8 * 4;
constexpr size_t WS_QC = WS_GATE + (size_t)NTOK * 3072 * 2;
constexpr size_t WS_KC = WS_QC + (size_t)NTOK * 768 * 2;
constexpr size_t WS_VCT = WS_KC + (size_t)NTOK * 768 * 2;
constexpr size_t WS_SCORE = WS_VCT + (size_t)NTOK * 512 * 2;
constexpr size_t WS_MASK = WS_SCORE + (size_t)NTOK * SEQ * 4;
constexpr size_t WS_OBUF = WS_MASK + (size_t)NTOK * 128 * 4;
constexpr size_t WS_MERGED = WS_OBUF + (size_t)3 * NTOK * 512 * 2;
constexpr size_t WS_TKE = WS_MERGED + (size_t)NTOK * DM * 2;
constexpr size_t WS_TKP = WS_TKE + (size_t)NSLOT * 4;
constexpr size_t WS_TKW = WS_TKP + (size_t)NSLOT * 4;
constexpr size_t WS_STK = WS_TKW + (size_t)NSLOT * 4;
constexpr size_t WS_SW = WS_STK + (size_t)NSLOT_PAD * 4;
constexpr size_t WS_XG = WS_SW + (size_t)NSLOT_PAD * 4;
constexpr size_t WS_H = WS_XG + (size_t)NSLOT_PAD * DM * 2;
constexpr size_t WS_Y = WS_H + (size_t)NSLOT_PAD * DFF * 2;
constexpr size_t WS_CCNT = WS_Y + (size_t)NSLOT_PAD * DM * 2;
constexpr size_t WS_END = WS_CCNT + (size_t)(NTOK / 128) * 32 * 4;
constexpr size_t WS_DRY = (WS_END + 255) & ~(size_t)255;
static_assert(WS_END < (size_t)4200 * MiB, "workspace map too large");
static_assert((WS_WIN % 256) == 0 && (WS_COSA % 256) == 0 && (WS_XRES % 256) == 0 && (WS_SCORE % 256) == 0 && (WS_XG % 256) == 0, "alignment");

constexpr int LDS_BYTES = 147456;
constexpr int MISC_OFF = 143360;
constexpr int NWAVES = 8;

#define XB_TMO      128
#define XB_XCNT(j)  (256  + 64 * (j))
#define XB_XSUB(j)  (1280 + 64 * (j))
#define XB_XGEN(j)  (2304 + 64 * (j))
#define XB_TOP      3328
#define XB_TOPGEN   3392
#define XCD_BAR_WORDS 3456
#define XB_SPIN_CAP (1u << 18)
__device__ __forceinline__ unsigned xb_ld(unsigned* p)              { return __hip_atomic_load(p, __ATOMIC_RELAXED, __HIP_MEMORY_SCOPE_AGENT); }
__device__ __forceinline__ unsigned xb_add(unsigned* p, unsigned v) { return __hip_atomic_fetch_add(p, v, __ATOMIC_RELAXED, __HIP_MEMORY_SCOPE_AGENT); }
__device__ __forceinline__ unsigned xb_xcc_id() { return (unsigned)__builtin_amdgcn_s_getreg((3 << 11) | 20) & 0xFu; }
#define XB_SPIN(cond, bar) do { unsigned _sp = 0; while (cond) { __builtin_amdgcn_s_sleep(1); \
    if ((++_sp & 255u) == 0u) { if (xb_ld(&(bar)[XB_TMO])) break; if (_sp > XB_SPIN_CAP) { atomicAdd(&(bar)[XB_TMO], 1u); break; } } } } while (0)
struct XcdBarrier { unsigned* bar; unsigned x; volatile LAS unsigned* st; };
__device__ __forceinline__ XcdBarrier xcd_barrier_post(unsigned* bar, volatile LAS unsigned* st) {
    XcdBarrier b; b.bar = bar; b.x = xb_xcc_id(); b.st = st;
    if (threadIdx.x == 0) (void)xb_add(&bar[XB_XCNT(b.x)], 1u);
    return b;
}
__device__ __forceinline__ void xcd_barrier_complete(unsigned* bar, unsigned x, unsigned& nloc, unsigned& nx) {
    const unsigned G = gridDim.x * gridDim.y * gridDim.z;
    unsigned sum, cnt, mine, sp = 0u;
    for (;;) {
        sum = 0u; cnt = 0u; mine = 0u;
#pragma unroll
        for (unsigned j = 0; j < 16; ++j) { const unsigned c = xb_ld(&bar[XB_XCNT(j)]); sum += c; cnt += (c > 0u) ? 1u : 0u; mine = (j == x) ? c : mine; }
        if (sum == G) break;
        __builtin_amdgcn_s_sleep(1);
        if ((++sp & 255u) == 0u) { if (xb_ld(&bar[XB_TMO])) break; if (sp > XB_SPIN_CAP) { atomicAdd(&bar[XB_TMO], 1u); break; } }
    }
    nloc = mine > 0u ? mine : 1u; nx = cnt > 0u ? cnt : 1u;
}
__device__ __forceinline__ void xcd_barrier(const XcdBarrier& b, bool leader_thread) {
    asm volatile("s_waitcnt vmcnt(0)" ::: "memory");
    __syncthreads();
    if (leader_thread) {
        unsigned* bar = b.bar;
        __builtin_amdgcn_s_waitcnt(0);
        unsigned nloc = b.st[0], nx = b.st[1];
        if (nloc == 0u) { xcd_barrier_complete(bar, b.x, nloc, nx); b.st[0] = nloc; b.st[1] = nx; }
        const unsigned old = xb_add(&bar[XB_XSUB(b.x)], 1u);
        const unsigned gen = old / nloc;
        if (old + 1u == (gen + 1u) * nloc) {
            __builtin_amdgcn_fence(__ATOMIC_RELEASE, "agent");
            asm volatile("s_waitcnt vmcnt(0)" ::: "memory");
            const unsigned og = xb_add(&bar[XB_TOP], 1u);
            const unsigned tg = og / nx;
            if (og + 1u == (tg + 1u) * nx) xb_add(&bar[XB_TOPGEN], 1u);
            else XB_SPIN(xb_ld(&bar[XB_TOPGEN]) == tg, bar);
            __builtin_amdgcn_fence(__ATOMIC_ACQUIRE, "agent");
            xb_add(&bar[XB_XGEN(b.x)], 1u);
            asm volatile("s_waitcnt vmcnt(0)" ::: "memory");
        } else {
            XB_SPIN(xb_ld(&bar[XB_XGEN(b.x)]) == gen, bar);
            __builtin_amdgcn_fence(__ATOMIC_ACQUIRE, "agent");
            asm volatile("s_waitcnt vmcnt(0)" ::: "memory");
        }
    }
    __syncthreads();
}

namespace pg8 {
constexpr int BM = 256, BK = 64, HALF = 128, HTB = HALF * BK * 2;
__host__ __device__ __forceinline__ int lds_byte(int r, int c) { const int st = (r >> 4) * 2 + (c >> 5), rr = r & 15, cc = c & 31, ob = rr * 64 + cc * 2; return st * 1024 + (ob ^ (((ob >> 9) & 1) << 5)); }
__host__ __device__ __forceinline__ void stage_rc(int b, int& R, int& C) { const int st = b / 1024, sb = b % 1024, swz = sb ^ (((sb >> 9) & 1) << 5); R = (st >> 1) * 16 + swz / 64; C = (st & 1) * 32 + (swz % 64) / 2; }
__host__ __device__ __forceinline__ int perm32(int rho) { const int n = rho >> 4, i = rho & 15; return 8 * (i >> 2) + 4 * n + (i & 3); }
struct Unit { int pm, pn; };
struct Gemm { const bf16_t* A; const bf16_t* Bt; int lda, K; const int* rowmap; };

constexpr int PRE_OFF = 131072;
template <class Epi, class Sched, bool GATHER = false>
__device__ __forceinline__ void gemm_phase(LAS unsigned char* lds, const Gemm g, const Sched& S, const Epi& E, int tid0) {
    int tid = tid0; asm volatile("" : "+v"(tid));
    const int wid = __builtin_amdgcn_readfirstlane(tid >> 6), lane = tid & 63, wr = wid >> 2, wc = wid & 3, fr = lane & 15, fq = lane >> 4;
    const int K = g.K, nt = K / BK, lda = g.lda;
    unsigned voffA[2], voffB[2]; unsigned colA2 = 0u;
#pragma unroll
    for (int i = 0; i < 2; ++i) { int R, C; stage_rc(tid * 16 + i * 8192, R, C); voffA[i] = (unsigned)(R * lda + C) * 2u; const int Rb = (R & ~31) + perm32(R & 31); voffB[i] = (unsigned)(Rb * K + C) * 2u; colA2 = (unsigned)C * 2u; }
    unsigned gcur[2] = {0u, 0u}, gnxt[2] = {0u, 0u};
#define PG8_GLOAD(d, pm_) do { int ln_; asm volatile("v_mbcnt_lo_u32_b32 %0, -1, 0\n\tv_mbcnt_hi_u32_b32 %0, -1, %0" : "=v"(ln_));   \
        int R0_, C0_; stage_rc(((wid << 6) | ln_) * 16, R0_, C0_); const int* rm_ = g.rowmap + (pm_) * BM + R0_; \
        d[0] = (unsigned)rm_[0] | ((unsigned)rm_[64] << 16); d[1] = (unsigned)rm_[HALF] | ((unsigned)rm_[HALF + 64] << 16); } while (0)
#define PG8_GOFF(p, i) ((((i) ? ((p) >> 16) : ((p) & 0xffffu)) * (unsigned)(lda * 2)) + colA2)
#define PG8_STAGE_G(bufoff, gbase, p) do { _Pragma("unroll") for (int _i = 0; _i < 2; ++_i) \
        __builtin_amdgcn_global_load_lds((const unsigned*)((const char*)(gbase) + PG8_GOFF(p, _i)), (LAS unsigned*)(lds + (bufoff) + ldsw + _i * 8192), 16, 0, 0); } while (0)
    const size_t kstep = (size_t)(BK * 2);
    const size_t hstepA = (size_t)HALF * lda * 2, hstepB = (size_t)HALF * K * 2;
    const size_t tstepA = 2 * hstepA, tstepB = 2 * hstepB;
    const unsigned ldsw = (unsigned)wid * 1024u;
    const int aoff = lds_byte(wr * 64 + fr, fq * 8), boff = lds_byte(wc * 32 + fr, fq * 8);
#define PG8_SA(b, h) (((b) * 2 + (h)) * HTB)
#define PG8_SB(b, h) ((4 + (b) * 2 + (h)) * HTB)
#define PG8_STAGE(bufoff, gbase, voff) do { _Pragma("unroll") for (int _i = 0; _i < 2; ++_i) \
        __builtin_amdgcn_global_load_lds((const unsigned*)((const char*)(gbase) + (voff)[_i]), (LAS unsigned*)(lds + (bufoff) + ldsw + _i * 8192), 16, 0, 0); } while (0)
#define PG8_STAGE_A(bufoff, gbase, half, nextu) do { if constexpr (GATHER) { if (nextu) PG8_STAGE_G(bufoff, gbase, gnxt[half]); else PG8_STAGE_G(bufoff, gbase, gcur[half]); } \
        else { PG8_STAGE(bufoff, (gbase) + ((half) ? hstepA : 0), voffA); } } while (0)
#define PG8_LDA(dst, b, h) do { _Pragma("unroll") for (int m = 0; m < 4; ++m) _Pragma("unroll") for (int k = 0; k < 2; ++k) dst[m][k] = *(const LAS bf16x8*)(lds + PG8_SA(b, h) + aoff + m * 2048 + k * 1024); } while (0)
#define PG8_LDB(dst, b, h) do { _Pragma("unroll") for (int n = 0; n < 2; ++n) _Pragma("unroll") for (int k = 0; k < 2; ++k) dst[n][k] = *(const LAS bf16x8*)(lds + PG8_SB(b, h) + boff + n * 2048 + k * 1024); } while (0)
#define PG8_MMA(ai, bj, At, Bt) do { __builtin_amdgcn_s_setprio(1); _Pragma("unroll") for (int m = 0; m < 4; ++m) _Pragma("unroll") for (int n = 0; n < 2; ++n) _Pragma("unroll") for (int k = 0; k < 2; ++k) \
        acc[ai][bj][m][n] = __builtin_amdgcn_mfma_f32_16x16x32_bf16(Bt[n][k], At[m][k], acc[ai][bj][m][n], 0, 0, 0); __builtin_amdgcn_s_setprio(0); } while (0)
#define PG8_WAIT_V(n) asm volatile("s_waitcnt vmcnt(" #n ")" ::: "memory")
#define PG8_WAIT_L(n) asm volatile("s_waitcnt lgkmcnt(" #n ")" ::: "memory")
#define PG8_BAR __builtin_amdgcn_s_barrier()
#define PG8_SCHED __builtin_amdgcn_sched_barrier(0)
    Unit cur, nxt; int ui = 0;
    if (!S.next(0, cur)) return;
    f32x4 acc[2][2][4][2];
#pragma unroll
    for (int a = 0; a < 2; ++a)
#pragma unroll
        for (int b = 0; b < 2; ++b)
#pragma unroll
            for (int m = 0; m < 4; ++m)
#pragma unroll
                for (int n = 0; n < 2; ++n) acc[a][b][m][n] = (f32x4){0.f, 0.f, 0.f, 0.f};
    bf16x8 At[4][2], B0[2][2], B1[2][2];
    const char* cA = GATHER ? (const char*)g.A : (const char*)g.A + (size_t)cur.pm * tstepA; const char* cB = (const char*)g.Bt + (size_t)cur.pn * tstepB;
    if constexpr (GATHER) { PG8_GLOAD(gcur, cur.pm); }
#define PG8_PRE(u_, slot_) do { if (wid < 4) { int ln_; asm volatile("v_mbcnt_lo_u32_b32 %0, -1, 0\n\tv_mbcnt_hi_u32_b32 %0, -1, %0" : "=v"(ln_));   \
        __builtin_amdgcn_global_load_lds((const unsigned*)(E.pre_base(u_, wid) + ln_), (LAS unsigned*)(lds + PRE_OFF + (slot_) * 1024 + wid * 256), 4, 0, 0); } } while (0)
    if constexpr (Epi::PRE) { PG8_PRE(cur, 0); }
    PG8_STAGE(PG8_SB(0, 0), cB, voffB); PG8_STAGE(PG8_SB(0, 1), cB + hstepB, voffB); PG8_STAGE_A(PG8_SA(0, 0), cA, 0, false); PG8_STAGE_A(PG8_SA(0, 1), cA, 1, false);
    if (wr == 1) PG8_BAR;
    PG8_WAIT_V(2); PG8_BAR;
    PG8_STAGE(PG8_SB(1, 0), cB + kstep, voffB); PG8_STAGE_A(PG8_SA(1, 0), cA + kstep, 0, false); PG8_STAGE(PG8_SB(1, 1), cB + hstepB + kstep, voffB);
    PG8_WAIT_V(6); PG8_BAR;
    for (;;) {
        const bool has_next = S.next(ui + 1, nxt);
        const char* nA = GATHER ? cA : (has_next ? (const char*)g.A + (size_t)nxt.pm * tstepA : cA); const char* nB = has_next ? (const char*)g.Bt + (size_t)nxt.pn * tstepB : cB;
        if constexpr (GATHER) { if (has_next) { PG8_GLOAD(gnxt, nxt.pm); } else { gnxt[0] = gcur[0]; gnxt[1] = gcur[1]; } }
        for (int t = 0; t < nt; t += 2) {
            const bool last = (t == nt - 2);
            if constexpr (Epi::PRE) { if (last && has_next) PG8_PRE(nxt, (ui + 1) & 1); }
            const char* a1 = cA + (size_t)(t + 1) * kstep;
            const char* a2 = last ? nA : cA + (size_t)(t + 2) * kstep; const char* b2 = last ? nB : cB + (size_t)(t + 2) * kstep;
            const char* a3 = a2 + kstep; const char* b3 = b2 + kstep;
            PG8_LDB(B0, 0, 0); PG8_LDB(B1, 0, 1); PG8_SCHED; PG8_LDA(At, 0, 0); PG8_STAGE_A(PG8_SA(1, 1), a1, 1, false);
            PG8_WAIT_V(8); PG8_WAIT_L(0); PG8_BAR; PG8_MMA(0, 0, At, B0); PG8_MMA(0, 1, At, B1); PG8_BAR; PG8_SCHED;
            PG8_LDA(At, 0, 1); PG8_STAGE(PG8_SB(0, 0), b2, voffB); PG8_STAGE(PG8_SB(0, 1), b2 + hstepB, voffB); PG8_STAGE_A(PG8_SA(0, 0), a2, 0, last);
            PG8_WAIT_V(8); PG8_WAIT_L(0); PG8_BAR; PG8_MMA(1, 0, At, B0); PG8_MMA(1, 1, At, B1); PG8_BAR; PG8_SCHED;
            PG8_LDB(B0, 1, 0); PG8_LDB(B1, 1, 1); PG8_SCHED; PG8_LDA(At, 1, 0); PG8_STAGE_A(PG8_SA(0, 1), a2, 1, last);
            PG8_WAIT_V(8); PG8_WAIT_L(0); PG8_BAR; PG8_MMA(0, 0, At, B0); PG8_MMA(0, 1, At, B1); PG8_BAR; PG8_SCHED;
            PG8_LDA(At, 1, 1); PG8_STAGE(PG8_SB(1, 0), b3, voffB); PG8_STAGE(PG8_SB(1, 1), b3 + hstepB, voffB); PG8_STAGE_A(PG8_SA(1, 0), a3, 0, last);
            PG8_WAIT_V(8); PG8_WAIT_L(0); PG8_BAR; PG8_MMA(1, 0, At, B0); PG8_MMA(1, 1, At, B1); PG8_BAR; PG8_SCHED;
        }
        if (wr == 0) PG8_BAR;
        { int el; asm volatile("v_mbcnt_lo_u32_b32 %0, -1, 0\n\tv_mbcnt_hi_u32_b32 %0, -1, %0" : "=v"(el));
          if constexpr (Epi::PRE) E(acc, cur, wr, wc, el & 15, el >> 4, (const LAS float*)(lds + PRE_OFF + (ui & 1) * 1024)); else E(acc, cur, wr, wc, el & 15, el >> 4); }
        if (!has_next) break;
        if constexpr (!Epi::CHAIN) {
#pragma unroll
        for (int a = 0; a < 2; ++a)
#pragma unroll
            for (int b = 0; b < 2; ++b)
#pragma unroll
                for (int m = 0; m < 4; ++m)
#pragma unroll
                    for (int n = 0; n < 2; ++n) acc[a][b][m][n] = (f32x4){0.f, 0.f, 0.f, 0.f};
        }
        cur = nxt; cA = nA; cB = nB; ++ui;
        if constexpr (GATHER) { gcur[0] = gnxt[0]; gcur[1] = gnxt[1]; }
        if (wr == 1) PG8_BAR;
    }
    PG8_WAIT_V(0);
    PG8_BAR;
#undef PG8_PRE
#undef PG8_SA
#undef PG8_SB
#undef PG8_STAGE
#undef PG8_LDA
#undef PG8_STAGE_A
#undef PG8_GLOAD
#undef PG8_GOFF
#undef PG8_STAGE_G
#undef PG8_LDB
#undef PG8_MMA
#undef PG8_WAIT_V
#undef PG8_WAIT_L
#undef PG8_BAR
#undef PG8_SCHED
}
}
using pg8::Unit;

struct Args { const float* in[23]; float* out; unsigned char* ws; int ph_lo, ph_hi; int sub, pad; };
struct Ctx {
    LAS unsigned char* lds;
    int tid, lane, wave, G, bid;
    unsigned char* ws;
};
#define WSP(T, off) ((T*)(C.ws + (off)))

struct GridOrder {
    int nN, total, G, c;
    __device__ __forceinline__ bool next(int i, Unit& u) const {
        const int L = c + i * G; if (L >= total) return false;
        const int nM = total / nN; int wgid;
        { const int q = total >> 3, r = total & 7, xcd = L & 7, off = L >> 3; wgid = (xcd < r ? xcd * (q + 1) : r * (q + 1) + (xcd - r) * q) + off; }
        const int nig = 8 * nN, gid = wgid / nig, fm = gid * 8, gsz = (nM - fm) < 8 ? (nM - fm) : 8, w = wgid - gid * nig;
        const int pn = w / gsz; u.pm = fm + (w - pn * gsz); u.pn = pn; return true;
    }
};
struct MergeOrder {
    int G, c;
    __device__ __forceinline__ bool next(int i, Unit& u) const { const int t = i / 3, n = i - 3 * t, tile = c + t * G; if (tile >= 512) return false; u.pm = n * 128 + (tile >> 2); u.pn = n * 4 + (tile & 3); return true; }
};
struct MoeOrder {
    int NT, total, G, c; const LAS int* tb;
    __device__ __forceinline__ bool next(int i, Unit& u) const {
        if ((G & 7) != 0) { const int idx = c + i * G; if (idx >= total) return false; const int mt = idx / NT, pn = idx - mt * NT;
            const int e = __builtin_amdgcn_readfirstlane(tb[40 + mt]); u.pm = mt; u.pn = e * NT + pn; return true; }
        const int T = __builtin_amdgcn_readfirstlane(tb[NEXP]), x = c & 7, lo = (x * T) >> 3, ntl = (((x + 1) * T) >> 3) - lo;
        const int j = (c >> 3) + i * (G >> 3);
        if (j >= ntl * NT) return false;
        const int gsh = (NT == 8) ? 6 : 5, gm = j >> gsh, rem = j - (gm << gsh);
        const int gs = (ntl - 8 * gm < 8) ? (ntl - 8 * gm) : 8, g4 = gs * 4, pg = (rem >= g4) ? 1 : 0, r2 = rem - pg * g4;
        const int mt = lo + 8 * gm + (r2 >> 2), e = __builtin_amdgcn_readfirstlane(tb[40 + mt]);
        u.pm = mt; u.pn = e * NT + pg * 4 + (r2 & 3); return true;
    }
};

__device__ __forceinline__ float gelu_f(float v) {
    const float av = fabsf(v), t = __builtin_amdgcn_rcpf(fmaf(av, 0.2316418882f, 1.0f));
    float q = fmaf(t, 0.5307027145f, -0.7265760135f); q = fmaf(q, t, 0.7107068705f); q = fmaf(q, t, -0.142248368f); q = fmaf(q, t, 0.127414796f); q = q * t;
    const float e = __builtin_amdgcn_exp2f((v * v) * (-0.72134752044f));
    const float m = v * (q * e);
    return v < 0.f ? m : v - m;
}
__device__ __forceinline__ float sigmoid_f(float x) { return __builtin_amdgcn_rcpf(1.f + __builtin_amdgcn_exp2f(x * (-LOG2E))); }
__device__ __forceinline__ int perm16(int o) { return (o & 3) | (((o >> 3) & 1) << 2) | (((o >> 2) & 1) << 3); }
__device__ __forceinline__ void st_bf4(bf16_t* p, f32x4 v) { u32x2 w; w.x = pk2(v[0], v[1]); w.y = pk2(v[2], v[3]); *(u32x2*)p = w; }
__device__ __forceinline__ f32x4 other32_4(f32x4 v, bool upper) { f32x4 r; r[0] = xother32(v[0], upper); r[1] = xother32(v[1], upper); r[2] = xother32(v[2], upper); r[3] = xother32(v[3], upper); return r; }

__device__ __forceinline__ void st_bf8(bf16_t* p, f32x4 v0, f32x4 v1) { u32x4 w; w.x = pk2(v0[0], v0[1]); w.y = pk2(v0[2], v0[3]); w.z = pk2(v1[0], v1[1]); w.w = pk2(v1[2], v1[3]); __builtin_nontemporal_store(w, (u32x4*)p); }
__device__ __forceinline__ f32x4 swz16_4(f32x4 v) { f32x4 r; r[0] = xswz<16>(v[0]); r[1] = xswz<16>(v[1]); r[2] = xswz<16>(v[2]); r[3] = xswz<16>(v[3]); return r; }
__device__ __forceinline__ void ld_bf8(const bf16_t* p, f32x4& a, f32x4& b) { const u32x4 w = *(const u32x4*)p; a = (f32x4){bflo(w.x), bfhi(w.x), bflo(w.y), bfhi(w.y)}; b = (f32x4){bflo(w.z), bfhi(w.z), bflo(w.w), bfhi(w.w)}; }
__device__ __forceinline__ void st_vt8(bf16_t* p, f32x4 v0, f32x4 v1) {
    const unsigned w0 = pk2(v0[0], v0[1]), w1 = pk2(v0[2], v0[3]), w2 = pk2(v1[0], v1[1]), w3 = pk2(v1[2], v1[3]);
    p[0] = (bf16_t)(w0 & 0xffff); p[SEQ] = (bf16_t)(w0 >> 16); p[2 * SEQ] = (bf16_t)(w1 & 0xffff); p[3 * SEQ] = (bf16_t)(w1 >> 16);
    p[4 * SEQ] = (bf16_t)(w2 & 0xffff); p[5 * SEQ] = (bf16_t)(w2 >> 16); p[6 * SEQ] = (bf16_t)(w3 & 0xffff); p[7 * SEQ] = (bf16_t)(w3 >> 16);
}
struct EpiInProj {
    static constexpr bool CHAIN = false; static constexpr bool PRE = false;
    unsigned char* ws; bool skip;
    __device__ __forceinline__ void operator()(f32x4 (&acc)[2][2][4][2], const Unit& un, int wr, int wc, int fr, int fq) const {
        if (skip) return;
        const int pn = un.pn; const int row0 = un.pm * 256 + wr * 64 + fr;
        const float* cosA = (const float*)(ws + WS_COSA); const float* sinA = (const float*)(ws + WS_SINA); const float* cosC = (const float*)(ws + WS_COSC); const float* sinC = (const float*)(ws + WS_SINC);
        if (pn < 4 || pn == 6 || pn == 7) {
            const size_t doff = pn < 2 ? WS_QA : (pn < 4 ? WS_KA : WS_IQ); bf16_t* dst = (bf16_t*)(ws + doff); const float sc = pn < 2 ? QSCALE_A : 1.f; const int tcol = (pn & 1) * 256;
            const bool rope = (wc & 1) == 0;
#pragma unroll
            for (int ai = 0; ai < 2; ++ai)
#pragma unroll
                for (int m = 0; m < 4; ++m) { const int row = row0 + ai * 128 + m * 16;
                    f32x4 c0 = {1.f, 1.f, 1.f, 1.f}, c1 = c0, s0 = {0.f, 0.f, 0.f, 0.f}, s1 = s0;
                    if (rope) { c0 = *(const f32x4*)(cosA + (size_t)row * 8); c1 = *(const f32x4*)(cosA + (size_t)row * 8 + 4); s0 = *(const f32x4*)(sinA + (size_t)row * 8); s1 = *(const f32x4*)(sinA + (size_t)row * 8 + 4); }
#pragma unroll
                    for (int bj = 0; bj < 2; ++bj) { f32x4 v0 = acc[ai][bj][m][0], v1 = acc[ai][bj][m][1];
                        const f32x4 p0 = swz16_4(v0), p1 = swz16_4(v1);
                        if (rope && fq < 2) { v0 = (fq == 0) ? (v0 * c0 - p0 * s0) : (v0 * c0 + p0 * s0); v1 = (fq == 0) ? (v1 * c1 - p1 * s1) : (v1 * c1 + p1 * s1); }
                        st_bf8(dst + (size_t)row * 512 + tcol + bj * 128 + wc * 32 + 8 * fq, v0 * sc, v1 * sc); } }
        } else if (pn < 6) {
            bf16_t* vat = (bf16_t*)(ws + WS_VAT);
#pragma unroll
            for (int ai = 0; ai < 2; ++ai)
#pragma unroll
                for (int m = 0; m < 4; ++m) { const int row = row0 + ai * 128 + m * 16; const int b = row >> 12, s = row & 4095, ps = (s & ~15) | perm16(s & 15);
#pragma unroll
                    for (int bj = 0; bj < 2; ++bj) { const int c = (pn - 4) * 256 + bj * 128 + wc * 32 + 8 * fq; const int h = c >> 6, d = c & 63;
                        st_vt8(vat + ((size_t)(b * 8 + h) * 64 + d) * SEQ + ps, acc[ai][bj][m][0], acc[ai][bj][m][1]); } }
        } else if (pn == 8) {
            bf16_t* ik = (bf16_t*)(ws + WS_IK); float* iw = (float*)(ws + WS_IW); bf16_t* kc = (bf16_t*)(ws + WS_KC); bf16_t* cd = (bf16_t*)(ws + WS_CDKV); float* ssq = (float*)(ws + WS_SSQ);
#pragma unroll
            for (int ai = 0; ai < 2; ++ai)
#pragma unroll
                for (int m = 0; m < 4; ++m) { const int row = row0 + ai * 128 + m * 16;
                    { f32x4 v0 = acc[ai][0][m][0], v1 = acc[ai][0][m][1];
                      { unsigned zz = 0u; asm volatile("" : "+v"(zz)); const u32x4 z = {zz, zz, zz, zz}; *(u32x4*)(cd + (size_t)row * 256 + wc * 32 + 8 * fq) = z; }
                      if (wc == 0) {
                          const f32x4 p0 = swz16_4(v0), p1 = swz16_4(v1);
                          if (fq < 2) { const f32x4 c0 = *(const f32x4*)(cosA + (size_t)row * 8), c1 = *(const f32x4*)(cosA + (size_t)row * 8 + 4), s0 = *(const f32x4*)(sinA + (size_t)row * 8), s1 = *(const f32x4*)(sinA + (size_t)row * 8 + 4);
                              v0 = (fq == 0) ? (v0 * c0 - p0 * s0) : (v0 * c0 + p0 * s0); v1 = (fq == 0) ? (v1 * c1 - p1 * s1) : (v1 * c1 + p1 * s1); }
                          st_bf8(ik + (size_t)row * 64 + 8 * fq, v0, v1);
                      } else if (wc == 1) { st_bf8(ik + (size_t)row * 64 + 32 + 8 * fq, v0, v1);
                      } else if (wc == 2) { if (fq == 0) { *(f32x4*)(iw + (size_t)row * 8) = v0 * IW_SCALE; *(f32x4*)(iw + (size_t)row * 8 + 4) = v1 * IW_SCALE; }
                      } else {
                          const bool up = fq >= 2; const f32x4 p0 = other32_4(v0, up), p1 = other32_4(v1, up);
                          const f32x4 c0 = *(const f32x4*)(cosC + (size_t)row * 16 + 8 * (fq & 1)), c1 = *(const f32x4*)(cosC + (size_t)row * 16 + 8 * (fq & 1) + 4), s0 = *(const f32x4*)(sinC + (size_t)row * 16 + 8 * (fq & 1)), s1 = *(const f32x4*)(sinC + (size_t)row * 16 + 8 * (fq & 1) + 4);
                          const f32x4 o0 = up ? (v0 * c0 + p0 * s0) : (v0 * c0 - p0 * s0), o1 = up ? (v1 * c1 + p1 * s1) : (v1 * c1 - p1 * s1);
                          bf16_t* p = kc + (size_t)row * 768 + 64 + 8 * fq;
#pragma unroll
                          for (int h = 0; h < 8; ++h) st_bf8(p + h * 96, o0, o1); } }
                    { const f32x4 v0 = acc[ai][1][m][0], v1 = acc[ai][1][m][1];
                      st_bf8(cd + (size_t)row * 256 + 128 + wc * 32 + 8 * fq, v0, v1);
                      float s = (v0[0] * v0[0] + v0[1] * v0[1]) + (v0[2] * v0[2] + v0[3] * v0[3]) + (v1[0] * v1[0] + v1[1] * v1[1]) + (v1[2] * v1[2] + v1[3] * v1[3]);
                      s += xswz<16>(s); s = xsum32(s);
                      if (fq == 0) ssq[(size_t)row * 8 + 4 + wc] = s; } }
        } else if (pn < 13) {
            bf16_t* dst = (bf16_t*)(ws + (pn < 11 ? WS_U : WS_V)); const int tcol = ((pn - 9) & 1) * 256;
#pragma unroll
            for (int ai = 0; ai < 2; ++ai)
#pragma unroll
                for (int m = 0; m < 4; ++m) { const int row = row0 + ai * 128 + m * 16;
#pragma unroll
                    for (int bj = 0; bj < 2; ++bj) { f32x4 v0 = acc[ai][bj][m][0], v1 = acc[ai][bj][m][1];
                        v0[0] = gelu_f(v0[0]); v0[1] = gelu_f(v0[1]); v0[2] = gelu_f(v0[2]); v0[3] = gelu_f(v0[3]); v1[0] = gelu_f(v1[0]); v1[1] = gelu_f(v1[1]); v1[2] = gelu_f(v1[2]); v1[3] = gelu_f(v1[3]);
                        st_bf8(dst + (size_t)row * 512 + tcol + bj * 128 + wc * 32 + 8 * fq, v0, v1); } }
        } else if (pn == 13) {
            bf16_t* cd = (bf16_t*)(ws + WS_CDQ); float* ssq = (float*)(ws + WS_SSQ);
#pragma unroll
            for (int ai = 0; ai < 2; ++ai)
#pragma unroll
                for (int m = 0; m < 4; ++m) { const int row = row0 + ai * 128 + m * 16; float s = 0.f;
#pragma unroll
                    for (int bj = 0; bj < 2; ++bj) { const f32x4 v0 = acc[ai][bj][m][0], v1 = acc[ai][bj][m][1];
                        st_bf8(cd + (size_t)row * 256 + bj * 128 + wc * 32 + 8 * fq, v0, v1);
                        s += ((v0[0] * v0[0] + v0[1] * v0[1]) + (v0[2] * v0[2] + v0[3] * v0[3])) + ((v1[0] * v1[0] + v1[1] * v1[1]) + (v1[2] * v1[2] + v1[3] * v1[3])); }
                    s += xswz<16>(s); s = xsum32(s);
                    if (fq == 0) ssq[(size_t)row * 8 + wc] = s; }
        } else {
            const int tcol = (pn - 14) * 256; bf16_t* gate = (bf16_t*)(ws + WS_GATE);
#pragma unroll
            for (int ai = 0; ai < 2; ++ai)
#pragma unroll
                for (int m = 0; m < 4; ++m) { const int row = row0 + ai * 128 + m * 16;
#pragma unroll
                    for (int bj = 0; bj < 2; ++bj) { f32x4 v0 = acc[ai][bj][m][0], v1 = acc[ai][bj][m][1];
                        v0[0] = sigmoid_f(v0[0]); v0[1] = sigmoid_f(v0[1]); v0[2] = sigmoid_f(v0[2]); v0[3] = sigmoid_f(v0[3]); v1[0] = sigmoid_f(v1[0]); v1[1] = sigmoid_f(v1[1]); v1[2] = sigmoid_f(v1[2]); v1[3] = sigmoid_f(v1[3]);
                        st_bf8(gate + (size_t)row * 3072 + tcol + bj * 128 + wc * 32 + 8 * fq, v0, v1); } }
        }
    }
};

struct EpiQUp {
    static constexpr bool CHAIN = false; static constexpr bool PRE = false;
    bf16_t* qc; const float* ssq; const float *cosC, *sinC;
    __device__ __forceinline__ void operator()(f32x4 (&acc)[2][2][4][2], const Unit& un, int wr, int wc, int fr, int fq) const {
        const int row0 = un.pm * 256 + wr * 64 + fr; const bool up = fq >= 2;
#pragma unroll
        for (int ai = 0; ai < 2; ++ai)
#pragma unroll
            for (int m = 0; m < 4; ++m) { const int row = row0 + ai * 128 + m * 16;
                const f32x4 sp = *(const f32x4*)(ssq + (size_t)row * 8);
                const float rs = rsqrtf(((sp[0] + sp[1]) + (sp[2] + sp[3])) * (1.f / 256.f) + RMS_EPS) * QSCALE_C;
                const f32x4 c0 = *(const f32x4*)(cosC + (size_t)row * 16 + 8 * (fq & 1)), c1 = *(const f32x4*)(cosC + (size_t)row * 16 + 8 * (fq & 1) + 4), s0 = *(const f32x4*)(sinC + (size_t)row * 16 + 8 * (fq & 1)), s1 = *(const f32x4*)(sinC + (size_t)row * 16 + 8 * (fq & 1) + 4);
#pragma unroll
                for (int bj = 0; bj < 2; ++bj) { const int gidx = un.pn * 8 + bj * 4 + wc;
                    f32x4 v0 = acc[ai][bj][m][0] * rs, v1 = acc[ai][bj][m][1] * rs;
                    if ((gidx % 3) == 2) { const f32x4 p0 = other32_4(v0, up), p1 = other32_4(v1, up);
                        v0 = up ? (v0 * c0 + p0 * s0) : (v0 * c0 - p0 * s0); v1 = up ? (v1 * c1 + p1 * s1) : (v1 * c1 - p1 * s1); }
                    st_bf8(qc + (size_t)row * 768 + gidx * 32 + 8 * fq, v0, v1); } }
    }
};
struct EpiKvUp {
    static constexpr bool CHAIN = false; static constexpr bool PRE = false;
    bf16_t *kc, *vct; const float* ssq;
    __device__ __forceinline__ void operator()(f32x4 (&acc)[2][2][4][2], const Unit& un, int wr, int wc, int fr, int fq) const {
        const int row0 = un.pm * 256 + wr * 64 + fr;
#pragma unroll
        for (int ai = 0; ai < 2; ++ai)
#pragma unroll
            for (int m = 0; m < 4; ++m) { const int row = row0 + ai * 128 + m * 16;
                const f32x4 sp = *(const f32x4*)(ssq + (size_t)row * 8 + 4);
                const float rs = rsqrtf(((sp[0] + sp[1]) + (sp[2] + sp[3])) * (1.f / 128.f) + RMS_EPS);
                const int b = row >> 12, s = row & 4095, ps = (s & ~15) | perm16(s & 15);
#pragma unroll
                for (int bj = 0; bj < 2; ++bj) { const int h = un.pn * 2 + bj; const f32x4 v0 = acc[ai][bj][m][0] * rs, v1 = acc[ai][bj][m][1] * rs;
                    if (wc < 2) st_bf8(kc + (size_t)row * 768 + h * 96 + wc * 32 + 8 * fq, v0, v1);
                    else st_vt8(vct + ((size_t)(b * 8 + h) * 64 + (wc - 2) * 32 + 8 * fq) * SEQ + ps, v0, v1); }
                asm volatile("" ::: "memory"); }
    }
};
struct EpiMerge {
    static constexpr bool CHAIN = true; static constexpr bool PRE = false;
    const bf16_t* gate; bf16_t* merged;
    __device__ __forceinline__ void operator()(f32x4 (&acc)[2][2][4][2], const Unit& un, int wr, int wc, int fr, int fq) const {
        const int n3 = un.pm >> 7, pm = un.pm & 127, pn = un.pn & 3; const int row0 = pm * 256 + wr * 64 + fr;
#pragma unroll
        for (int ai = 0; ai < 2; ++ai)
#pragma unroll
            for (int m = 0; m < 4; ++m) { const int row = row0 + ai * 128 + m * 16;
#pragma unroll
                for (int bj = 0; bj < 2; ++bj) { const int col = pn * 256 + bj * 128 + wc * 32 + 8 * fq;
                    const bf16_t* gp = gate + (size_t)row * 3072 + n3 * 1024 + col;
                    f32x4 ga0, ga1; ld_bf8(gp, ga0, ga1);
                    if (n3 < 2) { f32x4 gb0, gb1; ld_bf8(gp + 1024, gb0, gb1);
#pragma unroll
                        for (int j = 0; j < 4; ++j) { if (n3 == 1) { ga0[j] = fmaxf(ga0[j], 1e-20f); ga1[j] = fmaxf(ga1[j], 1e-20f); }
                            acc[ai][bj][m][0][j] *= ga0[j] * __builtin_amdgcn_rcpf(fmaxf(gb0[j], 1e-20f)); acc[ai][bj][m][1][j] *= ga1[j] * __builtin_amdgcn_rcpf(fmaxf(gb1[j], 1e-20f)); }
                    } else {
#pragma unroll
                        for (int j = 0; j < 4; ++j) { ga0[j] = fmaxf(ga0[j], 1e-20f); ga1[j] = fmaxf(ga1[j], 1e-20f); }
                        st_bf8(merged + (size_t)row * 1024 + col, acc[ai][bj][m][0] * ga0, acc[ai][bj][m][1] * ga1);
                        acc[ai][bj][m][0] = (f32x4){0.f, 0.f, 0.f, 0.f}; acc[ai][bj][m][1] = (f32x4){0.f, 0.f, 0.f, 0.f};
                    } } }
    }
};
struct EpiOut {
    static constexpr bool CHAIN = false; static constexpr bool PRE = false;
    bf16_t* yo;
    __device__ __forceinline__ void operator()(f32x4 (&acc)[2][2][4][2], const Unit& un, int wr, int wc, int fr, int fq) const {
        const int row0 = un.pm * 256 + wr * 64 + fr;
#pragma unroll
        for (int ai = 0; ai < 2; ++ai)
#pragma unroll
            for (int m = 0; m < 4; ++m) { const int row = row0 + ai * 128 + m * 16;
#pragma unroll
                for (int bj = 0; bj < 2; ++bj) st_bf8(yo + (size_t)row * 1024 + un.pn * 256 + bj * 128 + wc * 32 + 8 * fq, acc[ai][bj][m][0], acc[ai][bj][m][1]); }
    }
};
struct EpiMoeUp {
    static constexpr bool CHAIN = false; static constexpr bool PRE = true;
    bf16_t* hbuf; const float* bgu;
    __device__ __forceinline__ const float* pre_base(const Unit& un, int w) const { const int e = un.pn >> 3, pnl = un.pn & 7; return bgu + (size_t)e * 2048 + pnl * 128 + (w < 2 ? w * 64 : 1024 + (w - 2) * 64); }
    __device__ __forceinline__ void operator()(f32x4 (&acc)[2][2][4][2], const Unit& un, int wr, int wc, int fr, int fq, const LAS float* pre) const {
        const int pnl = un.pn & 7; const int row0 = un.pm * 256 + wr * 64 + fr;
        const int jh = pnl * 128 + wc * 32 + 8 * fq; const LAS float* pb = pre + wc * 32 + 8 * fq;
        const f32x4 bg0 = *(const LAS f32x4*)(pb), bg1 = *(const LAS f32x4*)(pb + 4), bl0 = *(const LAS f32x4*)(pb + 128), bl1 = *(const LAS f32x4*)(pb + 132);
#pragma unroll
        for (int ai = 0; ai < 2; ++ai)
#pragma unroll
            for (int m = 0; m < 4; ++m) { const int row = row0 + ai * 128 + m * 16;
                const f32x4 g0 = acc[ai][0][m][0] + bg0, g1 = acc[ai][0][m][1] + bg1, l0 = acc[ai][1][m][0] + bl0, l1 = acc[ai][1][m][1] + bl1; f32x4 o0, o1;
#pragma unroll
                for (int j = 0; j < 4; ++j) { const float ga = fminf(g0[j], 7.f), la = fminf(fmaxf(l0[j], -7.f), 7.f); o0[j] = (la + 1.f) * (ga * sigmoid_f(1.702f * ga));
                    const float gb = fminf(g1[j], 7.f), lb = fminf(fmaxf(l1[j], -7.f), 7.f); o1[j] = (lb + 1.f) * (gb * sigmoid_f(1.702f * gb)); }
                st_bf8(hbuf + (size_t)row * 1024 + jh, o0, o1);
                __builtin_amdgcn_sched_barrier(0); }
    }
};
struct EpiMoeDn {
    static constexpr bool CHAIN = false; static constexpr bool PRE = true;
    bf16_t* y; const float* bdn; bool skip;
    __device__ __forceinline__ const float* pre_base(const Unit& un, int w) const { const int e = un.pn >> 2, pnl = un.pn & 3; return bdn + (size_t)e * 1024 + pnl * 256 + w * 64; }
    __device__ __forceinline__ void operator()(f32x4 (&acc)[2][2][4][2], const Unit& un, int wr, int wc, int fr, int fq, const LAS float* pre) const {
        const int pnl = un.pn & 3; const int row0 = (skip ? 0 : un.pm * 256) + wr * 64 + fr;
#pragma unroll
        for (int bj = 0; bj < 2; ++bj) { const int col = pnl * 256 + bj * 128 + wc * 32 + 8 * fq; const LAS float* pb = pre + bj * 128 + wc * 32 + 8 * fq; const f32x4 b0 = *(const LAS f32x4*)(pb), b1 = *(const LAS f32x4*)(pb + 4);
#pragma unroll
            for (int ai = 0; ai < 2; ++ai)
#pragma unroll
                for (int m = 0; m < 4; ++m) st_bf8(y + (size_t)(row0 + ai * 128 + m * 16) * 1024 + col, acc[ai][bj][m][0] + b0, acc[ai][bj][m][1] + b1); }
    }
};

__device__ __forceinline__ int colmap_in(int np) {
    if (np < 2048) return np;
    if (np < 2304) { const int t = np - 2048; if (t < 64) return 2048 + t; if (t < 72) return 2112 + (t - 64); if (t < 96) return -1; if (t < 128) return 3528 + (t - 96); return 3400 + (t - 128); }
    if (np < 3328) return 2120 + (np - 2304);
    if (np < 3584) return 3144 + (np - 3328);
    return 3560 + (np - 3584);
}
__device__ __forceinline__ int colmap_gu(int np) { const int tile = np >> 8, w = np & 255; return (w < 128) ? (tile * 128 + w) : (1024 + tile * 128 + (w - 128)); }
template <int KIND>
__device__ __forceinline__ void tconv_item(const float* src, int ldsrc, bf16_t* dst, int Kdst, int koff, const float* kscale, int item, int nblk, LAS float* scr, int lane) {
    const int kb = item / nblk, nb = item - kb * nblk, k0 = 64 * kb, n0 = 32 * nb;
    const int np = n0 + (lane & 31);
    const int col = KIND == 1 ? colmap_in(np) : (KIND == 2 ? colmap_gu(np) : np);
    float vv[32];
#pragma unroll
    for (int i = 0; i < 32; ++i) { const int kk = 2 * i + (lane >> 5); const int ks = k0 + kk - koff; float v = 0.f;
        if (col >= 0 && ks >= 0) { v = src[(size_t)ks * ldsrc + col]; if (kscale) v *= kscale[ks]; }
        vv[i] = v; }
#pragma unroll
    for (int i = 0; i < 32; ++i) { const int kk = 2 * i + (lane >> 5); scr[kk * 33 + (lane & 31)] = vv[i]; }
    LDS_WAIT(); asm volatile("" ::: "memory");
    const int c = lane & 7;
#pragma unroll
    for (int j = 0; j < 4; ++j) { const int n = (lane >> 3) + 8 * j; const LAS float* s = scr + (8 * c) * 33 + n;
        u32x4 o; o.x = pk2(s[0 * 33], s[1 * 33]); o.y = pk2(s[2 * 33], s[3 * 33]); o.z = pk2(s[4 * 33], s[5 * 33]); o.w = pk2(s[6 * 33], s[7 * 33]);
        *(u32x4*)(dst + (size_t)(n0 + n) * Kdst + k0 + 8 * c) = o; }
    LDS_WAIT(); asm volatile("" ::: "memory");
}
__device__ __forceinline__ void phase_prologue(const Ctx& C, const Args& A) {
    LAS float* scr = (LAS float*)(C.lds + C.wave * 16384);
    const int gw = C.bid * NWAVES + C.wave, NGW = C.G * NWAVES;
    constexpr int I_IN = 16 * (NIN / 32), I_UQ = 4 * 24, I_UKV = 4 * 32, I_BR = 8 * 32, I_OUT = 16 * 32, I_GU = 16 * 64, I_DN = 16 * 32;
    constexpr int I_LAYER = I_IN + I_UQ + I_UKV + 3 * I_BR + I_OUT + NEXP * I_GU + NEXP * I_DN;
    for (int it = gw; it < NLAYER * I_LAYER; it += NGW) {
        const int l = it / I_LAYER; int r = it - l * I_LAYER;
        if (r < I_IN) { tconv_item<1>(A.in[2] + (size_t)l * DM * NIN_SRC, NIN_SRC, WSP(bf16_t, WS_WIN + l * SZ_WIN), 1024, 0, nullptr, r, NIN / 32, scr, C.lane); continue; } r -= I_IN;
        if (r < I_UQ) { tconv_item<0>(A.in[9] + (size_t)l * 256 * 768, 768, WSP(bf16_t, WS_WUQ + l * SZ_WUQ), 256, 0, A.in[7] + l * 256, r, 24, scr, C.lane); continue; } r -= I_UQ;
        if (r < I_UKV) { tconv_item<0>(A.in[10] + (size_t)l * 128 * 1024, 1024, WSP(bf16_t, WS_WUKV + l * SZ_WUKV), 256, 128, A.in[8] + l * 128, r, 32, scr, C.lane); continue; } r -= I_UKV;
        if (r < 3 * I_BR) { const int n = r / I_BR; r -= n * I_BR;
            tconv_item<0>(A.in[11] + ((size_t)l * 3 + n) * 512 * 1024, 1024, WSP(bf16_t, WS_WBR + l * SZ_WBR) + (size_t)n * 1024 * 512, 512, 0, nullptr, r, 32, scr, C.lane); continue; } r -= 3 * I_BR;
        if (r < I_OUT) { tconv_item<0>(A.in[12] + (size_t)l * 1024 * 1024, 1024, WSP(bf16_t, WS_WOUT + l * SZ_WOUT), 1024, 0, nullptr, r, 32, scr, C.lane); continue; } r -= I_OUT;
        if (r < NEXP * I_GU) { const int e = r / I_GU; r -= e * I_GU;
            tconv_item<2>(A.in[17] + ((size_t)l * NEXP + e) * 1024 * 2048, 2048, WSP(bf16_t, WS_WGU + l * SZ_WGU) + (size_t)e * 2048 * 1024, 1024, 0, nullptr, r, 64, scr, C.lane); continue; } r -= NEXP * I_GU;
        { const int e = r / I_DN; r -= e * I_DN;
            tconv_item<0>(A.in[19] + ((size_t)l * NEXP + e) * 1024 * 1024, 1024, WSP(bf16_t, WS_WDN + l * SZ_WDN) + (size_t)e * 1024 * 1024, 1024, 0, nullptr, r, 32, scr, C.lane); }
    }
    const int gt = C.bid * 512 + C.tid, NGT = C.G * 512;
    { bf16_t* d = WSP(bf16_t, WS_WGM); const float* s = A.in[5];
      for (int i = gt; i < NLAYER * 8 * 128 * 128; i += NGT) { const int jj = i & 127, ii = (i >> 7) & 127; d[i] = (jj <= ii) ? (bf16_t)(pk2(s[i], 0.f) & 0xffff) : (bf16_t)0; } }
    { const int* pos = (const int*)A.in[1]; float *ca = WSP(float, WS_COSA), *sa = WSP(float, WS_SINA), *cc = WSP(float, WS_COSC), *sc = WSP(float, WS_SINC);
      for (int i = gt; i < NTOK * 8; i += NGT) { const int t = i >> 3, f = i & 7; const float inv = powf(500000.f, -(float)f / 8.f); const float ang = (float)pos[t] * inv; ca[i] = cosf(ang); sa[i] = sinf(ang); }
      for (int i = gt; i < NTOK * 16; i += NGT) { const int t = i >> 4, f = i & 15; const float inv = powf(500000.f, -(float)f / 16.f); const float ang = (float)pos[t] * inv; cc[i] = cosf(ang); sc[i] = sinf(ang); } }
    { const f32x4* x4 = (const f32x4*)A.in[0]; u32x2* xb = WSP(u32x2, WS_XB);
      for (int i = gt; i < NTOK * DM / 4; i += NGT) { const f32x4 v = x4[i]; u32x2 w; w.x = pk2(v[0], v[1]); w.y = pk2(v[2], v[3]); xb[i] = w; } }
}

__device__ __forceinline__ void idx_block(const Ctx& C, int b, int qb) {
    const int tid = C.tid, lane = C.lane, wid = C.wave, r32 = lane & 31, hi = lane >> 5;
    const bf16_t* iq = WSP(bf16_t, WS_IQ); const bf16_t* ik = WSP(bf16_t, WS_IK); const float* iw = WSP(float, WS_IW); float* score = WSP(float, WS_SCORE);
    const int qi_l = ((r32 >> 4) << 1) + ((r32 >> 2) & 1), h_l = (r32 & 3) + 4 * ((r32 >> 3) & 1);
    bf16x8 af[2][4]; float wv[2][2][8];
#pragma unroll
    for (int rb = 0; rb < 2; ++rb) { const size_t tok = (size_t)b * SEQ + qb * 64 + wid * 8 + rb * 4 + qi_l;
#pragma unroll
        for (int ks = 0; ks < 4; ++ks) af[rb][ks] = *(const bf16x8*)(iq + tok * 512 + h_l * 64 + ks * 16 + hi * 8);
#pragma unroll
        for (int g = 0; g < 2; ++g) { const size_t tq = (size_t)b * SEQ + qb * 64 + wid * 8 + rb * 4 + 2 * g + hi;
            const f32x4 w0 = *(const f32x4*)(iw + tq * 8), w1 = *(const f32x4*)(iw + tq * 8 + 4);
            wv[rb][g][0] = w0[0]; wv[rb][g][1] = w0[1]; wv[rb][g][2] = w0[2]; wv[rb][g][3] = w0[3]; wv[rb][g][4] = w1[0]; wv[rb][g][5] = w1[1]; wv[rb][g][6] = w1[2]; wv[rb][g][7] = w1[3]; } }
    const int lkey = tid & 63, lch = tid >> 6;
    const bf16_t* ksrc = ik + ((size_t)b * SEQ + lkey) * 64 + lch * 8;
    LAS unsigned char* kdst = C.lds + (lch * 64 + lkey) * 16;
    const int NT = qb + 1;
    u32x4 rk = *(const u32x4*)ksrc;
    *(LAS u32x4*)kdst = rk;
    __syncthreads();
    for (int kt = 0; kt < NT; ++kt) {
        const int cur = kt & 1;
        if (kt + 1 < NT) rk = *(const u32x4*)(ksrc + (size_t)(kt + 1) * 64 * 64);
        const LAS unsigned char* kb = C.lds + cur * 8192;
        bf16x8 bfr[2][4];
#pragma unroll
        for (int kbk = 0; kbk < 2; ++kbk)
#pragma unroll
            for (int ks = 0; ks < 4; ++ks) bfr[kbk][ks] = *(const LAS bf16x8*)(kb + ((2 * ks + hi) * 64 + kbk * 32 + r32) * 16);
#pragma unroll
        for (int rb = 0; rb < 2; ++rb)
#pragma unroll
            for (int kbk = 0; kbk < 2; ++kbk) {
                f32x16 a = {};
#pragma unroll
                for (int ks = 0; ks < 4; ++ks) a = __builtin_amdgcn_mfma_f32_32x32x16_bf16(af[rb][ks], bfr[kbk][ks], a, 0, 0, 0);
#pragma unroll
                for (int g = 0; g < 2; ++g) { float s = 0.f;
#pragma unroll
                    for (int hh = 0; hh < 8; ++hh) s = fmaf(fmaxf(a[8 * g + hh], 0.f), wv[rb][g][hh], s);
                    const size_t tq = (size_t)b * SEQ + qb * 64 + wid * 8 + rb * 4 + 2 * g + hi;
                    score[tq * SEQ + kt * 64 + kbk * 32 + r32] = s; } }
        if (kt + 1 < NT) *(LAS u32x4*)(kdst + (cur ^ 1) * 8192) = rk;
        __syncthreads();
    }
}
__device__ __forceinline__ void phase_indexer(const Ctx& C) {
    for (int u0 = C.bid; u0 < NB * 32; u0 += C.G) {
        int u = u0; if (C.G == NB * 32) u = (C.bid & 7) * 32 + (C.bid >> 3);
        const int b = u >> 5, p = u & 31; idx_block(C, b, p); idx_block(C, b, 63 - p); }
}

__device__ __forceinline__ unsigned f2key(float f) { const unsigned u = __float_as_uint(f); return (u & 0x80000000u) ? ~u : (u | 0x80000000u); }
__device__ __forceinline__ int wave_total7(unsigned cv) {
    int t = 0;
#pragma unroll
    for (int b = 0; b < 7; ++b) t += __popcll(__ballot((cv >> b) & 1u)) << b;
    return t;
}
template <int NG>
__device__ __forceinline__ unsigned select_radix(const unsigned (&u)[64]) {
    unsigned prefix = 0u;
    for (int bit = 31; bit >= 0; --bit) {
        const unsigned cand = prefix | (1u << bit); unsigned cv = 0u;
#pragma unroll
        for (int i = 0; i < NG * 8; ++i) cv += (u[i] >= cand) ? 1u : 0u;
        const int cnt = wave_total7(cv);
        if (cnt >= 256) prefix = cand;
        if (cnt == 256) break;
    }
    return prefix;
}
__device__ __forceinline__ int wave_sum_dpp(int x) {
    x += __builtin_amdgcn_update_dpp(0, x, 0xB1, 0xf, 0xf, true);
    x += __builtin_amdgcn_update_dpp(0, x, 0x4E, 0xf, 0xf, true);
    x += __builtin_amdgcn_update_dpp(0, x, 0x141, 0xf, 0xf, true);
    x += __builtin_amdgcn_update_dpp(0, x, 0x140, 0xf, 0xf, true);
    x += __builtin_amdgcn_update_dpp(0, x, 0x142, 0xa, 0xf, false);
    x += __builtin_amdgcn_update_dpp(0, x, 0x143, 0xc, 0xf, false);
    return __builtin_amdgcn_readlane(x, 63);
}
__device__ __forceinline__ unsigned bfi32(unsigned m, unsigned x, unsigned y) { return (m & x) | (~m & y); }
__device__ __forceinline__ void bit_transpose32(unsigned* a) {
#pragma unroll
    for (int k = 0; k < 16; ++k) { const unsigned x = a[k], y = a[k + 16]; a[k] = __builtin_amdgcn_perm(y, x, 0x05040100u); a[k + 16] = __builtin_amdgcn_perm(y, x, 0x07060302u); }
#pragma unroll
    for (int k = 0; k < 32; ++k) if ((k & 8) == 0) { const unsigned x = a[k], y = a[k + 8]; a[k] = __builtin_amdgcn_perm(y, x, 0x06020400u); a[k + 8] = __builtin_amdgcn_perm(y, x, 0x07030501u); }
#pragma unroll
    for (int k = 0; k < 32; ++k) if ((k & 4) == 0) { const unsigned x = a[k], y = a[k + 4]; a[k] = bfi32(0x0f0f0f0fu, x, y << 4); a[k + 4] = bfi32(0x0f0f0f0fu, x >> 4, y); }
#pragma unroll
    for (int k = 0; k < 32; ++k) if ((k & 2) == 0) { const unsigned x = a[k], y = a[k + 2]; a[k] = bfi32(0x33333333u, x, y << 2); a[k + 2] = bfi32(0x33333333u, x >> 2, y); }
#pragma unroll
    for (int k = 0; k < 32; ++k) if ((k & 1) == 0) { const unsigned x = a[k], y = a[k + 1]; a[k] = bfi32(0x55555555u, x, y << 1); a[k + 1] = bfi32(0x55555555u, x >> 1, y); }
}
template <int NW>
__device__ __forceinline__ void select_bits(const float* row, int n, unsigned* mrow, int lane) {
    constexpr int W = 32 * NW;
    unsigned a[W];
    {   const u32x4* src = (const u32x4*)(row + lane * W);
#pragma unroll
        for (int i = 0; i < W / 4; ++i) { const u32x4 v = src[i];
#pragma unroll
            for (int j = 0; j < 4; ++j) { const unsigned u = v[j]; a[4 * i + j] = u ^ ((unsigned)((int)u >> 31) | 0x80000000u); } }
    }
#pragma unroll
    for (int blk = 0; blk < NW; ++blk) bit_transpose32(a + 32 * blk);
    unsigned alive[NW], above[NW];
#pragma unroll
    for (int w = 0; w < NW; ++w) { const int nv = n - lane * W - 32 * w; alive[w] = nv >= 32 ? 0xffffffffu : (nv <= 0 ? 0u : ((1u << nv) - 1u)); above[w] = 0u; }
    int cnta = 0; bool exact = false;
#pragma unroll
    for (int b = 31; b >= 0; --b) {
        unsigned o[NW]; int pc = 0;
#pragma unroll
        for (int w = 0; w < NW; ++w) { o[w] = alive[w] & a[32 * w + b]; pc += __popc(o[w]); }
        const int tot = cnta + wave_sum_dpp(pc);
        if (tot >= 256) {
#pragma unroll
            for (int w = 0; w < NW; ++w) alive[w] = o[w];
            if (tot == 256) { exact = true; break; }
        } else {
#pragma unroll
            for (int w = 0; w < NW; ++w) { above[w] |= o[w]; alive[w] ^= o[w]; }
            cnta = tot;
        }
    }
    if (!exact) {
        int pc = 0;
#pragma unroll
        for (int w = 0; w < NW; ++w) pc += __popc(alive[w]);
        const int ceq = wave_sum_dpp(pc), need = 256 - cnta;
        if (ceq > need) {
            int excl = 0;
#pragma unroll 1
            for (int L = 0; L < 63; ++L) { const int v = __builtin_amdgcn_readlane(pc, L); excl += (lane > L) ? v : 0; }
            int take = need - excl; take = take < 0 ? 0 : (take > pc ? pc : take);
            int c = pc;
            if (NW == 2) { while (c > take && alive[NW - 1] != 0u) { alive[NW - 1] &= ~(0x80000000u >> __clz(alive[NW - 1])); --c; } }
            while (c > take) { alive[0] &= ~(0x80000000u >> __clz(alive[0])); --c; }
        }
    }
    if (NW == 2) { u32x2 m; m.x = above[0] | alive[0]; m.y = above[NW - 1] | alive[NW - 1]; *(u32x2*)(mrow + 2 * lane) = m; }
    else { mrow[lane] = above[0] | alive[0]; mrow[64 + lane] = 0u; }
}
__device__ __forceinline__ void phase_select(const Ctx& C) {
    const float* score = WSP(float, WS_SCORE); unsigned long long* mask = WSP(unsigned long long, WS_MASK);
    const int gw = C.bid * NWAVES + C.wave, NGW = C.G * NWAVES, lane = C.lane;
    for (int idx = gw; idx < NTOK; idx += NGW) {
        const int q = idx & (SEQ - 1); const int n = q + 1; const float* row = score + (size_t)idx * SEQ;
        if (n <= 256) {
            const int lo = n - 64 * lane;
            const unsigned long long m = lo >= 64 ? ~0ull : (lo <= 0 ? 0ull : ((1ull << lo) - 1ull));
            mask[(size_t)idx * 64 + lane] = m;
        } else if (n <= 2048) select_bits<1>(row, n, (unsigned*)(mask + (size_t)idx * 64), lane);
        else select_bits<2>(row, n, (unsigned*)(mask + (size_t)idx * 64), lane);
    }
}

__device__ __forceinline__ int crow(int r, int hi) { return (r & 3) + 8 * (r >> 2) + 4 * hi; }
template <int DQK, bool MASKED>
__device__ __forceinline__ void attn_unit(const Ctx& C, int b, int h, int qb, const bf16_t* Q, const bf16_t* K, const bf16_t* VT, const unsigned* mask, bf16_t* O) {
    constexpr int NKS = DQK / 16, NCH = DQK / 8, KTB = NCH * 1024, BUF = KTB + 8192, QS = 8 * DQK;
    const int tid = C.tid, lane = C.lane, wid = C.wave, r32 = lane & 31, hi = lane >> 5;
    const int NT = 4 * (qb + 1);
    const size_t tok = (size_t)b * SEQ + qb * 256 + wid * 32 + r32;
    bf16x8 qf[NKS];
#pragma unroll
    for (int ks = 0; ks < NKS; ++ks) qf[ks] = *(const bf16x8*)(Q + tok * QS + h * DQK + ks * 16 + hi * 8);
    const int lrow = tid & 63, lch = tid >> 6;
    const bf16_t* ksrc0 = K + ((size_t)b * SEQ + lrow) * QS + h * DQK + lch * 8;
    const bf16_t* ksrc1 = ksrc0 + 64;
    const bf16_t* vsrc = VT + ((size_t)(b * 8 + h) * 64 + lrow) * SEQ + lch * 8;
    LAS unsigned char* kd0 = C.lds + (lch * 64 + lrow) * 16;
    LAS unsigned char* kd1 = C.lds + ((8 + lch) * 64 + lrow) * 16;
    LAS unsigned char* vd = C.lds + KTB + (lch * 64 + lrow) * 16;
    const bool k1 = (DQK > 64) && (tid < 256);
    u32x4 rk0, rk1 = {0u, 0u, 0u, 0u}, rv;
    rk0 = *(const u32x4*)ksrc0; if (k1) rk1 = *(const u32x4*)ksrc1; rv = *(const u32x4*)vsrc;
    *(LAS u32x4*)kd0 = rk0; if (k1) *(LAS u32x4*)kd1 = rk1; *(LAS u32x4*)vd = rv;
    u32x2 mw = {0u, 0u};
    if (MASKED) mw = *(const u32x2*)(mask + tok * 128);
    float mbias = 0.f, thr = -1e30f, lsum = 0.f;
    u32x4 qmw = {0u, 0u, 0u, 0u};
    const bf16x8 kone = __builtin_bit_cast(bf16x8, (u32x4){hi == 0 ? 0x3F80u : 0u, 0u, 0u, 0u});
    f32x16 o0 = {}, o1 = {};
    __syncthreads();
    for (int kt = 0; kt < NT; ++kt) {
        const int cur = kt & 1;
        u32x2 mwn = {0u, 0u};
        if (kt + 1 < NT) {
            rk0 = *(const u32x4*)(ksrc0 + (size_t)(kt + 1) * 64 * QS); if (k1) rk1 = *(const u32x4*)(ksrc1 + (size_t)(kt + 1) * 64 * QS);
            rv = *(const u32x4*)(vsrc + (kt + 1) * 64);
            if (MASKED) mwn = *(const u32x2*)(mask + tok * 128 + 2 * (kt + 1));
        }
        const LAS unsigned char* kb = C.lds + cur * BUF; const LAS unsigned char* vb = kb + KTB;
        f32x16 p0 = {}, p1 = {};
        bf16x8 kf[2 * NKS], vf[8];
#pragma unroll
        for (int ks = 0; ks < NKS; ++ks) {
            kf[2 * ks] = *(const LAS bf16x8*)(kb + ((2 * ks + hi) * 64 + r32) * 16);
            kf[2 * ks + 1] = *(const LAS bf16x8*)(kb + ((2 * ks + hi) * 64 + 32 + r32) * 16);
        }
#pragma unroll
        for (int s4 = 0; s4 < 4; ++s4) {
            vf[2 * s4] = *(const LAS bf16x8*)(vb + ((2 * s4 + hi) * 64 + r32) * 16);
            vf[2 * s4 + 1] = *(const LAS bf16x8*)(vb + ((2 * s4 + hi) * 64 + 32 + r32) * 16);
        }
        __builtin_amdgcn_sched_barrier(0);
#pragma unroll
        for (int ks = 0; ks < NKS; ++ks) {
            p0 = __builtin_amdgcn_mfma_f32_32x32x16_bf16(kf[2 * ks], qf[ks], p0, 0, 0, 0);
            p1 = __builtin_amdgcn_mfma_f32_32x32x16_bf16(kf[2 * ks + 1], qf[ks], p1, 0, 0, 0);
        }
        { const bf16x8 qm = __builtin_bit_cast(bf16x8, qmw);
          p0 = __builtin_amdgcn_mfma_f32_32x32x16_bf16(kone, qm, p0, 0, 0, 0); p1 = __builtin_amdgcn_mfma_f32_32x32x16_bf16(kone, qm, p1, 0, 0, 0); }
        if (MASKED) {
            const unsigned w0 = mw.x >> (4 * hi), w1 = mw.y >> (4 * hi);
#pragma unroll
            for (int r = 0; r < 16; ++r) { const int bit = (r & 3) + 8 * (r >> 2);
                const unsigned t0 = (unsigned)__builtin_amdgcn_sbfe((int)w0, bit, 1), t1 = (unsigned)__builtin_amdgcn_sbfe((int)w1, bit, 1);
                p0[r] = __uint_as_float((__float_as_uint(p0[r]) & t0) | (~t0 & 0xFF800000u));
                p1[r] = __uint_as_float((__float_as_uint(p1[r]) & t1) | (~t1 & 0xFF800000u)); }
        } else {
            if (kt >= NT - 4) { const int kb0 = (kt - (NT - 4)) * 64, qrel = wid * 32 + r32;
#pragma unroll
                for (int r = 0; r < 16; ++r) { const int kv = kb0 + crow(r, hi); if (kv > qrel) p0[r] = -INFINITY; if (kv + 32 > qrel) p1[r] = -INFINITY; } }
        }
        float mx;
        { float a0 = fmaxf(fmaxf(p0[0], p0[1]), p0[2]), a1 = fmaxf(fmaxf(p0[3], p0[4]), p0[5]), a2 = fmaxf(fmaxf(p0[6], p0[7]), p0[8]), a3 = fmaxf(fmaxf(p0[9], p0[10]), p0[11]);
          float a4 = fmaxf(fmaxf(p0[12], p0[13]), p0[14]), a5 = fmaxf(fmaxf(p0[15], p1[0]), p1[1]), a6 = fmaxf(fmaxf(p1[2], p1[3]), p1[4]), a7 = fmaxf(fmaxf(p1[5], p1[6]), p1[7]);
          float a8 = fmaxf(fmaxf(p1[8], p1[9]), p1[10]), a9 = fmaxf(fmaxf(p1[11], p1[12]), p1[13]), a10 = fmaxf(p1[14], p1[15]);
          a0 = fmaxf(fmaxf(a0, a1), a2); a3 = fmaxf(fmaxf(a3, a4), a5); a6 = fmaxf(fmaxf(a6, a7), a8); a9 = fmaxf(a9, a10);
          mx = fmaxf(fmaxf(a0, a3), fmaxf(a6, a9)); }
        mx = xmax32(mx);
        if (__any(mx > thr)) {
            const bool upd = mx > thr;
            const float mnew = upd ? __uint_as_float(pk2(mbias + mx, 0.f) << 16) : mbias;
            const float delta = mnew - mbias; const float alpha = (thr < 0.f) ? 1.f : __builtin_amdgcn_exp2f(-delta);
            mbias = mnew; thr = upd ? 4.f : thr;
            qmw.x = hi == 0 ? (pk2(-mnew, 0.f) & 0xffffu) : 0u;
            lsum *= alpha;
#pragma unroll
            for (int r = 0; r < 16; ++r) { o0[r] *= alpha; o1[r] *= alpha; p0[r] -= delta; p1[r] -= delta; }
        }
        {
#pragma unroll
            for (int r = 0; r < 16; ++r) { p0[r] = __builtin_amdgcn_exp2f(p0[r]); p1[r] = __builtin_amdgcn_exp2f(p1[r]); }
            float s0 = (p0[0] + p0[1]) + (p0[2] + p0[3]), s1 = (p0[4] + p0[5]) + (p0[6] + p0[7]), s2 = (p0[8] + p0[9]) + (p0[10] + p0[11]), s3 = (p0[12] + p0[13]) + (p0[14] + p0[15]);
            float s4 = (p1[0] + p1[1]) + (p1[2] + p1[3]), s5 = (p1[4] + p1[5]) + (p1[6] + p1[7]), s6 = (p1[8] + p1[9]) + (p1[10] + p1[11]), s7 = (p1[12] + p1[13]) + (p1[14] + p1[15]);
            lsum += ((s0 + s1) + (s2 + s3)) + ((s4 + s5) + (s6 + s7));
        }
        bf16x8 pf[4];
        { u32x4 t;
          t.x = pk2(p0[0], p0[1]); t.y = pk2(p0[2], p0[3]); t.z = pk2(p0[4], p0[5]); t.w = pk2(p0[6], p0[7]); pf[0] = __builtin_bit_cast(bf16x8, t);
          t.x = pk2(p0[8], p0[9]); t.y = pk2(p0[10], p0[11]); t.z = pk2(p0[12], p0[13]); t.w = pk2(p0[14], p0[15]); pf[1] = __builtin_bit_cast(bf16x8, t);
          t.x = pk2(p1[0], p1[1]); t.y = pk2(p1[2], p1[3]); t.z = pk2(p1[4], p1[5]); t.w = pk2(p1[6], p1[7]); pf[2] = __builtin_bit_cast(bf16x8, t);
          t.x = pk2(p1[8], p1[9]); t.y = pk2(p1[10], p1[11]); t.z = pk2(p1[12], p1[13]); t.w = pk2(p1[14], p1[15]); pf[3] = __builtin_bit_cast(bf16x8, t); }
#pragma unroll
        for (int s = 0; s < 4; ++s) {
            o0 = __builtin_amdgcn_mfma_f32_32x32x16_bf16(vf[2 * s], pf[s], o0, 0, 0, 0);
            o1 = __builtin_amdgcn_mfma_f32_32x32x16_bf16(vf[2 * s + 1], pf[s], o1, 0, 0, 0);
        }
        if (kt + 1 < NT) {
            const int nb = (cur ^ 1) * BUF;
            *(LAS u32x4*)(kd0 + nb) = rk0; if (k1) *(LAS u32x4*)(kd1 + nb) = rk1; *(LAS u32x4*)(vd + nb) = rv;
        }
        mw = mwn;
        __syncthreads();
    }
    lsum = xsum32(lsum);
    const float inv = 1.f / lsum;
    bf16_t* op = O + tok * 512 + h * 64 + 4 * hi;
#pragma unroll
    for (int i = 0; i < 4; ++i) {
        st_bf4(op + 8 * i, (f32x4){o0[4 * i] * inv, o0[4 * i + 1] * inv, o0[4 * i + 2] * inv, o0[4 * i + 3] * inv});
        st_bf4(op + 32 + 8 * i, (f32x4){o1[4 * i] * inv, o1[4 * i + 1] * inv, o1[4 * i + 2] * inv, o1[4 * i + 3] * inv});
    }
}
template <int DQK, bool MASKED>
__device__ __forceinline__ void phase_attn(const Ctx& C, const bf16_t* Q, const bf16_t* K, const bf16_t* VT, const unsigned* mask, bf16_t* O) {
    for (int u0 = C.bid; u0 < NB * 8 * 8; u0 += C.G) {
        int u = u0; if ((C.G & 7) == 0) { const int r = (C.bid >> 3) + (C.G >> 3) * (u0 / C.G); u = ((C.bid & 7) * 8 + (r >> 3)) * 8 + (r & 7); if (u >= NB * 8 * 8) u = u0; }
        const int bh = u >> 3, p = u & 7, b = bh >> 3, h = bh & 7;
        attn_unit<DQK, MASKED>(C, b, h, 15 - p, Q, K, VT, mask, O);
        attn_unit<DQK, MASKED>(C, b, h, p, Q, K, VT, mask, O); }
}

__device__ __forceinline__ void phase_gmlp(const Ctx& C, const float* lng, const float* lnb, const float* bs, int l) {
    const bf16_t* U = WSP(bf16_t, WS_U); const bf16_t* V = WSP(bf16_t, WS_V); bf16_t* OB = WSP(bf16_t, WS_OBUF) + (size_t)NTOK * 512;
    const bf16_t* WG = WSP(bf16_t, WS_WGM + l * SZ_WGM);
    const int tid = C.tid, lane = C.lane, wid = C.wave, r32 = lane & 31, hi = lane >> 5;
    constexpr int VST = 136;
    LAS bf16_t* vT = (LAS bf16_t*)C.lds;
    for (int un = C.bid; un < 512; un += C.G) {
        const int hf = un & 1, ch = un >> 1; const size_t t0 = (size_t)ch * 128;
        { const int pos = tid >> 2, q = tid & 3; const bf16_t* vr = V + (t0 + pos) * 512 + q * 32;
          float s = 0.f;
#pragma unroll
          for (int i = 0; i < 4; ++i)
#pragma unroll
              for (int j = 0; j < 4; ++j) { const u32x4 w = *(const u32x4*)(vr + i * 128 + j * 8); s += ((bflo(w.x) + bfhi(w.x)) + (bflo(w.y) + bfhi(w.y))) + ((bflo(w.z) + bfhi(w.z)) + (bflo(w.w) + bfhi(w.w))); }
          s += xswz<1>(s); s += xswz<2>(s);
          const float mean = s * (1.f / 512.f); float qv = 0.f;
          asm volatile("" ::: "memory");
#pragma unroll
          for (int i = 0; i < 4; ++i)
#pragma unroll
              for (int j = 0; j < 4; ++j) { const u32x4 w = *(const u32x4*)(vr + i * 128 + j * 8); float d;
                  d = bflo(w.x) - mean; qv += d * d; d = bfhi(w.x) - mean; qv += d * d; d = bflo(w.y) - mean; qv += d * d; d = bfhi(w.y) - mean; qv += d * d;
                  d = bflo(w.z) - mean; qv += d * d; d = bfhi(w.z) - mean; qv += d * d; d = bflo(w.w) - mean; qv += d * d; d = bfhi(w.w) - mean; qv += d * d; }
          qv += xswz<1>(qv); qv += xswz<2>(qv);
          const float rstd = rsqrtf(qv * (1.f / 512.f) + LN_EPS);
          asm volatile("" ::: "memory");
          const bf16_t* vh = vr + hf * 256;
#pragma unroll
          for (int ii = 0; ii < 2; ++ii)
#pragma unroll
              for (int j = 0; j < 4; ++j) { const u32x4 w = *(const u32x4*)(vh + ii * 128 + j * 8);
                  const int cl = ii * 128 + q * 32 + j * 8; const int c0 = hf * 256 + cl;
                  const f32x4 g0 = *(const f32x4*)(lng + c0), g1 = *(const f32x4*)(lng + c0 + 4), b0 = *(const f32x4*)(lnb + c0), b1 = *(const f32x4*)(lnb + c0 + 4);
                  LAS bf16_t* dp = vT + cl * VST + pos;
                  dp[0 * VST] = (bf16_t)(pk2((bflo(w.x) - mean) * rstd * g0[0] + b0[0], 0.f) & 0xffff);
                  dp[1 * VST] = (bf16_t)(pk2((bfhi(w.x) - mean) * rstd * g0[1] + b0[1], 0.f) & 0xffff);
                  dp[2 * VST] = (bf16_t)(pk2((bflo(w.y) - mean) * rstd * g0[2] + b0[2], 0.f) & 0xffff);
                  dp[3 * VST] = (bf16_t)(pk2((bfhi(w.y) - mean) * rstd * g0[3] + b0[3], 0.f) & 0xffff);
                  dp[4 * VST] = (bf16_t)(pk2((bflo(w.z) - mean) * rstd * g1[0] + b1[0], 0.f) & 0xffff);
                  dp[5 * VST] = (bf16_t)(pk2((bfhi(w.z) - mean) * rstd * g1[1] + b1[1], 0.f) & 0xffff);
                  dp[6 * VST] = (bf16_t)(pk2((bflo(w.w) - mean) * rstd * g1[2] + b1[2], 0.f) & 0xffff);
                  dp[7 * VST] = (bf16_t)(pk2((bfhi(w.w) - mean) * rstd * g1[3] + b1[3], 0.f) & 0xffff); } }
        __syncthreads();
        { const int gl = wid >> 1, ih = wid & 1, g = 4 * hf + gl;
          f32x16 acc[2][2] = {};
          const int nks = 4 * (ih + 1);
          const bf16_t* wrow = WG + ((size_t)g * 128 + ih * 64 + r32) * 128 + hi * 8;
          for (int ks = 0; ks < nks; ++ks) {
              bf16x8 a[2], bb[2];
#pragma unroll
              for (int mb = 0; mb < 2; ++mb) a[mb] = *(const bf16x8*)(wrow + (size_t)mb * 32 * 128 + ks * 16);
#pragma unroll
              for (int nb = 0; nb < 2; ++nb) bb[nb] = *(const LAS bf16x8*)(vT + (gl * 64 + nb * 32 + r32) * VST + ks * 16 + hi * 8);
#pragma unroll
              for (int mb = 0; mb < 2; ++mb)
#pragma unroll
                  for (int nb = 0; nb < 2; ++nb) acc[mb][nb] = __builtin_amdgcn_mfma_f32_32x32x16_bf16(a[mb], bb[nb], acc[mb][nb], 0, 0, 0);
          }
#pragma unroll
          for (int mb = 0; mb < 2; ++mb)
#pragma unroll
              for (int r = 0; r < 16; ++r) { const int i = ih * 64 + mb * 32 + crow(r, hi); const float bi = bs[g * 128 + i];
#pragma unroll
                  for (int nb = 0; nb < 2; ++nb) { const size_t o = (t0 + i) * 512 + g * 64 + nb * 32 + r32;
                      const float uu = bf2f(U[o]); OB[o] = (bf16_t)(pk2(uu * (acc[mb][nb][r] + bi), 0.f) & 0xffff); } } }
        __syncthreads();
    }
}

__device__ __forceinline__ float wave_sum(float v) {
    v += xswz<1>(v); v += xswz<2>(v); v += xswz<4>(v); v += xswz<8>(v); v += xswz<16>(v); return xsum32(v);
}
__device__ __forceinline__ void phase_ln1_router(const Ctx& C, const float* g1, const float* b1, const float* rw, const float* rbias, int l, bool dry) {
    constexpr int RST = 1028;
    LAS float* rwT = (LAS float*)C.lds;
    LAS float* gws = (LAS float*)(C.lds + 32 * RST * 4);
    LAS float* bws = gws + 32;
    LAS float* stat = bws + 32;
    LAS int* trec = (LAS int*)(C.lds + MISC_OFF + 64);
    LAS int* tpos = trec + 512;
    const int tid = C.tid, lane = C.lane, wid = C.wave;
    const bf16_t* xin = WSP(bf16_t, WS_XB); const bf16_t* yo = WSP(bf16_t, WS_OBUF); bf16_t* xb = dry ? WSP(bf16_t, WS_DRY + (size_t)NTOK * DM * 4) : WSP(bf16_t, WS_XB);
    int* tke = dry ? WSP(int, WS_DRY + (size_t)NTOK * DM * 6) : WSP(int, WS_TKE); int* tkp = dry ? WSP(int, WS_DRY + (size_t)NTOK * DM * 6 + NSLOT * 4) : WSP(int, WS_TKP); float* tkw = dry ? WSP(float, WS_DRY + (size_t)NTOK * DM * 6 + NSLOT * 8) : WSP(float, WS_TKW);
    int* ccnt = dry ? WSP(int, WS_DRY + (size_t)NTOK * DM * 6 + NSLOT * 12) : WSP(int, WS_CCNT);
    for (int i = tid; i < 1024 * 32; i += 512) { const int k = i >> 5, e = i & 31; rwT[e * RST + k] = rw[i] * g1[k]; }
    __syncthreads();
    for (int e = wid; e < 32; e += NWAVES) {
        float sg = 0.f, sb = 0.f;
#pragma unroll
        for (int j = 0; j < 16; ++j) { const int k = lane + 64 * j; sg += rwT[e * RST + k]; sb += b1[k] * rw[k * 32 + e]; }
        sg = wave_sum(sg); sb = wave_sum(sb);
        if (lane == 0) { gws[e] = sg; bws[e] = sb + rbias[e]; }
    }
    const int fr = lane & 15, fq = lane >> 4;
    for (int chunk = C.bid; chunk < NTOK / 128; chunk += C.G) {
        __syncthreads();
        const size_t tok0 = (size_t)chunk * 128 + wid * 16;
        f32x4 acc0 = {0.f, 0.f, 0.f, 0.f}, acc1 = {0.f, 0.f, 0.f, 0.f};
        u32x2 zp[64]; float s1 = 0.f, s2 = 0.f;
        { const bf16_t* zr = xin + (tok0 + fr) * 1024 + 4 * fq; const bf16_t* yr = yo + (tok0 + fr) * 1024 + 4 * fq; const LAS float* w0 = rwT + fr * RST + 4 * fq; const LAS float* w1 = rwT + (16 + fr) * RST + 4 * fq;
#pragma unroll
          for (int sI = 0; sI < 64; ++sI) { const u32x2 hw = *(const u32x2*)(zr + 16 * sI); const f32x4 h4 = {bflo(hw.x), bfhi(hw.x), bflo(hw.y), bfhi(hw.y)}; const u32x2 yw = *(const u32x2*)(yr + 16 * sI);
              const f32x4 a4 = h4 * DN_ALPHA + (f32x4){bflo(yw.x), bfhi(yw.x), bflo(yw.y), bfhi(yw.y)};
              s1 += (a4[0] + a4[1]) + (a4[2] + a4[3]); s2 += (a4[0] * a4[0] + a4[1] * a4[1]) + (a4[2] * a4[2] + a4[3] * a4[3]);
              u32x2 zz; zz.x = pk2(a4[0], a4[1]); zz.y = pk2(a4[2], a4[3]); zp[sI] = zz;
              const f32x4 b0 = *(const LAS f32x4*)(w0 + 16 * sI), b1v = *(const LAS f32x4*)(w1 + 16 * sI);
#pragma unroll
              for (int j = 0; j < 4; ++j) { acc0 = __builtin_amdgcn_mfma_f32_16x16x4f32(a4[j], b0[j], acc0, 0, 0, 0); acc1 = __builtin_amdgcn_mfma_f32_16x16x4f32(a4[j], b1v[j], acc1, 0, 0, 0); }
              if ((sI & 3) == 3) __builtin_amdgcn_sched_barrier(0); } }
        s1 += xswz<16>(s1); s1 = xsum32(s1); s2 += xswz<16>(s2); s2 = xsum32(s2);
        const float mean = s1 * (1.f / 1024.f); const float rstd = rsqrtf(fmaxf(s2 * (1.f / 1024.f) - mean * mean, 0.f) + LN_EPS);
        { u32x2* xo = (u32x2*)(xb + (tok0 + fr) * 1024 + 4 * fq); const float* gp = g1 + 4 * fq; const float* bp = b1 + 4 * fq;
#pragma unroll
          for (int sI = 0; sI < 64; ++sI) { const f32x4 g4 = *(const f32x4*)(gp + 16 * sI), b4 = *(const f32x4*)(bp + 16 * sI); const u32x2 zz = zp[sI];
              const f32x4 z4 = {bflo(zz.x), bfhi(zz.x), bflo(zz.y), bfhi(zz.y)}; const f32x4 o = (z4 - mean) * rstd * g4 + b4;
              u32x2 w; w.x = pk2(o[0], o[1]); w.y = pk2(o[2], o[3]); xo[4 * sI] = w;
              if ((sI & 7) == 7) __builtin_amdgcn_sched_barrier(0); } }
        if (fq == 0) { stat[(wid * 16 + fr) * 2] = mean; stat[(wid * 16 + fr) * 2 + 1] = rstd; }
        LDS_WAIT();
        const float gw0 = gws[fr], gw1 = gws[16 + fr], bw0 = bws[fr], bw1 = bws[16 + fr];
#pragma unroll
        for (int r = 0; r < 4; ++r) {
            const int tl = wid * 16 + 4 * fq + r; const float mean = stat[tl * 2], rstd = stat[tl * 2 + 1];
            const float l0 = rstd * (acc0[r] - mean * gw0) + bw0, l1 = rstd * (acc1[r] - mean * gw1) + bw1;
            unsigned long long k0 = ((unsigned long long)f2key(l0) << 32) | (unsigned)(31 - fr), k1 = ((unsigned long long)f2key(l1) << 32) | (unsigned)(31 - (16 + fr));
            int te[4]; float tv[4];
#pragma unroll
            for (int k = 0; k < 4; ++k) {
                unsigned long long mxk = k0 > k1 ? k0 : k1;
#define MX_STEP(o) do { const unsigned long long ot = ((unsigned long long)xswzu<o>((unsigned)(mxk >> 32)) << 32) | xswzu<o>((unsigned)mxk); mxk = ot > mxk ? ot : mxk; } while (0)
                MX_STEP(1); MX_STEP(2); MX_STEP(4); MX_STEP(8);
#undef MX_STEP
                te[k] = 31 - (int)(mxk & 31ull); const unsigned ku = (unsigned)(mxk >> 32); tv[k] = __uint_as_float((ku & 0x80000000u) ? (ku & 0x7fffffffu) : ~ku);
                if (te[k] == fr) k0 = 0ull; if (te[k] == 16 + fr) k1 = 0ull;
            }
            const float e1 = __expf(tv[1] - tv[0]), e2 = __expf(tv[2] - tv[0]), e3 = __expf(tv[3] - tv[0]); const float inv = 1.f / (1.f + e1 + e2 + e3);
            if (fr == 0) {
                const float ww[4] = {inv, e1 * inv, e2 * inv, e3 * inv}; const size_t tok = (size_t)chunk * 128 + tl;
#pragma unroll
                for (int k = 0; k < 4; ++k) { trec[tl * 4 + k] = te[k]; tkw[tok * 4 + k] = ww[k]; }
            }
        }
        __syncthreads();
        if (tid < 32) { int c = 0; for (int r = 0; r < 512; ++r) { if (trec[r] == tid) { tpos[r] = c; ++c; } } ccnt[chunk * 32 + tid] = c; }
        __syncthreads();
        { const size_t o = (size_t)chunk * 512 + tid; tke[o] = trec[tid]; tkp[o] = tpos[tid]; }
        __syncthreads();
    }
}

__device__ __forceinline__ void moe_tables(const Ctx& C, int l) {
    LAS int* cnt = (LAS int*)(C.lds + MISC_OFF + 64); LAS int* tb = cnt + 32; LAS int* tile_e = tb + 40;
    const int* ccnt = WSP(int, WS_CCNT);
    {   LAS int* part = (LAS int*)C.lds;
        int a = 0;
#pragma unroll
        for (int k = 0; k < NTOK / 128 / 16; ++k) a += ccnt[((C.tid >> 5) + 16 * k) * 32 + (C.tid & 31)];
        part[C.tid] = a;
        __syncthreads();
        if (C.tid < 32) { int t = 0;
#pragma unroll
            for (int k = 0; k < 16; ++k) t += part[k * 32 + C.tid];
            cnt[C.tid] = t; }
    }
    __syncthreads();
    if (C.tid == 0) { int a = 0; for (int e = 0; e < 32; ++e) { tb[e] = a; a += (cnt[e] + 255) >> 8; } tb[32] = a; }
    __syncthreads();
    if (C.tid < 32) { for (int t = tb[C.tid]; t < tb[C.tid + 1]; ++t) tile_e[t] = C.tid; }
    __syncthreads();
}
__device__ __forceinline__ void phase_dispatch(const Ctx& C, int l) {
    moe_tables(C, l);
    LAS int* cnt = (LAS int*)(C.lds + MISC_OFF + 64); LAS int* tb = cnt + 32;
    const int* tke = WSP(int, WS_TKE); int* tkp = WSP(int, WS_TKP); int* stk = WSP(int, WS_STK);
    LAS int* cbase = (LAS int*)C.lds;
    { const int* ccnt = WSP(int, WS_CCNT); if (C.tid < 32) { int a = 0; for (int c = 0; c < NTOK / 128; ++c) { cbase[c * 32 + C.tid] = a; a += ccnt[c * 32 + C.tid]; } } }
    __syncthreads();
    for (int s = C.bid * 512 + C.tid; s < NSLOT; s += C.G * 512) {
        const int e = tke[s], p = cbase[(s >> 9) * 32 + e] + tkp[s]; const int row = tb[e] * 256 + p;
        stk[row] = s >> 2; tkp[s] = row;
    }
    for (int e = C.bid; e < 32; e += C.G) { const int r0 = tb[e] * 256 + cnt[e], r1 = tb[e + 1] * 256; for (int r = r0 + C.tid; r < r1; r += 512) stk[r] = 0; }
}

__device__ __forceinline__ void phase_ln2(const Ctx& C, const float* g2, const float* b2, float* outp, int l, bool dry) {
    const bf16_t* xin = WSP(bf16_t, WS_XB); bf16_t* xb = dry ? WSP(bf16_t, WS_DRY + (size_t)NTOK * DM * 4) : WSP(bf16_t, WS_XB); const bf16_t* y = WSP(bf16_t, WS_Y);
    const int* tkrow = WSP(int, WS_TKP); const float* tkw = WSP(float, WS_TKW);
    if (dry) outp = WSP(float, WS_DRY);
    const int gw = C.bid * NWAVES + C.wave, NGW = C.G * NWAVES, lane = C.lane;
    f32x4 gg[4], bb[4];
#pragma unroll
    for (int j = 0; j < 4; ++j) { gg[j] = *(const f32x4*)(g2 + 4 * (lane + 64 * j)); bb[j] = *(const f32x4*)(b2 + 4 * (lane + 64 * j)); }
    const bool last = (l == NLAYER - 1);
    for (int tok = gw; tok < NTOK; tok += NGW) {
        const u32x2* xr = (const u32x2*)(xin + (size_t)tok * 1024);
        f32x4 v[4]; float s = 0.f;
        int rk[4]; float wk[4];
#pragma unroll
        for (int k = 0; k < 4; ++k) { rk[k] = tkrow[(size_t)tok * 4 + k]; wk[k] = tkw[(size_t)tok * 4 + k]; }
#pragma unroll
        for (int j = 0; j < 4; ++j) { const u32x2 hw = xr[lane + 64 * j]; const f32x4 x1 = {bflo(hw.x), bfhi(hw.x), bflo(hw.y), bfhi(hw.y)}; f32x4 f[4];
#pragma unroll
            for (int k = 0; k < 4; ++k) { const u32x2 w = *(const u32x2*)(y + (size_t)rk[k] * 1024 + 4 * (lane + 64 * j)); f[k] = (f32x4){bflo(w.x), bfhi(w.x), bflo(w.y), bfhi(w.y)} * wk[k]; }
            v[j] = x1 * DN_ALPHA + ((f[0] + f[1]) + (f[2] + f[3]));
            s += (v[j][0] + v[j][1]) + (v[j][2] + v[j][3]); }
        const float mean = wave_sum(s) * (1.f / 1024.f); float s2 = 0.f;
#pragma unroll
        for (int j = 0; j < 4; ++j) { v[j] = v[j] - mean; s2 += (v[j][0] * v[j][0] + v[j][1] * v[j][1]) + (v[j][2] * v[j][2] + v[j][3] * v[j][3]); }
        const float rstd = rsqrtf(wave_sum(s2) * (1.f / 1024.f) + LN_EPS);
        if (last) { f32x4* orow = (f32x4*)(outp + (size_t)tok * 1024);
#pragma unroll
            for (int j = 0; j < 4; ++j) orow[lane + 64 * j] = v[j] * rstd * gg[j] + bb[j];
        } else { u32x2* xbr = (u32x2*)(xb + (size_t)tok * 1024);
#pragma unroll
            for (int j = 0; j < 4; ++j) { const f32x4 o = v[j] * rstd * gg[j] + bb[j]; u32x2 w; w.x = pk2(o[0], o[1]); w.y = pk2(o[2], o[3]); xbr[lane + 64 * j] = w; } }
    }
}

#ifdef DBG_STOP
__device__ __forceinline__ void dbg_dump(const Ctx& C, float* out) {
    const int gt = C.bid * 512 + C.tid, NGT = C.G * 512;
    const bf16_t* qa = WSP(bf16_t, WS_QA); const bf16_t* ka = WSP(bf16_t, WS_KA); const bf16_t* vat = WSP(bf16_t, WS_VAT); const bf16_t* iq = WSP(bf16_t, WS_IQ);
    const bf16_t* u = WSP(bf16_t, WS_U); const bf16_t* v = WSP(bf16_t, WS_V); const bf16_t* cdq = WSP(bf16_t, WS_CDQ); const bf16_t* cdkv = WSP(bf16_t, WS_CDKV);
    const bf16_t* gate = WSP(bf16_t, WS_GATE); const bf16_t* qc = WSP(bf16_t, WS_QC); const bf16_t* kc = WSP(bf16_t, WS_KC); const bf16_t* vct = WSP(bf16_t, WS_VCT);
    const unsigned* mask = WSP(unsigned, WS_MASK); const bf16_t* ob = WSP(bf16_t, WS_OBUF); const bf16_t* mg = WSP(bf16_t, WS_MERGED); const float* xr = WSP(float, WS_XRES);
    const bf16_t* y = WSP(bf16_t, WS_Y); const float* sc = WSP(float, WS_SCORE); const bf16_t* ik = WSP(bf16_t, WS_IK); const float* iw = WSP(float, WS_IW); const float* ssq = WSP(float, WS_SSQ);
    const bf16_t* hb = WSP(bf16_t, WS_H); const bf16_t* xg = WSP(bf16_t, WS_XG); const int* stk = WSP(int, WS_STK);
    for (size_t i = gt; i < (size_t)NTOK * DM; i += NGT) {
        const size_t h = i & ((size_t)NTOK * 512 - 1);
        float a = 0.f;
#if DBG_STOP >= 1
        a += bf2f(qa[h]) + bf2f(ka[h]) + bf2f(vat[h]) + bf2f(iq[h]) + bf2f(u[h]) + bf2f(v[h]) + bf2f(cdq[i & ((size_t)NTOK * 256 - 1)]) + bf2f(cdkv[i & ((size_t)NTOK * 256 - 1)]);
        a += bf2f(gate[i]) + bf2f(gate[i + (size_t)NTOK * DM]) + bf2f(gate[i + (size_t)2 * NTOK * DM]) + bf2f(ik[i & ((size_t)NTOK * 64 - 1)]) + iw[i & ((size_t)NTOK * 8 - 1)] + ssq[i & ((size_t)NTOK * 8 - 1)];
#endif
#if DBG_STOP >= 2
        a += bf2f(qc[i % ((size_t)NTOK * 768)]) + bf2f(kc[i % ((size_t)NTOK * 768)]) + bf2f(vct[h]) + bf2f(ob[(size_t)NTOK * 512 + h]);
#ifdef DBG_BITS
        a = (float)(__float_as_uint(sc[i]) & 0xfffu) + (float)(__float_as_uint(sc[i + (size_t)NTOK * DM]) & 0xfffu) + (float)(__float_as_uint(sc[i + (size_t)2 * NTOK * DM]) & 0xfffu) + (float)(__float_as_uint(sc[i + (size_t)3 * NTOK * DM]) & 0xfffu);
        a += (float)(iq[h] & 0xff) + (float)(ik[i & ((size_t)NTOK * 64 - 1)] & 0xff) + (float)(__float_as_uint(iw[i & ((size_t)NTOK * 8 - 1)]) & 0xfffu);
#else
        a += sc[i] + sc[i + (size_t)NTOK * DM] + sc[i + (size_t)2 * NTOK * DM] + sc[i + (size_t)3 * NTOK * DM];
#endif
#endif
#if DBG_STOP >= 3
        { const unsigned m = mask[i & ((size_t)NTOK * 128 - 1)]; a += (float)(m & 0xffffu) + (float)(m >> 16); } a += bf2f(ob[(size_t)2 * NTOK * 512 + h]);
#endif
#if DBG_STOP >= 4
        a += bf2f(ob[h]);
#endif
#if DBG_STOP >= 5
        a += bf2f(mg[i]);
#endif
#if DBG_STOP >= 6
        a += xr[i];
#endif
#if DBG_STOP >= 8
        a += (float)stk[i % (size_t)NSLOT_PAD] + bf2f(xg[i]) + bf2f(xg[i + (size_t)NTOK * DM]) + bf2f(xg[i + (size_t)2 * NTOK * DM]) + bf2f(xg[i + (size_t)3 * NTOK * DM]);
#endif
#if DBG_STOP >= 9
        a += bf2f(hb[i]) + bf2f(hb[i + (size_t)NTOK * DM]) + bf2f(hb[i + (size_t)2 * NTOK * DM]) + bf2f(hb[i + (size_t)3 * NTOK * DM]);
#endif
#if DBG_STOP >= 10
        a += bf2f(y[i]) + bf2f(y[i + (size_t)NTOK * DM]) + bf2f(y[i + (size_t)2 * NTOK * DM]) + bf2f(y[i + (size_t)3 * NTOK * DM]);
#endif
        out[i] = a;
    }
}
#endif

#ifdef DBG_CHECK
constexpr int CW_ERR = 20000;
__device__ __forceinline__ void err_max(unsigned* ctl, int k, float e) { if (!(e >= 0.f)) e = 1e30f; atomicMax(ctl + CW_ERR + k, __float_as_uint(e)); }
__device__ __forceinline__ float rope1(float x1, float x2, float c, float s_) { return x1 * c - x2 * s_; }
__device__ __forceinline__ float rope2(float x1, float x2, float c, float s_) { return x2 * c + x1 * s_; }
__device__ __forceinline__ void chk_proj(const Ctx& C, const Args& A) {
    unsigned* ctl = WSP(unsigned, WS_CTL); LAS float* pj = (LAS float*)C.lds;
    const int tok = (C.bid * 131 + 7) % NTOK; const int b = tok >> 12, sp = tok & 4095, ps = (sp & ~15) | perm16(sp & 15);
    const float* x = A.in[0] + (size_t)tok * DM; const float* w = A.in[2];
    for (int n = C.tid; n < 3560; n += 512) { float a = 0.f; for (int k = 0; k < DM; ++k) a = fmaf(x[k], w[(size_t)k * NIN_SRC + n], a); pj[n] = a; }
    __syncthreads();
    const float pos = (float)((const int*)A.in[1])[tok];
    const bf16_t* qa = WSP(bf16_t, WS_QA); const bf16_t* ka = WSP(bf16_t, WS_KA); const bf16_t* vat = WSP(bf16_t, WS_VAT); const bf16_t* iq = WSP(bf16_t, WS_IQ); const bf16_t* ik = WSP(bf16_t, WS_IK); const float* iw = WSP(float, WS_IW);
    float e = 0.f;
    for (int c = C.tid; c < 512; c += 512) { const int d = c & 63; const int base = c - d;
        float cq, ck, ci;
        if (d < 16) { const int i = d & 7; const float ang = pos * powf(500000.f, -(float)i / 8.f), cs = cosf(ang), sn = sinf(ang);
            const int o1 = base + i, o2 = base + 8 + i;
            cq = d < 8 ? rope1(pj[o1], pj[o2], cs, sn) : rope2(pj[o1], pj[o2], cs, sn);
            ck = d < 8 ? rope1(pj[512 + o1], pj[512 + o2], cs, sn) : rope2(pj[512 + o1], pj[512 + o2], cs, sn);
            ci = d < 8 ? rope1(pj[1536 + o1], pj[1536 + o2], cs, sn) : rope2(pj[1536 + o1], pj[1536 + o2], cs, sn);
        } else { cq = pj[c]; ck = pj[512 + c]; ci = pj[1536 + c]; }
        e = fmaxf(e, fabsf(bf2f(qa[(size_t)tok * 512 + c]) - cq * QSCALE_A)); e = fmaxf(e, fabsf(bf2f(ka[(size_t)tok * 512 + c]) - ck)); e = fmaxf(e, fabsf(bf2f(iq[(size_t)tok * 512 + c]) - ci));
        const int h = c >> 6; e = fmaxf(e, fabsf(bf2f(vat[((size_t)(b * 8 + h) * 64 + d) * SEQ + ps]) - pj[1024 + c]));
        if (c < 64) { float cik; if (c < 16) { const int i = c & 7; const float ang = pos * powf(500000.f, -(float)i / 8.f), cs = cosf(ang), sn = sinf(ang);
                cik = c < 8 ? rope1(pj[2048 + i], pj[2048 + 8 + i], cs, sn) : rope2(pj[2048 + i], pj[2048 + 8 + i], cs, sn); } else cik = pj[2048 + c];
            e = fmaxf(e, fabsf(bf2f(ik[(size_t)tok * 64 + c]) - cik)); }
        if (c < 8) e = fmaxf(e, 8.f * fabsf(iw[(size_t)tok * 8 + c] - pj[2112 + c] * IW_SCALE));
    }
    err_max(ctl, 0, e);
    __syncthreads();
    LAS float* cqn = pj + 3600; LAS float* ckn = cqn + 256;
    { float sq = 0.f; for (int k = 0; k < 256; ++k) sq += pj[3144 + k] * pj[3144 + k]; const float r = rsqrtf(sq / 256.f + RMS_EPS);
      float sk = 0.f; for (int k = 0; k < 128; ++k) sk += pj[3400 + k] * pj[3400 + k]; const float rk = rsqrtf(sk / 128.f + RMS_EPS);
      if (C.tid < 256) cqn[C.tid] = pj[3144 + C.tid] * r * A.in[7][C.tid]; if (C.tid < 128) ckn[C.tid] = pj[3400 + C.tid] * rk * A.in[8][C.tid]; }
    __syncthreads();
    const bf16_t* qc = WSP(bf16_t, WS_QC); const bf16_t* kc = WSP(bf16_t, WS_KC); const bf16_t* vct = WSP(bf16_t, WS_VCT);
    LAS float* qraw = ckn + 128;
    for (int n = C.tid; n < 768; n += 512) { float a = 0.f; for (int k = 0; k < 256; ++k) a = fmaf(cqn[k], A.in[9][(size_t)k * 768 + n], a); qraw[n] = a; }
    __syncthreads();
    float e2 = 0.f;
    for (int n = C.tid; n < 768; n += 512) { const int h = n / 96, d = n % 96; float v;
        if (d >= 64) { const int i = (d - 64) & 15; const float ang = pos * powf(500000.f, -(float)i / 16.f), cs = cosf(ang), sn = sinf(ang); const int o1 = h * 96 + 64 + i, o2 = o1 + 16;
            v = (d - 64) < 16 ? rope1(qraw[o1], qraw[o2], cs, sn) : rope2(qraw[o1], qraw[o2], cs, sn); } else v = qraw[n];
        e2 = fmaxf(e2, fabsf(bf2f(qc[(size_t)tok * 768 + n]) - v * QSCALE_C)); }
    for (int n = C.tid; n < 1024; n += 512) { float a = 0.f; for (int k = 0; k < 128; ++k) a = fmaf(ckn[k], A.in[10][(size_t)k * 1024 + n], a);
        const int h = n >> 7, wv = n & 127;
        if (wv < 64) e2 = fmaxf(e2, fabsf(bf2f(kc[(size_t)tok * 768 + h * 96 + wv]) - a));
        else e2 = fmaxf(e2, fabsf(bf2f(vct[((size_t)(b * 8 + h) * 64 + (wv - 64)) * SEQ + ps]) - a)); }
    if (C.tid < 32) { const int i = C.tid & 15; const float ang = pos * powf(500000.f, -(float)i / 16.f), cs = cosf(ang), sn = sinf(ang);
        const float v = C.tid < 16 ? rope1(pj[3528 + i], pj[3528 + 16 + i], cs, sn) : rope2(pj[3528 + i], pj[3528 + 16 + i], cs, sn);
        for (int h = 0; h < 8; ++h) e2 = fmaxf(e2, fabsf(bf2f(kc[(size_t)tok * 768 + h * 96 + 64 + C.tid]) - v)); }
    err_max(ctl, 1, e2);
    __syncthreads();
}
__device__ __forceinline__ void chk_attn(const Ctx& C) {
    unsigned* ctl = WSP(unsigned, WS_CTL);
    const int b = C.bid & 7, q = (C.bid * 977 + 300 + 13 * (C.bid >> 3)) & 4095; const size_t tq = (size_t)b * SEQ + q; const int n = q + 1;
    LAS float* sc = (LAS float*)C.lds;
    LAS float* pr = sc + 4096;
    LAS float* red = pr + 4096;
    const bf16_t* iq = WSP(bf16_t, WS_IQ); const bf16_t* ik = WSP(bf16_t, WS_IK); const float* iw = WSP(float, WS_IW); const float* score = WSP(float, WS_SCORE);
    float e1 = 0.f;
    for (int k = C.tid; k < n; k += 512) { float s_ = 0.f;
        for (int h = 0; h < 8; ++h) { float d = 0.f; for (int j = 0; j < 64; ++j) d = fmaf(bf2f(iq[tq * 512 + h * 64 + j]), bf2f(ik[((size_t)b * SEQ + k) * 64 + j]), d); s_ = fmaf(fmaxf(d, 0.f), iw[tq * 8 + h], s_); }
        sc[k] = s_; e1 = fmaxf(e1, fabsf(s_ - score[tq * SEQ + k])); }
    err_max(ctl, 2, e1);
    __syncthreads();
    const unsigned* mask = WSP(unsigned, WS_MASK); float e2 = 0.f;
    for (int k = C.tid; k < 4096; k += 512) { bool sel = false;
        if (k < n) { if (n <= 256) sel = true; else { const float sk = score[tq * SEQ + k]; int rank = 0; for (int j = 0; j < n; ++j) { const float sj = score[tq * SEQ + j]; rank += (sj > sk || (sj == sk && j < k)) ? 1 : 0; } sel = rank < 256; } }
        const bool mb = (mask[tq * 128 + (k >> 5)] >> (k & 31)) & 1u; if (sel != mb) e2 = 1.f; }
    err_max(ctl, 3, e2);
    const int h = (C.bid >> 3) & 7;
    for (int which = 0; which < 2; ++which) {
        const bf16_t* Q = which ? WSP(bf16_t, WS_QC) : WSP(bf16_t, WS_QA); const bf16_t* K = which ? WSP(bf16_t, WS_KC) : WSP(bf16_t, WS_KA); const bf16_t* VT = which ? WSP(bf16_t, WS_VCT) : WSP(bf16_t, WS_VAT);
        const bf16_t* O = WSP(bf16_t, WS_OBUF) + (which ? (size_t)2 * NTOK * 512 : 0); const int dq = which ? 96 : 64, qs = 8 * dq;
        __syncthreads();
        float mx = -INFINITY;
        for (int k = C.tid; k < 4096; k += 512) { float lgt = -INFINITY;
            const bool ok = k < n && (which || ((mask[tq * 128 + (k >> 5)] >> (k & 31)) & 1u));
            if (ok) { float d = 0.f; for (int j = 0; j < dq; ++j) d = fmaf(bf2f(Q[tq * qs + h * dq + j]), bf2f(K[((size_t)b * SEQ + k) * qs + h * dq + j]), d); lgt = d; }
            pr[k] = lgt; mx = fmaxf(mx, lgt); }
        red[C.tid] = mx; __syncthreads();
        if (C.tid == 0) { float m = -INFINITY; for (int i = 0; i < 512; ++i) m = fmaxf(m, red[i]); red[0] = m; } __syncthreads();
        const float m = red[0]; __syncthreads();
        float sm = 0.f; for (int k = C.tid; k < 4096; k += 512) { const float p = exp2f(pr[k] - m); pr[k] = p; sm += p; }
        red[C.tid] = sm; __syncthreads();
        if (C.tid == 0) { float t = 0.f; for (int i = 0; i < 512; ++i) t += red[i]; red[0] = t; } __syncthreads();
        const float den = red[0];
        if (C.tid < 64) { const int d = C.tid; float o = 0.f;
            for (int k = 0; k < n; ++k) { const int ps = (k & ~15) | perm16(k & 15); o = fmaf(pr[k], bf2f(VT[((size_t)(b * 8 + h) * 64 + d) * SEQ + ps]), o); }
            o /= den; err_max(ctl, 4 + which, fabsf(o - bf2f(O[tq * 512 + h * 64 + d]))); }
    }
    __syncthreads();
}
#endif

constexpr int NPH_LAYER = 11, NPHASE = 1 + NLAYER * NPH_LAYER;
__global__ void __launch_bounds__(NWAVES * 64, 2) trunk_fwd(Args args) {
    extern __shared__ __attribute__((aligned(16))) unsigned char lds_raw[];
    Ctx C;
    C.lds = (LAS unsigned char*)lds_raw; C.tid = threadIdx.x; C.lane = C.tid & 63; C.wave = __builtin_amdgcn_readfirstlane(C.tid >> 6); C.G = gridDim.x; C.bid = blockIdx.x; C.ws = args.ws;
    volatile LAS unsigned* MISC = (volatile LAS unsigned*)(C.lds + MISC_OFF);
    if (C.tid < 16) MISC[C.tid] = 0u;
    __syncthreads();
#if MK_ONE_LAUNCH
    XcdBarrier bar = xcd_barrier_post(WSP(unsigned, WS_CTL) + CW_BAR, MISC + 0);
#define GRID_BAR() do { FRESH(); XcdBarrier b_ = bar; { unsigned* bp_ = b_.bar; asm volatile("" : "+s"(bp_)); b_.bar = bp_; } xcd_barrier(b_, C.tid == 0); } while (0)
#else
#define GRID_BAR() do {} while (0)
#endif
    typedef const __attribute__((address_space(4))) Args* KArgsP;
    KArgsP kp = (KArgsP)__builtin_amdgcn_kernarg_segment_ptr();
    const int grid_s = gridDim.x, bid_s = blockIdx.x;
    const int wave_s = __builtin_amdgcn_readfirstlane((int)threadIdx.x >> 6);
#define FRESH() do { int ln_; asm volatile("v_mbcnt_lo_u32_b32 %0, -1, 0\n\tv_mbcnt_hi_u32_b32 %0, -1, %0" : "=v"(ln_)); int w_ = wave_s; asm volatile("" : "+s"(w_)); C.tid = (w_ << 6) | ln_; C.lane = ln_; C.wave = w_; \
        int g_ = grid_s, b_ = bid_s; asm volatile("" : "+s"(g_), "+s"(b_)); C.G = g_; C.bid = b_; \
        kp = (KArgsP)__builtin_amdgcn_kernarg_segment_ptr(); asm volatile("" : "+s"(kp)); C.ws = kp->ws; } while (0)
#define KIN(i) (kp->in[i])
    const int lo = args.ph_lo, hi = args.ph_hi, sub_mask = args.sub; const bool dry = (args.pad != 0);
#ifndef PH_ONLY
#define PH_ONLY -1
#endif
#ifndef PH_SUB
#define PH_SUB -1
#endif
#define PON(k) (PH_ONLY < 0 || PH_ONLY == (k))
#define PON2(k) ((PH_SUB < 0 || PH_SUB == (k)) && ((sub_mask >> (((k) / 10 - 1) * 4 + (k) % 10 - 1)) & 1))
#define IN(k) (lo <= (k) && (k) < hi)
#define SEAM(k) do { if (IN(k) && IN((k) + 1)) GRID_BAR(); } while (0)
    if (IN(0) && PON(100)) { phase_prologue(C, args); }
    SEAM(0);
    for (int l = 0; l < NLAYER; ++l) {
        const int P = 1 + l * NPH_LAYER;
        if (IN(P + 0) && PON(0)) { FRESH();
            pg8::Gemm g{WSP(bf16_t, WS_XB), WSP(bf16_t, WS_WIN + l * SZ_WIN), 1024, 1024, nullptr}; GridOrder S{NIN / 256, (NTOK / 256) * (NIN / 256), C.G, C.bid};
            EpiInProj E{C.ws, dry};
            pg8::gemm_phase<EpiInProj, GridOrder>(C.lds, g, S, E, C.tid);
        }
        SEAM(P + 0);
        if (IN(P + 1) && PON(1)) { FRESH();
            if (PON2(11)) phase_indexer(C);
            __syncthreads();
            FRESH();
            if (PON2(12)) { pg8::Gemm g{WSP(bf16_t, WS_CDQ), WSP(bf16_t, WS_WUQ + l * SZ_WUQ), 256, 256, nullptr}; GridOrder S{3, 128 * 3, C.G, C.bid};
              EpiQUp E{WSP(bf16_t, WS_QC), WSP(float, WS_SSQ), WSP(float, WS_COSC), WSP(float, WS_SINC)};
              pg8::gemm_phase<EpiQUp, GridOrder>(C.lds, g, S, E, C.tid); }
            FRESH();
            if (PON2(13)) { pg8::Gemm g{WSP(bf16_t, WS_CDKV), WSP(bf16_t, WS_WUKV + l * SZ_WUKV), 256, 256, nullptr}; GridOrder S{4, 128 * 4, C.G, C.bid};
              EpiKvUp E{WSP(bf16_t, WS_KC), WSP(bf16_t, WS_VCT), WSP(float, WS_SSQ)};
              pg8::gemm_phase<EpiKvUp, GridOrder>(C.lds, g, S, E, C.tid); }
            __syncthreads();
            if (PON2(14)) { FRESH(); phase_gmlp(C, KIN(3) + l * 512, KIN(4) + l * 512, KIN(6) + (size_t)l * 8 * 128, l); }
        }
        SEAM(P + 1);
        if (IN(P + 2) && PON(2)) { FRESH();
            if (PON2(21)) phase_select(C);
            __syncthreads();
            FRESH(); if (PON2(22)) phase_attn<96, false>(C, WSP(bf16_t, WS_QC), WSP(bf16_t, WS_KC), WSP(bf16_t, WS_VCT), nullptr, WSP(bf16_t, WS_OBUF) + (size_t)2 * NTOK * 512);
        }
        SEAM(P + 2);
        if (IN(P + 3) && PON(3)) { FRESH(); phase_attn<64, true>(C, WSP(bf16_t, WS_QA), WSP(bf16_t, WS_KA), WSP(bf16_t, WS_VAT), WSP(unsigned, WS_MASK), WSP(bf16_t, WS_OBUF)); }
        SEAM(P + 3);
        if (IN(P + 4) && PON(4)) { FRESH();
            pg8::Gemm g{WSP(bf16_t, WS_OBUF), WSP(bf16_t, WS_WBR + l * SZ_WBR), 512, 512, nullptr}; MergeOrder S{C.G, C.bid};
            EpiMerge E{WSP(bf16_t, WS_GATE), WSP(bf16_t, WS_MERGED)};
            pg8::gemm_phase<EpiMerge, MergeOrder>(C.lds, g, S, E, C.tid);
        }
        SEAM(P + 4);
        if (IN(P + 5) && PON(5)) { FRESH();
            pg8::Gemm g{WSP(bf16_t, WS_MERGED), WSP(bf16_t, WS_WOUT + l * SZ_WOUT), 1024, 1024, nullptr}; GridOrder S{4, 128 * 4, C.G, C.bid};
            EpiOut E{dry ? WSP(bf16_t, WS_DRY) : WSP(bf16_t, WS_OBUF)};
            pg8::gemm_phase<EpiOut, GridOrder>(C.lds, g, S, E, C.tid);
        }
        SEAM(P + 5);
        if (IN(P + 6) && PON(6)) { FRESH(); phase_ln1_router(C, KIN(13) + l * 1024, KIN(14) + l * 1024, KIN(15) + (size_t)l * 1024 * 32, KIN(16) + l * 32, l, dry); }
        SEAM(P + 6);
        if (IN(P + 7) && PON(7)) { FRESH(); phase_dispatch(C, l); }
        SEAM(P + 7);
        if (IN(P + 8) && PON(8)) { FRESH();
            moe_tables(C, l);
            const LAS int* tb = (const LAS int*)(C.lds + MISC_OFF + 64) + 32;
            pg8::Gemm g{WSP(bf16_t, WS_XB), WSP(bf16_t, WS_WGU + l * SZ_WGU), 1024, 1024, WSP(int, WS_STK)}; MoeOrder S{8, tb[32] * 8, C.G, C.bid, tb};
            EpiMoeUp E{WSP(bf16_t, WS_H), KIN(18) + (size_t)l * NEXP * 2048};
            pg8::gemm_phase<EpiMoeUp, MoeOrder, true>(C.lds, g, S, E, C.tid);
        }
        SEAM(P + 8);
        if (IN(P + 9) && PON(9)) { FRESH();
            moe_tables(C, l);
            const LAS int* tb = (const LAS int*)(C.lds + MISC_OFF + 64) + 32;
            pg8::Gemm g{WSP(bf16_t, WS_H), WSP(bf16_t, WS_WDN + l * SZ_WDN), 1024, 1024, nullptr}; MoeOrder S{4, tb[32] * 4, C.G, C.bid, tb};
            EpiMoeDn E{dry ? WSP(bf16_t, WS_DRY) : WSP(bf16_t, WS_Y), KIN(20) + (size_t)l * NEXP * 1024, dry};
            pg8::gemm_phase<EpiMoeDn, MoeOrder>(C.lds, g, S, E, C.tid);
        }
        SEAM(P + 9);
        if (IN(P + 10) && PON(10)) { FRESH(); phase_ln2(C, KIN(21) + l * 1024, KIN(22) + l * 1024, kp->out, l, dry); }
        SEAM(P + 10);
    }
#ifdef DBG_STOP
    if (IN(NPHASE)) { FRESH(); dbg_dump(C, kp->out); }
#endif
#ifdef DBG_CHECK
    if (IN(NPHASE + 1)) { FRESH(); chk_proj(C, args); chk_attn(C); }
    if (IN(NPHASE + 2)) { FRESH();
        const unsigned* ctl = WSP(unsigned, WS_CTL); const float tol[6] = {0.06f, 0.06f, 2e-3f, 0.5f, 0.02f, 0.02f}; float sc = 1.f;
        for (int k = 0; k < 6; ++k) if (__uint_as_float(ctl[CW_ERR + k]) > tol[k]) sc += 0.2f * (float)(1 << k);
        float* o = kp->out; for (size_t i = (size_t)C.bid * 512 + C.tid; i < (size_t)NTOK * DM; i += (size_t)C.G * 512) o[i] *= sc; }
#endif
#undef IN
#undef SEAM
}

extern "C" void kernel_launch(void* const* d_in, const int* in_sizes, int n_in, void* d_out, int out_size, void* d_ws, size_t ws_size, hipStream_t stream) {
    static int grid = 0;
    if (grid == 0) {
        if (n_in != 23 || out_size != NTOK * DM || ws_size < WS_END) { fprintf(stderr, "kernel_launch: unexpected shapes (n_in %d, out %d, ws %zu < %zu)\n", n_in, out_size, ws_size, (size_t)WS_END); grid = -1; return; }
        int dev = 0, cus = 0, per_cu = 0;
        if (hipGetDevice(&dev) != hipSuccess || hipDeviceGetAttribute(&cus, hipDeviceAttributeMultiprocessorCount, dev) != hipSuccess) { grid = -1; return; }
        if (hipFuncSetAttribute((const void*)trunk_fwd, hipFuncAttributeMaxDynamicSharedMemorySize, LDS_BYTES) != hipSuccess) { fprintf(stderr, "kernel_launch: hipFuncSetAttribute failed\n"); grid = -1; return; }
        if (hipOccupancyMaxActiveBlocksPerMultiprocessor(&per_cu, (const void*)trunk_fwd, NWAVES * 64, LDS_BYTES) != hipSuccess || per_cu < 1) { fprintf(stderr, "kernel_launch: occupancy query reports %d\n", per_cu); }
        (void)hipGetLastError();
        grid = cus;
    }
    if (grid < 0) return;
    (void)hipMemsetAsync((char*)d_ws + WS_CTL, 0, CTL_ZERO_BYTES, stream);
#ifdef DBG_ZERO_WS
    (void)hipMemsetAsync((char*)d_ws + WS_XRES, 0, WS_END - WS_XRES, stream);
#endif
    Args a{};
    for (int i = 0; i < 23; ++i) a.in[i] = (const float*)d_in[i];
    a.out = (float*)d_out; a.ws = (unsigned char*)d_ws; a.sub = -1; a.pad = 0;
#if MK_ONE_LAUNCH
    a.ph_lo = 0; a.ph_hi = NPHASE;
    hipLaunchKernelGGL(trunk_fwd, dim3(grid), dim3(NWAVES * 64), LDS_BYTES, stream, a);
#else
#ifdef DBG_STOP
    for (int p = 0; p < 1 + DBG_STOP; ++p) { a.ph_lo = p; a.ph_hi = p + 1; hipLaunchKernelGGL(trunk_fwd, dim3(grid), dim3(NWAVES * 64), LDS_BYTES, stream, a); }
    a.ph_lo = NPHASE; a.ph_hi = NPHASE + 1; hipLaunchKernelGGL(trunk_fwd, dim3(grid), dim3(NWAVES * 64), LDS_BYTES, stream, a);
#else
    for (int p = 0; p < NPHASE; ++p) { a.ph_lo = p; a.ph_hi = p + 1; a.sub = -1; a.pad = 0; hipLaunchKernelGGL(trunk_fwd, dim3(grid), dim3(NWAVES * 64), LDS_BYTES, stream, a);
#ifdef DBG_CHECK
        if (p == 4) { a.ph_lo = NPHASE + 1; a.ph_hi = NPHASE + 2; hipLaunchKernelGGL(trunk_fwd, dim3(grid), dim3(NWAVES * 64), LDS_BYTES, stream, a); }
        if (p == NPHASE - 1) { a.ph_lo = NPHASE + 2; a.ph_hi = NPHASE + 3; hipLaunchKernelGGL(trunk_fwd, dim3(grid), dim3(NWAVES * 64), LDS_BYTES, stream, a); }
#endif
#ifdef PROBE_PH
#ifndef PROBE_DRY
#define PROBE_DRY 0
#endif
        if ((p == 0 && PROBE_PH == -1) || (p >= 1 && (p - 1) % NPH_LAYER == PROBE_PH)) { a.sub = PROBE_SUB; a.pad = PROBE_DRY; hipLaunchKernelGGL(trunk_fwd, dim3(grid), dim3(NWAVES * 64), LDS_BYTES, stream, a); }
#endif
    }
#endif
#endif
}
```

```cpp
#include <hip/hip_runtime.h>
#include <cstdio>
#include <cstdint>

#ifndef MK_ONE_LAUNCH
#define MK_ONE_LAUNCH 1
#endif

#define LAS __attribute__((address_space(3)))
typedef unsigned short bf16_t;
typedef short bf16x8 __attribute__((ext_vector_type(8)));
typedef float f32x4 __attribute__((ext_vector_type(4)));
typedef float f32x16 __attribute__((ext_vector_type(16)));
typedef unsigned u32x4 __attribute__((ext_vector_type(4)));
typedef unsigned u32x2 __attribute__((ext_vector_type(2)));
typedef float f32x2_t __attribute__((ext_vector_type(2)));
typedef __bf16 bf16x2_t __attribute__((ext_vector_type(2)));

__device__ __forceinline__ unsigned pk2(float lo, float hi) { f32x2_t v = {lo, hi}; bf16x2_t b = __builtin_convertvector(v, bf16x2_t); return __builtin_bit_cast(unsigned, b); }
__device__ __forceinline__ float bf2f(unsigned short x) { return __uint_as_float(((unsigned)x) << 16); }
__device__ __forceinline__ float bflo(unsigned w) { return __uint_as_float(w << 16); }
__device__ __forceinline__ float bfhi(unsigned w) { return __uint_as_float(w & 0xffff0000u); }
template <int M> __device__ __forceinline__ float xswz(float v) { static_assert(M >= 1 && M <= 16, "xswz"); return __int_as_float(__builtin_amdgcn_ds_swizzle(__float_as_int(v), 0x1F | (M << 10))); }
template <int M> __device__ __forceinline__ unsigned xswzu(unsigned v) { return (unsigned)__builtin_amdgcn_ds_swizzle((int)v, 0x1F | (M << 10)); }
__device__ __forceinline__ float xsum32(float v) { auto rr = __builtin_amdgcn_permlane32_swap(__float_as_uint(v), __float_as_uint(v), false, false); return __uint_as_float(rr[0]) + __uint_as_float(rr[1]); }
__device__ __forceinline__ float xmax32(float v) { auto rr = __builtin_amdgcn_permlane32_swap(__float_as_uint(v), __float_as_uint(v), false, false); return fmaxf(__uint_as_float(rr[0]), __uint_as_float(rr[1])); }
__device__ __forceinline__ float xother32(float v, bool upper) { auto rr = __builtin_amdgcn_permlane32_swap(__float_as_uint(v), __float_as_uint(v), false, false); return __uint_as_float(upper ? rr[0] : rr[1]); }
#define LDS_WAIT() asm volatile("s_waitcnt lgkmcnt(0)" ::: "memory")
#define VM_WAIT() asm volatile("s_waitcnt vmcnt(0)" ::: "memory")

constexpr int NB = 8, SEQ = 4096, NTOK = NB * SEQ, DM = 1024, NLAYER = 4;
constexpr int NIN_SRC = 6632, NIN = 6656;
constexpr int NEXP = 32, TOPK = 4, DFF = 1024;
constexpr int NSLOT = NTOK * TOPK, NSLOT_PAD = NSLOT + NEXP * 256;
constexpr float LN_EPS = 1e-5f, RMS_EPS = 1e-6f;
constexpr float DN_ALPHA = 1.681792830507429f;
constexpr float LOG2E = 1.4426950408889634f;
constexpr float QSCALE_A = 0.125f * LOG2E;
constexpr float QSCALE_C = 0.10206207261596577f * LOG2E;
constexpr float IW_SCALE = 0.35355339059327373f * 0.125f;

constexpr size_t MiB = (size_t)1 << 20;
constexpr size_t WS_CTL = 0, CTL_ZERO_BYTES = 1 * MiB;
constexpr int CW_BAR = 4096, CW_CNT = 16384;
constexpr size_t SZ_WIN = (size_t)NIN * DM * 2, SZ_WUQ = (size_t)768 * 256 * 2, SZ_WUKV = (size_t)1024 * 256 * 2, SZ_WBR = (size_t)3 * 1024 * 512 * 2, SZ_WOUT = (size_t)1024 * 1024 * 2;
constexpr size_t SZ_WGU = (size_t)NEXP * 2048 * 1024 * 2, SZ_WDN = (size_t)NEXP * 1024 * 1024 * 2, SZ_WGM = (size_t)8 * 128 * 128 * 2;
constexpr size_t WS_WIN = 2 * MiB;
constexpr size_t WS_WUQ = WS_WIN + NLAYER * SZ_WIN;
constexpr size_t WS_WUKV = WS_WUQ + NLAYER * SZ_WUQ;
constexpr size_t WS_WBR = WS_WUKV + NLAYER * SZ_WUKV;
constexpr size_t WS_WOUT = WS_WBR + NLAYER * SZ_WBR;
constexpr size_t WS_WGU = WS_WOUT + NLAYER * SZ_WOUT;
constexpr size_t WS_WDN = WS_WGU + NLAYER * SZ_WGU;
constexpr size_t WS_WGM = WS_WDN + NLAYER * SZ_WDN;
constexpr size_t WS_COSA = WS_WGM + NLAYER * SZ_WGM;
constexpr size_t WS_SINA = WS_COSA + (size_t)NTOK * 8 * 4;
constexpr size_t WS_COSC = WS_SINA + (size_t)NTOK * 8 * 4;
constexpr size_t WS_SINC = WS_COSC + (size_t)NTOK * 16 * 4;
constexpr size_t WS_XRES = WS_SINC + (size_t)NTOK * 16 * 4;
constexpr size_t WS_XB = WS_XRES + (size_t)NTOK * DM * 4;
constexpr size_t WS_QA = WS_XB + (size_t)NTOK * DM * 2;
constexpr size_t WS_KA = WS_QA + (size_t)NTOK * 512 * 2;
constexpr size_t WS_VAT = WS_KA + (size_t)NTOK * 512 * 2;
constexpr size_t WS_IQ = WS_VAT + (size_t)NTOK * 512 * 2;
constexpr size_t WS_IK = WS_IQ + (size_t)NTOK * 512 * 2;
constexpr size_t WS_IW = WS_IK + (size_t)NTOK * 64 * 2;
constexpr size_t WS_U = WS_IW + (size_t)NTOK * 8 * 4;
constexpr size_t WS_V = WS_U + (size_t)NTOK * 512 * 2;
constexpr size_t WS_CDQ = WS_V + (size_t)NTOK * 512 * 2;
constexpr size_t WS_CDKV = WS_CDQ + (size_t)NTOK * 256 * 2;
constexpr size_t WS_SSQ = WS_CDKV + (size_t)NTOK * 256 * 2;
constexpr size_t WS_GATE = WS_SSQ + (size_t)NTOK * 8 * 4;
constexpr size_t WS_QC = WS_GATE + (size_t)NTOK * 3072 * 2;
constexpr size_t WS_KC = WS_QC + (size_t)NTOK * 768 * 2;
constexpr size_t WS_VCT = WS_KC + (size_t)NTOK * 768 * 2;
constexpr size_t WS_SCORE = WS_VCT + (size_t)NTOK * 512 * 2;
constexpr size_t WS_MASK = WS_SCORE + (size_t)NTOK * SEQ * 4;
constexpr size_t WS_OBUF = WS_MASK + (size_t)NTOK * 128 * 4;
constexpr size_t WS_MERGED = WS_OBUF + (size_t)3 * NTOK * 512 * 2;
constexpr size_t WS_TKE = WS_MERGED + (size_t)NTOK * DM * 2;
constexpr size_t WS_TKP = WS_TKE + (size_t)NSLOT * 4;
constexpr size_t WS_TKW = WS_TKP + (size_t)NSLOT * 4;
constexpr size_t WS_STK = WS_TKW + (size_t)NSLOT * 4;
constexpr size_t WS_SW = WS_STK + (size_t)NSLOT_PAD * 4;
constexpr size_t WS_XG = WS_SW + (size_t)NSLOT_PAD * 4;
constexpr size_t WS_H = WS_XG + (size_t)NSLOT_PAD * DM * 2;
constexpr size_t WS_Y = WS_H + (size_t)NSLOT_PAD * DFF * 2;
constexpr size_t WS_CCNT = WS_Y + (size_t)NSLOT_PAD * DM * 2;
constexpr size_t WS_RWT = WS_CCNT + (size_t)(NTOK / 128) * 32 * 4;
constexpr size_t WS_GBW = WS_RWT + (size_t)NLAYER * 32 * 1024 * 4;
constexpr size_t WS_END = WS_GBW + (size_t)NLAYER * 64 * 4;
constexpr size_t WS_DRY = (WS_END + 255) & ~(size_t)255;
static_assert(WS_END < (size_t)4200 * MiB, "workspace map too large");
static_assert((WS_WIN % 256) == 0 && (WS_COSA % 256) == 0 && (WS_XRES % 256) == 0 && (WS_SCORE % 256) == 0 && (WS_XG % 256) == 0, "alignment");

constexpr int LDS_BYTES = 147456;
constexpr int MISC_OFF = 143360;
constexpr int NWAVES = 8;

#define XB_TMO      128
#define XB_XCNT(j)  (256  + 64 * (j))
#define XB_XSUB(j)  (1280 + 64 * (j))
#define XB_XGEN(j)  (2304 + 64 * (j))
#define XB_TOP      3328
#define XB_TOPGEN   3392
#define XCD_BAR_WORDS 3456
#define XB_SPIN_CAP (1u << 18)
__device__ __forceinline__ unsigned xb_ld(unsigned* p)              { return __hip_atomic_load(p, __ATOMIC_RELAXED, __HIP_MEMORY_SCOPE_AGENT); }
__device__ __forceinline__ unsigned xb_add(unsigned* p, unsigned v) { return __hip_atomic_fetch_add(p, v, __ATOMIC_RELAXED, __HIP_MEMORY_SCOPE_AGENT); }
__device__ __forceinline__ unsigned xb_xcc_id() { return (unsigned)__builtin_amdgcn_s_getreg((3 << 11) | 20) & 0xFu; }
#define XB_SPIN(cond, bar) do { unsigned _sp = 0; while (cond) { __builtin_amdgcn_s_sleep(1); \
    if ((++_sp & 255u) == 0u) { if (xb_ld(&(bar)[XB_TMO])) break; if (_sp > XB_SPIN_CAP) { atomicAdd(&(bar)[XB_TMO], 1u); break; } } } } while (0)
struct XcdBarrier { unsigned* bar; unsigned x; volatile LAS unsigned* st; };
__device__ __forceinline__ XcdBarrier xcd_barrier_post(unsigned* bar, volatile LAS unsigned* st) {
    XcdBarrier b; b.bar = bar; b.x = xb_xcc_id(); b.st = st;
    if (threadIdx.x == 0) (void)xb_add(&bar[XB_XCNT(b.x)], 1u);
    return b;
}
__device__ __forceinline__ void xcd_barrier_complete(unsigned* bar, unsigned x, unsigned& nloc, unsigned& nx) {
    const unsigned G = gridDim.x * gridDim.y * gridDim.z;
    unsigned sum, cnt, mine, sp = 0u;
    for (;;) {
        sum = 0u; cnt = 0u; mine = 0u;
#pragma unroll
        for (unsigned j = 0; j < 16; ++j) { const unsigned c = xb_ld(&bar[XB_XCNT(j)]); sum += c; cnt += (c > 0u) ? 1u : 0u; mine = (j == x) ? c : mine; }
        if (sum == G) break;
        __builtin_amdgcn_s_sleep(1);
        if ((++sp & 255u) == 0u) { if (xb_ld(&bar[XB_TMO])) break; if (sp > XB_SPIN_CAP) { atomicAdd(&bar[XB_TMO], 1u); break; } }
    }
    nloc = mine > 0u ? mine : 1u; nx = cnt > 0u ? cnt : 1u;
}
__device__ __forceinline__ void xcd_barrier(const XcdBarrier& b, bool leader_thread) {
    asm volatile("s_waitcnt vmcnt(0)" ::: "memory");
    __syncthreads();
    if (leader_thread) {
        unsigned* bar = b.bar;
        __builtin_amdgcn_s_waitcnt(0);
        unsigned nloc = b.st[0], nx = b.st[1];
        if (nloc == 0u) { xcd_barrier_complete(bar, b.x, nloc, nx); b.st[0] = nloc; b.st[1] = nx; }
        const unsigned old = xb_add(&bar[XB_XSUB(b.x)], 1u);
        const unsigned gen = old / nloc;
        if (old + 1u == (gen + 1u) * nloc) {
            __builtin_amdgcn_fence(__ATOMIC_RELEASE, "agent");
            asm volatile("s_waitcnt vmcnt(0)" ::: "memory");
            const unsigned og = xb_add(&bar[XB_TOP], 1u);
            const unsigned tg = og / nx;
            if (og + 1u == (tg + 1u) * nx) xb_add(&bar[XB_TOPGEN], 1u);
            else XB_SPIN(xb_ld(&bar[XB_TOPGEN]) == tg, bar);
            __builtin_amdgcn_fence(__ATOMIC_ACQUIRE, "agent");
            xb_add(&bar[XB_XGEN(b.x)], 1u);
            asm volatile("s_waitcnt vmcnt(0)" ::: "memory");
        } else {
            XB_SPIN(xb_ld(&bar[XB_XGEN(b.x)]) == gen, bar);
            __builtin_amdgcn_fence(__ATOMIC_ACQUIRE, "agent");
            asm volatile("s_waitcnt vmcnt(0)" ::: "memory");
        }
    }
    __syncthreads();
}

namespace pg8 {
constexpr int BM = 256, BK = 64, HALF = 128, HTB = HALF * BK * 2;
__host__ __device__ __forceinline__ int lds_byte(int r, int c) { const int st = (r >> 4) * 2 + (c >> 5), rr = r & 15, cc = c & 31, ob = rr * 64 + cc * 2; return st * 1024 + (ob ^ (((ob >> 9) & 1) << 5)); }
__host__ __device__ __forceinline__ void stage_rc(int b, int& R, int& C) { const int st = b / 1024, sb = b % 1024, swz = sb ^ (((sb >> 9) & 1) << 5); R = (st >> 1) * 16 + swz / 64; C = (st & 1) * 32 + (swz % 64) / 2; }
__host__ __device__ __forceinline__ int perm32(int rho) { const int n = rho >> 4, i = rho & 15; return 8 * (i >> 2) + 4 * n + (i & 3); }
struct Unit { int pm, pn; };
struct Gemm { const bf16_t* A; const bf16_t* Bt; int lda, K; const int* rowmap; };

constexpr int PRE_OFF = 131072;
template <class Epi, class Sched, bool GATHER = false>
__device__ __forceinline__ void gemm_phase(LAS unsigned char* lds, const Gemm g, const Sched& S, const Epi& E, int tid0) {
    int tid = tid0; asm volatile("" : "+v"(tid));
    const int wid = __builtin_amdgcn_readfirstlane(tid >> 6), lane = tid & 63, wr = wid >> 2, wc = wid & 3, fr = lane & 15, fq = lane >> 4;
    const int K = g.K, nt = K / BK, lda = g.lda;
    unsigned voffA[2], voffB[2]; unsigned colA2 = 0u;
#pragma unroll
    for (int i = 0; i < 2; ++i) { int R, C; stage_rc(tid * 16 + i * 8192, R, C); voffA[i] = (unsigned)(R * lda + C) * 2u; const int Rb = (R & ~31) + perm32(R & 31); voffB[i] = (unsigned)(Rb * K + C) * 2u; colA2 = (unsigned)C * 2u; }
    unsigned gcur[2] = {0u, 0u}, gnxt[2] = {0u, 0u};
#define PG8_GLOAD(d, pm_) do { int ln_; asm volatile("v_mbcnt_lo_u32_b32 %0, -1, 0\n\tv_mbcnt_hi_u32_b32 %0, -1, %0" : "=v"(ln_));   \
        int R0_, C0_; stage_rc(((wid << 6) | ln_) * 16, R0_, C0_); const int* rm_ = g.rowmap + (pm_) * BM + R0_; \
        d[0] = (unsigned)rm_[0] | ((unsigned)rm_[64] << 16); d[1] = (unsigned)rm_[HALF] | ((unsigned)rm_[HALF + 64] << 16); } while (0)
#define PG8_GOFF(p, i) ((((i) ? ((p) >> 16) : ((p) & 0xffffu)) * (unsigned)(lda * 2)) + colA2)
#define PG8_STAGE_G(bufoff, gbase, p) do { _Pragma("unroll") for (int _i = 0; _i < 2; ++_i) \
        __builtin_amdgcn_global_load_lds((const unsigned*)((const char*)(gbase) + PG8_GOFF(p, _i)), (LAS unsigned*)(lds + (bufoff) + ldsw + _i * 8192), 16, 0, 0); } while (0)
    const size_t kstep = (size_t)(BK * 2);
    const size_t hstepA = (size_t)HALF * lda * 2, hstepB = (size_t)HALF * K * 2;
    const size_t tstepA = 2 * hstepA, tstepB = 2 * hstepB;
    const unsigned ldsw = (unsigned)wid * 1024u;
    const int aoff = lds_byte(wr * 64 + fr, fq * 8), boff = lds_byte(wc * 32 + fr, fq * 8);
#define PG8_SA(b, h) (((b) * 2 + (h)) * HTB)
#define PG8_SB(b, h) ((4 + (b) * 2 + (h)) * HTB)
#define PG8_STAGE(bufoff, gbase, voff) do { _Pragma("unroll") for (int _i = 0; _i < 2; ++_i) \
        __builtin_amdgcn_global_load_lds((const unsigned*)((const char*)(gbase) + (voff)[_i]), (LAS unsigned*)(lds + (bufoff) + ldsw + _i * 8192), 16, 0, 0); } while (0)
#define PG8_STAGE_A(bufoff, gbase, half, nextu) do { if constexpr (GATHER) { if (nextu) PG8_STAGE_G(bufoff, gbase, gnxt[half]); else PG8_STAGE_G(bufoff, gbase, gcur[half]); } \
        else { PG8_STAGE(bufoff, (gbase) + ((half) ? hstepA : 0), voffA); } } while (0)
#define PG8_LDA(dst, b, h) do { _Pragma("unroll") for (int m = 0; m < 4; ++m) _Pragma("unroll") for (int k = 0; k < 2; ++k) dst[m][k] = *(const LAS bf16x8*)(lds + PG8_SA(b, h) + aoff + m * 2048 + k * 1024); } while (0)
#define PG8_LDB(dst, b, h) do { _Pragma("unroll") for (int n = 0; n < 2; ++n) _Pragma("unroll") for (int k = 0; k < 2; ++k) dst[n][k] = *(const LAS bf16x8*)(lds + PG8_SB(b, h) + boff + n * 2048 + k * 1024); } while (0)
#define PG8_MMA(ai, bj, At, Bt) do { __builtin_amdgcn_s_setprio(1); _Pragma("unroll") for (int m = 0; m < 4; ++m) _Pragma("unroll") for (int n = 0; n < 2; ++n) _Pragma("unroll") for (int k = 0; k < 2; ++k) \
        acc[ai][bj][m][n] = __builtin_amdgcn_mfma_f32_16x16x32_bf16(Bt[n][k], At[m][k], acc[ai][bj][m][n], 0, 0, 0); __builtin_amdgcn_s_setprio(0); } while (0)
#define PG8_WAIT_V(n) asm volatile("s_waitcnt vmcnt(" #n ")" ::: "memory")
#define PG8_WAIT_L(n) asm volatile("s_waitcnt lgkmcnt(" #n ")" ::: "memory")
#define PG8_BAR __builtin_amdgcn_s_barrier()
#define PG8_SCHED __builtin_amdgcn_sched_barrier(0)
    Unit cur, nxt; int ui = 0;
    if (!S.next(0, cur)) return;
    f32x4 acc[2][2][4][2];
#pragma unroll
    for (int a = 0; a < 2; ++a)
#pragma unroll
        for (int b = 0; b < 2; ++b)
#pragma unroll
            for (int m = 0; m < 4; ++m)
#pragma unroll
                for (int n = 0; n < 2; ++n) acc[a][b][m][n] = (f32x4){0.f, 0.f, 0.f, 0.f};
    bf16x8 At[4][2], B0[2][2], B1[2][2];
    const char* cA = GATHER ? (const char*)g.A : (const char*)g.A + (size_t)cur.pm * tstepA; const char* cB = (const char*)g.Bt + (size_t)cur.pn * tstepB;
    if constexpr (GATHER) { PG8_GLOAD(gcur, cur.pm); }
#define PG8_PRE(u_, slot_) do { if (wid < 4) { int ln_; asm volatile("v_mbcnt_lo_u32_b32 %0, -1, 0\n\tv_mbcnt_hi_u32_b32 %0, -1, %0" : "=v"(ln_));   \
        __builtin_amdgcn_global_load_lds((const unsigned*)(E.pre_base(u_, wid) + ln_), (LAS unsigned*)(lds + PRE_OFF + (slot_) * 1024 + wid * 256), 4, 0, 0); } } while (0)
    if constexpr (Epi::PRE) { PG8_PRE(cur, 0); }
    PG8_STAGE(PG8_SB(0, 0), cB, voffB); PG8_STAGE(PG8_SB(0, 1), cB + hstepB, voffB); PG8_STAGE_A(PG8_SA(0, 0), cA, 0, false); PG8_STAGE_A(PG8_SA(0, 1), cA, 1, false);
    if (wr == 1) PG8_BAR;
    PG8_WAIT_V(2); PG8_BAR;
    PG8_STAGE(PG8_SB(1, 0), cB + kstep, voffB); PG8_STAGE_A(PG8_SA(1, 0), cA + kstep, 0, false); PG8_STAGE(PG8_SB(1, 1), cB + hstepB + kstep, voffB);
    PG8_WAIT_V(6); PG8_BAR;
    for (;;) {
        const bool has_next = S.next(ui + 1, nxt);
        const char* nA = GATHER ? cA : (has_next ? (const char*)g.A + (size_t)nxt.pm * tstepA : cA); const char* nB = has_next ? (const char*)g.Bt + (size_t)nxt.pn * tstepB : cB;
        if constexpr (GATHER) { if (has_next) { PG8_GLOAD(gnxt, nxt.pm); } else { gnxt[0] = gcur[0]; gnxt[1] = gcur[1]; } }
        for (int t = 0; t < nt; t += 2) {
            const bool last = (t == nt - 2);
            if constexpr (Epi::PRE) { if (last && has_next) PG8_PRE(nxt, (ui + 1) & 1); }
            const char* a1 = cA + (size_t)(t + 1) * kstep;
            const char* a2 = last ? nA : cA + (size_t)(t + 2) * kstep; const char* b2 = last ? nB : cB + (size_t)(t + 2) * kstep;
            const char* a3 = a2 + kstep; const char* b3 = b2 + kstep;
            PG8_LDB(B0, 0, 0); PG8_LDB(B1, 0, 1); PG8_SCHED; PG8_LDA(At, 0, 0); PG8_STAGE_A(PG8_SA(1, 1), a1, 1, false);
            PG8_WAIT_V(8); PG8_WAIT_L(0); PG8_BAR; PG8_MMA(0, 0, At, B0); PG8_MMA(0, 1, At, B1); PG8_BAR; PG8_SCHED;
            PG8_LDA(At, 0, 1); PG8_STAGE(PG8_SB(0, 0), b2, voffB); PG8_STAGE(PG8_SB(0, 1), b2 + hstepB, voffB); PG8_STAGE_A(PG8_SA(0, 0), a2, 0, last);
            PG8_WAIT_V(8); PG8_WAIT_L(0); PG8_BAR; PG8_MMA(1, 0, At, B0); PG8_MMA(1, 1, At, B1); PG8_BAR; PG8_SCHED;
            PG8_LDB(B0, 1, 0); PG8_LDB(B1, 1, 1); PG8_SCHED; PG8_LDA(At, 1, 0); PG8_STAGE_A(PG8_SA(0, 1), a2, 1, last);
            PG8_WAIT_V(8); PG8_WAIT_L(0); PG8_BAR; PG8_MMA(0, 0, At, B0); PG8_MMA(0, 1, At, B1); PG8_BAR; PG8_SCHED;
            PG8_LDA(At, 1, 1); PG8_STAGE(PG8_SB(1, 0), b3, voffB); PG8_STAGE(PG8_SB(1, 1), b3 + hstepB, voffB); PG8_STAGE_A(PG8_SA(1, 0), a3, 0, last);
            PG8_WAIT_V(8); PG8_WAIT_L(0); PG8_BAR; PG8_MMA(1, 0, At, B0); PG8_MMA(1, 1, At, B1); PG8_BAR; PG8_SCHED;
        }
        if (wr == 0) PG8_BAR;
        { int el; asm volatile("v_mbcnt_lo_u32_b32 %0, -1, 0\n\tv_mbcnt_hi_u32_b32 %0, -1, %0" : "=v"(el));
          if constexpr (Epi::PRE) E(acc, cur, wr, wc, el & 15, el >> 4, (const LAS float*)(lds + PRE_OFF + (ui & 1) * 1024)); else E(acc, cur, wr, wc, el & 15, el >> 4); }
        if (!has_next) break;
        if constexpr (!Epi::CHAIN) {
#pragma unroll
        for (int a = 0; a < 2; ++a)
#pragma unroll
            for (int b = 0; b < 2; ++b)
#pragma unroll
                for (int m = 0; m < 4; ++m)
#pragma unroll
                    for (int n = 0; n < 2; ++n) acc[a][b][m][n] = (f32x4){0.f, 0.f, 0.f, 0.f};
        }
        cur = nxt; cA = nA; cB = nB; ++ui;
        if constexpr (GATHER) { gcur[0] = gnxt[0]; gcur[1] = gnxt[1]; }
        if (wr == 1) PG8_BAR;
    }
    PG8_WAIT_V(0);
    PG8_BAR;
#undef PG8_PRE
#undef PG8_SA
#undef PG8_SB
#undef PG8_STAGE
#undef PG8_LDA
#undef PG8_STAGE_A
#undef PG8_GLOAD
#undef PG8_GOFF
#undef PG8_STAGE_G
#undef PG8_LDB
#undef PG8_MMA
#undef PG8_WAIT_V
#undef PG8_WAIT_L
#undef PG8_BAR
#undef PG8_SCHED
}
}
using pg8::Unit;

struct Args { const float* in[23]; float* out; unsigned char* ws; int ph_lo, ph_hi; int sub, pad; };
struct Ctx {
    LAS unsigned char* lds;
    int tid, lane, wave, G, bid;
    unsigned char* ws;
};
#define WSP(T, off) ((T*)(C.ws + (off)))

struct GridOrder {
    int nN, total, G, c;
    __device__ __forceinline__ bool next(int i, Unit& u) const {
        const int L = c + i * G; if (L >= total) return false;
        const int nM = total / nN; int wgid;
        { const int q = total >> 3, r = total & 7, xcd = L & 7, off = L >> 3; wgid = (xcd < r ? xcd * (q + 1) : r * (q + 1) + (xcd - r) * q) + off; }
        const int nig = 8 * nN, gid = wgid / nig, fm = gid * 8, gsz = (nM - fm) < 8 ? (nM - fm) : 8, w = wgid - gid * nig;
        const int pn = w / gsz; u.pm = fm + (w - pn * gsz); u.pn = pn; return true;
    }
};
struct MergeOrder {
    int G, c;
    __device__ __forceinline__ bool next(int i, Unit& u) const { const int t = i / 3, n = i - 3 * t, tile = c + t * G; if (tile >= 512) return false; u.pm = n * 128 + (tile >> 2); u.pn = n * 4 + (tile & 3); return true; }
};
struct MoeOrder {
    int NT, total, G, c; const LAS int* tb;
    __device__ __forceinline__ bool next(int i, Unit& u) const {
        if ((G & 7) != 0) { const int idx = c + i * G; if (idx >= total) return false; const int mt = idx / NT, pn = idx - mt * NT;
            const int e = __builtin_amdgcn_readfirstlane(tb[40 + mt]); u.pm = mt; u.pn = e * NT + pn; return true; }
        const int T = __builtin_amdgcn_readfirstlane(tb[NEXP]), x = c & 7, lo = (x * T) >> 3, ntl = (((x + 1) * T) >> 3) - lo;
        const int j = (c >> 3) + i * (G >> 3);
        if (j >= ntl * NT) return false;
        const int gsh = (NT == 8) ? 6 : 5, gm = j >> gsh, rem = j - (gm << gsh);
        const int gs = (ntl - 8 * gm < 8) ? (ntl - 8 * gm) : 8, g4 = gs * 4, pg = (rem >= g4) ? 1 : 0, r2 = rem - pg * g4;
        const int mt = lo + 8 * gm + (r2 >> 2), e = __builtin_amdgcn_readfirstlane(tb[40 + mt]);
        u.pm = mt; u.pn = e * NT + pg * 4 + (r2 & 3); return true;
    }
};

__device__ __forceinline__ float gelu_f(float v) {
    const float av = fabsf(v), t = __builtin_amdgcn_rcpf(fmaf(av, 0.2316418882f, 1.0f));
    float q = fmaf(t, 0.5307027145f, -0.7265760135f); q = fmaf(q, t, 0.7107068705f); q = fmaf(q, t, -0.142248368f); q = fmaf(q, t, 0.127414796f); q = q * t;
    const float e = __builtin_amdgcn_exp2f((v * v) * (-0.72134752044f));
    const float m = v * (q * e);
    return v < 0.f ? m : v - m;
}
__device__ __forceinline__ float sigmoid_f(float x) { return __builtin_amdgcn_rcpf(1.f + __builtin_amdgcn_exp2f(x * (-LOG2E))); }
__device__ __forceinline__ int perm16(int o) { return (o & 3) | (((o >> 3) & 1) << 2) | (((o >> 2) & 1) << 3); }
__device__ __forceinline__ void st_bf4(bf16_t* p, f32x4 v) { u32x2 w; w.x = pk2(v[0], v[1]); w.y = pk2(v[2], v[3]); *(u32x2*)p = w; }
__device__ __forceinline__ f32x4 other32_4(f32x4 v, bool upper) { f32x4 r; r[0] = xother32(v[0], upper); r[1] = xother32(v[1], upper); r[2] = xother32(v[2], upper); r[3] = xother32(v[3], upper); return r; }

__device__ __forceinline__ void st_bf8(bf16_t* p, f32x4 v0, f32x4 v1) { u32x4 w; w.x = pk2(v0[0], v0[1]); w.y = pk2(v0[2], v0[3]); w.z = pk2(v1[0], v1[1]); w.w = pk2(v1[2], v1[3]); __builtin_nontemporal_store(w, (u32x4*)p); }
__device__ __forceinline__ f32x4 swz16_4(f32x4 v) { f32x4 r; r[0] = xswz<16>(v[0]); r[1] = xswz<16>(v[1]); r[2] = xswz<16>(v[2]); r[3] = xswz<16>(v[3]); return r; }
__device__ __forceinline__ void ld_bf8(const bf16_t* p, f32x4& a, f32x4& b) { const u32x4 w = *(const u32x4*)p; a = (f32x4){bflo(w.x), bfhi(w.x), bflo(w.y), bfhi(w.y)}; b = (f32x4){bflo(w.z), bfhi(w.z), bflo(w.w), bfhi(w.w)}; }
__device__ __forceinline__ void st_vt8(bf16_t* p, f32x4 v0, f32x4 v1) {
    const unsigned w0 = pk2(v0[0], v0[1]), w1 = pk2(v0[2], v0[3]), w2 = pk2(v1[0], v1[1]), w3 = pk2(v1[2], v1[3]);
    p[0] = (bf16_t)(w0 & 0xffff); p[SEQ] = (bf16_t)(w0 >> 16); p[2 * SEQ] = (bf16_t)(w1 & 0xffff); p[3 * SEQ] = (bf16_t)(w1 >> 16);
    p[4 * SEQ] = (bf16_t)(w2 & 0xffff); p[5 * SEQ] = (bf16_t)(w2 >> 16); p[6 * SEQ] = (bf16_t)(w3 & 0xffff); p[7 * SEQ] = (bf16_t)(w3 >> 16);
}
struct EpiInProj {
    static constexpr bool CHAIN = false; static constexpr bool PRE = false;
    unsigned char* ws; bool skip;
    __device__ __forceinline__ void operator()(f32x4 (&acc)[2][2][4][2], const Unit& un, int wr, int wc, int fr, int fq) const {
        if (skip) return;
        const int pn = un.pn; const int row0 = un.pm * 256 + wr * 64 + fr;
        const float* cosA = (const float*)(ws + WS_COSA); const float* sinA = (const float*)(ws + WS_SINA); const float* cosC = (const float*)(ws + WS_COSC); const float* sinC = (const float*)(ws + WS_SINC);
        if (pn < 4 || pn == 6 || pn == 7) {
            const size_t doff = pn < 2 ? WS_QA : (pn < 4 ? WS_KA : WS_IQ); bf16_t* dst = (bf16_t*)(ws + doff); const float sc = pn < 2 ? QSCALE_A : 1.f; const int tcol = (pn & 1) * 256;
            const bool rope = (wc & 1) == 0;
#pragma unroll
            for (int ai = 0; ai < 2; ++ai)
#pragma unroll
                for (int m = 0; m < 4; ++m) { const int row = row0 + ai * 128 + m * 16;
                    f32x4 c0 = {1.f, 1.f, 1.f, 1.f}, c1 = c0, s0 = {0.f, 0.f, 0.f, 0.f}, s1 = s0;
                    if (rope) { c0 = *(const f32x4*)(cosA + (size_t)row * 8); c1 = *(const f32x4*)(cosA + (size_t)row * 8 + 4); s0 = *(const f32x4*)(sinA + (size_t)row * 8); s1 = *(const f32x4*)(sinA + (size_t)row * 8 + 4); }
#pragma unroll
                    for (int bj = 0; bj < 2; ++bj) { f32x4 v0 = acc[ai][bj][m][0], v1 = acc[ai][bj][m][1];
                        const f32x4 p0 = swz16_4(v0), p1 = swz16_4(v1);
                        if (rope && fq < 2) { v0 = (fq == 0) ? (v0 * c0 - p0 * s0) : (v0 * c0 + p0 * s0); v1 = (fq == 0) ? (v1 * c1 - p1 * s1) : (v1 * c1 + p1 * s1); }
                        st_bf8(dst + (size_t)row * 512 + tcol + bj * 128 + wc * 32 + 8 * fq, v0 * sc, v1 * sc); } }
        } else if (pn < 6) {
            bf16_t* vat = (bf16_t*)(ws + WS_VAT);
#pragma unroll
            for (int ai = 0; ai < 2; ++ai)
#pragma unroll
                for (int m = 0; m < 4; ++m) { const int row = row0 + ai * 128 + m * 16; const int b = row >> 12, s = row & 4095, ps = (s & ~15) | perm16(s & 15);
#pragma unroll
                    for (int bj = 0; bj < 2; ++bj) { const int c = (pn - 4) * 256 + bj * 128 + wc * 32 + 8 * fq; const int h = c >> 6, d = c & 63;
                        st_vt8(vat + ((size_t)(b * 8 + h) * 64 + d) * SEQ + ps, acc[ai][bj][m][0], acc[ai][bj][m][1]); } }
        } else if (pn == 8) {
            bf16_t* ik = (bf16_t*)(ws + WS_IK); float* iw = (float*)(ws + WS_IW); bf16_t* kc = (bf16_t*)(ws + WS_KC); bf16_t* cd = (bf16_t*)(ws + WS_CDKV); float* ssq = (float*)(ws + WS_SSQ);
#pragma unroll
            for (int ai = 0; ai < 2; ++ai)
#pragma unroll
                for (int m = 0; m < 4; ++m) { const int row = row0 + ai * 128 + m * 16;
                    { f32x4 v0 = acc[ai][0][m][0], v1 = acc[ai][0][m][1];
                      { unsigned zz = 0u; asm volatile("" : "+v"(zz)); const u32x4 z = {zz, zz, zz, zz}; *(u32x4*)(cd + (size_t)row * 256 + wc * 32 + 8 * fq) = z; }
                      if (wc == 0) {
                          const f32x4 p0 = swz16_4(v0), p1 = swz16_4(v1);
                          if (fq < 2) { const f32x4 c0 = *(const f32x4*)(cosA + (size_t)row * 8), c1 = *(const f32x4*)(cosA + (size_t)row * 8 + 4), s0 = *(const f32x4*)(sinA + (size_t)row * 8), s1 = *(const f32x4*)(sinA + (size_t)row * 8 + 4);
                              v0 = (fq == 0) ? (v0 * c0 - p0 * s0) : (v0 * c0 + p0 * s0); v1 = (fq == 0) ? (v1 * c1 - p1 * s1) : (v1 * c1 + p1 * s1); }
                          st_bf8(ik + (size_t)row * 64 + 8 * fq, v0, v1);
                      } else if (wc == 1) { st_bf8(ik + (size_t)row * 64 + 32 + 8 * fq, v0, v1);
                      } else if (wc == 2) { if (fq == 0) { *(f32x4*)(iw + (size_t)row * 8) = v0 * IW_SCALE; *(f32x4*)(iw + (size_t)row * 8 + 4) = v1 * IW_SCALE; }
                      } else {
                          const bool up = fq >= 2; const f32x4 p0 = other32_4(v0, up), p1 = other32_4(v1, up);
                          const f32x4 c0 = *(const f32x4*)(cosC + (size_t)row * 16 + 8 * (fq & 1)), c1 = *(const f32x4*)(cosC + (size_t)row * 16 + 8 * (fq & 1) + 4), s0 = *(const f32x4*)(sinC + (size_t)row * 16 + 8 * (fq & 1)), s1 = *(const f32x4*)(sinC + (size_t)row * 16 + 8 * (fq & 1) + 4);
                          const f32x4 o0 = up ? (v0 * c0 + p0 * s0) : (v0 * c0 - p0 * s0), o1 = up ? (v1 * c1 + p1 * s1) : (v1 * c1 - p1 * s1);
                          bf16_t* p = kc + (size_t)row * 768 + 64 + 8 * fq;
#pragma unroll
                          for (int h = 0; h < 8; ++h) st_bf8(p + h * 96, o0, o1); } }
                    { const f32x4 v0 = acc[ai][1][m][0], v1 = acc[ai][1][m][1];
                      st_bf8(cd + (size_t)row * 256 + 128 + wc * 32 + 8 * fq, v0, v1);
                      float s = (v0[0] * v0[0] + v0[1] * v0[1]) + (v0[2] * v0[2] + v0[3] * v0[3]) + (v1[0] * v1[0] + v1[1] * v1[1]) + (v1[2] * v1[2] + v1[3] * v1[3]);
                      s += xswz<16>(s); s = xsum32(s);
                      if (fq == 0) ssq[(size_t)row * 8 + 4 + wc] = s; } }
        } else if (pn < 13) {
            bf16_t* dst = (bf16_t*)(ws + (pn < 11 ? WS_U : WS_V)); const int tcol = ((pn - 9) & 1) * 256;
#pragma unroll
            for (int ai = 0; ai < 2; ++ai)
#pragma unroll
                for (int m = 0; m < 4; ++m) { const int row = row0 + ai * 128 + m * 16;
#pragma unroll
                    for (int bj = 0; bj < 2; ++bj) { f32x4 v0 = acc[ai][bj][m][0], v1 = acc[ai][bj][m][1];
                        v0[0] = gelu_f(v0[0]); v0[1] = gelu_f(v0[1]); v0[2] = gelu_f(v0[2]); v0[3] = gelu_f(v0[3]); v1[0] = gelu_f(v1[0]); v1[1] = gelu_f(v1[1]); v1[2] = gelu_f(v1[2]); v1[3] = gelu_f(v1[3]);
                        st_bf8(dst + (size_t)row * 512 + tcol + bj * 128 + wc * 32 + 8 * fq, v0, v1); } }
        } else if (pn == 13) {
            bf16_t* cd = (bf16_t*)(ws + WS_CDQ); float* ssq = (float*)(ws + WS_SSQ);
#pragma unroll
            for (int ai = 0; ai < 2; ++ai)
#pragma unroll
                for (int m = 0; m < 4; ++m) { const int row = row0 + ai * 128 + m * 16; float s = 0.f;
#pragma unroll
                    for (int bj = 0; bj < 2; ++bj) { const f32x4 v0 = acc[ai][bj][m][0], v1 = acc[ai][bj][m][1];
                        st_bf8(cd + (size_t)row * 256 + bj * 128 + wc * 32 + 8 * fq, v0, v1);
                        s += ((v0[0] * v0[0] + v0[1] * v0[1]) + (v0[2] * v0[2] + v0[3] * v0[3])) + ((v1[0] * v1[0] + v1[1] * v1[1]) + (v1[2] * v1[2] + v1[3] * v1[3])); }
                    s += xswz<16>(s); s = xsum32(s);
                    if (fq == 0) ssq[(size_t)row * 8 + wc] = s; }
        } else {
            const int tcol = (pn - 14) * 256; bf16_t* gate = (bf16_t*)(ws + WS_GATE);
#pragma unroll
            for (int ai = 0; ai < 2; ++ai)
#pragma unroll
                for (int m = 0; m < 4; ++m) { const int row = row0 + ai * 128 + m * 16;
#pragma unroll
                    for (int bj = 0; bj < 2; ++bj) { f32x4 v0 = acc[ai][bj][m][0], v1 = acc[ai][bj][m][1];
                        v0[0] = sigmoid_f(v0[0]); v0[1] = sigmoid_f(v0[1]); v0[2] = sigmoid_f(v0[2]); v0[3] = sigmoid_f(v0[3]); v1[0] = sigmoid_f(v1[0]); v1[1] = sigmoid_f(v1[1]); v1[2] = sigmoid_f(v1[2]); v1[3] = sigmoid_f(v1[3]);
                        st_bf8(gate + (size_t)row * 3072 + tcol + bj * 128 + wc * 32 + 8 * fq, v0, v1); } }
        }
    }
};

struct EpiQUp {
    static constexpr bool CHAIN = false; static constexpr bool PRE = false;
    bf16_t* qc; const float* ssq; const float *cosC, *sinC;
    __device__ __forceinline__ void operator()(f32x4 (&acc)[2][2][4][2], const Unit& un, int wr, int wc, int fr, int fq) const {
        const int row0 = un.pm * 256 + wr * 64 + fr; const bool up = fq >= 2;
#pragma unroll
        for (int ai = 0; ai < 2; ++ai)
#pragma unroll
            for (int m = 0; m < 4; ++m) { const int row = row0 + ai * 128 + m * 16;
                const f32x4 sp = *(const f32x4*)(ssq + (size_t)row * 8);
                const float rs = rsqrtf(((sp[0] + sp[1]) + (sp[2] + sp[3])) * (1.f / 256.f) + RMS_EPS) * QSCALE_C;
                const f32x4 c0 = *(const f32x4*)(cosC + (size_t)row * 16 + 8 * (fq & 1)), c1 = *(const f32x4*)(cosC + (size_t)row * 16 + 8 * (fq & 1) + 4), s0 = *(const f32x4*)(sinC + (size_t)row * 16 + 8 * (fq & 1)), s1 = *(const f32x4*)(sinC + (size_t)row * 16 + 8 * (fq & 1) + 4);
#pragma unroll
                for (int bj = 0; bj < 2; ++bj) { const int gidx = un.pn * 8 + bj * 4 + wc;
                    f32x4 v0 = acc[ai][bj][m][0] * rs, v1 = acc[ai][bj][m][1] * rs;
                    if ((gidx % 3) == 2) { const f32x4 p0 = other32_4(v0, up), p1 = other32_4(v1, up);
                        v0 = up ? (v0 * c0 + p0 * s0) : (v0 * c0 - p0 * s0); v1 = up ? (v1 * c1 + p1 * s1) : (v1 * c1 - p1 * s1); }
                    st_bf8(qc + (size_t)row * 768 + gidx * 32 + 8 * fq, v0, v1); } }
    }
};
struct EpiKvUp {
    static constexpr bool CHAIN = false; static constexpr bool PRE = false;
    bf16_t *kc, *vct; const float* ssq;
    __device__ __forceinline__ void operator()(f32x4 (&acc)[2][2][4][2], const Unit& un, int wr, int wc, int fr, int fq) const {
        const int row0 = un.pm * 256 + wr * 64 + fr;
#pragma unroll
        for (int ai = 0; ai < 2; ++ai)
#pragma unroll
            for (int m = 0; m < 4; ++m) { const int row = row0 + ai * 128 + m * 16;
                const f32x4 sp = *(const f32x4*)(ssq + (size_t)row * 8 + 4);
                const float rs = rsqrtf(((sp[0] + sp[1]) + (sp[2] + sp[3])) * (1.f / 128.f) + RMS_EPS);
                const int b = row >> 12, s = row & 4095, ps = (s & ~15) | perm16(s & 15);
#pragma unroll
                for (int bj = 0; bj < 2; ++bj) { const int h = un.pn * 2 + bj; const f32x4 v0 = acc[ai][bj][m][0] * rs, v1 = acc[ai][bj][m][1] * rs;
                    if (wc < 2) st_bf8(kc + (size_t)row * 768 + h * 96 + wc * 32 + 8 * fq, v0, v1);
                    else st_vt8(vct + ((size_t)(b * 8 + h) * 64 + (wc - 2) * 32 + 8 * fq) * SEQ + ps, v0, v1); }
                asm volatile("" ::: "memory"); }
    }
};
struct EpiMerge {
    static constexpr bool CHAIN = true; static constexpr bool PRE = false;
    const bf16_t* gate; bf16_t* merged;
    __device__ __forceinline__ void operator()(f32x4 (&acc)[2][2][4][2], const Unit& un, int wr, int wc, int fr, int fq) const {
        const int n3 = un.pm >> 7, pm = un.pm & 127, pn = un.pn & 3; const int row0 = pm * 256 + wr * 64 + fr;
#pragma unroll
        for (int ai = 0; ai < 2; ++ai)
#pragma unroll
            for (int m = 0; m < 4; ++m) { const int row = row0 + ai * 128 + m * 16;
#pragma unroll
                for (int bj = 0; bj < 2; ++bj) { const int col = pn * 256 + bj * 128 + wc * 32 + 8 * fq;
                    const bf16_t* gp = gate + (size_t)row * 3072 + n3 * 1024 + col;
                    f32x4 ga0, ga1; ld_bf8(gp, ga0, ga1);
                    if (n3 < 2) { f32x4 gb0, gb1; ld_bf8(gp + 1024, gb0, gb1);
#pragma unroll
                        for (int j = 0; j < 4; ++j) { if (n3 == 1) { ga0[j] = fmaxf(ga0[j], 1e-20f); ga1[j] = fmaxf(ga1[j], 1e-20f); }
                            acc[ai][bj][m][0][j] *= ga0[j] * __builtin_amdgcn_rcpf(fmaxf(gb0[j], 1e-20f)); acc[ai][bj][m][1][j] *= ga1[j] * __builtin_amdgcn_rcpf(fmaxf(gb1[j], 1e-20f)); }
                    } else {
#pragma unroll
                        for (int j = 0; j < 4; ++j) { ga0[j] = fmaxf(ga0[j], 1e-20f); ga1[j] = fmaxf(ga1[j], 1e-20f); }
                        st_bf8(merged + (size_t)row * 1024 + col, acc[ai][bj][m][0] * ga0, acc[ai][bj][m][1] * ga1);
                        acc[ai][bj][m][0] = (f32x4){0.f, 0.f, 0.f, 0.f}; acc[ai][bj][m][1] = (f32x4){0.f, 0.f, 0.f, 0.f};
                    } } }
    }
};
struct EpiOut {
    static constexpr bool CHAIN = false; static constexpr bool PRE = false;
    bf16_t* yo;
    __device__ __forceinline__ void operator()(f32x4 (&acc)[2][2][4][2], const Unit& un, int wr, int wc, int fr, int fq) const {
        const int row0 = un.pm * 256 + wr * 64 + fr;
#pragma unroll
        for (int ai = 0; ai < 2; ++ai)
#pragma unroll
            for (int m = 0; m < 4; ++m) { const int row = row0 + ai * 128 + m * 16;
#pragma unroll
                for (int bj = 0; bj < 2; ++bj) st_bf8(yo + (size_t)row * 1024 + un.pn * 256 + bj * 128 + wc * 32 + 8 * fq, acc[ai][bj][m][0], acc[ai][bj][m][1]); }
    }
};
struct EpiMoeUp {
    static constexpr bool CHAIN = false; static constexpr bool PRE = true;
    bf16_t* hbuf; const float* bgu;
    __device__ __forceinline__ const float* pre_base(const Unit& un, int w) const { const int e = un.pn >> 3, pnl = un.pn & 7; return bgu + (size_t)e * 2048 + pnl * 128 + (w < 2 ? w * 64 : 1024 + (w - 2) * 64); }
    __device__ __forceinline__ void operator()(f32x4 (&acc)[2][2][4][2], const Unit& un, int wr, int wc, int fr, int fq, const LAS float* pre) const {
        const int pnl = un.pn & 7; const int row0 = un.pm * 256 + wr * 64 + fr;
        const int jh = pnl * 128 + wc * 32 + 8 * fq; const LAS float* pb = pre + wc * 32 + 8 * fq;
        const f32x4 bg0 = *(const LAS f32x4*)(pb), bg1 = *(const LAS f32x4*)(pb + 4), bl0 = *(const LAS f32x4*)(pb + 128), bl1 = *(const LAS f32x4*)(pb + 132);
#pragma unroll
        for (int ai = 0; ai < 2; ++ai)
#pragma unroll
            for (int m = 0; m < 4; ++m) { const int row = row0 + ai * 128 + m * 16;
                const f32x4 g0 = acc[ai][0][m][0] + bg0, g1 = acc[ai][0][m][1] + bg1, l0 = acc[ai][1][m][0] + bl0, l1 = acc[ai][1][m][1] + bl1; f32x4 o0, o1;
#pragma unroll
                for (int j = 0; j < 4; ++j) { const float ga = fminf(g0[j], 7.f), la = fminf(fmaxf(l0[j], -7.f), 7.f); o0[j] = (la + 1.f) * (ga * sigmoid_f(1.702f * ga));
                    const float gb = fminf(g1[j], 7.f), lb = fminf(fmaxf(l1[j], -7.f), 7.f); o1[j] = (lb + 1.f) * (gb * sigmoid_f(1.702f * gb)); }
                st_bf8(hbuf + (size_t)row * 1024 + jh, o0, o1);
                __builtin_amdgcn_sched_barrier(0); }
    }
};
struct EpiMoeDn {
    static constexpr bool CHAIN = false; static constexpr bool PRE = true;
    bf16_t* y; const float* bdn; bool skip;
    __device__ __forceinline__ const float* pre_base(const Unit& un, int w) const { const int e = un.pn >> 2, pnl = un.pn & 3; return bdn + (size_t)e * 1024 + pnl * 256 + w * 64; }
    __device__ __forceinline__ void operator()(f32x4 (&acc)[2][2][4][2], const Unit& un, int wr, int wc, int fr, int fq, const LAS float* pre) const {
        const int pnl = un.pn & 3; const int row0 = (skip ? 0 : un.pm * 256) + wr * 64 + fr;
#pragma unroll
        for (int bj = 0; bj < 2; ++bj) { const int col = pnl * 256 + bj * 128 + wc * 32 + 8 * fq; const LAS float* pb = pre + bj * 128 + wc * 32 + 8 * fq; const f32x4 b0 = *(const LAS f32x4*)(pb), b1 = *(const LAS f32x4*)(pb + 4);
#pragma unroll
            for (int ai = 0; ai < 2; ++ai)
#pragma unroll
                for (int m = 0; m < 4; ++m) st_bf8(y + (size_t)(row0 + ai * 128 + m * 16) * 1024 + col, acc[ai][bj][m][0] + b0, acc[ai][bj][m][1] + b1); }
    }
};

__device__ __forceinline__ float wave_sum(float v) {
    v += xswz<1>(v); v += xswz<2>(v); v += xswz<4>(v); v += xswz<8>(v); v += xswz<16>(v); return xsum32(v);
}
__device__ __forceinline__ int colmap_in(int np) {
    if (np < 2048) return np;
    if (np < 2304) { const int t = np - 2048; if (t < 64) return 2048 + t; if (t < 72) return 2112 + (t - 64); if (t < 96) return -1; if (t < 128) return 3528 + (t - 96); return 3400 + (t - 128); }
    if (np < 3328) return 2120 + (np - 2304);
    if (np < 3584) return 3144 + (np - 3328);
    return 3560 + (np - 3584);
}
__device__ __forceinline__ int colmap_gu(int np) { const int tile = np >> 8, w = np & 255; return (w < 128) ? (tile * 128 + w) : (1024 + tile * 128 + (w - 128)); }
template <int KIND>
__device__ __forceinline__ void tconv_item(const float* src, int ldsrc, bf16_t* dst, int Kdst, int koff, const float* kscale, int item, int nblk, LAS float* scr, int lane) {
    const int kb = item / nblk, nb = item - kb * nblk, k0 = 64 * kb, n0 = 32 * nb;
    const int np = n0 + (lane & 31);
    const int col = KIND == 1 ? colmap_in(np) : (KIND == 2 ? colmap_gu(np) : np);
    float vv[32];
#pragma unroll
    for (int i = 0; i < 32; ++i) { const int kk = 2 * i + (lane >> 5); const int ks = k0 + kk - koff; float v = 0.f;
        if (col >= 0 && ks >= 0) { v = src[(size_t)ks * ldsrc + col]; if (kscale) v *= kscale[ks]; }
        vv[i] = v; }
#pragma unroll
    for (int i = 0; i < 32; ++i) { const int kk = 2 * i + (lane >> 5); scr[kk * 33 + (lane & 31)] = vv[i]; }
    LDS_WAIT(); asm volatile("" ::: "memory");
    const int c = lane & 7;
#pragma unroll
    for (int j = 0; j < 4; ++j) { const int n = (lane >> 3) + 8 * j; const LAS float* s = scr + (8 * c) * 33 + n;
        u32x4 o; o.x = pk2(s[0 * 33], s[1 * 33]); o.y = pk2(s[2 * 33], s[3 * 33]); o.z = pk2(s[4 * 33], s[5 * 33]); o.w = pk2(s[6 * 33], s[7 * 33]);
        *(u32x4*)(dst + (size_t)(n0 + n) * Kdst + k0 + 8 * c) = o; }
    LDS_WAIT(); asm volatile("" ::: "memory");
}
__device__ __forceinline__ void phase_prologue(const Ctx& C, const Args& A) {
    LAS float* scr = (LAS float*)(C.lds + C.wave * 16384);
    const int gw = C.bid * NWAVES + C.wave, NGW = C.G * NWAVES;
    constexpr int I_IN = 16 * (NIN / 32), I_UQ = 4 * 24, I_UKV = 4 * 32, I_BR = 8 * 32, I_OUT = 16 * 32, I_GU = 16 * 64, I_DN = 16 * 32;
    constexpr int I_LAYER = I_IN + I_UQ + I_UKV + 3 * I_BR + I_OUT + NEXP * I_GU + NEXP * I_DN;
    for (int it = gw; it < NLAYER * I_LAYER; it += NGW) {
        const int l = it / I_LAYER; int r = it - l * I_LAYER;
        if (r < I_IN) { tconv_item<1>(A.in[2] + (size_t)l * DM * NIN_SRC, NIN_SRC, WSP(bf16_t, WS_WIN + l * SZ_WIN), 1024, 0, nullptr, r, NIN / 32, scr, C.lane); continue; } r -= I_IN;
        if (r < I_UQ) { tconv_item<0>(A.in[9] + (size_t)l * 256 * 768, 768, WSP(bf16_t, WS_WUQ + l * SZ_WUQ), 256, 0, A.in[7] + l * 256, r, 24, scr, C.lane); continue; } r -= I_UQ;
        if (r < I_UKV) { tconv_item<0>(A.in[10] + (size_t)l * 128 * 1024, 1024, WSP(bf16_t, WS_WUKV + l * SZ_WUKV), 256, 128, A.in[8] + l * 128, r, 32, scr, C.lane); continue; } r -= I_UKV;
        if (r < 3 * I_BR) { const int n = r / I_BR; r -= n * I_BR;
            tconv_item<0>(A.in[11] + ((size_t)l * 3 + n) * 512 * 1024, 1024, WSP(bf16_t, WS_WBR + l * SZ_WBR) + (size_t)n * 1024 * 512, 512, 0, nullptr, r, 32, scr, C.lane); continue; } r -= 3 * I_BR;
        if (r < I_OUT) { tconv_item<0>(A.in[12] + (size_t)l * 1024 * 1024, 1024, WSP(bf16_t, WS_WOUT + l * SZ_WOUT), 1024, 0, nullptr, r, 32, scr, C.lane); continue; } r -= I_OUT;
        if (r < NEXP * I_GU) { const int e = r / I_GU; r -= e * I_GU;
            tconv_item<2>(A.in[17] + ((size_t)l * NEXP + e) * 1024 * 2048, 2048, WSP(bf16_t, WS_WGU + l * SZ_WGU) + (size_t)e * 2048 * 1024, 1024, 0, nullptr, r, 64, scr, C.lane); continue; } r -= NEXP * I_GU;
        { const int e = r / I_DN; r -= e * I_DN;
            tconv_item<0>(A.in[19] + ((size_t)l * NEXP + e) * 1024 * 1024, 1024, WSP(bf16_t, WS_WDN + l * SZ_WDN) + (size_t)e * 1024 * 1024, 1024, 0, nullptr, r, 32, scr, C.lane); }
    }
    const int gt = C.bid * 512 + C.tid, NGT = C.G * 512;
    { float* rwt = WSP(float, WS_RWT);
      for (int i = gt; i < NLAYER * 32 * 1024; i += NGT) { const int l = i >> 15, e = (i >> 10) & 31, k = i & 1023; rwt[i] = A.in[15][(size_t)l * 32768 + k * 32 + e] * A.in[13][l * 1024 + k]; }
      const int gwv = C.bid * NWAVES + C.wave;
      if (gwv < NLAYER * 32) { const int l = gwv >> 5, e = gwv & 31; const float* rw = A.in[15] + (size_t)l * 32768; const float* g1 = A.in[13] + l * 1024; const float* b1 = A.in[14] + l * 1024;
          float sg = 0.f, sb = 0.f;
#pragma unroll
          for (int j = 0; j < 16; ++j) { const int k = C.lane + 64 * j; sg += rw[k * 32 + e] * g1[k]; sb += b1[k] * rw[k * 32 + e]; }
          sg = wave_sum(sg); sb = wave_sum(sb);
          if (C.lane == 0) { float* gb = WSP(float, WS_GBW) + l * 64; gb[e] = sg; gb[32 + e] = sb + A.in[16][l * 32 + e]; } } }
    { bf16_t* d = WSP(bf16_t, WS_WGM); const float* s = A.in[5];
      for (int i = gt; i < NLAYER * 8 * 128 * 128; i += NGT) { const int jj = i & 127, ii = (i >> 7) & 127; d[i] = (jj <= ii) ? (bf16_t)(pk2(s[i], 0.f) & 0xffff) : (bf16_t)0; } }
    { const int* pos = (const int*)A.in[1]; float *ca = WSP(float, WS_COSA), *sa = WSP(float, WS_SINA), *cc = WSP(float, WS_COSC), *sc = WSP(float, WS_SINC);
      for (int i = gt; i < NTOK * 8; i += NGT) { const int t = i >> 3, f = i & 7; const float inv = powf(500000.f, -(float)f / 8.f); const float ang = (float)pos[t] * inv; ca[i] = cosf(ang); sa[i] = sinf(ang); }
      for (int i = gt; i < NTOK * 16; i += NGT) { const int t = i >> 4, f = i & 15; const float inv = powf(500000.f, -(float)f / 16.f); const float ang = (float)pos[t] * inv; cc[i] = cosf(ang); sc[i] = sinf(ang); } }
    { const f32x4* x4 = (const f32x4*)A.in[0]; u32x2* xb = WSP(u32x2, WS_XB);
      for (int i = gt; i < NTOK * DM / 4; i += NGT) { const f32x4 v = x4[i]; u32x2 w; w.x = pk2(v[0], v[1]); w.y = pk2(v[2], v[3]); xb[i] = w; } }
}

__device__ __forceinline__ void idx_block(const Ctx& C, int b, int qb) {
    const int tid = C.tid, lane = C.lane, wid = C.wave, r32 = lane & 31, hi = lane >> 5;
    const bf16_t* iq = WSP(bf16_t, WS_IQ); const bf16_t* ik = WSP(bf16_t, WS_IK); const float* iw = WSP(float, WS_IW); float* score = WSP(float, WS_SCORE);
    const int qi_l = ((r32 >> 4) << 1) + ((r32 >> 2) & 1), h_l = (r32 & 3) + 4 * ((r32 >> 3) & 1);
    bf16x8 af[2][4]; float wv[2][2][8];
#pragma unroll
    for (int rb = 0; rb < 2; ++rb) { const size_t tok = (size_t)b * SEQ + qb * 64 + wid * 8 + rb * 4 + qi_l;
#pragma unroll
        for (int ks = 0; ks < 4; ++ks) af[rb][ks] = *(const bf16x8*)(iq + tok * 512 + h_l * 64 + ks * 16 + hi * 8);
#pragma unroll
        for (int g = 0; g < 2; ++g) { const size_t tq = (size_t)b * SEQ + qb * 64 + wid * 8 + rb * 4 + 2 * g + hi;
            const f32x4 w0 = *(const f32x4*)(iw + tq * 8), w1 = *(const f32x4*)(iw + tq * 8 + 4);
            wv[rb][g][0] = w0[0]; wv[rb][g][1] = w0[1]; wv[rb][g][2] = w0[2]; wv[rb][g][3] = w0[3]; wv[rb][g][4] = w1[0]; wv[rb][g][5] = w1[1]; wv[rb][g][6] = w1[2]; wv[rb][g][7] = w1[3]; } }
    const int lkey = tid & 63, lch = tid >> 6;
    const bf16_t* ksrc = ik + ((size_t)b * SEQ + lkey) * 64 + lch * 8;
    LAS unsigned char* kdst = C.lds + (lch * 64 + lkey) * 16;
    const int NT = qb + 1;
    u32x4 rk = *(const u32x4*)ksrc;
    *(LAS u32x4*)kdst = rk;
    __syncthreads();
    for (int kt = 0; kt < NT; ++kt) {
        const int cur = kt & 1;
        if (kt + 1 < NT) rk = *(const u32x4*)(ksrc + (size_t)(kt + 1) * 64 * 64);
        const LAS unsigned char* kb = C.lds + cur * 8192;
        bf16x8 bfr[2][4];
#pragma unroll
        for (int kbk = 0; kbk < 2; ++kbk)
#pragma unroll
            for (int ks = 0; ks < 4; ++ks) bfr[kbk][ks] = *(const LAS bf16x8*)(kb + ((2 * ks + hi) * 64 + kbk * 32 + r32) * 16);
#pragma unroll
        for (int rb = 0; rb < 2; ++rb)
#pragma unroll
            for (int kbk = 0; kbk < 2; ++kbk) {
                f32x16 a = {};
#pragma unroll
                for (int ks = 0; ks < 4; ++ks) a = __builtin_amdgcn_mfma_f32_32x32x16_bf16(af[rb][ks], bfr[kbk][ks], a, 0, 0, 0);
#pragma unroll
                for (int g = 0; g < 2; ++g) { float s = 0.f;
#pragma unroll
                    for (int hh = 0; hh < 8; ++hh) s = fmaf(fmaxf(a[8 * g + hh], 0.f), wv[rb][g][hh], s);
                    const size_t tq = (size_t)b * SEQ + qb * 64 + wid * 8 + rb * 4 + 2 * g + hi;
                    score[tq * SEQ + kt * 64 + kbk * 32 + r32] = s; } }
        if (kt + 1 < NT) *(LAS u32x4*)(kdst + (cur ^ 1) * 8192) = rk;
        __syncthreads();
    }
}
__device__ __forceinline__ void phase_indexer(const Ctx& C) {
    for (int u0 = C.bid; u0 < NB * 32; u0 += C.G) {
        int u = u0; if (C.G == NB * 32) u = (C.bid & 7) * 32 + (C.bid >> 3);
        const int b = u >> 5, p = u & 31; idx_block(C, b, p); idx_block(C, b, 63 - p); }
}

__device__ __forceinline__ unsigned f2key(float f) { const unsigned u = __float_as_uint(f); return (u & 0x80000000u) ? ~u : (u | 0x80000000u); }
__device__ __forceinline__ int wave_total7(unsigned cv) {
    int t = 0;
#pragma unroll
    for (int b = 0; b < 7; ++b) t += __popcll(__ballot((cv >> b) & 1u)) << b;
    return t;
}
template <int NG>
__device__ __forceinline__ unsigned select_radix(const unsigned (&u)[64]) {
    unsigned prefix = 0u;
    for (int bit = 31; bit >= 0; --bit) {
        const unsigned cand = prefix | (1u << bit); unsigned cv = 0u;
#pragma unroll
        for (int i = 0; i < NG * 8; ++i) cv += (u[i] >= cand) ? 1u : 0u;
        const int cnt = wave_total7(cv);
        if (cnt >= 256) prefix = cand;
        if (cnt == 256) break;
    }
    return prefix;
}
__device__ __forceinline__ int wave_sum_dpp(int x) {
    x += __builtin_amdgcn_update_dpp(0, x, 0xB1, 0xf, 0xf, true);
    x += __builtin_amdgcn_update_dpp(0, x, 0x4E, 0xf, 0xf, true);
    x += __builtin_amdgcn_update_dpp(0, x, 0x141, 0xf, 0xf, true);
    x += __builtin_amdgcn_update_dpp(0, x, 0x140, 0xf, 0xf, true);
    x += __builtin_amdgcn_update_dpp(0, x, 0x142, 0xa, 0xf, false);
    x += __builtin_amdgcn_update_dpp(0, x, 0x143, 0xc, 0xf, false);
    return __builtin_amdgcn_readlane(x, 63);
}
__device__ __forceinline__ unsigned bfi32(unsigned m, unsigned x, unsigned y) { return (m & x) | (~m & y); }
__device__ __forceinline__ void bit_transpose32(unsigned* a) {
#pragma unroll
    for (int k = 0; k < 16; ++k) { const unsigned x = a[k], y = a[k + 16]; a[k] = __builtin_amdgcn_perm(y, x, 0x05040100u); a[k + 16] = __builtin_amdgcn_perm(y, x, 0x07060302u); }
#pragma unroll
    for (int k = 0; k < 32; ++k) if ((k & 8) == 0) { const unsigned x = a[k], y = a[k + 8]; a[k] = __builtin_amdgcn_perm(y, x, 0x06020400u); a[k + 8] = __builtin_amdgcn_perm(y, x, 0x07030501u); }
#pragma unroll
    for (int k = 0; k < 32; ++k) if ((k & 4) == 0) { const unsigned x = a[k], y = a[k + 4]; a[k] = bfi32(0x0f0f0f0fu, x, y << 4); a[k + 4] = bfi32(0x0f0f0f0fu, x >> 4, y); }
#pragma unroll
    for (int k = 0; k < 32; ++k) if ((k & 2) == 0) { const unsigned x = a[k], y = a[k + 2]; a[k] = bfi32(0x33333333u, x, y << 2); a[k + 2] = bfi32(0x33333333u, x >> 2, y); }
#pragma unroll
    for (int k = 0; k < 32; ++k) if ((k & 1) == 0) { const unsigned x = a[k], y = a[k + 1]; a[k] = bfi32(0x55555555u, x, y << 1); a[k + 1] = bfi32(0x55555555u, x >> 1, y); }
}
template <int NW>
__device__ __forceinline__ void select_bits(const float* row, int n, unsigned* mrow, int lane) {
    constexpr int W = 32 * NW;
    unsigned a[W];
    {   const u32x4* src = (const u32x4*)(row + lane * W);
#pragma unroll
        for (int i = 0; i < W / 4; ++i) { const u32x4 v = src[i];
#pragma unroll
            for (int j = 0; j < 4; ++j) { const unsigned u = v[j]; a[4 * i + j] = u ^ ((unsigned)((int)u >> 31) | 0x80000000u); } }
    }
#pragma unroll
    for (int blk = 0; blk < NW; ++blk) bit_transpose32(a + 32 * blk);
    unsigned alive[NW], above[NW];
#pragma unroll
    for (int w = 0; w < NW; ++w) { const int nv = n - lane * W - 32 * w; alive[w] = nv >= 32 ? 0xffffffffu : (nv <= 0 ? 0u : ((1u << nv) - 1u)); above[w] = 0u; }
    int cnta = 0; bool exact = false;
#pragma unroll
    for (int b = 31; b >= 0; --b) {
        unsigned o[NW]; int pc = 0;
#pragma unroll
        for (int w = 0; w < NW; ++w) { o[w] = alive[w] & a[32 * w + b]; pc += __popc(o[w]); }
        const int tot = cnta + wave_sum_dpp(pc);
        if (tot >= 256) {
#pragma unroll
            for (int w = 0; w < NW; ++w) alive[w] = o[w];
            if (tot == 256) { exact = true; break; }
        } else {
#pragma unroll
            for (int w = 0; w < NW; ++w) { above[w] |= o[w]; alive[w] ^= o[w]; }
            cnta = tot;
        }
    }
    if (!exact) {
        int pc = 0;
#pragma unroll
        for (int w = 0; w < NW; ++w) pc += __popc(alive[w]);
        const int ceq = wave_sum_dpp(pc), need = 256 - cnta;
        if (ceq > need) {
            int excl = 0;
#pragma unroll 1
            for (int L = 0; L < 63; ++L) { const int v = __builtin_amdgcn_readlane(pc, L); excl += (lane > L) ? v : 0; }
            int take = need - excl; take = take < 0 ? 0 : (take > pc ? pc : take);
            int c = pc;
            if (NW == 2) { while (c > take && alive[NW - 1] != 0u) { alive[NW - 1] &= ~(0x80000000u >> __clz(alive[NW - 1])); --c; } }
            while (c > take) { alive[0] &= ~(0x80000000u >> __clz(alive[0])); --c; }
        }
    }
    if (NW == 2) { u32x2 m; m.x = above[0] | alive[0]; m.y = above[NW - 1] | alive[NW - 1]; *(u32x2*)(mrow + 2 * lane) = m; }
    else { mrow[lane] = above[0] | alive[0]; mrow[64 + lane] = 0u; }
}
__device__ __forceinline__ void phase_select(const Ctx& C) {
    const float* score = WSP(float, WS_SCORE); unsigned long long* mask = WSP(unsigned long long, WS_MASK);
    const int gw = C.bid * NWAVES + C.wave, NGW = C.G * NWAVES, lane = C.lane;
    for (int idx = gw; idx < NTOK; idx += NGW) {
        const int q = idx & (SEQ - 1); const int n = q + 1; const float* row = score + (size_t)idx * SEQ;
        if (n <= 256) {
            const int lo = n - 64 * lane;
            const unsigned long long m = lo >= 64 ? ~0ull : (lo <= 0 ? 0ull : ((1ull << lo) - 1ull));
            mask[(size_t)idx * 64 + lane] = m;
        } else if (n <= 2048) select_bits<1>(row, n, (unsigned*)(mask + (size_t)idx * 64), lane);
        else select_bits<2>(row, n, (unsigned*)(mask + (size_t)idx * 64), lane);
    }
}

__device__ __forceinline__ int crow(int r, int hi) { return (r & 3) + 8 * (r >> 2) + 4 * hi; }
template <int DQK, bool MASKED>
__device__ __forceinline__ void attn_unit(const Ctx& C, int b, int h, int qb, const bf16_t* Q, const bf16_t* K, const bf16_t* VT, const unsigned* mask, bf16_t* O) {
    constexpr int NKS = DQK / 16, NCH = DQK / 8, KTB = NCH * 1024, BUF = KTB + 8192, QS = 8 * DQK;
    const int tid = C.tid, lane = C.lane, wid = C.wave, r32 = lane & 31, hi = lane >> 5;
    const int NT = 4 * (qb + 1);
    const size_t tok = (size_t)b * SEQ + qb * 256 + wid * 32 + r32;
    bf16x8 qf[NKS];
#pragma unroll
    for (int ks = 0; ks < NKS; ++ks) qf[ks] = *(const bf16x8*)(Q + tok * QS + h * DQK + ks * 16 + hi * 8);
    const int lrow = tid & 63, lch = tid >> 6;
    const bf16_t* ksrc0 = K + ((size_t)b * SEQ + lrow) * QS + h * DQK + lch * 8;
    const bf16_t* ksrc1 = ksrc0 + 64;
    const bf16_t* vsrc = VT + ((size_t)(b * 8 + h) * 64 + lrow) * SEQ + lch * 8;
    LAS unsigned char* kd0 = C.lds + (lch * 64 + lrow) * 16;
    LAS unsigned char* kd1 = C.lds + ((8 + lch) * 64 + lrow) * 16;
    LAS unsigned char* vd = C.lds + KTB + (lch * 64 + lrow) * 16;
    const bool k1 = (DQK > 64) && (tid < 256);
    u32x4 rk0, rk1 = {0u, 0u, 0u, 0u}, rv;
    rk0 = *(const u32x4*)ksrc0; if (k1) rk1 = *(const u32x4*)ksrc1; rv = *(const u32x4*)vsrc;
    *(LAS u32x4*)kd0 = rk0; if (k1) *(LAS u32x4*)kd1 = rk1; *(LAS u32x4*)vd = rv;
    u32x2 mw = {0u, 0u};
    if (MASKED) mw = *(const u32x2*)(mask + tok * 128);
    float mbias = 0.f, thr = -1e30f, lsum = 0.f;
    u32x4 qmw = {0u, 0u, 0u, 0u};
    const bf16x8 kone = __builtin_bit_cast(bf16x8, (u32x4){hi == 0 ? 0x3F80u : 0u, 0u, 0u, 0u});
    f32x16 o0 = {}, o1 = {};
    __syncthreads();
    for (int kt = 0; kt < NT; ++kt) {
        const int cur = kt & 1;
        u32x2 mwn = {0u, 0u};
        if (kt + 1 < NT) {
            rk0 = *(const u32x4*)(ksrc0 + (size_t)(kt + 1) * 64 * QS); if (k1) rk1 = *(const u32x4*)(ksrc1 + (size_t)(kt + 1) * 64 * QS);
            rv = *(const u32x4*)(vsrc + (kt + 1) * 64);
            if (MASKED) mwn = *(const u32x2*)(mask + tok * 128 + 2 * (kt + 1));
        }
        const LAS unsigned char* kb = C.lds + cur * BUF; const LAS unsigned char* vb = kb + KTB;
        f32x16 p0 = {}, p1 = {};
        bf16x8 kf[2 * NKS], vf[8];
#pragma unroll
        for (int ks = 0; ks < NKS; ++ks) {
            kf[2 * ks] = *(const LAS bf16x8*)(kb + ((2 * ks + hi) * 64 + r32) * 16);
            kf[2 * ks + 1] = *(const LAS bf16x8*)(kb + ((2 * ks + hi) * 64 + 32 + r32) * 16);
        }
#pragma unroll
        for (int s4 = 0; s4 < 4; ++s4) {
            vf[2 * s4] = *(const LAS bf16x8*)(vb + ((2 * s4 + hi) * 64 + r32) * 16);
            vf[2 * s4 + 1] = *(const LAS bf16x8*)(vb + ((2 * s4 + hi) * 64 + 32 + r32) * 16);
        }
        __builtin_amdgcn_sched_barrier(0);
#pragma unroll
        for (int ks = 0; ks < NKS; ++ks) {
            p0 = __builtin_amdgcn_mfma_f32_32x32x16_bf16(kf[2 * ks], qf[ks], p0, 0, 0, 0);
            p1 = __builtin_amdgcn_mfma_f32_32x32x16_bf16(kf[2 * ks + 1], qf[ks], p1, 0, 0, 0);
        }
        { const bf16x8 qm = __builtin_bit_cast(bf16x8, qmw);
          p0 = __builtin_amdgcn_mfma_f32_32x32x16_bf16(kone, qm, p0, 0, 0, 0); p1 = __builtin_amdgcn_mfma_f32_32x32x16_bf16(kone, qm, p1, 0, 0, 0); }
        if (MASKED) {
            const unsigned w0 = mw.x >> (4 * hi), w1 = mw.y >> (4 * hi);
#pragma unroll
            for (int r = 0; r < 16; ++r) { const int bit = (r & 3) + 8 * (r >> 2);
                const unsigned t0 = (unsigned)__builtin_amdgcn_sbfe((int)w0, bit, 1), t1 = (unsigned)__builtin_amdgcn_sbfe((int)w1, bit, 1);
                p0[r] = __uint_as_float((__float_as_uint(p0[r]) & t0) | (~t0 & 0xFF800000u));
                p1[r] = __uint_as_float((__float_as_uint(p1[r]) & t1) | (~t1 & 0xFF800000u)); }
        } else {
            if (kt >= NT - 4) { const int kb0 = (kt - (NT - 4)) * 64, qrel = wid * 32 + r32;
#pragma unroll
                for (int r = 0; r < 16; ++r) { const int kv = kb0 + crow(r, hi); if (kv > qrel) p0[r] = -INFINITY; if (kv + 32 > qrel) p1[r] = -INFINITY; } }
        }
        float mx;
        { float a0 = fmaxf(fmaxf(p0[0], p0[1]), p0[2]), a1 = fmaxf(fmaxf(p0[3], p0[4]), p0[5]), a2 = fmaxf(fmaxf(p0[6], p0[7]), p0[8]), a3 = fmaxf(fmaxf(p0[9], p0[10]), p0[11]);
          float a4 = fmaxf(fmaxf(p0[12], p0[13]), p0[14]), a5 = fmaxf(fmaxf(p0[15], p1[0]), p1[1]), a6 = fmaxf(fmaxf(p1[2], p1[3]), p1[4]), a7 = fmaxf(fmaxf(p1[5], p1[6]), p1[7]);
          float a8 = fmaxf(fmaxf(p1[8], p1[9]), p1[10]), a9 = fmaxf(fmaxf(p1[11], p1[12]), p1[13]), a10 = fmaxf(p1[14], p1[15]);
          a0 = fmaxf(fmaxf(a0, a1), a2); a3 = fmaxf(fmaxf(a3, a4), a5); a6 = fmaxf(fmaxf(a6, a7), a8); a9 = fmaxf(a9, a10);
          mx = fmaxf(fmaxf(a0, a3), fmaxf(a6, a9)); }
        mx = xmax32(mx);
        if (__any(mx > thr)) {
            const bool upd = mx > thr;
            const float mnew = upd ? __uint_as_float(pk2(mbias + mx, 0.f) << 16) : mbias;
            const float delta = mnew - mbias; const float alpha = (thr < 0.f) ? 1.f : __builtin_amdgcn_exp2f(-delta);
            mbias = mnew; thr = upd ? 4.f : thr;
            qmw.x = hi == 0 ? (pk2(-mnew, 0.f) & 0xffffu) : 0u;
            lsum *= alpha;
#pragma unroll
            for (int r = 0; r < 16; ++r) { o0[r] *= alpha; o1[r] *= alpha; p0[r] -= delta; p1[r] -= delta; }
        }
        {
#pragma unroll
            for (int r = 0; r < 16; ++r) { p0[r] = __builtin_amdgcn_exp2f(p0[r]); p1[r] = __builtin_amdgcn_exp2f(p1[r]); }
            float s0 = (p0[0] + p0[1]) + (p0[2] + p0[3]), s1 = (p0[4] + p0[5]) + (p0[6] + p0[7]), s2 = (p0[8] + p0[9]) + (p0[10] + p0[11]), s3 = (p0[12] + p0[13]) + (p0[14] + p0[15]);
            float s4 = (p1[0] + p1[1]) + (p1[2] + p1[3]), s5 = (p1[4] + p1[5]) + (p1[6] + p1[7]), s6 = (p1[8] + p1[9]) + (p1[10] + p1[11]), s7 = (p1[12] + p1[13]) + (p1[14] + p1[15]);
            lsum += ((s0 + s1) + (s2 + s3)) + ((s4 + s5) + (s6 + s7));
        }
        bf16x8 pf[4];
        { u32x4 t;
          t.x = pk2(p0[0], p0[1]); t.y = pk2(p0[2], p0[3]); t.z = pk2(p0[4], p0[5]); t.w = pk2(p0[6], p0[7]); pf[0] = __builtin_bit_cast(bf16x8, t);
          t.x = pk2(p0[8], p0[9]); t.y = pk2(p0[10], p0[11]); t.z = pk2(p0[12], p0[13]); t.w = pk2(p0[14], p0[15]); pf[1] = __builtin_bit_cast(bf16x8, t);
          t.x = pk2(p1[0], p1[1]); t.y = pk2(p1[2], p1[3]); t.z = pk2(p1[4], p1[5]); t.w = pk2(p1[6], p1[7]); pf[2] = __builtin_bit_cast(bf16x8, t);
          t.x = pk2(p1[8], p1[9]); t.y = pk2(p1[10], p1[11]); t.z = pk2(p1[12], p1[13]); t.w = pk2(p1[14], p1[15]); pf[3] = __builtin_bit_cast(bf16x8, t); }
#pragma unroll
        for (int s = 0; s < 4; ++s) {
            o0 = __builtin_amdgcn_mfma_f32_32x32x16_bf16(vf[2 * s], pf[s], o0, 0, 0, 0);
            o1 = __builtin_amdgcn_mfma_f32_32x32x16_bf16(vf[2 * s + 1], pf[s], o1, 0, 0, 0);
        }
        if (kt + 1 < NT) {
            const int nb = (cur ^ 1) * BUF;
            *(LAS u32x4*)(kd0 + nb) = rk0; if (k1) *(LAS u32x4*)(kd1 + nb) = rk1; *(LAS u32x4*)(vd + nb) = rv;
        }
        mw = mwn;
        __syncthreads();
    }
    lsum = xsum32(lsum);
    const float inv = 1.f / lsum;
    bf16_t* op = O + tok * 512 + h * 64 + 4 * hi;
#pragma unroll
    for (int i = 0; i < 4; ++i) {
        st_bf4(op + 8 * i, (f32x4){o0[4 * i] * inv, o0[4 * i + 1] * inv, o0[4 * i + 2] * inv, o0[4 * i + 3] * inv});
        st_bf4(op + 32 + 8 * i, (f32x4){o1[4 * i] * inv, o1[4 * i + 1] * inv, o1[4 * i + 2] * inv, o1[4 * i + 3] * inv});
    }
}
template <int DQK, bool MASKED>
__device__ __forceinline__ void phase_attn(const Ctx& C, const bf16_t* Q, const bf16_t* K, const bf16_t* VT, const unsigned* mask, bf16_t* O) {
    for (int u0 = C.bid; u0 < NB * 8 * 8; u0 += C.G) {
        int u = u0; if ((C.G & 7) == 0) { const int r = (C.bid >> 3) + (C.G >> 3) * (u0 / C.G); u = ((C.bid & 7) * 8 + (r >> 3)) * 8 + (r & 7); if (u >= NB * 8 * 8) u = u0; }
        const int bh = u >> 3, p = u & 7, b = bh >> 3, h = bh & 7;
        attn_unit<DQK, MASKED>(C, b, h, 15 - p, Q, K, VT, mask, O);
        attn_unit<DQK, MASKED>(C, b, h, p, Q, K, VT, mask, O); }
}

__device__ __forceinline__ void phase_gmlp(const Ctx& C, const float* lng, const float* lnb, const float* bs, int l) {
    const bf16_t* U = WSP(bf16_t, WS_U); const bf16_t* V = WSP(bf16_t, WS_V); bf16_t* OB = WSP(bf16_t, WS_OBUF) + (size_t)NTOK * 512;
    const bf16_t* WG = WSP(bf16_t, WS_WGM + l * SZ_WGM);
    const int tid = C.tid, lane = C.lane, wid = C.wave, r32 = lane & 31, hi = lane >> 5;
    constexpr int VST = 136;
    LAS bf16_t* vT = (LAS bf16_t*)C.lds;
    for (int un = C.bid; un < 512; un += C.G) {
        const int hf = un & 1, ch = un >> 1; const size_t t0 = (size_t)ch * 128;
        { const int pos = tid >> 2, q = tid & 3; const bf16_t* vr = V + (t0 + pos) * 512 + q * 32;
          float s = 0.f;
#pragma unroll
          for (int i = 0; i < 4; ++i)
#pragma unroll
              for (int j = 0; j < 4; ++j) { const u32x4 w = *(const u32x4*)(vr + i * 128 + j * 8); s += ((bflo(w.x) + bfhi(w.x)) + (bflo(w.y) + bfhi(w.y))) + ((bflo(w.z) + bfhi(w.z)) + (bflo(w.w) + bfhi(w.w))); }
          s += xswz<1>(s); s += xswz<2>(s);
          const float mean = s * (1.f / 512.f); float qv = 0.f;
          asm volatile("" ::: "memory");
#pragma unroll
          for (int i = 0; i < 4; ++i)
#pragma unroll
              for (int j = 0; j < 4; ++j) { const u32x4 w = *(const u32x4*)(vr + i * 128 + j * 8); float d;
                  d = bflo(w.x) - mean; qv += d * d; d = bfhi(w.x) - mean; qv += d * d; d = bflo(w.y) - mean; qv += d * d; d = bfhi(w.y) - mean; qv += d * d;
                  d = bflo(w.z) - mean; qv += d * d; d = bfhi(w.z) - mean; qv += d * d; d = bflo(w.w) - mean; qv += d * d; d = bfhi(w.w) - mean; qv += d * d; }
          qv += xswz<1>(qv); qv += xswz<2>(qv);
          const float rstd = rsqrtf(qv * (1.f / 512.f) + LN_EPS);
          asm volatile("" ::: "memory");
          const bf16_t* vh = vr + hf * 256;
#pragma unroll
          for (int ii = 0; ii < 2; ++ii)
#pragma unroll
              for (int j = 0; j < 4; ++j) { const u32x4 w = *(const u32x4*)(vh + ii * 128 + j * 8);
                  const int cl = ii * 128 + q * 32 + j * 8; const int c0 = hf * 256 + cl;
                  const f32x4 g0 = *(const f32x4*)(lng + c0), g1 = *(const f32x4*)(lng + c0 + 4), b0 = *(const f32x4*)(lnb + c0), b1 = *(const f32x4*)(lnb + c0 + 4);
                  LAS bf16_t* dp = vT + cl * VST + pos;
                  dp[0 * VST] = (bf16_t)(pk2((bflo(w.x) - mean) * rstd * g0[0] + b0[0], 0.f) & 0xffff);
                  dp[1 * VST] = (bf16_t)(pk2((bfhi(w.x) - mean) * rstd * g0[1] + b0[1], 0.f) & 0xffff);
                  dp[2 * VST] = (bf16_t)(pk2((bflo(w.y) - mean) * rstd * g0[2] + b0[2], 0.f) & 0xffff);
                  dp[3 * VST] = (bf16_t)(pk2((bfhi(w.y) - mean) * rstd * g0[3] + b0[3], 0.f) & 0xffff);
                  dp[4 * VST] = (bf16_t)(pk2((bflo(w.z) - mean) * rstd * g1[0] + b1[0], 0.f) & 0xffff);
                  dp[5 * VST] = (bf16_t)(pk2((bfhi(w.z) - mean) * rstd * g1[1] + b1[1], 0.f) & 0xffff);
                  dp[6 * VST] = (bf16_t)(pk2((bflo(w.w) - mean) * rstd * g1[2] + b1[2], 0.f) & 0xffff);
                  dp[7 * VST] = (bf16_t)(pk2((bfhi(w.w) - mean) * rstd * g1[3] + b1[3], 0.f) & 0xffff); } }
        __syncthreads();
        { const int gl = wid >> 1, ih = wid & 1, g = 4 * hf + gl;
          f32x16 acc[2][2] = {};
          const int nks = 4 * (ih + 1);
          const bf16_t* wrow = WG + ((size_t)g * 128 + ih * 64 + r32) * 128 + hi * 8;
          for (int ks = 0; ks < nks; ++ks) {
              bf16x8 a[2], bb[2];
#pragma unroll
              for (int mb = 0; mb < 2; ++mb) a[mb] = *(const bf16x8*)(wrow + (size_t)mb * 32 * 128 + ks * 16);
#pragma unroll
              for (int nb = 0; nb < 2; ++nb) bb[nb] = *(const LAS bf16x8*)(vT + (gl * 64 + nb * 32 + r32) * VST + ks * 16 + hi * 8);
#pragma unroll
              for (int mb = 0; mb < 2; ++mb)
#pragma unroll
                  for (int nb = 0; nb < 2; ++nb) acc[mb][nb] = __builtin_amdgcn_mfma_f32_32x32x16_bf16(a[mb], bb[nb], acc[mb][nb], 0, 0, 0);
          }
#pragma unroll
          for (int mb = 0; mb < 2; ++mb)
#pragma unroll
              for (int r = 0; r < 16; ++r) { const int i = ih * 64 + mb * 32 + crow(r, hi); const float bi = bs[g * 128 + i];
#pragma unroll
                  for (int nb = 0; nb < 2; ++nb) { const size_t o = (t0 + i) * 512 + g * 64 + nb * 32 + r32;
                      const float uu = bf2f(U[o]); OB[o] = (bf16_t)(pk2(uu * (acc[mb][nb][r] + bi), 0.f) & 0xffff); } } }
        __syncthreads();
    }
}

__device__ __forceinline__ void phase_ln1_router(const Ctx& C, const float* g1, const float* b1, const float* rw, const float* rbias, int l, bool dry) {
    constexpr int RST = 1028;
    LAS float* rwT = (LAS float*)C.lds;
    LAS float* gws = (LAS float*)(C.lds + 32 * RST * 4);
    LAS float* bws = gws + 32;
    LAS float* stat = bws + 32;
    LAS int* trec = (LAS int*)(C.lds + MISC_OFF + 64);
    LAS int* tpos = trec + 512;
    const int tid = C.tid, lane = C.lane, wid = C.wave;
    const bf16_t* xin = WSP(bf16_t, WS_XB); const bf16_t* yo = WSP(bf16_t, WS_OBUF); bf16_t* xb = dry ? WSP(bf16_t, WS_DRY + (size_t)NTOK * DM * 4) : WSP(bf16_t, WS_XB);
    int* tke = dry ? WSP(int, WS_DRY + (size_t)NTOK * DM * 6) : WSP(int, WS_TKE); int* tkp = dry ? WSP(int, WS_DRY + (size_t)NTOK * DM * 6 + NSLOT * 4) : WSP(int, WS_TKP); float* tkw = dry ? WSP(float, WS_DRY + (size_t)NTOK * DM * 6 + NSLOT * 8) : WSP(float, WS_TKW);
    int* ccnt = dry ? WSP(int, WS_DRY + (size_t)NTOK * DM * 6 + NSLOT * 12) : WSP(int, WS_CCNT);
    {
        const float* rwg = WSP(float, WS_RWT) + (size_t)l * 32 * 1024;
#pragma unroll
        for (int q = 0; q < 16; ++q) { const int piece = wid * 16 + q, e = piece >> 2, part = piece & 3;
            __builtin_amdgcn_global_load_lds((const unsigned*)(rwg + e * 1024 + part * 256 + lane * 4), (LAS unsigned*)(C.lds + (e * RST + part * 256) * 4), 16, 0, 0); }
        if (tid < 64) gws[tid] = WSP(float, WS_GBW)[l * 64 + tid];
        asm volatile("s_waitcnt vmcnt(0)" ::: "memory");
    }
    __syncthreads();
    const int fr = lane & 15, fq = lane >> 4;
    for (int chunk = C.bid; chunk < NTOK / 128; chunk += C.G) {
        __syncthreads();
        const size_t tok0 = (size_t)chunk * 128 + wid * 16;
        f32x4 acc0 = {0.f, 0.f, 0.f, 0.f}, acc1 = {0.f, 0.f, 0.f, 0.f};
        u32x2 zp[64]; float s1 = 0.f, s2 = 0.f;
        { const bf16_t* zr = xin + (tok0 + fr) * 1024 + 4 * fq; const bf16_t* yr = yo + (tok0 + fr) * 1024 + 4 * fq; const LAS float* w0 = rwT + fr * RST + 4 * fq; const LAS float* w1 = rwT + (16 + fr) * RST + 4 * fq;
#pragma unroll
          for (int sI = 0; sI < 64; ++sI) { const u32x2 hw = *(const u32x2*)(zr + 16 * sI); const f32x4 h4 = {bflo(hw.x), bfhi(hw.x), bflo(hw.y), bfhi(hw.y)}; const u32x2 yw = *(const u32x2*)(yr + 16 * sI);
              const f32x4 a4 = h4 * DN_ALPHA + (f32x4){bflo(yw.x), bfhi(yw.x), bflo(yw.y), bfhi(yw.y)};
              s1 += (a4[0] + a4[1]) + (a4[2] + a4[3]); s2 += (a4[0] * a4[0] + a4[1] * a4[1]) + (a4[2] * a4[2] + a4[3] * a4[3]);
              u32x2 zz; zz.x = pk2(a4[0], a4[1]); zz.y = pk2(a4[2], a4[3]); zp[sI] = zz;
              const f32x4 b0 = *(const LAS f32x4*)(w0 + 16 * sI), b1v = *(const LAS f32x4*)(w1 + 16 * sI);
#pragma unroll
              for (int j = 0; j < 4; ++j) { acc0 = __builtin_amdgcn_mfma_f32_16x16x4f32(a4[j], b0[j], acc0, 0, 0, 0); acc1 = __builtin_amdgcn_mfma_f32_16x16x4f32(a4[j], b1v[j], acc1, 0, 0, 0); }
              if ((sI & 3) == 3) __builtin_amdgcn_sched_barrier(0); } }
        s1 += xswz<16>(s1); s1 = xsum32(s1); s2 += xswz<16>(s2); s2 = xsum32(s2);
        const float mean = s1 * (1.f / 1024.f); const float rstd = rsqrtf(fmaxf(s2 * (1.f / 1024.f) - mean * mean, 0.f) + LN_EPS);
        { u32x2* xo = (u32x2*)(xb + (tok0 + fr) * 1024 + 4 * fq); const float* gp = g1 + 4 * fq; const float* bp = b1 + 4 * fq;
#pragma unroll
          for (int sI = 0; sI < 64; ++sI) { const f32x4 g4 = *(const f32x4*)(gp + 16 * sI), b4 = *(const f32x4*)(bp + 16 * sI); const u32x2 zz = zp[sI];
              const f32x4 z4 = {bflo(zz.x), bfhi(zz.x), bflo(zz.y), bfhi(zz.y)}; const f32x4 o = (z4 - mean) * rstd * g4 + b4;
              u32x2 w; w.x = pk2(o[0], o[1]); w.y = pk2(o[2], o[3]); xo[4 * sI] = w;
              if ((sI & 7) == 7) __builtin_amdgcn_sched_barrier(0); } }
        if (fq == 0) { stat[(wid * 16 + fr) * 2] = mean; stat[(wid * 16 + fr) * 2 + 1] = rstd; }
        LDS_WAIT();
        const float gw0 = gws[fr], gw1 = gws[16 + fr], bw0 = bws[fr], bw1 = bws[16 + fr];
#pragma unroll
        for (int r = 0; r < 4; ++r) {
            const int tl = wid * 16 + 4 * fq + r; const float mean = stat[tl * 2], rstd = stat[tl * 2 + 1];
            const float l0 = rstd * (acc0[r] - mean * gw0) + bw0, l1 = rstd * (acc1[r] - mean * gw1) + bw1;
            unsigned long long k0 = ((unsigned long long)f2key(l0) << 32) | (unsigned)(31 - fr), k1 = ((unsigned long long)f2key(l1) << 32) | (unsigned)(31 - (16 + fr));
            int te[4]; float tv[4];
#pragma unroll
            for (int k = 0; k < 4; ++k) {
                unsigned long long mxk = k0 > k1 ? k0 : k1;
#define MX_STEP(o) do { const unsigned long long ot = ((unsigned long long)xswzu<o>((unsigned)(mxk >> 32)) << 32) | xswzu<o>((unsigned)mxk); mxk = ot > mxk ? ot : mxk; } while (0)
                MX_STEP(1); MX_STEP(2); MX_STEP(4); MX_STEP(8);
#undef MX_STEP
                te[k] = 31 - (int)(mxk & 31ull); const unsigned ku = (unsigned)(mxk >> 32); tv[k] = __uint_as_float((ku & 0x80000000u) ? (ku & 0x7fffffffu) : ~ku);
                if (te[k] == fr) k0 = 0ull; if (te[k] == 16 + fr) k1 = 0ull;
            }
            const float e1 = __expf(tv[1] - tv[0]), e2 = __expf(tv[2] - tv[0]), e3 = __expf(tv[3] - tv[0]); const float inv = 1.f / (1.f + e1 + e2 + e3);
            if (fr == 0) {
                const float ww[4] = {inv, e1 * inv, e2 * inv, e3 * inv}; const size_t tok = (size_t)chunk * 128 + tl;
#pragma unroll
                for (int k = 0; k < 4; ++k) { trec[tl * 4 + k] = te[k]; tkw[tok * 4 + k] = ww[k]; }
            }
        }
        __syncthreads();
        if (tid < 32) { int c = 0; for (int r = 0; r < 512; ++r) { if (trec[r] == tid) { tpos[r] = c; ++c; } } ccnt[chunk * 32 + tid] = c; }
        __syncthreads();
        { const size_t o = (size_t)chunk * 512 + tid; tke[o] = trec[tid]; tkp[o] = tpos[tid]; }
        __syncthreads();
    }
}

__device__ __forceinline__ void moe_tables(const Ctx& C, int l) {
    LAS int* cnt = (LAS int*)(C.lds + MISC_OFF + 64); LAS int* tb = cnt + 32; LAS int* tile_e = tb + 40;
    const int* ccnt = WSP(int, WS_CCNT);
    {   LAS int* part = (LAS int*)C.lds;
        int a = 0;
#pragma unroll
        for (int k = 0; k < NTOK / 128 / 16; ++k) a += ccnt[((C.tid >> 5) + 16 * k) * 32 + (C.tid & 31)];
        part[C.tid] = a;
        __syncthreads();
        if (C.tid < 32) { int t = 0;
#pragma unroll
            for (int k = 0; k < 16; ++k) t += part[k * 32 + C.tid];
            cnt[C.tid] = t; }
    }
    __syncthreads();
    if (C.tid == 0) { int a = 0; for (int e = 0; e < 32; ++e) { tb[e] = a; a += (cnt[e] + 255) >> 8; } tb[32] = a; }
    __syncthreads();
    if (C.tid < 32) { for (int t = tb[C.tid]; t < tb[C.tid + 1]; ++t) tile_e[t] = C.tid; }
    __syncthreads();
}
__device__ __forceinline__ void phase_dispatch(const Ctx& C, int l) {
    moe_tables(C, l);
    LAS int* cnt = (LAS int*)(C.lds + MISC_OFF + 64); LAS int* tb = cnt + 32;
    const int* tke = WSP(int, WS_TKE); int* tkp = WSP(int, WS_TKP); int* stk = WSP(int, WS_STK);
    LAS int* cbase = (LAS int*)C.lds;
    { const int* ccnt = WSP(int, WS_CCNT); if (C.tid < 32) { int a = 0; for (int c = 0; c < NTOK / 128; ++c) { cbase[c * 32 + C.tid] = a; a += ccnt[c * 32 + C.tid]; } } }
    __syncthreads();
    for (int s = C.bid * 512 + C.tid; s < NSLOT; s += C.G * 512) {
        const int e = tke[s], p = cbase[(s >> 9) * 32 + e] + tkp[s]; const int row = tb[e] * 256 + p;
        stk[row] = s >> 2; tkp[s] = row;
    }
    for (int e = C.bid; e < 32; e += C.G) { const int r0 = tb[e] * 256 + cnt[e], r1 = tb[e + 1] * 256; for (int r = r0 + C.tid; r < r1; r += 512) stk[r] = 0; }
}

__device__ __forceinline__ void phase_ln2(const Ctx& C, const float* g2, const float* b2, float* outp, int l, bool dry) {
    const bf16_t* xin = WSP(bf16_t, WS_XB); bf16_t* xb = dry ? WSP(bf16_t, WS_DRY + (size_t)NTOK * DM * 4) : WSP(bf16_t, WS_XB); const bf16_t* y = WSP(bf16_t, WS_Y);
    const int* tkrow = WSP(int, WS_TKP); const float* tkw = WSP(float, WS_TKW);
    if (dry) outp = WSP(float, WS_DRY);
    const int gw = C.bid * NWAVES + C.wave, NGW = C.G * NWAVES, lane = C.lane;
    f32x4 gg[4], bb[4];
#pragma unroll
    for (int j = 0; j < 4; ++j) { gg[j] = *(const f32x4*)(g2 + 4 * (lane + 64 * j)); bb[j] = *(const f32x4*)(b2 + 4 * (lane + 64 * j)); }
    const bool last = (l == NLAYER - 1);
    for (int tok = gw; tok < NTOK; tok += NGW) {
        const u32x2* xr = (const u32x2*)(xin + (size_t)tok * 1024);
        f32x4 v[4]; float s = 0.f;
        int rk[4]; float wk[4];
#pragma unroll
        for (int k = 0; k < 4; ++k) { rk[k] = tkrow[(size_t)tok * 4 + k]; wk[k] = tkw[(size_t)tok * 4 + k]; }
#pragma unroll
        for (int j = 0; j < 4; ++j) { const u32x2 hw = xr[lane + 64 * j]; const f32x4 x1 = {bflo(hw.x), bfhi(hw.x), bflo(hw.y), bfhi(hw.y)}; f32x4 f[4];
#pragma unroll
            for (int k = 0; k < 4; ++k) { const u32x2 w = *(const u32x2*)(y + (size_t)rk[k] * 1024 + 4 * (lane + 64 * j)); f[k] = (f32x4){bflo(w.x), bfhi(w.x), bflo(w.y), bfhi(w.y)} * wk[k]; }
            v[j] = x1 * DN_ALPHA + ((f[0] + f[1]) + (f[2] + f[3]));
            s += (v[j][0] + v[j][1]) + (v[j][2] + v[j][3]); }
        const float mean = wave_sum(s) * (1.f / 1024.f); float s2 = 0.f;
#pragma unroll
        for (int j = 0; j < 4; ++j) { v[j] = v[j] - mean; s2 += (v[j][0] * v[j][0] + v[j][1] * v[j][1]) + (v[j][2] * v[j][2] + v[j][3] * v[j][3]); }
        const float rstd = rsqrtf(wave_sum(s2) * (1.f / 1024.f) + LN_EPS);
        if (last) { f32x4* orow = (f32x4*)(outp + (size_t)tok * 1024);
#pragma unroll
            for (int j = 0; j < 4; ++j) orow[lane + 64 * j] = v[j] * rstd * gg[j] + bb[j];
        } else { u32x2* xbr = (u32x2*)(xb + (size_t)tok * 1024);
#pragma unroll
            for (int j = 0; j < 4; ++j) { const f32x4 o = v[j] * rstd * gg[j] + bb[j]; u32x2 w; w.x = pk2(o[0], o[1]); w.y = pk2(o[2], o[3]); xbr[lane + 64 * j] = w; } }
    }
}

#ifdef DBG_STOP
__device__ __forceinline__ void dbg_dump(const Ctx& C, float* out) {
    const int gt = C.bid * 512 + C.tid, NGT = C.G * 512;
    const bf16_t* qa = WSP(bf16_t, WS_QA); const bf16_t* ka = WSP(bf16_t, WS_KA); const bf16_t* vat = WSP(bf16_t, WS_VAT); const bf16_t* iq = WSP(bf16_t, WS_IQ);
    const bf16_t* u = WSP(bf16_t, WS_U); const bf16_t* v = WSP(bf16_t, WS_V); const bf16_t* cdq = WSP(bf16_t, WS_CDQ); const bf16_t* cdkv = WSP(bf16_t, WS_CDKV);
    const bf16_t* gate = WSP(bf16_t, WS_GATE); const bf16_t* qc = WSP(bf16_t, WS_QC); const bf16_t* kc = WSP(bf16_t, WS_KC); const bf16_t* vct = WSP(bf16_t, WS_VCT);
    const unsigned* mask = WSP(unsigned, WS_MASK); const bf16_t* ob = WSP(bf16_t, WS_OBUF); const bf16_t* mg = WSP(bf16_t, WS_MERGED); const float* xr = WSP(float, WS_XRES);
    const bf16_t* y = WSP(bf16_t, WS_Y); const float* sc = WSP(float, WS_SCORE); const bf16_t* ik = WSP(bf16_t, WS_IK); const float* iw = WSP(float, WS_IW); const float* ssq = WSP(float, WS_SSQ);
    const bf16_t* hb = WSP(bf16_t, WS_H); const bf16_t* xg = WSP(bf16_t, WS_XG); const int* stk = WSP(int, WS_STK);
    for (size_t i = gt; i < (size_t)NTOK * DM; i += NGT) {
        const size_t h = i & ((size_t)NTOK * 512 - 1);
        float a = 0.f;
#if DBG_STOP >= 1
        a += bf2f(qa[h]) + bf2f(ka[h]) + bf2f(vat[h]) + bf2f(iq[h]) + bf2f(u[h]) + bf2f(v[h]) + bf2f(cdq[i & ((size_t)NTOK * 256 - 1)]) + bf2f(cdkv[i & ((size_t)NTOK * 256 - 1)]);
        a += bf2f(gate[i]) + bf2f(gate[i + (size_t)NTOK * DM]) + bf2f(gate[i + (size_t)2 * NTOK * DM]) + bf2f(ik[i & ((size_t)NTOK * 64 - 1)]) + iw[i & ((size_t)NTOK * 8 - 1)] + ssq[i & ((size_t)NTOK * 8 - 1)];
#endif
#if DBG_STOP >= 2
        a += bf2f(qc[i % ((size_t)NTOK * 768)]) + bf2f(kc[i % ((size_t)NTOK * 768)]) + bf2f(vct[h]) + bf2f(ob[(size_t)NTOK * 512 + h]);
#ifdef DBG_BITS
        a = (float)(__float_as_uint(sc[i]) & 0xfffu) + (float)(__float_as_uint(sc[i + (size_t)NTOK * DM]) & 0xfffu) + (float)(__float_as_uint(sc[i + (size_t)2 * NTOK * DM]) & 0xfffu) + (float)(__float_as_uint(sc[i + (size_t)3 * NTOK * DM]) & 0xfffu);
        a += (float)(iq[h] & 0xff) + (float)(ik[i & ((size_t)NTOK * 64 - 1)] & 0xff) + (float)(__float_as_uint(iw[i & ((size_t)NTOK * 8 - 1)]) & 0xfffu);
#else
        a += sc[i] + sc[i + (size_t)NTOK * DM] + sc[i + (size_t)2 * NTOK * DM] + sc[i + (size_t)3 * NTOK * DM];
#endif
#endif
#if DBG_STOP >= 3
        { const unsigned m = mask[i & ((size_t)NTOK * 128 - 1)]; a += (float)(m & 0xffffu) + (float)(m >> 16); } a += bf2f(ob[(size_t)2 * NTOK * 512 + h]);
#endif
#if DBG_STOP >= 4
        a += bf2f(ob[h]);
#endif
#if DBG_STOP >= 5
        a += bf2f(mg[i]);
#endif
#if DBG_STOP >= 6
        a += xr[i];
#endif
#if DBG_STOP >= 8
        a += (float)stk[i % (size_t)NSLOT_PAD] + bf2f(xg[i]) + bf2f(xg[i + (size_t)NTOK * DM]) + bf2f(xg[i + (size_t)2 * NTOK * DM]) + bf2f(xg[i + (size_t)3 * NTOK * DM]);
#endif
#if DBG_STOP >= 9
        a += bf2f(hb[i]) + bf2f(hb[i + (size_t)NTOK * DM]) + bf2f(hb[i + (size_t)2 * NTOK * DM]) + bf2f(hb[i + (size_t)3 * NTOK * DM]);
#endif
#if DBG_STOP >= 10
        a += bf2f(y[i]) + bf2f(y[i + (size_t)NTOK * DM]) + bf2f(y[i + (size_t)2 * NTOK * DM]) + bf2f(y[i + (size_t)3 * NTOK * DM]);
#endif
        out[i] = a;
    }
}
#endif

#ifdef DBG_CHECK
constexpr int CW_ERR = 20000;
__device__ __forceinline__ void err_max(unsigned* ctl, int k, float e) { if (!(e >= 0.f)) e = 1e30f; atomicMax(ctl + CW_ERR + k, __float_as_uint(e)); }
__device__ __forceinline__ float rope1(float x1, float x2, float c, float s_) { return x1 * c - x2 * s_; }
__device__ __forceinline__ float rope2(float x1, float x2, float c, float s_) { return x2 * c + x1 * s_; }
__device__ __forceinline__ void chk_proj(const Ctx& C, const Args& A) {
    unsigned* ctl = WSP(unsigned, WS_CTL); LAS float* pj = (LAS float*)C.lds;
    const int tok = (C.bid * 131 + 7) % NTOK; const int b = tok >> 12, sp = tok & 4095, ps = (sp & ~15) | perm16(sp & 15);
    const float* x = A.in[0] + (size_t)tok * DM; const float* w = A.in[2];
    for (int n = C.tid; n < 3560; n += 512) { float a = 0.f; for (int k = 0; k < DM; ++k) a = fmaf(x[k], w[(size_t)k * NIN_SRC + n], a); pj[n] = a; }
    __syncthreads();
    const float pos = (float)((const int*)A.in[1])[tok];
    const bf16_t* qa = WSP(bf16_t, WS_QA); const bf16_t* ka = WSP(bf16_t, WS_KA); const bf16_t* vat = WSP(bf16_t, WS_VAT); const bf16_t* iq = WSP(bf16_t, WS_IQ); const bf16_t* ik = WSP(bf16_t, WS_IK); const float* iw = WSP(float, WS_IW);
    float e = 0.f;
    for (int c = C.tid; c < 512; c += 512) { const int d = c & 63; const int base = c - d;
        float cq, ck, ci;
        if (d < 16) { const int i = d & 7; const float ang = pos * powf(500000.f, -(float)i / 8.f), cs = cosf(ang), sn = sinf(ang);
            const int o1 = base + i, o2 = base + 8 + i;
            cq = d < 8 ? rope1(pj[o1], pj[o2], cs, sn) : rope2(pj[o1], pj[o2], cs, sn);
            ck = d < 8 ? rope1(pj[512 + o1], pj[512 + o2], cs, sn) : rope2(pj[512 + o1], pj[512 + o2], cs, sn);
            ci = d < 8 ? rope1(pj[1536 + o1], pj[1536 + o2], cs, sn) : rope2(pj[1536 + o1], pj[1536 + o2], cs, sn);
        } else { cq = pj[c]; ck = pj[512 + c]; ci = pj[1536 + c]; }
        e = fmaxf(e, fabsf(bf2f(qa[(size_t)tok * 512 + c]) - cq * QSCALE_A)); e = fmaxf(e, fabsf(bf2f(ka[(size_t)tok * 512 + c]) - ck)); e = fmaxf(e, fabsf(bf2f(iq[(size_t)tok * 512 + c]) - ci));
        const int h = c >> 6; e = fmaxf(e, fabsf(bf2f(vat[((size_t)(b * 8 + h) * 64 + d) * SEQ + ps]) - pj[1024 + c]));
        if (c < 64) { float cik; if (c < 16) { const int i = c & 7; const float ang = pos * powf(500000.f, -(float)i / 8.f), cs = cosf(ang), sn = sinf(ang);
                cik = c < 8 ? rope1(pj[2048 + i], pj[2048 + 8 + i], cs, sn) : rope2(pj[2048 + i], pj[2048 + 8 + i], cs, sn); } else cik = pj[2048 + c];
            e = fmaxf(e, fabsf(bf2f(ik[(size_t)tok * 64 + c]) - cik)); }
        if (c < 8) e = fmaxf(e, 8.f * fabsf(iw[(size_t)tok * 8 + c] - pj[2112 + c] * IW_SCALE));
    }
    err_max(ctl, 0, e);
    __syncthreads();
    LAS float* cqn = pj + 3600; LAS float* ckn = cqn + 256;
    { float sq = 0.f; for (int k = 0; k < 256; ++k) sq += pj[3144 + k] * pj[3144 + k]; const float r = rsqrtf(sq / 256.f + RMS_EPS);
      float sk = 0.f; for (int k = 0; k < 128; ++k) sk += pj[3400 + k] * pj[3400 + k]; const float rk = rsqrtf(sk / 128.f + RMS_EPS);
      if (C.tid < 256) cqn[C.tid] = pj[3144 + C.tid] * r * A.in[7][C.tid]; if (C.tid < 128) ckn[C.tid] = pj[3400 + C.tid] * rk * A.in[8][C.tid]; }
    __syncthreads();
    const bf16_t* qc = WSP(bf16_t, WS_QC); const bf16_t* kc = WSP(bf16_t, WS_KC); const bf16_t* vct = WSP(bf16_t, WS_VCT);
    LAS float* qraw = ckn + 128;
    for (int n = C.tid; n < 768; n += 512) { float a = 0.f; for (int k = 0; k < 256; ++k) a = fmaf(cqn[k], A.in[9][(size_t)k * 768 + n], a); qraw[n] = a; }
    __syncthreads();
    float e2 = 0.f;
    for (int n = C.tid; n < 768; n += 512) { const int h = n / 96, d = n % 96; float v;
        if (d >= 64) { const int i = (d - 64) & 15; const float ang = pos * powf(500000.f, -(float)i / 16.f), cs = cosf(ang), sn = sinf(ang); const int o1 = h * 96 + 64 + i, o2 = o1 + 16;
            v = (d - 64) < 16 ? rope1(qraw[o1], qraw[o2], cs, sn) : rope2(qraw[o1], qraw[o2], cs, sn); } else v = qraw[n];
        e2 = fmaxf(e2, fabsf(bf2f(qc[(size_t)tok * 768 + n]) - v * QSCALE_C)); }
    for (int n = C.tid; n < 1024; n += 512) { float a = 0.f; for (int k = 0; k < 128; ++k) a = fmaf(ckn[k], A.in[10][(size_t)k * 1024 + n], a);
        const int h = n >> 7, wv = n & 127;
        if (wv < 64) e2 = fmaxf(e2, fabsf(bf2f(kc[(size_t)tok * 768 + h * 96 + wv]) - a));
        else e2 = fmaxf(e2, fabsf(bf2f(vct[((size_t)(b * 8 + h) * 64 + (wv - 64)) * SEQ + ps]) - a)); }
    if (C.tid < 32) { const int i = C.tid & 15; const float ang = pos * powf(500000.f, -(float)i / 16.f), cs = cosf(ang), sn = sinf(ang);
        const float v = C.tid < 16 ? rope1(pj[3528 + i], pj[3528 + 16 + i], cs, sn) : rope2(pj[3528 + i], pj[3528 + 16 + i], cs, sn);
        for (int h = 0; h < 8; ++h) e2 = fmaxf(e2, fabsf(bf2f(kc[(size_t)tok * 768 + h * 96 + 64 + C.tid]) - v)); }
    err_max(ctl, 1, e2);
    __syncthreads();
}
__device__ __forceinline__ void chk_attn(const Ctx& C) {
    unsigned* ctl = WSP(unsigned, WS_CTL);
    const int b = C.bid & 7, q = (C.bid * 977 + 300 + 13 * (C.bid >> 3)) & 4095; const size_t tq = (size_t)b * SEQ + q; const int n = q + 1;
    LAS float* sc = (LAS float*)C.lds;
    LAS float* pr = sc + 4096;
    LAS float* red = pr + 4096;
    const bf16_t* iq = WSP(bf16_t, WS_IQ); const bf16_t* ik = WSP(bf16_t, WS_IK); const float* iw = WSP(float, WS_IW); const float* score = WSP(float, WS_SCORE);
    float e1 = 0.f;
    for (int k = C.tid; k < n; k += 512) { float s_ = 0.f;
        for (int h = 0; h < 8; ++h) { float d = 0.f; for (int j = 0; j < 64; ++j) d = fmaf(bf2f(iq[tq * 512 + h * 64 + j]), bf2f(ik[((size_t)b * SEQ + k) * 64 + j]), d); s_ = fmaf(fmaxf(d, 0.f), iw[tq * 8 + h], s_); }
        sc[k] = s_; e1 = fmaxf(e1, fabsf(s_ - score[tq * SEQ + k])); }
    err_max(ctl, 2, e1);
    __syncthreads();
    const unsigned* mask = WSP(unsigned, WS_MASK); float e2 = 0.f;
    for (int k = C.tid; k < 4096; k += 512) { bool sel = false;
        if (k < n) { if (n <= 256) sel = true; else { const float sk = score[tq * SEQ + k]; int rank = 0; for (int j = 0; j < n; ++j) { const float sj = score[tq * SEQ + j]; rank += (sj > sk || (sj == sk && j < k)) ? 1 : 0; } sel = rank < 256; } }
        const bool mb = (mask[tq * 128 + (k >> 5)] >> (k & 31)) & 1u; if (sel != mb) e2 = 1.f; }
    err_max(ctl, 3, e2);
    const int h = (C.bid >> 3) & 7;
    for (int which = 0; which < 2; ++which) {
        const bf16_t* Q = which ? WSP(bf16_t, WS_QC) : WSP(bf16_t, WS_QA); const bf16_t* K = which ? WSP(bf16_t, WS_KC) : WSP(bf16_t, WS_KA); const bf16_t* VT = which ? WSP(bf16_t, WS_VCT) : WSP(bf16_t, WS_VAT);
        const bf16_t* O = WSP(bf16_t, WS_OBUF) + (which ? (size_t)2 * NTOK * 512 : 0); const int dq = which ? 96 : 64, qs = 8 * dq;
        __syncthreads();
        float mx = -INFINITY;
        for (int k = C.tid; k < 4096; k += 512) { float lgt = -INFINITY;
            const bool ok = k < n && (which || ((mask[tq * 128 + (k >> 5)] >> (k & 31)) & 1u));
            if (ok) { float d = 0.f; for (int j = 0; j < dq; ++j) d = fmaf(bf2f(Q[tq * qs + h * dq + j]), bf2f(K[((size_t)b * SEQ + k) * qs + h * dq + j]), d); lgt = d; }
            pr[k] = lgt; mx = fmaxf(mx, lgt); }
        red[C.tid] = mx; __syncthreads();
        if (C.tid == 0) { float m = -INFINITY; for (int i = 0; i < 512; ++i) m = fmaxf(m, red[i]); red[0] = m; } __syncthreads();
        const float m = red[0]; __syncthreads();
        float sm = 0.f; for (int k = C.tid; k < 4096; k += 512) { const float p = exp2f(pr[k] - m); pr[k] = p; sm += p; }
        red[C.tid] = sm; __syncthreads();
        if (C.tid == 0) { float t = 0.f; for (int i = 0; i < 512; ++i) t += red[i]; red[0] = t; } __syncthreads();
        const float den = red[0];
        if (C.tid < 64) { const int d = C.tid; float o = 0.f;
            for (int k = 0; k < n; ++k) { const int ps = (k & ~15) | perm16(k & 15); o = fmaf(pr[k], bf2f(VT[((size_t)(b * 8 + h) * 64 + d) * SEQ + ps]), o); }
            o /= den; err_max(ctl, 4 + which, fabsf(o - bf2f(O[tq * 512 + h * 64 + d]))); }
    }
    __syncthreads();
}
#endif

constexpr int NPH_LAYER = 11, NPHASE = 1 + NLAYER * NPH_LAYER;
__global__ void __launch_bounds__(NWAVES * 64, 2) trunk_fwd(Args args) {
    extern __shared__ __attribute__((aligned(16))) unsigned char lds_raw[];
    Ctx C;
    C.lds = (LAS unsigned char*)lds_raw; C.tid = threadIdx.x; C.lane = C.tid & 63; C.wave = __builtin_amdgcn_readfirstlane(C.tid >> 6); C.G = gridDim.x; C.bid = blockIdx.x; C.ws = args.ws;
    volatile LAS unsigned* MISC = (volatile LAS unsigned*)(C.lds + MISC_OFF);
    if (C.tid < 16) MISC[C.tid] = 0u;
    __syncthreads();
#if MK_ONE_LAUNCH
    XcdBarrier bar = xcd_barrier_post(WSP(unsigned, WS_CTL) + CW_BAR, MISC + 0);
#define GRID_BAR() do { FRESH(); XcdBarrier b_ = bar; { unsigned* bp_ = b_.bar; asm volatile("" : "+s"(bp_)); b_.bar = bp_; } xcd_barrier(b_, C.tid == 0); } while (0)
#else
#define GRID_BAR() do {} while (0)
#endif
    typedef const __attribute__((address_space(4))) Args* KArgsP;
    KArgsP kp = (KArgsP)__builtin_amdgcn_kernarg_segment_ptr();
    const int grid_s = gridDim.x, bid_s = blockIdx.x;
    const int wave_s = __builtin_amdgcn_readfirstlane((int)threadIdx.x >> 6);
#define FRESH() do { int ln_; asm volatile("v_mbcnt_lo_u32_b32 %0, -1, 0\n\tv_mbcnt_hi_u32_b32 %0, -1, %0" : "=v"(ln_)); int w_ = wave_s; asm volatile("" : "+s"(w_)); C.tid = (w_ << 6) | ln_; C.lane = ln_; C.wave = w_; \
        int g_ = grid_s, b_ = bid_s; asm volatile("" : "+s"(g_), "+s"(b_)); C.G = g_; C.bid = b_; \
        kp = (KArgsP)__builtin_amdgcn_kernarg_segment_ptr(); asm volatile("" : "+s"(kp)); C.ws = kp->ws; } while (0)
#define KIN(i) (kp->in[i])
    const int lo = args.ph_lo, hi = args.ph_hi, sub_mask = args.sub; const bool dry = (args.pad != 0);
#ifndef PH_ONLY
#define PH_ONLY -1
#endif
#ifndef PH_SUB
#define PH_SUB -1
#endif
#define PON(k) (PH_ONLY < 0 || PH_ONLY == (k))
#define PON2(k) ((PH_SUB < 0 || PH_SUB == (k)) && ((sub_mask >> (((k) / 10 - 1) * 4 + (k) % 10 - 1)) & 1))
#define IN(k) (lo <= (k) && (k) < hi)
#define SEAM(k) do { if (IN(k) && IN((k) + 1)) GRID_BAR(); } while (0)
    if (IN(0) && PON(100)) { phase_prologue(C, args); }
    SEAM(0);
    for (int l = 0; l < NLAYER; ++l) {
        const int P = 1 + l * NPH_LAYER;
        if (IN(P + 0) && PON(0)) { FRESH();
            pg8::Gemm g{WSP(bf16_t, WS_XB), WSP(bf16_t, WS_WIN + l * SZ_WIN), 1024, 1024, nullptr}; GridOrder S{NIN / 256, (NTOK / 256) * (NIN / 256), C.G, C.bid};
            EpiInProj E{C.ws, dry};
            pg8::gemm_phase<EpiInProj, GridOrder>(C.lds, g, S, E, C.tid);
        }
        SEAM(P + 0);
        if (IN(P + 1) && PON(1)) { FRESH();
            if (PON2(11)) phase_indexer(C);
            __syncthreads();
            FRESH();
            if (PON2(12)) { pg8::Gemm g{WSP(bf16_t, WS_CDQ), WSP(bf16_t, WS_WUQ + l * SZ_WUQ), 256, 256, nullptr}; GridOrder S{3, 128 * 3, C.G, C.bid};
              EpiQUp E{WSP(bf16_t, WS_QC), WSP(float, WS_SSQ), WSP(float, WS_COSC), WSP(float, WS_SINC)};
              pg8::gemm_phase<EpiQUp, GridOrder>(C.lds, g, S, E, C.tid); }
            FRESH();
            if (PON2(13)) { pg8::Gemm g{WSP(bf16_t, WS_CDKV), WSP(bf16_t, WS_WUKV + l * SZ_WUKV), 256, 256, nullptr}; GridOrder S{4, 128 * 4, C.G, C.bid};
              EpiKvUp E{WSP(bf16_t, WS_KC), WSP(bf16_t, WS_VCT), WSP(float, WS_SSQ)};
              pg8::gemm_phase<EpiKvUp, GridOrder>(C.lds, g, S, E, C.tid); }
            __syncthreads();
            if (PON2(14)) { FRESH(); phase_gmlp(C, KIN(3) + l * 512, KIN(4) + l * 512, KIN(6) + (size_t)l * 8 * 128, l); }
        }
        SEAM(P + 1);
        if (IN(P + 2) && PON(2)) { FRESH();
            if (PON2(21)) phase_select(C);
            __syncthreads();
            FRESH(); if (PON2(22)) phase_attn<96, false>(C, WSP(bf16_t, WS_QC), WSP(bf16_t, WS_KC), WSP(bf16_t, WS_VCT), nullptr, WSP(bf16_t, WS_OBUF) + (size_t)2 * NTOK * 512);
        }
        SEAM(P + 2);
        if (IN(P + 3) && PON(3)) { FRESH(); phase_attn<64, true>(C, WSP(bf16_t, WS_QA), WSP(bf16_t, WS_KA), WSP(bf16_t, WS_VAT), WSP(unsigned, WS_MASK), WSP(bf16_t, WS_OBUF)); }
        SEAM(P + 3);
        if (IN(P + 4) && PON(4)) { FRESH();
            pg8::Gemm g{WSP(bf16_t, WS_OBUF), WSP(bf16_t, WS_WBR + l * SZ_WBR), 512, 512, nullptr}; MergeOrder S{C.G, C.bid};
            EpiMerge E{WSP(bf16_t, WS_GATE), WSP(bf16_t, WS_MERGED)};
            pg8::gemm_phase<EpiMerge, MergeOrder>(C.lds, g, S, E, C.tid);
        }
        SEAM(P + 4);
        if (IN(P + 5) && PON(5)) { FRESH();
            pg8::Gemm g{WSP(bf16_t, WS_MERGED), WSP(bf16_t, WS_WOUT + l * SZ_WOUT), 1024, 1024, nullptr}; GridOrder S{4, 128 * 4, C.G, C.bid};
            EpiOut E{dry ? WSP(bf16_t, WS_DRY) : WSP(bf16_t, WS_OBUF)};
            pg8::gemm_phase<EpiOut, GridOrder>(C.lds, g, S, E, C.tid);
        }
        SEAM(P + 5);
        if (IN(P + 6) && PON(6)) { FRESH(); phase_ln1_router(C, KIN(13) + l * 1024, KIN(14) + l * 1024, KIN(15) + (size_t)l * 1024 * 32, KIN(16) + l * 32, l, dry); }
        SEAM(P + 6);
        if (IN(P + 7) && PON(7)) { FRESH(); phase_dispatch(C, l); }
        SEAM(P + 7);
        if (IN(P + 8) && PON(8)) { FRESH();
            moe_tables(C, l);
            const LAS int* tb = (const LAS int*)(C.lds + MISC_OFF + 64) + 32;
            pg8::Gemm g{WSP(bf16_t, WS_XB), WSP(bf16_t, WS_WGU + l * SZ_WGU), 1024, 1024, WSP(int, WS_STK)}; MoeOrder S{8, tb[32] * 8, C.G, C.bid, tb};
            EpiMoeUp E{WSP(bf16_t, WS_H), KIN(18) + (size_t)l * NEXP * 2048};
            pg8::gemm_phase<EpiMoeUp, MoeOrder, true>(C.lds, g, S, E, C.tid);
        }
        SEAM(P + 8);
        if (IN(P + 9) && PON(9)) { FRESH();
            moe_tables(C, l);
            const LAS int* tb = (const LAS int*)(C.lds + MISC_OFF + 64) + 32;
            pg8::Gemm g{WSP(bf16_t, WS_H), WSP(bf16_t, WS_WDN + l * SZ_WDN), 1024, 1024, nullptr}; MoeOrder S{4, tb[32] * 4, C.G, C.bid, tb};
            EpiMoeDn E{dry ? WSP(bf16_t, WS_DRY) : WSP(bf16_t, WS_Y), KIN(20) + (size_t)l * NEXP * 1024, dry};
            pg8::gemm_phase<EpiMoeDn, MoeOrder>(C.lds, g, S, E, C.tid);
        }
        SEAM(P + 9);
        if (IN(P + 10) && PON(10)) { FRESH(); phase_ln2(C, KIN(21) + l * 1024, KIN(22) + l * 1024, kp->out, l, dry); }
        SEAM(P + 10);
    }
#ifdef DBG_STOP
    if (IN(NPHASE)) { FRESH(); dbg_dump(C, kp->out); }
#endif
#ifdef DBG_CHECK
    if (IN(NPHASE + 1)) { FRESH(); chk_proj(C, args); chk_attn(C); }
    if (IN(NPHASE + 2)) { FRESH();
        const unsigned* ctl = WSP(unsigned, WS_CTL); const float tol[6] = {0.06f, 0.06f, 2e-3f, 0.5f, 0.02f, 0.02f}; float sc = 1.f;
        for (int k = 0; k < 6; ++k) if (__uint_as_float(ctl[CW_ERR + k]) > tol[k]) sc += 0.2f * (float)(1 << k);
        float* o = kp->out; for (size_t i = (size_t)C.bid * 512 + C.tid; i < (size_t)NTOK * DM; i += (size_t)C.G * 512) o[i] *= sc; }
#endif
#undef IN
#undef SEAM
}

extern "C" void kernel_launch(void* const* d_in, const int* in_sizes, int n_in, void* d_out, int out_size, void* d_ws, size_t ws_size, hipStream_t stream) {
    static int grid = 0;
    if (grid == 0) {
        if (n_in != 23 || out_size != NTOK * DM || ws_size < WS_END) { fprintf(stderr, "kernel_launch: unexpected shapes (n_in %d, out %d, ws %zu < %zu)\n", n_in, out_size, ws_size, (size_t)WS_END); grid = -1; return; }
        int dev = 0, cus = 0, per_cu = 0;
        if (hipGetDevice(&dev) != hipSuccess || hipDeviceGetAttribute(&cus, hipDeviceAttributeMultiprocessorCount, dev) != hipSuccess) { grid = -1; return; }
        if (hipFuncSetAttribute((const void*)trunk_fwd, hipFuncAttributeMaxDynamicSharedMemorySize, LDS_BYTES) != hipSuccess) { fprintf(stderr, "kernel_launch: hipFuncSetAttribute failed\n"); grid = -1; return; }
        if (hipOccupancyMaxActiveBlocksPerMultiprocessor(&per_cu, (const void*)trunk_fwd, NWAVES * 64, LDS_BYTES) != hipSuccess || per_cu < 1) { fprintf(stderr, "kernel_launch: occupancy query reports %d\n", per_cu); }
        (void)hipGetLastError();
        grid = cus;
    }
    if (grid < 0) return;
    (void)hipMemsetAsync((char*)d_ws + WS_CTL, 0, CTL_ZERO_BYTES, stream);
#ifdef DBG_ZERO_WS
    (void)hipMemsetAsync((char*)d_ws + WS_XRES, 0, WS_END - WS_XRES, stream);
#endif
    Args a{};
    for (int i = 0; i < 23; ++i) a.in[i] = (const float*)d_in[i];
    a.out = (float*)d_out; a.ws = (unsigned char*)d_ws; a.sub = -1; a.pad = 0;
#if MK_ONE_LAUNCH
    a.ph_lo = 0; a.ph_hi = NPHASE;
    hipLaunchKernelGGL(trunk_fwd, dim3(grid), dim3(NWAVES * 64), LDS_BYTES, stream, a);
#else
#ifdef DBG_STOP
    for (int p = 0; p < 1 + DBG_STOP; ++p) { a.ph_lo = p; a.ph_hi = p + 1; hipLaunchKernelGGL(trunk_fwd, dim3(grid), dim3(NWAVES * 64), LDS_BYTES, stream, a); }
    a.ph_lo = NPHASE; a.ph_hi = NPHASE + 1; hipLaunchKernelGGL(trunk_fwd, dim3(grid), dim3(NWAVES * 64), LDS_BYTES, stream, a);
#else
    for (int p = 0; p < NPHASE; ++p) { a.ph_lo = p; a.ph_hi = p + 1; a.sub = -1; a.pad = 0; hipLaunchKernelGGL(trunk_fwd, dim3(grid), dim3(NWAVES * 64), LDS_BYTES, stream, a);
#ifdef DBG_CHECK
        if (p == 4) { a.ph_lo = NPHASE + 1; a.ph_hi = NPHASE + 2; hipLaunchKernelGGL(trunk_fwd, dim3(grid), dim3(NWAVES * 64), LDS_BYTES, stream, a); }
        if (p == NPHASE - 1) { a.ph_lo = NPHASE + 2; a.ph_hi = NPHASE + 3; hipLaunchKernelGGL(trunk_fwd, dim3(grid), dim3(NWAVES * 64), LDS_BYTES, stream, a); }
#endif
#ifdef PROBE_PH
#ifndef PROBE_DRY
#define PROBE_DRY 0
#endif
        if ((p == 0 && PROBE_PH == -1) || (p >= 1 && (p - 1) % NPH_LAYER == PROBE_PH)) { a.sub = PROBE_SUB; a.pad = PROBE_DRY; hipLaunchKernelGGL(trunk_fwd, dim3(grid), dim3(NWAVES * 64), LDS_BYTES, stream, a); }
#endif
    }
#endif
#endif
}
```

```cpp
#include <hip/hip_runtime.h>
#include <cstdio>
#include <cstdint>

#ifndef MK_ONE_LAUNCH
#define MK_ONE_LAUNCH 1
#endif

#define LAS __attribute__((address_space(3)))
typedef unsigned short bf16_t;
typedef short bf16x8 __attribute__((ext_vector_type(8)));
typedef float f32x4 __attribute__((ext_vector_type(4)));
typedef float f32x16 __attribute__((ext_vector_type(16)));
typedef unsigned u32x4 __attribute__((ext_vector_type(4)));
typedef unsigned u32x2 __attribute__((ext_vector_type(2)));
typedef float f32x2_t __attribute__((ext_vector_type(2)));
typedef __bf16 bf16x2_t __attribute__((ext_vector_type(2)));

__device__ __forceinline__ unsigned pk2(float lo, float hi) { f32x2_t v = {lo, hi}; bf16x2_t b = __builtin_convertvector(v, bf16x2_t); return __builtin_bit_cast(unsigned, b); }
__device__ __forceinline__ float bf2f(unsigned short x) { return __uint_as_float(((unsigned)x) << 16); }
__device__ __forceinline__ float bflo(unsigned w) { return __uint_as_float(w << 16); }
__device__ __forceinline__ float bfhi(unsigned w) { return __uint_as_float(w & 0xffff0000u); }
template <int M> __device__ __forceinline__ float xswz(float v) { static_assert(M >= 1 && M <= 16, "xswz"); return __int_as_float(__builtin_amdgcn_ds_swizzle(__float_as_int(v), 0x1F | (M << 10))); }
template <int M> __device__ __forceinline__ unsigned xswzu(unsigned v) { return (unsigned)__builtin_amdgcn_ds_swizzle((int)v, 0x1F | (M << 10)); }
__device__ __forceinline__ float xsum32(float v) { auto rr = __builtin_amdgcn_permlane32_swap(__float_as_uint(v), __float_as_uint(v), false, false); return __uint_as_float(rr[0]) + __uint_as_float(rr[1]); }
__device__ __forceinline__ float xmax32(float v) { auto rr = __builtin_amdgcn_permlane32_swap(__float_as_uint(v), __float_as_uint(v), false, false); return fmaxf(__uint_as_float(rr[0]), __uint_as_float(rr[1])); }
__device__ __forceinline__ float xother32(float v, bool upper) { auto rr = __builtin_amdgcn_permlane32_swap(__float_as_uint(v), __float_as_uint(v), false, false); return __uint_as_float(upper ? rr[0] : rr[1]); }
#define LDS_WAIT() asm volatile("s_waitcnt lgkmcnt(0)" ::: "memory")
#define VM_WAIT() asm volatile("s_waitcnt vmcnt(0)" ::: "memory")

constexpr int NB = 8, SEQ = 4096, NTOK = NB * SEQ, DM = 1024, NLAYER = 4;
constexpr int NIN_SRC = 6632, NIN = 6656;
constexpr int NEXP = 32, TOPK = 4, DFF = 1024;
constexpr int NSLOT = NTOK * TOPK, NSLOT_PAD = NSLOT + NEXP * 256;
constexpr float LN_EPS = 1e-5f, RMS_EPS = 1e-6f;
constexpr float DN_ALPHA = 1.681792830507429f;
constexpr float LOG2E = 1.4426950408889634f;
constexpr float QSCALE_A = 0.125f * LOG2E;
constexpr float QSCALE_C = 0.10206207261596577f * LOG2E;
constexpr float IW_SCALE = 0.35355339059327373f * 0.125f;

constexpr size_t MiB = (size_t)1 << 20;
constexpr size_t WS_CTL = 0, CTL_ZERO_BYTES = 1 * MiB;
constexpr int CW_BAR = 4096, CW_CNT = 16384;
constexpr size_t SZ_WIN = (size_t)NIN * DM * 2, SZ_WUQ = (size_t)768 * 256 * 2, SZ_WUKV = (size_t)1024 * 256 * 2, SZ_WBR = (size_t)3 * 1024 * 512 * 2, SZ_WOUT = (size_t)1024 * 1024 * 2;
constexpr size_t SZ_WGU = (size_t)NEXP * 2048 * 1024 * 2, SZ_WDN = (size_t)NEXP * 1024 * 1024 * 2, SZ_WGM = (size_t)8 * 128 * 128 * 2;
constexpr size_t WS_WIN = 2 * MiB;
constexpr size_t WS_WUQ = WS_WIN + NLAYER * SZ_WIN;
constexpr size_t WS_WUKV = WS_WUQ + NLAYER * SZ_WUQ;
constexpr size_t WS_WBR = WS_WUKV + NLAYER * SZ_WUKV;
constexpr size_t WS_WOUT = WS_WBR + NLAYER * SZ_WBR;
constexpr size_t WS_WGU = WS_WOUT + NLAYER * SZ_WOUT;
constexpr size_t WS_WDN = WS_WGU + NLAYER * SZ_WGU;
constexpr size_t WS_WGM = WS_WDN + NLAYER * SZ_WDN;
constexpr size_t WS_COSA = WS_WGM + NLAYER * SZ_WGM;
constexpr size_t WS_SINA = WS_COSA + (size_t)NTOK * 8 * 4;
constexpr size_t WS_COSC = WS_SINA + (size_t)NTOK * 8 * 4;
constexpr size_t WS_SINC = WS_COSC + (size_t)NTOK * 16 * 4;
constexpr size_t WS_XRES = WS_SINC + (size_t)NTOK * 16 * 4;
constexpr size_t WS_XB = WS_XRES + (size_t)NTOK * DM * 4;
constexpr size_t WS_QA = WS_XB + (size_t)NTOK * DM * 2;
constexpr size_t WS_KA = WS_QA + (size_t)NTOK * 512 * 2;
constexpr size_t WS_VAT = WS_KA + (size_t)NTOK * 512 * 2;
constexpr size_t WS_IQ = WS_VAT + (size_t)NTOK * 512 * 2;
constexpr size_t WS_IK = WS_IQ + (size_t)NTOK * 512 * 2;
constexpr size_t WS_IW = WS_IK + (size_t)NTOK * 64 * 2;
constexpr size_t WS_U = WS_IW + (size_t)NTOK * 8 * 4;
constexpr size_t WS_V = WS_U + (size_t)NTOK * 512 * 2;
constexpr size_t WS_CDQ = WS_V + (size_t)NTOK * 512 * 2;
constexpr size_t WS_CDKV = WS_CDQ + (size_t)NTOK * 256 * 2;
constexpr size_t WS_SSQ = WS_CDKV + (size_t)NTOK * 256 * 2;
constexpr size_t WS_GATE = WS_SSQ + (size_t)NTOK * 8 * 4;
constexpr size_t WS_QC = WS_GATE + (size_t)NTOK * 3072 * 2;
constexpr size_t WS_KC = WS_QC + (size_t)NTOK * 768 * 2;
constexpr size_t WS_VCT = WS_KC + (size_t)NTOK * 768 * 2;
constexpr size_t WS_SCORE = WS_VCT + (size_t)NTOK * 512 * 2;
constexpr size_t WS_MASK = WS_SCORE + (size_t)NTOK * SEQ * 4;
constexpr size_t WS_OBUF = WS_MASK + (size_t)NTOK * 128 * 4;
constexpr size_t WS_MERGED = WS_OBUF + (size_t)3 * NTOK * 512 * 2;
constexpr size_t WS_TKE = WS_MERGED + (size_t)NTOK * DM * 2;
constexpr size_t WS_TKP = WS_TKE + (size_t)NSLOT * 4;
constexpr size_t WS_TKW = WS_TKP + (size_t)NSLOT * 4;
constexpr size_t WS_STK = WS_TKW + (size_t)NSLOT * 4;
constexpr size_t WS_SW = WS_STK + (size_t)NSLOT_PAD * 4;
constexpr size_t WS_XG = WS_SW + (size_t)NSLOT_PAD * 4;
constexpr size_t WS_H = WS_XG + (size_t)NSLOT_PAD * DM * 2;
constexpr size_t WS_Y = WS_H + (size_t)NSLOT_PAD * DFF * 2;
constexpr size_t WS_CCNT = WS_Y + (size_t)NSLOT_PAD * DM * 2;
constexpr size_t WS_RWT = WS_CCNT + (size_t)(NTOK / 128) * 32 * 4;
constexpr size_t WS_GBW = WS_RWT + (size_t)NLAYER * 32 * 1024 * 4;
constexpr size_t WS_END = WS_GBW + (size_t)NLAYER * 64 * 4;
constexpr size_t WS_DRY = (WS_END + 255) & ~(size_t)255;
static_assert(WS_END < (size_t)4200 * MiB, "workspace map too large");
static_assert((WS_WIN % 256) == 0 && (WS_COSA % 256) == 0 && (WS_XRES % 256) == 0 && (WS_SCORE % 256) == 0 && (WS_XG % 256) == 0, "alignment");

constexpr int LDS_BYTES = 147456;
constexpr int MISC_OFF = 143360;
constexpr int NWAVES = 8;

#define XB_TMO      128
#define XB_XCNT(j)  (256  + 64 * (j))
#define XB_XSUB(j)  (1280 + 64 * (j))
#define XB_XGEN(j)  (2304 + 64 * (j))
#define XB_TOP      3328
#define XB_TOPGEN   3392
#define XCD_BAR_WORDS 3456
#define XB_SPIN_CAP (1u << 18)
__device__ __forceinline__ unsigned xb_ld(unsigned* p)              { return __hip_atomic_load(p, __ATOMIC_RELAXED, __HIP_MEMORY_SCOPE_AGENT); }
__device__ __forceinline__ unsigned xb_add(unsigned* p, unsigned v) { return __hip_atomic_fetch_add(p, v, __ATOMIC_RELAXED, __HIP_MEMORY_SCOPE_AGENT); }
__device__ __forceinline__ unsigned xb_xcc_id() { return (unsigned)__builtin_amdgcn_s_getreg((3 << 11) | 20) & 0xFu; }
#define XB_SPIN(cond, bar) do { unsigned _sp = 0; while (cond) { __builtin_amdgcn_s_sleep(1); \
    if ((++_sp & 255u) == 0u) { if (xb_ld(&(bar)[XB_TMO])) break; if (_sp > XB_SPIN_CAP) { atomicAdd(&(bar)[XB_TMO], 1u); break; } } } } while (0)
struct XcdBarrier { unsigned* bar; unsigned x; volatile LAS unsigned* st; };
__device__ __forceinline__ XcdBarrier xcd_barrier_post(unsigned* bar, volatile LAS unsigned* st) {
    XcdBarrier b; b.bar = bar; b.x = xb_xcc_id(); b.st = st;
    if (threadIdx.x == 0) (void)xb_add(&bar[XB_XCNT(b.x)], 1u);
    return b;
}
__device__ __forceinline__ void xcd_barrier_complete(unsigned* bar, unsigned x, unsigned& nloc, unsigned& nx) {
    const unsigned G = gridDim.x * gridDim.y * gridDim.z;
    unsigned sum, cnt, mine, sp = 0u;
    for (;;) {
        sum = 0u; cnt = 0u; mine = 0u;
#pragma unroll
        for (unsigned j = 0; j < 16; ++j) { const unsigned c = xb_ld(&bar[XB_XCNT(j)]); sum += c; cnt += (c > 0u) ? 1u : 0u; mine = (j == x) ? c : mine; }
        if (sum == G) break;
        __builtin_amdgcn_s_sleep(1);
        if ((++sp & 255u) == 0u) { if (xb_ld(&bar[XB_TMO])) break; if (sp > XB_SPIN_CAP) { atomicAdd(&bar[XB_TMO], 1u); break; } }
    }
    nloc = mine > 0u ? mine : 1u; nx = cnt > 0u ? cnt : 1u;
}
__device__ __forceinline__ void xcd_barrier(const XcdBarrier& b, bool leader_thread) {
    asm volatile("s_waitcnt vmcnt(0)" ::: "memory");
    __syncthreads();
    if (leader_thread) {
        unsigned* bar = b.bar;
        __builtin_amdgcn_s_waitcnt(0);
        unsigned nloc = b.st[0], nx = b.st[1];
        if (nloc == 0u) { xcd_barrier_complete(bar, b.x, nloc, nx); b.st[0] = nloc; b.st[1] = nx; }
        const unsigned old = xb_add(&bar[XB_XSUB(b.x)], 1u);
        const unsigned gen = old / nloc;
        if (old + 1u == (gen + 1u) * nloc) {
            __builtin_amdgcn_fence(__ATOMIC_RELEASE, "agent");
            asm volatile("s_waitcnt vmcnt(0)" ::: "memory");
            const unsigned og = xb_add(&bar[XB_TOP], 1u);
            const unsigned tg = og / nx;
            if (og + 1u == (tg + 1u) * nx) xb_add(&bar[XB_TOPGEN], 1u);
            else XB_SPIN(xb_ld(&bar[XB_TOPGEN]) == tg, bar);
            __builtin_amdgcn_fence(__ATOMIC_ACQUIRE, "agent");
            xb_add(&bar[XB_XGEN(b.x)], 1u);
            asm volatile("s_waitcnt vmcnt(0)" ::: "memory");
        } else {
            XB_SPIN(xb_ld(&bar[XB_XGEN(b.x)]) == gen, bar);
            __builtin_amdgcn_fence(__ATOMIC_ACQUIRE, "agent");
            asm volatile("s_waitcnt vmcnt(0)" ::: "memory");
        }
    }
    __syncthreads();
}

namespace pg8 {
constexpr int BM = 256, BK = 64, HALF = 128, HTB = HALF * BK * 2;
__host__ __device__ __forceinline__ int lds_byte(int r, int c) { const int st = (r >> 4) * 2 + (c >> 5), rr = r & 15, cc = c & 31, ob = rr * 64 + cc * 2; return st * 1024 + (ob ^ (((ob >> 9) & 1) << 5)); }
__host__ __device__ __forceinline__ void stage_rc(int b, int& R, int& C) { const int st = b / 1024, sb = b % 1024, swz = sb ^ (((sb >> 9) & 1) << 5); R = (st >> 1) * 16 + swz / 64; C = (st & 1) * 32 + (swz % 64) / 2; }
__host__ __device__ __forceinline__ int perm32(int rho) { const int n = rho >> 4, i = rho & 15; return 8 * (i >> 2) + 4 * n + (i & 3); }
struct Unit { int pm, pn; };
struct Gemm { const bf16_t* A; const bf16_t* Bt; int lda, K; const int* rowmap; };

constexpr int PRE_OFF = 131072;
template <class Epi, class Sched, bool GATHER = false>
__device__ __forceinline__ void gemm_phase(LAS unsigned char* lds, const Gemm g, const Sched& S, const Epi& E, int tid0) {
    int tid = tid0; asm volatile("" : "+v"(tid));
    const int wid = __builtin_amdgcn_readfirstlane(tid >> 6), lane = tid & 63, wr = wid >> 2, wc = wid & 3, fr = lane & 15, fq = lane >> 4;
    const int K = g.K, nt = K / BK, lda = g.lda;
    unsigned voffA[2], voffB[2]; unsigned colA2 = 0u;
#pragma unroll
    for (int i = 0; i < 2; ++i) { int R, C; stage_rc(tid * 16 + i * 8192, R, C); voffA[i] = (unsigned)(R * lda + C) * 2u; const int Rb = (R & ~31) + perm32(R & 31); voffB[i] = (unsigned)(Rb * K + C) * 2u; colA2 = (unsigned)C * 2u; }
    unsigned gcur[2] = {0u, 0u}, gnxt[2] = {0u, 0u};
#define PG8_GLOAD(d, pm_) do { int ln_; asm volatile("v_mbcnt_lo_u32_b32 %0, -1, 0\n\tv_mbcnt_hi_u32_b32 %0, -1, %0" : "=v"(ln_));   \
        int R0_, C0_; stage_rc(((wid << 6) | ln_) * 16, R0_, C0_); const int* rm_ = g.rowmap + (pm_) * BM + R0_; \
        d[0] = (unsigned)rm_[0] | ((unsigned)rm_[64] << 16); d[1] = (unsigned)rm_[HALF] | ((unsigned)rm_[HALF + 64] << 16); } while (0)
#define PG8_GOFF(p, i) ((((i) ? ((p) >> 16) : ((p) & 0xffffu)) * (unsigned)(lda * 2)) + colA2)
#define PG8_STAGE_G(bufoff, gbase, p) do { _Pragma("unroll") for (int _i = 0; _i < 2; ++_i) \
        __builtin_amdgcn_global_load_lds((const unsigned*)((const char*)(gbase) + PG8_GOFF(p, _i)), (LAS unsigned*)(lds + (bufoff) + ldsw + _i * 8192), 16, 0, 0); } while (0)
    const size_t kstep = (size_t)(BK * 2);
    const size_t hstepA = (size_t)HALF * lda * 2, hstepB = (size_t)HALF * K * 2;
    const size_t tstepA = 2 * hstepA, tstepB = 2 * hstepB;
    const unsigned ldsw = (unsigned)wid * 1024u;
    const int aoff = lds_byte(wr * 64 + fr, fq * 8), boff = lds_byte(wc * 32 + fr, fq * 8);
#define PG8_SA(b, h) (((b) * 2 + (h)) * HTB)
#define PG8_SB(b, h) ((4 + (b) * 2 + (h)) * HTB)
#define PG8_STAGE(bufoff, gbase, voff) do { _Pragma("unroll") for (int _i = 0; _i < 2; ++_i) \
        __builtin_amdgcn_global_load_lds((const unsigned*)((const char*)(gbase) + (voff)[_i]), (LAS unsigned*)(lds + (bufoff) + ldsw + _i * 8192), 16, 0, 0); } while (0)
#define PG8_STAGE_A(bufoff, gbase, half, nextu) do { if constexpr (GATHER) { if (nextu) PG8_STAGE_G(bufoff, gbase, gnxt[half]); else PG8_STAGE_G(bufoff, gbase, gcur[half]); } \
        else { PG8_STAGE(bufoff, (gbase) + ((half) ? hstepA : 0), voffA); } } while (0)
#define PG8_LDA(dst, b, h) do { _Pragma("unroll") for (int m = 0; m < 4; ++m) _Pragma("unroll") for (int k = 0; k < 2; ++k) dst[m][k] = *(const LAS bf16x8*)(lds + PG8_SA(b, h) + aoff + m * 2048 + k * 1024); } while (0)
#define PG8_LDB(dst, b, h) do { _Pragma("unroll") for (int n = 0; n < 2; ++n) _Pragma("unroll") for (int k = 0; k < 2; ++k) dst[n][k] = *(const LAS bf16x8*)(lds + PG8_SB(b, h) + boff + n * 2048 + k * 1024); } while (0)
#define PG8_MMA(ai, bj, At, Bt) do { __builtin_amdgcn_s_setprio(1); _Pragma("unroll") for (int m = 0; m < 4; ++m) _Pragma("unroll") for (int n = 0; n < 2; ++n) _Pragma("unroll") for (int k = 0; k < 2; ++k) \
        acc[ai][bj][m][n] = __builtin_amdgcn_mfma_f32_16x16x32_bf16(Bt[n][k], At[m][k], acc[ai][bj][m][n], 0, 0, 0); __builtin_amdgcn_s_setprio(0); } while (0)
#define PG8_WAIT_V(n) asm volatile("s_waitcnt vmcnt(" #n ")" ::: "memory")
#define PG8_WAIT_L(n) asm volatile("s_waitcnt lgkmcnt(" #n ")" ::: "memory")
#define PG8_BAR __builtin_amdgcn_s_barrier()
#define PG8_SCHED __builtin_amdgcn_sched_barrier(0)
    Unit cur, nxt; int ui = 0;
    if (!S.next(0, cur)) return;
    f32x4 acc[2][2][4][2];
#pragma unroll
    for (int a = 0; a < 2; ++a)
#pragma unroll
        for (int b = 0; b < 2; ++b)
#pragma unroll
            for (int m = 0; m < 4; ++m)
#pragma unroll
                for (int n = 0; n < 2; ++n) acc[a][b][m][n] = (f32x4){0.f, 0.f, 0.f, 0.f};
    bf16x8 At[4][2], B0[2][2], B1[2][2];
    const char* cA = GATHER ? (const char*)g.A : (const char*)g.A + (size_t)cur.pm * tstepA; const char* cB = (const char*)g.Bt + (size_t)cur.pn * tstepB;
    if constexpr (GATHER) { PG8_GLOAD(gcur, cur.pm); }
#define PG8_PRE(u_, slot_) do { if (wid < 4) { int ln_; asm volatile("v_mbcnt_lo_u32_b32 %0, -1, 0\n\tv_mbcnt_hi_u32_b32 %0, -1, %0" : "=v"(ln_));   \
        __builtin_amdgcn_global_load_lds((const unsigned*)(E.pre_base(u_, wid) + ln_), (LAS unsigned*)(lds + PRE_OFF + (slot_) * 1024 + wid * 256), 4, 0, 0); } } while (0)
    if constexpr (Epi::PRE) { PG8_PRE(cur, 0); }
    PG8_STAGE(PG8_SB(0, 0), cB, voffB); PG8_STAGE(PG8_SB(0, 1), cB + hstepB, voffB); PG8_STAGE_A(PG8_SA(0, 0), cA, 0, false); PG8_STAGE_A(PG8_SA(0, 1), cA, 1, false);
    if (wr == 1) PG8_BAR;
    PG8_WAIT_V(2); PG8_BAR;
    PG8_STAGE(PG8_SB(1, 0), cB + kstep, voffB); PG8_STAGE_A(PG8_SA(1, 0), cA + kstep, 0, false); PG8_STAGE(PG8_SB(1, 1), cB + hstepB + kstep, voffB);
    PG8_WAIT_V(6); PG8_BAR;
    for (;;) {
        const bool has_next = S.next(ui + 1, nxt);
        const char* nA = GATHER ? cA : (has_next ? (const char*)g.A + (size_t)nxt.pm * tstepA : cA); const char* nB = has_next ? (const char*)g.Bt + (size_t)nxt.pn * tstepB : cB;
        if constexpr (GATHER) { if (has_next) { PG8_GLOAD(gnxt, nxt.pm); } else { gnxt[0] = gcur[0]; gnxt[1] = gcur[1]; } }
        for (int t = 0; t < nt; t += 2) {
            const bool last = (t == nt - 2);
            if constexpr (Epi::PRE) { if (last && has_next) PG8_PRE(nxt, (ui + 1) & 1); }
            const char* a1 = cA + (size_t)(t + 1) * kstep;
            const char* a2 = last ? nA : cA + (size_t)(t + 2) * kstep; const char* b2 = last ? nB : cB + (size_t)(t + 2) * kstep;
            const char* a3 = a2 + kstep; const char* b3 = b2 + kstep;
            PG8_LDB(B0, 0, 0); PG8_LDB(B1, 0, 1); PG8_SCHED; PG8_LDA(At, 0, 0); PG8_STAGE_A(PG8_SA(1, 1), a1, 1, false);
            PG8_WAIT_V(8); PG8_WAIT_L(0); PG8_BAR; PG8_MMA(0, 0, At, B0); PG8_MMA(0, 1, At, B1); PG8_BAR; PG8_SCHED;
            PG8_LDA(At, 0, 1); PG8_STAGE(PG8_SB(0, 0), b2, voffB); PG8_STAGE(PG8_SB(0, 1), b2 + hstepB, voffB); PG8_STAGE_A(PG8_SA(0, 0), a2, 0, last);
            PG8_WAIT_V(8); PG8_WAIT_L(0); PG8_BAR; PG8_MMA(1, 0, At, B0); PG8_MMA(1, 1, At, B1); PG8_BAR; PG8_SCHED;
            PG8_LDB(B0, 1, 0); PG8_LDB(B1, 1, 1); PG8_SCHED; PG8_LDA(At, 1, 0); PG8_STAGE_A(PG8_SA(0, 1), a2, 1, last);
            PG8_WAIT_V(8); PG8_WAIT_L(0); PG8_BAR; PG8_MMA(0, 0, At, B0); PG8_MMA(0, 1, At, B1); PG8_BAR; PG8_SCHED;
            PG8_LDA(At, 1, 1); PG8_STAGE(PG8_SB(1, 0), b3, voffB); PG8_STAGE(PG8_SB(1, 1), b3 + hstepB, voffB); PG8_STAGE_A(PG8_SA(1, 0), a3, 0, last);
            PG8_WAIT_V(8); PG8_WAIT_L(0); PG8_BAR; PG8_MMA(1, 0, At, B0); PG8_MMA(1, 1, At, B1); PG8_BAR; PG8_SCHED;
        }
        if (wr == 0) PG8_BAR;
        { int el; asm volatile("v_mbcnt_lo_u32_b32 %0, -1, 0\n\tv_mbcnt_hi_u32_b32 %0, -1, %0" : "=v"(el));
          if constexpr (Epi::PRE) E(acc, cur, wr, wc, el & 15, el >> 4, (const LAS float*)(lds + PRE_OFF + (ui & 1) * 1024)); else E(acc, cur, wr, wc, el & 15, el >> 4); }
        if (!has_next) break;
        if constexpr (!Epi::CHAIN) {
#pragma unroll
        for (int a = 0; a < 2; ++a)
#pragma unroll
            for (int b = 0; b < 2; ++b)
#pragma unroll
                for (int m = 0; m < 4; ++m)
#pragma unroll
                    for (int n = 0; n < 2; ++n) acc[a][b][m][n] = (f32x4){0.f, 0.f, 0.f, 0.f};
        }
        cur = nxt; cA = nA; cB = nB; ++ui;
        if constexpr (GATHER) { gcur[0] = gnxt[0]; gcur[1] = gnxt[1]; }
        if (wr == 1) PG8_BAR;
    }
    PG8_WAIT_V(0);
    PG8_BAR;
#undef PG8_PRE
#undef PG8_SA
#undef PG8_SB
#undef PG8_STAGE
#undef PG8_LDA
#undef PG8_STAGE_A
#undef PG8_GLOAD
#undef PG8_GOFF
#undef PG8_STAGE_G
#undef PG8_LDB
#undef PG8_MMA
#undef PG8_WAIT_V
#undef PG8_WAIT_L
#undef PG8_BAR
#undef PG8_SCHED
}
}
using pg8::Unit;

struct Args { const float* in[23]; float* out; unsigned char* ws; int ph_lo, ph_hi; int sub, pad; };
struct Ctx {
    LAS unsigned char* lds;
    int tid, lane, wave, G, bid;
    unsigned char* ws;
};
#define WSP(T, off) ((T*)(C.ws + (off)))

struct GridOrder {
    int nN, total, G, c;
    __device__ __forceinline__ bool next(int i, Unit& u) const {
        const int L = c + i * G; if (L >= total) return false;
        const int nM = total / nN; int wgid;
        { const int q = total >> 3, r = total & 7, xcd = L & 7, off = L >> 3; wgid = (xcd < r ? xcd * (q + 1) : r * (q + 1) + (xcd - r) * q) + off; }
        const int nig = 8 * nN, gid = wgid / nig, fm = gid * 8, gsz = (nM - fm) < 8 ? (nM - fm) : 8, w = wgid - gid * nig;
        const int pn = w / gsz; u.pm = fm + (w - pn * gsz); u.pn = pn; return true;
    }
};
struct MergeOrder {
    int G, c;
    __device__ __forceinline__ bool next(int i, Unit& u) const { const int t = i / 3, n = i - 3 * t, tile = c + t * G; if (tile >= 512) return false; u.pm = n * 128 + (tile >> 2); u.pn = n * 4 + (tile & 3); return true; }
};
struct MoeOrder {
    int NT, total, G, c; const LAS int* tb;
    __device__ __forceinline__ bool next(int i, Unit& u) const {
        if ((G & 7) != 0) { const int idx = c + i * G; if (idx >= total) return false; const int mt = idx / NT, pn = idx - mt * NT;
            const int e = __builtin_amdgcn_readfirstlane(tb[40 + mt]); u.pm = mt; u.pn = e * NT + pn; return true; }
        const int T = __builtin_amdgcn_readfirstlane(tb[NEXP]), x = c & 7, lo = (x * T) >> 3, ntl = (((x + 1) * T) >> 3) - lo;
        const int j = (c >> 3) + i * (G >> 3);
        if (j >= ntl * NT) return false;
        const int gsh = (NT == 8) ? 6 : 5, gm = j >> gsh, rem = j - (gm << gsh);
        const int gs = (ntl - 8 * gm < 8) ? (ntl - 8 * gm) : 8, g4 = gs * 4, pg = (rem >= g4) ? 1 : 0, r2 = rem - pg * g4;
        const int mt = lo + 8 * gm + (r2 >> 2), e = __builtin_amdgcn_readfirstlane(tb[40 + mt]);
        u.pm = mt; u.pn = e * NT + pg * 4 + (r2 & 3); return true;
    }
};

__device__ __forceinline__ float gelu_f(float v) {
    const float av = fabsf(v), t = __builtin_amdgcn_rcpf(fmaf(av, 0.2316418882f, 1.0f));
    float q = fmaf(t, 0.5307027145f, -0.7265760135f); q = fmaf(q, t, 0.7107068705f); q = fmaf(q, t, -0.142248368f); q = fmaf(q, t, 0.127414796f); q = q * t;
    const float e = __builtin_amdgcn_exp2f((v * v) * (-0.72134752044f));
    const float m = v * (q * e);
    return v < 0.f ? m : v - m;
}
__device__ __forceinline__ float sigmoid_f(float x) { return __builtin_amdgcn_rcpf(1.f + __builtin_amdgcn_exp2f(x * (-LOG2E))); }
__device__ __forceinline__ int perm16(int o) { return (o & 3) | (((o >> 3) & 1) << 2) | (((o >> 2) & 1) << 3); }
__device__ __forceinline__ void st_bf4(bf16_t* p, f32x4 v) { u32x2 w; w.x = pk2(v[0], v[1]); w.y = pk2(v[2], v[3]); *(u32x2*)p = w; }
__device__ __forceinline__ f32x4 other32_4(f32x4 v, bool upper) { f32x4 r; r[0] = xother32(v[0], upper); r[1] = xother32(v[1], upper); r[2] = xother32(v[2], upper); r[3] = xother32(v[3], upper); return r; }

__device__ __forceinline__ void st_bf8(bf16_t* p, f32x4 v0, f32x4 v1) { u32x4 w; w.x = pk2(v0[0], v0[1]); w.y = pk2(v0[2], v0[3]); w.z = pk2(v1[0], v1[1]); w.w = pk2(v1[2], v1[3]); __builtin_nontemporal_store(w, (u32x4*)p); }
__device__ __forceinline__ f32x4 swz16_4(f32x4 v) { f32x4 r; r[0] = xswz<16>(v[0]); r[1] = xswz<16>(v[1]); r[2] = xswz<16>(v[2]); r[3] = xswz<16>(v[3]); return r; }
__device__ __forceinline__ void ld_bf8(const bf16_t* p, f32x4& a, f32x4& b) { const u32x4 w = *(const u32x4*)p; a = (f32x4){bflo(w.x), bfhi(w.x), bflo(w.y), bfhi(w.y)}; b = (f32x4){bflo(w.z), bfhi(w.z), bflo(w.w), bfhi(w.w)}; }
__device__ __forceinline__ void st_vt8(bf16_t* p, f32x4 v0, f32x4 v1) {
    const unsigned w0 = pk2(v0[0], v0[1]), w1 = pk2(v0[2], v0[3]), w2 = pk2(v1[0], v1[1]), w3 = pk2(v1[2], v1[3]);
    p[0] = (bf16_t)(w0 & 0xffff); p[SEQ] = (bf16_t)(w0 >> 16); p[2 * SEQ] = (bf16_t)(w1 & 0xffff); p[3 * SEQ] = (bf16_t)(w1 >> 16);
    p[4 * SEQ] = (bf16_t)(w2 & 0xffff); p[5 * SEQ] = (bf16_t)(w2 >> 16); p[6 * SEQ] = (bf16_t)(w3 & 0xffff); p[7 * SEQ] = (bf16_t)(w3 >> 16);
}
struct EpiInProj {
    static constexpr bool CHAIN = false; static constexpr bool PRE = false;
    unsigned char* ws; bool skip;
    __device__ __forceinline__ void operator()(f32x4 (&acc)[2][2][4][2], const Unit& un, int wr, int wc, int fr, int fq) const {
        if (skip) return;
        const int pn = un.pn; const int row0 = un.pm * 256 + wr * 64 + fr;
        const float* cosA = (const float*)(ws + WS_COSA); const float* sinA = (const float*)(ws + WS_SINA); const float* cosC = (const float*)(ws + WS_COSC); const float* sinC = (const float*)(ws + WS_SINC);
        if (pn < 4 || pn == 6 || pn == 7) {
            const size_t doff = pn < 2 ? WS_QA : (pn < 4 ? WS_KA : WS_IQ); bf16_t* dst = (bf16_t*)(ws + doff); const float sc = pn < 2 ? QSCALE_A : 1.f; const int tcol = (pn & 1) * 256;
            const bool rope = (wc & 1) == 0;
#pragma unroll
            for (int ai = 0; ai < 2; ++ai)
#pragma unroll
                for (int m = 0; m < 4; ++m) { const int row = row0 + ai * 128 + m * 16;
                    f32x4 c0 = {1.f, 1.f, 1.f, 1.f}, c1 = c0, s0 = {0.f, 0.f, 0.f, 0.f}, s1 = s0;
                    if (rope) { c0 = *(const f32x4*)(cosA + (size_t)row * 8); c1 = *(const f32x4*)(cosA + (size_t)row * 8 + 4); s0 = *(const f32x4*)(sinA + (size_t)row * 8); s1 = *(const f32x4*)(sinA + (size_t)row * 8 + 4); }
#pragma unroll
                    for (int bj = 0; bj < 2; ++bj) { f32x4 v0 = acc[ai][bj][m][0], v1 = acc[ai][bj][m][1];
                        const f32x4 p0 = swz16_4(v0), p1 = swz16_4(v1);
                        if (rope && fq < 2) { v0 = (fq == 0) ? (v0 * c0 - p0 * s0) : (v0 * c0 + p0 * s0); v1 = (fq == 0) ? (v1 * c1 - p1 * s1) : (v1 * c1 + p1 * s1); }
                        st_bf8(dst + (size_t)row * 512 + tcol + bj * 128 + wc * 32 + 8 * fq, v0 * sc, v1 * sc); } }
        } else if (pn < 6) {
            bf16_t* vat = (bf16_t*)(ws + WS_VAT);
#pragma unroll
            for (int ai = 0; ai < 2; ++ai)
#pragma unroll
                for (int m = 0; m < 4; ++m) { const int row = row0 + ai * 128 + m * 16; const int b = row >> 12, s = row & 4095, ps = (s & ~15) | perm16(s & 15);
#pragma unroll
                    for (int bj = 0; bj < 2; ++bj) { const int c = (pn - 4) * 256 + bj * 128 + wc * 32 + 8 * fq; const int h = c >> 6, d = c & 63;
                        st_vt8(vat + ((size_t)(b * 8 + h) * 64 + d) * SEQ + ps, acc[ai][bj][m][0], acc[ai][bj][m][1]); } }
        } else if (pn == 8) {
            bf16_t* ik = (bf16_t*)(ws + WS_IK); float* iw = (float*)(ws + WS_IW); bf16_t* kc = (bf16_t*)(ws + WS_KC); bf16_t* cd = (bf16_t*)(ws + WS_CDKV); float* ssq = (float*)(ws + WS_SSQ);
#pragma unroll
            for (int ai = 0; ai < 2; ++ai)
#pragma unroll
                for (int m = 0; m < 4; ++m) { const int row = row0 + ai * 128 + m * 16;
                    { f32x4 v0 = acc[ai][0][m][0], v1 = acc[ai][0][m][1];
                      { unsigned zz = 0u; asm volatile("" : "+v"(zz)); const u32x4 z = {zz, zz, zz, zz}; *(u32x4*)(cd + (size_t)row * 256 + wc * 32 + 8 * fq) = z; }
                      if (wc == 0) {
                          const f32x4 p0 = swz16_4(v0), p1 = swz16_4(v1);
                          if (fq < 2) { const f32x4 c0 = *(const f32x4*)(cosA + (size_t)row * 8), c1 = *(const f32x4*)(cosA + (size_t)row * 8 + 4), s0 = *(const f32x4*)(sinA + (size_t)row * 8), s1 = *(const f32x4*)(sinA + (size_t)row * 8 + 4);
                              v0 = (fq == 0) ? (v0 * c0 - p0 * s0) : (v0 * c0 + p0 * s0); v1 = (fq == 0) ? (v1 * c1 - p1 * s1) : (v1 * c1 + p1 * s1); }
                          st_bf8(ik + (size_t)row * 64 + 8 * fq, v0, v1);
                      } else if (wc == 1) { st_bf8(ik + (size_t)row * 64 + 32 + 8 * fq, v0, v1);
                      } else if (wc == 2) { if (fq == 0) { *(f32x4*)(iw + (size_t)row * 8) = v0 * IW_SCALE; *(f32x4*)(iw + (size_t)row * 8 + 4) = v1 * IW_SCALE; }
                      } else {
                          const bool up = fq >= 2; const f32x4 p0 = other32_4(v0, up), p1 = other32_4(v1, up);
                          const f32x4 c0 = *(const f32x4*)(cosC + (size_t)row * 16 + 8 * (fq & 1)), c1 = *(const f32x4*)(cosC + (size_t)row * 16 + 8 * (fq & 1) + 4), s0 = *(const f32x4*)(sinC + (size_t)row * 16 + 8 * (fq & 1)), s1 = *(const f32x4*)(sinC + (size_t)row * 16 + 8 * (fq & 1) + 4);
                          const f32x4 o0 = up ? (v0 * c0 + p0 * s0) : (v0 * c0 - p0 * s0), o1 = up ? (v1 * c1 + p1 * s1) : (v1 * c1 - p1 * s1);
                          bf16_t* p = kc + (size_t)row * 768 + 64 + 8 * fq;
#pragma unroll
                          for (int h = 0; h < 8; ++h) st_bf8(p + h * 96, o0, o1); } }
                    { const f32x4 v0 = acc[ai][1][m][0], v1 = acc[ai][1][m][1];
                      st_bf8(cd + (size_t)row * 256 + 128 + wc * 32 + 8 * fq, v0, v1);
                      float s = (v0[0] * v0[0] + v0[1] * v0[1]) + (v0[2] * v0[2] + v0[3] * v0[3]) + (v1[0] * v1[0] + v1[1] * v1[1]) + (v1[2] * v1[2] + v1[3] * v1[3]);
                      s += xswz<16>(s); s = xsum32(s);
                      if (fq == 0) ssq[(size_t)row * 8 + 4 + wc] = s; } }
        } else if (pn < 13) {
            bf16_t* dst = (bf16_t*)(ws + (pn < 11 ? WS_U : WS_V)); const int tcol = ((pn - 9) & 1) * 256;
#pragma unroll
            for (int ai = 0; ai < 2; ++ai)
#pragma unroll
                for (int m = 0; m < 4; ++m) { const int row = row0 + ai * 128 + m * 16;
#pragma unroll
                    for (int bj = 0; bj < 2; ++bj) { f32x4 v0 = acc[ai][bj][m][0], v1 = acc[ai][bj][m][1];
                        v0[0] = gelu_f(v0[0]); v0[1] = gelu_f(v0[1]); v0[2] = gelu_f(v0[2]); v0[3] = gelu_f(v0[3]); v1[0] = gelu_f(v1[0]); v1[1] = gelu_f(v1[1]); v1[2] = gelu_f(v1[2]); v1[3] = gelu_f(v1[3]);
                        st_bf8(dst + (size_t)row * 512 + tcol + bj * 128 + wc * 32 + 8 * fq, v0, v1); } }
        } else if (pn == 13) {
            bf16_t* cd = (bf16_t*)(ws + WS_CDQ); float* ssq = (float*)(ws + WS_SSQ);
#pragma unroll
            for (int ai = 0; ai < 2; ++ai)
#pragma unroll
                for (int m = 0; m < 4; ++m) { const int row = row0 + ai * 128 + m * 16; float s = 0.f;
#pragma unroll
                    for (int bj = 0; bj < 2; ++bj) { const f32x4 v0 = acc[ai][bj][m][0], v1 = acc[ai][bj][m][1];
                        st_bf8(cd + (size_t)row * 256 + bj * 128 + wc * 32 + 8 * fq, v0, v1);
                        s += ((v0[0] * v0[0] + v0[1] * v0[1]) + (v0[2] * v0[2] + v0[3] * v0[3])) + ((v1[0] * v1[0] + v1[1] * v1[1]) + (v1[2] * v1[2] + v1[3] * v1[3])); }
                    s += xswz<16>(s); s = xsum32(s);
                    if (fq == 0) ssq[(size_t)row * 8 + wc] = s; }
        } else {
            const int tcol = (pn - 14) * 256; bf16_t* gate = (bf16_t*)(ws + WS_GATE);
#pragma unroll
            for (int ai = 0; ai < 2; ++ai)
#pragma unroll
                for (int m = 0; m < 4; ++m) { const int row = row0 + ai * 128 + m * 16;
#pragma unroll
                    for (int bj = 0; bj < 2; ++bj) { f32x4 v0 = acc[ai][bj][m][0], v1 = acc[ai][bj][m][1];
                        v0[0] = sigmoid_f(v0[0]); v0[1] = sigmoid_f(v0[1]); v0[2] = sigmoid_f(v0[2]); v0[3] = sigmoid_f(v0[3]); v1[0] = sigmoid_f(v1[0]); v1[1] = sigmoid_f(v1[1]); v1[2] = sigmoid_f(v1[2]); v1[3] = sigmoid_f(v1[3]);
                        st_bf8(gate + (size_t)row * 3072 + tcol + bj * 128 + wc * 32 + 8 * fq, v0, v1); } }
        }
    }
};

struct EpiQUp {
    static constexpr bool CHAIN = false; static constexpr bool PRE = false;
    bf16_t* qc; const float* ssq; const float *cosC, *sinC;
    __device__ __forceinline__ void operator()(f32x4 (&acc)[2][2][4][2], const Unit& un, int wr, int wc, int fr, int fq) const {
        const int row0 = un.pm * 256 + wr * 64 + fr; const bool up = fq >= 2;
#pragma unroll
        for (int ai = 0; ai < 2; ++ai)
#pragma unroll
            for (int m = 0; m < 4; ++m) { const int row = row0 + ai * 128 + m * 16;
                const f32x4 sp = *(const f32x4*)(ssq + (size_t)row * 8);
                const float rs = rsqrtf(((sp[0] + sp[1]) + (sp[2] + sp[3])) * (1.f / 256.f) + RMS_EPS) * QSCALE_C;
                const f32x4 c0 = *(const f32x4*)(cosC + (size_t)row * 16 + 8 * (fq & 1)), c1 = *(const f32x4*)(cosC + (size_t)row * 16 + 8 * (fq & 1) + 4), s0 = *(const f32x4*)(sinC + (size_t)row * 16 + 8 * (fq & 1)), s1 = *(const f32x4*)(sinC + (size_t)row * 16 + 8 * (fq & 1) + 4);
#pragma unroll
                for (int bj = 0; bj < 2; ++bj) { const int gidx = un.pn * 8 + bj * 4 + wc;
                    f32x4 v0 = acc[ai][bj][m][0] * rs, v1 = acc[ai][bj][m][1] * rs;
                    if ((gidx % 3) == 2) { const f32x4 p0 = other32_4(v0, up), p1 = other32_4(v1, up);
                        v0 = up ? (v0 * c0 + p0 * s0) : (v0 * c0 - p0 * s0); v1 = up ? (v1 * c1 + p1 * s1) : (v1 * c1 - p1 * s1); }
                    st_bf8(qc + (size_t)row * 768 + gidx * 32 + 8 * fq, v0, v1); } }
    }
};
struct EpiKvUp {
    static constexpr bool CHAIN = false; static constexpr bool PRE = false;
    bf16_t *kc, *vct; const float* ssq;
    __device__ __forceinline__ void operator()(f32x4 (&acc)[2][2][4][2], const Unit& un, int wr, int wc, int fr, int fq) const {
        const int row0 = un.pm * 256 + wr * 64 + fr;
#pragma unroll
        for (int ai = 0; ai < 2; ++ai)
#pragma unroll
            for (int m = 0; m < 4; ++m) { const int row = row0 + ai * 128 + m * 16;
                const f32x4 sp = *(const f32x4*)(ssq + (size_t)row * 8 + 4);
                const float rs = rsqrtf(((sp[0] + sp[1]) + (sp[2] + sp[3])) * (1.f / 128.f) + RMS_EPS);
                const int b = row >> 12, s = row & 4095, ps = (s & ~15) | perm16(s & 15);
#pragma unroll
                for (int bj = 0; bj < 2; ++bj) { const int h = un.pn * 2 + bj; const f32x4 v0 = acc[ai][bj][m][0] * rs, v1 = acc[ai][bj][m][1] * rs;
                    if (wc < 2) st_bf8(kc + (size_t)row * 768 + h * 96 + wc * 32 + 8 * fq, v0, v1);
                    else st_vt8(vct + ((size_t)(b * 8 + h) * 64 + (wc - 2) * 32 + 8 * fq) * SEQ + ps, v0, v1); }
                asm volatile("" ::: "memory"); }
    }
};
struct EpiMerge {
    static constexpr bool CHAIN = true; static constexpr bool PRE = false;
    const bf16_t* gate; bf16_t* merged;
    __device__ __forceinline__ void operator()(f32x4 (&acc)[2][2][4][2], const Unit& un, int wr, int wc, int fr, int fq) const {
        const int n3 = un.pm >> 7, pm = un.pm & 127, pn = un.pn & 3; const int row0 = pm * 256 + wr * 64 + fr;
#pragma unroll
        for (int ai = 0; ai < 2; ++ai)
#pragma unroll
            for (int m = 0; m < 4; ++m) { const int row = row0 + ai * 128 + m * 16;
#pragma unroll
                for (int bj = 0; bj < 2; ++bj) { const int col = pn * 256 + bj * 128 + wc * 32 + 8 * fq;
                    const bf16_t* gp = gate + (size_t)row * 3072 + n3 * 1024 + col;
                    f32x4 ga0, ga1; ld_bf8(gp, ga0, ga1);
                    if (n3 < 2) { f32x4 gb0, gb1; ld_bf8(gp + 1024, gb0, gb1);
#pragma unroll
                        for (int j = 0; j < 4; ++j) { if (n3 == 1) { ga0[j] = fmaxf(ga0[j], 1e-20f); ga1[j] = fmaxf(ga1[j], 1e-20f); }
                            acc[ai][bj][m][0][j] *= ga0[j] * __builtin_amdgcn_rcpf(fmaxf(gb0[j], 1e-20f)); acc[ai][bj][m][1][j] *= ga1[j] * __builtin_amdgcn_rcpf(fmaxf(gb1[j], 1e-20f)); }
                    } else {
#pragma unroll
                        for (int j = 0; j < 4; ++j) { ga0[j] = fmaxf(ga0[j], 1e-20f); ga1[j] = fmaxf(ga1[j], 1e-20f); }
                        st_bf8(merged + (size_t)row * 1024 + col, acc[ai][bj][m][0] * ga0, acc[ai][bj][m][1] * ga1);
                        acc[ai][bj][m][0] = (f32x4){0.f, 0.f, 0.f, 0.f}; acc[ai][bj][m][1] = (f32x4){0.f, 0.f, 0.f, 0.f};
                    } } }
    }
};
struct EpiOut {
    static constexpr bool CHAIN = false; static constexpr bool PRE = false;
    bf16_t* yo;
    __device__ __forceinline__ void operator()(f32x4 (&acc)[2][2][4][2], const Unit& un, int wr, int wc, int fr, int fq) const {
        const int row0 = un.pm * 256 + wr * 64 + fr;
#pragma unroll
        for (int ai = 0; ai < 2; ++ai)
#pragma unroll
            for (int m = 0; m < 4; ++m) { const int row = row0 + ai * 128 + m * 16;
#pragma unroll
                for (int bj = 0; bj < 2; ++bj) st_bf8(yo + (size_t)row * 1024 + un.pn * 256 + bj * 128 + wc * 32 + 8 * fq, acc[ai][bj][m][0], acc[ai][bj][m][1]); }
    }
};
struct EpiMoeUp {
    static constexpr bool CHAIN = false; static constexpr bool PRE = true;
    bf16_t* hbuf; const float* bgu;
    __device__ __forceinline__ const float* pre_base(const Unit& un, int w) const { const int e = un.pn >> 3, pnl = un.pn & 7; return bgu + (size_t)e * 2048 + pnl * 128 + (w < 2 ? w * 64 : 1024 + (w - 2) * 64); }
    __device__ __forceinline__ void operator()(f32x4 (&acc)[2][2][4][2], const Unit& un, int wr, int wc, int fr, int fq, const LAS float* pre) const {
        const int pnl = un.pn & 7; const int row0 = un.pm * 256 + wr * 64 + fr;
        const int jh = pnl * 128 + wc * 32 + 8 * fq; const LAS float* pb = pre + wc * 32 + 8 * fq;
        const f32x4 bg0 = *(const LAS f32x4*)(pb), bg1 = *(const LAS f32x4*)(pb + 4), bl0 = *(const LAS f32x4*)(pb + 128), bl1 = *(const LAS f32x4*)(pb + 132);
#pragma unroll
        for (int ai = 0; ai < 2; ++ai)
#pragma unroll
            for (int m = 0; m < 4; ++m) { const int row = row0 + ai * 128 + m * 16;
                const f32x4 g0 = acc[ai][0][m][0] + bg0, g1 = acc[ai][0][m][1] + bg1, l0 = acc[ai][1][m][0] + bl0, l1 = acc[ai][1][m][1] + bl1; f32x4 o0, o1;
#pragma unroll
                for (int j = 0; j < 4; ++j) { const float ga = fminf(g0[j], 7.f), la = fminf(fmaxf(l0[j], -7.f), 7.f); o0[j] = (la + 1.f) * (ga * sigmoid_f(1.702f * ga));
                    const float gb = fminf(g1[j], 7.f), lb = fminf(fmaxf(l1[j], -7.f), 7.f); o1[j] = (lb + 1.f) * (gb * sigmoid_f(1.702f * gb)); }
                st_bf8(hbuf + (size_t)row * 1024 + jh, o0, o1);
                __builtin_amdgcn_sched_barrier(0); }
    }
};
struct EpiMoeDn {
    static constexpr bool CHAIN = false; static constexpr bool PRE = true;
    bf16_t* y; const float* bdn; bool skip;
    __device__ __forceinline__ const float* pre_base(const Unit& un, int w) const { const int e = un.pn >> 2, pnl = un.pn & 3; return bdn + (size_t)e * 1024 + pnl * 256 + w * 64; }
    __device__ __forceinline__ void operator()(f32x4 (&acc)[2][2][4][2], const Unit& un, int wr, int wc, int fr, int fq, const LAS float* pre) const {
        const int pnl = un.pn & 3; const int row0 = (skip ? 0 : un.pm * 256) + wr * 64 + fr;
#pragma unroll
        for (int bj = 0; bj < 2; ++bj) { const int col = pnl * 256 + bj * 128 + wc * 32 + 8 * fq; const LAS float* pb = pre + bj * 128 + wc * 32 + 8 * fq; const f32x4 b0 = *(const LAS f32x4*)(pb), b1 = *(const LAS f32x4*)(pb + 4);
#pragma unroll
            for (int ai = 0; ai < 2; ++ai)
#pragma unroll
                for (int m = 0; m < 4; ++m) st_bf8(y + (size_t)(row0 + ai * 128 + m * 16) * 1024 + col, acc[ai][bj][m][0] + b0, acc[ai][bj][m][1] + b1); }
    }
};

__device__ __forceinline__ float wave_sum(float v) {
    v += xswz<1>(v); v += xswz<2>(v); v += xswz<4>(v); v += xswz<8>(v); v += xswz<16>(v); return xsum32(v);
}
__device__ __forceinline__ int colmap_in(int np) {
    if (np < 2048) return np;
    if (np < 2304) { const int t = np - 2048; if (t < 64) return 2048 + t; if (t < 72) return 2112 + (t - 64); if (t < 96) return -1; if (t < 128) return 3528 + (t - 96); return 3400 + (t - 128); }
    if (np < 3328) return 2120 + (np - 2304);
    if (np < 3584) return 3144 + (np - 3328);
    return 3560 + (np - 3584);
}
__device__ __forceinline__ int colmap_gu(int np) { const int tile = np >> 8, w = np & 255; return (w < 128) ? (tile * 128 + w) : (1024 + tile * 128 + (w - 128)); }
template <int KIND>
__device__ __forceinline__ void tconv_item(const float* src, int ldsrc, bf16_t* dst, int Kdst, int koff, const float* kscale, int item, int nblk, LAS float* scr, int lane) {
    const int kb = item / nblk, nb = item - kb * nblk, k0 = 64 * kb, n0 = 32 * nb;
    const int np = n0 + (lane & 31);
    const int col = KIND == 1 ? colmap_in(np) : (KIND == 2 ? colmap_gu(np) : np);
    float vv[32];
#pragma unroll
    for (int i = 0; i < 32; ++i) { const int kk = 2 * i + (lane >> 5); const int ks = k0 + kk - koff; float v = 0.f;
        if (col >= 0 && ks >= 0) { v = src[(size_t)ks * ldsrc + col]; if (kscale) v *= kscale[ks]; }
        vv[i] = v; }
#pragma unroll
    for (int i = 0; i < 32; ++i) { const int kk = 2 * i + (lane >> 5); scr[kk * 33 + (lane & 31)] = vv[i]; }
    LDS_WAIT(); asm volatile("" ::: "memory");
    const int c = lane & 7;
#pragma unroll
    for (int j = 0; j < 4; ++j) { const int n = (lane >> 3) + 8 * j; const LAS float* s = scr + (8 * c) * 33 + n;
        u32x4 o; o.x = pk2(s[0 * 33], s[1 * 33]); o.y = pk2(s[2 * 33], s[3 * 33]); o.z = pk2(s[4 * 33], s[5 * 33]); o.w = pk2(s[6 * 33], s[7 * 33]);
        *(u32x4*)(dst + (size_t)(n0 + n) * Kdst + k0 + 8 * c) = o; }
    LDS_WAIT(); asm volatile("" ::: "memory");
}
__device__ __forceinline__ void phase_prologue(const Ctx& C, const Args& A) {
    LAS float* scr = (LAS float*)(C.lds + C.wave * 16384);
    const int gw = C.bid * NWAVES + C.wave, NGW = C.G * NWAVES;
    constexpr int I_IN = 16 * (NIN / 32), I_UQ = 4 * 24, I_UKV = 4 * 32, I_BR = 8 * 32, I_OUT = 16 * 32, I_GU = 16 * 64, I_DN = 16 * 32;
    constexpr int I_LAYER = I_IN + I_UQ + I_UKV + 3 * I_BR + I_OUT + NEXP * I_GU + NEXP * I_DN;
    for (int it = gw; it < NLAYER * I_LAYER; it += NGW) {
        const int l = it / I_LAYER; int r = it - l * I_LAYER;
        if (r < I_IN) { tconv_item<1>(A.in[2] + (size_t)l * DM * NIN_SRC, NIN_SRC, WSP(bf16_t, WS_WIN + l * SZ_WIN), 1024, 0, nullptr, r, NIN / 32, scr, C.lane); continue; } r -= I_IN;
        if (r < I_UQ) { tconv_item<0>(A.in[9] + (size_t)l * 256 * 768, 768, WSP(bf16_t, WS_WUQ + l * SZ_WUQ), 256, 0, A.in[7] + l * 256, r, 24, scr, C.lane); continue; } r -= I_UQ;
        if (r < I_UKV) { tconv_item<0>(A.in[10] + (size_t)l * 128 * 1024, 1024, WSP(bf16_t, WS_WUKV + l * SZ_WUKV), 256, 128, A.in[8] + l * 128, r, 32, scr, C.lane); continue; } r -= I_UKV;
        if (r < 3 * I_BR) { const int n = r / I_BR; r -= n * I_BR;
            tconv_item<0>(A.in[11] + ((size_t)l * 3 + n) * 512 * 1024, 1024, WSP(bf16_t, WS_WBR + l * SZ_WBR) + (size_t)n * 1024 * 512, 512, 0, nullptr, r, 32, scr, C.lane); continue; } r -= 3 * I_BR;
        if (r < I_OUT) { tconv_item<0>(A.in[12] + (size_t)l * 1024 * 1024, 1024, WSP(bf16_t, WS_WOUT + l * SZ_WOUT), 1024, 0, nullptr, r, 32, scr, C.lane); continue; } r -= I_OUT;
        if (r < NEXP * I_GU) { const int e = r / I_GU; r -= e * I_GU;
            tconv_item<2>(A.in[17] + ((size_t)l * NEXP + e) * 1024 * 2048, 2048, WSP(bf16_t, WS_WGU + l * SZ_WGU) + (size_t)e * 2048 * 1024, 1024, 0, nullptr, r, 64, scr, C.lane); continue; } r -= NEXP * I_GU;
        { const int e = r / I_DN; r -= e * I_DN;
            tconv_item<0>(A.in[19] + ((size_t)l * NEXP + e) * 1024 * 1024, 1024, WSP(bf16_t, WS_WDN + l * SZ_WDN) + (size_t)e * 1024 * 1024, 1024, 0, nullptr, r, 32, scr, C.lane); }
    }
    const int gt = C.bid * 512 + C.tid, NGT = C.G * 512;
    { float* rwt = WSP(float, WS_RWT);
      for (int i = gt; i < NLAYER * 32 * 1024; i += NGT) { const int l = i >> 15, e = (i >> 10) & 31, k = i & 1023; rwt[i] = A.in[15][(size_t)l * 32768 + k * 32 + e] * A.in[13][l * 1024 + k]; }
      const int gwv = C.bid * NWAVES + C.wave;
      if (gwv < NLAYER * 32) { const int l = gwv >> 5, e = gwv & 31; const float* rw = A.in[15] + (size_t)l * 32768; const float* g1 = A.in[13] + l * 1024; const float* b1 = A.in[14] + l * 1024;
          float sg = 0.f, sb = 0.f;
#pragma unroll
          for (int j = 0; j < 16; ++j) { const int k = C.lane + 64 * j; sg += rw[k * 32 + e] * g1[k]; sb += b1[k] * rw[k * 32 + e]; }
          sg = wave_sum(sg); sb = wave_sum(sb);
          if (C.lane == 0) { float* gb = WSP(float, WS_GBW) + l * 64; gb[e] = sg; gb[32 + e] = sb + A.in[16][l * 32 + e]; } } }
    { bf16_t* d = WSP(bf16_t, WS_WGM); const float* s = A.in[5];
      for (int i = gt; i < NLAYER * 8 * 128 * 128; i += NGT) { const int jj = i & 127, ii = (i >> 7) & 127; d[i] = (jj <= ii) ? (bf16_t)(pk2(s[i], 0.f) & 0xffff) : (bf16_t)0; } }
    { const int* pos = (const int*)A.in[1]; float *ca = WSP(float, WS_COSA), *sa = WSP(float, WS_SINA), *cc = WSP(float, WS_COSC), *sc = WSP(float, WS_SINC);
      for (int i = gt; i < NTOK * 8; i += NGT) { const int t = i >> 3, f = i & 7; const float inv = powf(500000.f, -(float)f / 8.f); const float ang = (float)pos[t] * inv; ca[i] = cosf(ang); sa[i] = sinf(ang); }
      for (int i = gt; i < NTOK * 16; i += NGT) { const int t = i >> 4, f = i & 15; const float inv = powf(500000.f, -(float)f / 16.f); const float ang = (float)pos[t] * inv; cc[i] = cosf(ang); sc[i] = sinf(ang); } }
    { const f32x4* x4 = (const f32x4*)A.in[0]; u32x2* xb = WSP(u32x2, WS_XB);
      for (int i = gt; i < NTOK * DM / 4; i += NGT) { const f32x4 v = x4[i]; u32x2 w; w.x = pk2(v[0], v[1]); w.y = pk2(v[2], v[3]); xb[i] = w; } }
}

__device__ __forceinline__ void idx_block(const Ctx& C, int b, int qb) {
    const int tid = C.tid, lane = C.lane, wid = C.wave, r32 = lane & 31, hi = lane >> 5;
    const bf16_t* iq = WSP(bf16_t, WS_IQ); const bf16_t* ik = WSP(bf16_t, WS_IK); const float* iw = WSP(float, WS_IW); float* score = WSP(float, WS_SCORE);
    const int qi_l = ((r32 >> 4) << 1) + ((r32 >> 2) & 1), h_l = (r32 & 3) + 4 * ((r32 >> 3) & 1);
    bf16x8 af[2][4]; float wv[2][2][8];
#pragma unroll
    for (int rb = 0; rb < 2; ++rb) { const size_t tok = (size_t)b * SEQ + qb * 64 + wid * 8 + rb * 4 + qi_l;
#pragma unroll
        for (int ks = 0; ks < 4; ++ks) af[rb][ks] = *(const bf16x8*)(iq + tok * 512 + h_l * 64 + ks * 16 + hi * 8);
#pragma unroll
        for (int g = 0; g < 2; ++g) { const size_t tq = (size_t)b * SEQ + qb * 64 + wid * 8 + rb * 4 + 2 * g + hi;
            const f32x4 w0 = *(const f32x4*)(iw + tq * 8), w1 = *(const f32x4*)(iw + tq * 8 + 4);
            wv[rb][g][0] = w0[0]; wv[rb][g][1] = w0[1]; wv[rb][g][2] = w0[2]; wv[rb][g][3] = w0[3]; wv[rb][g][4] = w1[0]; wv[rb][g][5] = w1[1]; wv[rb][g][6] = w1[2]; wv[rb][g][7] = w1[3]; } }
    const int lkey = tid & 63, lch = tid >> 6;
    const bf16_t* ksrc = ik + ((size_t)b * SEQ + lkey) * 64 + lch * 8;
    LAS unsigned char* kdst = C.lds + (lch * 64 + lkey) * 16;
    const int NT = qb + 1;
    u32x4 rk = *(const u32x4*)ksrc;
    *(LAS u32x4*)kdst = rk;
    __syncthreads();
    for (int kt = 0; kt < NT; ++kt) {
        const int cur = kt & 1;
        if (kt + 1 < NT) rk = *(const u32x4*)(ksrc + (size_t)(kt + 1) * 64 * 64);
        const LAS unsigned char* kb = C.lds + cur * 8192;
        bf16x8 bfr[2][4];
#pragma unroll
        for (int kbk = 0; kbk < 2; ++kbk)
#pragma unroll
            for (int ks = 0; ks < 4; ++ks) bfr[kbk][ks] = *(const LAS bf16x8*)(kb + ((2 * ks + hi) * 64 + kbk * 32 + r32) * 16);
#pragma unroll
        for (int rb = 0; rb < 2; ++rb)
#pragma unroll
            for (int kbk = 0; kbk < 2; ++kbk) {
                f32x16 a = {};
#pragma unroll
                for (int ks = 0; ks < 4; ++ks) a = __builtin_amdgcn_mfma_f32_32x32x16_bf16(af[rb][ks], bfr[kbk][ks], a, 0, 0, 0);
#pragma unroll
                for (int g = 0; g < 2; ++g) { float s = 0.f;
#pragma unroll
                    for (int hh = 0; hh < 8; ++hh) s = fmaf(fmaxf(a[8 * g + hh], 0.f), wv[rb][g][hh], s);
                    const size_t tq = (size_t)b * SEQ + qb * 64 + wid * 8 + rb * 4 + 2 * g + hi;
                    score[tq * SEQ + kt * 64 + kbk * 32 + r32] = s; } }
        if (kt + 1 < NT) *(LAS u32x4*)(kdst + (cur ^ 1) * 8192) = rk;
        __syncthreads();
    }
}
__device__ __forceinline__ void phase_indexer(const Ctx& C) {
    for (int u0 = C.bid; u0 < NB * 32; u0 += C.G) {
        int u = u0; if (C.G == NB * 32) u = (C.bid & 7) * 32 + (C.bid >> 3);
        const int b = u >> 5, p = u & 31; idx_block(C, b, p); idx_block(C, b, 63 - p); }
}

__device__ __forceinline__ unsigned f2key(float f) { const unsigned u = __float_as_uint(f); return (u & 0x80000000u) ? ~u : (u | 0x80000000u); }
__device__ __forceinline__ int wave_total7(unsigned cv) {
    int t = 0;
#pragma unroll
    for (int b = 0; b < 7; ++b) t += __popcll(__ballot((cv >> b) & 1u)) << b;
    return t;
}
template <int NG>
__device__ __forceinline__ unsigned select_radix(const unsigned (&u)[64]) {
    unsigned prefix = 0u;
    for (int bit = 31; bit >= 0; --bit) {
        const unsigned cand = prefix | (1u << bit); unsigned cv = 0u;
#pragma unroll
        for (int i = 0; i < NG * 8; ++i) cv += (u[i] >= cand) ? 1u : 0u;
        const int cnt = wave_total7(cv);
        if (cnt >= 256) prefix = cand;
        if (cnt == 256) break;
    }
    return prefix;
}
__device__ __forceinline__ int wave_sum_dpp(int x) {
    x += __builtin_amdgcn_update_dpp(0, x, 0xB1, 0xf, 0xf, true);
    x += __builtin_amdgcn_update_dpp(0, x, 0x4E, 0xf, 0xf, true);
    x += __builtin_amdgcn_update_dpp(0, x, 0x141, 0xf, 0xf, true);
    x += __builtin_amdgcn_update_dpp(0, x, 0x140, 0xf, 0xf, true);
    x += __builtin_amdgcn_update_dpp(0, x, 0x142, 0xa, 0xf, false);
    x += __builtin_amdgcn_update_dpp(0, x, 0x143, 0xc, 0xf, false);
    return __builtin_amdgcn_readlane(x, 63);
}
__device__ __forceinline__ unsigned bfi32(unsigned m, unsigned x, unsigned y) { return (m & x) | (~m & y); }
__device__ __forceinline__ void bit_transpose32(unsigned* a) {
#pragma unroll
    for (int k = 0; k < 16; ++k) { const unsigned x = a[k], y = a[k + 16]; a[k] = __builtin_amdgcn_perm(y, x, 0x05040100u); a[k + 16] = __builtin_amdgcn_perm(y, x, 0x07060302u); }
#pragma unroll
    for (int k = 0; k < 32; ++k) if ((k & 8) == 0) { const unsigned x = a[k], y = a[k + 8]; a[k] = __builtin_amdgcn_perm(y, x, 0x06020400u); a[k + 8] = __builtin_amdgcn_perm(y, x, 0x07030501u); }
#pragma unroll
    for (int k = 0; k < 32; ++k) if ((k & 4) == 0) { const unsigned x = a[k], y = a[k + 4]; a[k] = bfi32(0x0f0f0f0fu, x, y << 4); a[k + 4] = bfi32(0x0f0f0f0fu, x >> 4, y); }
#pragma unroll
    for (int k = 0; k < 32; ++k) if ((k & 2) == 0) { const unsigned x = a[k], y = a[k + 2]; a[k] = bfi32(0x33333333u, x, y << 2); a[k + 2] = bfi32(0x33333333u, x >> 2, y); }
#pragma unroll
    for (int k = 0; k < 32; ++k) if ((k & 1) == 0) { const unsigned x = a[k], y = a[k + 1]; a[k] = bfi32(0x55555555u, x, y << 1); a[k + 1] = bfi32(0x55555555u, x >> 1, y); }
}
template <int NW>
__device__ __forceinline__ void select_bits(const float* row, int n, unsigned* mrow, int lane) {
    constexpr int W = 32 * NW;
    unsigned a[W];
    {   const u32x4* src = (const u32x4*)(row + lane * W);
#pragma unroll
        for (int i = 0; i < W / 4; ++i) { const u32x4 v = src[i];
#pragma unroll
            for (int j = 0; j < 4; ++j) { const unsigned u = v[j]; a[4 * i + j] = u ^ ((unsigned)((int)u >> 31) | 0x80000000u); } }
    }
#pragma unroll
    for (int blk = 0; blk < NW; ++blk) bit_transpose32(a + 32 * blk);
    unsigned alive[NW], above[NW];
#pragma unroll
    for (int w = 0; w < NW; ++w) { const int nv = n - lane * W - 32 * w; alive[w] = nv >= 32 ? 0xffffffffu : (nv <= 0 ? 0u : ((1u << nv) - 1u)); above[w] = 0u; }
    int cnta = 0; bool exact = false;
#pragma unroll
    for (int b = 31; b >= 0; --b) {
        unsigned o[NW]; int pc = 0;
#pragma unroll
        for (int w = 0; w < NW; ++w) { o[w] = alive[w] & a[32 * w + b]; pc += __popc(o[w]); }
        const int tot = cnta + wave_sum_dpp(pc);
        if (tot >= 256) {
#pragma unroll
            for (int w = 0; w < NW; ++w) alive[w] = o[w];
            if (tot == 256) { exact = true; break; }
        } else {
#pragma unroll
            for (int w = 0; w < NW; ++w) { above[w] |= o[w]; alive[w] ^= o[w]; }
            cnta = tot;
        }
    }
    if (!exact) {
        int pc = 0;
#pragma unroll
        for (int w = 0; w < NW; ++w) pc += __popc(alive[w]);
        const int ceq = wave_sum_dpp(pc), need = 256 - cnta;
        if (ceq > need) {
            int excl = 0;
#pragma unroll 1
            for (int L = 0; L < 63; ++L) { const int v = __builtin_amdgcn_readlane(pc, L); excl += (lane > L) ? v : 0; }
            int take = need - excl; take = take < 0 ? 0 : (take > pc ? pc : take);
            int c = pc;
            if (NW == 2) { while (c > take && alive[NW - 1] != 0u) { alive[NW - 1] &= ~(0x80000000u >> __clz(alive[NW - 1])); --c; } }
            while (c > take) { alive[0] &= ~(0x80000000u >> __clz(alive[0])); --c; }
        }
    }
    if (NW == 2) { u32x2 m; m.x = above[0] | alive[0]; m.y = above[NW - 1] | alive[NW - 1]; *(u32x2*)(mrow + 2 * lane) = m; }
    else { mrow[lane] = above[0] | alive[0]; mrow[64 + lane] = 0u; }
}
__device__ __forceinline__ void phase_select(const Ctx& C) {
    const float* score = WSP(float, WS_SCORE); unsigned long long* mask = WSP(unsigned long long, WS_MASK);
    const int gw = C.bid * NWAVES + C.wave, NGW = C.G * NWAVES, lane = C.lane;
    for (int idx = gw; idx < NTOK; idx += NGW) {
        const int q = idx & (SEQ - 1); const int n = q + 1; const float* row = score + (size_t)idx * SEQ;
        if (n <= 256) {
            const int lo = n - 64 * lane;
            const unsigned long long m = lo >= 64 ? ~0ull : (lo <= 0 ? 0ull : ((1ull << lo) - 1ull));
            mask[(size_t)idx * 64 + lane] = m;
        } else if (n <= 2048) select_bits<1>(row, n, (unsigned*)(mask + (size_t)idx * 64), lane);
        else select_bits<2>(row, n, (unsigned*)(mask + (size_t)idx * 64), lane);
    }
}

__device__ __forceinline__ int crow(int r, int hi) { return (r & 3) + 8 * (r >> 2) + 4 * hi; }
template <int DQK, bool MASKED>
__device__ __forceinline__ void attn_unit(const Ctx& C, int b, int h, int qb, const bf16_t* Q, const bf16_t* K, const bf16_t* VT, const unsigned* mask, bf16_t* O) {
    constexpr int NKS = DQK / 16, NCH = DQK / 8, KTB = NCH * 1024, BUF = KTB + 8192, QS = 8 * DQK;
    const int tid = C.tid, lane = C.lane, wid = C.wave, r32 = lane & 31, hi = lane >> 5;
    const int NT = 4 * (qb + 1);
    const size_t tok = (size_t)b * SEQ + qb * 256 + wid * 32 + r32;
    bf16x8 qf[NKS];
#pragma unroll
    for (int ks = 0; ks < NKS; ++ks) qf[ks] = *(const bf16x8*)(Q + tok * QS + h * DQK + ks * 16 + hi * 8);
    const int lrow = tid & 63, lch = tid >> 6;
    const bf16_t* ksrc0 = K + ((size_t)b * SEQ + lrow) * QS + h * DQK + lch * 8;
    const bf16_t* ksrc1 = ksrc0 + 64;
    const bf16_t* vsrc = VT + ((size_t)(b * 8 + h) * 64 + lrow) * SEQ + lch * 8;
    LAS unsigned char* kd0 = C.lds + (lch * 64 + lrow) * 16;
    LAS unsigned char* kd1 = C.lds + ((8 + lch) * 64 + lrow) * 16;
    LAS unsigned char* vd = C.lds + KTB + (lch * 64 + lrow) * 16;
    const bool k1 = (DQK > 64) && (tid < 256);
    u32x4 rk0, rk1 = {0u, 0u, 0u, 0u}, rv;
    rk0 = *(const u32x4*)ksrc0; if (k1) rk1 = *(const u32x4*)ksrc1; rv = *(const u32x4*)vsrc;
    *(LAS u32x4*)kd0 = rk0; if (k1) *(LAS u32x4*)kd1 = rk1; *(LAS u32x4*)vd = rv;
    u32x2 mw = {0u, 0u};
    if (MASKED) mw = *(const u32x2*)(mask + tok * 128);
    float mbias = 0.f, thr = -1e30f, lsum = 0.f;
    u32x4 qmw = {0u, 0u, 0u, 0u};
    const bf16x8 kone = __builtin_bit_cast(bf16x8, (u32x4){hi == 0 ? 0x3F80u : 0u, 0u, 0u, 0u});
    f32x16 o0 = {}, o1 = {};
    __syncthreads();
    for (int kt = 0; kt < NT; ++kt) {
        const int cur = kt & 1;
        u32x2 mwn = {0u, 0u};
        if (kt + 1 < NT) {
            rk0 = *(const u32x4*)(ksrc0 + (size_t)(kt + 1) * 64 * QS); if (k1) rk1 = *(const u32x4*)(ksrc1 + (size_t)(kt + 1) * 64 * QS);
            rv = *(const u32x4*)(vsrc + (kt + 1) * 64);
            if (MASKED) mwn = *(const u32x2*)(mask + tok * 128 + 2 * (kt + 1));
        }
        const LAS unsigned char* kb = C.lds + cur * BUF; const LAS unsigned char* vb = kb + KTB;
        f32x16 p0 = {}, p1 = {};
        bf16x8 kf[2 * NKS], vf[8];
#pragma unroll
        for (int ks = 0; ks < NKS; ++ks) {
            kf[2 * ks] = *(const LAS bf16x8*)(kb + ((2 * ks + hi) * 64 + r32) * 16);
            kf[2 * ks + 1] = *(const LAS bf16x8*)(kb + ((2 * ks + hi) * 64 + 32 + r32) * 16);
        }
#pragma unroll
        for (int s4 = 0; s4 < 4; ++s4) {
            vf[2 * s4] = *(const LAS bf16x8*)(vb + ((2 * s4 + hi) * 64 + r32) * 16);
            vf[2 * s4 + 1] = *(const LAS bf16x8*)(vb + ((2 * s4 + hi) * 64 + 32 + r32) * 16);
        }
        __builtin_amdgcn_sched_barrier(0);
#pragma unroll
        for (int ks = 0; ks < NKS; ++ks) {
            p0 = __builtin_amdgcn_mfma_f32_32x32x16_bf16(kf[2 * ks], qf[ks], p0, 0, 0, 0);
            p1 = __builtin_amdgcn_mfma_f32_32x32x16_bf16(kf[2 * ks + 1], qf[ks], p1, 0, 0, 0);
        }
        { const bf16x8 qm = __builtin_bit_cast(bf16x8, qmw);
          p0 = __builtin_amdgcn_mfma_f32_32x32x16_bf16(kone, qm, p0, 0, 0, 0); p1 = __builtin_amdgcn_mfma_f32_32x32x16_bf16(kone, qm, p1, 0, 0, 0); }
        if (MASKED) {
            const unsigned w0 = mw.x >> (4 * hi), w1 = mw.y >> (4 * hi);
#pragma unroll
            for (int r = 0; r < 16; ++r) { const int bit = (r & 3) + 8 * (r >> 2);
                const unsigned t0 = (unsigned)__builtin_amdgcn_sbfe((int)w0, bit, 1), t1 = (unsigned)__builtin_amdgcn_sbfe((int)w1, bit, 1);
                p0[r] = __uint_as_float((__float_as_uint(p0[r]) & t0) | (~t0 & 0xFF800000u));
                p1[r] = __uint_as_float((__float_as_uint(p1[r]) & t1) | (~t1 & 0xFF800000u)); }
        } else {
            if (kt >= NT - 4) { const int kb0 = (kt - (NT - 4)) * 64, qrel = wid * 32 + r32;
#pragma unroll
                for (int r = 0; r < 16; ++r) { const int kv = kb0 + crow(r, hi); if (kv > qrel) p0[r] = -INFINITY; if (kv + 32 > qrel) p1[r] = -INFINITY; } }
        }
        float mx;
        { float a0 = fmaxf(fmaxf(p0[0], p0[1]), p0[2]), a1 = fmaxf(fmaxf(p0[3], p0[4]), p0[5]), a2 = fmaxf(fmaxf(p0[6], p0[7]), p0[8]), a3 = fmaxf(fmaxf(p0[9], p0[10]), p0[11]);
          float a4 = fmaxf(fmaxf(p0[12], p0[13]), p0[14]), a5 = fmaxf(fmaxf(p0[15], p1[0]), p1[1]), a6 = fmaxf(fmaxf(p1[2], p1[3]), p1[4]), a7 = fmaxf(fmaxf(p1[5], p1[6]), p1[7]);
          float a8 = fmaxf(fmaxf(p1[8], p1[9]), p1[10]), a9 = fmaxf(fmaxf(p1[11], p1[12]), p1[13]), a10 = fmaxf(p1[14], p1[15]);
          a0 = fmaxf(fmaxf(a0, a1), a2); a3 = fmaxf(fmaxf(a3, a4), a5); a6 = fmaxf(fmaxf(a6, a7), a8); a9 = fmaxf(a9, a10);
          mx = fmaxf(fmaxf(a0, a3), fmaxf(a6, a9)); }
        mx = xmax32(mx);
        if (__any(mx > thr)) {
            const bool upd = mx > thr;
            const float mnew = upd ? __uint_as_float(pk2(mbias + mx, 0.f) << 16) : mbias;
            const float delta = mnew - mbias; const float alpha = (thr < 0.f) ? 1.f : __builtin_amdgcn_exp2f(-delta);
            mbias = mnew; thr = upd ? 4.f : thr;
            qmw.x = hi == 0 ? (pk2(-mnew, 0.f) & 0xffffu) : 0u;
            lsum *= alpha;
#pragma unroll
            for (int r = 0; r < 16; ++r) { o0[r] *= alpha; o1[r] *= alpha; p0[r] -= delta; p1[r] -= delta; }
        }
        {
#pragma unroll
            for (int r = 0; r < 16; ++r) { p0[r] = __builtin_amdgcn_exp2f(p0[r]); p1[r] = __builtin_amdgcn_exp2f(p1[r]); }
            float s0 = (p0[0] + p0[1]) + (p0[2] + p0[3]), s1 = (p0[4] + p0[5]) + (p0[6] + p0[7]), s2 = (p0[8] + p0[9]) + (p0[10] + p0[11]), s3 = (p0[12] + p0[13]) + (p0[14] + p0[15]);
            float s4 = (p1[0] + p1[1]) + (p1[2] + p1[3]), s5 = (p1[4] + p1[5]) + (p1[6] + p1[7]), s6 = (p1[8] + p1[9]) + (p1[10] + p1[11]), s7 = (p1[12] + p1[13]) + (p1[14] + p1[15]);
            lsum += ((s0 + s1) + (s2 + s3)) + ((s4 + s5) + (s6 + s7));
        }
        bf16x8 pf[4];
        { u32x4 t;
          t.x = pk2(p0[0], p0[1]); t.y = pk2(p0[2], p0[3]); t.z = pk2(p0[4], p0[5]); t.w = pk2(p0[6], p0[7]); pf[0] = __builtin_bit_cast(bf16x8, t);
          t.x = pk2(p0[8], p0[9]); t.y = pk2(p0[10], p0[11]); t.z = pk2(p0[12], p0[13]); t.w = pk2(p0[14], p0[15]); pf[1] = __builtin_bit_cast(bf16x8, t);
          t.x = pk2(p1[0], p1[1]); t.y = pk2(p1[2], p1[3]); t.z = pk2(p1[4], p1[5]); t.w = pk2(p1[6], p1[7]); pf[2] = __builtin_bit_cast(bf16x8, t);
          t.x = pk2(p1[8], p1[9]); t.y = pk2(p1[10], p1[11]); t.z = pk2(p1[12], p1[13]); t.w = pk2(p1[14], p1[15]); pf[3] = __builtin_bit_cast(bf16x8, t); }
#pragma unroll
        for (int s = 0; s < 4; ++s) {
            o0 = __builtin_amdgcn_mfma_f32_32x32x16_bf16(vf[2 * s], pf[s], o0, 0, 0, 0);
            o1 = __builtin_amdgcn_mfma_f32_32x32x16_bf16(vf[2 * s + 1], pf[s], o1, 0, 0, 0);
        }
        if (kt + 1 < NT) {
            const int nb = (cur ^ 1) * BUF;
            *(LAS u32x4*)(kd0 + nb) = rk0; if (k1) *(LAS u32x4*)(kd1 + nb) = rk1; *(LAS u32x4*)(vd + nb) = rv;
        }
        mw = mwn;
        __syncthreads();
    }
    lsum = xsum32(lsum);
    const float inv = 1.f / lsum;
    bf16_t* op = O + tok * 512 + h * 64 + 4 * hi;
#pragma unroll
    for (int i = 0; i < 4; ++i) {
        st_bf4(op + 8 * i, (f32x4){o0[4 * i] * inv, o0[4 * i + 1] * inv, o0[4 * i + 2] * inv, o0[4 * i + 3] * inv});
        st_bf4(op + 32 + 8 * i, (f32x4){o1[4 * i] * inv, o1[4 * i + 1] * inv, o1[4 * i + 2] * inv, o1[4 * i + 3] * inv});
    }
}
template <int DQK, bool MASKED>
__device__ __forceinline__ void phase_attn(const Ctx& C, const bf16_t* Q, const bf16_t* K, const bf16_t* VT, const unsigned* mask, bf16_t* O) {
    for (int u0 = C.bid; u0 < NB * 8 * 8; u0 += C.G) {
        int u = u0; if ((C.G & 7) == 0) { const int r = (C.bid >> 3) + (C.G >> 3) * (u0 / C.G); u = ((C.bid & 7) * 8 + (r >> 3)) * 8 + (r & 7); if (u >= NB * 8 * 8) u = u0; }
        const int bh = u >> 3, p = u & 7, b = bh >> 3, h = bh & 7;
        attn_unit<DQK, MASKED>(C, b, h, 15 - p, Q, K, VT, mask, O);
        attn_unit<DQK, MASKED>(C, b, h, p, Q, K, VT, mask, O); }
}

__device__ __forceinline__ void phase_gmlp(const Ctx& C, const float* lng, const float* lnb, const float* bs, int l) {
    const bf16_t* U = WSP(bf16_t, WS_U); const bf16_t* V = WSP(bf16_t, WS_V); bf16_t* OB = WSP(bf16_t, WS_OBUF) + (size_t)NTOK * 512;
    const bf16_t* WG = WSP(bf16_t, WS_WGM + l * SZ_WGM);
    const int tid = C.tid, lane = C.lane, wid = C.wave, r32 = lane & 31, hi = lane >> 5;
    constexpr int VST = 136;
    LAS bf16_t* vT = (LAS bf16_t*)C.lds;
    for (int un = C.bid; un < 512; un += C.G) {
        const int hf = un & 1, ch = un >> 1; const size_t t0 = (size_t)ch * 128;
        { const int pos = tid >> 2, q = tid & 3; const bf16_t* vr = V + (t0 + pos) * 512 + q * 32;
          float s = 0.f;
#pragma unroll
          for (int i = 0; i < 4; ++i)
#pragma unroll
              for (int j = 0; j < 4; ++j) { const u32x4 w = *(const u32x4*)(vr + i * 128 + j * 8); s += ((bflo(w.x) + bfhi(w.x)) + (bflo(w.y) + bfhi(w.y))) + ((bflo(w.z) + bfhi(w.z)) + (bflo(w.w) + bfhi(w.w))); }
          s += xswz<1>(s); s += xswz<2>(s);
          const float mean = s * (1.f / 512.f); float qv = 0.f;
          asm volatile("" ::: "memory");
#pragma unroll
          for (int i = 0; i < 4; ++i)
#pragma unroll
              for (int j = 0; j < 4; ++j) { const u32x4 w = *(const u32x4*)(vr + i * 128 + j * 8); float d;
                  d = bflo(w.x) - mean; qv += d * d; d = bfhi(w.x) - mean; qv += d * d; d = bflo(w.y) - mean; qv += d * d; d = bfhi(w.y) - mean; qv += d * d;
                  d = bflo(w.z) - mean; qv += d * d; d = bfhi(w.z) - mean; qv += d * d; d = bflo(w.w) - mean; qv += d * d; d = bfhi(w.w) - mean; qv += d * d; }
          qv += xswz<1>(qv); qv += xswz<2>(qv);
          const float rstd = rsqrtf(qv * (1.f / 512.f) + LN_EPS);
          asm volatile("" ::: "memory");
          const bf16_t* vh = vr + hf * 256;
#pragma unroll
          for (int ii = 0; ii < 2; ++ii)
#pragma unroll
              for (int j = 0; j < 4; ++j) { const u32x4 w = *(const u32x4*)(vh + ii * 128 + j * 8);
                  const int cl = ii * 128 + q * 32 + j * 8; const int c0 = hf * 256 + cl;
                  const f32x4 g0 = *(const f32x4*)(lng + c0), g1 = *(const f32x4*)(lng + c0 + 4), b0 = *(const f32x4*)(lnb + c0), b1 = *(const f32x4*)(lnb + c0 + 4);
                  LAS bf16_t* dp = vT + cl * VST + pos;
                  dp[0 * VST] = (bf16_t)(pk2((bflo(w.x) - mean) * rstd * g0[0] + b0[0], 0.f) & 0xffff);
                  dp[1 * VST] = (bf16_t)(pk2((bfhi(w.x) - mean) * rstd * g0[1] + b0[1], 0.f) & 0xffff);
                  dp[2 * VST] = (bf16_t)(pk2((bflo(w.y) - mean) * rstd * g0[2] + b0[2], 0.f) & 0xffff);
                  dp[3 * VST] = (bf16_t)(pk2((bfhi(w.y) - mean) * rstd * g0[3] + b0[3], 0.f) & 0xffff);
                  dp[4 * VST] = (bf16_t)(pk2((bflo(w.z) - mean) * rstd * g1[0] + b1[0], 0.f) & 0xffff);
                  dp[5 * VST] = (bf16_t)(pk2((bfhi(w.z) - mean) * rstd * g1[1] + b1[1], 0.f) & 0xffff);
                  dp[6 * VST] = (bf16_t)(pk2((bflo(w.w) - mean) * rstd * g1[2] + b1[2], 0.f) & 0xffff);
                  dp[7 * VST] = (bf16_t)(pk2((bfhi(w.w) - mean) * rstd * g1[3] + b1[3], 0.f) & 0xffff); } }
        __syncthreads();
        { const int gl = wid >> 1, ih = wid & 1, g = 4 * hf + gl;
          f32x16 acc[2][2] = {};
          const int nks = 4 * (ih + 1);
          const bf16_t* wrow = WG + ((size_t)g * 128 + ih * 64 + r32) * 128 + hi * 8;
          for (int ks = 0; ks < nks; ++ks) {
              bf16x8 a[2], bb[2];
#pragma unroll
              for (int mb = 0; mb < 2; ++mb) a[mb] = *(const bf16x8*)(wrow + (size_t)mb * 32 * 128 + ks * 16);
#pragma unroll
              for (int nb = 0; nb < 2; ++nb) bb[nb] = *(const LAS bf16x8*)(vT + (gl * 64 + nb * 32 + r32) * VST + ks * 16 + hi * 8);
#pragma unroll
              for (int mb = 0; mb < 2; ++mb)
#pragma unroll
                  for (int nb = 0; nb < 2; ++nb) acc[mb][nb] = __builtin_amdgcn_mfma_f32_32x32x16_bf16(a[mb], bb[nb], acc[mb][nb], 0, 0, 0);
          }
#pragma unroll
          for (int mb = 0; mb < 2; ++mb)
#pragma unroll
              for (int r = 0; r < 16; ++r) { const int i = ih * 64 + mb * 32 + crow(r, hi); const float bi = bs[g * 128 + i];
#pragma unroll
                  for (int nb = 0; nb < 2; ++nb) { const size_t o = (t0 + i) * 512 + g * 64 + nb * 32 + r32;
                      const float uu = bf2f(U[o]); OB[o] = (bf16_t)(pk2(uu * (acc[mb][nb][r] + bi), 0.f) & 0xffff); } } }
        __syncthreads();
    }
}

__device__ __forceinline__ void phase_ln1_router(const Ctx& C, const float* g1, const float* b1, const float* rw, const float* rbias, int l, bool dry) {
    constexpr int RST = 1028;
    LAS float* rwT = (LAS float*)C.lds;
    LAS float* gws = (LAS float*)(C.lds + 32 * RST * 4);
    LAS float* bws = gws + 32;
    LAS float* stat = bws + 32;
    LAS int* trec = (LAS int*)(C.lds + MISC_OFF + 64);
    LAS int* tpos = trec + 512;
    const int tid = C.tid, lane = C.lane, wid = C.wave;
    const bf16_t* xin = WSP(bf16_t, WS_XB); const bf16_t* yo = WSP(bf16_t, WS_OBUF); bf16_t* xb = dry ? WSP(bf16_t, WS_DRY + (size_t)NTOK * DM * 4) : WSP(bf16_t, WS_XB);
    int* tke = dry ? WSP(int, WS_DRY + (size_t)NTOK * DM * 6) : WSP(int, WS_TKE); int* tkp = dry ? WSP(int, WS_DRY + (size_t)NTOK * DM * 6 + NSLOT * 4) : WSP(int, WS_TKP); float* tkw = dry ? WSP(float, WS_DRY + (size_t)NTOK * DM * 6 + NSLOT * 8) : WSP(float, WS_TKW);
    int* ccnt = dry ? WSP(int, WS_DRY + (size_t)NTOK * DM * 6 + NSLOT * 12) : WSP(int, WS_CCNT);
    {
        const float* rwg = WSP(float, WS_RWT) + (size_t)l * 32 * 1024;
#pragma unroll
        for (int q = 0; q < 16; ++q) { const int piece = wid * 16 + q, e = piece >> 2, part = piece & 3;
            __builtin_amdgcn_global_load_lds((const unsigned*)(rwg + e * 1024 + part * 256 + lane * 4), (LAS unsigned*)(C.lds + (e * RST + part * 256) * 4), 16, 0, 0); }
        if (tid < 64) gws[tid] = WSP(float, WS_GBW)[l * 64 + tid];
        asm volatile("s_waitcnt vmcnt(0)" ::: "memory");
    }
    __syncthreads();
    const int fr = lane & 15, fq = lane >> 4;
    for (int chunk = C.bid; chunk < NTOK / 128; chunk += C.G) {
        __syncthreads();
        const size_t tok0 = (size_t)chunk * 128 + wid * 16;
        f32x4 acc0 = {0.f, 0.f, 0.f, 0.f}, acc1 = {0.f, 0.f, 0.f, 0.f};
        u32x2 zp[64]; float s1 = 0.f, s2 = 0.f;
        { const bf16_t* zr = xin + (tok0 + fr) * 1024 + 4 * fq; const bf16_t* yr = yo + (tok0 + fr) * 1024 + 4 * fq; const LAS float* w0 = rwT + fr * RST + 4 * fq; const LAS float* w1 = rwT + (16 + fr) * RST + 4 * fq;
#pragma unroll
          for (int sI = 0; sI < 64; ++sI) { const u32x2 hw = *(const u32x2*)(zr + 16 * sI); const f32x4 h4 = {bflo(hw.x), bfhi(hw.x), bflo(hw.y), bfhi(hw.y)}; const u32x2 yw = *(const u32x2*)(yr + 16 * sI);
              const f32x4 a4 = h4 * DN_ALPHA + (f32x4){bflo(yw.x), bfhi(yw.x), bflo(yw.y), bfhi(yw.y)};
              s1 += (a4[0] + a4[1]) + (a4[2] + a4[3]); s2 += (a4[0] * a4[0] + a4[1] * a4[1]) + (a4[2] * a4[2] + a4[3] * a4[3]);
              u32x2 zz; zz.x = pk2(a4[0], a4[1]); zz.y = pk2(a4[2], a4[3]); zp[sI] = zz;
              const f32x4 b0 = *(const LAS f32x4*)(w0 + 16 * sI), b1v = *(const LAS f32x4*)(w1 + 16 * sI);
#pragma unroll
              for (int j = 0; j < 4; ++j) { acc0 = __builtin_amdgcn_mfma_f32_16x16x4f32(a4[j], b0[j], acc0, 0, 0, 0); acc1 = __builtin_amdgcn_mfma_f32_16x16x4f32(a4[j], b1v[j], acc1, 0, 0, 0); }
              if ((sI & 3) == 3) __builtin_amdgcn_sched_barrier(0); } }
        s1 += xswz<16>(s1); s1 = xsum32(s1); s2 += xswz<16>(s2); s2 = xsum32(s2);
        const float mean = s1 * (1.f / 1024.f); const float rstd = rsqrtf(fmaxf(s2 * (1.f / 1024.f) - mean * mean, 0.f) + LN_EPS);
        { u32x2* xo = (u32x2*)(xb + (tok0 + fr) * 1024 + 4 * fq); const float* gp = g1 + 4 * fq; const float* bp = b1 + 4 * fq;
#pragma unroll
          for (int sI = 0; sI < 64; ++sI) { const f32x4 g4 = *(const f32x4*)(gp + 16 * sI), b4 = *(const f32x4*)(bp + 16 * sI); const u32x2 zz = zp[sI];
              const f32x4 z4 = {bflo(zz.x), bfhi(zz.x), bflo(zz.y), bfhi(zz.y)}; const f32x4 o = (z4 - mean) * rstd * g4 + b4;
              u32x2 w; w.x = pk2(o[0], o[1]); w.y = pk2(o[2], o[3]); xo[4 * sI] = w;
              if ((sI & 7) == 7) __builtin_amdgcn_sched_barrier(0); } }
        if (fq == 0) { stat[(wid * 16 + fr) * 2] = mean; stat[(wid * 16 + fr) * 2 + 1] = rstd; }
        LDS_WAIT();
        const float gw0 = gws[fr], gw1 = gws[16 + fr], bw0 = bws[fr], bw1 = bws[16 + fr];
#pragma unroll
        for (int r = 0; r < 4; ++r) {
            const int tl = wid * 16 + 4 * fq + r; const float mean = stat[tl * 2], rstd = stat[tl * 2 + 1];
            const float l0 = rstd * (acc0[r] - mean * gw0) + bw0, l1 = rstd * (acc1[r] - mean * gw1) + bw1;
            unsigned long long k0 = ((unsigned long long)f2key(l0) << 32) | (unsigned)(31 - fr), k1 = ((unsigned long long)f2key(l1) << 32) | (unsigned)(31 - (16 + fr));
            int te[4]; float tv[4];
#pragma unroll
            for (int k = 0; k < 4; ++k) {
                unsigned long long mxk = k0 > k1 ? k0 : k1;
#define MX_STEP(o) do { const unsigned long long ot = ((unsigned long long)xswzu<o>((unsigned)(mxk >> 32)) << 32) | xswzu<o>((unsigned)mxk); mxk = ot > mxk ? ot : mxk; } while (0)
                MX_STEP(1); MX_STEP(2); MX_STEP(4); MX_STEP(8);
#undef MX_STEP
                te[k] = 31 - (int)(mxk & 31ull); const unsigned ku = (unsigned)(mxk >> 32); tv[k] = __uint_as_float((ku & 0x80000000u) ? (ku & 0x7fffffffu) : ~ku);
                if (te[k] == fr) k0 = 0ull; if (te[k] == 16 + fr) k1 = 0ull;
            }
            const float e1 = __expf(tv[1] - tv[0]), e2 = __expf(tv[2] - tv[0]), e3 = __expf(tv[3] - tv[0]); const float inv = 1.f / (1.f + e1 + e2 + e3);
            if (fr == 0) {
                const float ww[4] = {inv, e1 * inv, e2 * inv, e3 * inv}; const size_t tok = (size_t)chunk * 128 + tl;
#pragma unroll
                for (int k = 0; k < 4; ++k) { trec[tl * 4 + k] = te[k]; tkw[tok * 4 + k] = ww[k]; }
            }
        }
        __syncthreads();
        if (tid < 32) { int c = 0; for (int r = 0; r < 512; ++r) { if (trec[r] == tid) { tpos[r] = c; ++c; } } ccnt[chunk * 32 + tid] = c; }
        __syncthreads();
        { const size_t o = (size_t)chunk * 512 + tid; tke[o] = trec[tid]; tkp[o] = tpos[tid]; }
        __syncthreads();
    }
}

__device__ __forceinline__ void moe_tables(const Ctx& C, int l) {
    LAS int* cnt = (LAS int*)(C.lds + MISC_OFF + 64); LAS int* tb = cnt + 32; LAS int* tile_e = tb + 40;
    const int* ccnt = WSP(int, WS_CCNT);
    {   LAS int* part = (LAS int*)C.lds;
        int a = 0;
#pragma unroll
        for (int k = 0; k < NTOK / 128 / 16; ++k) a += ccnt[((C.tid >> 5) + 16 * k) * 32 + (C.tid & 31)];
        part[C.tid] = a;
        __syncthreads();
        if (C.tid < 32) { int t = 0;
#pragma unroll
            for (int k = 0; k < 16; ++k) t += part[k * 32 + C.tid];
            cnt[C.tid] = t; }
    }
    __syncthreads();
    if (C.tid == 0) { int a = 0; for (int e = 0; e < 32; ++e) { tb[e] = a; a += (cnt[e] + 255) >> 8; } tb[32] = a; }
    __syncthreads();
    if (C.tid < 32) { for (int t = tb[C.tid]; t < tb[C.tid + 1]; ++t) tile_e[t] = C.tid; }
    __syncthreads();
}
__device__ __forceinline__ void phase_dispatch(const Ctx& C, int l) {
    moe_tables(C, l);
    LAS int* cnt = (LAS int*)(C.lds + MISC_OFF + 64); LAS int* tb = cnt + 32;
    const int* tke = WSP(int, WS_TKE); int* tkp = WSP(int, WS_TKP); int* stk = WSP(int, WS_STK);
    const int* ccnt = WSP(int, WS_CCNT);
    for (int ch = C.bid; ch < NSLOT / 512; ch += C.G) {
        LAS int* part = (LAS int*)C.lds; LAS int* cb = part + 512;
        int a = 0;
        for (int c = (C.tid >> 5); c < ch; c += 16) a += ccnt[c * 32 + (C.tid & 31)];
        part[C.tid] = a;
        __syncthreads();
        if (C.tid < 32) { int t = 0;
#pragma unroll
            for (int k = 0; k < 16; ++k) t += part[k * 32 + C.tid];
            cb[C.tid] = t; }
        __syncthreads();
        const int s = ch * 512 + C.tid;
        const int e = tke[s], p = cb[e] + tkp[s]; const int row = tb[e] * 256 + p;
        stk[row] = s >> 2; tkp[s] = row;
        __syncthreads();
    }
    for (int e = C.bid; e < 32; e += C.G) { const int r0 = tb[e] * 256 + cnt[e], r1 = tb[e + 1] * 256; for (int r = r0 + C.tid; r < r1; r += 512) stk[r] = 0; }
}

__device__ __forceinline__ void phase_ln2(const Ctx& C, const float* g2, const float* b2, float* outp, int l, bool dry) {
    const bf16_t* xin = WSP(bf16_t, WS_XB); bf16_t* xb = dry ? WSP(bf16_t, WS_DRY + (size_t)NTOK * DM * 4) : WSP(bf16_t, WS_XB); const bf16_t* y = WSP(bf16_t, WS_Y);
    const int* tkrow = WSP(int, WS_TKP); const float* tkw = WSP(float, WS_TKW);
    if (dry) outp = WSP(float, WS_DRY);
    const int gw = C.bid * NWAVES + C.wave, NGW = C.G * NWAVES, lane = C.lane;
    f32x4 gg[4], bb[4];
#pragma unroll
    for (int j = 0; j < 4; ++j) { gg[j] = *(const f32x4*)(g2 + 4 * (lane + 64 * j)); bb[j] = *(const f32x4*)(b2 + 4 * (lane + 64 * j)); }
    const bool last = (l == NLAYER - 1);
    for (int tok = gw; tok < NTOK; tok += NGW) {
        const u32x2* xr = (const u32x2*)(xin + (size_t)tok * 1024);
        f32x4 v[4]; float s = 0.f;
        int rk[4]; float wk[4];
#pragma unroll
        for (int k = 0; k < 4; ++k) { rk[k] = tkrow[(size_t)tok * 4 + k]; wk[k] = tkw[(size_t)tok * 4 + k]; }
#pragma unroll
        for (int j = 0; j < 4; ++j) { const u32x2 hw = xr[lane + 64 * j]; const f32x4 x1 = {bflo(hw.x), bfhi(hw.x), bflo(hw.y), bfhi(hw.y)}; f32x4 f[4];
#pragma unroll
            for (int k = 0; k < 4; ++k) { const u32x2 w = *(const u32x2*)(y + (size_t)rk[k] * 1024 + 4 * (lane + 64 * j)); f[k] = (f32x4){bflo(w.x), bfhi(w.x), bflo(w.y), bfhi(w.y)} * wk[k]; }
            v[j] = x1 * DN_ALPHA + ((f[0] + f[1]) + (f[2] + f[3]));
            s += (v[j][0] + v[j][1]) + (v[j][2] + v[j][3]); }
        const float mean = wave_sum(s) * (1.f / 1024.f); float s2 = 0.f;
#pragma unroll
        for (int j = 0; j < 4; ++j) { v[j] = v[j] - mean; s2 += (v[j][0] * v[j][0] + v[j][1] * v[j][1]) + (v[j][2] * v[j][2] + v[j][3] * v[j][3]); }
        const float rstd = rsqrtf(wave_sum(s2) * (1.f / 1024.f) + LN_EPS);
        if (last) { f32x4* orow = (f32x4*)(outp + (size_t)tok * 1024);
#pragma unroll
            for (int j = 0; j < 4; ++j) orow[lane + 64 * j] = v[j] * rstd * gg[j] + bb[j];
        } else { u32x2* xbr = (u32x2*)(xb + (size_t)tok * 1024);
#pragma unroll
            for (int j = 0; j < 4; ++j) { const f32x4 o = v[j] * rstd * gg[j] + bb[j]; u32x2 w; w.x = pk2(o[0], o[1]); w.y = pk2(o[2], o[3]); xbr[lane + 64 * j] = w; } }
    }
}

#ifdef DBG_STOP
__device__ __forceinline__ void dbg_dump(const Ctx& C, float* out) {
    const int gt = C.bid * 512 + C.tid, NGT = C.G * 512;
    const bf16_t* qa = WSP(bf16_t, WS_QA); const bf16_t* ka = WSP(bf16_t, WS_KA); const bf16_t* vat = WSP(bf16_t, WS_VAT); const bf16_t* iq = WSP(bf16_t, WS_IQ);
    const bf16_t* u = WSP(bf16_t, WS_U); const bf16_t* v = WSP(bf16_t, WS_V); const bf16_t* cdq = WSP(bf16_t, WS_CDQ); const bf16_t* cdkv = WSP(bf16_t, WS_CDKV);
    const bf16_t* gate = WSP(bf16_t, WS_GATE); const bf16_t* qc = WSP(bf16_t, WS_QC); const bf16_t* kc = WSP(bf16_t, WS_KC); const bf16_t* vct = WSP(bf16_t, WS_VCT);
    const unsigned* mask = WSP(unsigned, WS_MASK); const bf16_t* ob = WSP(bf16_t, WS_OBUF); const bf16_t* mg = WSP(bf16_t, WS_MERGED); const float* xr = WSP(float, WS_XRES);
    const bf16_t* y = WSP(bf16_t, WS_Y); const float* sc = WSP(float, WS_SCORE); const bf16_t* ik = WSP(bf16_t, WS_IK); const float* iw = WSP(float, WS_IW); const float* ssq = WSP(float, WS_SSQ);
    const bf16_t* hb = WSP(bf16_t, WS_H); const bf16_t* xg = WSP(bf16_t, WS_XG); const int* stk = WSP(int, WS_STK);
    for (size_t i = gt; i < (size_t)NTOK * DM; i += NGT) {
        const size_t h = i & ((size_t)NTOK * 512 - 1);
        float a = 0.f;
#if DBG_STOP >= 1
        a += bf2f(qa[h]) + bf2f(ka[h]) + bf2f(vat[h]) + bf2f(iq[h]) + bf2f(u[h]) + bf2f(v[h]) + bf2f(cdq[i & ((size_t)NTOK * 256 - 1)]) + bf2f(cdkv[i & ((size_t)NTOK * 256 - 1)]);
        a += bf2f(gate[i]) + bf2f(gate[i + (size_t)NTOK * DM]) + bf2f(gate[i + (size_t)2 * NTOK * DM]) + bf2f(ik[i & ((size_t)NTOK * 64 - 1)]) + iw[i & ((size_t)NTOK * 8 - 1)] + ssq[i & ((size_t)NTOK * 8 - 1)];
#endif
#if DBG_STOP >= 2
        a += bf2f(qc[i % ((size_t)NTOK * 768)]) + bf2f(kc[i % ((size_t)NTOK * 768)]) + bf2f(vct[h]) + bf2f(ob[(size_t)NTOK * 512 + h]);
#ifdef DBG_BITS
        a = (float)(__float_as_uint(sc[i]) & 0xfffu) + (float)(__float_as_uint(sc[i + (size_t)NTOK * DM]) & 0xfffu) + (float)(__float_as_uint(sc[i + (size_t)2 * NTOK * DM]) & 0xfffu) + (float)(__float_as_uint(sc[i + (size_t)3 * NTOK * DM]) & 0xfffu);
        a += (float)(iq[h] & 0xff) + (float)(ik[i & ((size_t)NTOK * 64 - 1)] & 0xff) + (float)(__float_as_uint(iw[i & ((size_t)NTOK * 8 - 1)]) & 0xfffu);
#else
        a += sc[i] + sc[i + (size_t)NTOK * DM] + sc[i + (size_t)2 * NTOK * DM] + sc[i + (size_t)3 * NTOK * DM];
#endif
#endif
#if DBG_STOP >= 3
        { const unsigned m = mask[i & ((size_t)NTOK * 128 - 1)]; a += (float)(m & 0xffffu) + (float)(m >> 16); } a += bf2f(ob[(size_t)2 * NTOK * 512 + h]);
#endif
#if DBG_STOP >= 4
        a += bf2f(ob[h]);
#endif
#if DBG_STOP >= 5
        a += bf2f(mg[i]);
#endif
#if DBG_STOP >= 6
        a += xr[i];
#endif
#if DBG_STOP >= 8
        a += (float)stk[i % (size_t)NSLOT_PAD] + bf2f(xg[i]) + bf2f(xg[i + (size_t)NTOK * DM]) + bf2f(xg[i + (size_t)2 * NTOK * DM]) + bf2f(xg[i + (size_t)3 * NTOK * DM]);
#endif
#if DBG_STOP >= 9
        a += bf2f(hb[i]) + bf2f(hb[i + (size_t)NTOK * DM]) + bf2f(hb[i + (size_t)2 * NTOK * DM]) + bf2f(hb[i + (size_t)3 * NTOK * DM]);
#endif
#if DBG_STOP >= 10
        a += bf2f(y[i]) + bf2f(y[i + (size_t)NTOK * DM]) + bf2f(y[i + (size_t)2 * NTOK * DM]) + bf2f(y[i + (size_t)3 * NTOK * DM]);
#endif
        out[i] = a;
    }
}
#endif

#ifdef DBG_CHECK
constexpr int CW_ERR = 20000;
__device__ __forceinline__ void err_max(unsigned* ctl, int k, float e) { if (!(e >= 0.f)) e = 1e30f; atomicMax(ctl + CW_ERR + k, __float_as_uint(e)); }
__device__ __forceinline__ float rope1(float x1, float x2, float c, float s_) { return x1 * c - x2 * s_; }
__device__ __forceinline__ float rope2(float x1, float x2, float c, float s_) { return x2 * c + x1 * s_; }
__device__ __forceinline__ void chk_proj(const Ctx& C, const Args& A) {
    unsigned* ctl = WSP(unsigned, WS_CTL); LAS float* pj = (LAS float*)C.lds;
    const int tok = (C.bid * 131 + 7) % NTOK; const int b = tok >> 12, sp = tok & 4095, ps = (sp & ~15) | perm16(sp & 15);
    const float* x = A.in[0] + (size_t)tok * DM; const float* w = A.in[2];
    for (int n = C.tid; n < 3560; n += 512) { float a = 0.f; for (int k = 0; k < DM; ++k) a = fmaf(x[k], w[(size_t)k * NIN_SRC + n], a); pj[n] = a; }
    __syncthreads();
    const float pos = (float)((const int*)A.in[1])[tok];
    const bf16_t* qa = WSP(bf16_t, WS_QA); const bf16_t* ka = WSP(bf16_t, WS_KA); const bf16_t* vat = WSP(bf16_t, WS_VAT); const bf16_t* iq = WSP(bf16_t, WS_IQ); const bf16_t* ik = WSP(bf16_t, WS_IK); const float* iw = WSP(float, WS_IW);
    float e = 0.f;
    for (int c = C.tid; c < 512; c += 512) { const int d = c & 63; const int base = c - d;
        float cq, ck, ci;
        if (d < 16) { const int i = d & 7; const float ang = pos * powf(500000.f, -(float)i / 8.f), cs = cosf(ang), sn = sinf(ang);
            const int o1 = base + i, o2 = base + 8 + i;
            cq = d < 8 ? rope1(pj[o1], pj[o2], cs, sn) : rope2(pj[o1], pj[o2], cs, sn);
            ck = d < 8 ? rope1(pj[512 + o1], pj[512 + o2], cs, sn) : rope2(pj[512 + o1], pj[512 + o2], cs, sn);
            ci = d < 8 ? rope1(pj[1536 + o1], pj[1536 + o2], cs, sn) : rope2(pj[1536 + o1], pj[1536 + o2], cs, sn);
        } else { cq = pj[c]; ck = pj[512 + c]; ci = pj[1536 + c]; }
        e = fmaxf(e, fabsf(bf2f(qa[(size_t)tok * 512 + c]) - cq * QSCALE_A)); e = fmaxf(e, fabsf(bf2f(ka[(size_t)tok * 512 + c]) - ck)); e = fmaxf(e, fabsf(bf2f(iq[(size_t)tok * 512 + c]) - ci));
        const int h = c >> 6; e = fmaxf(e, fabsf(bf2f(vat[((size_t)(b * 8 + h) * 64 + d) * SEQ + ps]) - pj[1024 + c]));
        if (c < 64) { float cik; if (c < 16) { const int i = c & 7; const float ang = pos * powf(500000.f, -(float)i / 8.f), cs = cosf(ang), sn = sinf(ang);
                cik = c < 8 ? rope1(pj[2048 + i], pj[2048 + 8 + i], cs, sn) : rope2(pj[2048 + i], pj[2048 + 8 + i], cs, sn); } else cik = pj[2048 + c];
            e = fmaxf(e, fabsf(bf2f(ik[(size_t)tok * 64 + c]) - cik)); }
        if (c < 8) e = fmaxf(e, 8.f * fabsf(iw[(size_t)tok * 8 + c] - pj[2112 + c] * IW_SCALE));
    }
    err_max(ctl, 0, e);
    __syncthreads();
    LAS float* cqn = pj + 3600; LAS float* ckn = cqn + 256;
    { float sq = 0.f; for (int k = 0; k < 256; ++k) sq += pj[3144 + k] * pj[3144 + k]; const float r = rsqrtf(sq / 256.f + RMS_EPS);
      float sk = 0.f; for (int k = 0; k < 128; ++k) sk += pj[3400 + k] * pj[3400 + k]; const float rk = rsqrtf(sk / 128.f + RMS_EPS);
      if (C.tid < 256) cqn[C.tid] = pj[3144 + C.tid] * r * A.in[7][C.tid]; if (C.tid < 128) ckn[C.tid] = pj[3400 + C.tid] * rk * A.in[8][C.tid]; }
    __syncthreads();
    const bf16_t* qc = WSP(bf16_t, WS_QC); const bf16_t* kc = WSP(bf16_t, WS_KC); const bf16_t* vct = WSP(bf16_t, WS_VCT);
    LAS float* qraw = ckn + 128;
    for (int n = C.tid; n < 768; n += 512) { float a = 0.f; for (int k = 0; k < 256; ++k) a = fmaf(cqn[k], A.in[9][(size_t)k * 768 + n], a); qraw[n] = a; }
    __syncthreads();
    float e2 = 0.f;
    for (int n = C.tid; n < 768; n += 512) { const int h = n / 96, d = n % 96; float v;
        if (d >= 64) { const int i = (d - 64) & 15; const float ang = pos * powf(500000.f, -(float)i / 16.f), cs = cosf(ang), sn = sinf(ang); const int o1 = h * 96 + 64 + i, o2 = o1 + 16;
            v = (d - 64) < 16 ? rope1(qraw[o1], qraw[o2], cs, sn) : rope2(qraw[o1], qraw[o2], cs, sn); } else v = qraw[n];
        e2 = fmaxf(e2, fabsf(bf2f(qc[(size_t)tok * 768 + n]) - v * QSCALE_C)); }
    for (int n = C.tid; n < 1024; n += 512) { float a = 0.f; for (int k = 0; k < 128; ++k) a = fmaf(ckn[k], A.in[10][(size_t)k * 1024 + n], a);
        const int h = n >> 7, wv = n & 127;
        if (wv < 64) e2 = fmaxf(e2, fabsf(bf2f(kc[(size_t)tok * 768 + h * 96 + wv]) - a));
        else e2 = fmaxf(e2, fabsf(bf2f(vct[((size_t)(b * 8 + h) * 64 + (wv - 64)) * SEQ + ps]) - a)); }
    if (C.tid < 32) { const int i = C.tid & 15; const float ang = pos * powf(500000.f, -(float)i / 16.f), cs = cosf(ang), sn = sinf(ang);
        const float v = C.tid < 16 ? rope1(pj[3528 + i], pj[3528 + 16 + i], cs, sn) : rope2(pj[3528 + i], pj[3528 + 16 + i], cs, sn);
        for (int h = 0; h < 8; ++h) e2 = fmaxf(e2, fabsf(bf2f(kc[(size_t)tok * 768 + h * 96 + 64 + C.tid]) - v)); }
    err_max(ctl, 1, e2);
    __syncthreads();
}
__device__ __forceinline__ void chk_attn(const Ctx& C) {
    unsigned* ctl = WSP(unsigned, WS_CTL);
    const int b = C.bid & 7, q = (C.bid * 977 + 300 + 13 * (C.bid >> 3)) & 4095; const size_t tq = (size_t)b * SEQ + q; const int n = q + 1;
    LAS float* sc = (LAS float*)C.lds;
    LAS float* pr = sc + 4096;
    LAS float* red = pr + 4096;
    const bf16_t* iq = WSP(bf16_t, WS_IQ); const bf16_t* ik = WSP(bf16_t, WS_IK); const float* iw = WSP(float, WS_IW); const float* score = WSP(float, WS_SCORE);
    float e1 = 0.f;
    for (int k = C.tid; k < n; k += 512) { float s_ = 0.f;
        for (int h = 0; h < 8; ++h) { float d = 0.f; for (int j = 0; j < 64; ++j) d = fmaf(bf2f(iq[tq * 512 + h * 64 + j]), bf2f(ik[((size_t)b * SEQ + k) * 64 + j]), d); s_ = fmaf(fmaxf(d, 0.f), iw[tq * 8 + h], s_); }
        sc[k] = s_; e1 = fmaxf(e1, fabsf(s_ - score[tq * SEQ + k])); }
    err_max(ctl, 2, e1);
    __syncthreads();
    const unsigned* mask = WSP(unsigned, WS_MASK); float e2 = 0.f;
    for (int k = C.tid; k < 4096; k += 512) { bool sel = false;
        if (k < n) { if (n <= 256) sel = true; else { const float sk = score[tq * SEQ + k]; int rank = 0; for (int j = 0; j < n; ++j) { const float sj = score[tq * SEQ + j]; rank += (sj > sk || (sj == sk && j < k)) ? 1 : 0; } sel = rank < 256; } }
        const bool mb = (mask[tq * 128 + (k >> 5)] >> (k & 31)) & 1u; if (sel != mb) e2 = 1.f; }
    err_max(ctl, 3, e2);
    const int h = (C.bid >> 3) & 7;
    for (int which = 0; which < 2; ++which) {
        const bf16_t* Q = which ? WSP(bf16_t, WS_QC) : WSP(bf16_t, WS_QA); const bf16_t* K = which ? WSP(bf16_t, WS_KC) : WSP(bf16_t, WS_KA); const bf16_t* VT = which ? WSP(bf16_t, WS_VCT) : WSP(bf16_t, WS_VAT);
        const bf16_t* O = WSP(bf16_t, WS_OBUF) + (which ? (size_t)2 * NTOK * 512 : 0); const int dq = which ? 96 : 64, qs = 8 * dq;
        __syncthreads();
        float mx = -INFINITY;
        for (int k = C.tid; k < 4096; k += 512) { float lgt = -INFINITY;
            const bool ok = k < n && (which || ((mask[tq * 128 + (k >> 5)] >> (k & 31)) & 1u));
            if (ok) { float d = 0.f; for (int j = 0; j < dq; ++j) d = fmaf(bf2f(Q[tq * qs + h * dq + j]), bf2f(K[((size_t)b * SEQ + k) * qs + h * dq + j]), d); lgt = d; }
            pr[k] = lgt; mx = fmaxf(mx, lgt); }
        red[C.tid] = mx; __syncthreads();
        if (C.tid == 0) { float m = -INFINITY; for (int i = 0; i < 512; ++i) m = fmaxf(m, red[i]); red[0] = m; } __syncthreads();
        const float m = red[0]; __syncthreads();
        float sm = 0.f; for (int k = C.tid; k < 4096; k += 512) { const float p = exp2f(pr[k] - m); pr[k] = p; sm += p; }
        red[C.tid] = sm; __syncthreads();
        if (C.tid == 0) { float t = 0.f; for (int i = 0; i < 512; ++i) t += red[i]; red[0] = t; } __syncthreads();
        const float den = red[0];
        if (C.tid < 64) { const int d = C.tid; float o = 0.f;
            for (int k = 0; k < n; ++k) { const int ps = (k & ~15) | perm16(k & 15); o = fmaf(pr[k], bf2f(VT[((size_t)(b * 8 + h) * 64 + d) * SEQ + ps]), o); }
            o /= den; err_max(ctl, 4 + which, fabsf(o - bf2f(O[tq * 512 + h * 64 + d]))); }
    }
    __syncthreads();
}
#endif

constexpr int NPH_LAYER = 11, NPHASE = 1 + NLAYER * NPH_LAYER;
__global__ void __launch_bounds__(NWAVES * 64, 2) trunk_fwd(Args args) {
    extern __shared__ __attribute__((aligned(16))) unsigned char lds_raw[];
    Ctx C;
    C.lds = (LAS unsigned char*)lds_raw; C.tid = threadIdx.x; C.lane = C.tid & 63; C.wave = __builtin_amdgcn_readfirstlane(C.tid >> 6); C.G = gridDim.x; C.bid = blockIdx.x; C.ws = args.ws;
    volatile LAS unsigned* MISC = (volatile LAS unsigned*)(C.lds + MISC_OFF);
    if (C.tid < 16) MISC[C.tid] = 0u;
    __syncthreads();
#if MK_ONE_LAUNCH
    XcdBarrier bar = xcd_barrier_post(WSP(unsigned, WS_CTL) + CW_BAR, MISC + 0);
#define GRID_BAR() do { FRESH(); XcdBarrier b_ = bar; { unsigned* bp_ = b_.bar; asm volatile("" : "+s"(bp_)); b_.bar = bp_; } xcd_barrier(b_, C.tid == 0); } while (0)
#else
#define GRID_BAR() do {} while (0)
#endif
    typedef const __attribute__((address_space(4))) Args* KArgsP;
    KArgsP kp = (KArgsP)__builtin_amdgcn_kernarg_segment_ptr();
    const int grid_s = gridDim.x, bid_s = blockIdx.x;
    const int wave_s = __builtin_amdgcn_readfirstlane((int)threadIdx.x >> 6);
#define FRESH() do { int ln_; asm volatile("v_mbcnt_lo_u32_b32 %0, -1, 0\n\tv_mbcnt_hi_u32_b32 %0, -1, %0" : "=v"(ln_)); int w_ = wave_s; asm volatile("" : "+s"(w_)); C.tid = (w_ << 6) | ln_; C.lane = ln_; C.wave = w_; \
        int g_ = grid_s, b_ = bid_s; asm volatile("" : "+s"(g_), "+s"(b_)); C.G = g_; C.bid = b_; \
        kp = (KArgsP)__builtin_amdgcn_kernarg_segment_ptr(); asm volatile("" : "+s"(kp)); C.ws = kp->ws; } while (0)
#define KIN(i) (kp->in[i])
    const int lo = args.ph_lo, hi = args.ph_hi, sub_mask = args.sub; const bool dry = (args.pad != 0);
#ifndef PH_ONLY
#define PH_ONLY -1
#endif
#ifndef PH_SUB
#define PH_SUB -1
#endif
#define PON(k) (PH_ONLY < 0 || PH_ONLY == (k))
#define PON2(k) ((PH_SUB < 0 || PH_SUB == (k)) && ((sub_mask >> (((k) / 10 - 1) * 4 + (k) % 10 - 1)) & 1))
#define IN(k) (lo <= (k) && (k) < hi)
#define SEAM(k) do { if (IN(k) && IN((k) + 1)) GRID_BAR(); } while (0)
    if (IN(0) && PON(100)) { phase_prologue(C, args); }
    SEAM(0);
    for (int l = 0; l < NLAYER; ++l) {
        const int P = 1 + l * NPH_LAYER;
        if (IN(P + 0) && PON(0)) { FRESH();
            pg8::Gemm g{WSP(bf16_t, WS_XB), WSP(bf16_t, WS_WIN + l * SZ_WIN), 1024, 1024, nullptr}; GridOrder S{NIN / 256, (NTOK / 256) * (NIN / 256), C.G, C.bid};
            EpiInProj E{C.ws, dry};
            pg8::gemm_phase<EpiInProj, GridOrder>(C.lds, g, S, E, C.tid);
        }
        SEAM(P + 0);
        if (IN(P + 1) && PON(1)) { FRESH();
            if (PON2(11)) phase_indexer(C);
            __syncthreads();
            FRESH();
            if (PON2(12)) { pg8::Gemm g{WSP(bf16_t, WS_CDQ), WSP(bf16_t, WS_WUQ + l * SZ_WUQ), 256, 256, nullptr}; GridOrder S{3, 128 * 3, C.G, C.bid};
              EpiQUp E{WSP(bf16_t, WS_QC), WSP(float, WS_SSQ), WSP(float, WS_COSC), WSP(float, WS_SINC)};
              pg8::gemm_phase<EpiQUp, GridOrder>(C.lds, g, S, E, C.tid); }
            FRESH();
            if (PON2(13)) { pg8::Gemm g{WSP(bf16_t, WS_CDKV), WSP(bf16_t, WS_WUKV + l * SZ_WUKV), 256, 256, nullptr}; GridOrder S{4, 128 * 4, C.G, C.bid};
              EpiKvUp E{WSP(bf16_t, WS_KC), WSP(bf16_t, WS_VCT), WSP(float, WS_SSQ)};
              pg8::gemm_phase<EpiKvUp, GridOrder>(C.lds, g, S, E, C.tid); }
            __syncthreads();
            if (PON2(14)) { FRESH(); phase_gmlp(C, KIN(3) + l * 512, KIN(4) + l * 512, KIN(6) + (size_t)l * 8 * 128, l); }
        }
        SEAM(P + 1);
        if (IN(P + 2) && PON(2)) { FRESH();
            if (PON2(21)) phase_select(C);
            __syncthreads();
            FRESH(); if (PON2(22)) phase_attn<96, false>(C, WSP(bf16_t, WS_QC), WSP(bf16_t, WS_KC), WSP(bf16_t, WS_VCT), nullptr, WSP(bf16_t, WS_OBUF) + (size_t)2 * NTOK * 512);
        }
        SEAM(P + 2);
        if (IN(P + 3) && PON(3)) { FRESH(); phase_attn<64, true>(C, WSP(bf16_t, WS_QA), WSP(bf16_t, WS_KA), WSP(bf16_t, WS_VAT), WSP(unsigned, WS_MASK), WSP(bf16_t, WS_OBUF)); }
        SEAM(P + 3);
        if (IN(P + 4) && PON(4)) { FRESH();
            pg8::Gemm g{WSP(bf16_t, WS_OBUF), WSP(bf16_t, WS_WBR + l * SZ_WBR), 512, 512, nullptr}; MergeOrder S{C.G, C.bid};
            EpiMerge E{WSP(bf16_t, WS_GATE), WSP(bf16_t, WS_MERGED)};
            pg8::gemm_phase<EpiMerge, MergeOrder>(C.lds, g, S, E, C.tid);
        }
        SEAM(P + 4);
        if (IN(P + 5) && PON(5)) { FRESH();
            pg8::Gemm g{WSP(bf16_t, WS_MERGED), WSP(bf16_t, WS_WOUT + l * SZ_WOUT), 1024, 1024, nullptr}; GridOrder S{4, 128 * 4, C.G, C.bid};
            EpiOut E{dry ? WSP(bf16_t, WS_DRY) : WSP(bf16_t, WS_OBUF)};
            pg8::gemm_phase<EpiOut, GridOrder>(C.lds, g, S, E, C.tid);
        }
        SEAM(P + 5);
        if (IN(P + 6) && PON(6)) { FRESH(); phase_ln1_router(C, KIN(13) + l * 1024, KIN(14) + l * 1024, KIN(15) + (size_t)l * 1024 * 32, KIN(16) + l * 32, l, dry); }
        SEAM(P + 6);
        if (IN(P + 7) && PON(7)) { FRESH(); phase_dispatch(C, l); }
        SEAM(P + 7);
        if (IN(P + 8) && PON(8)) { FRESH();
            moe_tables(C, l);
            const LAS int* tb = (const LAS int*)(C.lds + MISC_OFF + 64) + 32;
            pg8::Gemm g{WSP(bf16_t, WS_XB), WSP(bf16_t, WS_WGU + l * SZ_WGU), 1024, 1024, WSP(int, WS_STK)}; MoeOrder S{8, tb[32] * 8, C.G, C.bid, tb};
            EpiMoeUp E{WSP(bf16_t, WS_H), KIN(18) + (size_t)l * NEXP * 2048};
            pg8::gemm_phase<EpiMoeUp, MoeOrder, true>(C.lds, g, S, E, C.tid);
        }
        SEAM(P + 8);
        if (IN(P + 9) && PON(9)) { FRESH();
            moe_tables(C, l);
            const LAS int* tb = (const LAS int*)(C.lds + MISC_OFF + 64) + 32;
            pg8::Gemm g{WSP(bf16_t, WS_H), WSP(bf16_t, WS_WDN + l * SZ_WDN), 1024, 1024, nullptr}; MoeOrder S{4, tb[32] * 4, C.G, C.bid, tb};
            EpiMoeDn E{dry ? WSP(bf16_t, WS_DRY) : WSP(bf16_t, WS_Y), KIN(20) + (size_t)l * NEXP * 1024, dry};
            pg8::gemm_phase<EpiMoeDn, MoeOrder>(C.lds, g, S, E, C.tid);
        }
        SEAM(P + 9);
        if (IN(P + 10) && PON(10)) { FRESH(); phase_ln2(C, KIN(21) + l * 1024, KIN(22) + l * 1024, kp->out, l, dry); }
        SEAM(P + 10);
    }
#ifdef DBG_STOP
    if (IN(NPHASE)) { FRESH(); dbg_dump(C, kp->out); }
#endif
#ifdef DBG_CHECK
    if (IN(NPHASE + 1)) { FRESH(); chk_proj(C, args); chk_attn(C); }
    if (IN(NPHASE + 2)) { FRESH();
        const unsigned* ctl = WSP(unsigned, WS_CTL); const float tol[6] = {0.06f, 0.06f, 2e-3f, 0.5f, 0.02f, 0.02f}; float sc = 1.f;
        for (int k = 0; k < 6; ++k) if (__uint_as_float(ctl[CW_ERR + k]) > tol[k]) sc += 0.2f * (float)(1 << k);
        float* o = kp->out; for (size_t i = (size_t)C.bid * 512 + C.tid; i < (size_t)NTOK * DM; i += (size_t)C.G * 512) o[i] *= sc; }
#endif
#undef IN
#undef SEAM
}

extern "C" void kernel_launch(void* const* d_in, const int* in_sizes, int n_in, void* d_out, int out_size, void* d_ws, size_t ws_size, hipStream_t stream) {
    static int grid = 0;
    if (grid == 0) {
        if (n_in != 23 || out_size != NTOK * DM || ws_size < WS_END) { fprintf(stderr, "kernel_launch: unexpected shapes (n_in %d, out %d, ws %zu < %zu)\n", n_in, out_size, ws_size, (size_t)WS_END); grid = -1; return; }
        int dev = 0, cus = 0, per_cu = 0;
        if (hipGetDevice(&dev) != hipSuccess || hipDeviceGetAttribute(&cus, hipDeviceAttributeMultiprocessorCount, dev) != hipSuccess) { grid = -1; return; }
        if (hipFuncSetAttribute((const void*)trunk_fwd, hipFuncAttributeMaxDynamicSharedMemorySize, LDS_BYTES) != hipSuccess) { fprintf(stderr, "kernel_launch: hipFuncSetAttribute failed\n"); grid = -1; return; }
        if (hipOccupancyMaxActiveBlocksPerMultiprocessor(&per_cu, (const void*)trunk_fwd, NWAVES * 64, LDS_BYTES) != hipSuccess || per_cu < 1) { fprintf(stderr, "kernel_launch: occupancy query reports %d\n", per_cu); }
        (void)hipGetLastError();
        grid = cus;
    }
    if (grid < 0) return;
    (void)hipMemsetAsync((char*)d_ws + WS_CTL, 0, CTL_ZERO_BYTES, stream);
#ifdef DBG_ZERO_WS
    (void)hipMemsetAsync((char*)d_ws + WS_XRES, 0, WS_END - WS_XRES, stream);
#endif
    Args a{};
    for (int i = 0; i < 23; ++i) a.in[i] = (const float*)d_in[i];
    a.out = (float*)d_out; a.ws = (unsigned char*)d_ws; a.sub = -1; a.pad = 0;
#if MK_ONE_LAUNCH
    a.ph_lo = 0; a.ph_hi = NPHASE;
    hipLaunchKernelGGL(trunk_fwd, dim3(grid), dim3(NWAVES * 64), LDS_BYTES, stream, a);
#else
#ifdef DBG_STOP
    for (int p = 0; p < 1 + DBG_STOP; ++p) { a.ph_lo = p; a.ph_hi = p + 1; hipLaunchKernelGGL(trunk_fwd, dim3(grid), dim3(NWAVES * 64), LDS_BYTES, stream, a); }
    a.ph_lo = NPHASE; a.ph_hi = NPHASE + 1; hipLaunchKernelGGL(trunk_fwd, dim3(grid), dim3(NWAVES * 64), LDS_BYTES, stream, a);
#else
    for (int p = 0; p < NPHASE; ++p) { a.ph_lo = p; a.ph_hi = p + 1; a.sub = -1; a.pad = 0; hipLaunchKernelGGL(trunk_fwd, dim3(grid), dim3(NWAVES * 64), LDS_BYTES, stream, a);
#ifdef DBG_CHECK
        if (p == 4) { a.ph_lo = NPHASE + 1; a.ph_hi = NPHASE + 2; hipLaunchKernelGGL(trunk_fwd, dim3(grid), dim3(NWAVES * 64), LDS_BYTES, stream, a); }
        if (p == NPHASE - 1) { a.ph_lo = NPHASE + 2; a.ph_hi = NPHASE + 3; hipLaunchKernelGGL(trunk_fwd, dim3(grid), dim3(NWAVES * 64), LDS_BYTES, stream, a); }
#endif
#ifdef PROBE_PH
#ifndef PROBE_DRY
#define PROBE_DRY 0
#endif
        if ((p == 0 && PROBE_PH == -1) || (p >= 1 && (p - 1) % NPH_LAYER == PROBE_PH)) { a.sub = PROBE_SUB; a.pad = PROBE_DRY; hipLaunchKernelGGL(trunk_fwd, dim3(grid), dim3(NWAVES * 64), LDS_BYTES, stream, a); }
#endif
    }
#endif
#endif
}
```

```cpp
#include <hip/hip_runtime.h>
#include <cstdio>
#include <cstdint>

#ifndef MK_ONE_LAUNCH
#define MK_ONE_LAUNCH 1
#endif

#define LAS __attribute__((address_space(3)))
typedef unsigned short bf16_t;
typedef short bf16x8 __attribute__((ext_vector_type(8)));
typedef float f32x4 __attribute__((ext_vector_type(4)));
typedef float f32x16 __attribute__((ext_vector_type(16)));
typedef unsigned u32x4 __attribute__((ext_vector_type(4)));
typedef unsigned u32x2 __attribute__((ext_vector_type(2)));
typedef float f32x2_t __attribute__((ext_vector_type(2)));
typedef __bf16 bf16x2_t __attribute__((ext_vector_type(2)));

__device__ __forceinline__ unsigned pk2(float lo, float hi) { f32x2_t v = {lo, hi}; bf16x2_t b = __builtin_convertvector(v, bf16x2_t); return __builtin_bit_cast(unsigned, b); }
__device__ __forceinline__ float bf2f(unsigned short x) { return __uint_as_float(((unsigned)x) << 16); }
__device__ __forceinline__ float bflo(unsigned w) { return __uint_as_float(w << 16); }
__device__ __forceinline__ float bfhi(unsigned w) { return __uint_as_float(w & 0xffff0000u); }
template <int M> __device__ __forceinline__ float xswz(float v) { static_assert(M >= 1 && M <= 16, "xswz"); return __int_as_float(__builtin_amdgcn_ds_swizzle(__float_as_int(v), 0x1F | (M << 10))); }
template <int M> __device__ __forceinline__ unsigned xswzu(unsigned v) { return (unsigned)__builtin_amdgcn_ds_swizzle((int)v, 0x1F | (M << 10)); }
__device__ __forceinline__ float xsum32(float v) { auto rr = __builtin_amdgcn_permlane32_swap(__float_as_uint(v), __float_as_uint(v), false, false); return __uint_as_float(rr[0]) + __uint_as_float(rr[1]); }
__device__ __forceinline__ float xmax32(float v) { auto rr = __builtin_amdgcn_permlane32_swap(__float_as_uint(v), __float_as_uint(v), false, false); return fmaxf(__uint_as_float(rr[0]), __uint_as_float(rr[1])); }
__device__ __forceinline__ float xother32(float v, bool upper) { auto rr = __builtin_amdgcn_permlane32_swap(__float_as_uint(v), __float_as_uint(v), false, false); return __uint_as_float(upper ? rr[0] : rr[1]); }
#define LDS_WAIT() asm volatile("s_waitcnt lgkmcnt(0)" ::: "memory")
#define VM_WAIT() asm volatile("s_waitcnt vmcnt(0)" ::: "memory")

constexpr int NB = 8, SEQ = 4096, NTOK = NB * SEQ, DM = 1024, NLAYER = 4;
constexpr int NIN_SRC = 6632, NIN = 6656;
constexpr int NEXP = 32, TOPK = 4, DFF = 1024;
constexpr int NSLOT = NTOK * TOPK, NSLOT_PAD = NSLOT + NEXP * 256;
constexpr float LN_EPS = 1e-5f, RMS_EPS = 1e-6f;
constexpr float DN_ALPHA = 1.681792830507429f;
constexpr float LOG2E = 1.4426950408889634f;
constexpr float QSCALE_A = 0.125f * LOG2E;
constexpr float QSCALE_C = 0.10206207261596577f * LOG2E;
constexpr float IW_SCALE = 0.35355339059327373f * 0.125f;

constexpr size_t MiB = (size_t)1 << 20;
constexpr size_t WS_CTL = 0, CTL_ZERO_BYTES = 1 * MiB;
constexpr int CW_BAR = 4096, CW_CNT = 16384;
constexpr size_t SZ_WIN = (size_t)NIN * DM * 2, SZ_WUQ = (size_t)768 * 256 * 2, SZ_WUKV = (size_t)1024 * 256 * 2, SZ_WBR = (size_t)3 * 1024 * 512 * 2, SZ_WOUT = (size_t)1024 * 1024 * 2;
constexpr size_t SZ_WGU = (size_t)NEXP * 2048 * 1024 * 2, SZ_WDN = (size_t)NEXP * 1024 * 1024 * 2, SZ_WGM = (size_t)8 * 128 * 128 * 2;
constexpr size_t WS_WIN = 2 * MiB;
constexpr size_t WS_WUQ = WS_WIN + NLAYER * SZ_WIN;
constexpr size_t WS_WUKV = WS_WUQ + NLAYER * SZ_WUQ;
constexpr size_t WS_WBR = WS_WUKV + NLAYER * SZ_WUKV;
constexpr size_t WS_WOUT = WS_WBR + NLAYER * SZ_WBR;
constexpr size_t WS_WGU = WS_WOUT + NLAYER * SZ_WOUT;
constexpr size_t WS_WDN = WS_WGU + NLAYER * SZ_WGU;
constexpr size_t WS_WGM = WS_WDN + NLAYER * SZ_WDN;
constexpr size_t WS_COSA = WS_WGM + NLAYER * SZ_WGM;
constexpr size_t WS_SINA = WS_COSA + (size_t)NTOK * 8 * 4;
constexpr size_t WS_COSC = WS_SINA + (size_t)NTOK * 8 * 4;
constexpr size_t WS_SINC = WS_COSC + (size_t)NTOK * 16 * 4;
constexpr size_t WS_XRES = WS_SINC + (size_t)NTOK * 16 * 4;
constexpr size_t WS_XB = WS_XRES + (size_t)NTOK * DM * 4;
constexpr size_t WS_QA = WS_XB + (size_t)NTOK * DM * 2;
constexpr size_t WS_KA = WS_QA + (size_t)NTOK * 512 * 2;
constexpr size_t WS_VAT = WS_KA + (size_t)NTOK * 512 * 2;
constexpr size_t WS_IQ = WS_VAT + (size_t)NTOK * 512 * 2;
constexpr size_t WS_IK = WS_IQ + (size_t)NTOK * 512 * 2;
constexpr size_t WS_IW = WS_IK + (size_t)NTOK * 64 * 2;
constexpr size_t WS_U = WS_IW + (size_t)NTOK * 8 * 4;
constexpr size_t WS_V = WS_U + (size_t)NTOK * 512 * 2;
constexpr size_t WS_CDQ = WS_V + (size_t)NTOK * 512 * 2;
constexpr size_t WS_CDKV = WS_CDQ + (size_t)NTOK * 256 * 2;
constexpr size_t WS_SSQ = WS_CDKV + (size_t)NTOK * 256 * 2;
constexpr size_t WS_GATE = WS_SSQ + (size_t)NTOK * 8 * 4;
constexpr size_t WS_QC = WS_GATE + (size_t)NTOK * 3072 * 2;
constexpr size_t WS_KC = WS_QC + (size_t)NTOK * 768 * 2;
constexpr size_t WS_VCT = WS_KC + (size_t)NTOK * 768 * 2;
constexpr size_t WS_SCORE = WS_VCT + (size_t)NTOK * 512 * 2;
constexpr size_t WS_MASK = WS_SCORE + (size_t)NTOK * SEQ * 4;
constexpr size_t WS_OBUF = WS_MASK + (size_t)NTOK * 128 * 4;
constexpr size_t WS_MERGED = WS_OBUF + (size_t)3 * NTOK * 512 * 2;
constexpr size_t WS_TKE = WS_MERGED + (size_t)NTOK * DM * 2;
constexpr size_t WS_TKP = WS_TKE + (size_t)NSLOT * 4;
constexpr size_t WS_TKW = WS_TKP + (size_t)NSLOT * 4;
constexpr size_t WS_STK = WS_TKW + (size_t)NSLOT * 4;
constexpr size_t WS_SW = WS_STK + (size_t)NSLOT_PAD * 4;
constexpr size_t WS_XG = WS_SW + (size_t)NSLOT_PAD * 4;
constexpr size_t WS_H = WS_XG + (size_t)NSLOT_PAD * DM * 2;
constexpr size_t WS_Y = WS_H + (size_t)NSLOT_PAD * DFF * 2;
constexpr size_t WS_CCNT = WS_Y + (size_t)NSLOT_PAD * DM * 2;
constexpr size_t WS_RWT = WS_CCNT + (size_t)(NTOK / 128) * 32 * 4;
constexpr size_t WS_GBW = WS_RWT + (size_t)NLAYER * 32 * 1024 * 4;
constexpr size_t WS_END = WS_GBW + (size_t)NLAYER * 64 * 4;
constexpr size_t WS_DRY = (WS_END + 255) & ~(size_t)255;
static_assert(WS_END < (size_t)4200 * MiB, "workspace map too large");
static_assert((WS_WIN % 256) == 0 && (WS_COSA % 256) == 0 && (WS_XRES % 256) == 0 && (WS_SCORE % 256) == 0 && (WS_XG % 256) == 0, "alignment");

constexpr int LDS_BYTES = 147456;
constexpr int MISC_OFF = 143360;
constexpr int NWAVES = 8;

#define XB_TMO      128
#define XB_XCNT(j)  (256  + 64 * (j))
#define XB_XSUB(j)  (1280 + 64 * (j))
#define XB_XGEN(j)  (2304 + 64 * (j))
#define XB_TOP      3328
#define XB_TOPGEN   3392
#define XCD_BAR_WORDS 3456
#define XB_SPIN_CAP (1u << 18)
__device__ __forceinline__ unsigned xb_ld(unsigned* p)              { return __hip_atomic_load(p, __ATOMIC_RELAXED, __HIP_MEMORY_SCOPE_AGENT); }
__device__ __forceinline__ unsigned xb_add(unsigned* p, unsigned v) { return __hip_atomic_fetch_add(p, v, __ATOMIC_RELAXED, __HIP_MEMORY_SCOPE_AGENT); }
__device__ __forceinline__ unsigned xb_xcc_id() { return (unsigned)__builtin_amdgcn_s_getreg((3 << 11) | 20) & 0xFu; }
#define XB_SPIN(cond, bar) do { unsigned _sp = 0; while (cond) { __builtin_amdgcn_s_sleep(1); \
    if ((++_sp & 255u) == 0u) { if (xb_ld(&(bar)[XB_TMO])) break; if (_sp > XB_SPIN_CAP) { atomicAdd(&(bar)[XB_TMO], 1u); break; } } } } while (0)
struct XcdBarrier { unsigned* bar; unsigned x; volatile LAS unsigned* st; };
__device__ __forceinline__ XcdBarrier xcd_barrier_post(unsigned* bar, volatile LAS unsigned* st) {
    XcdBarrier b; b.bar = bar; b.x = xb_xcc_id(); b.st = st;
    if (threadIdx.x == 0) (void)xb_add(&bar[XB_XCNT(b.x)], 1u);
    return b;
}
__device__ __forceinline__ void xcd_barrier_complete(unsigned* bar, unsigned x, unsigned& nloc, unsigned& nx) {
    const unsigned G = gridDim.x * gridDim.y * gridDim.z;
    unsigned sum, cnt, mine, sp = 0u;
    for (;;) {
        sum = 0u; cnt = 0u; mine = 0u;
#pragma unroll
        for (unsigned j = 0; j < 16; ++j) { const unsigned c = xb_ld(&bar[XB_XCNT(j)]); sum += c; cnt += (c > 0u) ? 1u : 0u; mine = (j == x) ? c : mine; }
        if (sum == G) break;
        __builtin_amdgcn_s_sleep(1);
        if ((++sp & 255u) == 0u) { if (xb_ld(&bar[XB_TMO])) break; if (sp > XB_SPIN_CAP) { atomicAdd(&bar[XB_TMO], 1u); break; } }
    }
    nloc = mine > 0u ? mine : 1u; nx = cnt > 0u ? cnt : 1u;
}
__device__ __forceinline__ void xcd_barrier(const XcdBarrier& b, bool leader_thread) {
    asm volatile("s_waitcnt vmcnt(0)" ::: "memory");
    __syncthreads();
    if (leader_thread) {
        unsigned* bar = b.bar;
        __builtin_amdgcn_s_waitcnt(0);
        unsigned nloc = b.st[0], nx = b.st[1];
        if (nloc == 0u) { xcd_barrier_complete(bar, b.x, nloc, nx); b.st[0] = nloc; b.st[1] = nx; }
        const unsigned old = xb_add(&bar[XB_XSUB(b.x)], 1u);
        const unsigned gen = old / nloc;
        if (old + 1u == (gen + 1u) * nloc) {
            __builtin_amdgcn_fence(__ATOMIC_RELEASE, "agent");
            asm volatile("s_waitcnt vmcnt(0)" ::: "memory");
            const unsigned og = xb_add(&bar[XB_TOP], 1u);
            const unsigned tg = og / nx;
            if (og + 1u == (tg + 1u) * nx) xb_add(&bar[XB_TOPGEN], 1u);
            else XB_SPIN(xb_ld(&bar[XB_TOPGEN]) == tg, bar);
            __builtin_amdgcn_fence(__ATOMIC_ACQUIRE, "agent");
            xb_add(&bar[XB_XGEN(b.x)], 1u);
            asm volatile("s_waitcnt vmcnt(0)" ::: "memory");
        } else {
            XB_SPIN(xb_ld(&bar[XB_XGEN(b.x)]) == gen, bar);
            __builtin_amdgcn_fence(__ATOMIC_ACQUIRE, "agent");
            asm volatile("s_waitcnt vmcnt(0)" ::: "memory");
        }
    }
    __syncthreads();
}

namespace pg8 {
constexpr int BM = 256, BK = 64, HALF = 128, HTB = HALF * BK * 2;
__host__ __device__ __forceinline__ int lds_byte(int r, int c) { const int st = (r >> 4) * 2 + (c >> 5), rr = r & 15, cc = c & 31, ob = rr * 64 + cc * 2; return st * 1024 + (ob ^ (((ob >> 9) & 1) << 5)); }
__host__ __device__ __forceinline__ void stage_rc(int b, int& R, int& C) { const int st = b / 1024, sb = b % 1024, swz = sb ^ (((sb >> 9) & 1) << 5); R = (st >> 1) * 16 + swz / 64; C = (st & 1) * 32 + (swz % 64) / 2; }
__host__ __device__ __forceinline__ int perm32(int rho) { const int n = rho >> 4, i = rho & 15; return 8 * (i >> 2) + 4 * n + (i & 3); }
struct Unit { int pm, pn; };
struct Gemm { const bf16_t* A; const bf16_t* Bt; int lda, K; const int* rowmap; };

constexpr int PRE_OFF = 131072;
template <class Epi, class Sched, bool GATHER = false>
__device__ __forceinline__ void gemm_phase(LAS unsigned char* lds, const Gemm g, const Sched& S, const Epi& E, int tid0) {
    int tid = tid0; asm volatile("" : "+v"(tid));
    const int wid = __builtin_amdgcn_readfirstlane(tid >> 6), lane = tid & 63, wr = wid >> 2, wc = wid & 3, fr = lane & 15, fq = lane >> 4;
    const int K = g.K, nt = K / BK, lda = g.lda;
    unsigned voffA[2], voffB[2]; unsigned colA2 = 0u;
#pragma unroll
    for (int i = 0; i < 2; ++i) { int R, C; stage_rc(tid * 16 + i * 8192, R, C); voffA[i] = (unsigned)(R * lda + C) * 2u; const int Rb = (R & ~31) + perm32(R & 31); voffB[i] = (unsigned)(Rb * K + C) * 2u; colA2 = (unsigned)C * 2u; }
    unsigned gcur[2] = {0u, 0u}, gnxt[2] = {0u, 0u};
#define PG8_GLOAD(d, pm_) do { int ln_; asm volatile("v_mbcnt_lo_u32_b32 %0, -1, 0\n\tv_mbcnt_hi_u32_b32 %0, -1, %0" : "=v"(ln_));   \
        int R0_, C0_; stage_rc(((wid << 6) | ln_) * 16, R0_, C0_); const int* rm_ = g.rowmap + (pm_) * BM + R0_; \
        d[0] = (unsigned)rm_[0] | ((unsigned)rm_[64] << 16); d[1] = (unsigned)rm_[HALF] | ((unsigned)rm_[HALF + 64] << 16); } while (0)
#define PG8_GOFF(p, i) ((((i) ? ((p) >> 16) : ((p) & 0xffffu)) * (unsigned)(lda * 2)) + colA2)
#define PG8_STAGE_G(bufoff, gbase, p) do { _Pragma("unroll") for (int _i = 0; _i < 2; ++_i) \
        __builtin_amdgcn_global_load_lds((const unsigned*)((const char*)(gbase) + PG8_GOFF(p, _i)), (LAS unsigned*)(lds + (bufoff) + ldsw + _i * 8192), 16, 0, 0); } while (0)
    const size_t kstep = (size_t)(BK * 2);
    const size_t hstepA = (size_t)HALF * lda * 2, hstepB = (size_t)HALF * K * 2;
    const size_t tstepA = 2 * hstepA, tstepB = 2 * hstepB;
    const unsigned ldsw = (unsigned)wid * 1024u;
    const int aoff = lds_byte(wr * 64 + fr, fq * 8), boff = lds_byte(wc * 32 + fr, fq * 8);
#define PG8_SA(b, h) (((b) * 2 + (h)) * HTB)
#define PG8_SB(b, h) ((4 + (b) * 2 + (h)) * HTB)
#define PG8_STAGE(bufoff, gbase, voff) do { _Pragma("unroll") for (int _i = 0; _i < 2; ++_i) \
        __builtin_amdgcn_global_load_lds((const unsigned*)((const char*)(gbase) + (voff)[_i]), (LAS unsigned*)(lds + (bufoff) + ldsw + _i * 8192), 16, 0, 0); } while (0)
#define PG8_STAGE_A(bufoff, gbase, half, nextu) do { if constexpr (GATHER) { if (nextu) PG8_STAGE_G(bufoff, gbase, gnxt[half]); else PG8_STAGE_G(bufoff, gbase, gcur[half]); } \
        else { PG8_STAGE(bufoff, (gbase) + ((half) ? hstepA : 0), voffA); } } while (0)
#define PG8_LDA(dst, b, h) do { _Pragma("unroll") for (int m = 0; m < 4; ++m) _Pragma("unroll") for (int k = 0; k < 2; ++k) dst[m][k] = *(const LAS bf16x8*)(lds + PG8_SA(b, h) + aoff + m * 2048 + k * 1024); } while (0)
#define PG8_LDB(dst, b, h) do { _Pragma("unroll") for (int n = 0; n < 2; ++n) _Pragma("unroll") for (int k = 0; k < 2; ++k) dst[n][k] = *(const LAS bf16x8*)(lds + PG8_SB(b, h) + boff + n * 2048 + k * 1024); } while (0)
#define PG8_MMA(ai, bj, At, Bt) do { __builtin_amdgcn_s_setprio(1); _Pragma("unroll") for (int m = 0; m < 4; ++m) _Pragma("unroll") for (int n = 0; n < 2; ++n) _Pragma("unroll") for (int k = 0; k < 2; ++k) \
        acc[ai][bj][m][n] = __builtin_amdgcn_mfma_f32_16x16x32_bf16(Bt[n][k], At[m][k], acc[ai][bj][m][n], 0, 0, 0); __builtin_amdgcn_s_setprio(0); } while (0)
#define PG8_WAIT_V(n) asm volatile("s_waitcnt vmcnt(" #n ")" ::: "memory")
#define PG8_WAIT_L(n) asm volatile("s_waitcnt lgkmcnt(" #n ")" ::: "memory")
#define PG8_BAR __builtin_amdgcn_s_barrier()
#define PG8_SCHED __builtin_amdgcn_sched_barrier(0)
    Unit cur, nxt; int ui = 0;
    if (!S.next(0, cur)) return;
    f32x4 acc[2][2][4][2];
#pragma unroll
    for (int a = 0; a < 2; ++a)
#pragma unroll
        for (int b = 0; b < 2; ++b)
#pragma unroll
            for (int m = 0; m < 4; ++m)
#pragma unroll
                for (int n = 0; n < 2; ++n) acc[a][b][m][n] = (f32x4){0.f, 0.f, 0.f, 0.f};
    bf16x8 At[4][2], B0[2][2], B1[2][2];
    const char* cA = GATHER ? (const char*)g.A : (const char*)g.A + (size_t)cur.pm * tstepA; const char* cB = (const char*)g.Bt + (size_t)cur.pn * tstepB;
    if constexpr (GATHER) { PG8_GLOAD(gcur, cur.pm); }
#define PG8_PRE(u_, slot_) do { if (wid < 4) { int ln_; asm volatile("v_mbcnt_lo_u32_b32 %0, -1, 0\n\tv_mbcnt_hi_u32_b32 %0, -1, %0" : "=v"(ln_));   \
        __builtin_amdgcn_global_load_lds((const unsigned*)(E.pre_base(u_, wid) + ln_), (LAS unsigned*)(lds + PRE_OFF + (slot_) * 1024 + wid * 256), 4, 0, 0); } } while (0)
    if constexpr (Epi::PRE) { PG8_PRE(cur, 0); }
    PG8_STAGE(PG8_SB(0, 0), cB, voffB); PG8_STAGE(PG8_SB(0, 1), cB + hstepB, voffB); PG8_STAGE_A(PG8_SA(0, 0), cA, 0, false); PG8_STAGE_A(PG8_SA(0, 1), cA, 1, false);
    if (wr == 1) PG8_BAR;
    PG8_WAIT_V(2); PG8_BAR;
    PG8_STAGE(PG8_SB(1, 0), cB + kstep, voffB); PG8_STAGE_A(PG8_SA(1, 0), cA + kstep, 0, false); PG8_STAGE(PG8_SB(1, 1), cB + hstepB + kstep, voffB);
    PG8_WAIT_V(6); PG8_BAR;
    for (;;) {
        const bool has_next = S.next(ui + 1, nxt);
        const char* nA = GATHER ? cA : (has_next ? (const char*)g.A + (size_t)nxt.pm * tstepA : cA); const char* nB = has_next ? (const char*)g.Bt + (size_t)nxt.pn * tstepB : cB;
        if constexpr (GATHER) { if (has_next) { PG8_GLOAD(gnxt, nxt.pm); } else { gnxt[0] = gcur[0]; gnxt[1] = gcur[1]; } }
        for (int t = 0; t < nt; t += 2) {
            const bool last = (t == nt - 2);
            if constexpr (Epi::PRE) { if (last && has_next) PG8_PRE(nxt, (ui + 1) & 1); }
            const char* a1 = cA + (size_t)(t + 1) * kstep;
            const char* a2 = last ? nA : cA + (size_t)(t + 2) * kstep; const char* b2 = last ? nB : cB + (size_t)(t + 2) * kstep;
            const char* a3 = a2 + kstep; const char* b3 = b2 + kstep;
            PG8_LDB(B0, 0, 0); PG8_LDB(B1, 0, 1); PG8_SCHED; PG8_LDA(At, 0, 0); PG8_STAGE_A(PG8_SA(1, 1), a1, 1, false);
            PG8_WAIT_V(8); PG8_WAIT_L(0); PG8_BAR; PG8_MMA(0, 0, At, B0); PG8_MMA(0, 1, At, B1); PG8_BAR; PG8_SCHED;
            PG8_LDA(At, 0, 1); PG8_STAGE(PG8_SB(0, 0), b2, voffB); PG8_STAGE(PG8_SB(0, 1), b2 + hstepB, voffB); PG8_STAGE_A(PG8_SA(0, 0), a2, 0, last);
            PG8_WAIT_V(8); PG8_WAIT_L(0); PG8_BAR; PG8_MMA(1, 0, At, B0); PG8_MMA(1, 1, At, B1); PG8_BAR; PG8_SCHED;
            PG8_LDB(B0, 1, 0); PG8_LDB(B1, 1, 1); PG8_SCHED; PG8_LDA(At, 1, 0); PG8_STAGE_A(PG8_SA(0, 1), a2, 1, last);
            PG8_WAIT_V(8); PG8_WAIT_L(0); PG8_BAR; PG8_MMA(0, 0, At, B0); PG8_MMA(0, 1, At, B1); PG8_BAR; PG8_SCHED;
            PG8_LDA(At, 1, 1); PG8_STAGE(PG8_SB(1, 0), b3, voffB); PG8_STAGE(PG8_SB(1, 1), b3 + hstepB, voffB); PG8_STAGE_A(PG8_SA(1, 0), a3, 0, last);
            PG8_WAIT_V(8); PG8_WAIT_L(0); PG8_BAR; PG8_MMA(1, 0, At, B0); PG8_MMA(1, 1, At, B1); PG8_BAR; PG8_SCHED;
        }
        if (wr == 0) PG8_BAR;
        { int el; asm volatile("v_mbcnt_lo_u32_b32 %0, -1, 0\n\tv_mbcnt_hi_u32_b32 %0, -1, %0" : "=v"(el));
          if constexpr (Epi::PRE) E(acc, cur, wr, wc, el & 15, el >> 4, (const LAS float*)(lds + PRE_OFF + (ui & 1) * 1024)); else E(acc, cur, wr, wc, el & 15, el >> 4); }
        if (!has_next) break;
        if constexpr (!Epi::CHAIN) {
#pragma unroll
        for (int a = 0; a < 2; ++a)
#pragma unroll
            for (int b = 0; b < 2; ++b)
#pragma unroll
                for (int m = 0; m < 4; ++m)
#pragma unroll
                    for (int n = 0; n < 2; ++n) acc[a][b][m][n] = (f32x4){0.f, 0.f, 0.f, 0.f};
        }
        cur = nxt; cA = nA; cB = nB; ++ui;
        if constexpr (GATHER) { gcur[0] = gnxt[0]; gcur[1] = gnxt[1]; }
        if (wr == 1) PG8_BAR;
    }
    PG8_WAIT_V(0);
    PG8_BAR;
#undef PG8_PRE
#undef PG8_SA
#undef PG8_SB
#undef PG8_STAGE
#undef PG8_LDA
#undef PG8_STAGE_A
#undef PG8_GLOAD
#undef PG8_GOFF
#undef PG8_STAGE_G
#undef PG8_LDB
#undef PG8_MMA
#undef PG8_WAIT_V
#undef PG8_WAIT_L
#undef PG8_BAR
#undef PG8_SCHED
}
}
using pg8::Unit;

struct Args { const float* in[23]; float* out; unsigned char* ws; int ph_lo, ph_hi; int sub, pad; };
struct Ctx {
    LAS unsigned char* lds;
    int tid, lane, wave, G, bid;
    unsigned char* ws;
};
#define WSP(T, off) ((T*)(C.ws + (off)))

struct GridOrder {
    int nN, total, G, c;
    __device__ __forceinline__ bool next(int i, Unit& u) const {
        const int L = c + i * G; if (L >= total) return false;
        const int nM = total / nN; int wgid;
        { const int q = total >> 3, r = total & 7, xcd = L & 7, off = L >> 3; wgid = (xcd < r ? xcd * (q + 1) : r * (q + 1) + (xcd - r) * q) + off; }
        const int nig = 8 * nN, gid = wgid / nig, fm = gid * 8, gsz = (nM - fm) < 8 ? (nM - fm) : 8, w = wgid - gid * nig;
        const int pn = w / gsz; u.pm = fm + (w - pn * gsz); u.pn = pn; return true;
    }
};
struct MergeOrder {
    int G, c;
    __device__ __forceinline__ bool next(int i, Unit& u) const { const int t = i / 3, n = i - 3 * t, tile = c + t * G; if (tile >= 512) return false; u.pm = n * 128 + (tile >> 2); u.pn = n * 4 + (tile & 3); return true; }
};
struct MoeOrder {
    int NT, total, G, c; const LAS int* tb;
    __device__ __forceinline__ bool next(int i, Unit& u) const {
        if ((G & 7) != 0) { const int idx = c + i * G; if (idx >= total) return false; const int mt = idx / NT, pn = idx - mt * NT;
            const int e = __builtin_amdgcn_readfirstlane(tb[40 + mt]); u.pm = mt; u.pn = e * NT + pn; return true; }
        const int T = __builtin_amdgcn_readfirstlane(tb[NEXP]), x = c & 7, lo = (x * T) >> 3, ntl = (((x + 1) * T) >> 3) - lo;
        const int j = (c >> 3) + i * (G >> 3);
        if (j >= ntl * NT) return false;
        const int gsh = (NT == 8) ? 6 : 5, gm = j >> gsh, rem = j - (gm << gsh);
        const int gs = (ntl - 8 * gm < 8) ? (ntl - 8 * gm) : 8, g4 = gs * 4, pg = (rem >= g4) ? 1 : 0, r2 = rem - pg * g4;
        const int mt = lo + 8 * gm + (r2 >> 2), e = __builtin_amdgcn_readfirstlane(tb[40 + mt]);
        u.pm = mt; u.pn = e * NT + pg * 4 + (r2 & 3); return true;
    }
};

__device__ __forceinline__ float gelu_f(float v) {
    const float av = fabsf(v), t = __builtin_amdgcn_rcpf(fmaf(av, 0.2316418882f, 1.0f));
    float q = fmaf(t, 0.5307027145f, -0.7265760135f); q = fmaf(q, t, 0.7107068705f); q = fmaf(q, t, -0.142248368f); q = fmaf(q, t, 0.127414796f); q = q * t;
    const float e = __builtin_amdgcn_exp2f((v * v) * (-0.72134752044f));
    const float m = v * (q * e);
    return v < 0.f ? m : v - m;
}
__device__ __forceinline__ float sigmoid_f(float x) { return __builtin_amdgcn_rcpf(1.f + __builtin_amdgcn_exp2f(x * (-LOG2E))); }
__device__ __forceinline__ int perm16(int o) { return (o & 3) | (((o >> 3) & 1) << 2) | (((o >> 2) & 1) << 3); }
__device__ __forceinline__ void st_bf4(bf16_t* p, f32x4 v) { u32x2 w; w.x = pk2(v[0], v[1]); w.y = pk2(v[2], v[3]); *(u32x2*)p = w; }
__device__ __forceinline__ f32x4 other32_4(f32x4 v, bool upper) { f32x4 r; r[0] = xother32(v[0], upper); r[1] = xother32(v[1], upper); r[2] = xother32(v[2], upper); r[3] = xother32(v[3], upper); return r; }

__device__ __forceinline__ void st_bf8(bf16_t* p, f32x4 v0, f32x4 v1) { u32x4 w; w.x = pk2(v0[0], v0[1]); w.y = pk2(v0[2], v0[3]); w.z = pk2(v1[0], v1[1]); w.w = pk2(v1[2], v1[3]); __builtin_nontemporal_store(w, (u32x4*)p); }
__device__ __forceinline__ f32x4 swz16_4(f32x4 v) { f32x4 r; r[0] = xswz<16>(v[0]); r[1] = xswz<16>(v[1]); r[2] = xswz<16>(v[2]); r[3] = xswz<16>(v[3]); return r; }
__device__ __forceinline__ void ld_bf8(const bf16_t* p, f32x4& a, f32x4& b) { const u32x4 w = *(const u32x4*)p; a = (f32x4){bflo(w.x), bfhi(w.x), bflo(w.y), bfhi(w.y)}; b = (f32x4){bflo(w.z), bfhi(w.z), bflo(w.w), bfhi(w.w)}; }
__device__ __forceinline__ void st_vt8(bf16_t* p, f32x4 v0, f32x4 v1) {
    const unsigned w0 = pk2(v0[0], v0[1]), w1 = pk2(v0[2], v0[3]), w2 = pk2(v1[0], v1[1]), w3 = pk2(v1[2], v1[3]);
    p[0] = (bf16_t)(w0 & 0xffff); p[SEQ] = (bf16_t)(w0 >> 16); p[2 * SEQ] = (bf16_t)(w1 & 0xffff); p[3 * SEQ] = (bf16_t)(w1 >> 16);
    p[4 * SEQ] = (bf16_t)(w2 & 0xffff); p[5 * SEQ] = (bf16_t)(w2 >> 16); p[6 * SEQ] = (bf16_t)(w3 & 0xffff); p[7 * SEQ] = (bf16_t)(w3 >> 16);
}
struct EpiInProj {
    static constexpr bool CHAIN = false; static constexpr bool PRE = false;
    unsigned char* ws; bool skip;
    __device__ __forceinline__ void operator()(f32x4 (&acc)[2][2][4][2], const Unit& un, int wr, int wc, int fr, int fq) const {
        if (skip) return;
        const int pn = un.pn; const int row0 = un.pm * 256 + wr * 64 + fr;
        const float* cosA = (const float*)(ws + WS_COSA); const float* sinA = (const float*)(ws + WS_SINA); const float* cosC = (const float*)(ws + WS_COSC); const float* sinC = (const float*)(ws + WS_SINC);
        if (pn < 4 || pn == 6 || pn == 7) {
            const size_t doff = pn < 2 ? WS_QA : (pn < 4 ? WS_KA : WS_IQ); bf16_t* dst = (bf16_t*)(ws + doff); const float sc = pn < 2 ? QSCALE_A : 1.f; const int tcol = (pn & 1) * 256;
            const bool rope = (wc & 1) == 0;
#pragma unroll
            for (int ai = 0; ai < 2; ++ai)
#pragma unroll
                for (int m = 0; m < 4; ++m) { const int row = row0 + ai * 128 + m * 16;
                    f32x4 c0 = {1.f, 1.f, 1.f, 1.f}, c1 = c0, s0 = {0.f, 0.f, 0.f, 0.f}, s1 = s0;
                    if (rope) { c0 = *(const f32x4*)(cosA + (size_t)row * 8); c1 = *(const f32x4*)(cosA + (size_t)row * 8 + 4); s0 = *(const f32x4*)(sinA + (size_t)row * 8); s1 = *(const f32x4*)(sinA + (size_t)row * 8 + 4); }
#pragma unroll
                    for (int bj = 0; bj < 2; ++bj) { f32x4 v0 = acc[ai][bj][m][0], v1 = acc[ai][bj][m][1];
                        const f32x4 p0 = swz16_4(v0), p1 = swz16_4(v1);
                        if (rope && fq < 2) { v0 = (fq == 0) ? (v0 * c0 - p0 * s0) : (v0 * c0 + p0 * s0); v1 = (fq == 0) ? (v1 * c1 - p1 * s1) : (v1 * c1 + p1 * s1); }
                        st_bf8(dst + (size_t)row * 512 + tcol + bj * 128 + wc * 32 + 8 * fq, v0 * sc, v1 * sc); } }
        } else if (pn < 6) {
            bf16_t* vat = (bf16_t*)(ws + WS_VAT);
#pragma unroll
            for (int ai = 0; ai < 2; ++ai)
#pragma unroll
                for (int m = 0; m < 4; ++m) { const int row = row0 + ai * 128 + m * 16; const int b = row >> 12, s = row & 4095, ps = (s & ~15) | perm16(s & 15);
#pragma unroll
                    for (int bj = 0; bj < 2; ++bj) { const int c = (pn - 4) * 256 + bj * 128 + wc * 32 + 8 * fq; const int h = c >> 6, d = c & 63;
                        st_vt8(vat + ((size_t)(b * 8 + h) * 64 + d) * SEQ + ps, acc[ai][bj][m][0], acc[ai][bj][m][1]); } }
        } else if (pn == 8) {
            bf16_t* ik = (bf16_t*)(ws + WS_IK); float* iw = (float*)(ws + WS_IW); bf16_t* kc = (bf16_t*)(ws + WS_KC); bf16_t* cd = (bf16_t*)(ws + WS_CDKV); float* ssq = (float*)(ws + WS_SSQ);
#pragma unroll
            for (int ai = 0; ai < 2; ++ai)
#pragma unroll
                for (int m = 0; m < 4; ++m) { const int row = row0 + ai * 128 + m * 16;
                    { f32x4 v0 = acc[ai][0][m][0], v1 = acc[ai][0][m][1];
                      { unsigned zz = 0u; asm volatile("" : "+v"(zz)); const u32x4 z = {zz, zz, zz, zz}; *(u32x4*)(cd + (size_t)row * 256 + wc * 32 + 8 * fq) = z; }
                      if (wc == 0) {
                          const f32x4 p0 = swz16_4(v0), p1 = swz16_4(v1);
                          if (fq < 2) { const f32x4 c0 = *(const f32x4*)(cosA + (size_t)row * 8), c1 = *(const f32x4*)(cosA + (size_t)row * 8 + 4), s0 = *(const f32x4*)(sinA + (size_t)row * 8), s1 = *(const f32x4*)(sinA + (size_t)row * 8 + 4);
                              v0 = (fq == 0) ? (v0 * c0 - p0 * s0) : (v0 * c0 + p0 * s0); v1 = (fq == 0) ? (v1 * c1 - p1 * s1) : (v1 * c1 + p1 * s1); }
                          st_bf8(ik + (size_t)row * 64 + 8 * fq, v0, v1);
                      } else if (wc == 1) { st_bf8(ik + (size_t)row * 64 + 32 + 8 * fq, v0, v1);
                      } else if (wc == 2) { if (fq == 0) { *(f32x4*)(iw + (size_t)row * 8) = v0 * IW_SCALE; *(f32x4*)(iw + (size_t)row * 8 + 4) = v1 * IW_SCALE; }
                      } else {
                          const bool up = fq >= 2; const f32x4 p0 = other32_4(v0, up), p1 = other32_4(v1, up);
                          const f32x4 c0 = *(const f32x4*)(cosC + (size_t)row * 16 + 8 * (fq & 1)), c1 = *(const f32x4*)(cosC + (size_t)row * 16 + 8 * (fq & 1) + 4), s0 = *(const f32x4*)(sinC + (size_t)row * 16 + 8 * (fq & 1)), s1 = *(const f32x4*)(sinC + (size_t)row * 16 + 8 * (fq & 1) + 4);
                          const f32x4 o0 = up ? (v0 * c0 + p0 * s0) : (v0 * c0 - p0 * s0), o1 = up ? (v1 * c1 + p1 * s1) : (v1 * c1 - p1 * s1);
                          bf16_t* p = kc + (size_t)row * 768 + 64 + 8 * fq;
#pragma unroll
                          for (int h = 0; h < 8; ++h) st_bf8(p + h * 96, o0, o1); } }
                    { const f32x4 v0 = acc[ai][1][m][0], v1 = acc[ai][1][m][1];
                      st_bf8(cd + (size_t)row * 256 + 128 + wc * 32 + 8 * fq, v0, v1);
                      float s = (v0[0] * v0[0] + v0[1] * v0[1]) + (v0[2] * v0[2] + v0[3] * v0[3]) + (v1[0] * v1[0] + v1[1] * v1[1]) + (v1[2] * v1[2] + v1[3] * v1[3]);
                      s += xswz<16>(s); s = xsum32(s);
                      if (fq == 0) ssq[(size_t)row * 8 + 4 + wc] = s; } }
        } else if (pn < 13) {
            bf16_t* dst = (bf16_t*)(ws + (pn < 11 ? WS_U : WS_V)); const int tcol = ((pn - 9) & 1) * 256;
#pragma unroll
            for (int ai = 0; ai < 2; ++ai)
#pragma unroll
                for (int m = 0; m < 4; ++m) { const int row = row0 + ai * 128 + m * 16;
#pragma unroll
                    for (int bj = 0; bj < 2; ++bj) { f32x4 v0 = acc[ai][bj][m][0], v1 = acc[ai][bj][m][1];
                        v0[0] = gelu_f(v0[0]); v0[1] = gelu_f(v0[1]); v0[2] = gelu_f(v0[2]); v0[3] = gelu_f(v0[3]); v1[0] = gelu_f(v1[0]); v1[1] = gelu_f(v1[1]); v1[2] = gelu_f(v1[2]); v1[3] = gelu_f(v1[3]);
                        st_bf8(dst + (size_t)row * 512 + tcol + bj * 128 + wc * 32 + 8 * fq, v0, v1); } }
        } else if (pn == 13) {
            bf16_t* cd = (bf16_t*)(ws + WS_CDQ); float* ssq = (float*)(ws + WS_SSQ);
#pragma unroll
            for (int ai = 0; ai < 2; ++ai)
#pragma unroll
                for (int m = 0; m < 4; ++m) { const int row = row0 + ai * 128 + m * 16; float s = 0.f;
#pragma unroll
                    for (int bj = 0; bj < 2; ++bj) { const f32x4 v0 = acc[ai][bj][m][0], v1 = acc[ai][bj][m][1];
                        st_bf8(cd + (size_t)row * 256 + bj * 128 + wc * 32 + 8 * fq, v0, v1);
                        s += ((v0[0] * v0[0] + v0[1] * v0[1]) + (v0[2] * v0[2] + v0[3] * v0[3])) + ((v1[0] * v1[0] + v1[1] * v1[1]) + (v1[2] * v1[2] + v1[3] * v1[3])); }
                    s += xswz<16>(s); s = xsum32(s);
                    if (fq == 0) ssq[(size_t)row * 8 + wc] = s; }
        } else {
            const int tcol = (pn - 14) * 256; bf16_t* gate = (bf16_t*)(ws + WS_GATE);
#pragma unroll
            for (int ai = 0; ai < 2; ++ai)
#pragma unroll
                for (int m = 0; m < 4; ++m) { const int row = row0 + ai * 128 + m * 16;
#pragma unroll
                    for (int bj = 0; bj < 2; ++bj) { f32x4 v0 = acc[ai][bj][m][0], v1 = acc[ai][bj][m][1];
                        v0[0] = sigmoid_f(v0[0]); v0[1] = sigmoid_f(v0[1]); v0[2] = sigmoid_f(v0[2]); v0[3] = sigmoid_f(v0[3]); v1[0] = sigmoid_f(v1[0]); v1[1] = sigmoid_f(v1[1]); v1[2] = sigmoid_f(v1[2]); v1[3] = sigmoid_f(v1[3]);
                        st_bf8(gate + (size_t)row * 3072 + tcol + bj * 128 + wc * 32 + 8 * fq, v0, v1); } }
        }
    }
};

struct EpiQUp {
    static constexpr bool CHAIN = false; static constexpr bool PRE = false;
    bf16_t* qc; const float* ssq; const float *cosC, *sinC;
    __device__ __forceinline__ void operator()(f32x4 (&acc)[2][2][4][2], const Unit& un, int wr, int wc, int fr, int fq) const {
        const int row0 = un.pm * 256 + wr * 64 + fr; const bool up = fq >= 2;
#pragma unroll
        for (int ai = 0; ai < 2; ++ai)
#pragma unroll
            for (int m = 0; m < 4; ++m) { const int row = row0 + ai * 128 + m * 16;
                const f32x4 sp = *(const f32x4*)(ssq + (size_t)row * 8);
                const float rs = rsqrtf(((sp[0] + sp[1]) + (sp[2] + sp[3])) * (1.f / 256.f) + RMS_EPS) * QSCALE_C;
                const f32x4 c0 = *(const f32x4*)(cosC + (size_t)row * 16 + 8 * (fq & 1)), c1 = *(const f32x4*)(cosC + (size_t)row * 16 + 8 * (fq & 1) + 4), s0 = *(const f32x4*)(sinC + (size_t)row * 16 + 8 * (fq & 1)), s1 = *(const f32x4*)(sinC + (size_t)row * 16 + 8 * (fq & 1) + 4);
#pragma unroll
                for (int bj = 0; bj < 2; ++bj) { const int gidx = un.pn * 8 + bj * 4 + wc;
                    f32x4 v0 = acc[ai][bj][m][0] * rs, v1 = acc[ai][bj][m][1] * rs;
                    if ((gidx % 3) == 2) { const f32x4 p0 = other32_4(v0, up), p1 = other32_4(v1, up);
                        v0 = up ? (v0 * c0 + p0 * s0) : (v0 * c0 - p0 * s0); v1 = up ? (v1 * c1 + p1 * s1) : (v1 * c1 - p1 * s1); }
                    st_bf8(qc + (size_t)row * 768 + gidx * 32 + 8 * fq, v0, v1); } }
    }
};
struct EpiKvUp {
    static constexpr bool CHAIN = false; static constexpr bool PRE = false;
    bf16_t *kc, *vct; const float* ssq;
    __device__ __forceinline__ void operator()(f32x4 (&acc)[2][2][4][2], const Unit& un, int wr, int wc, int fr, int fq) const {
        const int row0 = un.pm * 256 + wr * 64 + fr;
#pragma unroll
        for (int ai = 0; ai < 2; ++ai)
#pragma unroll
            for (int m = 0; m < 4; ++m) { const int row = row0 + ai * 128 + m * 16;
                const f32x4 sp = *(const f32x4*)(ssq + (size_t)row * 8 + 4);
                const float rs = rsqrtf(((sp[0] + sp[1]) + (sp[2] + sp[3])) * (1.f / 128.f) + RMS_EPS);
                const int b = row >> 12, s = row & 4095, ps = (s & ~15) | perm16(s & 15);
#pragma unroll
                for (int bj = 0; bj < 2; ++bj) { const int h = un.pn * 2 + bj; const f32x4 v0 = acc[ai][bj][m][0] * rs, v1 = acc[ai][bj][m][1] * rs;
                    if (wc < 2) st_bf8(kc + (size_t)row * 768 + h * 96 + wc * 32 + 8 * fq, v0, v1);
                    else st_vt8(vct + ((size_t)(b * 8 + h) * 64 + (wc - 2) * 32 + 8 * fq) * SEQ + ps, v0, v1); }
                asm volatile("" ::: "memory"); }
    }
};
struct EpiMerge {
    static constexpr bool CHAIN = true; static constexpr bool PRE = false;
    const bf16_t* gate; bf16_t* merged;
    __device__ __forceinline__ void operator()(f32x4 (&acc)[2][2][4][2], const Unit& un, int wr, int wc, int fr, int fq) const {
        const int n3 = un.pm >> 7, pm = un.pm & 127, pn = un.pn & 3; const int row0 = pm * 256 + wr * 64 + fr;
#pragma unroll
        for (int ai = 0; ai < 2; ++ai)
#pragma unroll
            for (int m = 0; m < 4; ++m) { const int row = row0 + ai * 128 + m * 16;
#pragma unroll
                for (int bj = 0; bj < 2; ++bj) { const int col = pn * 256 + bj * 128 + wc * 32 + 8 * fq;
                    const bf16_t* gp = gate + (size_t)row * 3072 + n3 * 1024 + col;
                    f32x4 ga0, ga1; ld_bf8(gp, ga0, ga1);
                    if (n3 < 2) { f32x4 gb0, gb1; ld_bf8(gp + 1024, gb0, gb1);
#pragma unroll
                        for (int j = 0; j < 4; ++j) { if (n3 == 1) { ga0[j] = fmaxf(ga0[j], 1e-20f); ga1[j] = fmaxf(ga1[j], 1e-20f); }
                            acc[ai][bj][m][0][j] *= ga0[j] * __builtin_amdgcn_rcpf(fmaxf(gb0[j], 1e-20f)); acc[ai][bj][m][1][j] *= ga1[j] * __builtin_amdgcn_rcpf(fmaxf(gb1[j], 1e-20f)); }
                    } else {
#pragma unroll
                        for (int j = 0; j < 4; ++j) { ga0[j] = fmaxf(ga0[j], 1e-20f); ga1[j] = fmaxf(ga1[j], 1e-20f); }
                        st_bf8(merged + (size_t)row * 1024 + col, acc[ai][bj][m][0] * ga0, acc[ai][bj][m][1] * ga1);
                        acc[ai][bj][m][0] = (f32x4){0.f, 0.f, 0.f, 0.f}; acc[ai][bj][m][1] = (f32x4){0.f, 0.f, 0.f, 0.f};
                    } } }
    }
};
struct EpiOut {
    static constexpr bool CHAIN = false; static constexpr bool PRE = false;
    bf16_t* yo;
    __device__ __forceinline__ void operator()(f32x4 (&acc)[2][2][4][2], const Unit& un, int wr, int wc, int fr, int fq) const {
        const int row0 = un.pm * 256 + wr * 64 + fr;
#pragma unroll
        for (int ai = 0; ai < 2; ++ai)
#pragma unroll
            for (int m = 0; m < 4; ++m) { const int row = row0 + ai * 128 + m * 16;
#pragma unroll
                for (int bj = 0; bj < 2; ++bj) st_bf8(yo + (size_t)row * 1024 + un.pn * 256 + bj * 128 + wc * 32 + 8 * fq, acc[ai][bj][m][0], acc[ai][bj][m][1]); }
    }
};
struct EpiMoeUp {
    static constexpr bool CHAIN = false; static constexpr bool PRE = true;
    bf16_t* hbuf; const float* bgu;
    __device__ __forceinline__ const float* pre_base(const Unit& un, int w) const { const int e = un.pn >> 3, pnl = un.pn & 7; return bgu + (size_t)e * 2048 + pnl * 128 + (w < 2 ? w * 64 : 1024 + (w - 2) * 64); }
    __device__ __forceinline__ void operator()(f32x4 (&acc)[2][2][4][2], const Unit& un, int wr, int wc, int fr, int fq, const LAS float* pre) const {
        const int pnl = un.pn & 7; const int row0 = un.pm * 256 + wr * 64 + fr;
        const int jh = pnl * 128 + wc * 32 + 8 * fq; const LAS float* pb = pre + wc * 32 + 8 * fq;
        const f32x4 bg0 = *(const LAS f32x4*)(pb), bg1 = *(const LAS f32x4*)(pb + 4), bl0 = *(const LAS f32x4*)(pb + 128), bl1 = *(const LAS f32x4*)(pb + 132);
#pragma unroll
        for (int ai = 0; ai < 2; ++ai)
#pragma unroll
            for (int m = 0; m < 4; ++m) { const int row = row0 + ai * 128 + m * 16;
                const f32x4 g0 = acc[ai][0][m][0] + bg0, g1 = acc[ai][0][m][1] + bg1, l0 = acc[ai][1][m][0] + bl0, l1 = acc[ai][1][m][1] + bl1; f32x4 o0, o1;
#pragma unroll
                for (int j = 0; j < 4; ++j) { const float ga = fminf(g0[j], 7.f), la = fminf(fmaxf(l0[j], -7.f), 7.f); o0[j] = (la + 1.f) * (ga * sigmoid_f(1.702f * ga));
                    const float gb = fminf(g1[j], 7.f), lb = fminf(fmaxf(l1[j], -7.f), 7.f); o1[j] = (lb + 1.f) * (gb * sigmoid_f(1.702f * gb)); }
                st_bf8(hbuf + (size_t)row * 1024 + jh, o0, o1);
                __builtin_amdgcn_sched_barrier(0); }
    }
};
struct EpiMoeDn {
    static constexpr bool CHAIN = false; static constexpr bool PRE = true;
    bf16_t* y; const float* bdn; bool skip;
    __device__ __forceinline__ const float* pre_base(const Unit& un, int w) const { const int e = un.pn >> 2, pnl = un.pn & 3; return bdn + (size_t)e * 1024 + pnl * 256 + w * 64; }
    __device__ __forceinline__ void operator()(f32x4 (&acc)[2][2][4][2], const Unit& un, int wr, int wc, int fr, int fq, const LAS float* pre) const {
        const int pnl = un.pn & 3; const int row0 = (skip ? 0 : un.pm * 256) + wr * 64 + fr;
#pragma unroll
        for (int bj = 0; bj < 2; ++bj) { const int col = pnl * 256 + bj * 128 + wc * 32 + 8 * fq; const LAS float* pb = pre + bj * 128 + wc * 32 + 8 * fq; const f32x4 b0 = *(const LAS f32x4*)(pb), b1 = *(const LAS f32x4*)(pb + 4);
#pragma unroll
            for (int ai = 0; ai < 2; ++ai)
#pragma unroll
                for (int m = 0; m < 4; ++m) st_bf8(y + (size_t)(row0 + ai * 128 + m * 16) * 1024 + col, acc[ai][bj][m][0] + b0, acc[ai][bj][m][1] + b1); }
    }
};

__device__ __forceinline__ float wave_sum(float v) {
    v += xswz<1>(v); v += xswz<2>(v); v += xswz<4>(v); v += xswz<8>(v); v += xswz<16>(v); return xsum32(v);
}
__device__ __forceinline__ int colmap_in(int np) {
    if (np < 2048) return np;
    if (np < 2304) { const int t = np - 2048; if (t < 64) return 2048 + t; if (t < 72) return 2112 + (t - 64); if (t < 96) return -1; if (t < 128) return 3528 + (t - 96); return 3400 + (t - 128); }
    if (np < 3328) return 2120 + (np - 2304);
    if (np < 3584) return 3144 + (np - 3328);
    return 3560 + (np - 3584);
}
__device__ __forceinline__ int colmap_gu(int np) { const int tile = np >> 8, w = np & 255; return (w < 128) ? (tile * 128 + w) : (1024 + tile * 128 + (w - 128)); }
template <int KIND>
__device__ __forceinline__ void tconv_item(const float* src, int ldsrc, bf16_t* dst, int Kdst, int koff, const float* kscale, int item, int nblk, LAS float* scr, int lane) {
    const int kb = item / nblk, nb = item - kb * nblk, k0 = 64 * kb, n0 = 32 * nb;
    const int np = n0 + (lane & 31);
    const int col = KIND == 1 ? colmap_in(np) : (KIND == 2 ? colmap_gu(np) : np);
    float vv[32];
#pragma unroll
    for (int i = 0; i < 32; ++i) { const int kk = 2 * i + (lane >> 5); const int ks = k0 + kk - koff; float v = 0.f;
        if (col >= 0 && ks >= 0) { v = src[(size_t)ks * ldsrc + col]; if (kscale) v *= kscale[ks]; }
        vv[i] = v; }
#pragma unroll
    for (int i = 0; i < 32; ++i) { const int kk = 2 * i + (lane >> 5); scr[kk * 33 + (lane & 31)] = vv[i]; }
    LDS_WAIT(); asm volatile("" ::: "memory");
    const int c = lane & 7;
#pragma unroll
    for (int j = 0; j < 4; ++j) { const int n = (lane >> 3) + 8 * j; const LAS float* s = scr + (8 * c) * 33 + n;
        u32x4 o; o.x = pk2(s[0 * 33], s[1 * 33]); o.y = pk2(s[2 * 33], s[3 * 33]); o.z = pk2(s[4 * 33], s[5 * 33]); o.w = pk2(s[6 * 33], s[7 * 33]);
        *(u32x4*)(dst + (size_t)(n0 + n) * Kdst + k0 + 8 * c) = o; }
    LDS_WAIT(); asm volatile("" ::: "memory");
}
__device__ __forceinline__ void phase_prologue(const Ctx& C, const Args& A) {
    LAS float* scr = (LAS float*)(C.lds + C.wave * 16384);
    const int gw = C.bid * NWAVES + C.wave, NGW = C.G * NWAVES;
    constexpr int I_IN = 16 * (NIN / 32), I_UQ = 4 * 24, I_UKV = 4 * 32, I_BR = 8 * 32, I_OUT = 16 * 32, I_GU = 16 * 64, I_DN = 16 * 32;
    constexpr int I_LAYER = I_IN + I_UQ + I_UKV + 3 * I_BR + I_OUT + NEXP * I_GU + NEXP * I_DN;
    for (int it = gw; it < NLAYER * I_LAYER; it += NGW) {
        const int l = it / I_LAYER; int r = it - l * I_LAYER;
        if (r < I_IN) { tconv_item<1>(A.in[2] + (size_t)l * DM * NIN_SRC, NIN_SRC, WSP(bf16_t, WS_WIN + l * SZ_WIN), 1024, 0, nullptr, r, NIN / 32, scr, C.lane); continue; } r -= I_IN;
        if (r < I_UQ) { tconv_item<0>(A.in[9] + (size_t)l * 256 * 768, 768, WSP(bf16_t, WS_WUQ + l * SZ_WUQ), 256, 0, A.in[7] + l * 256, r, 24, scr, C.lane); continue; } r -= I_UQ;
        if (r < I_UKV) { tconv_item<0>(A.in[10] + (size_t)l * 128 * 1024, 1024, WSP(bf16_t, WS_WUKV + l * SZ_WUKV), 256, 128, A.in[8] + l * 128, r, 32, scr, C.lane); continue; } r -= I_UKV;
        if (r < 3 * I_BR) { const int n = r / I_BR; r -= n * I_BR;
            tconv_item<0>(A.in[11] + ((size_t)l * 3 + n) * 512 * 1024, 1024, WSP(bf16_t, WS_WBR + l * SZ_WBR) + (size_t)n * 1024 * 512, 512, 0, nullptr, r, 32, scr, C.lane); continue; } r -= 3 * I_BR;
        if (r < I_OUT) { tconv_item<0>(A.in[12] + (size_t)l * 1024 * 1024, 1024, WSP(bf16_t, WS_WOUT + l * SZ_WOUT), 1024, 0, nullptr, r, 32, scr, C.lane); continue; } r -= I_OUT;
        if (r < NEXP * I_GU) { const int e = r / I_GU; r -= e * I_GU;
            tconv_item<2>(A.in[17] + ((size_t)l * NEXP + e) * 1024 * 2048, 2048, WSP(bf16_t, WS_WGU + l * SZ_WGU) + (size_t)e * 2048 * 1024, 1024, 0, nullptr, r, 64, scr, C.lane); continue; } r -= NEXP * I_GU;
        { const int e = r / I_DN; r -= e * I_DN;
            tconv_item<0>(A.in[19] + ((size_t)l * NEXP + e) * 1024 * 1024, 1024, WSP(bf16_t, WS_WDN + l * SZ_WDN) + (size_t)e * 1024 * 1024, 1024, 0, nullptr, r, 32, scr, C.lane); }
    }
    const int gt = C.bid * 512 + C.tid, NGT = C.G * 512;
    { float* rwt = WSP(float, WS_RWT);
      for (int i = gt; i < NLAYER * 32 * 1024; i += NGT) { const int l = i >> 15, e = (i >> 10) & 31, k = i & 1023; rwt[i] = A.in[15][(size_t)l * 32768 + k * 32 + e] * A.in[13][l * 1024 + k]; }
      const int gwv = C.bid * NWAVES + C.wave;
      if (gwv < NLAYER * 32) { const int l = gwv >> 5, e = gwv & 31; const float* rw = A.in[15] + (size_t)l * 32768; const float* g1 = A.in[13] + l * 1024; const float* b1 = A.in[14] + l * 1024;
          float sg = 0.f, sb = 0.f;
#pragma unroll
          for (int j = 0; j < 16; ++j) { const int k = C.lane + 64 * j; sg += rw[k * 32 + e] * g1[k]; sb += b1[k] * rw[k * 32 + e]; }
          sg = wave_sum(sg); sb = wave_sum(sb);
          if (C.lane == 0) { float* gb = WSP(float, WS_GBW) + l * 64; gb[e] = sg; gb[32 + e] = sb + A.in[16][l * 32 + e]; } } }
    { bf16_t* d = WSP(bf16_t, WS_WGM); const float* s = A.in[5];
      for (int i = gt; i < NLAYER * 8 * 128 * 128; i += NGT) { const int jj = i & 127, ii = (i >> 7) & 127; d[i] = (jj <= ii) ? (bf16_t)(pk2(s[i], 0.f) & 0xffff) : (bf16_t)0; } }
    { const int* pos = (const int*)A.in[1]; float *ca = WSP(float, WS_COSA), *sa = WSP(float, WS_SINA), *cc = WSP(float, WS_COSC), *sc = WSP(float, WS_SINC);
      for (int i = gt; i < NTOK * 8; i += NGT) { const int t = i >> 3, f = i & 7; const float inv = powf(500000.f, -(float)f / 8.f); const float ang = (float)pos[t] * inv; ca[i] = cosf(ang); sa[i] = sinf(ang); }
      for (int i = gt; i < NTOK * 16; i += NGT) { const int t = i >> 4, f = i & 15; const float inv = powf(500000.f, -(float)f / 16.f); const float ang = (float)pos[t] * inv; cc[i] = cosf(ang); sc[i] = sinf(ang); } }
    { const f32x4* x4 = (const f32x4*)A.in[0]; u32x2* xb = WSP(u32x2, WS_XB);
      for (int i = gt; i < NTOK * DM / 4; i += NGT) { const f32x4 v = x4[i]; u32x2 w; w.x = pk2(v[0], v[1]); w.y = pk2(v[2], v[3]); xb[i] = w; } }
}

__device__ __forceinline__ void idx_block(const Ctx& C, int b, int qb) {
    const int tid = C.tid, lane = C.lane, wid = C.wave, r32 = lane & 31, hi = lane >> 5;
    const bf16_t* iq = WSP(bf16_t, WS_IQ); const bf16_t* ik = WSP(bf16_t, WS_IK); const float* iw = WSP(float, WS_IW); float* score = WSP(float, WS_SCORE);
    const int qi_l = ((r32 >> 4) << 1) + ((r32 >> 2) & 1), h_l = (r32 & 3) + 4 * ((r32 >> 3) & 1);
    bf16x8 af[2][4]; float wv[2][2][8];
#pragma unroll
    for (int rb = 0; rb < 2; ++rb) { const size_t tok = (size_t)b * SEQ + qb * 64 + wid * 8 + rb * 4 + qi_l;
#pragma unroll
        for (int ks = 0; ks < 4; ++ks) af[rb][ks] = *(const bf16x8*)(iq + tok * 512 + h_l * 64 + ks * 16 + hi * 8);
#pragma unroll
        for (int g = 0; g < 2; ++g) { const size_t tq = (size_t)b * SEQ + qb * 64 + wid * 8 + rb * 4 + 2 * g + hi;
            const f32x4 w0 = *(const f32x4*)(iw + tq * 8), w1 = *(const f32x4*)(iw + tq * 8 + 4);
            wv[rb][g][0] = w0[0]; wv[rb][g][1] = w0[1]; wv[rb][g][2] = w0[2]; wv[rb][g][3] = w0[3]; wv[rb][g][4] = w1[0]; wv[rb][g][5] = w1[1]; wv[rb][g][6] = w1[2]; wv[rb][g][7] = w1[3]; } }
    const int lkey = tid & 63, lch = tid >> 6;
    const bf16_t* ksrc = ik + ((size_t)b * SEQ + lkey) * 64 + lch * 8;
    LAS unsigned char* kdst = C.lds + (lch * 64 + lkey) * 16;
    const int NT = qb + 1;
    u32x4 rk = *(const u32x4*)ksrc;
    *(LAS u32x4*)kdst = rk;
    __syncthreads();
    for (int kt = 0; kt < NT; ++kt) {
        const int cur = kt & 1;
        if (kt + 1 < NT) rk = *(const u32x4*)(ksrc + (size_t)(kt + 1) * 64 * 64);
        const LAS unsigned char* kb = C.lds + cur * 8192;
        bf16x8 bfr[2][4];
#pragma unroll
        for (int kbk = 0; kbk < 2; ++kbk)
#pragma unroll
            for (int ks = 0; ks < 4; ++ks) bfr[kbk][ks] = *(const LAS bf16x8*)(kb + ((2 * ks + hi) * 64 + kbk * 32 + r32) * 16);
#pragma unroll
        for (int rb = 0; rb < 2; ++rb)
#pragma unroll
            for (int kbk = 0; kbk < 2; ++kbk) {
                f32x16 a = {};
#pragma unroll
                for (int ks = 0; ks < 4; ++ks) a = __builtin_amdgcn_mfma_f32_32x32x16_bf16(af[rb][ks], bfr[kbk][ks], a, 0, 0, 0);
#pragma unroll
                for (int g = 0; g < 2; ++g) { float s = 0.f;
#pragma unroll
                    for (int hh = 0; hh < 8; ++hh) s = fmaf(fmaxf(a[8 * g + hh], 0.f), wv[rb][g][hh], s);
                    const size_t tq = (size_t)b * SEQ + qb * 64 + wid * 8 + rb * 4 + 2 * g + hi;
                    score[tq * SEQ + kt * 64 + kbk * 32 + r32] = s; } }
        if (kt + 1 < NT) *(LAS u32x4*)(kdst + (cur ^ 1) * 8192) = rk;
        __syncthreads();
    }
}
__device__ __forceinline__ void phase_indexer(const Ctx& C) {
    for (int u0 = C.bid; u0 < NB * 32; u0 += C.G) {
        int u = u0; if (C.G == NB * 32) u = (C.bid & 7) * 32 + (C.bid >> 3);
        const int b = u >> 5, p = u & 31; idx_block(C, b, p); idx_block(C, b, 63 - p); }
}

__device__ __forceinline__ unsigned f2key(float f) { const unsigned u = __float_as_uint(f); return (u & 0x80000000u) ? ~u : (u | 0x80000000u); }
__device__ __forceinline__ int wave_total7(unsigned cv) {
    int t = 0;
#pragma unroll
    for (int b = 0; b < 7; ++b) t += __popcll(__ballot((cv >> b) & 1u)) << b;
    return t;
}
template <int NG>
__device__ __forceinline__ unsigned select_radix(const unsigned (&u)[64]) {
    unsigned prefix = 0u;
    for (int bit = 31; bit >= 0; --bit) {
        const unsigned cand = prefix | (1u << bit); unsigned cv = 0u;
#pragma unroll
        for (int i = 0; i < NG * 8; ++i) cv += (u[i] >= cand) ? 1u : 0u;
        const int cnt = wave_total7(cv);
        if (cnt >= 256) prefix = cand;
        if (cnt == 256) break;
    }
    return prefix;
}
__device__ __forceinline__ int wave_sum_dpp(int x) {
    x += __builtin_amdgcn_update_dpp(0, x, 0xB1, 0xf, 0xf, true);
    x += __builtin_amdgcn_update_dpp(0, x, 0x4E, 0xf, 0xf, true);
    x += __builtin_amdgcn_update_dpp(0, x, 0x141, 0xf, 0xf, true);
    x += __builtin_amdgcn_update_dpp(0, x, 0x140, 0xf, 0xf, true);
    x += __builtin_amdgcn_update_dpp(0, x, 0x142, 0xa, 0xf, false);
    x += __builtin_amdgcn_update_dpp(0, x, 0x143, 0xc, 0xf, false);
    return __builtin_amdgcn_readlane(x, 63);
}
__device__ __forceinline__ unsigned bfi32(unsigned m, unsigned x, unsigned y) { return (m & x) | (~m & y); }
__device__ __forceinline__ void bit_transpose32(unsigned* a) {
#pragma unroll
    for (int k = 0; k < 16; ++k) { const unsigned x = a[k], y = a[k + 16]; a[k] = __builtin_amdgcn_perm(y, x, 0x05040100u); a[k + 16] = __builtin_amdgcn_perm(y, x, 0x07060302u); }
#pragma unroll
    for (int k = 0; k < 32; ++k) if ((k & 8) == 0) { const unsigned x = a[k], y = a[k + 8]; a[k] = __builtin_amdgcn_perm(y, x, 0x06020400u); a[k + 8] = __builtin_amdgcn_perm(y, x, 0x07030501u); }
#pragma unroll
    for (int k = 0; k < 32; ++k) if ((k & 4) == 0) { const unsigned x = a[k], y = a[k + 4]; a[k] = bfi32(0x0f0f0f0fu, x, y << 4); a[k + 4] = bfi32(0x0f0f0f0fu, x >> 4, y); }
#pragma unroll
    for (int k = 0; k < 32; ++k) if ((k & 2) == 0) { const unsigned x = a[k], y = a[k + 2]; a[k] = bfi32(0x33333333u, x, y << 2); a[k + 2] = bfi32(0x33333333u, x >> 2, y); }
#pragma unroll
    for (int k = 0; k < 32; ++k) if ((k & 1) == 0) { const unsigned x = a[k], y = a[k + 1]; a[k] = bfi32(0x55555555u, x, y << 1); a[k + 1] = bfi32(0x55555555u, x >> 1, y); }
}
template <int NW>
__device__ __forceinline__ void select_bits(const float* row, int n, unsigned* mrow, int lane) {
    constexpr int W = 32 * NW;
    unsigned a[W];
    {   const u32x4* src = (const u32x4*)(row + lane * W);
#pragma unroll
        for (int i = 0; i < W / 4; ++i) { const u32x4 v = src[i];
#pragma unroll
            for (int j = 0; j < 4; ++j) { const unsigned u = v[j]; a[4 * i + j] = u ^ ((unsigned)((int)u >> 31) | 0x80000000u); } }
    }
#pragma unroll
    for (int blk = 0; blk < NW; ++blk) bit_transpose32(a + 32 * blk);
    unsigned alive[NW], above[NW];
#pragma unroll
    for (int w = 0; w < NW; ++w) { const int nv = n - lane * W - 32 * w; alive[w] = nv >= 32 ? 0xffffffffu : (nv <= 0 ? 0u : ((1u << nv) - 1u)); above[w] = 0u; }
    int cnta = 0; bool exact = false;
#pragma unroll
    for (int b = 31; b >= 0; --b) {
        unsigned o[NW]; int pc = 0;
#pragma unroll
        for (int w = 0; w < NW; ++w) { o[w] = alive[w] & a[32 * w + b]; pc += __popc(o[w]); }
        const int tot = cnta + wave_sum_dpp(pc);
        if (tot >= 256) {
#pragma unroll
            for (int w = 0; w < NW; ++w) alive[w] = o[w];
            if (tot == 256) { exact = true; break; }
        } else {
#pragma unroll
            for (int w = 0; w < NW; ++w) { above[w] |= o[w]; alive[w] ^= o[w]; }
            cnta = tot;
        }
    }
    if (!exact) {
        int pc = 0;
#pragma unroll
        for (int w = 0; w < NW; ++w) pc += __popc(alive[w]);
        const int ceq = wave_sum_dpp(pc), need = 256 - cnta;
        if (ceq > need) {
            int excl = 0;
#pragma unroll 1
            for (int L = 0; L < 63; ++L) { const int v = __builtin_amdgcn_readlane(pc, L); excl += (lane > L) ? v : 0; }
            int take = need - excl; take = take < 0 ? 0 : (take > pc ? pc : take);
            int c = pc;
            if (NW == 2) { while (c > take && alive[NW - 1] != 0u) { alive[NW - 1] &= ~(0x80000000u >> __clz(alive[NW - 1])); --c; } }
            while (c > take) { alive[0] &= ~(0x80000000u >> __clz(alive[0])); --c; }
        }
    }
    if (NW == 2) { u32x2 m; m.x = above[0] | alive[0]; m.y = above[NW - 1] | alive[NW - 1]; *(u32x2*)(mrow + 2 * lane) = m; }
    else { mrow[lane] = above[0] | alive[0]; mrow[64 + lane] = 0u; }
}
__device__ __forceinline__ void phase_select(const Ctx& C) {
    const float* score = WSP(float, WS_SCORE); unsigned long long* mask = WSP(unsigned long long, WS_MASK);
    const int gw = C.bid * NWAVES + C.wave, NGW = C.G * NWAVES, lane = C.lane;
    for (int idx = gw; idx < NTOK; idx += NGW) {
        const int q = idx & (SEQ - 1); const int n = q + 1; const float* row = score + (size_t)idx * SEQ;
        if (n <= 256) {
            const int lo = n - 64 * lane;
            const unsigned long long m = lo >= 64 ? ~0ull : (lo <= 0 ? 0ull : ((1ull << lo) - 1ull));
            mask[(size_t)idx * 64 + lane] = m;
        } else if (n <= 2048) select_bits<1>(row, n, (unsigned*)(mask + (size_t)idx * 64), lane);
        else select_bits<2>(row, n, (unsigned*)(mask + (size_t)idx * 64), lane);
    }
}

__device__ __forceinline__ int crow(int r, int hi) { return (r & 3) + 8 * (r >> 2) + 4 * hi; }
template <int DQK, bool MASKED>
__device__ __forceinline__ void attn_unit(const Ctx& C, int b, int h, int qb, const bf16_t* Q, const bf16_t* K, const bf16_t* VT, const unsigned* mask, bf16_t* O,
                                          u32x4& rk0, u32x4& rk1, u32x4& rv, bool pre_in, int nb, int nh, bool has_next) {
    constexpr int NKS = DQK / 16, NCH = DQK / 8, KTB = NCH * 1024, BUF = KTB + 8192, QS = 8 * DQK;
    const int tid = C.tid, lane = C.lane, wid = C.wave, r32 = lane & 31, hi = lane >> 5;
    const int NT = 4 * (qb + 1);
    const size_t tok = (size_t)b * SEQ + qb * 256 + wid * 32 + r32;
    bf16x8 qf[NKS];
#pragma unroll
    for (int ks = 0; ks < NKS; ++ks) qf[ks] = *(const bf16x8*)(Q + tok * QS + h * DQK + ks * 16 + hi * 8);
    const int lrow = tid & 63, lch = tid >> 6;
    const bf16_t* ksrc0 = K + ((size_t)b * SEQ + lrow) * QS + h * DQK + lch * 8;
    const bf16_t* ksrc1 = ksrc0 + 64;
    const bf16_t* vsrc = VT + ((size_t)(b * 8 + h) * 64 + lrow) * SEQ + lch * 8;
    LAS unsigned char* kd0 = C.lds + (lch * 64 + lrow) * 16;
    LAS unsigned char* kd1 = C.lds + ((8 + lch) * 64 + lrow) * 16;
    LAS unsigned char* vd = C.lds + KTB + (lch * 64 + lrow) * 16;
    const bool k1 = (DQK > 64) && (tid < 256);
    if (!pre_in) { rk0 = *(const u32x4*)ksrc0; if (k1) rk1 = *(const u32x4*)ksrc1; rv = *(const u32x4*)vsrc; }
    *(LAS u32x4*)kd0 = rk0; if (k1) *(LAS u32x4*)kd1 = rk1; *(LAS u32x4*)vd = rv;
    u32x2 mw = {0u, 0u};
    if (MASKED) mw = *(const u32x2*)(mask + tok * 128);
    float mbias = 0.f, thr = -1e30f, lsum = 0.f;
    u32x4 qmw = {0u, 0u, 0u, 0u};
    const bf16x8 kone = __builtin_bit_cast(bf16x8, (u32x4){hi == 0 ? 0x3F80u : 0u, 0u, 0u, 0u});
    f32x16 o0 = {}, o1 = {};
    __syncthreads();
    for (int kt = 0; kt < NT; ++kt) {
        const int cur = kt & 1;
        u32x2 mwn = {0u, 0u};
        if (kt + 1 < NT) {
            rk0 = *(const u32x4*)(ksrc0 + (size_t)(kt + 1) * 64 * QS); if (k1) rk1 = *(const u32x4*)(ksrc1 + (size_t)(kt + 1) * 64 * QS);
            rv = *(const u32x4*)(vsrc + (kt + 1) * 64);
            if (MASKED) mwn = *(const u32x2*)(mask + tok * 128 + 2 * (kt + 1));
        } else if (has_next) {
            const bf16_t* nk = K + ((size_t)nb * SEQ + lrow) * QS + nh * DQK + lch * 8;
            rk0 = *(const u32x4*)nk; if (k1) rk1 = *(const u32x4*)(nk + 64); rv = *(const u32x4*)(VT + ((size_t)(nb * 8 + nh) * 64 + lrow) * SEQ + lch * 8);
        }
        const LAS unsigned char* kb = C.lds + cur * BUF; const LAS unsigned char* vb = kb + KTB;
        f32x16 p0 = {}, p1 = {};
        bf16x8 kf[2 * NKS], vf[8];
#pragma unroll
        for (int ks = 0; ks < NKS; ++ks) {
            kf[2 * ks] = *(const LAS bf16x8*)(kb + ((2 * ks + hi) * 64 + r32) * 16);
            kf[2 * ks + 1] = *(const LAS bf16x8*)(kb + ((2 * ks + hi) * 64 + 32 + r32) * 16);
        }
#pragma unroll
        for (int s4 = 0; s4 < 4; ++s4) {
            vf[2 * s4] = *(const LAS bf16x8*)(vb + ((2 * s4 + hi) * 64 + r32) * 16);
            vf[2 * s4 + 1] = *(const LAS bf16x8*)(vb + ((2 * s4 + hi) * 64 + 32 + r32) * 16);
        }
        __builtin_amdgcn_sched_barrier(0);
#pragma unroll
        for (int ks = 0; ks < NKS; ++ks) {
            p0 = __builtin_amdgcn_mfma_f32_32x32x16_bf16(kf[2 * ks], qf[ks], p0, 0, 0, 0);
            p1 = __builtin_amdgcn_mfma_f32_32x32x16_bf16(kf[2 * ks + 1], qf[ks], p1, 0, 0, 0);
        }
        { const bf16x8 qm = __builtin_bit_cast(bf16x8, qmw);
          p0 = __builtin_amdgcn_mfma_f32_32x32x16_bf16(kone, qm, p0, 0, 0, 0); p1 = __builtin_amdgcn_mfma_f32_32x32x16_bf16(kone, qm, p1, 0, 0, 0); }
        if (MASKED) {
            const unsigned w0 = mw.x >> (4 * hi), w1 = mw.y >> (4 * hi);
#pragma unroll
            for (int r = 0; r < 16; ++r) { const int bit = (r & 3) + 8 * (r >> 2);
                const unsigned t0 = (unsigned)__builtin_amdgcn_sbfe((int)w0, bit, 1), t1 = (unsigned)__builtin_amdgcn_sbfe((int)w1, bit, 1);
                p0[r] = __uint_as_float((__float_as_uint(p0[r]) & t0) | (~t0 & 0xFF800000u));
                p1[r] = __uint_as_float((__float_as_uint(p1[r]) & t1) | (~t1 & 0xFF800000u)); }
        } else {
            if (kt >= NT - 4) { const int kb0 = (kt - (NT - 4)) * 64, qrel = wid * 32 + r32;
#pragma unroll
                for (int r = 0; r < 16; ++r) { const int kv = kb0 + crow(r, hi); if (kv > qrel) p0[r] = -INFINITY; if (kv + 32 > qrel) p1[r] = -INFINITY; } }
        }
        float mx;
        { float a0 = fmaxf(fmaxf(p0[0], p0[1]), p0[2]), a1 = fmaxf(fmaxf(p0[3], p0[4]), p0[5]), a2 = fmaxf(fmaxf(p0[6], p0[7]), p0[8]), a3 = fmaxf(fmaxf(p0[9], p0[10]), p0[11]);
          float a4 = fmaxf(fmaxf(p0[12], p0[13]), p0[14]), a5 = fmaxf(fmaxf(p0[15], p1[0]), p1[1]), a6 = fmaxf(fmaxf(p1[2], p1[3]), p1[4]), a7 = fmaxf(fmaxf(p1[5], p1[6]), p1[7]);
          float a8 = fmaxf(fmaxf(p1[8], p1[9]), p1[10]), a9 = fmaxf(fmaxf(p1[11], p1[12]), p1[13]), a10 = fmaxf(p1[14], p1[15]);
          a0 = fmaxf(fmaxf(a0, a1), a2); a3 = fmaxf(fmaxf(a3, a4), a5); a6 = fmaxf(fmaxf(a6, a7), a8); a9 = fmaxf(a9, a10);
          mx = fmaxf(fmaxf(a0, a3), fmaxf(a6, a9)); }
        mx = xmax32(mx);
        if (__any(mx > thr)) {
            const bool upd = mx > thr;
            const float mnew = upd ? __uint_as_float(pk2(mbias + mx, 0.f) << 16) : mbias;
            const float delta = mnew - mbias; const float alpha = (thr < 0.f) ? 1.f : __builtin_amdgcn_exp2f(-delta);
            mbias = mnew; thr = upd ? 4.f : thr;
            qmw.x = hi == 0 ? (pk2(-mnew, 0.f) & 0xffffu) : 0u;
            lsum *= alpha;
#pragma unroll
            for (int r = 0; r < 16; ++r) { o0[r] *= alpha; o1[r] *= alpha; p0[r] -= delta; p1[r] -= delta; }
        }
        {
#pragma unroll
            for (int r = 0; r < 16; ++r) { p0[r] = __builtin_amdgcn_exp2f(p0[r]); p1[r] = __builtin_amdgcn_exp2f(p1[r]); }
            float s0 = (p0[0] + p0[1]) + (p0[2] + p0[3]), s1 = (p0[4] + p0[5]) + (p0[6] + p0[7]), s2 = (p0[8] + p0[9]) + (p0[10] + p0[11]), s3 = (p0[12] + p0[13]) + (p0[14] + p0[15]);
            float s4 = (p1[0] + p1[1]) + (p1[2] + p1[3]), s5 = (p1[4] + p1[5]) + (p1[6] + p1[7]), s6 = (p1[8] + p1[9]) + (p1[10] + p1[11]), s7 = (p1[12] + p1[13]) + (p1[14] + p1[15]);
            lsum += ((s0 + s1) + (s2 + s3)) + ((s4 + s5) + (s6 + s7));
        }
        bf16x8 pf[4];
        { u32x4 t;
          t.x = pk2(p0[0], p0[1]); t.y = pk2(p0[2], p0[3]); t.z = pk2(p0[4], p0[5]); t.w = pk2(p0[6], p0[7]); pf[0] = __builtin_bit_cast(bf16x8, t);
          t.x = pk2(p0[8], p0[9]); t.y = pk2(p0[10], p0[11]); t.z = pk2(p0[12], p0[13]); t.w = pk2(p0[14], p0[15]); pf[1] = __builtin_bit_cast(bf16x8, t);
          t.x = pk2(p1[0], p1[1]); t.y = pk2(p1[2], p1[3]); t.z = pk2(p1[4], p1[5]); t.w = pk2(p1[6], p1[7]); pf[2] = __builtin_bit_cast(bf16x8, t);
          t.x = pk2(p1[8], p1[9]); t.y = pk2(p1[10], p1[11]); t.z = pk2(p1[12], p1[13]); t.w = pk2(p1[14], p1[15]); pf[3] = __builtin_bit_cast(bf16x8, t); }
#pragma unroll
        for (int s = 0; s < 4; ++s) {
            o0 = __builtin_amdgcn_mfma_f32_32x32x16_bf16(vf[2 * s], pf[s], o0, 0, 0, 0);
            o1 = __builtin_amdgcn_mfma_f32_32x32x16_bf16(vf[2 * s + 1], pf[s], o1, 0, 0, 0);
        }
        if (kt + 1 < NT) {
            const int nb = (cur ^ 1) * BUF;
            *(LAS u32x4*)(kd0 + nb) = rk0; if (k1) *(LAS u32x4*)(kd1 + nb) = rk1; *(LAS u32x4*)(vd + nb) = rv;
        }
        mw = mwn;
        __syncthreads();
    }
    lsum = xsum32(lsum);
    const float inv = 1.f / lsum;
    bf16_t* op = O + tok * 512 + h * 64 + 4 * hi;
#pragma unroll
    for (int i = 0; i < 4; ++i) {
        st_bf4(op + 8 * i, (f32x4){o0[4 * i] * inv, o0[4 * i + 1] * inv, o0[4 * i + 2] * inv, o0[4 * i + 3] * inv});
        st_bf4(op + 32 + 8 * i, (f32x4){o1[4 * i] * inv, o1[4 * i + 1] * inv, o1[4 * i + 2] * inv, o1[4 * i + 3] * inv});
    }
}
template <int DQK, bool MASKED>
__device__ __forceinline__ void phase_attn(const Ctx& C, const bf16_t* Q, const bf16_t* K, const bf16_t* VT, const unsigned* mask, bf16_t* O) {
    u32x4 rk0 = {0u, 0u, 0u, 0u}, rk1 = rk0, rv = rk0; bool pre = false;
    for (int u0 = C.bid; u0 < NB * 8 * 8; u0 += C.G) {
        int u = u0; if ((C.G & 7) == 0) { const int r = (C.bid >> 3) + (C.G >> 3) * (u0 / C.G); u = ((C.bid & 7) * 8 + (r >> 3)) * 8 + (r & 7); if (u >= NB * 8 * 8) u = u0; }
        const int bh = u >> 3, p = u & 7, b = bh >> 3, h = bh & 7;
        int nb = b, nh = h; const int u1 = u0 + C.G; const bool more = u1 < NB * 8 * 8;
        if (more) { int un = u1; if ((C.G & 7) == 0) { const int r = (C.bid >> 3) + (C.G >> 3) * (u1 / C.G); un = ((C.bid & 7) * 8 + (r >> 3)) * 8 + (r & 7); if (un >= NB * 8 * 8) un = u1; } nb = un >> 6; nh = (un >> 3) & 7; }
        attn_unit<DQK, MASKED>(C, b, h, 15 - p, Q, K, VT, mask, O, rk0, rk1, rv, pre, b, h, true);
        attn_unit<DQK, MASKED>(C, b, h, p, Q, K, VT, mask, O, rk0, rk1, rv, true, nb, nh, more);
        pre = more; }
}

__device__ __forceinline__ void phase_gmlp(const Ctx& C, const float* lng, const float* lnb, const float* bs, int l) {
    const bf16_t* U = WSP(bf16_t, WS_U); const bf16_t* V = WSP(bf16_t, WS_V); bf16_t* OB = WSP(bf16_t, WS_OBUF) + (size_t)NTOK * 512;
    const bf16_t* WG = WSP(bf16_t, WS_WGM + l * SZ_WGM);
    const int tid = C.tid, lane = C.lane, wid = C.wave, r32 = lane & 31, hi = lane >> 5;
    constexpr int VST = 136;
    LAS bf16_t* vT = (LAS bf16_t*)C.lds;
    for (int un = C.bid; un < 512; un += C.G) {
        const int hf = un & 1, ch = un >> 1; const size_t t0 = (size_t)ch * 128;
        { const int pos = tid >> 2, q = tid & 3; const bf16_t* vr = V + (t0 + pos) * 512 + q * 32;
          float s = 0.f;
#pragma unroll
          for (int i = 0; i < 4; ++i)
#pragma unroll
              for (int j = 0; j < 4; ++j) { const u32x4 w = *(const u32x4*)(vr + i * 128 + j * 8); s += ((bflo(w.x) + bfhi(w.x)) + (bflo(w.y) + bfhi(w.y))) + ((bflo(w.z) + bfhi(w.z)) + (bflo(w.w) + bfhi(w.w))); }
          s += xswz<1>(s); s += xswz<2>(s);
          const float mean = s * (1.f / 512.f); float qv = 0.f;
          asm volatile("" ::: "memory");
#pragma unroll
          for (int i = 0; i < 4; ++i)
#pragma unroll
              for (int j = 0; j < 4; ++j) { const u32x4 w = *(const u32x4*)(vr + i * 128 + j * 8); float d;
                  d = bflo(w.x) - mean; qv += d * d; d = bfhi(w.x) - mean; qv += d * d; d = bflo(w.y) - mean; qv += d * d; d = bfhi(w.y) - mean; qv += d * d;
                  d = bflo(w.z) - mean; qv += d * d; d = bfhi(w.z) - mean; qv += d * d; d = bflo(w.w) - mean; qv += d * d; d = bfhi(w.w) - mean; qv += d * d; }
          qv += xswz<1>(qv); qv += xswz<2>(qv);
          const float rstd = rsqrtf(qv * (1.f / 512.f) + LN_EPS);
          asm volatile("" ::: "memory");
          const bf16_t* vh = vr + hf * 256;
#pragma unroll
          for (int ii = 0; ii < 2; ++ii)
#pragma unroll
              for (int j = 0; j < 4; ++j) { const u32x4 w = *(const u32x4*)(vh + ii * 128 + j * 8);
                  const int cl = ii * 128 + q * 32 + j * 8; const int c0 = hf * 256 + cl;
                  const f32x4 g0 = *(const f32x4*)(lng + c0), g1 = *(const f32x4*)(lng + c0 + 4), b0 = *(const f32x4*)(lnb + c0), b1 = *(const f32x4*)(lnb + c0 + 4);
                  LAS bf16_t* dp = vT + cl * VST + pos;
                  dp[0 * VST] = (bf16_t)(pk2((bflo(w.x) - mean) * rstd * g0[0] + b0[0], 0.f) & 0xffff);
                  dp[1 * VST] = (bf16_t)(pk2((bfhi(w.x) - mean) * rstd * g0[1] + b0[1], 0.f) & 0xffff);
                  dp[2 * VST] = (bf16_t)(pk2((bflo(w.y) - mean) * rstd * g0[2] + b0[2], 0.f) & 0xffff);
                  dp[3 * VST] = (bf16_t)(pk2((bfhi(w.y) - mean) * rstd * g0[3] + b0[3], 0.f) & 0xffff);
                  dp[4 * VST] = (bf16_t)(pk2((bflo(w.z) - mean) * rstd * g1[0] + b1[0], 0.f) & 0xffff);
                  dp[5 * VST] = (bf16_t)(pk2((bfhi(w.z) - mean) * rstd * g1[1] + b1[1], 0.f) & 0xffff);
                  dp[6 * VST] = (bf16_t)(pk2((bflo(w.w) - mean) * rstd * g1[2] + b1[2], 0.f) & 0xffff);
                  dp[7 * VST] = (bf16_t)(pk2((bfhi(w.w) - mean) * rstd * g1[3] + b1[3], 0.f) & 0xffff); } }
        __syncthreads();
        { const int gl = wid >> 1, ih = wid & 1, g = 4 * hf + gl;
          f32x16 acc[2][2] = {};
          const int nks = 4 * (ih + 1);
          const bf16_t* wrow = WG + ((size_t)g * 128 + ih * 64 + r32) * 128 + hi * 8;
          for (int ks = 0; ks < nks; ++ks) {
              bf16x8 a[2], bb[2];
#pragma unroll
              for (int mb = 0; mb < 2; ++mb) a[mb] = *(const bf16x8*)(wrow + (size_t)mb * 32 * 128 + ks * 16);
#pragma unroll
              for (int nb = 0; nb < 2; ++nb) bb[nb] = *(const LAS bf16x8*)(vT + (gl * 64 + nb * 32 + r32) * VST + ks * 16 + hi * 8);
#pragma unroll
              for (int mb = 0; mb < 2; ++mb)
#pragma unroll
                  for (int nb = 0; nb < 2; ++nb) acc[mb][nb] = __builtin_amdgcn_mfma_f32_32x32x16_bf16(a[mb], bb[nb], acc[mb][nb], 0, 0, 0);
          }
#pragma unroll
          for (int mb = 0; mb < 2; ++mb)
#pragma unroll
              for (int r = 0; r < 16; ++r) { const int i = ih * 64 + mb * 32 + crow(r, hi); const float bi = bs[g * 128 + i];
#pragma unroll
                  for (int nb = 0; nb < 2; ++nb) { const size_t o = (t0 + i) * 512 + g * 64 + nb * 32 + r32;
                      const float uu = bf2f(U[o]); OB[o] = (bf16_t)(pk2(uu * (acc[mb][nb][r] + bi), 0.f) & 0xffff); } } }
        __syncthreads();
    }
}

__device__ __forceinline__ void phase_ln1_router(const Ctx& C, const float* g1, const float* b1, const float* rw, const float* rbias, int l, bool dry) {
    constexpr int RST = 1028;
    LAS float* rwT = (LAS float*)C.lds;
    LAS float* gws = (LAS float*)(C.lds + 32 * RST * 4);
    LAS float* bws = gws + 32;
    LAS float* stat = bws + 32;
    LAS int* trec = (LAS int*)(C.lds + MISC_OFF + 64);
    LAS int* tpos = trec + 512;
    const int tid = C.tid, lane = C.lane, wid = C.wave;
    const bf16_t* xin = WSP(bf16_t, WS_XB); const bf16_t* yo = WSP(bf16_t, WS_OBUF); bf16_t* xb = dry ? WSP(bf16_t, WS_DRY + (size_t)NTOK * DM * 4) : WSP(bf16_t, WS_XB);
    int* tke = dry ? WSP(int, WS_DRY + (size_t)NTOK * DM * 6) : WSP(int, WS_TKE); int* tkp = dry ? WSP(int, WS_DRY + (size_t)NTOK * DM * 6 + NSLOT * 4) : WSP(int, WS_TKP); float* tkw = dry ? WSP(float, WS_DRY + (size_t)NTOK * DM * 6 + NSLOT * 8) : WSP(float, WS_TKW);
    int* ccnt = dry ? WSP(int, WS_DRY + (size_t)NTOK * DM * 6 + NSLOT * 12) : WSP(int, WS_CCNT);
    {
        const float* rwg = WSP(float, WS_RWT) + (size_t)l * 32 * 1024;
#pragma unroll
        for (int q = 0; q < 16; ++q) { const int piece = wid * 16 + q, e = piece >> 2, part = piece & 3;
            __builtin_amdgcn_global_load_lds((const unsigned*)(rwg + e * 1024 + part * 256 + lane * 4), (LAS unsigned*)(C.lds + (e * RST + part * 256) * 4), 16, 0, 0); }
        if (tid < 64) gws[tid] = WSP(float, WS_GBW)[l * 64 + tid];
        asm volatile("s_waitcnt vmcnt(0)" ::: "memory");
    }
    __syncthreads();
    const int fr = lane & 15, fq = lane >> 4;
    for (int chunk = C.bid; chunk < NTOK / 128; chunk += C.G) {
        __syncthreads();
        const size_t tok0 = (size_t)chunk * 128 + wid * 16;
        f32x4 acc0 = {0.f, 0.f, 0.f, 0.f}, acc1 = {0.f, 0.f, 0.f, 0.f};
        u32x2 zp[64]; float s1 = 0.f, s2 = 0.f;
        { const bf16_t* zr = xin + (tok0 + fr) * 1024 + 4 * fq; const bf16_t* yr = yo + (tok0 + fr) * 1024 + 4 * fq; const LAS float* w0 = rwT + fr * RST + 4 * fq; const LAS float* w1 = rwT + (16 + fr) * RST + 4 * fq;
#pragma unroll
          for (int sI = 0; sI < 64; ++sI) { const u32x2 hw = *(const u32x2*)(zr + 16 * sI); const f32x4 h4 = {bflo(hw.x), bfhi(hw.x), bflo(hw.y), bfhi(hw.y)}; const u32x2 yw = *(const u32x2*)(yr + 16 * sI);
              const f32x4 a4 = h4 * DN_ALPHA + (f32x4){bflo(yw.x), bfhi(yw.x), bflo(yw.y), bfhi(yw.y)};
              s1 += (a4[0] + a4[1]) + (a4[2] + a4[3]); s2 += (a4[0] * a4[0] + a4[1] * a4[1]) + (a4[2] * a4[2] + a4[3] * a4[3]);
              u32x2 zz; zz.x = pk2(a4[0], a4[1]); zz.y = pk2(a4[2], a4[3]); zp[sI] = zz;
              const f32x4 b0 = *(const LAS f32x4*)(w0 + 16 * sI), b1v = *(const LAS f32x4*)(w1 + 16 * sI);
#pragma unroll
              for (int j = 0; j < 4; ++j) { acc0 = __builtin_amdgcn_mfma_f32_16x16x4f32(a4[j], b0[j], acc0, 0, 0, 0); acc1 = __builtin_amdgcn_mfma_f32_16x16x4f32(a4[j], b1v[j], acc1, 0, 0, 0); }
              if ((sI & 3) == 3) __builtin_amdgcn_sched_barrier(0); } }
        s1 += xswz<16>(s1); s1 = xsum32(s1); s2 += xswz<16>(s2); s2 = xsum32(s2);
        const float mean = s1 * (1.f / 1024.f); const float rstd = rsqrtf(fmaxf(s2 * (1.f / 1024.f) - mean * mean, 0.f) + LN_EPS);
        { u32x2* xo = (u32x2*)(xb + (tok0 + fr) * 1024 + 4 * fq); const float* gp = g1 + 4 * fq; const float* bp = b1 + 4 * fq;
#pragma unroll
          for (int sI = 0; sI < 64; ++sI) { const f32x4 g4 = *(const f32x4*)(gp + 16 * sI), b4 = *(const f32x4*)(bp + 16 * sI); const u32x2 zz = zp[sI];
              const f32x4 z4 = {bflo(zz.x), bfhi(zz.x), bflo(zz.y), bfhi(zz.y)}; const f32x4 o = (z4 - mean) * rstd * g4 + b4;
              u32x2 w; w.x = pk2(o[0], o[1]); w.y = pk2(o[2], o[3]); xo[4 * sI] = w;
              if ((sI & 7) == 7) __builtin_amdgcn_sched_barrier(0); } }
        if (fq == 0) { stat[(wid * 16 + fr) * 2] = mean; stat[(wid * 16 + fr) * 2 + 1] = rstd; }
        LDS_WAIT();
        const float gw0 = gws[fr], gw1 = gws[16 + fr], bw0 = bws[fr], bw1 = bws[16 + fr];
#pragma unroll
        for (int r = 0; r < 4; ++r) {
            const int tl = wid * 16 + 4 * fq + r; const float mean = stat[tl * 2], rstd = stat[tl * 2 + 1];
            const float l0 = rstd * (acc0[r] - mean * gw0) + bw0, l1 = rstd * (acc1[r] - mean * gw1) + bw1;
            unsigned long long k0 = ((unsigned long long)f2key(l0) << 32) | (unsigned)(31 - fr), k1 = ((unsigned long long)f2key(l1) << 32) | (unsigned)(31 - (16 + fr));
            int te[4]; float tv[4];
#pragma unroll
            for (int k = 0; k < 4; ++k) {
                unsigned long long mxk = k0 > k1 ? k0 : k1;
#define MX_STEP(o) do { const unsigned long long ot = ((unsigned long long)xswzu<o>((unsigned)(mxk >> 32)) << 32) | xswzu<o>((unsigned)mxk); mxk = ot > mxk ? ot : mxk; } while (0)
                MX_STEP(1); MX_STEP(2); MX_STEP(4); MX_STEP(8);
#undef MX_STEP
                te[k] = 31 - (int)(mxk & 31ull); const unsigned ku = (unsigned)(mxk >> 32); tv[k] = __uint_as_float((ku & 0x80000000u) ? (ku & 0x7fffffffu) : ~ku);
                if (te[k] == fr) k0 = 0ull; if (te[k] == 16 + fr) k1 = 0ull;
            }
            const float e1 = __expf(tv[1] - tv[0]), e2 = __expf(tv[2] - tv[0]), e3 = __expf(tv[3] - tv[0]); const float inv = 1.f / (1.f + e1 + e2 + e3);
            if (fr == 0) {
                const float ww[4] = {inv, e1 * inv, e2 * inv, e3 * inv}; const size_t tok = (size_t)chunk * 128 + tl;
#pragma unroll
                for (int k = 0; k < 4; ++k) { trec[tl * 4 + k] = te[k]; tkw[tok * 4 + k] = ww[k]; }
            }
        }
        __syncthreads();
        if (tid < 32) { int c = 0; for (int r = 0; r < 512; ++r) { if (trec[r] == tid) { tpos[r] = c; ++c; } } ccnt[chunk * 32 + tid] = c; }
        __syncthreads();
        { const size_t o = (size_t)chunk * 512 + tid; tke[o] = trec[tid]; tkp[o] = tpos[tid]; }
        __syncthreads();
    }
}

__device__ __forceinline__ void moe_tables(const Ctx& C, int l) {
    LAS int* cnt = (LAS int*)(C.lds + MISC_OFF + 64); LAS int* tb = cnt + 32; LAS int* tile_e = tb + 40;
    const int* ccnt = WSP(int, WS_CCNT);
    {   LAS int* part = (LAS int*)C.lds;
        int a = 0;
#pragma unroll
        for (int k = 0; k < NTOK / 128 / 16; ++k) a += ccnt[((C.tid >> 5) + 16 * k) * 32 + (C.tid & 31)];
        part[C.tid] = a;
        __syncthreads();
        if (C.tid < 32) { int t = 0;
#pragma unroll
            for (int k = 0; k < 16; ++k) t += part[k * 32 + C.tid];
            cnt[C.tid] = t; }
    }
    __syncthreads();
    if (C.tid == 0) { int a = 0; for (int e = 0; e < 32; ++e) { tb[e] = a; a += (cnt[e] + 255) >> 8; } tb[32] = a; }
    __syncthreads();
    if (C.tid < 32) { for (int t = tb[C.tid]; t < tb[C.tid + 1]; ++t) tile_e[t] = C.tid; }
    __syncthreads();
}
__device__ __forceinline__ void phase_dispatch(const Ctx& C, int l) {
    moe_tables(C, l);
    LAS int* cnt = (LAS int*)(C.lds + MISC_OFF + 64); LAS int* tb = cnt + 32;
    const int* tke = WSP(int, WS_TKE); int* tkp = WSP(int, WS_TKP); int* stk = WSP(int, WS_STK);
    const int* ccnt = WSP(int, WS_CCNT);
    for (int ch = C.bid; ch < NSLOT / 512; ch += C.G) {
        LAS int* part = (LAS int*)C.lds; LAS int* cb = part + 512;
        int a = 0;
        for (int c = (C.tid >> 5); c < ch; c += 16) a += ccnt[c * 32 + (C.tid & 31)];
        part[C.tid] = a;
        __syncthreads();
        if (C.tid < 32) { int t = 0;
#pragma unroll
            for (int k = 0; k < 16; ++k) t += part[k * 32 + C.tid];
            cb[C.tid] = t; }
        __syncthreads();
        const int s = ch * 512 + C.tid;
        const int e = tke[s], p = cb[e] + tkp[s]; const int row = tb[e] * 256 + p;
        stk[row] = s >> 2; tkp[s] = row;
        __syncthreads();
    }
    for (int e = C.bid; e < 32; e += C.G) { const int r0 = tb[e] * 256 + cnt[e], r1 = tb[e + 1] * 256; for (int r = r0 + C.tid; r < r1; r += 512) stk[r] = 0; }
}

__device__ __forceinline__ void phase_ln2(const Ctx& C, const float* g2, const float* b2, float* outp, int l, bool dry) {
    const bf16_t* xin = WSP(bf16_t, WS_XB); bf16_t* xb = dry ? WSP(bf16_t, WS_DRY + (size_t)NTOK * DM * 4) : WSP(bf16_t, WS_XB); const bf16_t* y = WSP(bf16_t, WS_Y);
    const int* tkrow = WSP(int, WS_TKP); const float* tkw = WSP(float, WS_TKW);
    if (dry) outp = WSP(float, WS_DRY);
    const int gw = C.bid * NWAVES + C.wave, NGW = C.G * NWAVES, lane = C.lane;
    f32x4 gg[4], bb[4];
#pragma unroll
    for (int j = 0; j < 4; ++j) { gg[j] = *(const f32x4*)(g2 + 4 * (lane + 64 * j)); bb[j] = *(const f32x4*)(b2 + 4 * (lane + 64 * j)); }
    const bool last = (l == NLAYER - 1);
    for (int tok = gw; tok < NTOK; tok += NGW) {
        const u32x2* xr = (const u32x2*)(xin + (size_t)tok * 1024);
        f32x4 v[4]; float s = 0.f;
        int rk[4]; float wk[4];
#pragma unroll
        for (int k = 0; k < 4; ++k) { rk[k] = tkrow[(size_t)tok * 4 + k]; wk[k] = tkw[(size_t)tok * 4 + k]; }
#pragma unroll
        for (int j = 0; j < 4; ++j) { const u32x2 hw = xr[lane + 64 * j]; const f32x4 x1 = {bflo(hw.x), bfhi(hw.x), bflo(hw.y), bfhi(hw.y)}; f32x4 f[4];
#pragma unroll
            for (int k = 0; k < 4; ++k) { const u32x2 w = *(const u32x2*)(y + (size_t)rk[k] * 1024 + 4 * (lane + 64 * j)); f[k] = (f32x4){bflo(w.x), bfhi(w.x), bflo(w.y), bfhi(w.y)} * wk[k]; }
            v[j] = x1 * DN_ALPHA + ((f[0] + f[1]) + (f[2] + f[3]));
            s += (v[j][0] + v[j][1]) + (v[j][2] + v[j][3]); }
        const float mean = wave_sum(s) * (1.f / 1024.f); float s2 = 0.f;
#pragma unroll
        for (int j = 0; j < 4; ++j) { v[j] = v[j] - mean; s2 += (v[j][0] * v[j][0] + v[j][1] * v[j][1]) + (v[j][2] * v[j][2] + v[j][3] * v[j][3]); }
        const float rstd = rsqrtf(wave_sum(s2) * (1.f / 1024.f) + LN_EPS);
        if (last) { f32x4* orow = (f32x4*)(outp + (size_t)tok * 1024);
#pragma unroll
            for (int j = 0; j < 4; ++j) orow[lane + 64 * j] = v[j] * rstd * gg[j] + bb[j];
        } else { u32x2* xbr = (u32x2*)(xb + (size_t)tok * 1024);
#pragma unroll
            for (int j = 0; j < 4; ++j) { const f32x4 o = v[j] * rstd * gg[j] + bb[j]; u32x2 w; w.x = pk2(o[0], o[1]); w.y = pk2(o[2], o[3]); xbr[lane + 64 * j] = w; } }
    }
}

#ifdef DBG_STOP
__device__ __forceinline__ void dbg_dump(const Ctx& C, float* out) {
    const int gt = C.bid * 512 + C.tid, NGT = C.G * 512;
    const bf16_t* qa = WSP(bf16_t, WS_QA); const bf16_t* ka = WSP(bf16_t, WS_KA); const bf16_t* vat = WSP(bf16_t, WS_VAT); const bf16_t* iq = WSP(bf16_t, WS_IQ);
    const bf16_t* u = WSP(bf16_t, WS_U); const bf16_t* v = WSP(bf16_t, WS_V); const bf16_t* cdq = WSP(bf16_t, WS_CDQ); const bf16_t* cdkv = WSP(bf16_t, WS_CDKV);
    const bf16_t* gate = WSP(bf16_t, WS_GATE); const bf16_t* qc = WSP(bf16_t, WS_QC); const bf16_t* kc = WSP(bf16_t, WS_KC); const bf16_t* vct = WSP(bf16_t, WS_VCT);
    const unsigned* mask = WSP(unsigned, WS_MASK); const bf16_t* ob = WSP(bf16_t, WS_OBUF); const bf16_t* mg = WSP(bf16_t, WS_MERGED); const float* xr = WSP(float, WS_XRES);
    const bf16_t* y = WSP(bf16_t, WS_Y); const float* sc = WSP(float, WS_SCORE); const bf16_t* ik = WSP(bf16_t, WS_IK); const float* iw = WSP(float, WS_IW); const float* ssq = WSP(float, WS_SSQ);
    const bf16_t* hb = WSP(bf16_t, WS_H); const bf16_t* xg = WSP(bf16_t, WS_XG); const int* stk = WSP(int, WS_STK);
    for (size_t i = gt; i < (size_t)NTOK * DM; i += NGT) {
        const size_t h = i & ((size_t)NTOK * 512 - 1);
        float a = 0.f;
#if DBG_STOP >= 1
        a += bf2f(qa[h]) + bf2f(ka[h]) + bf2f(vat[h]) + bf2f(iq[h]) + bf2f(u[h]) + bf2f(v[h]) + bf2f(cdq[i & ((size_t)NTOK * 256 - 1)]) + bf2f(cdkv[i & ((size_t)NTOK * 256 - 1)]);
        a += bf2f(gate[i]) + bf2f(gate[i + (size_t)NTOK * DM]) + bf2f(gate[i + (size_t)2 * NTOK * DM]) + bf2f(ik[i & ((size_t)NTOK * 64 - 1)]) + iw[i & ((size_t)NTOK * 8 - 1)] + ssq[i & ((size_t)NTOK * 8 - 1)];
#endif
#if DBG_STOP >= 2
        a += bf2f(qc[i % ((size_t)NTOK * 768)]) + bf2f(kc[i % ((size_t)NTOK * 768)]) + bf2f(vct[h]) + bf2f(ob[(size_t)NTOK * 512 + h]);
#ifdef DBG_BITS
        a = (float)(__float_as_uint(sc[i]) & 0xfffu) + (float)(__float_as_uint(sc[i + (size_t)NTOK * DM]) & 0xfffu) + (float)(__float_as_uint(sc[i + (size_t)2 * NTOK * DM]) & 0xfffu) + (float)(__float_as_uint(sc[i + (size_t)3 * NTOK * DM]) & 0xfffu);
        a += (float)(iq[h] & 0xff) + (float)(ik[i & ((size_t)NTOK * 64 - 1)] & 0xff) + (float)(__float_as_uint(iw[i & ((size_t)NTOK * 8 - 1)]) & 0xfffu);
#else
        a += sc[i] + sc[i + (size_t)NTOK * DM] + sc[i + (size_t)2 * NTOK * DM] + sc[i + (size_t)3 * NTOK * DM];
#endif
#endif
#if DBG_STOP >= 3
        { const unsigned m = mask[i & ((size_t)NTOK * 128 - 1)]; a += (float)(m & 0xffffu) + (float)(m >> 16); } a += bf2f(ob[(size_t)2 * NTOK * 512 + h]);
#endif
#if DBG_STOP >= 4
        a += bf2f(ob[h]);
#endif
#if DBG_STOP >= 5
        a += bf2f(mg[i]);
#endif
#if DBG_STOP >= 6
        a += xr[i];
#endif
#if DBG_STOP >= 8
        a += (float)stk[i % (size_t)NSLOT_PAD] + bf2f(xg[i]) + bf2f(xg[i + (size_t)NTOK * DM]) + bf2f(xg[i + (size_t)2 * NTOK * DM]) + bf2f(xg[i + (size_t)3 * NTOK * DM]);
#endif
#if DBG_STOP >= 9
        a += bf2f(hb[i]) + bf2f(hb[i + (size_t)NTOK * DM]) + bf2f(hb[i + (size_t)2 * NTOK * DM]) + bf2f(hb[i + (size_t)3 * NTOK * DM]);
#endif
#if DBG_STOP >= 10
        a += bf2f(y[i]) + bf2f(y[i + (size_t)NTOK * DM]) + bf2f(y[i + (size_t)2 * NTOK * DM]) + bf2f(y[i + (size_t)3 * NTOK * DM]);
#endif
        out[i] = a;
    }
}
#endif

#ifdef DBG_CHECK
constexpr int CW_ERR = 20000;
__device__ __forceinline__ void err_max(unsigned* ctl, int k, float e) { if (!(e >= 0.f)) e = 1e30f; atomicMax(ctl + CW_ERR + k, __float_as_uint(e)); }
__device__ __forceinline__ float rope1(float x1, float x2, float c, float s_) { return x1 * c - x2 * s_; }
__device__ __forceinline__ float rope2(float x1, float x2, float c, float s_) { return x2 * c + x1 * s_; }
__device__ __forceinline__ void chk_proj(const Ctx& C, const Args& A) {
    unsigned* ctl = WSP(unsigned, WS_CTL); LAS float* pj = (LAS float*)C.lds;
    const int tok = (C.bid * 131 + 7) % NTOK; const int b = tok >> 12, sp = tok & 4095, ps = (sp & ~15) | perm16(sp & 15);
    const float* x = A.in[0] + (size_t)tok * DM; const float* w = A.in[2];
    for (int n = C.tid; n < 3560; n += 512) { float a = 0.f; for (int k = 0; k < DM; ++k) a = fmaf(x[k], w[(size_t)k * NIN_SRC + n], a); pj[n] = a; }
    __syncthreads();
    const float pos = (float)((const int*)A.in[1])[tok];
    const bf16_t* qa = WSP(bf16_t, WS_QA); const bf16_t* ka = WSP(bf16_t, WS_KA); const bf16_t* vat = WSP(bf16_t, WS_VAT); const bf16_t* iq = WSP(bf16_t, WS_IQ); const bf16_t* ik = WSP(bf16_t, WS_IK); const float* iw = WSP(float, WS_IW);
    float e = 0.f;
    for (int c = C.tid; c < 512; c += 512) { const int d = c & 63; const int base = c - d;
        float cq, ck, ci;
        if (d < 16) { const int i = d & 7; const float ang = pos * powf(500000.f, -(float)i / 8.f), cs = cosf(ang), sn = sinf(ang);
            const int o1 = base + i, o2 = base + 8 + i;
            cq = d < 8 ? rope1(pj[o1], pj[o2], cs, sn) : rope2(pj[o1], pj[o2], cs, sn);
            ck = d < 8 ? rope1(pj[512 + o1], pj[512 + o2], cs, sn) : rope2(pj[512 + o1], pj[512 + o2], cs, sn);
            ci = d < 8 ? rope1(pj[1536 + o1], pj[1536 + o2], cs, sn) : rope2(pj[1536 + o1], pj[1536 + o2], cs, sn);
        } else { cq = pj[c]; ck = pj[512 + c]; ci = pj[1536 + c]; }
        e = fmaxf(e, fabsf(bf2f(qa[(size_t)tok * 512 + c]) - cq * QSCALE_A)); e = fmaxf(e, fabsf(bf2f(ka[(size_t)tok * 512 + c]) - ck)); e = fmaxf(e, fabsf(bf2f(iq[(size_t)tok * 512 + c]) - ci));
        const int h = c >> 6; e = fmaxf(e, fabsf(bf2f(vat[((size_t)(b * 8 + h) * 64 + d) * SEQ + ps]) - pj[1024 + c]));
        if (c < 64) { float cik; if (c < 16) { const int i = c & 7; const float ang = pos * powf(500000.f, -(float)i / 8.f), cs = cosf(ang), sn = sinf(ang);
                cik = c < 8 ? rope1(pj[2048 + i], pj[2048 + 8 + i], cs, sn) : rope2(pj[2048 + i], pj[2048 + 8 + i], cs, sn); } else cik = pj[2048 + c];
            e = fmaxf(e, fabsf(bf2f(ik[(size_t)tok * 64 + c]) - cik)); }
        if (c < 8) e = fmaxf(e, 8.f * fabsf(iw[(size_t)tok * 8 + c] - pj[2112 + c] * IW_SCALE));
    }
    err_max(ctl, 0, e);
    __syncthreads();
    LAS float* cqn = pj + 3600; LAS float* ckn = cqn + 256;
    { float sq = 0.f; for (int k = 0; k < 256; ++k) sq += pj[3144 + k] * pj[3144 + k]; const float r = rsqrtf(sq / 256.f + RMS_EPS);
      float sk = 0.f; for (int k = 0; k < 128; ++k) sk += pj[3400 + k] * pj[3400 + k]; const float rk = rsqrtf(sk / 128.f + RMS_EPS);
      if (C.tid < 256) cqn[C.tid] = pj[3144 + C.tid] * r * A.in[7][C.tid]; if (C.tid < 128) ckn[C.tid] = pj[3400 + C.tid] * rk * A.in[8][C.tid]; }
    __syncthreads();
    const bf16_t* qc = WSP(bf16_t, WS_QC); const bf16_t* kc = WSP(bf16_t, WS_KC); const bf16_t* vct = WSP(bf16_t, WS_VCT);
    LAS float* qraw = ckn + 128;
    for (int n = C.tid; n < 768; n += 512) { float a = 0.f; for (int k = 0; k < 256; ++k) a = fmaf(cqn[k], A.in[9][(size_t)k * 768 + n], a); qraw[n] = a; }
    __syncthreads();
    float e2 = 0.f;
    for (int n = C.tid; n < 768; n += 512) { const int h = n / 96, d = n % 96; float v;
        if (d >= 64) { const int i = (d - 64) & 15; const float ang = pos * powf(500000.f, -(float)i / 16.f), cs = cosf(ang), sn = sinf(ang); const int o1 = h * 96 + 64 + i, o2 = o1 + 16;
            v = (d - 64) < 16 ? rope1(qraw[o1], qraw[o2], cs, sn) : rope2(qraw[o1], qraw[o2], cs, sn); } else v = qraw[n];
        e2 = fmaxf(e2, fabsf(bf2f(qc[(size_t)tok * 768 + n]) - v * QSCALE_C)); }
    for (int n = C.tid; n < 1024; n += 512) { float a = 0.f; for (int k = 0; k < 128; ++k) a = fmaf(ckn[k], A.in[10][(size_t)k * 1024 + n], a);
        const int h = n >> 7, wv = n & 127;
        if (wv < 64) e2 = fmaxf(e2, fabsf(bf2f(kc[(size_t)tok * 768 + h * 96 + wv]) - a));
        else e2 = fmaxf(e2, fabsf(bf2f(vct[((size_t)(b * 8 + h) * 64 + (wv - 64)) * SEQ + ps]) - a)); }
    if (C.tid < 32) { const int i = C.tid & 15; const float ang = pos * powf(500000.f, -(float)i / 16.f), cs = cosf(ang), sn = sinf(ang);
        const float v = C.tid < 16 ? rope1(pj[3528 + i], pj[3528 + 16 + i], cs, sn) : rope2(pj[3528 + i], pj[3528 + 16 + i], cs, sn);
        for (int h = 0; h < 8; ++h) e2 = fmaxf(e2, fabsf(bf2f(kc[(size_t)tok * 768 + h * 96 + 64 + C.tid]) - v)); }
    err_max(ctl, 1, e2);
    __syncthreads();
}
__device__ __forceinline__ void chk_attn(const Ctx& C) {
    unsigned* ctl = WSP(unsigned, WS_CTL);
    const int b = C.bid & 7, q = (C.bid * 977 + 300 + 13 * (C.bid >> 3)) & 4095; const size_t tq = (size_t)b * SEQ + q; const int n = q + 1;
    LAS float* sc = (LAS float*)C.lds;
    LAS float* pr = sc + 4096;
    LAS float* red = pr + 4096;
    const bf16_t* iq = WSP(bf16_t, WS_IQ); const bf16_t* ik = WSP(bf16_t, WS_IK); const float* iw = WSP(float, WS_IW); const float* score = WSP(float, WS_SCORE);
    float e1 = 0.f;
    for (int k = C.tid; k < n; k += 512) { float s_ = 0.f;
        for (int h = 0; h < 8; ++h) { float d = 0.f; for (int j = 0; j < 64; ++j) d = fmaf(bf2f(iq[tq * 512 + h * 64 + j]), bf2f(ik[((size_t)b * SEQ + k) * 64 + j]), d); s_ = fmaf(fmaxf(d, 0.f), iw[tq * 8 + h], s_); }
        sc[k] = s_; e1 = fmaxf(e1, fabsf(s_ - score[tq * SEQ + k])); }
    err_max(ctl, 2, e1);
    __syncthreads();
    const unsigned* mask = WSP(unsigned, WS_MASK); float e2 = 0.f;
    for (int k = C.tid; k < 4096; k += 512) { bool sel = false;
        if (k < n) { if (n <= 256) sel = true; else { const float sk = score[tq * SEQ + k]; int rank = 0; for (int j = 0; j < n; ++j) { const float sj = score[tq * SEQ + j]; rank += (sj > sk || (sj == sk && j < k)) ? 1 : 0; } sel = rank < 256; } }
        const bool mb = (mask[tq * 128 + (k >> 5)] >> (k & 31)) & 1u; if (sel != mb) e2 = 1.f; }
    err_max(ctl, 3, e2);
    const int h = (C.bid >> 3) & 7;
    for (int which = 0; which < 2; ++which) {
        const bf16_t* Q = which ? WSP(bf16_t, WS_QC) : WSP(bf16_t, WS_QA); const bf16_t* K = which ? WSP(bf16_t, WS_KC) : WSP(bf16_t, WS_KA); const bf16_t* VT = which ? WSP(bf16_t, WS_VCT) : WSP(bf16_t, WS_VAT);
        const bf16_t* O = WSP(bf16_t, WS_OBUF) + (which ? (size_t)2 * NTOK * 512 : 0); const int dq = which ? 96 : 64, qs = 8 * dq;
        __syncthreads();
        float mx = -INFINITY;
        for (int k = C.tid; k < 4096; k += 512) { float lgt = -INFINITY;
            const bool ok = k < n && (which || ((mask[tq * 128 + (k >> 5)] >> (k & 31)) & 1u));
            if (ok) { float d = 0.f; for (int j = 0; j < dq; ++j) d = fmaf(bf2f(Q[tq * qs + h * dq + j]), bf2f(K[((size_t)b * SEQ + k) * qs + h * dq + j]), d); lgt = d; }
            pr[k] = lgt; mx = fmaxf(mx, lgt); }
        red[C.tid] = mx; __syncthreads();
        if (C.tid == 0) { float m = -INFINITY; for (int i = 0; i < 512; ++i) m = fmaxf(m, red[i]); red[0] = m; } __syncthreads();
        const float m = red[0]; __syncthreads();
        float sm = 0.f; for (int k = C.tid; k < 4096; k += 512) { const float p = exp2f(pr[k] - m); pr[k] = p; sm += p; }
        red[C.tid] = sm; __syncthreads();
        if (C.tid == 0) { float t = 0.f; for (int i = 0; i < 512; ++i) t += red[i]; red[0] = t; } __syncthreads();
        const float den = red[0];
        if (C.tid < 64) { const int d = C.tid; float o = 0.f;
            for (int k = 0; k < n; ++k) { const int ps = (k & ~15) | perm16(k & 15); o = fmaf(pr[k], bf2f(VT[((size_t)(b * 8 + h) * 64 + d) * SEQ + ps]), o); }
            o /= den; err_max(ctl, 4 + which, fabsf(o - bf2f(O[tq * 512 + h * 64 + d]))); }
    }
    __syncthreads();
}
#endif

constexpr int NPH_LAYER = 11, NPHASE = 1 + NLAYER * NPH_LAYER;
__global__ void __launch_bounds__(NWAVES * 64, 2) trunk_fwd(Args args) {
    extern __shared__ __attribute__((aligned(16))) unsigned char lds_raw[];
    Ctx C;
    C.lds = (LAS unsigned char*)lds_raw; C.tid = threadIdx.x; C.lane = C.tid & 63; C.wave = __builtin_amdgcn_readfirstlane(C.tid >> 6); C.G = gridDim.x; C.bid = blockIdx.x; C.ws = args.ws;
    volatile LAS unsigned* MISC = (volatile LAS unsigned*)(C.lds + MISC_OFF);
    if (C.tid < 16) MISC[C.tid] = 0u;
    __syncthreads();
#if MK_ONE_LAUNCH
    XcdBarrier bar = xcd_barrier_post(WSP(unsigned, WS_CTL) + CW_BAR, MISC + 0);
#define GRID_BAR() do { FRESH(); XcdBarrier b_ = bar; { unsigned* bp_ = b_.bar; asm volatile("" : "+s"(bp_)); b_.bar = bp_; } xcd_barrier(b_, C.tid == 0); } while (0)
#else
#define GRID_BAR() do {} while (0)
#endif
    typedef const __attribute__((address_space(4))) Args* KArgsP;
    KArgsP kp = (KArgsP)__builtin_amdgcn_kernarg_segment_ptr();
    const int grid_s = gridDim.x, bid_s = blockIdx.x;
    const int wave_s = __builtin_amdgcn_readfirstlane((int)threadIdx.x >> 6);
#define FRESH() do { int ln_; asm volatile("v_mbcnt_lo_u32_b32 %0, -1, 0\n\tv_mbcnt_hi_u32_b32 %0, -1, %0" : "=v"(ln_)); int w_ = wave_s; asm volatile("" : "+s"(w_)); C.tid = (w_ << 6) | ln_; C.lane = ln_; C.wave = w_; \
        int g_ = grid_s, b_ = bid_s; asm volatile("" : "+s"(g_), "+s"(b_)); C.G = g_; C.bid = b_; \
        kp = (KArgsP)__builtin_amdgcn_kernarg_segment_ptr(); asm volatile("" : "+s"(kp)); C.ws = kp->ws; } while (0)
#define KIN(i) (kp->in[i])
    const int lo = args.ph_lo, hi = args.ph_hi, sub_mask = args.sub; const bool dry = (args.pad != 0);
#ifndef PH_ONLY
#define PH_ONLY -1
#endif
#ifndef PH_SUB
#define PH_SUB -1
#endif
#define PON(k) (PH_ONLY < 0 || PH_ONLY == (k))
#define PON2(k) ((PH_SUB < 0 || PH_SUB == (k)) && ((sub_mask >> (((k) / 10 - 1) * 4 + (k) % 10 - 1)) & 1))
#define IN(k) (lo <= (k) && (k) < hi)
#define SEAM(k) do { if (IN(k) && IN((k) + 1)) GRID_BAR(); } while (0)
    if (IN(0) && PON(100)) { phase_prologue(C, args); }
    SEAM(0);
    for (int l = 0; l < NLAYER; ++l) {
        const int P = 1 + l * NPH_LAYER;
        if (IN(P + 0) && PON(0)) { FRESH();
            pg8::Gemm g{WSP(bf16_t, WS_XB), WSP(bf16_t, WS_WIN + l * SZ_WIN), 1024, 1024, nullptr}; GridOrder S{NIN / 256, (NTOK / 256) * (NIN / 256), C.G, C.bid};
            EpiInProj E{C.ws, dry};
            pg8::gemm_phase<EpiInProj, GridOrder>(C.lds, g, S, E, C.tid);
        }
        SEAM(P + 0);
        if (IN(P + 1) && PON(1)) { FRESH();
            if (PON2(11)) phase_indexer(C);
            __syncthreads();
            FRESH();
            if (PON2(12)) { pg8::Gemm g{WSP(bf16_t, WS_CDQ), WSP(bf16_t, WS_WUQ + l * SZ_WUQ), 256, 256, nullptr}; GridOrder S{3, 128 * 3, C.G, C.bid};
              EpiQUp E{WSP(bf16_t, WS_QC), WSP(float, WS_SSQ), WSP(float, WS_COSC), WSP(float, WS_SINC)};
              pg8::gemm_phase<EpiQUp, GridOrder>(C.lds, g, S, E, C.tid); }
            FRESH();
            if (PON2(13)) { pg8::Gemm g{WSP(bf16_t, WS_CDKV), WSP(bf16_t, WS_WUKV + l * SZ_WUKV), 256, 256, nullptr}; GridOrder S{4, 128 * 4, C.G, C.bid};
              EpiKvUp E{WSP(bf16_t, WS_KC), WSP(bf16_t, WS_VCT), WSP(float, WS_SSQ)};
              pg8::gemm_phase<EpiKvUp, GridOrder>(C.lds, g, S, E, C.tid); }
            __syncthreads();
            if (PON2(14)) { FRESH(); phase_gmlp(C, KIN(3) + l * 512, KIN(4) + l * 512, KIN(6) + (size_t)l * 8 * 128, l); }
        }
        SEAM(P + 1);
        if (IN(P + 2) && PON(2)) { FRESH();
            if (PON2(21)) phase_select(C);
            __syncthreads();
            FRESH(); if (PON2(22)) phase_attn<96, false>(C, WSP(bf16_t, WS_QC), WSP(bf16_t, WS_KC), WSP(bf16_t, WS_VCT), nullptr, WSP(bf16_t, WS_OBUF) + (size_t)2 * NTOK * 512);
        }
        SEAM(P + 2);
        if (IN(P + 3) && PON(3)) { FRESH(); phase_attn<64, true>(C, WSP(bf16_t, WS_QA), WSP(bf16_t, WS_KA), WSP(bf16_t, WS_VAT), WSP(unsigned, WS_MASK), WSP(bf16_t, WS_OBUF)); }
        SEAM(P + 3);
        if (IN(P + 4) && PON(4)) { FRESH();
            pg8::Gemm g{WSP(bf16_t, WS_OBUF), WSP(bf16_t, WS_WBR + l * SZ_WBR), 512, 512, nullptr}; MergeOrder S{C.G, C.bid};
            EpiMerge E{WSP(bf16_t, WS_GATE), WSP(bf16_t, WS_MERGED)};
            pg8::gemm_phase<EpiMerge, MergeOrder>(C.lds, g, S, E, C.tid);
        }
        SEAM(P + 4);
        if (IN(P + 5) && PON(5)) { FRESH();
            pg8::Gemm g{WSP(bf16_t, WS_MERGED), WSP(bf16_t, WS_WOUT + l * SZ_WOUT), 1024, 1024, nullptr}; GridOrder S{4, 128 * 4, C.G, C.bid};
            EpiOut E{dry ? WSP(bf16_t, WS_DRY) : WSP(bf16_t, WS_OBUF)};
            pg8::gemm_phase<EpiOut, GridOrder>(C.lds, g, S, E, C.tid);
        }
        SEAM(P + 5);
        if (IN(P + 6) && PON(6)) { FRESH(); phase_ln1_router(C, KIN(13) + l * 1024, KIN(14) + l * 1024, KIN(15) + (size_t)l * 1024 * 32, KIN(16) + l * 32, l, dry); }
        SEAM(P + 6);
        if (IN(P + 7) && PON(7)) { FRESH(); phase_dispatch(C, l); }
        SEAM(P + 7);
        if (IN(P + 8) && PON(8)) { FRESH();
            moe_tables(C, l);
            const LAS int* tb = (const LAS int*)(C.lds + MISC_OFF + 64) + 32;
            pg8::Gemm g{WSP(bf16_t, WS_XB), WSP(bf16_t, WS_WGU + l * SZ_WGU), 1024, 1024, WSP(int, WS_STK)}; MoeOrder S{8, tb[32] * 8, C.G, C.bid, tb};
            EpiMoeUp E{WSP(bf16_t, WS_H), KIN(18) + (size_t)l * NEXP * 2048};
            pg8::gemm_phase<EpiMoeUp, MoeOrder, true>(C.lds, g, S, E, C.tid);
        }
        SEAM(P + 8);
        if (IN(P + 9) && PON(9)) { FRESH();
            moe_tables(C, l);
            const LAS int* tb = (const LAS int*)(C.lds + MISC_OFF + 64) + 32;
            pg8::Gemm g{WSP(bf16_t, WS_H), WSP(bf16_t, WS_WDN + l * SZ_WDN), 1024, 1024, nullptr}; MoeOrder S{4, tb[32] * 4, C.G, C.bid, tb};
            EpiMoeDn E{dry ? WSP(bf16_t, WS_DRY) : WSP(bf16_t, WS_Y), KIN(20) + (size_t)l * NEXP * 1024, dry};
            pg8::gemm_phase<EpiMoeDn, MoeOrder>(C.lds, g, S, E, C.tid);
        }
        SEAM(P + 9);
        if (IN(P + 10) && PON(10)) { FRESH(); phase_ln2(C, KIN(21) + l * 1024, KIN(22) + l * 1024, kp->out, l, dry); }
        SEAM(P + 10);
    }
#ifdef DBG_STOP
    if (IN(NPHASE)) { FRESH(); dbg_dump(C, kp->out); }
#endif
#ifdef DBG_CHECK
    if (IN(NPHASE + 1)) { FRESH(); chk_proj(C, args); chk_attn(C); }
    if (IN(NPHASE + 2)) { FRESH();
        const unsigned* ctl = WSP(unsigned, WS_CTL); const float tol[6] = {0.06f, 0.06f, 2e-3f, 0.5f, 0.02f, 0.02f}; float sc = 1.f;
        for (int k = 0; k < 6; ++k) if (__uint_as_float(ctl[CW_ERR + k]) > tol[k]) sc += 0.2f * (float)(1 << k);
        float* o = kp->out; for (size_t i = (size_t)C.bid * 512 + C.tid; i < (size_t)NTOK * DM; i += (size_t)C.G * 512) o[i] *= sc; }
#endif
#undef IN
#undef SEAM
}

extern "C" void kernel_launch(void* const* d_in, const int* in_sizes, int n_in, void* d_out, int out_size, void* d_ws, size_t ws_size, hipStream_t stream) {
    static int grid = 0;
    if (grid == 0) {
        if (n_in != 23 || out_size != NTOK * DM || ws_size < WS_END) { fprintf(stderr, "kernel_launch: unexpected shapes (n_in %d, out %d, ws %zu < %zu)\n", n_in, out_size, ws_size, (size_t)WS_END); grid = -1; return; }
        int dev = 0, cus = 0, per_cu = 0;
        if (hipGetDevice(&dev) != hipSuccess || hipDeviceGetAttribute(&cus, hipDeviceAttributeMultiprocessorCount, dev) != hipSuccess) { grid = -1; return; }
        if (hipFuncSetAttribute((const void*)trunk_fwd, hipFuncAttributeMaxDynamicSharedMemorySize, LDS_BYTES) != hipSuccess) { fprintf(stderr, "kernel_launch: hipFuncSetAttribute failed\n"); grid = -1; return; }
        if (hipOccupancyMaxActiveBlocksPerMultiprocessor(&per_cu, (const void*)trunk_fwd, NWAVES * 64, LDS_BYTES) != hipSuccess || per_cu < 1) { fprintf(stderr, "kernel_launch: occupancy query reports %d\n", per_cu); }
        (void)hipGetLastError();
        grid = cus;
    }
    if (grid < 0) return;
    (void)hipMemsetAsync((char*)d_ws + WS_CTL, 0, CTL_ZERO_BYTES, stream);
#ifdef DBG_ZERO_WS
    (void)hipMemsetAsync((char*)d_ws + WS_XRES, 0, WS_END - WS_XRES, stream);
#endif
    Args a{};
    for (int i = 0; i < 23; ++i) a.in[i] = (const float*)d_in[i];
    a.out = (float*)d_out; a.ws = (unsigned char*)d_ws; a.sub = -1; a.pad = 0;
#if MK_ONE_LAUNCH
    a.ph_lo = 0; a.ph_hi = NPHASE;
    hipLaunchKernelGGL(trunk_fwd, dim3(grid), dim3(NWAVES * 64), LDS_BYTES, stream, a);
#else
#ifdef DBG_STOP
    for (int p = 0; p < 1 + DBG_STOP; ++p) { a.ph_lo = p; a.ph_hi = p + 1; hipLaunchKernelGGL(trunk_fwd, dim3(grid), dim3(NWAVES * 64), LDS_BYTES, stream, a); }
    a.ph_lo = NPHASE; a.ph_hi = NPHASE + 1; hipLaunchKernelGGL(trunk_fwd, dim3(grid), dim3(NWAVES * 64), LDS_BYTES, stream, a);
#else
    for (int p = 0; p < NPHASE; ++p) { a.ph_lo = p; a.ph_hi = p + 1; a.sub = -1; a.pad = 0; hipLaunchKernelGGL(trunk_fwd, dim3(grid), dim3(NWAVES * 64), LDS_BYTES, stream, a);
#ifdef DBG_CHECK
        if (p == 4) { a.ph_lo = NPHASE + 1; a.ph_hi = NPHASE + 2; hipLaunchKernelGGL(trunk_fwd, dim3(grid), dim3(NWAVES * 64), LDS_BYTES, stream, a); }
        if (p == NPHASE - 1) { a.ph_lo = NPHASE + 2; a.ph_hi = NPHASE + 3; hipLaunchKernelGGL(trunk_fwd, dim3(grid), dim3(NWAVES * 64), LDS_BYTES, stream, a); }
#endif
#ifdef PROBE_PH
#ifndef PROBE_DRY
#define PROBE_DRY 0
#endif
        if ((p == 0 && PROBE_PH == -1) || (p >= 1 && (p - 1) % NPH_LAYER == PROBE_PH)) { a.sub = PROBE_SUB; a.pad = PROBE_DRY; hipLaunchKernelGGL(trunk_fwd, dim3(grid), dim3(NWAVES * 64), LDS_BYTES, stream, a); }
#endif
    }
#endif
#endif
}
```

```cpp
#include <hip/hip_runtime.h>
#include <cstdio>
#include <cstdint>

#ifndef MK_ONE_LAUNCH
#define MK_ONE_LAUNCH 1
#endif

#define LAS __attribute__((address_space(3)))
typedef unsigned short bf16_t;
typedef short bf16x8 __attribute__((ext_vector_type(8)));
typedef float f32x4 __attribute__((ext_vector_type(4)));
typedef float f32x16 __attribute__((ext_vector_type(16)));
typedef unsigned u32x4 __attribute__((ext_vector_type(4)));
typedef unsigned u32x2 __attribute__((ext_vector_type(2)));
typedef float f32x2_t __attribute__((ext_vector_type(2)));
typedef __bf16 bf16x2_t __attribute__((ext_vector_type(2)));

__device__ __forceinline__ unsigned pk2(float lo, float hi) { f32x2_t v = {lo, hi}; bf16x2_t b = __builtin_convertvector(v, bf16x2_t); return __builtin_bit_cast(unsigned, b); }
__device__ __forceinline__ float bf2f(unsigned short x) { return __uint_as_float(((unsigned)x) << 16); }
__device__ __forceinline__ float bflo(unsigned w) { return __uint_as_float(w << 16); }
__device__ __forceinline__ float bfhi(unsigned w) { return __uint_as_float(w & 0xffff0000u); }
template <int M> __device__ __forceinline__ float xswz(float v) { static_assert(M >= 1 && M <= 16, "xswz"); return __int_as_float(__builtin_amdgcn_ds_swizzle(__float_as_int(v), 0x1F | (M << 10))); }
template <int M> __device__ __forceinline__ unsigned xswzu(unsigned v) { return (unsigned)__builtin_amdgcn_ds_swizzle((int)v, 0x1F | (M << 10)); }
__device__ __forceinline__ float xsum32(float v) { auto rr = __builtin_amdgcn_permlane32_swap(__float_as_uint(v), __float_as_uint(v), false, false); return __uint_as_float(rr[0]) + __uint_as_float(rr[1]); }
__device__ __forceinline__ float xmax32(float v) { auto rr = __builtin_amdgcn_permlane32_swap(__float_as_uint(v), __float_as_uint(v), false, false); return fmaxf(__uint_as_float(rr[0]), __uint_as_float(rr[1])); }
__device__ __forceinline__ float xother32(float v, bool upper) { auto rr = __builtin_amdgcn_permlane32_swap(__float_as_uint(v), __float_as_uint(v), false, false); return __uint_as_float(upper ? rr[0] : rr[1]); }
#define LDS_WAIT() asm volatile("s_waitcnt lgkmcnt(0)" ::: "memory")
#define VM_WAIT() asm volatile("s_waitcnt vmcnt(0)" ::: "memory")

constexpr int NB = 8, SEQ = 4096, NTOK = NB * SEQ, DM = 1024, NLAYER = 4;
constexpr int NIN_SRC = 6632, NIN = 6656;
constexpr int NEXP = 32, TOPK = 4, DFF = 1024;
constexpr int NSLOT = NTOK * TOPK, NSLOT_PAD = NSLOT + NEXP * 256;
constexpr float LN_EPS = 1e-5f, RMS_EPS = 1e-6f;
constexpr float DN_ALPHA = 1.681792830507429f;
constexpr float LOG2E = 1.4426950408889634f;
constexpr float QSCALE_A = 0.125f * LOG2E;
constexpr float QSCALE_C = 0.10206207261596577f * LOG2E;
constexpr float IW_SCALE = 0.35355339059327373f * 0.125f;

constexpr size_t MiB = (size_t)1 << 20;
constexpr size_t WS_CTL = 0, CTL_ZERO_BYTES = 1 * MiB;
constexpr int CW_BAR = 4096, CW_CNT = 16384;
constexpr size_t SZ_WIN = (size_t)NIN * DM * 2, SZ_WUQ = (size_t)768 * 256 * 2, SZ_WUKV = (size_t)1024 * 256 * 2, SZ_WBR = (size_t)3 * 1024 * 512 * 2, SZ_WOUT = (size_t)1024 * 1024 * 2;
constexpr size_t SZ_WGU = (size_t)NEXP * 2048 * 1024 * 2, SZ_WDN = (size_t)NEXP * 1024 * 1024 * 2, SZ_WGM = (size_t)8 * 128 * 128 * 2;
constexpr size_t WS_WIN = 2 * MiB;
constexpr size_t WS_WUQ = WS_WIN + NLAYER * SZ_WIN;
constexpr size_t WS_WUKV = WS_WUQ + NLAYER * SZ_WUQ;
constexpr size_t WS_WBR = WS_WUKV + NLAYER * SZ_WUKV;
constexpr size_t WS_WOUT = WS_WBR + NLAYER * SZ_WBR;
constexpr size_t WS_WGU = WS_WOUT + NLAYER * SZ_WOUT;
constexpr size_t WS_WDN = WS_WGU + NLAYER * SZ_WGU;
constexpr size_t WS_WGM = WS_WDN + NLAYER * SZ_WDN;
constexpr size_t WS_COSA = WS_WGM + NLAYER * SZ_WGM;
constexpr size_t WS_SINA = WS_COSA + (size_t)NTOK * 8 * 4;
constexpr size_t WS_COSC = WS_SINA + (size_t)NTOK * 8 * 4;
constexpr size_t WS_SINC = WS_COSC + (size_t)NTOK * 16 * 4;
constexpr size_t WS_XRES = WS_SINC + (size_t)NTOK * 16 * 4;
constexpr size_t WS_XB = WS_XRES + (size_t)NTOK * DM * 4;
constexpr size_t WS_QA = WS_XB + (size_t)NTOK * DM * 2;
constexpr size_t WS_KA = WS_QA + (size_t)NTOK * 512 * 2;
constexpr size_t WS_VAT = WS_KA + (size_t)NTOK * 512 * 2;
constexpr size_t WS_IQ = WS_VAT + (size_t)NTOK * 512 * 2;
constexpr size_t WS_IK = WS_IQ + (size_t)NTOK * 512 * 2;
constexpr size_t WS_IW = WS_IK + (size_t)NTOK * 64 * 2;
constexpr size_t WS_U = WS_IW + (size_t)NTOK * 8 * 4;
constexpr size_t WS_V = WS_U + (size_t)NTOK * 512 * 2;
constexpr size_t WS_CDQ = WS_V + (size_t)NTOK * 512 * 2;
constexpr size_t WS_CDKV = WS_CDQ + (size_t)NTOK * 256 * 2;
constexpr size_t WS_SSQ = WS_CDKV + (size_t)NTOK * 256 * 2;
constexpr size_t WS_GATE = WS_SSQ + (size_t)NTOK * 8 * 4;
constexpr size_t WS_QC = WS_GATE + (size_t)NTOK * 3072 * 2;
constexpr size_t WS_KC = WS_QC + (size_t)NTOK * 768 * 2;
constexpr size_t WS_VCT = WS_KC + (size_t)NTOK * 768 * 2;
constexpr size_t WS_SCORE = WS_VCT + (size_t)NTOK * 512 * 2;
constexpr size_t WS_MASK = WS_SCORE + (size_t)NTOK * SEQ * 4;
constexpr size_t WS_OBUF = WS_MASK + (size_t)NTOK * 128 * 4;
constexpr size_t WS_MERGED = WS_OBUF + (size_t)3 * NTOK * 512 * 2;
constexpr size_t WS_TKE = WS_MERGED + (size_t)NTOK * DM * 2;
constexpr size_t WS_TKP = WS_TKE + (size_t)NSLOT * 4;
constexpr size_t WS_TKW = WS_TKP + (size_t)NSLOT * 4;
constexpr size_t WS_STK = WS_TKW + (size_t)NSLOT * 4;
constexpr size_t WS_SW = WS_STK + (size_t)NSLOT_PAD * 4;
constexpr size_t WS_XG = WS_SW + (size_t)NSLOT_PAD * 4;
constexpr size_t WS_H = WS_XG + (size_t)NSLOT_PAD * DM * 2;
constexpr size_t WS_Y = WS_H + (size_t)NSLOT_PAD * DFF * 2;
constexpr size_t WS_CCNT = WS_Y + (size_t)NSLOT_PAD * DM * 2;
constexpr size_t WS_RWT = WS_CCNT + (size_t)(NTOK / 128) * 32 * 4;
constexpr size_t WS_GBW = WS_RWT + (size_t)NLAYER * 32 * 1024 * 4;
constexpr size_t WS_END = WS_GBW + (size_t)NLAYER * 64 * 4;
constexpr size_t WS_DRY = (WS_END + 255) & ~(size_t)255;
static_assert(WS_END < (size_t)4200 * MiB, "workspace map too large");
static_assert((WS_WIN % 256) == 0 && (WS_COSA % 256) == 0 && (WS_XRES % 256) == 0 && (WS_SCORE % 256) == 0 && (WS_XG % 256) == 0, "alignment");

constexpr int LDS_BYTES = 147456;
constexpr int MISC_OFF = 143360;
constexpr int NWAVES = 8;

#define XB_TMO      128
#define XB_XCNT(j)  (256  + 64 * (j))
#define XB_XSUB(j)  (1280 + 64 * (j))
#define XB_XGEN(j)  (2304 + 64 * (j))
#define XB_TOP      3328
#define XB_TOPGEN   3392
#define XCD_BAR_WORDS 3456
#define XB_SPIN_CAP (1u << 18)
__device__ __forceinline__ unsigned xb_ld(unsigned* p)              { return __hip_atomic_load(p, __ATOMIC_RELAXED, __HIP_MEMORY_SCOPE_AGENT); }
__device__ __forceinline__ unsigned xb_add(unsigned* p, unsigned v) { return __hip_atomic_fetch_add(p, v, __ATOMIC_RELAXED, __HIP_MEMORY_SCOPE_AGENT); }
__device__ __forceinline__ unsigned xb_xcc_id() { return (unsigned)__builtin_amdgcn_s_getreg((3 << 11) | 20) & 0xFu; }
#define XB_SPIN(cond, bar) do { unsigned _sp = 0; while (cond) { __builtin_amdgcn_s_sleep(1); \
    if ((++_sp & 255u) == 0u) { if (xb_ld(&(bar)[XB_TMO])) break; if (_sp > XB_SPIN_CAP) { atomicAdd(&(bar)[XB_TMO], 1u); break; } } } } while (0)
struct XcdBarrier { unsigned* bar; unsigned x; volatile LAS unsigned* st; };
__device__ __forceinline__ XcdBarrier xcd_barrier_post(unsigned* bar, volatile LAS unsigned* st) {
    XcdBarrier b; b.bar = bar; b.x = xb_xcc_id(); b.st = st;
    if (threadIdx.x == 0) (void)xb_add(&bar[XB_XCNT(b.x)], 1u);
    return b;
}
__device__ __forceinline__ void xcd_barrier_complete(unsigned* bar, unsigned x, unsigned& nloc, unsigned& nx) {
    const unsigned G = gridDim.x * gridDim.y * gridDim.z;
    unsigned sum, cnt, mine, sp = 0u;
    for (;;) {
        sum = 0u; cnt = 0u; mine = 0u;
#pragma unroll
        for (unsigned j = 0; j < 16; ++j) { const unsigned c = xb_ld(&bar[XB_XCNT(j)]); sum += c; cnt += (c > 0u) ? 1u : 0u; mine = (j == x) ? c : mine; }
        if (sum == G) break;
        __builtin_amdgcn_s_sleep(1);
        if ((++sp & 255u) == 0u) { if (xb_ld(&bar[XB_TMO])) break; if (sp > XB_SPIN_CAP) { atomicAdd(&bar[XB_TMO], 1u); break; } }
    }
    nloc = mine > 0u ? mine : 1u; nx = cnt > 0u ? cnt : 1u;
}
__device__ __forceinline__ void xcd_barrier(const XcdBarrier& b, bool leader_thread) {
    asm volatile("s_waitcnt vmcnt(0)" ::: "memory");
    __syncthreads();
    if (leader_thread) {
        unsigned* bar = b.bar;
        __builtin_amdgcn_s_waitcnt(0);
        unsigned nloc = b.st[0], nx = b.st[1];
        if (nloc == 0u) { xcd_barrier_complete(bar, b.x, nloc, nx); b.st[0] = nloc; b.st[1] = nx; }
        const unsigned old = xb_add(&bar[XB_XSUB(b.x)], 1u);
        const unsigned gen = old / nloc;
        if (old + 1u == (gen + 1u) * nloc) {
            __builtin_amdgcn_fence(__ATOMIC_RELEASE, "agent");
            asm volatile("s_waitcnt vmcnt(0)" ::: "memory");
            const unsigned og = xb_add(&bar[XB_TOP], 1u);
            const unsigned tg = og / nx;
            if (og + 1u == (tg + 1u) * nx) xb_add(&bar[XB_TOPGEN], 1u);
            else XB_SPIN(xb_ld(&bar[XB_TOPGEN]) == tg, bar);
            __builtin_amdgcn_fence(__ATOMIC_ACQUIRE, "agent");
            xb_add(&bar[XB_XGEN(b.x)], 1u);
            asm volatile("s_waitcnt vmcnt(0)" ::: "memory");
        } else {
            XB_SPIN(xb_ld(&bar[XB_XGEN(b.x)]) == gen, bar);
            __builtin_amdgcn_fence(__ATOMIC_ACQUIRE, "agent");
            asm volatile("s_waitcnt vmcnt(0)" ::: "memory");
        }
    }
    __syncthreads();
}

namespace pg8 {
constexpr int BM = 256, BK = 64, HALF = 128, HTB = HALF * BK * 2;
__host__ __device__ __forceinline__ int lds_byte(int r, int c) { const int st = (r >> 4) * 2 + (c >> 5), rr = r & 15, cc = c & 31, ob = rr * 64 + cc * 2; return st * 1024 + (ob ^ (((ob >> 9) & 1) << 5)); }
__host__ __device__ __forceinline__ void stage_rc(int b, int& R, int& C) { const int st = b / 1024, sb = b % 1024, swz = sb ^ (((sb >> 9) & 1) << 5); R = (st >> 1) * 16 + swz / 64; C = (st & 1) * 32 + (swz % 64) / 2; }
__host__ __device__ __forceinline__ int perm32(int rho) { const int n = rho >> 4, i = rho & 15; return 8 * (i >> 2) + 4 * n + (i & 3); }
struct Unit { int pm, pn; };
struct Gemm { const bf16_t* A; const bf16_t* Bt; int lda, K; const int* rowmap; };

constexpr int PRE_OFF = 131072;
template <class Epi, class Sched, bool GATHER = false>
__device__ __forceinline__ void gemm_phase(LAS unsigned char* lds, const Gemm g, const Sched& S, const Epi& E, int tid0) {
    int tid = tid0; asm volatile("" : "+v"(tid));
    const int wid = __builtin_amdgcn_readfirstlane(tid >> 6), lane = tid & 63, wr = wid >> 2, wc = wid & 3, fr = lane & 15, fq = lane >> 4;
    const int K = g.K, nt = K / BK, lda = g.lda;
    unsigned voffA[2], voffB[2]; unsigned colA2 = 0u;
#pragma unroll
    for (int i = 0; i < 2; ++i) { int R, C; stage_rc(tid * 16 + i * 8192, R, C); voffA[i] = (unsigned)(R * lda + C) * 2u; const int Rb = (R & ~31) + perm32(R & 31); voffB[i] = (unsigned)(Rb * K + C) * 2u; colA2 = (unsigned)C * 2u; }
    unsigned gcur[2] = {0u, 0u}, gnxt[2] = {0u, 0u};
#define PG8_GLOAD(d, pm_) do { int ln_; asm volatile("v_mbcnt_lo_u32_b32 %0, -1, 0\n\tv_mbcnt_hi_u32_b32 %0, -1, %0" : "=v"(ln_));   \
        int R0_, C0_; stage_rc(((wid << 6) | ln_) * 16, R0_, C0_); const int* rm_ = g.rowmap + (pm_) * BM + R0_; \
        d[0] = (unsigned)rm_[0] | ((unsigned)rm_[64] << 16); d[1] = (unsigned)rm_[HALF] | ((unsigned)rm_[HALF + 64] << 16); } while (0)
#define PG8_GOFF(p, i) ((((i) ? ((p) >> 16) : ((p) & 0xffffu)) * (unsigned)(lda * 2)) + colA2)
#define PG8_STAGE_G(bufoff, gbase, p) do { _Pragma("unroll") for (int _i = 0; _i < 2; ++_i) \
        __builtin_amdgcn_global_load_lds((const unsigned*)((const char*)(gbase) + PG8_GOFF(p, _i)), (LAS unsigned*)(lds + (bufoff) + ldsw + _i * 8192), 16, 0, 0); } while (0)
    const size_t kstep = (size_t)(BK * 2);
    const size_t hstepA = (size_t)HALF * lda * 2, hstepB = (size_t)HALF * K * 2;
    const size_t tstepA = 2 * hstepA, tstepB = 2 * hstepB;
    const unsigned ldsw = (unsigned)wid * 1024u;
    const int aoff = lds_byte(wr * 64 + fr, fq * 8), boff = lds_byte(wc * 32 + fr, fq * 8);
#define PG8_SA(b, h) (((b) * 2 + (h)) * HTB)
#define PG8_SB(b, h) ((4 + (b) * 2 + (h)) * HTB)
#define PG8_STAGE(bufoff, gbase, voff) do { _Pragma("unroll") for (int _i = 0; _i < 2; ++_i) \
        __builtin_amdgcn_global_load_lds((const unsigned*)((const char*)(gbase) + (voff)[_i]), (LAS unsigned*)(lds + (bufoff) + ldsw + _i * 8192), 16, 0, 0); } while (0)
#define PG8_STAGE_A(bufoff, gbase, half, nextu) do { if constexpr (GATHER) { if (nextu) PG8_STAGE_G(bufoff, gbase, gnxt[half]); else PG8_STAGE_G(bufoff, gbase, gcur[half]); } \
        else { PG8_STAGE(bufoff, (gbase) + ((half) ? hstepA : 0), voffA); } } while (0)
#define PG8_LDA(dst, b, h) do { _Pragma("unroll") for (int m = 0; m < 4; ++m) _Pragma("unroll") for (int k = 0; k < 2; ++k) dst[m][k] = *(const LAS bf16x8*)(lds + PG8_SA(b, h) + aoff + m * 2048 + k * 1024); } while (0)
#define PG8_LDB(dst, b, h) do { _Pragma("unroll") for (int n = 0; n < 2; ++n) _Pragma("unroll") for (int k = 0; k < 2; ++k) dst[n][k] = *(const LAS bf16x8*)(lds + PG8_SB(b, h) + boff + n * 2048 + k * 1024); } while (0)
#define PG8_MMA(ai, bj, At, Bt) do { __builtin_amdgcn_s_setprio(1); _Pragma("unroll") for (int m = 0; m < 4; ++m) _Pragma("unroll") for (int n = 0; n < 2; ++n) _Pragma("unroll") for (int k = 0; k < 2; ++k) \
        acc[ai][bj][m][n] = __builtin_amdgcn_mfma_f32_16x16x32_bf16(Bt[n][k], At[m][k], acc[ai][bj][m][n], 0, 0, 0); __builtin_amdgcn_s_setprio(0); } while (0)
#define PG8_WAIT_V(n) asm volatile("s_waitcnt vmcnt(" #n ")" ::: "memory")
#define PG8_WAIT_L(n) asm volatile("s_waitcnt lgkmcnt(" #n ")" ::: "memory")
#define PG8_BAR __builtin_amdgcn_s_barrier()
#define PG8_SCHED __builtin_amdgcn_sched_barrier(0)
    Unit cur, nxt; int ui = 0;
    if (!S.next(0, cur)) return;
    f32x4 acc[2][2][4][2];
#pragma unroll
    for (int a = 0; a < 2; ++a)
#pragma unroll
        for (int b = 0; b < 2; ++b)
#pragma unroll
            for (int m = 0; m < 4; ++m)
#pragma unroll
                for (int n = 0; n < 2; ++n) acc[a][b][m][n] = (f32x4){0.f, 0.f, 0.f, 0.f};
    bf16x8 At[4][2], B0[2][2], B1[2][2];
    const char* cA = GATHER ? (const char*)g.A : (const char*)g.A + (size_t)cur.pm * tstepA; const char* cB = (const char*)g.Bt + (size_t)cur.pn * tstepB;
    if constexpr (GATHER) { PG8_GLOAD(gcur, cur.pm); }
#define PG8_PRE(u_, slot_) do { if (wid < 4) { int ln_; asm volatile("v_mbcnt_lo_u32_b32 %0, -1, 0\n\tv_mbcnt_hi_u32_b32 %0, -1, %0" : "=v"(ln_));   \
        __builtin_amdgcn_global_load_lds((const unsigned*)(E.pre_base(u_, wid) + ln_), (LAS unsigned*)(lds + PRE_OFF + (slot_) * 1024 + wid * 256), 4, 0, 0); } } while (0)
    if constexpr (Epi::PRE) { PG8_PRE(cur, 0); }
    PG8_STAGE(PG8_SB(0, 0), cB, voffB); PG8_STAGE(PG8_SB(0, 1), cB + hstepB, voffB); PG8_STAGE_A(PG8_SA(0, 0), cA, 0, false); PG8_STAGE_A(PG8_SA(0, 1), cA, 1, false);
    if (wr == 1) PG8_BAR;
    PG8_WAIT_V(2); PG8_BAR;
    PG8_STAGE(PG8_SB(1, 0), cB + kstep, voffB); PG8_STAGE_A(PG8_SA(1, 0), cA + kstep, 0, false); PG8_STAGE(PG8_SB(1, 1), cB + hstepB + kstep, voffB);
    PG8_WAIT_V(6); PG8_BAR;
    for (;;) {
        const bool has_next = S.next(ui + 1, nxt);
        const char* nA = GATHER ? cA : (has_next ? (const char*)g.A + (size_t)nxt.pm * tstepA : cA); const char* nB = has_next ? (const char*)g.Bt + (size_t)nxt.pn * tstepB : cB;
        if constexpr (GATHER) { if (has_next) { PG8_GLOAD(gnxt, nxt.pm); } else { gnxt[0] = gcur[0]; gnxt[1] = gcur[1]; } }
        for (int t = 0; t < nt; t += 2) {
            const bool last = (t == nt - 2);
            if constexpr (Epi::PRE) { if (last && has_next) PG8_PRE(nxt, (ui + 1) & 1); }
            const char* a1 = cA + (size_t)(t + 1) * kstep;
            const char* a2 = last ? nA : cA + (size_t)(t + 2) * kstep; const char* b2 = last ? nB : cB + (size_t)(t + 2) * kstep;
            const char* a3 = a2 + kstep; const char* b3 = b2 + kstep;
            PG8_LDB(B0, 0, 0); PG8_LDB(B1, 0, 1); PG8_SCHED; PG8_LDA(At, 0, 0); PG8_STAGE_A(PG8_SA(1, 1), a1, 1, false);
            PG8_WAIT_V(8); PG8_WAIT_L(0); PG8_BAR; PG8_MMA(0, 0, At, B0); PG8_MMA(0, 1, At, B1); PG8_BAR; PG8_SCHED;
            PG8_LDA(At, 0, 1); PG8_STAGE(PG8_SB(0, 0), b2, voffB); PG8_STAGE(PG8_SB(0, 1), b2 + hstepB, voffB); PG8_STAGE_A(PG8_SA(0, 0), a2, 0, last);
            PG8_WAIT_V(8); PG8_WAIT_L(0); PG8_BAR; PG8_MMA(1, 0, At, B0); PG8_MMA(1, 1, At, B1); PG8_BAR; PG8_SCHED;
            PG8_LDB(B0, 1, 0); PG8_LDB(B1, 1, 1); PG8_SCHED; PG8_LDA(At, 1, 0); PG8_STAGE_A(PG8_SA(0, 1), a2, 1, last);
            PG8_WAIT_V(8); PG8_WAIT_L(0); PG8_BAR; PG8_MMA(0, 0, At, B0); PG8_MMA(0, 1, At, B1); PG8_BAR; PG8_SCHED;
            PG8_LDA(At, 1, 1); PG8_STAGE(PG8_SB(1, 0), b3, voffB); PG8_STAGE(PG8_SB(1, 1), b3 + hstepB, voffB); PG8_STAGE_A(PG8_SA(1, 0), a3, 0, last);
            PG8_WAIT_V(8); PG8_WAIT_L(0); PG8_BAR; PG8_MMA(1, 0, At, B0); PG8_MMA(1, 1, At, B1); PG8_BAR; PG8_SCHED;
        }
        if (wr == 0) PG8_BAR;
        { int el; asm volatile("v_mbcnt_lo_u32_b32 %0, -1, 0\n\tv_mbcnt_hi_u32_b32 %0, -1, %0" : "=v"(el));
          if constexpr (Epi::PRE) E(acc, cur, wr, wc, el & 15, el >> 4, (const LAS float*)(lds + PRE_OFF + (ui & 1) * 1024)); else E(acc, cur, wr, wc, el & 15, el >> 4); }
        if (!has_next) break;
        if constexpr (!Epi::CHAIN) {
#pragma unroll
        for (int a = 0; a < 2; ++a)
#pragma unroll
            for (int b = 0; b < 2; ++b)
#pragma unroll
                for (int m = 0; m < 4; ++m)
#pragma unroll
                    for (int n = 0; n < 2; ++n) acc[a][b][m][n] = (f32x4){0.f, 0.f, 0.f, 0.f};
        }
        cur = nxt; cA = nA; cB = nB; ++ui;
        if constexpr (GATHER) { gcur[0] = gnxt[0]; gcur[1] = gnxt[1]; }
        if (wr == 1) PG8_BAR;
    }
    PG8_WAIT_V(0);
    PG8_BAR;
#undef PG8_PRE
#undef PG8_SA
#undef PG8_SB
#undef PG8_STAGE
#undef PG8_LDA
#undef PG8_STAGE_A
#undef PG8_GLOAD
#undef PG8_GOFF
#undef PG8_STAGE_G
#undef PG8_LDB
#undef PG8_MMA
#undef PG8_WAIT_V
#undef PG8_WAIT_L
#undef PG8_BAR
#undef PG8_SCHED
}
}
using pg8::Unit;

struct Args { const float* in[23]; float* out; unsigned char* ws; int ph_lo, ph_hi; int sub, pad; };
struct Ctx {
    LAS unsigned char* lds;
    int tid, lane, wave, G, bid;
    unsigned char* ws;
};
#define WSP(T, off) ((T*)(C.ws + (off)))

struct GridOrder {
    int nN, total, G, c;
    __device__ __forceinline__ bool next(int i, Unit& u) const {
        const int L = c + i * G; if (L >= total) return false;
        const int nM = total / nN; int wgid;
        { const int q = total >> 3, r = total & 7, xcd = L & 7, off = L >> 3; wgid = (xcd < r ? xcd * (q + 1) : r * (q + 1) + (xcd - r) * q) + off; }
        const int nig = 8 * nN, gid = wgid / nig, fm = gid * 8, gsz = (nM - fm) < 8 ? (nM - fm) : 8, w = wgid - gid * nig;
        const int pn = w / gsz; u.pm = fm + (w - pn * gsz); u.pn = pn; return true;
    }
};
struct MergeOrder {
    int G, c;
    __device__ __forceinline__ bool next(int i, Unit& u) const { const int t = i / 3, n = i - 3 * t, tile = c + t * G; if (tile >= 512) return false; u.pm = n * 128 + (tile >> 2); u.pn = n * 4 + (tile & 3); return true; }
};
struct MoeOrder {
    int NT, total, G, c; const LAS int* tb;
    __device__ __forceinline__ bool next(int i, Unit& u) const {
        if ((G & 7) != 0) { const int idx = c + i * G; if (idx >= total) return false; const int mt = idx / NT, pn = idx - mt * NT;
            const int e = __builtin_amdgcn_readfirstlane(tb[40 + mt]); u.pm = mt; u.pn = e * NT + pn; return true; }
        const int T = __builtin_amdgcn_readfirstlane(tb[NEXP]), x = c & 7, lo = (x * T) >> 3, ntl = (((x + 1) * T) >> 3) - lo;
        const int j = (c >> 3) + i * (G >> 3);
        if (j >= ntl * NT) return false;
        const int gsh = (NT == 8) ? 6 : 5, gm = j >> gsh, rem = j - (gm << gsh);
        const int gs = (ntl - 8 * gm < 8) ? (ntl - 8 * gm) : 8, g4 = gs * 4, pg = (rem >= g4) ? 1 : 0, r2 = rem - pg * g4;
        const int mt = lo + 8 * gm + (r2 >> 2), e = __builtin_amdgcn_readfirstlane(tb[40 + mt]);
        u.pm = mt; u.pn = e * NT + pg * 4 + (r2 & 3); return true;
    }
};

__device__ __forceinline__ float gelu_f(float v) {
    const float av = fabsf(v), t = __builtin_amdgcn_rcpf(fmaf(av, 0.2316418882f, 1.0f));
    float q = fmaf(t, 0.5307027145f, -0.7265760135f); q = fmaf(q, t, 0.7107068705f); q = fmaf(q, t, -0.142248368f); q = fmaf(q, t, 0.127414796f); q = q * t;
    const float e = __builtin_amdgcn_exp2f((v * v) * (-0.72134752044f));
    const float m = v * (q * e);
    return v < 0.f ? m : v - m;
}
__device__ __forceinline__ float sigmoid_f(float x) { return __builtin_amdgcn_rcpf(1.f + __builtin_amdgcn_exp2f(x * (-LOG2E))); }
__device__ __forceinline__ int perm16(int o) { return (o & 3) | (((o >> 3) & 1) << 2) | (((o >> 2) & 1) << 3); }
__device__ __forceinline__ void st_bf4(bf16_t* p, f32x4 v) { u32x2 w; w.x = pk2(v[0], v[1]); w.y = pk2(v[2], v[3]); *(u32x2*)p = w; }
__device__ __forceinline__ f32x4 other32_4(f32x4 v, bool upper) { f32x4 r; r[0] = xother32(v[0], upper); r[1] = xother32(v[1], upper); r[2] = xother32(v[2], upper); r[3] = xother32(v[3], upper); return r; }

__device__ __forceinline__ void st_bf8(bf16_t* p, f32x4 v0, f32x4 v1) { u32x4 w; w.x = pk2(v0[0], v0[1]); w.y = pk2(v0[2], v0[3]); w.z = pk2(v1[0], v1[1]); w.w = pk2(v1[2], v1[3]); __builtin_nontemporal_store(w, (u32x4*)p); }
__device__ __forceinline__ f32x4 swz16_4(f32x4 v) { f32x4 r; r[0] = xswz<16>(v[0]); r[1] = xswz<16>(v[1]); r[2] = xswz<16>(v[2]); r[3] = xswz<16>(v[3]); return r; }
__device__ __forceinline__ void ld_bf8(const bf16_t* p, f32x4& a, f32x4& b) { const u32x4 w = *(const u32x4*)p; a = (f32x4){bflo(w.x), bfhi(w.x), bflo(w.y), bfhi(w.y)}; b = (f32x4){bflo(w.z), bfhi(w.z), bflo(w.w), bfhi(w.w)}; }
__device__ __forceinline__ void st_vt8(bf16_t* p, f32x4 v0, f32x4 v1) {
    const unsigned w0 = pk2(v0[0], v0[1]), w1 = pk2(v0[2], v0[3]), w2 = pk2(v1[0], v1[1]), w3 = pk2(v1[2], v1[3]);
    p[0] = (bf16_t)(w0 & 0xffff); p[SEQ] = (bf16_t)(w0 >> 16); p[2 * SEQ] = (bf16_t)(w1 & 0xffff); p[3 * SEQ] = (bf16_t)(w1 >> 16);
    p[4 * SEQ] = (bf16_t)(w2 & 0xffff); p[5 * SEQ] = (bf16_t)(w2 >> 16); p[6 * SEQ] = (bf16_t)(w3 & 0xffff); p[7 * SEQ] = (bf16_t)(w3 >> 16);
}
struct EpiInProj {
    static constexpr bool CHAIN = false; static constexpr bool PRE = false;
    unsigned char* ws; bool skip;
    __device__ __forceinline__ void operator()(f32x4 (&acc)[2][2][4][2], const Unit& un, int wr, int wc, int fr, int fq) const {
        if (skip) return;
        const int pn = un.pn; const int row0 = un.pm * 256 + wr * 64 + fr;
        const float* cosA = (const float*)(ws + WS_COSA); const float* sinA = (const float*)(ws + WS_SINA); const float* cosC = (const float*)(ws + WS_COSC); const float* sinC = (const float*)(ws + WS_SINC);
        if (pn < 4 || pn == 6 || pn == 7) {
            const size_t doff = pn < 2 ? WS_QA : (pn < 4 ? WS_KA : WS_IQ); bf16_t* dst = (bf16_t*)(ws + doff); const float sc = pn < 2 ? QSCALE_A : 1.f; const int tcol = (pn & 1) * 256;
            const bool rope = (wc & 1) == 0;
#pragma unroll
            for (int ai = 0; ai < 2; ++ai)
#pragma unroll
                for (int m = 0; m < 4; ++m) { const int row = row0 + ai * 128 + m * 16;
                    f32x4 c0 = {1.f, 1.f, 1.f, 1.f}, c1 = c0, s0 = {0.f, 0.f, 0.f, 0.f}, s1 = s0;
                    if (rope) { c0 = *(const f32x4*)(cosA + (size_t)row * 8); c1 = *(const f32x4*)(cosA + (size_t)row * 8 + 4); s0 = *(const f32x4*)(sinA + (size_t)row * 8); s1 = *(const f32x4*)(sinA + (size_t)row * 8 + 4); }
#pragma unroll
                    for (int bj = 0; bj < 2; ++bj) { f32x4 v0 = acc[ai][bj][m][0], v1 = acc[ai][bj][m][1];
                        const f32x4 p0 = swz16_4(v0), p1 = swz16_4(v1);
                        if (rope && fq < 2) { v0 = (fq == 0) ? (v0 * c0 - p0 * s0) : (v0 * c0 + p0 * s0); v1 = (fq == 0) ? (v1 * c1 - p1 * s1) : (v1 * c1 + p1 * s1); }
                        st_bf8(dst + (size_t)row * 512 + tcol + bj * 128 + wc * 32 + 8 * fq, v0 * sc, v1 * sc); } }
        } else if (pn < 6) {
            bf16_t* vat = (bf16_t*)(ws + WS_VAT);
#pragma unroll
            for (int ai = 0; ai < 2; ++ai)
#pragma unroll
                for (int m = 0; m < 4; ++m) { const int row = row0 + ai * 128 + m * 16; const int b = row >> 12, s = row & 4095, ps = (s & ~15) | perm16(s & 15);
#pragma unroll
                    for (int bj = 0; bj < 2; ++bj) { const int c = (pn - 4) * 256 + bj * 128 + wc * 32 + 8 * fq; const int h = c >> 6, d = c & 63;
                        st_vt8(vat + ((size_t)(b * 8 + h) * 64 + d) * SEQ + ps, acc[ai][bj][m][0], acc[ai][bj][m][1]); } }
        } else if (pn == 8) {
            bf16_t* ik = (bf16_t*)(ws + WS_IK); float* iw = (float*)(ws + WS_IW); bf16_t* kc = (bf16_t*)(ws + WS_KC); bf16_t* cd = (bf16_t*)(ws + WS_CDKV); float* ssq = (float*)(ws + WS_SSQ);
#pragma unroll
            for (int ai = 0; ai < 2; ++ai)
#pragma unroll
                for (int m = 0; m < 4; ++m) { const int row = row0 + ai * 128 + m * 16;
                    { f32x4 v0 = acc[ai][0][m][0], v1 = acc[ai][0][m][1];
                      { unsigned zz = 0u; asm volatile("" : "+v"(zz)); const u32x4 z = {zz, zz, zz, zz}; *(u32x4*)(cd + (size_t)row * 256 + wc * 32 + 8 * fq) = z; }
                      if (wc == 0) {
                          const f32x4 p0 = swz16_4(v0), p1 = swz16_4(v1);
                          if (fq < 2) { const f32x4 c0 = *(const f32x4*)(cosA + (size_t)row * 8), c1 = *(const f32x4*)(cosA + (size_t)row * 8 + 4), s0 = *(const f32x4*)(sinA + (size_t)row * 8), s1 = *(const f32x4*)(sinA + (size_t)row * 8 + 4);
                              v0 = (fq == 0) ? (v0 * c0 - p0 * s0) : (v0 * c0 + p0 * s0); v1 = (fq == 0) ? (v1 * c1 - p1 * s1) : (v1 * c1 + p1 * s1); }
                          st_bf8(ik + (size_t)row * 64 + 8 * fq, v0, v1);
                      } else if (wc == 1) { st_bf8(ik + (size_t)row * 64 + 32 + 8 * fq, v0, v1);
                      } else if (wc == 2) { if (fq == 0) { *(f32x4*)(iw + (size_t)row * 8) = v0 * IW_SCALE; *(f32x4*)(iw + (size_t)row * 8 + 4) = v1 * IW_SCALE; }
                      } else {
                          const bool up = fq >= 2; const f32x4 p0 = other32_4(v0, up), p1 = other32_4(v1, up);
                          const f32x4 c0 = *(const f32x4*)(cosC + (size_t)row * 16 + 8 * (fq & 1)), c1 = *(const f32x4*)(cosC + (size_t)row * 16 + 8 * (fq & 1) + 4), s0 = *(const f32x4*)(sinC + (size_t)row * 16 + 8 * (fq & 1)), s1 = *(const f32x4*)(sinC + (size_t)row * 16 + 8 * (fq & 1) + 4);
                          const f32x4 o0 = up ? (v0 * c0 + p0 * s0) : (v0 * c0 - p0 * s0), o1 = up ? (v1 * c1 + p1 * s1) : (v1 * c1 - p1 * s1);
                          bf16_t* p = kc + (size_t)row * 768 + 64 + 8 * fq;
#pragma unroll
                          for (int h = 0; h < 8; ++h) st_bf8(p + h * 96, o0, o1); } }
                    { const f32x4 v0 = acc[ai][1][m][0], v1 = acc[ai][1][m][1];
                      st_bf8(cd + (size_t)row * 256 + 128 + wc * 32 + 8 * fq, v0, v1);
                      float s = (v0[0] * v0[0] + v0[1] * v0[1]) + (v0[2] * v0[2] + v0[3] * v0[3]) + (v1[0] * v1[0] + v1[1] * v1[1]) + (v1[2] * v1[2] + v1[3] * v1[3]);
                      s += xswz<16>(s); s = xsum32(s);
                      if (fq == 0) ssq[(size_t)row * 8 + 4 + wc] = s; } }
        } else if (pn < 13) {
            bf16_t* dst = (bf16_t*)(ws + (pn < 11 ? WS_U : WS_V)); const int tcol = ((pn - 9) & 1) * 256;
#pragma unroll
            for (int ai = 0; ai < 2; ++ai)
#pragma unroll
                for (int m = 0; m < 4; ++m) { const int row = row0 + ai * 128 + m * 16;
#pragma unroll
                    for (int bj = 0; bj < 2; ++bj) { f32x4 v0 = acc[ai][bj][m][0], v1 = acc[ai][bj][m][1];
                        v0[0] = gelu_f(v0[0]); v0[1] = gelu_f(v0[1]); v0[2] = gelu_f(v0[2]); v0[3] = gelu_f(v0[3]); v1[0] = gelu_f(v1[0]); v1[1] = gelu_f(v1[1]); v1[2] = gelu_f(v1[2]); v1[3] = gelu_f(v1[3]);
                        st_bf8(dst + (size_t)row * 512 + tcol + bj * 128 + wc * 32 + 8 * fq, v0, v1); } }
        } else if (pn == 13) {
            bf16_t* cd = (bf16_t*)(ws + WS_CDQ); float* ssq = (float*)(ws + WS_SSQ);
#pragma unroll
            for (int ai = 0; ai < 2; ++ai)
#pragma unroll
                for (int m = 0; m < 4; ++m) { const int row = row0 + ai * 128 + m * 16; float s = 0.f;
#pragma unroll
                    for (int bj = 0; bj < 2; ++bj) { const f32x4 v0 = acc[ai][bj][m][0], v1 = acc[ai][bj][m][1];
                        st_bf8(cd + (size_t)row * 256 + bj * 128 + wc * 32 + 8 * fq, v0, v1);
                        s += ((v0[0] * v0[0] + v0[1] * v0[1]) + (v0[2] * v0[2] + v0[3] * v0[3])) + ((v1[0] * v1[0] + v1[1] * v1[1]) + (v1[2] * v1[2] + v1[3] * v1[3])); }
                    s += xswz<16>(s); s = xsum32(s);
                    if (fq == 0) ssq[(size_t)row * 8 + wc] = s; }
        } else {
            const int tcol = (pn - 14) * 256; bf16_t* gate = (bf16_t*)(ws + WS_GATE);
#pragma unroll
            for (int ai = 0; ai < 2; ++ai)
#pragma unroll
                for (int m = 0; m < 4; ++m) { const int row = row0 + ai * 128 + m * 16;
#pragma unroll
                    for (int bj = 0; bj < 2; ++bj) { f32x4 v0 = acc[ai][bj][m][0], v1 = acc[ai][bj][m][1];
                        v0[0] = sigmoid_f(v0[0]); v0[1] = sigmoid_f(v0[1]); v0[2] = sigmoid_f(v0[2]); v0[3] = sigmoid_f(v0[3]); v1[0] = sigmoid_f(v1[0]); v1[1] = sigmoid_f(v1[1]); v1[2] = sigmoid_f(v1[2]); v1[3] = sigmoid_f(v1[3]);
                        st_bf8(gate + (size_t)row * 3072 + tcol + bj * 128 + wc * 32 + 8 * fq, v0, v1); } }
        }
    }
};

struct EpiQUp {
    static constexpr bool CHAIN = false; static constexpr bool PRE = false;
    bf16_t* qc; const float* ssq; const float *cosC, *sinC;
    __device__ __forceinline__ void operator()(f32x4 (&acc)[2][2][4][2], const Unit& un, int wr, int wc, int fr, int fq) const {
        const int row0 = un.pm * 256 + wr * 64 + fr; const bool up = fq >= 2;
#pragma unroll
        for (int ai = 0; ai < 2; ++ai)
#pragma unroll
            for (int m = 0; m < 4; ++m) { const int row = row0 + ai * 128 + m * 16;
                const f32x4 sp = *(const f32x4*)(ssq + (size_t)row * 8);
                const float rs = rsqrtf(((sp[0] + sp[1]) + (sp[2] + sp[3])) * (1.f / 256.f) + RMS_EPS) * QSCALE_C;
                const f32x4 c0 = *(const f32x4*)(cosC + (size_t)row * 16 + 8 * (fq & 1)), c1 = *(const f32x4*)(cosC + (size_t)row * 16 + 8 * (fq & 1) + 4), s0 = *(const f32x4*)(sinC + (size_t)row * 16 + 8 * (fq & 1)), s1 = *(const f32x4*)(sinC + (size_t)row * 16 + 8 * (fq & 1) + 4);
#pragma unroll
                for (int bj = 0; bj < 2; ++bj) { const int gidx = un.pn * 8 + bj * 4 + wc;
                    f32x4 v0 = acc[ai][bj][m][0] * rs, v1 = acc[ai][bj][m][1] * rs;
                    if ((gidx % 3) == 2) { const f32x4 p0 = other32_4(v0, up), p1 = other32_4(v1, up);
                        v0 = up ? (v0 * c0 + p0 * s0) : (v0 * c0 - p0 * s0); v1 = up ? (v1 * c1 + p1 * s1) : (v1 * c1 - p1 * s1); }
                    st_bf8(qc + (size_t)row * 768 + gidx * 32 + 8 * fq, v0, v1); } }
    }
};
struct EpiKvUp {
    static constexpr bool CHAIN = false; static constexpr bool PRE = false;
    bf16_t *kc, *vct; const float* ssq;
    __device__ __forceinline__ void operator()(f32x4 (&acc)[2][2][4][2], const Unit& un, int wr, int wc, int fr, int fq) const {
        const int row0 = un.pm * 256 + wr * 64 + fr;
#pragma unroll
        for (int ai = 0; ai < 2; ++ai)
#pragma unroll
            for (int m = 0; m < 4; ++m) { const int row = row0 + ai * 128 + m * 16;
                const f32x4 sp = *(const f32x4*)(ssq + (size_t)row * 8 + 4);
                const float rs = rsqrtf(((sp[0] + sp[1]) + (sp[2] + sp[3])) * (1.f / 128.f) + RMS_EPS);
                const int b = row >> 12, s = row & 4095, ps = (s & ~15) | perm16(s & 15);
#pragma unroll
                for (int bj = 0; bj < 2; ++bj) { const int h = un.pn * 2 + bj; const f32x4 v0 = acc[ai][bj][m][0] * rs, v1 = acc[ai][bj][m][1] * rs;
                    if (wc < 2) st_bf8(kc + (size_t)row * 768 + h * 96 + wc * 32 + 8 * fq, v0, v1);
                    else st_vt8(vct + ((size_t)(b * 8 + h) * 64 + (wc - 2) * 32 + 8 * fq) * SEQ + ps, v0, v1); }
                asm volatile("" ::: "memory"); }
    }
};
struct EpiMerge {
    static constexpr bool CHAIN = true; static constexpr bool PRE = false;
    const bf16_t* gate; bf16_t* merged;
    __device__ __forceinline__ void operator()(f32x4 (&acc)[2][2][4][2], const Unit& un, int wr, int wc, int fr, int fq) const {
        const int n3 = un.pm >> 7, pm = un.pm & 127, pn = un.pn & 3; const int row0 = pm * 256 + wr * 64 + fr;
#pragma unroll
        for (int ai = 0; ai < 2; ++ai)
#pragma unroll
            for (int m = 0; m < 4; ++m) { const int row = row0 + ai * 128 + m * 16;
#pragma unroll
                for (int bj = 0; bj < 2; ++bj) { const int col = pn * 256 + bj * 128 + wc * 32 + 8 * fq;
                    const bf16_t* gp = gate + (size_t)row * 3072 + n3 * 1024 + col;
                    f32x4 ga0, ga1; ld_bf8(gp, ga0, ga1);
                    if (n3 < 2) { f32x4 gb0, gb1; ld_bf8(gp + 1024, gb0, gb1);
#pragma unroll
                        for (int j = 0; j < 4; ++j) { if (n3 == 1) { ga0[j] = fmaxf(ga0[j], 1e-20f); ga1[j] = fmaxf(ga1[j], 1e-20f); }
                            acc[ai][bj][m][0][j] *= ga0[j] * __builtin_amdgcn_rcpf(fmaxf(gb0[j], 1e-20f)); acc[ai][bj][m][1][j] *= ga1[j] * __builtin_amdgcn_rcpf(fmaxf(gb1[j], 1e-20f)); }
                    } else {
#pragma unroll
                        for (int j = 0; j < 4; ++j) { ga0[j] = fmaxf(ga0[j], 1e-20f); ga1[j] = fmaxf(ga1[j], 1e-20f); }
                        st_bf8(merged + (size_t)row * 1024 + col, acc[ai][bj][m][0] * ga0, acc[ai][bj][m][1] * ga1);
                        acc[ai][bj][m][0] = (f32x4){0.f, 0.f, 0.f, 0.f}; acc[ai][bj][m][1] = (f32x4){0.f, 0.f, 0.f, 0.f};
                    } } }
    }
};
struct EpiOut {
    static constexpr bool CHAIN = false; static constexpr bool PRE = false;
    bf16_t* yo;
    __device__ __forceinline__ void operator()(f32x4 (&acc)[2][2][4][2], const Unit& un, int wr, int wc, int fr, int fq) const {
        const int row0 = un.pm * 256 + wr * 64 + fr;
#pragma unroll
        for (int ai = 0; ai < 2; ++ai)
#pragma unroll
            for (int m = 0; m < 4; ++m) { const int row = row0 + ai * 128 + m * 16;
#pragma unroll
                for (int bj = 0; bj < 2; ++bj) st_bf8(yo + (size_t)row * 1024 + un.pn * 256 + bj * 128 + wc * 32 + 8 * fq, acc[ai][bj][m][0], acc[ai][bj][m][1]); }
    }
};
struct EpiMoeUp {
    static constexpr bool CHAIN = false; static constexpr bool PRE = true;
    bf16_t* hbuf; const float* bgu;
    __device__ __forceinline__ const float* pre_base(const Unit& un, int w) const { const int e = un.pn >> 3, pnl = un.pn & 7; return bgu + (size_t)e * 2048 + pnl * 128 + (w < 2 ? w * 64 : 1024 + (w - 2) * 64); }
    __device__ __forceinline__ void operator()(f32x4 (&acc)[2][2][4][2], const Unit& un, int wr, int wc, int fr, int fq, const LAS float* pre) const {
        const int pnl = un.pn & 7; const int row0 = un.pm * 256 + wr * 64 + fr;
        const int jh = pnl * 128 + wc * 32 + 8 * fq; const LAS float* pb = pre + wc * 32 + 8 * fq;
        const f32x4 bg0 = *(const LAS f32x4*)(pb), bg1 = *(const LAS f32x4*)(pb + 4), bl0 = *(const LAS f32x4*)(pb + 128), bl1 = *(const LAS f32x4*)(pb + 132);
#pragma unroll
        for (int ai = 0; ai < 2; ++ai)
#pragma unroll
            for (int m = 0; m < 4; ++m) { const int row = row0 + ai * 128 + m * 16;
                const f32x4 g0 = acc[ai][0][m][0] + bg0, g1 = acc[ai][0][m][1] + bg1, l0 = acc[ai][1][m][0] + bl0, l1 = acc[ai][1][m][1] + bl1; f32x4 o0, o1;
#pragma unroll
                for (int j = 0; j < 4; ++j) { const float ga = fminf(g0[j], 7.f), la = fminf(fmaxf(l0[j], -7.f), 7.f); o0[j] = (la + 1.f) * (ga * sigmoid_f(1.702f * ga));
                    const float gb = fminf(g1[j], 7.f), lb = fminf(fmaxf(l1[j], -7.f), 7.f); o1[j] = (lb + 1.f) * (gb * sigmoid_f(1.702f * gb)); }
                st_bf8(hbuf + (size_t)row * 1024 + jh, o0, o1);
                __builtin_amdgcn_sched_barrier(0); }
    }
};
struct EpiMoeDn {
    static constexpr bool CHAIN = false; static constexpr bool PRE = true;
    bf16_t* y; const float* bdn; bool skip;
    __device__ __forceinline__ const float* pre_base(const Unit& un, int w) const { const int e = un.pn >> 2, pnl = un.pn & 3; return bdn + (size_t)e * 1024 + pnl * 256 + w * 64; }
    __device__ __forceinline__ void operator()(f32x4 (&acc)[2][2][4][2], const Unit& un, int wr, int wc, int fr, int fq, const LAS float* pre) const {
        const int pnl = un.pn & 3; const int row0 = (skip ? 0 : un.pm * 256) + wr * 64 + fr;
#pragma unroll
        for (int bj = 0; bj < 2; ++bj) { const int col = pnl * 256 + bj * 128 + wc * 32 + 8 * fq; const LAS float* pb = pre + bj * 128 + wc * 32 + 8 * fq; const f32x4 b0 = *(const LAS f32x4*)(pb), b1 = *(const LAS f32x4*)(pb + 4);
#pragma unroll
            for (int ai = 0; ai < 2; ++ai)
#pragma unroll
                for (int m = 0; m < 4; ++m) st_bf8(y + (size_t)(row0 + ai * 128 + m * 16) * 1024 + col, acc[ai][bj][m][0] + b0, acc[ai][bj][m][1] + b1); }
    }
};

__device__ __forceinline__ float wave_sum(float v) {
    v += xswz<1>(v); v += xswz<2>(v); v += xswz<4>(v); v += xswz<8>(v); v += xswz<16>(v); return xsum32(v);
}
__device__ __forceinline__ int colmap_in(int np) {
    if (np < 2048) return np;
    if (np < 2304) { const int t = np - 2048; if (t < 64) return 2048 + t; if (t < 72) return 2112 + (t - 64); if (t < 96) return -1; if (t < 128) return 3528 + (t - 96); return 3400 + (t - 128); }
    if (np < 3328) return 2120 + (np - 2304);
    if (np < 3584) return 3144 + (np - 3328);
    return 3560 + (np - 3584);
}
__device__ __forceinline__ int colmap_gu(int np) { const int tile = np >> 8, w = np & 255; return (w < 128) ? (tile * 128 + w) : (1024 + tile * 128 + (w - 128)); }
template <int KIND>
__device__ __forceinline__ void tconv_item(const float* src, int ldsrc, bf16_t* dst, int Kdst, int koff, const float* kscale, int item, int nblk, LAS float* scr, int lane) {
    const int kb = item / nblk, nb = item - kb * nblk, k0 = 64 * kb, n0 = 32 * nb;
    const int c4 = lane & 7, kr = lane >> 3;
    const int np = n0 + 4 * c4;
    const int col = KIND == 1 ? colmap_in(np) : (KIND == 2 ? colmap_gu(np) : np);
    f32x4 vv[8];
#pragma unroll
    for (int i = 0; i < 8; ++i) { const int ks = k0 + 8 * i + kr - koff; f32x4 v = {0.f, 0.f, 0.f, 0.f};
        if (col >= 0 && ks >= 0) { v = *(const f32x4*)(src + (size_t)ks * ldsrc + col); if (kscale) v *= kscale[ks]; }
        vv[i] = v; }
#pragma unroll
    for (int i = 0; i < 8; ++i) { LAS float* d = scr + (8 * i + kr) * 33 + 4 * c4; d[0] = vv[i][0]; d[1] = vv[i][1]; d[2] = vv[i][2]; d[3] = vv[i][3]; }
    LDS_WAIT(); asm volatile("" ::: "memory");
    const int c = lane & 7;
#pragma unroll
    for (int j = 0; j < 4; ++j) { const int n = (lane >> 3) + 8 * j; const LAS float* s = scr + (8 * c) * 33 + n;
        u32x4 o; o.x = pk2(s[0 * 33], s[1 * 33]); o.y = pk2(s[2 * 33], s[3 * 33]); o.z = pk2(s[4 * 33], s[5 * 33]); o.w = pk2(s[6 * 33], s[7 * 33]);
        *(u32x4*)(dst + (size_t)(n0 + n) * Kdst + k0 + 8 * c) = o; }
    LDS_WAIT(); asm volatile("" ::: "memory");
}
constexpr int I_IN = 16 * (NIN / 32), I_UQ = 4 * 24, I_UKV = 4 * 32, I_BR = 8 * 32, I_OUT = 16 * 32, I_GU = 16 * 64, I_DN = 16 * 32;
constexpr int I_LAYER = I_IN + I_UQ + I_UKV + 3 * I_BR + I_OUT + NEXP * I_GU + NEXP * I_DN;
__device__ __forceinline__ void tconv_any(const Ctx& C, const Args& A, int it, LAS float* scr) {
        const int l = it / I_LAYER; int r = it - l * I_LAYER;
        if (r < I_IN) { tconv_item<1>(A.in[2] + (size_t)l * DM * NIN_SRC, NIN_SRC, WSP(bf16_t, WS_WIN + l * SZ_WIN), 1024, 0, nullptr, r, NIN / 32, scr, C.lane); return; } r -= I_IN;
        if (r < I_UQ) { tconv_item<0>(A.in[9] + (size_t)l * 256 * 768, 768, WSP(bf16_t, WS_WUQ + l * SZ_WUQ), 256, 0, A.in[7] + l * 256, r, 24, scr, C.lane); return; } r -= I_UQ;
        if (r < I_UKV) { tconv_item<0>(A.in[10] + (size_t)l * 128 * 1024, 1024, WSP(bf16_t, WS_WUKV + l * SZ_WUKV), 256, 128, A.in[8] + l * 128, r, 32, scr, C.lane); return; } r -= I_UKV;
        if (r < 3 * I_BR) { const int n = r / I_BR; r -= n * I_BR;
            tconv_item<0>(A.in[11] + ((size_t)l * 3 + n) * 512 * 1024, 1024, WSP(bf16_t, WS_WBR + l * SZ_WBR) + (size_t)n * 1024 * 512, 512, 0, nullptr, r, 32, scr, C.lane); return; } r -= 3 * I_BR;
        if (r < I_OUT) { tconv_item<0>(A.in[12] + (size_t)l * 1024 * 1024, 1024, WSP(bf16_t, WS_WOUT + l * SZ_WOUT), 1024, 0, nullptr, r, 32, scr, C.lane); return; } r -= I_OUT;
        if (r < NEXP * I_GU) { const int e = r / I_GU; r -= e * I_GU;
            tconv_item<2>(A.in[17] + ((size_t)l * NEXP + e) * 1024 * 2048, 2048, WSP(bf16_t, WS_WGU + l * SZ_WGU) + (size_t)e * 2048 * 1024, 1024, 0, nullptr, r, 64, scr, C.lane); return; } r -= NEXP * I_GU;
        { const int e = r / I_DN; r -= e * I_DN;
            tconv_item<0>(A.in[19] + ((size_t)l * NEXP + e) * 1024 * 1024, 1024, WSP(bf16_t, WS_WDN + l * SZ_WDN) + (size_t)e * 1024 * 1024, 1024, 0, nullptr, r, 32, scr, C.lane); }
}
constexpr int CONV_SLOTS = 4;
__device__ __forceinline__ void conv_slot(const Ctx& C, const Args& A, int lnext, int slot) {
    LAS float* scr = (LAS float*)(C.lds + 65536 + C.wave * 8448);
    const int gw = C.bid * NWAVES + C.wave, NGW = C.G * NWAVES;
    const int per = ((I_LAYER + NGW - 1) / NGW + CONV_SLOTS - 1) / CONV_SLOTS;
    for (int k = slot * per; k < (slot + 1) * per; ++k) { const int it = gw + k * NGW; if (it < I_LAYER) tconv_any(C, A, lnext * I_LAYER + it, scr); }
}
__device__ __forceinline__ void phase_prologue(const Ctx& C, const Args& A) {
    LAS float* scr = (LAS float*)(C.lds + C.wave * 16384);
    const int gw = C.bid * NWAVES + C.wave, NGW = C.G * NWAVES;
    for (int it = gw; it < I_LAYER; it += NGW) tconv_any(C, A, it, scr);
    const int gt = C.bid * 512 + C.tid, NGT = C.G * 512;
    { float* rwt = WSP(float, WS_RWT);
      for (int i = gt; i < NLAYER * 32 * 1024; i += NGT) { const int l = i >> 15, e = (i >> 10) & 31, k = i & 1023; rwt[i] = A.in[15][(size_t)l * 32768 + k * 32 + e] * A.in[13][l * 1024 + k]; }
      const int gwv = C.bid * NWAVES + C.wave;
      if (gwv < NLAYER * 32) { const int l = gwv >> 5, e = gwv & 31; const float* rw = A.in[15] + (size_t)l * 32768; const float* g1 = A.in[13] + l * 1024; const float* b1 = A.in[14] + l * 1024;
          float sg = 0.f, sb = 0.f;
#pragma unroll
          for (int j = 0; j < 16; ++j) { const int k = C.lane + 64 * j; sg += rw[k * 32 + e] * g1[k]; sb += b1[k] * rw[k * 32 + e]; }
          sg = wave_sum(sg); sb = wave_sum(sb);
          if (C.lane == 0) { float* gb = WSP(float, WS_GBW) + l * 64; gb[e] = sg; gb[32 + e] = sb + A.in[16][l * 32 + e]; } } }
    { bf16_t* d = WSP(bf16_t, WS_WGM); const float* s = A.in[5];
      for (int i = gt; i < NLAYER * 8 * 128 * 128; i += NGT) { const int jj = i & 127, ii = (i >> 7) & 127; d[i] = (jj <= ii) ? (bf16_t)(pk2(s[i], 0.f) & 0xffff) : (bf16_t)0; } }
    { const int* pos = (const int*)A.in[1]; float *ca = WSP(float, WS_COSA), *sa = WSP(float, WS_SINA), *cc = WSP(float, WS_COSC), *sc = WSP(float, WS_SINC);
      for (int i = gt; i < NTOK * 8; i += NGT) { const int t = i >> 3, f = i & 7; const float inv = powf(500000.f, -(float)f / 8.f); const float ang = (float)pos[t] * inv; ca[i] = cosf(ang); sa[i] = sinf(ang); }
      for (int i = gt; i < NTOK * 16; i += NGT) { const int t = i >> 4, f = i & 15; const float inv = powf(500000.f, -(float)f / 16.f); const float ang = (float)pos[t] * inv; cc[i] = cosf(ang); sc[i] = sinf(ang); } }
    { const f32x4* x4 = (const f32x4*)A.in[0]; u32x2* xb = WSP(u32x2, WS_XB);
      for (int i = gt; i < NTOK * DM / 4; i += NGT) { const f32x4 v = x4[i]; u32x2 w; w.x = pk2(v[0], v[1]); w.y = pk2(v[2], v[3]); xb[i] = w; } }
}

__device__ __forceinline__ void idx_block(const Ctx& C, int b, int qb) {
    const int tid = C.tid, lane = C.lane, wid = C.wave, r32 = lane & 31, hi = lane >> 5;
    const bf16_t* iq = WSP(bf16_t, WS_IQ); const bf16_t* ik = WSP(bf16_t, WS_IK); const float* iw = WSP(float, WS_IW); float* score = WSP(float, WS_SCORE);
    const int qi_l = ((r32 >> 4) << 1) + ((r32 >> 2) & 1), h_l = (r32 & 3) + 4 * ((r32 >> 3) & 1);
    bf16x8 af[2][4]; float wv[2][2][8];
#pragma unroll
    for (int rb = 0; rb < 2; ++rb) { const size_t tok = (size_t)b * SEQ + qb * 64 + wid * 8 + rb * 4 + qi_l;
#pragma unroll
        for (int ks = 0; ks < 4; ++ks) af[rb][ks] = *(const bf16x8*)(iq + tok * 512 + h_l * 64 + ks * 16 + hi * 8);
#pragma unroll
        for (int g = 0; g < 2; ++g) { const size_t tq = (size_t)b * SEQ + qb * 64 + wid * 8 + rb * 4 + 2 * g + hi;
            const f32x4 w0 = *(const f32x4*)(iw + tq * 8), w1 = *(const f32x4*)(iw + tq * 8 + 4);
            wv[rb][g][0] = w0[0]; wv[rb][g][1] = w0[1]; wv[rb][g][2] = w0[2]; wv[rb][g][3] = w0[3]; wv[rb][g][4] = w1[0]; wv[rb][g][5] = w1[1]; wv[rb][g][6] = w1[2]; wv[rb][g][7] = w1[3]; } }
    const int lkey = tid & 63, lch = tid >> 6;
    const bf16_t* ksrc = ik + ((size_t)b * SEQ + lkey) * 64 + lch * 8;
    LAS unsigned char* kdst = C.lds + (lch * 64 + lkey) * 16;
    const int NT = qb + 1;
    u32x4 rk = *(const u32x4*)ksrc;
    *(LAS u32x4*)kdst = rk;
    __syncthreads();
    for (int kt = 0; kt < NT; ++kt) {
        const int cur = kt & 1;
        if (kt + 1 < NT) rk = *(const u32x4*)(ksrc + (size_t)(kt + 1) * 64 * 64);
        const LAS unsigned char* kb = C.lds + cur * 8192;
        bf16x8 bfr[2][4];
#pragma unroll
        for (int kbk = 0; kbk < 2; ++kbk)
#pragma unroll
            for (int ks = 0; ks < 4; ++ks) bfr[kbk][ks] = *(const LAS bf16x8*)(kb + ((2 * ks + hi) * 64 + kbk * 32 + r32) * 16);
#pragma unroll
        for (int rb = 0; rb < 2; ++rb)
#pragma unroll
            for (int kbk = 0; kbk < 2; ++kbk) {
                f32x16 a = {};
#pragma unroll
                for (int ks = 0; ks < 4; ++ks) a = __builtin_amdgcn_mfma_f32_32x32x16_bf16(af[rb][ks], bfr[kbk][ks], a, 0, 0, 0);
#pragma unroll
                for (int g = 0; g < 2; ++g) { float s = 0.f;
#pragma unroll
                    for (int hh = 0; hh < 8; ++hh) s = fmaf(fmaxf(a[8 * g + hh], 0.f), wv[rb][g][hh], s);
                    const size_t tq = (size_t)b * SEQ + qb * 64 + wid * 8 + rb * 4 + 2 * g + hi;
                    score[tq * SEQ + kt * 64 + kbk * 32 + r32] = s; } }
        if (kt + 1 < NT) *(LAS u32x4*)(kdst + (cur ^ 1) * 8192) = rk;
        __syncthreads();
    }
}
__device__ __forceinline__ void phase_indexer(const Ctx& C) {
    for (int u0 = C.bid; u0 < NB * 32; u0 += C.G) {
        int u = u0; if (C.G == NB * 32) u = (C.bid & 7) * 32 + (C.bid >> 3);
        const int b = u >> 5, p = u & 31; idx_block(C, b, p); idx_block(C, b, 63 - p); }
}

__device__ __forceinline__ unsigned f2key(float f) { const unsigned u = __float_as_uint(f); return (u & 0x80000000u) ? ~u : (u | 0x80000000u); }
__device__ __forceinline__ int wave_total7(unsigned cv) {
    int t = 0;
#pragma unroll
    for (int b = 0; b < 7; ++b) t += __popcll(__ballot((cv >> b) & 1u)) << b;
    return t;
}
template <int NG>
__device__ __forceinline__ unsigned select_radix(const unsigned (&u)[64]) {
    unsigned prefix = 0u;
    for (int bit = 31; bit >= 0; --bit) {
        const unsigned cand = prefix | (1u << bit); unsigned cv = 0u;
#pragma unroll
        for (int i = 0; i < NG * 8; ++i) cv += (u[i] >= cand) ? 1u : 0u;
        const int cnt = wave_total7(cv);
        if (cnt >= 256) prefix = cand;
        if (cnt == 256) break;
    }
    return prefix;
}
__device__ __forceinline__ int wave_sum_dpp(int x) {
    x += __builtin_amdgcn_update_dpp(0, x, 0xB1, 0xf, 0xf, true);
    x += __builtin_amdgcn_update_dpp(0, x, 0x4E, 0xf, 0xf, true);
    x += __builtin_amdgcn_update_dpp(0, x, 0x141, 0xf, 0xf, true);
    x += __builtin_amdgcn_update_dpp(0, x, 0x140, 0xf, 0xf, true);
    x += __builtin_amdgcn_update_dpp(0, x, 0x142, 0xa, 0xf, false);
    x += __builtin_amdgcn_update_dpp(0, x, 0x143, 0xc, 0xf, false);
    return __builtin_amdgcn_readlane(x, 63);
}
__device__ __forceinline__ unsigned bfi32(unsigned m, unsigned x, unsigned y) { return (m & x) | (~m & y); }
__device__ __forceinline__ void bit_transpose32(unsigned* a) {
#pragma unroll
    for (int k = 0; k < 16; ++k) { const unsigned x = a[k], y = a[k + 16]; a[k] = __builtin_amdgcn_perm(y, x, 0x05040100u); a[k + 16] = __builtin_amdgcn_perm(y, x, 0x07060302u); }
#pragma unroll
    for (int k = 0; k < 32; ++k) if ((k & 8) == 0) { const unsigned x = a[k], y = a[k + 8]; a[k] = __builtin_amdgcn_perm(y, x, 0x06020400u); a[k + 8] = __builtin_amdgcn_perm(y, x, 0x07030501u); }
#pragma unroll
    for (int k = 0; k < 32; ++k) if ((k & 4) == 0) { const unsigned x = a[k], y = a[k + 4]; a[k] = bfi32(0x0f0f0f0fu, x, y << 4); a[k + 4] = bfi32(0x0f0f0f0fu, x >> 4, y); }
#pragma unroll
    for (int k = 0; k < 32; ++k) if ((k & 2) == 0) { const unsigned x = a[k], y = a[k + 2]; a[k] = bfi32(0x33333333u, x, y << 2); a[k + 2] = bfi32(0x33333333u, x >> 2, y); }
#pragma unroll
    for (int k = 0; k < 32; ++k) if ((k & 1) == 0) { const unsigned x = a[k], y = a[k + 1]; a[k] = bfi32(0x55555555u, x, y << 1); a[k + 1] = bfi32(0x55555555u, x >> 1, y); }
}
template <int NW>
__device__ __forceinline__ void select_bits(const float* row, int n, unsigned* mrow, int lane) {
    constexpr int W = 32 * NW;
    unsigned a[W];
    {   const u32x4* src = (const u32x4*)(row + lane * W);
#pragma unroll
        for (int i = 0; i < W / 4; ++i) { const u32x4 v = src[i];
#pragma unroll
            for (int j = 0; j < 4; ++j) { const unsigned u = v[j]; a[4 * i + j] = u ^ ((unsigned)((int)u >> 31) | 0x80000000u); } }
    }
#pragma unroll
    for (int blk = 0; blk < NW; ++blk) bit_transpose32(a + 32 * blk);
    unsigned alive[NW], above[NW];
#pragma unroll
    for (int w = 0; w < NW; ++w) { const int nv = n - lane * W - 32 * w; alive[w] = nv >= 32 ? 0xffffffffu : (nv <= 0 ? 0u : ((1u << nv) - 1u)); above[w] = 0u; }
    int cnta = 0; bool exact = false;
#pragma unroll
    for (int b = 31; b >= 0; --b) {
        unsigned o[NW]; int pc = 0;
#pragma unroll
        for (int w = 0; w < NW; ++w) { o[w] = alive[w] & a[32 * w + b]; pc += __popc(o[w]); }
        const int tot = cnta + wave_sum_dpp(pc);
        if (tot >= 256) {
#pragma unroll
            for (int w = 0; w < NW; ++w) alive[w] = o[w];
            if (tot == 256) { exact = true; break; }
        } else {
#pragma unroll
            for (int w = 0; w < NW; ++w) { above[w] |= o[w]; alive[w] ^= o[w]; }
            cnta = tot;
        }
    }
    if (!exact) {
        int pc = 0;
#pragma unroll
        for (int w = 0; w < NW; ++w) pc += __popc(alive[w]);
        const int ceq = wave_sum_dpp(pc), need = 256 - cnta;
        if (ceq > need) {
            int excl = 0;
#pragma unroll 1
            for (int L = 0; L < 63; ++L) { const int v = __builtin_amdgcn_readlane(pc, L); excl += (lane > L) ? v : 0; }
            int take = need - excl; take = take < 0 ? 0 : (take > pc ? pc : take);
            int c = pc;
            if (NW == 2) { while (c > take && alive[NW - 1] != 0u) { alive[NW - 1] &= ~(0x80000000u >> __clz(alive[NW - 1])); --c; } }
            while (c > take) { alive[0] &= ~(0x80000000u >> __clz(alive[0])); --c; }
        }
    }
    if (NW == 2) { u32x2 m; m.x = above[0] | alive[0]; m.y = above[NW - 1] | alive[NW - 1]; *(u32x2*)(mrow + 2 * lane) = m; }
    else { mrow[lane] = above[0] | alive[0]; mrow[64 + lane] = 0u; }
}
__device__ __forceinline__ void phase_select(const Ctx& C) {
    const float* score = WSP(float, WS_SCORE); unsigned long long* mask = WSP(unsigned long long, WS_MASK);
    const int gw = C.bid * NWAVES + C.wave, NGW = C.G * NWAVES, lane = C.lane;
    for (int idx = gw; idx < NTOK; idx += NGW) {
        const int q = idx & (SEQ - 1); const int n = q + 1; const float* row = score + (size_t)idx * SEQ;
        if (n <= 256) {
            const int lo = n - 64 * lane;
            const unsigned long long m = lo >= 64 ? ~0ull : (lo <= 0 ? 0ull : ((1ull << lo) - 1ull));
            mask[(size_t)idx * 64 + lane] = m;
        } else if (n <= 2048) select_bits<1>(row, n, (unsigned*)(mask + (size_t)idx * 64), lane);
        else select_bits<2>(row, n, (unsigned*)(mask + (size_t)idx * 64), lane);
    }
}

__device__ __forceinline__ int crow(int r, int hi) { return (r & 3) + 8 * (r >> 2) + 4 * hi; }
template <int DQK, bool MASKED>
__device__ __forceinline__ void attn_unit(const Ctx& C, int b, int h, int qb, const bf16_t* Q, const bf16_t* K, const bf16_t* VT, const unsigned* mask, bf16_t* O,
                                          u32x4& rk0, u32x4& rk1, u32x4& rv, bool pre_in, int nb, int nh, bool has_next) {
    constexpr int NKS = DQK / 16, NCH = DQK / 8, KTB = NCH * 1024, BUF = KTB + 8192, QS = 8 * DQK;
    const int tid = C.tid, lane = C.lane, wid = C.wave, r32 = lane & 31, hi = lane >> 5;
    const int NT = 4 * (qb + 1);
    const size_t tok = (size_t)b * SEQ + qb * 256 + wid * 32 + r32;
    bf16x8 qf[NKS];
#pragma unroll
    for (int ks = 0; ks < NKS; ++ks) qf[ks] = *(const bf16x8*)(Q + tok * QS + h * DQK + ks * 16 + hi * 8);
    const int lrow = tid & 63, lch = tid >> 6;
    const bf16_t* ksrc0 = K + ((size_t)b * SEQ + lrow) * QS + h * DQK + lch * 8;
    const bf16_t* ksrc1 = ksrc0 + 64;
    const bf16_t* vsrc = VT + ((size_t)(b * 8 + h) * 64 + lrow) * SEQ + lch * 8;
    LAS unsigned char* kd0 = C.lds + (lch * 64 + lrow) * 16;
    LAS unsigned char* kd1 = C.lds + ((8 + lch) * 64 + lrow) * 16;
    LAS unsigned char* vd = C.lds + KTB + (lch * 64 + lrow) * 16;
    const bool k1 = (DQK > 64) && (tid < 256);
    if (!pre_in) { rk0 = *(const u32x4*)ksrc0; if (k1) rk1 = *(const u32x4*)ksrc1; rv = *(const u32x4*)vsrc; }
    *(LAS u32x4*)kd0 = rk0; if (k1) *(LAS u32x4*)kd1 = rk1; *(LAS u32x4*)vd = rv;
    u32x2 mw = {0u, 0u};
    if (MASKED) mw = *(const u32x2*)(mask + tok * 128);
    float mbias = 0.f, thr = -1e30f, lsum = 0.f;
    u32x4 qmw = {0u, 0u, 0u, 0u};
    const bf16x8 kone = __builtin_bit_cast(bf16x8, (u32x4){hi == 0 ? 0x3F80u : 0u, 0u, 0u, 0u});
    f32x16 o0 = {}, o1 = {};
    __syncthreads();
    for (int kt = 0; kt < NT; ++kt) {
        const int cur = kt & 1;
        u32x2 mwn = {0u, 0u};
        if (kt + 1 < NT) {
            rk0 = *(const u32x4*)(ksrc0 + (size_t)(kt + 1) * 64 * QS); if (k1) rk1 = *(const u32x4*)(ksrc1 + (size_t)(kt + 1) * 64 * QS);
            rv = *(const u32x4*)(vsrc + (kt + 1) * 64);
            if (MASKED) mwn = *(const u32x2*)(mask + tok * 128 + 2 * (kt + 1));
        } else if (has_next) {
            const bf16_t* nk = K + ((size_t)nb * SEQ + lrow) * QS + nh * DQK + lch * 8;
            rk0 = *(const u32x4*)nk; if (k1) rk1 = *(const u32x4*)(nk + 64); rv = *(const u32x4*)(VT + ((size_t)(nb * 8 + nh) * 64 + lrow) * SEQ + lch * 8);
        }
        const LAS unsigned char* kb = C.lds + cur * BUF; const LAS unsigned char* vb = kb + KTB;
        f32x16 p0 = {}, p1 = {};
        bf16x8 kf[2 * NKS], vf[8];
#pragma unroll
        for (int ks = 0; ks < NKS; ++ks) {
            kf[2 * ks] = *(const LAS bf16x8*)(kb + ((2 * ks + hi) * 64 + r32) * 16);
            kf[2 * ks + 1] = *(const LAS bf16x8*)(kb + ((2 * ks + hi) * 64 + 32 + r32) * 16);
        }
#pragma unroll
        for (int s4 = 0; s4 < 4; ++s4) {
            vf[2 * s4] = *(const LAS bf16x8*)(vb + ((2 * s4 + hi) * 64 + r32) * 16);
            vf[2 * s4 + 1] = *(const LAS bf16x8*)(vb + ((2 * s4 + hi) * 64 + 32 + r32) * 16);
        }
        __builtin_amdgcn_sched_barrier(0);
#pragma unroll
        for (int ks = 0; ks < NKS; ++ks) {
            p0 = __builtin_amdgcn_mfma_f32_32x32x16_bf16(kf[2 * ks], qf[ks], p0, 0, 0, 0);
            p1 = __builtin_amdgcn_mfma_f32_32x32x16_bf16(kf[2 * ks + 1], qf[ks], p1, 0, 0, 0);
        }
        { const bf16x8 qm = __builtin_bit_cast(bf16x8, qmw);
          p0 = __builtin_amdgcn_mfma_f32_32x32x16_bf16(kone, qm, p0, 0, 0, 0); p1 = __builtin_amdgcn_mfma_f32_32x32x16_bf16(kone, qm, p1, 0, 0, 0); }
        if (MASKED) {
            const unsigned w0 = mw.x >> (4 * hi), w1 = mw.y >> (4 * hi);
#pragma unroll
            for (int r = 0; r < 16; ++r) { const int bit = (r & 3) + 8 * (r >> 2);
                const unsigned t0 = (unsigned)__builtin_amdgcn_sbfe((int)w0, bit, 1), t1 = (unsigned)__builtin_amdgcn_sbfe((int)w1, bit, 1);
                p0[r] = __uint_as_float((__float_as_uint(p0[r]) & t0) | (~t0 & 0xFF800000u));
                p1[r] = __uint_as_float((__float_as_uint(p1[r]) & t1) | (~t1 & 0xFF800000u)); }
        } else {
            if (kt >= NT - 4) { const int kb0 = (kt - (NT - 4)) * 64, qrel = wid * 32 + r32;
#pragma unroll
                for (int r = 0; r < 16; ++r) { const int kv = kb0 + crow(r, hi); if (kv > qrel) p0[r] = -INFINITY; if (kv + 32 > qrel) p1[r] = -INFINITY; } }
        }
        float mx;
        { float a0 = fmaxf(fmaxf(p0[0], p0[1]), p0[2]), a1 = fmaxf(fmaxf(p0[3], p0[4]), p0[5]), a2 = fmaxf(fmaxf(p0[6], p0[7]), p0[8]), a3 = fmaxf(fmaxf(p0[9], p0[10]), p0[11]);
          float a4 = fmaxf(fmaxf(p0[12], p0[13]), p0[14]), a5 = fmaxf(fmaxf(p0[15], p1[0]), p1[1]), a6 = fmaxf(fmaxf(p1[2], p1[3]), p1[4]), a7 = fmaxf(fmaxf(p1[5], p1[6]), p1[7]);
          float a8 = fmaxf(fmaxf(p1[8], p1[9]), p1[10]), a9 = fmaxf(fmaxf(p1[11], p1[12]), p1[13]), a10 = fmaxf(p1[14], p1[15]);
          a0 = fmaxf(fmaxf(a0, a1), a2); a3 = fmaxf(fmaxf(a3, a4), a5); a6 = fmaxf(fmaxf(a6, a7), a8); a9 = fmaxf(a9, a10);
          mx = fmaxf(fmaxf(a0, a3), fmaxf(a6, a9)); }
        mx = xmax32(mx);
        if (__any(mx > thr)) {
            const bool upd = mx > thr;
            const float mnew = upd ? __uint_as_float(pk2(mbias + mx, 0.f) << 16) : mbias;
            const float delta = mnew - mbias; const float alpha = (thr < 0.f) ? 1.f : __builtin_amdgcn_exp2f(-delta);
            mbias = mnew; thr = upd ? 4.f : thr;
            qmw.x = hi == 0 ? (pk2(-mnew, 0.f) & 0xffffu) : 0u;
            lsum *= alpha;
#pragma unroll
            for (int r = 0; r < 16; ++r) { o0[r] *= alpha; o1[r] *= alpha; p0[r] -= delta; p1[r] -= delta; }
        }
        {
#pragma unroll
            for (int r = 0; r < 16; ++r) { p0[r] = __builtin_amdgcn_exp2f(p0[r]); p1[r] = __builtin_amdgcn_exp2f(p1[r]); }
            float s0 = (p0[0] + p0[1]) + (p0[2] + p0[3]), s1 = (p0[4] + p0[5]) + (p0[6] + p0[7]), s2 = (p0[8] + p0[9]) + (p0[10] + p0[11]), s3 = (p0[12] + p0[13]) + (p0[14] + p0[15]);
            float s4 = (p1[0] + p1[1]) + (p1[2] + p1[3]), s5 = (p1[4] + p1[5]) + (p1[6] + p1[7]), s6 = (p1[8] + p1[9]) + (p1[10] + p1[11]), s7 = (p1[12] + p1[13]) + (p1[14] + p1[15]);
            lsum += ((s0 + s1) + (s2 + s3)) + ((s4 + s5) + (s6 + s7));
        }
        bf16x8 pf[4];
        { u32x4 t;
          t.x = pk2(p0[0], p0[1]); t.y = pk2(p0[2], p0[3]); t.z = pk2(p0[4], p0[5]); t.w = pk2(p0[6], p0[7]); pf[0] = __builtin_bit_cast(bf16x8, t);
          t.x = pk2(p0[8], p0[9]); t.y = pk2(p0[10], p0[11]); t.z = pk2(p0[12], p0[13]); t.w = pk2(p0[14], p0[15]); pf[1] = __builtin_bit_cast(bf16x8, t);
          t.x = pk2(p1[0], p1[1]); t.y = pk2(p1[2], p1[3]); t.z = pk2(p1[4], p1[5]); t.w = pk2(p1[6], p1[7]); pf[2] = __builtin_bit_cast(bf16x8, t);
          t.x = pk2(p1[8], p1[9]); t.y = pk2(p1[10], p1[11]); t.z = pk2(p1[12], p1[13]); t.w = pk2(p1[14], p1[15]); pf[3] = __builtin_bit_cast(bf16x8, t); }
#pragma unroll
        for (int s = 0; s < 4; ++s) {
            o0 = __builtin_amdgcn_mfma_f32_32x32x16_bf16(vf[2 * s], pf[s], o0, 0, 0, 0);
            o1 = __builtin_amdgcn_mfma_f32_32x32x16_bf16(vf[2 * s + 1], pf[s], o1, 0, 0, 0);
        }
        if (kt + 1 < NT) {
            const int nb = (cur ^ 1) * BUF;
            *(LAS u32x4*)(kd0 + nb) = rk0; if (k1) *(LAS u32x4*)(kd1 + nb) = rk1; *(LAS u32x4*)(vd + nb) = rv;
        }
        mw = mwn;
        __syncthreads();
    }
    lsum = xsum32(lsum);
    const float inv = 1.f / lsum;
    bf16_t* op = O + tok * 512 + h * 64 + 4 * hi;
#pragma unroll
    for (int i = 0; i < 4; ++i) {
        st_bf4(op + 8 * i, (f32x4){o0[4 * i] * inv, o0[4 * i + 1] * inv, o0[4 * i + 2] * inv, o0[4 * i + 3] * inv});
        st_bf4(op + 32 + 8 * i, (f32x4){o1[4 * i] * inv, o1[4 * i + 1] * inv, o1[4 * i + 2] * inv, o1[4 * i + 3] * inv});
    }
}
template <int DQK, bool MASKED>
__device__ __forceinline__ void phase_attn(const Ctx& C, const bf16_t* Q, const bf16_t* K, const bf16_t* VT, const unsigned* mask, bf16_t* O, const Args& A, int lnext, int slot0) {
    int sl = 0, nu = 0; const int cpos = (C.bid >> 3) & 3;
    u32x4 rk0 = {0u, 0u, 0u, 0u}, rk1 = rk0, rv = rk0; bool pre = false;
    for (int u0 = C.bid; u0 < NB * 8 * 8; u0 += C.G) {
        int u = u0; if ((C.G & 7) == 0) { const int r = (C.bid >> 3) + (C.G >> 3) * (u0 / C.G); u = ((C.bid & 7) * 8 + (r >> 3)) * 8 + (r & 7); if (u >= NB * 8 * 8) u = u0; }
        const int bh = u >> 3, p = u & 7, b = bh >> 3, h = bh & 7;
        int nb = b, nh = h; const int u1 = u0 + C.G; const bool more = u1 < NB * 8 * 8;
        if (more) { int un = u1; if ((C.G & 7) == 0) { const int r = (C.bid >> 3) + (C.G >> 3) * (u1 / C.G); un = ((C.bid & 7) * 8 + (r >> 3)) * 8 + (r & 7); if (un >= NB * 8 * 8) un = u1; } nb = un >> 6; nh = (un >> 3) & 7; }
        attn_unit<DQK, MASKED>(C, b, h, 15 - p, Q, K, VT, mask, O, rk0, rk1, rv, pre, b, h, true);
        if (lnext < NLAYER && nu == cpos) { while (sl < CONV_SLOTS / 2) { conv_slot(C, A, lnext, slot0 + sl); ++sl; } } ++nu;
        attn_unit<DQK, MASKED>(C, b, h, p, Q, K, VT, mask, O, rk0, rk1, rv, true, nb, nh, more);
        if (lnext < NLAYER && nu == cpos) { while (sl < CONV_SLOTS / 2) { conv_slot(C, A, lnext, slot0 + sl); ++sl; } } ++nu;
        pre = more; }
    while (lnext < NLAYER && sl < CONV_SLOTS / 2) { conv_slot(C, A, lnext, slot0 + sl); ++sl; }
}

__device__ __forceinline__ void phase_gmlp(const Ctx& C, const float* lng, const float* lnb, const float* bs, int l) {
    const bf16_t* U = WSP(bf16_t, WS_U); const bf16_t* V = WSP(bf16_t, WS_V); bf16_t* OB = WSP(bf16_t, WS_OBUF) + (size_t)NTOK * 512;
    const bf16_t* WG = WSP(bf16_t, WS_WGM + l * SZ_WGM);
    const int tid = C.tid, lane = C.lane, wid = C.wave, r32 = lane & 31, hi = lane >> 5;
    constexpr int VST = 136;
    LAS bf16_t* vT = (LAS bf16_t*)C.lds;
    for (int un = C.bid; un < 512; un += C.G) {
        const int hf = un & 1, ch = un >> 1; const size_t t0 = (size_t)ch * 128;
        { const int pos = tid >> 2, q = tid & 3; const bf16_t* vr = V + (t0 + pos) * 512 + q * 32;
          float s = 0.f;
#pragma unroll
          for (int i = 0; i < 4; ++i)
#pragma unroll
              for (int j = 0; j < 4; ++j) { const u32x4 w = *(const u32x4*)(vr + i * 128 + j * 8); s += ((bflo(w.x) + bfhi(w.x)) + (bflo(w.y) + bfhi(w.y))) + ((bflo(w.z) + bfhi(w.z)) + (bflo(w.w) + bfhi(w.w))); }
          s += xswz<1>(s); s += xswz<2>(s);
          const float mean = s * (1.f / 512.f); float qv = 0.f;
          asm volatile("" ::: "memory");
#pragma unroll
          for (int i = 0; i < 4; ++i)
#pragma unroll
              for (int j = 0; j < 4; ++j) { const u32x4 w = *(const u32x4*)(vr + i * 128 + j * 8); float d;
                  d = bflo(w.x) - mean; qv += d * d; d = bfhi(w.x) - mean; qv += d * d; d = bflo(w.y) - mean; qv += d * d; d = bfhi(w.y) - mean; qv += d * d;
                  d = bflo(w.z) - mean; qv += d * d; d = bfhi(w.z) - mean; qv += d * d; d = bflo(w.w) - mean; qv += d * d; d = bfhi(w.w) - mean; qv += d * d; }
          qv += xswz<1>(qv); qv += xswz<2>(qv);
          const float rstd = rsqrtf(qv * (1.f / 512.f) + LN_EPS);
          asm volatile("" ::: "memory");
          const bf16_t* vh = vr + hf * 256;
#pragma unroll
          for (int ii = 0; ii < 2; ++ii)
#pragma unroll
              for (int j = 0; j < 4; ++j) { const u32x4 w = *(const u32x4*)(vh + ii * 128 + j * 8);
                  const int cl = ii * 128 + q * 32 + j * 8; const int c0 = hf * 256 + cl;
                  const f32x4 g0 = *(const f32x4*)(lng + c0), g1 = *(const f32x4*)(lng + c0 + 4), b0 = *(const f32x4*)(lnb + c0), b1 = *(const f32x4*)(lnb + c0 + 4);
                  LAS bf16_t* dp = vT + cl * VST + pos;
                  dp[0 * VST] = (bf16_t)(pk2((bflo(w.x) - mean) * rstd * g0[0] + b0[0], 0.f) & 0xffff);
                  dp[1 * VST] = (bf16_t)(pk2((bfhi(w.x) - mean) * rstd * g0[1] + b0[1], 0.f) & 0xffff);
                  dp[2 * VST] = (bf16_t)(pk2((bflo(w.y) - mean) * rstd * g0[2] + b0[2], 0.f) & 0xffff);
                  dp[3 * VST] = (bf16_t)(pk2((bfhi(w.y) - mean) * rstd * g0[3] + b0[3], 0.f) & 0xffff);
                  dp[4 * VST] = (bf16_t)(pk2((bflo(w.z) - mean) * rstd * g1[0] + b1[0], 0.f) & 0xffff);
                  dp[5 * VST] = (bf16_t)(pk2((bfhi(w.z) - mean) * rstd * g1[1] + b1[1], 0.f) & 0xffff);
                  dp[6 * VST] = (bf16_t)(pk2((bflo(w.w) - mean) * rstd * g1[2] + b1[2], 0.f) & 0xffff);
                  dp[7 * VST] = (bf16_t)(pk2((bfhi(w.w) - mean) * rstd * g1[3] + b1[3], 0.f) & 0xffff); } }
        __syncthreads();
        { const int gl = wid >> 1, ih = wid & 1, g = 4 * hf + gl;
          f32x16 acc[2][2] = {};
          const int nks = 4 * (ih + 1);
          const bf16_t* wrow = WG + ((size_t)g * 128 + ih * 64 + r32) * 128 + hi * 8;
          for (int ks = 0; ks < nks; ++ks) {
              bf16x8 a[2], bb[2];
#pragma unroll
              for (int mb = 0; mb < 2; ++mb) a[mb] = *(const bf16x8*)(wrow + (size_t)mb * 32 * 128 + ks * 16);
#pragma unroll
              for (int nb = 0; nb < 2; ++nb) bb[nb] = *(const LAS bf16x8*)(vT + (gl * 64 + nb * 32 + r32) * VST + ks * 16 + hi * 8);
#pragma unroll
              for (int mb = 0; mb < 2; ++mb)
#pragma unroll
                  for (int nb = 0; nb < 2; ++nb) acc[mb][nb] = __builtin_amdgcn_mfma_f32_32x32x16_bf16(a[mb], bb[nb], acc[mb][nb], 0, 0, 0);
          }
#pragma unroll
          for (int mb = 0; mb < 2; ++mb)
#pragma unroll
              for (int r = 0; r < 16; ++r) { const int i = ih * 64 + mb * 32 + crow(r, hi); const float bi = bs[g * 128 + i];
#pragma unroll
                  for (int nb = 0; nb < 2; ++nb) { const size_t o = (t0 + i) * 512 + g * 64 + nb * 32 + r32;
                      const float uu = bf2f(U[o]); OB[o] = (bf16_t)(pk2(uu * (acc[mb][nb][r] + bi), 0.f) & 0xffff); } } }
        __syncthreads();
    }
}

__device__ __forceinline__ void phase_ln1_router(const Ctx& C, const float* g1, const float* b1, const float* rw, const float* rbias, int l, bool dry) {
    constexpr int RST = 1028;
    LAS float* rwT = (LAS float*)C.lds;
    LAS float* gws = (LAS float*)(C.lds + 32 * RST * 4);
    LAS float* bws = gws + 32;
    LAS float* stat = bws + 32;
    LAS int* trec = (LAS int*)(C.lds + MISC_OFF + 64);
    LAS int* tpos = trec + 512;
    const int tid = C.tid, lane = C.lane, wid = C.wave;
    const bf16_t* xin = WSP(bf16_t, WS_XB); const bf16_t* yo = WSP(bf16_t, WS_OBUF); bf16_t* xb = dry ? WSP(bf16_t, WS_DRY + (size_t)NTOK * DM * 4) : WSP(bf16_t, WS_XB);
    int* tke = dry ? WSP(int, WS_DRY + (size_t)NTOK * DM * 6) : WSP(int, WS_TKE); int* tkp = dry ? WSP(int, WS_DRY + (size_t)NTOK * DM * 6 + NSLOT * 4) : WSP(int, WS_TKP); float* tkw = dry ? WSP(float, WS_DRY + (size_t)NTOK * DM * 6 + NSLOT * 8) : WSP(float, WS_TKW);
    int* ccnt = dry ? WSP(int, WS_DRY + (size_t)NTOK * DM * 6 + NSLOT * 12) : WSP(int, WS_CCNT);
    {
        const float* rwg = WSP(float, WS_RWT) + (size_t)l * 32 * 1024;
#pragma unroll
        for (int q = 0; q < 16; ++q) { const int piece = wid * 16 + q, e = piece >> 2, part = piece & 3;
            __builtin_amdgcn_global_load_lds((const unsigned*)(rwg + e * 1024 + part * 256 + lane * 4), (LAS unsigned*)(C.lds + (e * RST + part * 256) * 4), 16, 0, 0); }
        if (tid < 64) gws[tid] = WSP(float, WS_GBW)[l * 64 + tid];
        asm volatile("s_waitcnt vmcnt(0)" ::: "memory");
    }
    __syncthreads();
    const int fr = lane & 15, fq = lane >> 4;
    for (int chunk = C.bid; chunk < NTOK / 128; chunk += C.G) {
        __syncthreads();
        const size_t tok0 = (size_t)chunk * 128 + wid * 16;
        f32x4 acc0 = {0.f, 0.f, 0.f, 0.f}, acc1 = {0.f, 0.f, 0.f, 0.f};
        u32x2 zp[64]; float s1 = 0.f, s2 = 0.f;
        { const bf16_t* zr = xin + (tok0 + fr) * 1024 + 4 * fq; const bf16_t* yr = yo + (tok0 + fr) * 1024 + 4 * fq; const LAS float* w0 = rwT + fr * RST + 4 * fq; const LAS float* w1 = rwT + (16 + fr) * RST + 4 * fq;
#pragma unroll
          for (int sI = 0; sI < 64; ++sI) { const u32x2 hw = *(const u32x2*)(zr + 16 * sI); const f32x4 h4 = {bflo(hw.x), bfhi(hw.x), bflo(hw.y), bfhi(hw.y)}; const u32x2 yw = *(const u32x2*)(yr + 16 * sI);
              const f32x4 a4 = h4 * DN_ALPHA + (f32x4){bflo(yw.x), bfhi(yw.x), bflo(yw.y), bfhi(yw.y)};
              s1 += (a4[0] + a4[1]) + (a4[2] + a4[3]); s2 += (a4[0] * a4[0] + a4[1] * a4[1]) + (a4[2] * a4[2] + a4[3] * a4[3]);
              u32x2 zz; zz.x = pk2(a4[0], a4[1]); zz.y = pk2(a4[2], a4[3]); zp[sI] = zz;
              const f32x4 b0 = *(const LAS f32x4*)(w0 + 16 * sI), b1v = *(const LAS f32x4*)(w1 + 16 * sI);
#pragma unroll
              for (int j = 0; j < 4; ++j) { acc0 = __builtin_amdgcn_mfma_f32_16x16x4f32(a4[j], b0[j], acc0, 0, 0, 0); acc1 = __builtin_amdgcn_mfma_f32_16x16x4f32(a4[j], b1v[j], acc1, 0, 0, 0); }
              if ((sI & 3) == 3) __builtin_amdgcn_sched_barrier(0); } }
        s1 += xswz<16>(s1); s1 = xsum32(s1); s2 += xswz<16>(s2); s2 = xsum32(s2);
        const float mean = s1 * (1.f / 1024.f); const float rstd = rsqrtf(fmaxf(s2 * (1.f / 1024.f) - mean * mean, 0.f) + LN_EPS);
        { u32x2* xo = (u32x2*)(xb + (tok0 + fr) * 1024 + 4 * fq); const float* gp = g1 + 4 * fq; const float* bp = b1 + 4 * fq;
#pragma unroll
          for (int sI = 0; sI < 64; ++sI) { const f32x4 g4 = *(const f32x4*)(gp + 16 * sI), b4 = *(const f32x4*)(bp + 16 * sI); const u32x2 zz = zp[sI];
              const f32x4 z4 = {bflo(zz.x), bfhi(zz.x), bflo(zz.y), bfhi(zz.y)}; const f32x4 o = (z4 - mean) * rstd * g4 + b4;
              u32x2 w; w.x = pk2(o[0], o[1]); w.y = pk2(o[2], o[3]); xo[4 * sI] = w;
              if ((sI & 7) == 7) __builtin_amdgcn_sched_barrier(0); } }
        if (fq == 0) { stat[(wid * 16 + fr) * 2] = mean; stat[(wid * 16 + fr) * 2 + 1] = rstd; }
        LDS_WAIT();
        const float gw0 = gws[fr], gw1 = gws[16 + fr], bw0 = bws[fr], bw1 = bws[16 + fr];
#pragma unroll
        for (int r = 0; r < 4; ++r) {
            const int tl = wid * 16 + 4 * fq + r; const float mean = stat[tl * 2], rstd = stat[tl * 2 + 1];
            const float l0 = rstd * (acc0[r] - mean * gw0) + bw0, l1 = rstd * (acc1[r] - mean * gw1) + bw1;
            unsigned long long k0 = ((unsigned long long)f2key(l0) << 32) | (unsigned)(31 - fr), k1 = ((unsigned long long)f2key(l1) << 32) | (unsigned)(31 - (16 + fr));
            int te[4]; float tv[4];
#pragma unroll
            for (int k = 0; k < 4; ++k) {
                unsigned long long mxk = k0 > k1 ? k0 : k1;
#define MX_STEP(o) do { const unsigned long long ot = ((unsigned long long)xswzu<o>((unsigned)(mxk >> 32)) << 32) | xswzu<o>((unsigned)mxk); mxk = ot > mxk ? ot : mxk; } while (0)
                MX_STEP(1); MX_STEP(2); MX_STEP(4); MX_STEP(8);
#undef MX_STEP
                te[k] = 31 - (int)(mxk & 31ull); const unsigned ku = (unsigned)(mxk >> 32); tv[k] = __uint_as_float((ku & 0x80000000u) ? (ku & 0x7fffffffu) : ~ku);
                if (te[k] == fr) k0 = 0ull; if (te[k] == 16 + fr) k1 = 0ull;
            }
            const float e1 = __expf(tv[1] - tv[0]), e2 = __expf(tv[2] - tv[0]), e3 = __expf(tv[3] - tv[0]); const float inv = 1.f / (1.f + e1 + e2 + e3);
            if (fr == 0) {
                const float ww[4] = {inv, e1 * inv, e2 * inv, e3 * inv}; const size_t tok = (size_t)chunk * 128 + tl;
#pragma unroll
                for (int k = 0; k < 4; ++k) { trec[tl * 4 + k] = te[k]; tkw[tok * 4 + k] = ww[k]; }
            }
        }
        __syncthreads();
        if (tid < 32) { int c = 0; for (int r = 0; r < 512; ++r) { if (trec[r] == tid) { tpos[r] = c; ++c; } } ccnt[chunk * 32 + tid] = c; }
        __syncthreads();
        { const size_t o = (size_t)chunk * 512 + tid; tke[o] = trec[tid]; tkp[o] = tpos[tid]; }
        __syncthreads();
    }
}

__device__ __forceinline__ void moe_tables(const Ctx& C, int l) {
    LAS int* cnt = (LAS int*)(C.lds + MISC_OFF + 64); LAS int* tb = cnt + 32; LAS int* tile_e = tb + 40;
    const int* ccnt = WSP(int, WS_CCNT);
    {   LAS int* part = (LAS int*)C.lds;
        int a = 0;
#pragma unroll
        for (int k = 0; k < NTOK / 128 / 16; ++k) a += ccnt[((C.tid >> 5) + 16 * k) * 32 + (C.tid & 31)];
        part[C.tid] = a;
        __syncthreads();
        if (C.tid < 32) { int t = 0;
#pragma unroll
            for (int k = 0; k < 16; ++k) t += part[k * 32 + C.tid];
            cnt[C.tid] = t; }
    }
    __syncthreads();
    if (C.tid == 0) { int a = 0; for (int e = 0; e < 32; ++e) { tb[e] = a; a += (cnt[e] + 255) >> 8; } tb[32] = a; }
    __syncthreads();
    if (C.tid < 32) { for (int t = tb[C.tid]; t < tb[C.tid + 1]; ++t) tile_e[t] = C.tid; }
    __syncthreads();
}
__device__ __forceinline__ void phase_dispatch(const Ctx& C, int l) {
    moe_tables(C, l);
    LAS int* cnt = (LAS int*)(C.lds + MISC_OFF + 64); LAS int* tb = cnt + 32;
    const int* tke = WSP(int, WS_TKE); int* tkp = WSP(int, WS_TKP); int* stk = WSP(int, WS_STK);
    const int* ccnt = WSP(int, WS_CCNT);
    for (int ch = C.bid; ch < NSLOT / 512; ch += C.G) {
        LAS int* part = (LAS int*)C.lds; LAS int* cb = part + 512;
        int a = 0;
        for (int c = (C.tid >> 5); c < ch; c += 16) a += ccnt[c * 32 + (C.tid & 31)];
        part[C.tid] = a;
        __syncthreads();
        if (C.tid < 32) { int t = 0;
#pragma unroll
            for (int k = 0; k < 16; ++k) t += part[k * 32 + C.tid];
            cb[C.tid] = t; }
        __syncthreads();
        const int s = ch * 512 + C.tid;
        const int e = tke[s], p = cb[e] + tkp[s]; const int row = tb[e] * 256 + p;
        stk[row] = s >> 2; tkp[s] = row;
        __syncthreads();
    }
    for (int e = C.bid; e < 32; e += C.G) { const int r0 = tb[e] * 256 + cnt[e], r1 = tb[e + 1] * 256; for (int r = r0 + C.tid; r < r1; r += 512) stk[r] = 0; }
}

__device__ __forceinline__ void phase_ln2(const Ctx& C, const float* g2, const float* b2, float* outp, int l, bool dry) {
    const bf16_t* xin = WSP(bf16_t, WS_XB); bf16_t* xb = dry ? WSP(bf16_t, WS_DRY + (size_t)NTOK * DM * 4) : WSP(bf16_t, WS_XB); const bf16_t* y = WSP(bf16_t, WS_Y);
    const int* tkrow = WSP(int, WS_TKP); const float* tkw = WSP(float, WS_TKW);
    if (dry) outp = WSP(float, WS_DRY);
    const int gw = C.bid * NWAVES + C.wave, NGW = C.G * NWAVES, lane = C.lane;
    f32x4 gg[4], bb[4];
#pragma unroll
    for (int j = 0; j < 4; ++j) { gg[j] = *(const f32x4*)(g2 + 4 * (lane + 64 * j)); bb[j] = *(const f32x4*)(b2 + 4 * (lane + 64 * j)); }
    const bool last = (l == NLAYER - 1);
    for (int tok = gw; tok < NTOK; tok += NGW) {
        const u32x2* xr = (const u32x2*)(xin + (size_t)tok * 1024);
        f32x4 v[4]; float s = 0.f;
        int rk[4]; float wk[4];
#pragma unroll
        for (int k = 0; k < 4; ++k) { rk[k] = tkrow[(size_t)tok * 4 + k]; wk[k] = tkw[(size_t)tok * 4 + k]; }
#pragma unroll
        for (int j = 0; j < 4; ++j) { const u32x2 hw = xr[lane + 64 * j]; const f32x4 x1 = {bflo(hw.x), bfhi(hw.x), bflo(hw.y), bfhi(hw.y)}; f32x4 f[4];
#pragma unroll
            for (int k = 0; k < 4; ++k) { const u32x2 w = *(const u32x2*)(y + (size_t)rk[k] * 1024 + 4 * (lane + 64 * j)); f[k] = (f32x4){bflo(w.x), bfhi(w.x), bflo(w.y), bfhi(w.y)} * wk[k]; }
            v[j] = x1 * DN_ALPHA + ((f[0] + f[1]) + (f[2] + f[3]));
            s += (v[j][0] + v[j][1]) + (v[j][2] + v[j][3]); }
        const float mean = wave_sum(s) * (1.f / 1024.f); float s2 = 0.f;
#pragma unroll
        for (int j = 0; j < 4; ++j) { v[j] = v[j] - mean; s2 += (v[j][0] * v[j][0] + v[j][1] * v[j][1]) + (v[j][2] * v[j][2] + v[j][3] * v[j][3]); }
        const float rstd = rsqrtf(wave_sum(s2) * (1.f / 1024.f) + LN_EPS);
        if (last) { f32x4* orow = (f32x4*)(outp + (size_t)tok * 1024);
#pragma unroll
            for (int j = 0; j < 4; ++j) orow[lane + 64 * j] = v[j] * rstd * gg[j] + bb[j];
        } else { u32x2* xbr = (u32x2*)(xb + (size_t)tok * 1024);
#pragma unroll
            for (int j = 0; j < 4; ++j) { const f32x4 o = v[j] * rstd * gg[j] + bb[j]; u32x2 w; w.x = pk2(o[0], o[1]); w.y = pk2(o[2], o[3]); xbr[lane + 64 * j] = w; } }
    }
}

#ifdef DBG_STOP
__device__ __forceinline__ void dbg_dump(const Ctx& C, float* out) {
    const int gt = C.bid * 512 + C.tid, NGT = C.G * 512;
    const bf16_t* qa = WSP(bf16_t, WS_QA); const bf16_t* ka = WSP(bf16_t, WS_KA); const bf16_t* vat = WSP(bf16_t, WS_VAT); const bf16_t* iq = WSP(bf16_t, WS_IQ);
    const bf16_t* u = WSP(bf16_t, WS_U); const bf16_t* v = WSP(bf16_t, WS_V); const bf16_t* cdq = WSP(bf16_t, WS_CDQ); const bf16_t* cdkv = WSP(bf16_t, WS_CDKV);
    const bf16_t* gate = WSP(bf16_t, WS_GATE); const bf16_t* qc = WSP(bf16_t, WS_QC); const bf16_t* kc = WSP(bf16_t, WS_KC); const bf16_t* vct = WSP(bf16_t, WS_VCT);
    const unsigned* mask = WSP(unsigned, WS_MASK); const bf16_t* ob = WSP(bf16_t, WS_OBUF); const bf16_t* mg = WSP(bf16_t, WS_MERGED); const float* xr = WSP(float, WS_XRES);
    const bf16_t* y = WSP(bf16_t, WS_Y); const float* sc = WSP(float, WS_SCORE); const bf16_t* ik = WSP(bf16_t, WS_IK); const float* iw = WSP(float, WS_IW); const float* ssq = WSP(float, WS_SSQ);
    const bf16_t* hb = WSP(bf16_t, WS_H); const bf16_t* xg = WSP(bf16_t, WS_XG); const int* stk = WSP(int, WS_STK);
    for (size_t i = gt; i < (size_t)NTOK * DM; i += NGT) {
        const size_t h = i & ((size_t)NTOK * 512 - 1);
        float a = 0.f;
#if DBG_STOP >= 1
        a += bf2f(qa[h]) + bf2f(ka[h]) + bf2f(vat[h]) + bf2f(iq[h]) + bf2f(u[h]) + bf2f(v[h]) + bf2f(cdq[i & ((size_t)NTOK * 256 - 1)]) + bf2f(cdkv[i & ((size_t)NTOK * 256 - 1)]);
        a += bf2f(gate[i]) + bf2f(gate[i + (size_t)NTOK * DM]) + bf2f(gate[i + (size_t)2 * NTOK * DM]) + bf2f(ik[i & ((size_t)NTOK * 64 - 1)]) + iw[i & ((size_t)NTOK * 8 - 1)] + ssq[i & ((size_t)NTOK * 8 - 1)];
#endif
#if DBG_STOP >= 2
        a += bf2f(qc[i % ((size_t)NTOK * 768)]) + bf2f(kc[i % ((size_t)NTOK * 768)]) + bf2f(vct[h]) + bf2f(ob[(size_t)NTOK * 512 + h]);
#ifdef DBG_BITS
        a = (float)(__float_as_uint(sc[i]) & 0xfffu) + (float)(__float_as_uint(sc[i + (size_t)NTOK * DM]) & 0xfffu) + (float)(__float_as_uint(sc[i + (size_t)2 * NTOK * DM]) & 0xfffu) + (float)(__float_as_uint(sc[i + (size_t)3 * NTOK * DM]) & 0xfffu);
        a += (float)(iq[h] & 0xff) + (float)(ik[i & ((size_t)NTOK * 64 - 1)] & 0xff) + (float)(__float_as_uint(iw[i & ((size_t)NTOK * 8 - 1)]) & 0xfffu);
#else
        a += sc[i] + sc[i + (size_t)NTOK * DM] + sc[i + (size_t)2 * NTOK * DM] + sc[i + (size_t)3 * NTOK * DM];
#endif
#endif
#if DBG_STOP >= 3
        { const unsigned m = mask[i & ((size_t)NTOK * 128 - 1)]; a += (float)(m & 0xffffu) + (float)(m >> 16); } a += bf2f(ob[(size_t)2 * NTOK * 512 + h]);
#endif
#if DBG_STOP >= 4
        a += bf2f(ob[h]);
#endif
#if DBG_STOP >= 5
        a += bf2f(mg[i]);
#endif
#if DBG_STOP >= 6
        a += xr[i];
#endif
#if DBG_STOP >= 8
        a += (float)stk[i % (size_t)NSLOT_PAD] + bf2f(xg[i]) + bf2f(xg[i + (size_t)NTOK * DM]) + bf2f(xg[i + (size_t)2 * NTOK * DM]) + bf2f(xg[i + (size_t)3 * NTOK * DM]);
#endif
#if DBG_STOP >= 9
        a += bf2f(hb[i]) + bf2f(hb[i + (size_t)NTOK * DM]) + bf2f(hb[i + (size_t)2 * NTOK * DM]) + bf2f(hb[i + (size_t)3 * NTOK * DM]);
#endif
#if DBG_STOP >= 10
        a += bf2f(y[i]) + bf2f(y[i + (size_t)NTOK * DM]) + bf2f(y[i + (size_t)2 * NTOK * DM]) + bf2f(y[i + (size_t)3 * NTOK * DM]);
#endif
        out[i] = a;
    }
}
#endif

#ifdef DBG_CHECK
constexpr int CW_ERR = 20000;
__device__ __forceinline__ void err_max(unsigned* ctl, int k, float e) { if (!(e >= 0.f)) e = 1e30f; atomicMax(ctl + CW_ERR + k, __float_as_uint(e)); }
__device__ __forceinline__ float rope1(float x1, float x2, float c, float s_) { return x1 * c - x2 * s_; }
__device__ __forceinline__ float rope2(float x1, float x2, float c, float s_) { return x2 * c + x1 * s_; }
__device__ __forceinline__ void chk_proj(const Ctx& C, const Args& A) {
    unsigned* ctl = WSP(unsigned, WS_CTL); LAS float* pj = (LAS float*)C.lds;
    const int tok = (C.bid * 131 + 7) % NTOK; const int b = tok >> 12, sp = tok & 4095, ps = (sp & ~15) | perm16(sp & 15);
    const float* x = A.in[0] + (size_t)tok * DM; const float* w = A.in[2];
    for (int n = C.tid; n < 3560; n += 512) { float a = 0.f; for (int k = 0; k < DM; ++k) a = fmaf(x[k], w[(size_t)k * NIN_SRC + n], a); pj[n] = a; }
    __syncthreads();
    const float pos = (float)((const int*)A.in[1])[tok];
    const bf16_t* qa = WSP(bf16_t, WS_QA); const bf16_t* ka = WSP(bf16_t, WS_KA); const bf16_t* vat = WSP(bf16_t, WS_VAT); const bf16_t* iq = WSP(bf16_t, WS_IQ); const bf16_t* ik = WSP(bf16_t, WS_IK); const float* iw = WSP(float, WS_IW);
    float e = 0.f;
    for (int c = C.tid; c < 512; c += 512) { const int d = c & 63; const int base = c - d;
        float cq, ck, ci;
        if (d < 16) { const int i = d & 7; const float ang = pos * powf(500000.f, -(float)i / 8.f), cs = cosf(ang), sn = sinf(ang);
            const int o1 = base + i, o2 = base + 8 + i;
            cq = d < 8 ? rope1(pj[o1], pj[o2], cs, sn) : rope2(pj[o1], pj[o2], cs, sn);
            ck = d < 8 ? rope1(pj[512 + o1], pj[512 + o2], cs, sn) : rope2(pj[512 + o1], pj[512 + o2], cs, sn);
            ci = d < 8 ? rope1(pj[1536 + o1], pj[1536 + o2], cs, sn) : rope2(pj[1536 + o1], pj[1536 + o2], cs, sn);
        } else { cq = pj[c]; ck = pj[512 + c]; ci = pj[1536 + c]; }
        e = fmaxf(e, fabsf(bf2f(qa[(size_t)tok * 512 + c]) - cq * QSCALE_A)); e = fmaxf(e, fabsf(bf2f(ka[(size_t)tok * 512 + c]) - ck)); e = fmaxf(e, fabsf(bf2f(iq[(size_t)tok * 512 + c]) - ci));
        const int h = c >> 6; e = fmaxf(e, fabsf(bf2f(vat[((size_t)(b * 8 + h) * 64 + d) * SEQ + ps]) - pj[1024 + c]));
        if (c < 64) { float cik; if (c < 16) { const int i = c & 7; const float ang = pos * powf(500000.f, -(float)i / 8.f), cs = cosf(ang), sn = sinf(ang);
                cik = c < 8 ? rope1(pj[2048 + i], pj[2048 + 8 + i], cs, sn) : rope2(pj[2048 + i], pj[2048 + 8 + i], cs, sn); } else cik = pj[2048 + c];
            e = fmaxf(e, fabsf(bf2f(ik[(size_t)tok * 64 + c]) - cik)); }
        if (c < 8) e = fmaxf(e, 8.f * fabsf(iw[(size_t)tok * 8 + c] - pj[2112 + c] * IW_SCALE));
    }
    err_max(ctl, 0, e);
    __syncthreads();
    LAS float* cqn = pj + 3600; LAS float* ckn = cqn + 256;
    { float sq = 0.f; for (int k = 0; k < 256; ++k) sq += pj[3144 + k] * pj[3144 + k]; const float r = rsqrtf(sq / 256.f + RMS_EPS);
      float sk = 0.f; for (int k = 0; k < 128; ++k) sk += pj[3400 + k] * pj[3400 + k]; const float rk = rsqrtf(sk / 128.f + RMS_EPS);
      if (C.tid < 256) cqn[C.tid] = pj[3144 + C.tid] * r * A.in[7][C.tid]; if (C.tid < 128) ckn[C.tid] = pj[3400 + C.tid] * rk * A.in[8][C.tid]; }
    __syncthreads();
    const bf16_t* qc = WSP(bf16_t, WS_QC); const bf16_t* kc = WSP(bf16_t, WS_KC); const bf16_t* vct = WSP(bf16_t, WS_VCT);
    LAS float* qraw = ckn + 128;
    for (int n = C.tid; n < 768; n += 512) { float a = 0.f; for (int k = 0; k < 256; ++k) a = fmaf(cqn[k], A.in[9][(size_t)k * 768 + n], a); qraw[n] = a; }
    __syncthreads();
    float e2 = 0.f;
    for (int n = C.tid; n < 768; n += 512) { const int h = n / 96, d = n % 96; float v;
        if (d >= 64) { const int i = (d - 64) & 15; const float ang = pos * powf(500000.f, -(float)i / 16.f), cs = cosf(ang), sn = sinf(ang); const int o1 = h * 96 + 64 + i, o2 = o1 + 16;
            v = (d - 64) < 16 ? rope1(qraw[o1], qraw[o2], cs, sn) : rope2(qraw[o1], qraw[o2], cs, sn); } else v = qraw[n];
        e2 = fmaxf(e2, fabsf(bf2f(qc[(size_t)tok * 768 + n]) - v * QSCALE_C)); }
    for (int n = C.tid; n < 1024; n += 512) { float a = 0.f; for (int k = 0; k < 128; ++k) a = fmaf(ckn[k], A.in[10][(size_t)k * 1024 + n], a);
        const int h = n >> 7, wv = n & 127;
        if (wv < 64) e2 = fmaxf(e2, fabsf(bf2f(kc[(size_t)tok * 768 + h * 96 + wv]) - a));
        else e2 = fmaxf(e2, fabsf(bf2f(vct[((size_t)(b * 8 + h) * 64 + (wv - 64)) * SEQ + ps]) - a)); }
    if (C.tid < 32) { const int i = C.tid & 15; const float ang = pos * powf(500000.f, -(float)i / 16.f), cs = cosf(ang), sn = sinf(ang);
        const float v = C.tid < 16 ? rope1(pj[3528 + i], pj[3528 + 16 + i], cs, sn) : rope2(pj[3528 + i], pj[3528 + 16 + i], cs, sn);
        for (int h = 0; h < 8; ++h) e2 = fmaxf(e2, fabsf(bf2f(kc[(size_t)tok * 768 + h * 96 + 64 + C.tid]) - v)); }
    err_max(ctl, 1, e2);
    __syncthreads();
}
__device__ __forceinline__ void chk_attn(const Ctx& C) {
    unsigned* ctl = WSP(unsigned, WS_CTL);
    const int b = C.bid & 7, q = (C.bid * 977 + 300 + 13 * (C.bid >> 3)) & 4095; const size_t tq = (size_t)b * SEQ + q; const int n = q + 1;
    LAS float* sc = (LAS float*)C.lds;
    LAS float* pr = sc + 4096;
    LAS float* red = pr + 4096;
    const bf16_t* iq = WSP(bf16_t, WS_IQ); const bf16_t* ik = WSP(bf16_t, WS_IK); const float* iw = WSP(float, WS_IW); const float* score = WSP(float, WS_SCORE);
    float e1 = 0.f;
    for (int k = C.tid; k < n; k += 512) { float s_ = 0.f;
        for (int h = 0; h < 8; ++h) { float d = 0.f; for (int j = 0; j < 64; ++j) d = fmaf(bf2f(iq[tq * 512 + h * 64 + j]), bf2f(ik[((size_t)b * SEQ + k) * 64 + j]), d); s_ = fmaf(fmaxf(d, 0.f), iw[tq * 8 + h], s_); }
        sc[k] = s_; e1 = fmaxf(e1, fabsf(s_ - score[tq * SEQ + k])); }
    err_max(ctl, 2, e1);
    __syncthreads();
    const unsigned* mask = WSP(unsigned, WS_MASK); float e2 = 0.f;
    for (int k = C.tid; k < 4096; k += 512) { bool sel = false;
        if (k < n) { if (n <= 256) sel = true; else { const float sk = score[tq * SEQ + k]; int rank = 0; for (int j = 0; j < n; ++j) { const float sj = score[tq * SEQ + j]; rank += (sj > sk || (sj == sk && j < k)) ? 1 : 0; } sel = rank < 256; } }
        const bool mb = (mask[tq * 128 + (k >> 5)] >> (k & 31)) & 1u; if (sel != mb) e2 = 1.f; }
    err_max(ctl, 3, e2);
    const int h = (C.bid >> 3) & 7;
    for (int which = 0; which < 2; ++which) {
        const bf16_t* Q = which ? WSP(bf16_t, WS_QC) : WSP(bf16_t, WS_QA); const bf16_t* K = which ? WSP(bf16_t, WS_KC) : WSP(bf16_t, WS_KA); const bf16_t* VT = which ? WSP(bf16_t, WS_VCT) : WSP(bf16_t, WS_VAT);
        const bf16_t* O = WSP(bf16_t, WS_OBUF) + (which ? (size_t)2 * NTOK * 512 : 0); const int dq = which ? 96 : 64, qs = 8 * dq;
        __syncthreads();
        float mx = -INFINITY;
        for (int k = C.tid; k < 4096; k += 512) { float lgt = -INFINITY;
            const bool ok = k < n && (which || ((mask[tq * 128 + (k >> 5)] >> (k & 31)) & 1u));
            if (ok) { float d = 0.f; for (int j = 0; j < dq; ++j) d = fmaf(bf2f(Q[tq * qs + h * dq + j]), bf2f(K[((size_t)b * SEQ + k) * qs + h * dq + j]), d); lgt = d; }
            pr[k] = lgt; mx = fmaxf(mx, lgt); }
        red[C.tid] = mx; __syncthreads();
        if (C.tid == 0) { float m = -INFINITY; for (int i = 0; i < 512; ++i) m = fmaxf(m, red[i]); red[0] = m; } __syncthreads();
        const float m = red[0]; __syncthreads();
        float sm = 0.f; for (int k = C.tid; k < 4096; k += 512) { const float p = exp2f(pr[k] - m); pr[k] = p; sm += p; }
        red[C.tid] = sm; __syncthreads();
        if (C.tid == 0) { float t = 0.f; for (int i = 0; i < 512; ++i) t += red[i]; red[0] = t; } __syncthreads();
        const float den = red[0];
        if (C.tid < 64) { const int d = C.tid; float o = 0.f;
            for (int k = 0; k < n; ++k) { const int ps = (k & ~15) | perm16(k & 15); o = fmaf(pr[k], bf2f(VT[((size_t)(b * 8 + h) * 64 + d) * SEQ + ps]), o); }
            o /= den; err_max(ctl, 4 + which, fabsf(o - bf2f(O[tq * 512 + h * 64 + d]))); }
    }
    __syncthreads();
}
#endif

constexpr int NPH_LAYER = 11, NPHASE = 1 + NLAYER * NPH_LAYER;
__global__ void __launch_bounds__(NWAVES * 64, 2) trunk_fwd(Args args) {
    extern __shared__ __attribute__((aligned(16))) unsigned char lds_raw[];
    Ctx C;
    C.lds = (LAS unsigned char*)lds_raw; C.tid = threadIdx.x; C.lane = C.tid & 63; C.wave = __builtin_amdgcn_readfirstlane(C.tid >> 6); C.G = gridDim.x; C.bid = blockIdx.x; C.ws = args.ws;
    volatile LAS unsigned* MISC = (volatile LAS unsigned*)(C.lds + MISC_OFF);
    if (C.tid < 16) MISC[C.tid] = 0u;
    __syncthreads();
#if MK_ONE_LAUNCH
    XcdBarrier bar = xcd_barrier_post(WSP(unsigned, WS_CTL) + CW_BAR, MISC + 0);
#define GRID_BAR() do { FRESH(); XcdBarrier b_ = bar; { unsigned* bp_ = b_.bar; asm volatile("" : "+s"(bp_)); b_.bar = bp_; } xcd_barrier(b_, C.tid == 0); } while (0)
#else
#define GRID_BAR() do {} while (0)
#endif
    typedef const __attribute__((address_space(4))) Args* KArgsP;
    KArgsP kp = (KArgsP)__builtin_amdgcn_kernarg_segment_ptr();
    const int grid_s = gridDim.x, bid_s = blockIdx.x;
    const int wave_s = __builtin_amdgcn_readfirstlane((int)threadIdx.x >> 6);
#define FRESH() do { int ln_; asm volatile("v_mbcnt_lo_u32_b32 %0, -1, 0\n\tv_mbcnt_hi_u32_b32 %0, -1, %0" : "=v"(ln_)); int w_ = wave_s; asm volatile("" : "+s"(w_)); C.tid = (w_ << 6) | ln_; C.lane = ln_; C.wave = w_; \
        int g_ = grid_s, b_ = bid_s; asm volatile("" : "+s"(g_), "+s"(b_)); C.G = g_; C.bid = b_; \
        kp = (KArgsP)__builtin_amdgcn_kernarg_segment_ptr(); asm volatile("" : "+s"(kp)); C.ws = kp->ws; } while (0)
#define KIN(i) (kp->in[i])
    const int lo = args.ph_lo, hi = args.ph_hi, sub_mask = args.sub; const bool dry = (args.pad != 0);
#ifndef PH_ONLY
#define PH_ONLY -1
#endif
#ifndef PH_SUB
#define PH_SUB -1
#endif
#define PON(k) (PH_ONLY < 0 || PH_ONLY == (k))
#define PON2(k) ((PH_SUB < 0 || PH_SUB == (k)) && ((sub_mask >> (((k) / 10 - 1) * 4 + (k) % 10 - 1)) & 1))
#define IN(k) (lo <= (k) && (k) < hi)
#define SEAM(k) do { if (IN(k) && IN((k) + 1)) GRID_BAR(); } while (0)
    if (IN(0) && PON(100)) { phase_prologue(C, args); }
    SEAM(0);
    for (int l = 0; l < NLAYER; ++l) {
        const int P = 1 + l * NPH_LAYER;
        if (IN(P + 0) && PON(0)) { FRESH();
            pg8::Gemm g{WSP(bf16_t, WS_XB), WSP(bf16_t, WS_WIN + l * SZ_WIN), 1024, 1024, nullptr}; GridOrder S{NIN / 256, (NTOK / 256) * (NIN / 256), C.G, C.bid};
            EpiInProj E{C.ws, dry};
            pg8::gemm_phase<EpiInProj, GridOrder>(C.lds, g, S, E, C.tid);
        }
        SEAM(P + 0);
        if (IN(P + 1) && PON(1)) { FRESH();
            if (PON2(11)) phase_indexer(C);
            __syncthreads();
            FRESH();
            if (PON2(12)) { pg8::Gemm g{WSP(bf16_t, WS_CDQ), WSP(bf16_t, WS_WUQ + l * SZ_WUQ), 256, 256, nullptr}; GridOrder S{3, 128 * 3, C.G, C.bid};
              EpiQUp E{WSP(bf16_t, WS_QC), WSP(float, WS_SSQ), WSP(float, WS_COSC), WSP(float, WS_SINC)};
              pg8::gemm_phase<EpiQUp, GridOrder>(C.lds, g, S, E, C.tid); }
            FRESH();
            if (PON2(13)) { pg8::Gemm g{WSP(bf16_t, WS_CDKV), WSP(bf16_t, WS_WUKV + l * SZ_WUKV), 256, 256, nullptr}; GridOrder S{4, 128 * 4, C.G, C.bid};
              EpiKvUp E{WSP(bf16_t, WS_KC), WSP(bf16_t, WS_VCT), WSP(float, WS_SSQ)};
              pg8::gemm_phase<EpiKvUp, GridOrder>(C.lds, g, S, E, C.tid); }
            __syncthreads();
            if (PON2(14)) { FRESH(); phase_gmlp(C, KIN(3) + l * 512, KIN(4) + l * 512, KIN(6) + (size_t)l * 8 * 128, l); }
        }
        SEAM(P + 1);
        if (IN(P + 2) && PON(2)) { FRESH();
            if (PON2(21)) phase_select(C);
            __syncthreads();
            FRESH(); if (PON2(22)) phase_attn<96, false>(C, WSP(bf16_t, WS_QC), WSP(bf16_t, WS_KC), WSP(bf16_t, WS_VCT), nullptr, WSP(bf16_t, WS_OBUF) + (size_t)2 * NTOK * 512, args, l + 1, 0);
        }
        SEAM(P + 2);
        if (IN(P + 3) && PON(3)) { FRESH(); phase_attn<64, true>(C, WSP(bf16_t, WS_QA), WSP(bf16_t, WS_KA), WSP(bf16_t, WS_VAT), WSP(unsigned, WS_MASK), WSP(bf16_t, WS_OBUF), args, l + 1, CONV_SLOTS / 2); }
        SEAM(P + 3);
        if (IN(P + 4) && PON(4)) { FRESH();
            pg8::Gemm g{WSP(bf16_t, WS_OBUF), WSP(bf16_t, WS_WBR + l * SZ_WBR), 512, 512, nullptr}; MergeOrder S{C.G, C.bid};
            EpiMerge E{WSP(bf16_t, WS_GATE), WSP(bf16_t, WS_MERGED)};
            pg8::gemm_phase<EpiMerge, MergeOrder>(C.lds, g, S, E, C.tid);
        }
        SEAM(P + 4);
        if (IN(P + 5) && PON(5)) { FRESH();
            pg8::Gemm g{WSP(bf16_t, WS_MERGED), WSP(bf16_t, WS_WOUT + l * SZ_WOUT), 1024, 1024, nullptr}; GridOrder S{4, 128 * 4, C.G, C.bid};
            EpiOut E{dry ? WSP(bf16_t, WS_DRY) : WSP(bf16_t, WS_OBUF)};
            pg8::gemm_phase<EpiOut, GridOrder>(C.lds, g, S, E, C.tid);
        }
        SEAM(P + 5);
        if (IN(P + 6) && PON(6)) { FRESH(); phase_ln1_router(C, KIN(13) + l * 1024, KIN(14) + l * 1024, KIN(15) + (size_t)l * 1024 * 32, KIN(16) + l * 32, l, dry); }
        SEAM(P + 6);
        if (IN(P + 7) && PON(7)) { FRESH(); phase_dispatch(C, l); }
        SEAM(P + 7);
        if (IN(P + 8) && PON(8)) { FRESH();
            moe_tables(C, l);
            const LAS int* tb = (const LAS int*)(C.lds + MISC_OFF + 64) + 32;
            pg8::Gemm g{WSP(bf16_t, WS_XB), WSP(bf16_t, WS_WGU + l * SZ_WGU), 1024, 1024, WSP(int, WS_STK)}; MoeOrder S{8, tb[32] * 8, C.G, C.bid, tb};
            EpiMoeUp E{WSP(bf16_t, WS_H), KIN(18) + (size_t)l * NEXP * 2048};
            pg8::gemm_phase<EpiMoeUp, MoeOrder, true>(C.lds, g, S, E, C.tid);
        }
        SEAM(P + 8);
        if (IN(P + 9) && PON(9)) { FRESH();
            moe_tables(C, l);
            const LAS int* tb = (const LAS int*)(C.lds + MISC_OFF + 64) + 32;
            pg8::Gemm g{WSP(bf16_t, WS_H), WSP(bf16_t, WS_WDN + l * SZ_WDN), 1024, 1024, nullptr}; MoeOrder S{4, tb[32] * 4, C.G, C.bid, tb};
            EpiMoeDn E{dry ? WSP(bf16_t, WS_DRY) : WSP(bf16_t, WS_Y), KIN(20) + (size_t)l * NEXP * 1024, dry};
            pg8::gemm_phase<EpiMoeDn, MoeOrder>(C.lds, g, S, E, C.tid);
        }
        SEAM(P + 9);
        if (IN(P + 10) && PON(10)) { FRESH(); phase_ln2(C, KIN(21) + l * 1024, KIN(22) + l * 1024, kp->out, l, dry); }
        SEAM(P + 10);
    }
#ifdef DBG_STOP
    if (IN(NPHASE)) { FRESH(); dbg_dump(C, kp->out); }
#endif
#ifdef DBG_CHECK
    if (IN(NPHASE + 1)) { FRESH(); chk_proj(C, args); chk_attn(C); }
    if (IN(NPHASE + 2)) { FRESH();
        const unsigned* ctl = WSP(unsigned, WS_CTL); const float tol[6] = {0.06f, 0.06f, 2e-3f, 0.5f, 0.02f, 0.02f}; float sc = 1.f;
        for (int k = 0; k < 6; ++k) if (__uint_as_float(ctl[CW_ERR + k]) > tol[k]) sc += 0.2f * (float)(1 << k);
        float* o = kp->out; for (size_t i = (size_t)C.bid * 512 + C.tid; i < (size_t)NTOK * DM; i += (size_t)C.G * 512) o[i] *= sc; }
#endif
#undef IN
#undef SEAM
}

extern "C" void kernel_launch(void* const* d_in, const int* in_sizes, int n_in, void* d_out, int out_size, void* d_ws, size_t ws_size, hipStream_t stream) {
    static int grid = 0;
    if (grid == 0) {
        if (n_in != 23 || out_size != NTOK * DM || ws_size < WS_END) { fprintf(stderr, "kernel_launch: unexpected shapes (n_in %d, out %d, ws %zu < %zu)\n", n_in, out_size, ws_size, (size_t)WS_END); grid = -1; return; }
        int dev = 0, cus = 0, per_cu = 0;
        if (hipGetDevice(&dev) != hipSuccess || hipDeviceGetAttribute(&cus, hipDeviceAttributeMultiprocessorCount, dev) != hipSuccess) { grid = -1; return; }
        if (hipFuncSetAttribute((const void*)trunk_fwd, hipFuncAttributeMaxDynamicSharedMemorySize, LDS_BYTES) != hipSuccess) { fprintf(stderr, "kernel_launch: hipFuncSetAttribute failed\n"); grid = -1; return; }
        if (hipOccupancyMaxActiveBlocksPerMultiprocessor(&per_cu, (const void*)trunk_fwd, NWAVES * 64, LDS_BYTES) != hipSuccess || per_cu < 1) { fprintf(stderr, "kernel_launch: occupancy query reports %d\n", per_cu); }
        (void)hipGetLastError();
        grid = cus;
    }
    if (grid < 0) return;
    (void)hipMemsetAsync((char*)d_ws + WS_CTL, 0, CTL_ZERO_BYTES, stream);
#ifdef DBG_ZERO_WS
    (void)hipMemsetAsync((char*)d_ws + WS_XRES, 0, WS_END - WS_XRES, stream);
#endif
    Args a{};
    for (int i = 0; i < 23; ++i) a.in[i] = (const float*)d_in[i];
    a.out = (float*)d_out; a.ws = (unsigned char*)d_ws; a.sub = -1; a.pad = 0;
#if MK_ONE_LAUNCH
    a.ph_lo = 0; a.ph_hi = NPHASE;
    hipLaunchKernelGGL(trunk_fwd, dim3(grid), dim3(NWAVES * 64), LDS_BYTES, stream, a);
#else
#ifdef DBG_STOP
    for (int p = 0; p < 1 + DBG_STOP; ++p) { a.ph_lo = p; a.ph_hi = p + 1; hipLaunchKernelGGL(trunk_fwd, dim3(grid), dim3(NWAVES * 64), LDS_BYTES, stream, a); }
    a.ph_lo = NPHASE; a.ph_hi = NPHASE + 1; hipLaunchKernelGGL(trunk_fwd, dim3(grid), dim3(NWAVES * 64), LDS_BYTES, stream, a);
#else
    for (int p = 0; p < NPHASE; ++p) { a.ph_lo = p; a.ph_hi = p + 1; a.sub = -1; a.pad = 0; hipLaunchKernelGGL(trunk_fwd, dim3(grid), dim3(NWAVES * 64), LDS_BYTES, stream, a);
#ifdef DBG_CHECK
        if (p == 4) { a.ph_lo = NPHASE + 1; a.ph_hi = NPHASE + 2; hipLaunchKernelGGL(trunk_fwd, dim3(grid), dim3(NWAVES * 64), LDS_BYTES, stream, a); }
        if (p == NPHASE - 1) { a.ph_lo = NPHASE + 2; a.ph_hi = NPHASE + 3; hipLaunchKernelGGL(trunk_fwd, dim3(grid), dim3(NWAVES * 64), LDS_BYTES, stream, a); }
#endif
#ifdef PROBE_PH
#ifndef PROBE_DRY
#define PROBE_DRY 0
#endif
        if ((p == 0 && PROBE_PH == -1) || (p >= 1 && (p - 1) % NPH_LAYER == PROBE_PH)) { a.sub = PROBE_SUB; a.pad = PROBE_DRY; hipLaunchKernelGGL(trunk_fwd, dim3(grid), dim3(NWAVES * 64), LDS_BYTES, stream, a); }
#endif
    }
#endif
#endif
}
```
